# Optimizing an MI355X kernel written in HIP

```python
import jax, jax.numpy as jnp
from jax import lax
import numpy as np

D_MODEL = 1024
BATCH = 4
SEQ = 4096
DEPTH = 2
DEC_BATCH = 128
DEC_SEQ = 1
PAST_LEN = 8192
PAGE_SIZE = 128

N_MIXERS = 2
HEAD_DIM = 64
RWKV_HEADS = D_MODEL // HEAD_DIM
DECAY_LORA = 64
AAA_LORA = 64
GATE_LORA = 128
N_MIX_VEC = 6
ATT_HEADS = D_MODEL // HEAD_DIM
KV_HEADS = 4
GROUP = ATT_HEADS // KV_HEADS
WINDOW = 128
ATT_BLOCK = 128
ROPE_DIM = HEAD_DIM // 4
ROPE_THETA = 500000.0
D_FF = 4 * D_MODEL
N_RWKV = (DEPTH + N_MIXERS - 1) // N_MIXERS
N_ATTN = DEPTH // N_MIXERS
NORM_EPS = 1e-6
LNX_EPS = 64e-5
N_ADA = 6

kernel_name = 'rwkv7_swa_sink_hybrid_decode_step'


def rms_norm(x, g):
    xf = x.astype(jnp.float32)
    y = xf * lax.rsqrt(jnp.mean(xf * xf, axis=-1, keepdims=True) + NORM_EPS)
    return (y * g.astype(jnp.float32)).astype(x.dtype)


def ada_params(c, w, b):
    m = jax.nn.silu(c) @ w + b
    m = m.reshape(c.shape[0], N_ADA, 1, D_MODEL)
    return [m[:, i] for i in range(N_ADA)]


def pre_norm(x, g, shift, scale):
    return rms_norm(x, g) * (1 + scale) + shift


def rope_partial(x, pos):
    half = ROPE_DIM // 2
    inv_freq = ROPE_THETA ** (-jnp.arange(half, dtype=jnp.float32) / half)
    ang = pos.astype(jnp.float32)[:, None] * inv_freq[None, :]
    cos = jnp.cos(ang)[:, None, :]
    sin = jnp.sin(ang)[:, None, :]
    xf = x[..., :ROPE_DIM].astype(jnp.float32)
    x1, x2 = xf[..., :half], xf[..., half:]
    rot = jnp.concatenate([x1 * cos - x2 * sin, x2 * cos + x1 * sin], axis=-1).astype(x.dtype)
    return jnp.concatenate([rot, x[..., ROPE_DIM:]], axis=-1)


def sink_softmax(scores, sink):
    s = sink[:, :, None, None]
    m = jnp.maximum(jnp.max(scores, axis=-1, keepdims=True), s)
    p = jnp.exp(scores - m)
    return p / (jnp.sum(p, axis=-1, keepdims=True) + jnp.exp(s - m))


def sq_relu_mlp(h, w_up, w_down):
    return jnp.square(jax.nn.relu(h @ w_up)) @ w_down


def wkv7_step(state, inp):
    r_t, w_t, k_t, v_t, a_t, b_t = inp
    sa = jnp.einsum('bhij,bhj->bhi', state, a_t)
    state = (state * w_t[:, :, None, :] + sa[..., None] * b_t[:, :, None, :]
             + v_t[..., None] * k_t[:, :, None, :])
    y = jnp.einsum('bhij,bhj->bhi', state, r_t)
    return state, y


def rwkv7_time_mix(h, shift_prev, wkv_prev, mix, w_r, w_k, w_v, w_o, w0, w1, w2,
                   a0, a1, a2, g1, g2, k_k, k_a, r_k, lnx_g, lnx_b):
    B, S, D = h.shape
    H, N = RWKV_HEADS, HEAD_DIM
    f32 = jnp.float32
    prev = jnp.concatenate([shift_prev[:, None, :].astype(h.dtype), h[:, :-1]], axis=1)
    xx = prev - h
    xr, xw, xk, xv, xa, xg = [h + xx * mix[i] for i in range(N_MIX_VEC)]
    r = xr @ w_r
    k = xk @ w_k
    v = xv @ w_v
    w = -jax.nn.softplus(-(w0 + jnp.tanh(xw @ w1) @ w2)) - 0.5
    a = jax.nn.sigmoid(a0 + (xa @ a1) @ a2)
    g = jax.nn.sigmoid(xg @ g1) @ g2
    heads = lambda t: t.reshape(B, S, H, N).astype(f32)
    kk = heads(k * k_k)
    kk = kk / jnp.maximum(jnp.sqrt(jnp.sum(kk * kk, axis=-1, keepdims=True)), 1e-12)
    k = k * (1 + (a - 1) * k_a)
    r_h, k_h, v_h, a_h = heads(r), heads(k), heads(v), heads(a)
    decay = jnp.exp(-jnp.exp(heads(w)))
    seq_first = lambda t: jnp.moveaxis(t, 1, 0)
    xs = tuple(seq_first(t) for t in (r_h, decay, k_h, v_h, -kk, kk * a_h))
    state, y = lax.scan(wkv7_step, wkv_prev.astype(f32), xs)
    y = jnp.moveaxis(y, 0, 1)
    mu = jnp.mean(y, axis=-1, keepdims=True)
    var = jnp.mean(jnp.square(y - mu), axis=-1, keepdims=True)
    y = ((y - mu) * lax.rsqrt(var + LNX_EPS) * lnx_g.astype(f32).reshape(H, N)
         + lnx_b.astype(f32).reshape(H, N))
    bonus = jnp.sum(r_h * k_h * r_k.astype(f32), axis=-1, keepdims=True) * v_h
    out = ((y + bonus).reshape(B, S, D).astype(h.dtype) * g) @ w_o
    return out, h[:, -1], state.astype(wkv_prev.dtype)


def qkv_proj(h, w_qkv, b_qkv, pos):
    B, S, _ = h.shape
    qkv = h @ w_qkv + b_qkv
    nq, nk = ATT_HEADS * HEAD_DIM, KV_HEADS * HEAD_DIM
    q = qkv[..., :nq].reshape(B, S, ATT_HEADS, HEAD_DIM)
    k = qkv[..., nq:nq + nk].reshape(B, S, KV_HEADS, HEAD_DIM)
    v = qkv[..., nq + nk:].reshape(B, S, KV_HEADS, HEAD_DIM)
    return rope_partial(q, pos), rope_partial(k, pos), v


def swa_prompt(h, w_qkv, b_qkv, w_o, sink):
    B, S, _ = h.shape
    pos = jnp.arange(S, dtype=jnp.int32)
    q, k, v = qkv_proj(h, w_qkv, b_qkv, pos)
    nb = S // ATT_BLOCK
    qb = q.reshape(B, nb, ATT_BLOCK, KV_HEADS, GROUP, HEAD_DIM)
    kb = k.reshape(B, nb, ATT_BLOCK, KV_HEADS, HEAD_DIM)
    vb = v.reshape(B, nb, ATT_BLOCK, KV_HEADS, HEAD_DIM)

    def with_prev(t):
        prev = jnp.concatenate([jnp.zeros_like(t[:, :1]), t[:, :-1]], axis=1)
        return jnp.concatenate([prev, t], axis=2)

    kw, vw = with_prev(kb), with_prev(vb)
    scores = jnp.einsum('bnqkgd,bnskd->bnkgqs', qb, kw,
                        preferred_element_type=jnp.float32) * (HEAD_DIM ** -0.5)
    blk = jnp.arange(nb, dtype=jnp.int32)[:, None, None]
    qpos = blk * ATT_BLOCK + jnp.arange(ATT_BLOCK, dtype=jnp.int32)[None, :, None]
    kpos = (blk - 1) * ATT_BLOCK + jnp.arange(2 * ATT_BLOCK, dtype=jnp.int32)[None, None, :]
    mask = (kpos <= qpos) & (kpos >= qpos - WINDOW) & (kpos >= 0)
    scores = jnp.where(mask[None, :, None, None], scores, -jnp.inf)
    probs = sink_softmax(scores, sink.astype(jnp.float32).reshape(KV_HEADS, GROUP)).astype(h.dtype)
    o = jnp.einsum('bnkgqs,bnskd->bnqkgd', probs, vw).reshape(B, S, ATT_HEADS * HEAD_DIM)
    w_keep = min(WINDOW, S)
    return o @ w_o, k[:, S - w_keep:], v[:, S - w_keep:]


def swa_sample(h, k_buf, v_buf, w_qkv, b_qkv, w_o, sink):
    B, S, _ = h.shape
    W = k_buf.shape[1]
    qpos = PAST_LEN + jnp.arange(S, dtype=jnp.int32)
    q, k, v = qkv_proj(h, w_qkv, b_qkv, qpos)
    k_all = jnp.concatenate([k_buf.astype(k.dtype), k], axis=1)
    v_all = jnp.concatenate([v_buf.astype(v.dtype), v], axis=1)
    kpos = jnp.concatenate([PAST_LEN - W + jnp.arange(W, dtype=jnp.int32), qpos])
    mask = (kpos[None, :] <= qpos[:, None]) & (kpos[None, :] >= qpos[:, None] - WINDOW)
    qg = q.reshape(B, S, KV_HEADS, GROUP, HEAD_DIM)
    scores = jnp.einsum('bqkgd,bskd->bkgqs', qg, k_all,
                        preferred_element_type=jnp.float32) * (HEAD_DIM ** -0.5)
    scores = jnp.where(mask, scores, -jnp.inf)
    probs = sink_softmax(scores, sink.astype(jnp.float32).reshape(KV_HEADS, GROUP)).astype(h.dtype)
    o = jnp.einsum('bkgqs,bskd->bqkgd', probs, v_all).reshape(B, S, ATT_HEADS * HEAD_DIM)
    return o @ w_o, k_all[:, S:], v_all[:, S:]


def setup_inputs(seed: int = 0) -> dict:
    key = jax.random.key(seed)
    ks = iter(jax.random.split(key, 64))
    f32 = jnp.float32

    def nrm(shape, scale):
        return jax.random.normal(next(ks), shape, f32) * scale

    def uni(shape, lo, hi):
        return jax.random.uniform(next(ks), shape, f32, lo, hi)

    D, H, N = D_MODEL, RWKV_HEADS, HEAD_DIM
    w_buf = min(WINDOW, PAST_LEN)
    qkv_out = (ATT_HEADS + 2 * KV_HEADS) * HEAD_DIM
    return {
        'x_prompt': nrm((BATCH, SEQ, D), 1.0),
        'x_sample': nrm((DEC_BATCH, DEC_SEQ, D), 1.0),
        'c_prompt': nrm((BATCH, D), 1.0),
        'c_sample': nrm((DEC_BATCH, D), 1.0),
        'state_wkv': nrm((N_RWKV, DEC_BATCH, H, N, N), 0.3),
        'state_shift': nrm((N_RWKV, DEC_BATCH, D), 1.0),
        'cache_k': nrm((N_ATTN, DEC_BATCH, w_buf, KV_HEADS, HEAD_DIM), 1.0),
        'cache_v': nrm((N_ATTN, DEC_BATCH, w_buf, KV_HEADS, HEAD_DIM), 1.0),
        'norm1_g': 1.0 + nrm((DEPTH, D), 0.05),
        'norm2_g': 1.0 + nrm((DEPTH, D), 0.05),
        'ada_w': nrm((DEPTH, D, N_ADA * D), 0.5 * D ** -0.5),
        'ada_b': nrm((DEPTH, N_ADA * D), 0.02),
        'mlp_up': nrm((DEPTH, D, D_FF), D ** -0.5),
        'mlp_down': nrm((DEPTH, D_FF, D), D_FF ** -0.5),
        'final_g': 1.0 + nrm((D,), 0.05),
        'rw_mix': uni((N_RWKV, N_MIX_VEC, D), 0.0, 1.0),
        'rw_wr': nrm((N_RWKV, D, D), D ** -0.5),
        'rw_wk': nrm((N_RWKV, D, D), D ** -0.5),
        'rw_wv': nrm((N_RWKV, D, D), D ** -0.5),
        'rw_wo': nrm((N_RWKV, D, D), D ** -0.5),
        'rw_w0': uni((N_RWKV, D), -6.0, 1.0),
        'rw_w1': nrm((N_RWKV, D, DECAY_LORA), D ** -0.5),
        'rw_w2': nrm((N_RWKV, DECAY_LORA, D), 0.5 * DECAY_LORA ** -0.5),
        'rw_a0': nrm((N_RWKV, D), 0.5),
        'rw_a1': nrm((N_RWKV, D, AAA_LORA), D ** -0.5),
        'rw_a2': nrm((N_RWKV, AAA_LORA, D), 0.5 * AAA_LORA ** -0.5),
        'rw_g1': nrm((N_RWKV, D, GATE_LORA), D ** -0.5),
        'rw_g2': nrm((N_RWKV, GATE_LORA, D), GATE_LORA ** -0.5),
        'rw_kk': 0.85 + nrm((N_RWKV, D), 0.05),
        'rw_ka': 1.0 + nrm((N_RWKV, D), 0.05),
        'rw_rk': nrm((N_RWKV, H, N), 0.1),
        'rw_lnx_g': 1.0 + nrm((N_RWKV, D), 0.05),
        'rw_lnx_b': nrm((N_RWKV, D), 0.02),
        'at_wqkv': nrm((N_ATTN, D, qkv_out), D ** -0.5),
        'at_bqkv': nrm((N_ATTN, qkv_out), 0.02),
        'at_wo': nrm((N_ATTN, ATT_HEADS * HEAD_DIM, D), (ATT_HEADS * HEAD_DIM) ** -0.5),
        'at_sink': nrm((N_ATTN, ATT_HEADS), 1.0),
    }


def reference(x_prompt, x_sample, c_prompt, c_sample, state_wkv, state_shift, cache_k, cache_v,
              norm1_g, norm2_g, ada_w, ada_b, mlp_up, mlp_down, final_g,
              rw_mix, rw_wr, rw_wk, rw_wv, rw_wo, rw_w0, rw_w1, rw_w2, rw_a0, rw_a1, rw_a2,
              rw_g1, rw_g2, rw_kk, rw_ka, rw_rk, rw_lnx_g, rw_lnx_b,
              at_wqkv, at_bqkv, at_wo, at_sink):
    xp, xs = x_prompt, x_sample
    bp = xp.shape[0]
    wkv_p, wkv_s, sh_p, sh_s = [], [], [], []
    k_p, k_s, v_p, v_s = [], [], [], []
    for i in range(DEPTH):
        mp = ada_params(c_prompt, ada_w[i], ada_b[i])
        ms = ada_params(c_sample, ada_w[i], ada_b[i])
        hp = pre_norm(xp, norm1_g[i], mp[0], mp[1])
        hs = pre_norm(xs, norm1_g[i], ms[0], ms[1])
        j = i // N_MIXERS
        if i % N_MIXERS == 0:
            prm = (rw_mix[j], rw_wr[j], rw_wk[j], rw_wv[j], rw_wo[j], rw_w0[j], rw_w1[j], rw_w2[j],
                   rw_a0[j], rw_a1[j], rw_a2[j], rw_g1[j], rw_g2[j], rw_kk[j], rw_ka[j], rw_rk[j],
                   rw_lnx_g[j], rw_lnx_b[j])
            zero_shift = jnp.zeros((bp, D_MODEL), hp.dtype)
            zero_wkv = jnp.zeros((bp, RWKV_HEADS, HEAD_DIM, HEAD_DIM), hp.dtype)
            op, shift_new_p, wkv_new_p = rwkv7_time_mix(hp, zero_shift, zero_wkv, *prm)
            os_, shift_new_s, wkv_new_s = rwkv7_time_mix(hs, state_shift[j], state_wkv[j], *prm)
            sh_p.append(shift_new_p)
            wkv_p.append(wkv_new_p)
            sh_s.append(shift_new_s)
            wkv_s.append(wkv_new_s)
        else:
            op, kn_p, vn_p = swa_prompt(hp, at_wqkv[j], at_bqkv[j], at_wo[j], at_sink[j])
            os_, kn_s, vn_s = swa_sample(hs, cache_k[j], cache_v[j], at_wqkv[j], at_bqkv[j],
                                        at_wo[j], at_sink[j])
            k_p.append(kn_p)
            v_p.append(vn_p)
            k_s.append(kn_s)
            v_s.append(vn_s)
        xp = xp + mp[2] * op
        xs = xs + ms[2] * os_
        hp = pre_norm(xp, norm2_g[i], mp[3], mp[4])
        hs = pre_norm(xs, norm2_g[i], ms[3], ms[4])
        xp = xp + mp[5] * sq_relu_mlp(hp, mlp_up[i], mlp_down[i])
        xs = xs + ms[5] * sq_relu_mlp(hs, mlp_up[i], mlp_down[i])
    y_prompt = rms_norm(xp, final_g)
    y_sample = rms_norm(xs, final_g)
    return (y_prompt, y_sample, jnp.stack(wkv_p), jnp.stack(wkv_s), jnp.stack(sh_p), jnp.stack(sh_s),
            jnp.stack(k_p), jnp.stack(k_s), jnp.stack(v_p), jnp.stack(v_s))
```

```cpp
#include <hip/hip_runtime.h>
#include <hip/hip_cooperative_groups.h>
#include <cstdio>
namespace cg = cooperative_groups;

typedef unsigned short u16;
typedef __attribute__((ext_vector_type(8))) short bf16x8;
typedef __attribute__((ext_vector_type(4))) float f32x4;

constexpr int NP = 16384, MROWS = 16512, MPAD = 16640;
constexpr int NTHR = 512;
constexpr size_t MEG = 1048576;

constexpr size_t O_Y = 0, O_WKVP = 16908288, O_WKVS = 17170432, O_SHP = 25559040, O_SHS = 25563136,
                 O_KP = 25694208, O_KS = 25825280, O_VP = 30019584, O_VS = 30150656;

constexpr size_t WT_WR = 0, WT_WK = MEG, WT_WV = 2 * MEG, WT_WO = 3 * MEG, WT_W1 = 4 * MEG, WT_A1 = WT_W1 + 65536,
                 WT_G1 = WT_A1 + 65536, WT_W2 = WT_G1 + 131072, WT_A2 = WT_W2 + 65536, WT_G2 = WT_A2 + 65536,
                 WT_UP0 = WT_G2 + 131072, WT_DN0 = WT_UP0 + 4 * MEG, WT_QKV = WT_DN0 + 4 * MEG, WT_WO1 = WT_QKV + 1536 * 1024,
                 WT_UP1 = WT_WO1 + MEG, WT_DN1 = WT_UP1 + 4 * MEG, WT_END = WT_DN1 + 4 * MEG;
constexpr size_t WS_WT = 0;
constexpr size_t WS_H = WS_WT + WT_END * 2;
constexpr size_t WS_MOD = WS_H + (size_t)MPAD * 1024 * 2;
constexpr size_t WS_TAB = WS_MOD + (size_t)2 * 132 * 6144 * 4;
constexpr size_t WS_HS = WS_TAB + (size_t)4097 * 8 * 8;
constexpr size_t WS_ZR = WS_HS + (size_t)128 * 1024 * 2;
constexpr size_t WS_RK = WS_ZR + 2048;
constexpr size_t WS_S = WS_RK + (size_t)MPAD * 16 * 4;
constexpr size_t RSZ = (size_t)MROWS * 1024 * 2;
constexpr size_t S_ADAWT = WS_S, S_SILUC = S_ADAWT + (size_t)2 * 6144 * 1024 * 2;
constexpr size_t S_R = WS_S, S_K = S_R + RSZ, S_V = S_K + RSZ, S_EW = S_V + RSZ, S_A = S_EW + RSZ,
                 S_WH = S_A + RSZ, S_AH = S_WH + (size_t)MPAD * 64 * 2, S_GH = S_AH + (size_t)MPAD * 64 * 2,
                 S_RW_END = S_GH + (size_t)MPAD * 128 * 2;
constexpr size_t S_UP = WS_S;
constexpr size_t S_Q = WS_S, S_O = S_Q + (size_t)MPAD * 1024 * 2, S_KB = S_O + (size_t)MPAD * 1024 * 2,
                 S_VT = S_KB + (size_t)MPAD * 256 * 2;
constexpr size_t WS_END = S_RW_END;
static_assert(S_UP + (size_t)MPAD * 4096 * 2 <= WS_END, "up fits");
static_assert(S_VT + (size_t)16 * 64 * 4096 * 2 <= WS_END, "attn fits");
static_assert(WS_END <= 268435456, "ws fits 256MiB");

constexpr int LDS_ROW = 144;
constexpr int LDS_A_BYTES = 256 * LDS_ROW;
constexpr int LDS_B_BYTES = 128 * LDS_ROW;
constexpr int LDS_STAGE = LDS_A_BYTES + LDS_B_BYTES;
constexpr int LDS_BYTES = 115712;

struct Params {
  const float *x_prompt, *x_sample, *c_prompt, *c_sample, *state_wkv, *state_shift, *cache_k, *cache_v;
  const float *norm1_g, *norm2_g, *ada_w, *ada_b, *mlp_up, *mlp_down, *final_g;
  const float *rw_mix, *rw_wr, *rw_wk, *rw_wv, *rw_wo, *rw_w0, *rw_w1, *rw_w2, *rw_a0, *rw_a1, *rw_a2, *rw_g1, *rw_g2,
      *rw_kk, *rw_ka, *rw_rk, *rw_lnx_g, *rw_lnx_b;
  const float *at_wqkv, *at_bqkv, *at_wo, *at_sink;
  float* out;
  char* ws;
};

__device__ __forceinline__ u16 f2bf(float f) {
  unsigned u = __float_as_uint(f);
  u += 0x7fffu + ((u >> 16) & 1u);
  return (u16)(u >> 16);
}
__device__ __forceinline__ float bf2f(u16 h) { return __uint_as_float(((unsigned)h) << 16); }
__device__ __forceinline__ float bflo(unsigned w) { return __uint_as_float(w << 16); }
__device__ __forceinline__ float bfhi(unsigned w) { return __uint_as_float(w & 0xffff0000u); }
__device__ __forceinline__ unsigned pack2(float a, float b) { return (unsigned)f2bf(a) | (((unsigned)f2bf(b)) << 16); }
__device__ __forceinline__ float h2f(u16 h) { return (float)__builtin_bit_cast(_Float16, h); }
__device__ __forceinline__ u16 f2h(float f) { return __builtin_bit_cast(u16, (_Float16)f); }
__device__ __forceinline__ float sigmoidf_(float x) { return 1.f / (1.f + __expf(-x)); }

template <int CTRL>
__device__ __forceinline__ float dppf(float x) {
  return __int_as_float(__builtin_amdgcn_update_dpp(0, __float_as_int(x), CTRL, 0xf, 0xf, true));
}
__device__ __forceinline__ float rowsum16(float x) {
  x += dppf<0xB1>(x);
  x += dppf<0x4E>(x);
  x += dppf<0x124>(x);
  x += dppf<0x128>(x);
  return x;
}
__device__ __forceinline__ float rowmax16(float x) {
  x = fmaxf(x, dppf<0xB1>(x));
  x = fmaxf(x, dppf<0x4E>(x));
  x = fmaxf(x, dppf<0x124>(x));
  x = fmaxf(x, dppf<0x128>(x));
  return x;
}
__device__ __forceinline__ float wavesum(float x) {
#pragma unroll
  for (int o = 32; o > 0; o >>= 1) x += __shfl_xor(x, o);
  return x;
}
__device__ __forceinline__ float wavemax(float x) {
#pragma unroll
  for (int o = 32; o > 0; o >>= 1) x = fmaxf(x, __shfl_xor(x, o));
  return x;
}
__device__ __forceinline__ int bidx_of(int row) { return row < NP ? (row >> 12) : (4 + row - NP); }

struct MixSrc {
  const u16* hs;
  const u16* zr;
  const float* mix;
};

__device__ __forceinline__ unsigned mix2(unsigned h, unsigned p, float m0, float m1) {
  float h0 = bflo(h), h1 = bfhi(h), p0 = bflo(p), p1 = bfhi(p);
  return pack2(h0 + (p0 - h0) * m0, h1 + (p1 - h1) * m1);
}

template <bool MIX, class Epi>
__device__ __forceinline__ void gemm_tile(const u16* __restrict__ A, int lda, MixSrc ms, const u16* __restrict__ Bt, int N, int K,
                                          int m0, int n0, char* lds, Epi&& epi) {
  const int tid = threadIdx.x, lane = tid & 63, w = tid >> 6;
  const int wm = w >> 1, wn = w & 1, lr = lane & 15, lg = lane >> 4;
  const int kc = tid & 7, r0 = tid >> 3;
  const u16* ap[4];
  const u16* pp[4];
#pragma unroll
  for (int i = 0; i < 4; ++i) {
    int row = m0 + r0 + 64 * i;
    ap[i] = A + (size_t)row * lda + kc * 8;
    pp[i] = ap[i];
    if (MIX) {
      const u16* q;
      if (row < NP) q = (row & 4095) ? (A + (size_t)(row - 1) * lda) : ms.zr;
      else if (row < MROWS) q = ms.hs + (size_t)(row - NP) * 1024;
      else q = ms.zr;
      pp[i] = q + kc * 8;
    }
  }
  const u16* bp[2];
  bool bv[2];
#pragma unroll
  for (int j = 0; j < 2; ++j) {
    int n = n0 + r0 + 64 * j;
    bv[j] = n < N;
    bp[j] = Bt + (size_t)(bv[j] ? n : 0) * K + kc * 8;
  }
  uint4 ra[4], rp[4], rb[2];
  float4 mx0, mx1;
  auto gload = [&](int kt) {
    const int ko = kt * 64;
#pragma unroll
    for (int i = 0; i < 4; ++i) {
      ra[i] = *(const uint4*)(ap[i] + ko);
      if (MIX) rp[i] = *(const uint4*)(pp[i] + ko);
    }
    if (MIX) {
      mx0 = *(const float4*)(ms.mix + ko + kc * 8);
      mx1 = *(const float4*)(ms.mix + ko + kc * 8 + 4);
    }
#pragma unroll
    for (int j = 0; j < 2; ++j) {
      uint4 z = {0u, 0u, 0u, 0u};
      if (bv[j]) z = *(const uint4*)(bp[j] + ko);
      rb[j] = z;
    }
  };
  auto lstore = [&](int s) {
    char* base = lds + s * LDS_STAGE;
#pragma unroll
    for (int i = 0; i < 4; ++i) {
      uint4 v = ra[i];
      if (MIX) {
        v.x = mix2(ra[i].x, rp[i].x, mx0.x, mx0.y);
        v.y = mix2(ra[i].y, rp[i].y, mx0.z, mx0.w);
        v.z = mix2(ra[i].z, rp[i].z, mx1.x, mx1.y);
        v.w = mix2(ra[i].w, rp[i].w, mx1.z, mx1.w);
      }
      *(uint4*)(base + (r0 + 64 * i) * LDS_ROW + kc * 16) = v;
    }
#pragma unroll
    for (int j = 0; j < 2; ++j) *(uint4*)(base + LDS_A_BYTES + (r0 + 64 * j) * LDS_ROW + kc * 16) = rb[j];
  };
  f32x4 acc[4][4];
#pragma unroll
  for (int i = 0; i < 4; ++i)
#pragma unroll
    for (int j = 0; j < 4; ++j) acc[i][j] = f32x4{0.f, 0.f, 0.f, 0.f};
  const int nk = K >> 6;
  gload(0);
  lstore(0);
  __syncthreads();
#pragma unroll 1
  for (int kt = 0; kt < nk; ++kt) {
    if (kt + 1 < nk) gload(kt + 1);
    const char* sa = lds + (kt & 1) * LDS_STAGE + (wm * 64 + lr) * LDS_ROW + lg * 16;
    const char* sb = lds + (kt & 1) * LDS_STAGE + LDS_A_BYTES + (wn * 64 + lr) * LDS_ROW + lg * 16;
#pragma unroll
    for (int ks = 0; ks < 2; ++ks) {
      bf16x8 af[4], bfg[4];
#pragma unroll
      for (int mi = 0; mi < 4; ++mi) af[mi] = *(const bf16x8*)(sa + mi * 16 * LDS_ROW + ks * 64);
#pragma unroll
      for (int ni = 0; ni < 4; ++ni) bfg[ni] = *(const bf16x8*)(sb + ni * 16 * LDS_ROW + ks * 64);
#pragma unroll
      for (int mi = 0; mi < 4; ++mi)
#pragma unroll
        for (int ni = 0; ni < 4; ++ni)
          acc[mi][ni] = __builtin_amdgcn_mfma_f32_16x16x32_bf16(af[mi], bfg[ni], acc[mi][ni], 0, 0, 0);
    }
    if (kt + 1 < nk) lstore((kt + 1) & 1);
    __syncthreads();
  }
  epi(acc);
}

#define GEMM_LANE_VARS                                            \
  const int tid_ = threadIdx.x, lane_ = tid_ & 63, w_ = tid_ >> 6; \
  const int wm = w_ >> 1, wn = w_ & 1, lr = lane_ & 15, lg = lane_ >> 4; \
  (void)wm; (void)wn; (void)lr; (void)lg;

#define EPI_FOREACH(acc, BODY)                                         \
  _Pragma("unroll") for (int mi = 0; mi < 4; ++mi) {                   \
  _Pragma("unroll") for (int r = 0; r < 4; ++r)                        \
  _Pragma("unroll") for (int ni = 0; ni < 4; ++ni) {                   \
    const int row = m0 + wm * 64 + mi * 16 + lg * 4 + r;               \
    const int col = n0 + wn * 64 + ni * 16 + lr;                       \
    const float v = acc[mi][ni][r];                                    \
    BODY                                                               \
  }                                                                    \
  __builtin_amdgcn_sched_barrier(0); }

__device__ __forceinline__ void conv_job(const float* __restrict__ src, u16* __restrict__ dst, int K, int N, float* tl, int rot) {
  const int tid = threadIdx.x;
  const int tn = N >> 6, nt = (K >> 6) * tn;
  const int G = gridDim.x;
  int start = ((int)blockIdx.x + G - (rot % G)) % G;
  for (int t = start; t < nt; t += G) {
    const int k0 = (t / tn) << 6, n0 = (t % tn) << 6;
#pragma unroll
    for (int i = 0; i < 8; ++i) {
      int e = tid + 512 * i;
      tl[(e >> 6) * 65 + (e & 63)] = src[(size_t)(k0 + (e >> 6)) * N + n0 + (e & 63)];
    }
    __syncthreads();
    const int n = tid >> 3, kc = tid & 7;
    float f[8];
#pragma unroll
    for (int j = 0; j < 8; ++j) f[j] = tl[(kc * 8 + j) * 65 + n];
    uint4 v;
    v.x = pack2(f[0], f[1]);
    v.y = pack2(f[2], f[3]);
    v.z = pack2(f[4], f[5]);
    v.w = pack2(f[6], f[7]);
    *(uint4*)(dst + (size_t)(n0 + n) * K + k0 + kc * 8) = v;
    __syncthreads();
  }
}

__device__ __forceinline__ void phase0(const Params& p, char* lds) {
  float* tl = (float*)lds;
  u16* wt = (u16*)(p.ws + WS_WT);
  u16* adawt = (u16*)(p.ws + S_ADAWT);
  int rot = 0;
#define CJ(SRC, DST, K, N)            \
  conv_job(SRC, DST, K, N, tl, rot);  \
  rot += ((K) >> 6) * ((N) >> 6);
  CJ(p.ada_w, adawt, 1024, 6144)
  CJ(p.ada_w + (size_t)1024 * 6144, adawt + (size_t)6144 * 1024, 1024, 6144)
  CJ(p.rw_wr, wt + WT_WR, 1024, 1024)
  CJ(p.rw_wk, wt + WT_WK, 1024, 1024)
  CJ(p.rw_wv, wt + WT_WV, 1024, 1024)
  CJ(p.rw_wo, wt + WT_WO, 1024, 1024)
  CJ(p.rw_w1, wt + WT_W1, 1024, 64)
  CJ(p.rw_a1, wt + WT_A1, 1024, 64)
  CJ(p.rw_g1, wt + WT_G1, 1024, 128)
  CJ(p.rw_w2, wt + WT_W2, 64, 1024)
  CJ(p.rw_a2, wt + WT_A2, 64, 1024)
  CJ(p.rw_g2, wt + WT_G2, 128, 1024)
  CJ(p.mlp_up, wt + WT_UP0, 1024, 4096)
  CJ(p.mlp_down, wt + WT_DN0, 4096, 1024)
  CJ(p.at_wqkv, wt + WT_QKV, 1024, 1536)
  CJ(p.at_wo, wt + WT_WO1, 1024, 1024)
  CJ(p.mlp_up + (size_t)4 * MEG, wt + WT_UP1, 1024, 4096)
  CJ(p.mlp_down + (size_t)4 * MEG, wt + WT_DN1, 4096, 1024)
#undef CJ
  const int gtid = blockIdx.x * NTHR + threadIdx.x, gsz = gridDim.x * NTHR;
  u16* siluc = (u16*)(p.ws + S_SILUC);
  for (int i = gtid; i < 256 * 1024; i += gsz) {
    int row = i >> 10, col = i & 1023;
    float c = 0.f;
    if (row < 4) c = p.c_prompt[row * 1024 + col];
    else if (row < 132) c = p.c_sample[(row - 4) * 1024 + col];
    siluc[i] = f2bf(c * sigmoidf_(c));
  }
  u16* hs = (u16*)(p.ws + WS_HS);
  for (int i = gtid; i < 128 * 1024; i += gsz) hs[i] = f2bf(p.state_shift[i]);
  u16* zr = (u16*)(p.ws + WS_ZR);
  for (int i = gtid; i < 1024; i += gsz) zr[i] = 0;
  float2* tab = (float2*)(p.ws + WS_TAB);
  for (int i = gtid; i < 4097 * 8; i += gsz) {
    int pi = i >> 3, f = i & 7;
    float pos = pi < 4096 ? (float)pi : 8192.f;
    float inv = f == 0 ? 1.0f : f == 1 ? 0.1939227432012558f : f == 2 ? 0.03760603070259094f : f == 3 ? 0.007292664609849453f
              : f == 4 ? 0.0014142135623842478f : f == 5 ? 0.00027424818836152554f : f == 6 ? 5.318296098266728e-05f
              : 1.0313386155758053e-05f;
    float ang = pos * inv;
    double t = (double)ang * 0.15915494309189535;
    t -= rint(t);
    float fr = (float)t;
    tab[i] = make_float2(__builtin_amdgcn_cosf(fr), __builtin_amdgcn_sinf(fr));
  }
}

__device__ __forceinline__ void phase_ada(const Params& p, char* lds) {
  GEMM_LANE_VARS
  const u16* siluc = (const u16*)(p.ws + S_SILUC);
  const u16* adawt = (const u16*)(p.ws + S_ADAWT);
  float* mod = (float*)(p.ws + WS_MOD);
  MixSrc ms{nullptr, nullptr, nullptr};
  for (int t = blockIdx.x; t < 96; t += gridDim.x) {
    const int layer = t / 48, nt = t % 48;
    const int m0 = 0, n0 = nt * 128;
    const float* bias = p.ada_b + layer * 6144;
    float* mo = mod + (size_t)layer * 132 * 6144;
    gemm_tile<false>(siluc, 1024, ms, adawt + (size_t)layer * 6144 * 1024, 6144, 1024, m0, n0, lds, [&](f32x4(&acc)[4][4]) {
      EPI_FOREACH(acc, if (row < 132) mo[(size_t)row * 6144 + col] = v + bias[col];)
    });
  }
}

__device__ __forceinline__ void phase_norm(const Params& p, int layer, int which, bool from_input, bool shift_out) {
  const int lane = threadIdx.x & 63, w = threadIdx.x >> 6;
  const float* mod = (const float*)(p.ws + WS_MOD);
  u16* H = (u16*)(p.ws + WS_H);
  const float* g = (which ? p.norm2_g : p.norm1_g) + layer * 1024;
  const int nw = gridDim.x * 8;
  for (int row = blockIdx.x * 8 + w; row < MROWS; row += nw) {
    const float* xr = from_input ? (row < NP ? p.x_prompt + (size_t)row * 1024 : p.x_sample + (size_t)(row - NP) * 1024)
                                 : p.out + (size_t)row * 1024;
    float4 x[4];
    float ss = 0.f;
#pragma unroll
    for (int i = 0; i < 4; ++i) {
      x[i] = *(const float4*)(xr + lane * 4 + 256 * i);
      ss += x[i].x * x[i].x + x[i].y * x[i].y + x[i].z * x[i].z + x[i].w * x[i].w;
    }
    ss = wavesum(ss);
    const float rs = rsqrtf(ss * (1.f / 1024.f) + 1e-6f);
    const int bi = bidx_of(row);
    const float* mb = mod + ((size_t)layer * 132 + bi) * 6144;
    const float* sh = mb + (which ? 3 : 0) * 1024;
    const float* sc = mb + (which ? 4 : 1) * 1024;
    const bool so = shift_out && (row >= NP || (row & 4095) == 4095);
    float* sop = row >= NP ? p.out + O_SHS + (size_t)(row - NP) * 1024 : p.out + O_SHP + (size_t)(row >> 12) * 1024;
#pragma unroll
    for (int i = 0; i < 4; ++i) {
      const int c = lane * 4 + 256 * i;
      float4 gg = *(const float4*)(g + c), s4 = *(const float4*)(sh + c), c4 = *(const float4*)(sc + c);
      float4 h;
      h.x = x[i].x * rs * gg.x * (1.f + c4.x) + s4.x;
      h.y = x[i].y * rs * gg.y * (1.f + c4.y) + s4.y;
      h.z = x[i].z * rs * gg.z * (1.f + c4.z) + s4.z;
      h.w = x[i].w * rs * gg.w * (1.f + c4.w) + s4.w;
      uint2 pk;
      pk.x = pack2(h.x, h.y);
      pk.y = pack2(h.z, h.w);
      *(uint2*)(H + (size_t)row * 1024 + c) = pk;
      if (so) *(float4*)(sop + c) = h;
    }
  }
}

__device__ __forceinline__ void phase_final(const Params& p) {
  const int lane = threadIdx.x & 63, w = threadIdx.x >> 6;
  const int nw = gridDim.x * 8;
  for (int row = blockIdx.x * 8 + w; row < MROWS; row += nw) {
    float* xr = p.out + (size_t)row * 1024;
    float4 x[4];
    float ss = 0.f;
#pragma unroll
    for (int i = 0; i < 4; ++i) {
      x[i] = *(const float4*)(xr + lane * 4 + 256 * i);
      ss += x[i].x * x[i].x + x[i].y * x[i].y + x[i].z * x[i].z + x[i].w * x[i].w;
    }
    ss = wavesum(ss);
    const float rs = rsqrtf(ss * (1.f / 1024.f) + 1e-6f);
#pragma unroll
    for (int i = 0; i < 4; ++i) {
      const int c = lane * 4 + 256 * i;
      float4 gg = *(const float4*)(p.final_g + c);
      float4 h;
      h.x = x[i].x * rs * gg.x;
      h.y = x[i].y * rs * gg.y;
      h.z = x[i].z * rs * gg.z;
      h.w = x[i].w * rs * gg.w;
      *(float4*)(xr + c) = h;
    }
  }
}

__device__ __forceinline__ void phase_rwkv_proj(const Params& p, char* lds) {
  GEMM_LANE_VARS
  const u16* H = (const u16*)(p.ws + WS_H);
  const u16* wt = (const u16*)(p.ws + WS_WT);
  u16* R = (u16*)(p.ws + S_R);
  u16* Kk = (u16*)(p.ws + S_K);
  u16* V = (u16*)(p.ws + S_V);
  u16* WH = (u16*)(p.ws + S_WH);
  u16* AH = (u16*)(p.ws + S_AH);
  u16* GH = (u16*)(p.ws + S_GH);
  for (int t = blockIdx.x; t < 65 * 27; t += gridDim.x) {
    const int mt = t / 27, j = t % 27;
    const int m0 = mt * 256;
    int kind, n0, N, mixi;
    const u16* Bt;
    if (j < 8) { kind = 0; n0 = j * 128; N = 1024; mixi = 0; Bt = wt + WT_WR; }
    else if (j < 16) { kind = 1; n0 = (j - 8) * 128; N = 1024; mixi = 2; Bt = wt + WT_WK; }
    else if (j < 24) { kind = 2; n0 = (j - 16) * 128; N = 1024; mixi = 3; Bt = wt + WT_WV; }
    else if (j == 24) { kind = 3; n0 = 0; N = 64; mixi = 1; Bt = wt + WT_W1; }
    else if (j == 25) { kind = 4; n0 = 0; N = 64; mixi = 4; Bt = wt + WT_A1; }
    else { kind = 5; n0 = 0; N = 128; mixi = 5; Bt = wt + WT_G1; }
    MixSrc ms{(const u16*)(p.ws + WS_HS), (const u16*)(p.ws + WS_ZR), p.rw_mix + mixi * 1024};
    gemm_tile<true>(H, 1024, ms, Bt, N, 1024, m0, n0, lds, [&](f32x4(&acc)[4][4]) {
      u16* dst = kind == 0 ? R : kind == 1 ? Kk : kind == 2 ? V : kind == 3 ? WH : kind == 4 ? AH : GH;
      const int ld = kind < 3 ? 1024 : (kind == 5 ? 128 : 64);
      EPI_FOREACH(acc, if (row < MROWS && col < ld) {
        float o = v;
        if (kind == 3) {
          const float e = __expf(2.f * v);
          o = 1.f - 2.f / (e + 1.f);
        } else if (kind == 5) {
          o = sigmoidf_(v);
        }
        dst[(size_t)row * ld + col] = f2bf(o);
      })
    });
  }
}

__device__ __forceinline__ void phase_rwkv_lora2(const Params& p, char* lds) {
  GEMM_LANE_VARS
  const u16* wt = (const u16*)(p.ws + WS_WT);
  const u16* WH = (const u16*)(p.ws + S_WH);
  const u16* AH = (const u16*)(p.ws + S_AH);
  u16* EW = (u16*)(p.ws + S_EW);
  u16* Aa = (u16*)(p.ws + S_A);
  MixSrc ms{nullptr, nullptr, nullptr};
  for (int t = blockIdx.x; t < 65 * 16; t += gridDim.x) {
    const int mt = t >> 4, j = t & 15;
    const int m0 = mt * 256, n0 = (j & 7) * 128;
    if (j < 8) {
      gemm_tile<false>(WH, 64, ms, wt + WT_W2, 1024, 64, m0, n0, lds, [&](f32x4(&acc)[4][4]) {
        EPI_FOREACH(acc, if (row < MROWS) {
          float z = p.rw_w0[col] + v;
          EW[(size_t)row * 1024 + col] = f2h(0.6065306597126334f * sigmoidf_(z));
        })
      });
    } else {
      gemm_tile<false>(AH, 64, ms, wt + WT_A2, 1024, 64, m0, n0, lds, [&](f32x4(&acc)[4][4]) {
        EPI_FOREACH(acc, if (row < MROWS) Aa[(size_t)row * 1024 + col] = f2bf(sigmoidf_(p.rw_a0[col] + v));)
      });
    }
  }
}

constexpr int RING_TS = 344;
constexpr int RING_BUF = 16 * RING_TS;

__device__ __forceinline__ void phase_scan(const Params& p, char* lds) {
  const int tid = threadIdx.x, lane = tid & 63, w = tid >> 6;
  const u16* R = (const u16*)(p.ws + S_R);
  const u16* Kk = (const u16*)(p.ws + S_K);
  const u16* V = (const u16*)(p.ws + S_V);
  const u16* EW = (const u16*)(p.ws + S_EW);
  const u16* Aa = (const u16*)(p.ws + S_A);
  u16* Y = (u16*)(p.ws + WS_H);
  float* RK = (float*)(p.ws + WS_RK);
  float* ring = (float*)lds;
  float* ybuf = (float*)(lds + 2 * RING_BUF * 4);
  for (int item = blockIdx.x; item < 256; item += gridDim.x) {
    const int chain = item >> 2, qr = item & 3, b = chain >> 4, h = chain & 15;
    const size_t rowbase = (size_t)b * 4096;
    __syncthreads();
    if (tid >= 256) {
      const int pt = tid - 256, tok = pt >> 4, cq = pt & 15;
      const int ch = h * 64 + cq * 4;
      const float4 kk4 = *(const float4*)(p.rw_kk + ch), ka4 = *(const float4*)(p.rw_ka + ch), rk4 = *(const float4*)(p.rw_rk + ch);
      uint2 rr, rk_, rv, ra_, re;
      auto pload = [&](int c) {
        const size_t off = (rowbase + (size_t)c * 16 + tok) * 1024 + ch;
        rr = *(const uint2*)(R + off);
        rk_ = *(const uint2*)(Kk + off);
        rv = *(const uint2*)(V + off);
        ra_ = *(const uint2*)(Aa + off);
        re = *(const uint2*)(EW + off);
      };
      auto pproc = [&](int c) {
        float rf[4] = {bflo(rr.x), bfhi(rr.x), bflo(rr.y), bfhi(rr.y)};
        float kf[4] = {bflo(rk_.x), bfhi(rk_.x), bflo(rk_.y), bfhi(rk_.y)};
        float vf[4] = {bflo(rv.x), bfhi(rv.x), bflo(rv.y), bfhi(rv.y)};
        float af[4] = {bflo(ra_.x), bfhi(ra_.x), bflo(ra_.y), bfhi(ra_.y)};
        float ef[4] = {h2f((u16)(re.x & 0xffff)), h2f((u16)(re.x >> 16)), h2f((u16)(re.y & 0xffff)), h2f((u16)(re.y >> 16))};
        const float kkw[4] = {kk4.x, kk4.y, kk4.z, kk4.w}, kaw[4] = {ka4.x, ka4.y, ka4.z, ka4.w}, rkw[4] = {rk4.x, rk4.y, rk4.z, rk4.w};
        float kkr[4], kp[4], ss = 0.f, rks = 0.f;
#pragma unroll
        for (int j = 0; j < 4; ++j) {
          kkr[j] = kf[j] * kkw[j];
          ss += kkr[j] * kkr[j];
          kp[j] = kf[j] * (1.f + (af[j] - 1.f) * kaw[j]);
          rks += rf[j] * kp[j] * rkw[j];
        }
        ss = rowsum16(ss);
        rks = rowsum16(rks);
        const float inv = 1.f / fmaxf(sqrtf(ss), 1e-12f);
        float* slot = ring + (c & 1) * RING_BUF + tok * RING_TS;
        float4 o;
        o = make_float4(-kkr[0] * inv, -kkr[1] * inv, -kkr[2] * inv, -kkr[3] * inv);
        *(float4*)(slot + cq * 4) = o;
        o = make_float4(__expf(-ef[0]), __expf(-ef[1]), __expf(-ef[2]), __expf(-ef[3]));
        *(float4*)(slot + 64 + cq * 4) = o;
        o = make_float4(kkr[0] * inv * af[0], kkr[1] * inv * af[1], kkr[2] * inv * af[2], kkr[3] * inv * af[3]);
        *(float4*)(slot + 128 + cq * 4) = o;
        o = make_float4(kp[0], kp[1], kp[2], kp[3]);
        *(float4*)(slot + 192 + cq * 4) = o;
        o = make_float4(rf[0], rf[1], rf[2], rf[3]);
        *(float4*)(slot + 256 + cq * 4) = o;
        if ((cq >> 2) == qr) *(float4*)(slot + 320 + (cq & 3) * 4) = make_float4(vf[0], vf[1], vf[2], vf[3]);
        if (cq == 0 && qr == 0) RK[(rowbase + (size_t)c * 16 + tok) * 16 + h] = rks;
      };
      pload(0);
      pproc(0);
      pload(1);
      __syncthreads();
      for (int c = 0; c < 256; ++c) {
        if (c + 1 < 256) pproc(c + 1);
        if (c + 2 < 256) pload(c + 2);
        __syncthreads();
      }
    } else {
      const int rl = tid >> 4, cgp = tid & 15;
      float s0 = 0.f, s1 = 0.f, s2 = 0.f, s3 = 0.f;
      __syncthreads();
      for (int c = 0; c < 256; ++c) {
        if (c > 0) {
          const float yv = ybuf[((c - 1) & 1) * 256 + tid];
          Y[(rowbase + (size_t)(c - 1) * 16 + rl) * 1024 + h * 64 + qr * 16 + cgp] = f2bf(yv);
        }
        const float* bufp = ring + (c & 1) * RING_BUF;
        float* yb = ybuf + (c & 1) * 256;
#pragma unroll 4
        for (int tk = 0; tk < 16; ++tk) {
          const float* slot = bufp + tk * RING_TS;
          const float4 a4 = *(const float4*)(slot + cgp * 4);
          const float4 w4 = *(const float4*)(slot + 64 + cgp * 4);
          const float4 b4 = *(const float4*)(slot + 128 + cgp * 4);
          const float4 k4 = *(const float4*)(slot + 192 + cgp * 4);
          const float4 r4 = *(const float4*)(slot + 256 + cgp * 4);
          const float vv = slot[320 + rl];
          float sa = s0 * a4.x + s1 * a4.y + s2 * a4.z + s3 * a4.w;
          sa = rowsum16(sa);
          s0 = s0 * w4.x + sa * b4.x + vv * k4.x;
          s1 = s1 * w4.y + sa * b4.y + vv * k4.y;
          s2 = s2 * w4.z + sa * b4.z + vv * k4.z;
          s3 = s3 * w4.w + sa * b4.w + vv * k4.w;
          float y = s0 * r4.x + s1 * r4.y + s2 * r4.z + s3 * r4.w;
          y = rowsum16(y);
          if (cgp == 0) yb[tk * 16 + rl] = y;
        }
        __syncthreads();
      }
      {
        const float yv = ybuf[(255 & 1) * 256 + tid];
        Y[(rowbase + (size_t)255 * 16 + rl) * 1024 + h * 64 + qr * 16 + cgp] = f2bf(yv);
      }
      float* wo = p.out + O_WKVP + (((size_t)(b * 16 + h) * 64) + qr * 16 + rl) * 64 + cgp * 4;
      *(float4*)wo = make_float4(s0, s1, s2, s3);
    }
  }
  float* sl = (float*)lds;
  for (int chain = blockIdx.x; chain < 2048; chain += gridDim.x) {
    const int b = chain >> 4, h = chain & 15;
    const size_t row = (size_t)NP + b;
    __syncthreads();
    if (w == 0) {
      const int ch = h * 64 + lane;
      const size_t off = row * 1024 + ch;
      const float rf = bf2f(R[off]), kf = bf2f(Kk[off]), vf = bf2f(V[off]), af = bf2f(Aa[off]), ef = h2f(EW[off]);
      const float kkr = kf * p.rw_kk[ch];
      const float ss = wavesum(kkr * kkr);
      const float inv = 1.f / fmaxf(sqrtf(ss), 1e-12f);
      const float kp = kf * (1.f + (af - 1.f) * p.rw_ka[ch]);
      const float rks = wavesum(rf * kp * p.rw_rk[ch]);
      sl[lane] = -kkr * inv;
      sl[64 + lane] = __expf(-ef);
      sl[128 + lane] = kkr * inv * af;
      sl[192 + lane] = kp;
      sl[256 + lane] = rf;
      sl[320 + lane] = vf;
      if (lane == 0) RK[row * 16 + h] = rks;
    }
    __syncthreads();
    const int i = tid >> 3, c8 = tid & 7;
    const float* sp = p.state_wkv + (((size_t)(b * 16 + h) * 64) + i) * 64 + c8 * 8;
    float4 sA = *(const float4*)sp, sB = *(const float4*)(sp + 4);
    float s[8] = {sA.x, sA.y, sA.z, sA.w, sB.x, sB.y, sB.z, sB.w};
    float sa = 0.f;
#pragma unroll
    for (int j = 0; j < 8; ++j) sa += s[j] * sl[c8 * 8 + j];
    sa += __shfl_xor(sa, 1);
    sa += __shfl_xor(sa, 2);
    sa += __shfl_xor(sa, 4);
    const float vv = sl[320 + i];
    float y = 0.f;
#pragma unroll
    for (int j = 0; j < 8; ++j) {
      const int cj = c8 * 8 + j;
      s[j] = s[j] * sl[64 + cj] + sa * sl[128 + cj] + vv * sl[192 + cj];
      y += s[j] * sl[256 + cj];
    }
    y += __shfl_xor(y, 1);
    y += __shfl_xor(y, 2);
    y += __shfl_xor(y, 4);
    float* wo = p.out + O_WKVS + (((size_t)(b * 16 + h) * 64) + i) * 64 + c8 * 8;
    *(float4*)wo = make_float4(s[0], s[1], s[2], s[3]);
    *(float4*)(wo + 4) = make_float4(s[4], s[5], s[6], s[7]);
    if (c8 == 0) Y[row * 1024 + h * 64 + i] = f2bf(y);
  }
}

__device__ __forceinline__ void phase_gate(const Params& p, char* lds) {
  GEMM_LANE_VARS
  const u16* wt = (const u16*)(p.ws + WS_WT);
  const u16* GH = (const u16*)(p.ws + S_GH);
  const u16* V = (const u16*)(p.ws + S_V);
  const float* RK = (const float*)(p.ws + WS_RK);
  u16* Y = (u16*)(p.ws + WS_H);
  MixSrc ms{nullptr, nullptr, nullptr};
  for (int t = blockIdx.x; t < 65 * 8; t += gridDim.x) {
    const int mt = t >> 3, nt = t & 7;
    const int m0 = mt * 256, n0 = nt * 128;
    gemm_tile<false>(GH, 128, ms, wt + WT_G2, 1024, 128, m0, n0, lds, [&](f32x4(&acc)[4][4]) {
      const int hh = (n0 + wn * 64) >> 6;
#pragma unroll
      for (int mi = 0; mi < 4; ++mi)
#pragma unroll
        for (int r = 0; r < 4; ++r) {
          const int row = m0 + wm * 64 + mi * 16 + lg * 4 + r;
          const int rowc = row < MROWS ? row : MROWS - 1;
          float yv[4], sum = 0.f;
#pragma unroll
          for (int ni = 0; ni < 4; ++ni) {
            yv[ni] = bf2f(Y[(size_t)rowc * 1024 + hh * 64 + ni * 16 + lr]);
            sum += yv[ni];
          }
          sum = rowsum16(sum);
          const float mu = sum * (1.f / 64.f);
          float vs = 0.f;
#pragma unroll
          for (int ni = 0; ni < 4; ++ni) {
            const float d = yv[ni] - mu;
            vs += d * d;
          }
          vs = rowsum16(vs);
          const float rstd = rsqrtf(vs * (1.f / 64.f) + 64e-5f);
          const float rk = RK[(size_t)rowc * 16 + hh];
#pragma unroll
          for (int ni = 0; ni < 4; ++ni) {
            const int col = hh * 64 + ni * 16 + lr;
            const float vv = bf2f(V[(size_t)rowc * 1024 + col]);
            const float o = ((yv[ni] - mu) * rstd * p.rw_lnx_g[col] + p.rw_lnx_b[col] + rk * vv) * acc[mi][ni][r];
            if (row < MROWS) Y[(size_t)row * 1024 + col] = f2bf(o);
          }
        }
    });
  }
}

__device__ __forceinline__ void phase_oproj(const Params& p, char* lds, const u16* A, int K, const u16* Bt, int layer, int gidx, bool first) {
  GEMM_LANE_VARS
  const float* mod = (const float*)(p.ws + WS_MOD);
  MixSrc ms{nullptr, nullptr, nullptr};
  for (int t = blockIdx.x; t < 65 * 8; t += gridDim.x) {
    const int mt = t >> 3, nt = t & 7;
    const int m0 = mt * 256, n0 = nt * 128;
    gemm_tile<false>(A, K, ms, Bt, 1024, K, m0, n0, lds, [&](f32x4(&acc)[4][4]) {
      EPI_FOREACH(acc, if (row < MROWS) {
        const float gt = mod[((size_t)layer * 132 + bidx_of(row)) * 6144 + gidx * 1024 + col];
        float* xp = p.out + (size_t)row * 1024 + col;
        float xo;
        if (first) xo = row < NP ? p.x_prompt[(size_t)row * 1024 + col] : p.x_sample[(size_t)(row - NP) * 1024 + col];
        else xo = *xp;
        *xp = xo + gt * v;
      })
    });
  }
}

__device__ __forceinline__ void phase_up(const Params& p, char* lds, const u16* Bt) {
  GEMM_LANE_VARS
  const u16* H = (const u16*)(p.ws + WS_H);
  u16* UP = (u16*)(p.ws + S_UP);
  MixSrc ms{nullptr, nullptr, nullptr};
  for (int t = blockIdx.x; t < 65 * 32; t += gridDim.x) {
    const int mt = t >> 5, nt = t & 31;
    const int m0 = mt * 256, n0 = nt * 128;
    gemm_tile<false>(H, 1024, ms, Bt, 4096, 1024, m0, n0, lds, [&](f32x4(&acc)[4][4]) {
      EPI_FOREACH(acc, if (row < MROWS) {
        const float rl = fmaxf(v, 0.f);
        UP[(size_t)row * 4096 + col] = f2bf(rl * rl);
      })
    });
  }
}

__device__ __forceinline__ void phase_qkv(const Params& p, char* lds) {
  GEMM_LANE_VARS
  const u16* H = (const u16*)(p.ws + WS_H);
  const u16* wt = (const u16*)(p.ws + WS_WT);
  const float2* tab = (const float2*)(p.ws + WS_TAB);
  u16* Qb = (u16*)(p.ws + S_Q);
  u16* Kb = (u16*)(p.ws + S_KB);
  u16* Vt = (u16*)(p.ws + S_VT);
  MixSrc ms{nullptr, nullptr, nullptr};
  for (int t = blockIdx.x; t < 65 * 12; t += gridDim.x) {
    const int mt = t / 12, nt = t % 12;
    const int m0 = mt * 256, n0 = nt * 128;
    gemm_tile<false>(H, 1024, ms, wt + WT_QKV, 1536, 1024, m0, n0, lds, [&](f32x4(&acc)[4][4]) {
      const int hc0 = n0 + wn * 64;
#pragma unroll
      for (int mi = 0; mi < 4; ++mi)
#pragma unroll
        for (int r = 0; r < 4; ++r) {
          const int row = m0 + wm * 64 + mi * 16 + lg * 4 + r;
          const bool valid = row < MROWS;
          const bool isp = row < NP;
          const int pos = row & 4095;
          const int bq = isp ? (row >> 12) : (row - NP);
          const int posidx = isp ? pos : 4096;
#pragma unroll
          for (int ni = 0; ni < 4; ++ni) {
            const int col = hc0 + ni * 16 + lr;
            float v = acc[mi][ni][r] + p.at_bqkv[col];
            if (ni == 0 && hc0 < 1280) {
              const float pv = dppf<0x128>(v);
              const float2 cs = tab[posidx * 8 + (lr & 7)];
              v = (lr < 8) ? (v * cs.x - pv * cs.y) : (v * cs.x + pv * cs.y);
            }
            if (valid) {
              if (hc0 < 1024) {
                Qb[(size_t)row * 1024 + col] = f2bf(v);
              } else if (hc0 < 1280) {
                const int c2 = col - 1024;
                Kb[(size_t)row * 256 + c2] = f2bf(v);
                if (isp) {
                  if (pos >= 3968) p.out[O_KP + ((size_t)(bq * 128 + pos - 3968)) * 256 + c2] = v;
                } else {
                  p.out[O_KS + ((size_t)(bq * 128 + 127)) * 256 + c2] = v;
                }
              } else {
                const int c3 = col - 1280;
                if (isp) {
                  Vt[((size_t)(bq * 4 + (c3 >> 6)) * 64 + (c3 & 63)) * 4096 + pos] = f2bf(v);
                  if (pos >= 3968) p.out[O_VP + ((size_t)(bq * 128 + pos - 3968)) * 256 + c3] = v;
                } else {
                  p.out[O_VS + ((size_t)(bq * 128 + 127)) * 256 + c3] = v;
                }
              }
            }
          }
        }
    });
  }
}

constexpr int AT_KS = 0, AT_VS = 36864, AT_PS = 36864 + 35840, AT_PW = 5376;

__device__ __forceinline__ void phase_attn(const Params& p, char* lds) {
  const int tid = threadIdx.x, lane = tid & 63, w = tid >> 6, lr = lane & 15, lg = lane >> 4;
  const u16* Qb = (const u16*)(p.ws + S_Q);
  const u16* Kb = (const u16*)(p.ws + S_KB);
  const u16* Vt = (const u16*)(p.ws + S_VT);
  u16* O = (u16*)(p.ws + S_O);
  char* Ks = lds + AT_KS;
  char* Vs = lds + AT_VS;
  char* Ps = lds + AT_PS + w * AT_PW;
  for (int u = blockIdx.x; u < 512; u += gridDim.x) {
    const int b = u >> 7, n = (u >> 2) & 31, kvh = u & 3;
    __syncthreads();
#pragma unroll
    for (int i = 0; i < 4; ++i) {
      const int c = tid + 512 * i;
      {
        const int key = c >> 3, kc = c & 7;
        const int pos = n * 128 - 128 + key;
        uint4 v = {0u, 0u, 0u, 0u};
        if (pos >= 0) v = *(const uint4*)(Kb + ((size_t)b * 4096 + pos) * 256 + kvh * 64 + kc * 8);
        *(uint4*)(Ks + key * 144 + kc * 16) = v;
      }
      {
        const int d = c >> 5, kc = c & 31;
        const int pos0 = n * 128 - 128 + kc * 8;
        uint4 v = {0u, 0u, 0u, 0u};
        if (pos0 >= 0) v = *(const uint4*)(Vt + ((size_t)(b * 4 + kvh) * 64 + d) * 4096 + pos0);
        *(uint4*)(Vs + d * 560 + kc * 16) = v;
      }
    }
    if (tid < 192) {
      const int d = tid / 3, c = tid % 3;
      *(uint4*)(Vs + d * 560 + 512 + c * 16) = uint4{0u, 0u, 0u, 0u};
    }
    {
      const int prow = lane >> 2, pc = 144 + (lane & 3) * 4;
      *(uint2*)(Ps + prow * 336 + pc * 2) = uint2{0u, 0u};
    }
    __syncthreads();
    const int g = w >> 1, hf = w & 1;
    const int qh = kvh * 4 + g;
    const float sink = p.at_sink[qh];
#pragma unroll 1
    for (int i = 0; i < 4; ++i) {
      const int q0 = hf * 64 + i * 16;
      const size_t tok = (size_t)b * 4096 + n * 128 + q0 + lr;
      const bf16x8 qf0 = *(const bf16x8*)(Qb + tok * 1024 + qh * 64 + lg * 8);
      const bf16x8 qf1 = *(const bf16x8*)(Qb + tok * 1024 + qh * 64 + 32 + lg * 8);
      f32x4 s[9];
#pragma unroll
      for (int j = 0; j < 9; ++j) {
        const char* kp = Ks + (q0 + j * 16 + lr) * 144 + lg * 16;
        const bf16x8 k0 = *(const bf16x8*)kp;
        const bf16x8 k1 = *(const bf16x8*)(kp + 64);
        f32x4 z = {0.f, 0.f, 0.f, 0.f};
        z = __builtin_amdgcn_mfma_f32_16x16x32_bf16(qf0, k0, z, 0, 0, 0);
        z = __builtin_amdgcn_mfma_f32_16x16x32_bf16(qf1, k1, z, 0, 0, 0);
        s[j] = z;
      }
      float mx[4], sum[4];
#pragma unroll
      for (int r = 0; r < 4; ++r) {
        const int ql = lg * 4 + r;
        float m = sink;
#pragma unroll
        for (int j = 0; j < 9; ++j) {
          float v = s[j][r] * 0.125f;
          bool ok = true;
          if (j == 0) ok = (lr >= ql);
          if (j == 8) ok = (lr <= ql);
          if (n == 0 && (q0 + j * 16 + lr) < 128) ok = false;
          v = ok ? v : -INFINITY;
          s[j][r] = v;
          m = fmaxf(m, v);
        }
        mx[r] = rowmax16(m);
      }
#pragma unroll
      for (int r = 0; r < 4; ++r) {
        float sm = 0.f;
#pragma unroll
        for (int j = 0; j < 9; ++j) {
          const float e = __expf(s[j][r] - mx[r]);
          s[j][r] = e;
          sm += e;
        }
        sm = rowsum16(sm);
        sum[r] = sm + __expf(sink - mx[r]);
      }
      u16* P = (u16*)Ps;
#pragma unroll
      for (int j = 0; j < 9; ++j)
#pragma unroll
        for (int r = 0; r < 4; ++r) P[(lg * 4 + r) * 168 + j * 16 + lr] = f2bf(s[j][r]);
      __builtin_amdgcn_wave_barrier();
      f32x4 o[4];
#pragma unroll
      for (int nd = 0; nd < 4; ++nd) o[nd] = f32x4{0.f, 0.f, 0.f, 0.f};
#pragma unroll
      for (int kk = 0; kk < 5; ++kk) {
        const bf16x8 pf = *(const bf16x8*)(Ps + lr * 336 + kk * 64 + lg * 16);
#pragma unroll
        for (int nd = 0; nd < 4; ++nd) {
          const bf16x8 vf = *(const bf16x8*)(Vs + (nd * 16 + lr) * 560 + (q0 + kk * 32 + lg * 8) * 2);
          o[nd] = __builtin_amdgcn_mfma_f32_16x16x32_bf16(pf, vf, o[nd], 0, 0, 0);
        }
      }
#pragma unroll
      for (int nd = 0; nd < 4; ++nd)
#pragma unroll
        for (int r = 0; r < 4; ++r) {
          const float v = o[nd][r] / sum[r];
          O[((size_t)b * 4096 + n * 128 + q0 + lg * 4 + r) * 1024 + qh * 64 + nd * 16 + lr] = f2bf(v);
        }
      __builtin_amdgcn_wave_barrier();
    }
  }
  float* qs = (float*)lds;
  float* sc = (float*)(lds + 1024);
  float* part = (float*)(lds + 1024 + 2112);
  for (int it = blockIdx.x; it < 512; it += gridDim.x) {
    const int b = it >> 2, kvh = it & 3;
    const size_t row = (size_t)NP + b;
    __syncthreads();
    if (tid < 256) qs[tid] = bf2f(Qb[row * 1024 + kvh * 256 + tid]);
    __syncthreads();
    {
      const int key = tid >> 2, g = tid & 3;
      const float* kp = p.cache_k + (((size_t)b * 128 + key) * 4 + kvh) * 64;
      float dot = 0.f;
#pragma unroll
      for (int d4 = 0; d4 < 16; ++d4) {
        const float4 kv = *(const float4*)(kp + d4 * 4);
        const float* q = qs + g * 64 + d4 * 4;
        dot += kv.x * q[0] + kv.y * q[1] + kv.z * q[2] + kv.w * q[3];
      }
      sc[g * 132 + key] = dot * 0.125f;
      if (key >= 1) {
        float* dst = p.out + O_KS + (((size_t)b * 128 + key - 1) * 4 + kvh) * 64 + g * 16;
        const float* src = kp + g * 16;
#pragma unroll
        for (int d4 = 0; d4 < 4; ++d4) *(float4*)(dst + d4 * 4) = *(const float4*)(src + d4 * 4);
      }
      if (tid < 4) {
        const float* kn = p.out + O_KS + (((size_t)b * 128 + 127) * 4 + kvh) * 64;
        float d2 = 0.f;
        for (int d = 0; d < 64; ++d) d2 += kn[d] * qs[tid * 64 + d];
        sc[tid * 132 + 128] = d2 * 0.125f;
      }
    }
    __syncthreads();
    if (w < 4) {
      const float sink = p.at_sink[kvh * 4 + w];
      float* s = sc + w * 132;
      const float v0 = s[lane], v1 = s[64 + lane], v2 = lane == 0 ? s[128] : -INFINITY;
      float m = fmaxf(fmaxf(v0, v1), fmaxf(v2, sink));
      m = wavemax(m);
      const float e0 = __expf(v0 - m), e1 = __expf(v1 - m), e2 = lane == 0 ? __expf(v2 - m) : 0.f;
      float sm = wavesum(e0 + e1 + e2) + __expf(sink - m);
      const float inv = 1.f / sm;
      s[lane] = e0 * inv;
      s[64 + lane] = e1 * inv;
      if (lane == 0) s[128] = e2 * inv;
    }
    __syncthreads();
    {
      const int d = tid & 63, g = (tid >> 6) & 3, half = tid >> 8;
      const float* vp = p.cache_v + (((size_t)b * 128) * 4 + kvh) * 64 + d;
      float accv = 0.f;
      for (int key = half * 64; key < half * 64 + 64; ++key) {
        const float vv = vp[(size_t)key * 256];
        accv += sc[g * 132 + key] * vv;
        if (g == 0 && key >= 1) p.out[O_VS + (((size_t)b * 128 + key - 1) * 4 + kvh) * 64 + d] = vv;
      }
      if (half == 1) accv += sc[g * 132 + 128] * p.out[O_VS + (((size_t)b * 128 + 127) * 4 + kvh) * 64 + d];
      part[(half * 4 + g) * 64 + d] = accv;
    }
    __syncthreads();
    if (tid < 256) {
      const int d = tid & 63, g = tid >> 6;
      O[row * 1024 + (kvh * 4 + g) * 64 + d] = f2bf(part[g * 64 + d] + part[(4 + g) * 64 + d]);
    }
  }
}

__global__ void __launch_bounds__(NTHR) mega(Params p) {
  extern __shared__ __attribute__((aligned(16))) char lds[];
  cg::grid_group grid = cg::this_grid();
  const u16* wt = (const u16*)(p.ws + WS_WT);
  phase0(p, lds);
  grid.sync();
  phase_ada(p, lds);
  grid.sync();
  phase_norm(p, 0, 0, true, true);
  grid.sync();
  phase_rwkv_proj(p, lds);
  grid.sync();
  phase_rwkv_lora2(p, lds);
  grid.sync();
  phase_scan(p, lds);
  grid.sync();
  phase_gate(p, lds);
  grid.sync();
  phase_oproj(p, lds, (const u16*)(p.ws + WS_H), 1024, wt + WT_WO, 0, 2, true);
  grid.sync();
  phase_norm(p, 0, 1, false, false);
  grid.sync();
  phase_up(p, lds, wt + WT_UP0);
  grid.sync();
  phase_oproj(p, lds, (const u16*)(p.ws + S_UP), 4096, wt + WT_DN0, 0, 5, false);
  grid.sync();
  phase_norm(p, 1, 0, false, false);
  grid.sync();
  phase_qkv(p, lds);
  grid.sync();
  phase_attn(p, lds);
  grid.sync();
  phase_oproj(p, lds, (const u16*)(p.ws + S_O), 1024, wt + WT_WO1, 1, 2, false);
  grid.sync();
  phase_norm(p, 1, 1, false, false);
  grid.sync();
  phase_up(p, lds, wt + WT_UP1);
  grid.sync();
  phase_oproj(p, lds, (const u16*)(p.ws + S_UP), 4096, wt + WT_DN1, 1, 5, false);
  grid.sync();
  phase_final(p);
}

extern "C" void kernel_launch(void* const* d_in, const int* in_sizes, int n_in, void* d_out, int out_size, void* d_ws,
                              size_t ws_size, hipStream_t stream) {
  static int grid_blocks = 0;
  if (grid_blocks == 0) {
    if (ws_size < WS_END) {
      fprintf(stderr, "kernel_launch: workspace too small: %zu < %zu\n", ws_size, (size_t)WS_END);
      grid_blocks = -1;
      return;
    }
    int dev = 0, cus = 0, per_cu = 0;
    hipGetDevice(&dev);
    hipDeviceGetAttribute(&cus, hipDeviceAttributeMultiprocessorCount, dev);
    hipFuncSetAttribute((const void*)mega, hipFuncAttributeMaxDynamicSharedMemorySize, LDS_BYTES);
    hipOccupancyMaxActiveBlocksPerMultiprocessor(&per_cu, (const void*)mega, NTHR, LDS_BYTES);
    if (per_cu < 1) per_cu = 1;
    grid_blocks = cus * per_cu;
  }
  if (grid_blocks < 0) return;
  Params p{};
  const float** pp = (const float**)&p;
  for (int i = 0; i < 37; ++i) pp[i] = (const float*)d_in[i];
  p.out = (float*)d_out;
  p.ws = (char*)d_ws;
  void* args[] = {&p};
  hipError_t e = hipLaunchCooperativeKernel((const void*)mega, dim3(grid_blocks), dim3(NTHR), args, LDS_BYTES, stream);
  if (e != hipSuccess) fprintf(stderr, "cooperative launch failed: %s (grid %d)\n", hipGetErrorString(e), grid_blocks);
}
```

```cpp
#include <hip/hip_runtime.h>
#include <hip/hip_cooperative_groups.h>
#include <cstdio>
namespace cg = cooperative_groups;

typedef unsigned short u16;
typedef __attribute__((ext_vector_type(8))) short bf16x8;
typedef __attribute__((ext_vector_type(4))) float f32x4;

constexpr int NP = 16384, MROWS = 16512, MPAD = 16640;
constexpr int NTHR = 512;
constexpr size_t MEG = 1048576;

constexpr size_t O_Y = 0, O_WKVP = 16908288, O_WKVS = 17170432, O_SHP = 25559040, O_SHS = 25563136,
                 O_KP = 25694208, O_KS = 25825280, O_VP = 30019584, O_VS = 30150656;

constexpr size_t WT_WR = 0, WT_WK = MEG, WT_WV = 2 * MEG, WT_WO = 3 * MEG, WT_W1 = 4 * MEG, WT_A1 = WT_W1 + 65536,
                 WT_G1 = WT_A1 + 65536, WT_W2 = WT_G1 + 131072, WT_A2 = WT_W2 + 65536, WT_G2 = WT_A2 + 65536,
                 WT_UP0 = WT_G2 + 131072, WT_DN0 = WT_UP0 + 4 * MEG, WT_QKV = WT_DN0 + 4 * MEG, WT_WO1 = WT_QKV + 1536 * 1024,
                 WT_UP1 = WT_WO1 + MEG, WT_DN1 = WT_UP1 + 4 * MEG, WT_END = WT_DN1 + 4 * MEG;
constexpr size_t WS_WT = 0;
constexpr size_t WS_H = WS_WT + WT_END * 2;
constexpr size_t WS_MOD = WS_H + (size_t)MPAD * 1024 * 2;
constexpr size_t WS_TAB = WS_MOD + (size_t)2 * 132 * 6144 * 4;
constexpr size_t WS_HS = WS_TAB + (size_t)4097 * 8 * 8;
constexpr size_t WS_ZR = WS_HS + (size_t)128 * 1024 * 2;
constexpr size_t WS_RK = WS_ZR + 2048;
constexpr size_t WS_BAR = WS_RK + (size_t)MPAD * 16 * 4;
constexpr size_t WS_S = WS_BAR + 16384;
constexpr size_t RSZ = (size_t)MROWS * 1024 * 2;
constexpr size_t S_ADAWT = WS_S, S_SILUC = S_ADAWT + (size_t)2 * 6144 * 1024 * 2;
constexpr size_t S_R = WS_S, S_K = S_R + RSZ, S_V = S_K + RSZ, S_EW = S_V + RSZ, S_A = S_EW + RSZ,
                 S_WH = S_A + RSZ, S_AH = S_WH + (size_t)MPAD * 64 * 2, S_GH = S_AH + (size_t)MPAD * 64 * 2,
                 S_RW_END = S_GH + (size_t)MPAD * 128 * 2;
constexpr size_t S_UP = WS_S;
constexpr size_t S_Q = WS_S, S_O = S_Q + (size_t)MPAD * 1024 * 2, S_KB = S_O + (size_t)MPAD * 1024 * 2,
                 S_VT = S_KB + (size_t)MPAD * 256 * 2;
constexpr size_t WS_END = S_RW_END;
static_assert(S_UP + (size_t)MPAD * 4096 * 2 <= WS_END, "up fits");
static_assert(S_VT + (size_t)16 * 64 * 4096 * 2 <= WS_END, "attn fits");
static_assert(WS_END <= 268435456, "ws fits 256MiB");

constexpr int LDS_ROW = 144;
constexpr int LDS_A_BYTES = 256 * LDS_ROW;
constexpr int LDS_B_BYTES = 128 * LDS_ROW;
constexpr int LDS_STAGE = LDS_A_BYTES + LDS_B_BYTES;
constexpr int LDS_BYTES = 115712;

struct Params {
  const float *x_prompt, *x_sample, *c_prompt, *c_sample, *state_wkv, *state_shift, *cache_k, *cache_v;
  const float *norm1_g, *norm2_g, *ada_w, *ada_b, *mlp_up, *mlp_down, *final_g;
  const float *rw_mix, *rw_wr, *rw_wk, *rw_wv, *rw_wo, *rw_w0, *rw_w1, *rw_w2, *rw_a0, *rw_a1, *rw_a2, *rw_g1, *rw_g2,
      *rw_kk, *rw_ka, *rw_rk, *rw_lnx_g, *rw_lnx_b;
  const float *at_wqkv, *at_bqkv, *at_wo, *at_sink;
  float* out;
  char* ws;
};

__device__ __forceinline__ u16 f2bf(float f) {
  unsigned u = __float_as_uint(f);
  u += 0x7fffu + ((u >> 16) & 1u);
  return (u16)(u >> 16);
}
__device__ __forceinline__ float bf2f(u16 h) { return __uint_as_float(((unsigned)h) << 16); }
__device__ __forceinline__ float bflo(unsigned w) { return __uint_as_float(w << 16); }
__device__ __forceinline__ float bfhi(unsigned w) { return __uint_as_float(w & 0xffff0000u); }
__device__ __forceinline__ unsigned pack2(float a, float b) { return (unsigned)f2bf(a) | (((unsigned)f2bf(b)) << 16); }
__device__ __forceinline__ float h2f(u16 h) { return (float)__builtin_bit_cast(_Float16, h); }
__device__ __forceinline__ u16 f2h(float f) { return __builtin_bit_cast(u16, (_Float16)f); }
__device__ __forceinline__ float sigmoidf_(float x) { return 1.f / (1.f + __expf(-x)); }

template <int CTRL>
__device__ __forceinline__ float dppf(float x) {
  return __int_as_float(__builtin_amdgcn_update_dpp(0, __float_as_int(x), CTRL, 0xf, 0xf, true));
}
__device__ __forceinline__ float rowsum16(float x) {
  x += dppf<0xB1>(x);
  x += dppf<0x4E>(x);
  x += dppf<0x124>(x);
  x += dppf<0x128>(x);
  return x;
}
__device__ __forceinline__ float rowmax16(float x) {
  x = fmaxf(x, dppf<0xB1>(x));
  x = fmaxf(x, dppf<0x4E>(x));
  x = fmaxf(x, dppf<0x124>(x));
  x = fmaxf(x, dppf<0x128>(x));
  return x;
}
__device__ __forceinline__ float wavesum(float x) {
#pragma unroll
  for (int o = 32; o > 0; o >>= 1) x += __shfl_xor(x, o);
  return x;
}
__device__ __forceinline__ float wavemax(float x) {
#pragma unroll
  for (int o = 32; o > 0; o >>= 1) x = fmaxf(x, __shfl_xor(x, o));
  return x;
}
__device__ __forceinline__ int bidx_of(int row) { return row < NP ? (row >> 12) : (4 + row - NP); }

#define XB_TMO      128
#define XB_XCNT(j)  (256  + 64 * (j))
#define XB_XSUB(j)  (1280 + 64 * (j))
#define XB_XGEN(j)  (2304 + 64 * (j))
#define XB_TOP      3328
#define XB_TOPGEN   3392
#define XCD_BAR_WORDS 3456
#define XB_SPIN_CAP (1u << 22)
#define LAS __attribute__((address_space(3)))
__device__ __forceinline__ unsigned xb_ld(unsigned* p) { return __hip_atomic_load(p, __ATOMIC_RELAXED, __HIP_MEMORY_SCOPE_AGENT); }
__device__ __forceinline__ unsigned xb_add(unsigned* p, unsigned v) { return __hip_atomic_fetch_add(p, v, __ATOMIC_RELAXED, __HIP_MEMORY_SCOPE_AGENT); }
__device__ __forceinline__ unsigned xb_xcc_id() { return (unsigned)__builtin_amdgcn_s_getreg((3 << 11) | 20) & 0xFu; }
#define XB_SPIN(cond, bar) do { unsigned _sp = 0; while (cond) { __builtin_amdgcn_s_sleep(1); \
    if ((++_sp & 255u) == 0u) { if (xb_ld(&(bar)[XB_TMO])) break; if (_sp > XB_SPIN_CAP) { atomicAdd(&(bar)[XB_TMO], 1u); break; } } } } while (0)
struct XcdBarrier {
  unsigned* bar;
  unsigned x;
  volatile LAS unsigned* st;
};
__device__ __forceinline__ XcdBarrier xcd_barrier_post(unsigned* bar, volatile LAS unsigned* st) {
  XcdBarrier b;
  b.bar = bar;
  b.x = xb_xcc_id();
  b.st = st;
  if (threadIdx.x == 0) (void)xb_add(&bar[XB_XCNT(b.x)], 1u);
  return b;
}
__device__ __forceinline__ void xcd_barrier_complete(unsigned* bar, unsigned x, unsigned& nloc, unsigned& nx) {
  const unsigned G = gridDim.x * gridDim.y * gridDim.z;
  unsigned sum, cnt, mine, sp = 0u;
  for (;;) {
    sum = 0u; cnt = 0u; mine = 0u;
#pragma unroll
    for (unsigned j = 0; j < 16; ++j) {
      const unsigned c = xb_ld(&bar[XB_XCNT(j)]);
      sum += c;
      cnt += (c > 0u) ? 1u : 0u;
      mine = (j == x) ? c : mine;
    }
    if (sum == G) break;
    __builtin_amdgcn_s_sleep(1);
    if ((++sp & 255u) == 0u) {
      if (xb_ld(&bar[XB_TMO])) break;
      if (sp > XB_SPIN_CAP) { atomicAdd(&bar[XB_TMO], 1u); break; }
    }
  }
  nloc = mine > 0u ? mine : 1u;
  nx = cnt > 0u ? cnt : 1u;
}
__device__ __forceinline__ void xcd_barrier(const XcdBarrier& b) {
  asm volatile("s_waitcnt vmcnt(0)" ::: "memory");
  __syncthreads();
  if (threadIdx.x == 0) {
    unsigned* bar = b.bar;
    __builtin_amdgcn_s_waitcnt(0);
    unsigned nloc = b.st[0], nx = b.st[1];
    if (nloc == 0u) { xcd_barrier_complete(bar, b.x, nloc, nx); b.st[0] = nloc; b.st[1] = nx; }
    const unsigned old = xb_add(&bar[XB_XSUB(b.x)], 1u);
    const unsigned gen = old / nloc;
    if (old + 1u == (gen + 1u) * nloc) {
      __builtin_amdgcn_fence(__ATOMIC_RELEASE, "agent");
      asm volatile("s_waitcnt vmcnt(0)" ::: "memory");
      const unsigned og = xb_add(&bar[XB_TOP], 1u);
      const unsigned tg = og / nx;
      if (og + 1u == (tg + 1u) * nx) xb_add(&bar[XB_TOPGEN], 1u);
      else XB_SPIN(xb_ld(&bar[XB_TOPGEN]) == tg, bar);
      __builtin_amdgcn_fence(__ATOMIC_ACQUIRE, "agent");
      xb_add(&bar[XB_XGEN(b.x)], 1u);
      asm volatile("s_waitcnt vmcnt(0)" ::: "memory");
    } else {
      XB_SPIN(xb_ld(&bar[XB_XGEN(b.x)]) == gen, bar);
      __builtin_amdgcn_fence(__ATOMIC_ACQUIRE, "agent");
      asm volatile("s_waitcnt vmcnt(0)" ::: "memory");
    }
  }
  __syncthreads();
}

struct MixSrc {
  const u16* hs;
  const u16* zr;
  const float* mix;
};

__device__ __forceinline__ unsigned mix2(unsigned h, unsigned p, float m0, float m1) {
  float h0 = bflo(h), h1 = bfhi(h), p0 = bflo(p), p1 = bfhi(p);
  return pack2(h0 + (p0 - h0) * m0, h1 + (p1 - h1) * m1);
}

template <bool MIX, class Epi>
__device__ __forceinline__ void gemm_tile(const u16* __restrict__ A, int lda, MixSrc ms, const u16* __restrict__ Bt, int N, int K,
                                          int m0, int n0, char* lds, Epi&& epi) {
  const int tid = threadIdx.x, lane = tid & 63, w = tid >> 6;
  const int wm = w >> 1, wn = w & 1, lr = lane & 15, lg = lane >> 4;
  const int kc = tid & 7, r0 = tid >> 3;
  const u16* ap[4];
  const u16* pp[4];
#pragma unroll
  for (int i = 0; i < 4; ++i) {
    int row = m0 + r0 + 64 * i;
    ap[i] = A + (size_t)row * lda + kc * 8;
    pp[i] = ap[i];
    if (MIX) {
      const u16* q;
      if (row < NP) q = (row & 4095) ? (A + (size_t)(row - 1) * lda) : ms.zr;
      else if (row < MROWS) q = ms.hs + (size_t)(row - NP) * 1024;
      else q = ms.zr;
      pp[i] = q + kc * 8;
    }
  }
  const u16* bp[2];
  bool bv[2];
#pragma unroll
  for (int j = 0; j < 2; ++j) {
    int n = n0 + r0 + 64 * j;
    bv[j] = n < N;
    bp[j] = Bt + (size_t)(bv[j] ? n : 0) * K + kc * 8;
  }
  uint4 ra[4], rp[4], rb[2];
  float4 mx0, mx1;
  auto gload = [&](int kt) {
    const int ko = kt * 64;
#pragma unroll
    for (int i = 0; i < 4; ++i) {
      ra[i] = *(const uint4*)(ap[i] + ko);
      if (MIX) rp[i] = *(const uint4*)(pp[i] + ko);
    }
    if (MIX) {
      mx0 = *(const float4*)(ms.mix + ko + kc * 8);
      mx1 = *(const float4*)(ms.mix + ko + kc * 8 + 4);
    }
#pragma unroll
    for (int j = 0; j < 2; ++j) {
      uint4 z = {0u, 0u, 0u, 0u};
      if (bv[j]) z = *(const uint4*)(bp[j] + ko);
      rb[j] = z;
    }
  };
  auto lstore = [&](int s) {
    char* base = lds + s * LDS_STAGE;
#pragma unroll
    for (int i = 0; i < 4; ++i) {
      uint4 v = ra[i];
      if (MIX) {
        v.x = mix2(ra[i].x, rp[i].x, mx0.x, mx0.y);
        v.y = mix2(ra[i].y, rp[i].y, mx0.z, mx0.w);
        v.z = mix2(ra[i].z, rp[i].z, mx1.x, mx1.y);
        v.w = mix2(ra[i].w, rp[i].w, mx1.z, mx1.w);
      }
      *(uint4*)(base + (r0 + 64 * i) * LDS_ROW + kc * 16) = v;
    }
#pragma unroll
    for (int j = 0; j < 2; ++j) *(uint4*)(base + LDS_A_BYTES + (r0 + 64 * j) * LDS_ROW + kc * 16) = rb[j];
  };
  f32x4 acc[4][4];
#pragma unroll
  for (int i = 0; i < 4; ++i)
#pragma unroll
    for (int j = 0; j < 4; ++j) acc[i][j] = f32x4{0.f, 0.f, 0.f, 0.f};
  const int nk = K >> 6;
  gload(0);
  lstore(0);
  __syncthreads();
#pragma unroll 1
  for (int kt = 0; kt < nk; ++kt) {
    if (kt + 1 < nk) gload(kt + 1);
    const char* sa = lds + (kt & 1) * LDS_STAGE + (wm * 64 + lr) * LDS_ROW + lg * 16;
    const char* sb = lds + (kt & 1) * LDS_STAGE + LDS_A_BYTES + (wn * 64 + lr) * LDS_ROW + lg * 16;
#pragma unroll
    for (int ks = 0; ks < 2; ++ks) {
      bf16x8 af[4], bfg[4];
#pragma unroll
      for (int mi = 0; mi < 4; ++mi) af[mi] = *(const bf16x8*)(sa + mi * 16 * LDS_ROW + ks * 64);
#pragma unroll
      for (int ni = 0; ni < 4; ++ni) bfg[ni] = *(const bf16x8*)(sb + ni * 16 * LDS_ROW + ks * 64);
#pragma unroll
      for (int mi = 0; mi < 4; ++mi)
#pragma unroll
        for (int ni = 0; ni < 4; ++ni)
          acc[mi][ni] = __builtin_amdgcn_mfma_f32_16x16x32_bf16(af[mi], bfg[ni], acc[mi][ni], 0, 0, 0);
    }
    if (kt + 1 < nk) lstore((kt + 1) & 1);
    __syncthreads();
  }
  epi(acc);
}

#define GEMM_LANE_VARS                                            \
  const int tid_ = threadIdx.x, lane_ = tid_ & 63, w_ = tid_ >> 6; \
  const int wm = w_ >> 1, wn = w_ & 1, lr = lane_ & 15, lg = lane_ >> 4; \
  (void)wm; (void)wn; (void)lr; (void)lg;

#define EPI_FOREACH(acc, BODY)                                         \
  _Pragma("unroll") for (int mi = 0; mi < 4; ++mi) {                   \
  _Pragma("unroll") for (int r = 0; r < 4; ++r)                        \
  _Pragma("unroll") for (int ni = 0; ni < 4; ++ni) {                   \
    const int row = m0 + wm * 64 + mi * 16 + lg * 4 + r;               \
    const int col = n0 + wn * 64 + ni * 16 + lr;                       \
    const float v = acc[mi][ni][r];                                    \
    BODY                                                               \
  }                                                                    \
  __builtin_amdgcn_sched_barrier(0); }

__device__ __forceinline__ void conv_job(const float* __restrict__ src, u16* __restrict__ dst, int K, int N, float* tl, int rot) {
  const int tid = threadIdx.x;
  const int tn = N >> 6, nt = (K >> 6) * tn;
  const int G = gridDim.x;
  int start = ((int)blockIdx.x + G - (rot % G)) % G;
  for (int t = start; t < nt; t += G) {
    const int k0 = (t / tn) << 6, n0 = (t % tn) << 6;
#pragma unroll
    for (int i = 0; i < 8; ++i) {
      int e = tid + 512 * i;
      tl[(e >> 6) * 65 + (e & 63)] = src[(size_t)(k0 + (e >> 6)) * N + n0 + (e & 63)];
    }
    __syncthreads();
    const int n = tid >> 3, kc = tid & 7;
    float f[8];
#pragma unroll
    for (int j = 0; j < 8; ++j) f[j] = tl[(kc * 8 + j) * 65 + n];
    uint4 v;
    v.x = pack2(f[0], f[1]);
    v.y = pack2(f[2], f[3]);
    v.z = pack2(f[4], f[5]);
    v.w = pack2(f[6], f[7]);
    *(uint4*)(dst + (size_t)(n0 + n) * K + k0 + kc * 8) = v;
    __syncthreads();
  }
}

__device__ __forceinline__ void phase0(const Params& p, char* lds) {
  float* tl = (float*)lds;
  u16* wt = (u16*)(p.ws + WS_WT);
  u16* adawt = (u16*)(p.ws + S_ADAWT);
  int rot = 0;
#define CJ(SRC, DST, K, N)            \
  conv_job(SRC, DST, K, N, tl, rot);  \
  rot += ((K) >> 6) * ((N) >> 6);
  CJ(p.ada_w, adawt, 1024, 6144)
  CJ(p.ada_w + (size_t)1024 * 6144, adawt + (size_t)6144 * 1024, 1024, 6144)
  CJ(p.rw_wr, wt + WT_WR, 1024, 1024)
  CJ(p.rw_wk, wt + WT_WK, 1024, 1024)
  CJ(p.rw_wv, wt + WT_WV, 1024, 1024)
  CJ(p.rw_wo, wt + WT_WO, 1024, 1024)
  CJ(p.rw_w1, wt + WT_W1, 1024, 64)
  CJ(p.rw_a1, wt + WT_A1, 1024, 64)
  CJ(p.rw_g1, wt + WT_G1, 1024, 128)
  CJ(p.rw_w2, wt + WT_W2, 64, 1024)
  CJ(p.rw_a2, wt + WT_A2, 64, 1024)
  CJ(p.rw_g2, wt + WT_G2, 128, 1024)
  CJ(p.mlp_up, wt + WT_UP0, 1024, 4096)
  CJ(p.mlp_down, wt + WT_DN0, 4096, 1024)
  CJ(p.at_wqkv, wt + WT_QKV, 1024, 1536)
  CJ(p.at_wo, wt + WT_WO1, 1024, 1024)
  CJ(p.mlp_up + (size_t)4 * MEG, wt + WT_UP1, 1024, 4096)
  CJ(p.mlp_down + (size_t)4 * MEG, wt + WT_DN1, 4096, 1024)
#undef CJ
  const int gtid = blockIdx.x * NTHR + threadIdx.x, gsz = gridDim.x * NTHR;
  u16* siluc = (u16*)(p.ws + S_SILUC);
  for (int i = gtid; i < 256 * 1024; i += gsz) {
    int row = i >> 10, col = i & 1023;
    float c = 0.f;
    if (row < 4) c = p.c_prompt[row * 1024 + col];
    else if (row < 132) c = p.c_sample[(row - 4) * 1024 + col];
    siluc[i] = f2bf(c * sigmoidf_(c));
  }
  u16* hs = (u16*)(p.ws + WS_HS);
  for (int i = gtid; i < 128 * 1024; i += gsz) hs[i] = f2bf(p.state_shift[i]);
  u16* zr = (u16*)(p.ws + WS_ZR);
  for (int i = gtid; i < 1024; i += gsz) zr[i] = 0;
  float2* tab = (float2*)(p.ws + WS_TAB);
  for (int i = gtid; i < 4097 * 8; i += gsz) {
    int pi = i >> 3, f = i & 7;
    float pos = pi < 4096 ? (float)pi : 8192.f;
    float inv = f == 0 ? 1.0f : f == 1 ? 0.1939227432012558f : f == 2 ? 0.03760603070259094f : f == 3 ? 0.007292664609849453f
              : f == 4 ? 0.0014142135623842478f : f == 5 ? 0.00027424818836152554f : f == 6 ? 5.318296098266728e-05f
              : 1.0313386155758053e-05f;
    float ang = pos * inv;
    double t = (double)ang * 0.15915494309189535;
    t -= rint(t);
    float fr = (float)t;
    tab[i] = make_float2(__builtin_amdgcn_cosf(fr), __builtin_amdgcn_sinf(fr));
  }
}

__device__ __forceinline__ void phase_ada(const Params& p, char* lds) {
  GEMM_LANE_VARS
  const u16* siluc = (const u16*)(p.ws + S_SILUC);
  const u16* adawt = (const u16*)(p.ws + S_ADAWT);
  float* mod = (float*)(p.ws + WS_MOD);
  MixSrc ms{nullptr, nullptr, nullptr};
  for (int t = blockIdx.x; t < 96; t += gridDim.x) {
    const int layer = t / 48, nt = t % 48;
    const int m0 = 0, n0 = nt * 128;
    const float* bias = p.ada_b + layer * 6144;
    float* mo = mod + (size_t)layer * 132 * 6144;
    gemm_tile<false>(siluc, 1024, ms, adawt + (size_t)layer * 6144 * 1024, 6144, 1024, m0, n0, lds, [&](f32x4(&acc)[4][4]) {
      EPI_FOREACH(acc, if (row < 132) mo[(size_t)row * 6144 + col] = v + bias[col];)
    });
  }
}

__device__ __forceinline__ void phase_norm(const Params& p, int layer, int which, bool from_input, bool shift_out) {
  const int lane = threadIdx.x & 63, w = threadIdx.x >> 6;
  const float* mod = (const float*)(p.ws + WS_MOD);
  u16* H = (u16*)(p.ws + WS_H);
  const float* g = (which ? p.norm2_g : p.norm1_g) + layer * 1024;
  const int nw = gridDim.x * 8;
  for (int row = blockIdx.x * 8 + w; row < MROWS; row += nw) {
    const float* xr = from_input ? (row < NP ? p.x_prompt + (size_t)row * 1024 : p.x_sample + (size_t)(row - NP) * 1024)
                                 : p.out + (size_t)row * 1024;
    float4 x[4];
    float ss = 0.f;
#pragma unroll
    for (int i = 0; i < 4; ++i) {
      x[i] = *(const float4*)(xr + lane * 4 + 256 * i);
      ss += x[i].x * x[i].x + x[i].y * x[i].y + x[i].z * x[i].z + x[i].w * x[i].w;
    }
    ss = wavesum(ss);
    const float rs = rsqrtf(ss * (1.f / 1024.f) + 1e-6f);
    const int bi = bidx_of(row);
    const float* mb = mod + ((size_t)layer * 132 + bi) * 6144;
    const float* sh = mb + (which ? 3 : 0) * 1024;
    const float* sc = mb + (which ? 4 : 1) * 1024;
    const bool so = shift_out && (row >= NP || (row & 4095) == 4095);
    float* sop = row >= NP ? p.out + O_SHS + (size_t)(row - NP) * 1024 : p.out + O_SHP + (size_t)(row >> 12) * 1024;
#pragma unroll
    for (int i = 0; i < 4; ++i) {
      const int c = lane * 4 + 256 * i;
      float4 gg = *(const float4*)(g + c), s4 = *(const float4*)(sh + c), c4 = *(const float4*)(sc + c);
      float4 h;
      h.x = x[i].x * rs * gg.x * (1.f + c4.x) + s4.x;
      h.y = x[i].y * rs * gg.y * (1.f + c4.y) + s4.y;
      h.z = x[i].z * rs * gg.z * (1.f + c4.z) + s4.z;
      h.w = x[i].w * rs * gg.w * (1.f + c4.w) + s4.w;
      uint2 pk;
      pk.x = pack2(h.x, h.y);
      pk.y = pack2(h.z, h.w);
      *(uint2*)(H + (size_t)row * 1024 + c) = pk;
      if (so) *(float4*)(sop + c) = h;
    }
  }
}

__device__ __forceinline__ void phase_final(const Params& p) {
  const int lane = threadIdx.x & 63, w = threadIdx.x >> 6;
  const int nw = gridDim.x * 8;
  for (int row = blockIdx.x * 8 + w; row < MROWS; row += nw) {
    float* xr = p.out + (size_t)row * 1024;
    float4 x[4];
    float ss = 0.f;
#pragma unroll
    for (int i = 0; i < 4; ++i) {
      x[i] = *(const float4*)(xr + lane * 4 + 256 * i);
      ss += x[i].x * x[i].x + x[i].y * x[i].y + x[i].z * x[i].z + x[i].w * x[i].w;
    }
    ss = wavesum(ss);
    const float rs = rsqrtf(ss * (1.f / 1024.f) + 1e-6f);
#pragma unroll
    for (int i = 0; i < 4; ++i) {
      const int c = lane * 4 + 256 * i;
      float4 gg = *(const float4*)(p.final_g + c);
      float4 h;
      h.x = x[i].x * rs * gg.x;
      h.y = x[i].y * rs * gg.y;
      h.z = x[i].z * rs * gg.z;
      h.w = x[i].w * rs * gg.w;
      *(float4*)(xr + c) = h;
    }
  }
}

__device__ __forceinline__ void phase_rwkv_proj(const Params& p, char* lds) {
  GEMM_LANE_VARS
  const u16* H = (const u16*)(p.ws + WS_H);
  const u16* wt = (const u16*)(p.ws + WS_WT);
  u16* R = (u16*)(p.ws + S_R);
  u16* Kk = (u16*)(p.ws + S_K);
  u16* V = (u16*)(p.ws + S_V);
  u16* WH = (u16*)(p.ws + S_WH);
  u16* AH = (u16*)(p.ws + S_AH);
  u16* GH = (u16*)(p.ws + S_GH);
  for (int t = blockIdx.x; t < 65 * 27; t += gridDim.x) {
    const int mt = t / 27, j = t % 27;
    const int m0 = mt * 256;
    int kind, n0, N, mixi;
    const u16* Bt;
    if (j < 8) { kind = 0; n0 = j * 128; N = 1024; mixi = 0; Bt = wt + WT_WR; }
    else if (j < 16) { kind = 1; n0 = (j - 8) * 128; N = 1024; mixi = 2; Bt = wt + WT_WK; }
    else if (j < 24) { kind = 2; n0 = (j - 16) * 128; N = 1024; mixi = 3; Bt = wt + WT_WV; }
    else if (j == 24) { kind = 3; n0 = 0; N = 64; mixi = 1; Bt = wt + WT_W1; }
    else if (j == 25) { kind = 4; n0 = 0; N = 64; mixi = 4; Bt = wt + WT_A1; }
    else { kind = 5; n0 = 0; N = 128; mixi = 5; Bt = wt + WT_G1; }
    MixSrc ms{(const u16*)(p.ws + WS_HS), (const u16*)(p.ws + WS_ZR), p.rw_mix + mixi * 1024};
    gemm_tile<true>(H, 1024, ms, Bt, N, 1024, m0, n0, lds, [&](f32x4(&acc)[4][4]) {
      u16* dst = kind == 0 ? R : kind == 1 ? Kk : kind == 2 ? V : kind == 3 ? WH : kind == 4 ? AH : GH;
      const int ld = kind < 3 ? 1024 : (kind == 5 ? 128 : 64);
      EPI_FOREACH(acc, if (row < MROWS && col < ld) {
        float o = v;
        if (kind == 3) {
          const float e = __expf(2.f * v);
          o = 1.f - 2.f / (e + 1.f);
        } else if (kind == 5) {
          o = sigmoidf_(v);
        }
        dst[(size_t)row * ld + col] = f2bf(o);
      })
    });
  }
}

__device__ __forceinline__ void phase_rwkv_lora2(const Params& p, char* lds) {
  GEMM_LANE_VARS
  const u16* wt = (const u16*)(p.ws + WS_WT);
  const u16* WH = (const u16*)(p.ws + S_WH);
  const u16* AH = (const u16*)(p.ws + S_AH);
  u16* EW = (u16*)(p.ws + S_EW);
  u16* Aa = (u16*)(p.ws + S_A);
  MixSrc ms{nullptr, nullptr, nullptr};
  for (int t = blockIdx.x; t < 65 * 16; t += gridDim.x) {
    const int mt = t >> 4, j = t & 15;
    const int m0 = mt * 256, n0 = (j & 7) * 128;
    if (j < 8) {
      gemm_tile<false>(WH, 64, ms, wt + WT_W2, 1024, 64, m0, n0, lds, [&](f32x4(&acc)[4][4]) {
        EPI_FOREACH(acc, if (row < MROWS) {
          float z = p.rw_w0[col] + v;
          EW[(size_t)row * 1024 + col] = f2h(0.6065306597126334f * sigmoidf_(z));
        })
      });
    } else {
      gemm_tile<false>(AH, 64, ms, wt + WT_A2, 1024, 64, m0, n0, lds, [&](f32x4(&acc)[4][4]) {
        EPI_FOREACH(acc, if (row < MROWS) Aa[(size_t)row * 1024 + col] = f2bf(sigmoidf_(p.rw_a0[col] + v));)
      });
    }
  }
}

constexpr int RING_TS = 344;
constexpr int RING_BUF = 16 * RING_TS;

__device__ __forceinline__ void phase_scan(const Params& p, char* lds) {
  const int tid = threadIdx.x, lane = tid & 63, w = tid >> 6;
  const u16* R = (const u16*)(p.ws + S_R);
  const u16* Kk = (const u16*)(p.ws + S_K);
  const u16* V = (const u16*)(p.ws + S_V);
  const u16* EW = (const u16*)(p.ws + S_EW);
  const u16* Aa = (const u16*)(p.ws + S_A);
  u16* Y = (u16*)(p.ws + WS_H);
  float* RK = (float*)(p.ws + WS_RK);
  float* ring = (float*)lds;
  float* ybuf = (float*)(lds + 2 * RING_BUF * 4);
  for (int item = blockIdx.x; item < 256; item += gridDim.x) {
    const int chain = item >> 2, qr = item & 3, b = chain >> 4, h = chain & 15;
    const size_t rowbase = (size_t)b * 4096;
    __syncthreads();
    if (tid >= 256) {
      const int pt = tid - 256, tok = pt >> 4, cq = pt & 15;
      const int ch = h * 64 + cq * 4;
      const float4 kk4 = *(const float4*)(p.rw_kk + ch), ka4 = *(const float4*)(p.rw_ka + ch), rk4 = *(const float4*)(p.rw_rk + ch);
      uint2 rr, rk_, rv, ra_, re;
      auto pload = [&](int c) {
        const size_t off = (rowbase + (size_t)c * 16 + tok) * 1024 + ch;
        rr = *(const uint2*)(R + off);
        rk_ = *(const uint2*)(Kk + off);
        rv = *(const uint2*)(V + off);
        ra_ = *(const uint2*)(Aa + off);
        re = *(const uint2*)(EW + off);
      };
      auto pproc = [&](int c) {
        float rf[4] = {bflo(rr.x), bfhi(rr.x), bflo(rr.y), bfhi(rr.y)};
        float kf[4] = {bflo(rk_.x), bfhi(rk_.x), bflo(rk_.y), bfhi(rk_.y)};
        float vf[4] = {bflo(rv.x), bfhi(rv.x), bflo(rv.y), bfhi(rv.y)};
        float af[4] = {bflo(ra_.x), bfhi(ra_.x), bflo(ra_.y), bfhi(ra_.y)};
        float ef[4] = {h2f((u16)(re.x & 0xffff)), h2f((u16)(re.x >> 16)), h2f((u16)(re.y & 0xffff)), h2f((u16)(re.y >> 16))};
        const float kkw[4] = {kk4.x, kk4.y, kk4.z, kk4.w}, kaw[4] = {ka4.x, ka4.y, ka4.z, ka4.w}, rkw[4] = {rk4.x, rk4.y, rk4.z, rk4.w};
        float kkr[4], kp[4], ss = 0.f, rks = 0.f;
#pragma unroll
        for (int j = 0; j < 4; ++j) {
          kkr[j] = kf[j] * kkw[j];
          ss += kkr[j] * kkr[j];
          kp[j] = kf[j] * (1.f + (af[j] - 1.f) * kaw[j]);
          rks += rf[j] * kp[j] * rkw[j];
        }
        ss = rowsum16(ss);
        rks = rowsum16(rks);
        const float inv = 1.f / fmaxf(sqrtf(ss), 1e-12f);
        float* slot = ring + (c & 1) * RING_BUF + tok * RING_TS;
        float4 o;
        o = make_float4(-kkr[0] * inv, -kkr[1] * inv, -kkr[2] * inv, -kkr[3] * inv);
        *(float4*)(slot + cq * 4) = o;
        o = make_float4(__expf(-ef[0]), __expf(-ef[1]), __expf(-ef[2]), __expf(-ef[3]));
        *(float4*)(slot + 64 + cq * 4) = o;
        o = make_float4(kkr[0] * inv * af[0], kkr[1] * inv * af[1], kkr[2] * inv * af[2], kkr[3] * inv * af[3]);
        *(float4*)(slot + 128 + cq * 4) = o;
        o = make_float4(kp[0], kp[1], kp[2], kp[3]);
        *(float4*)(slot + 192 + cq * 4) = o;
        o = make_float4(rf[0], rf[1], rf[2], rf[3]);
        *(float4*)(slot + 256 + cq * 4) = o;
        if ((cq >> 2) == qr) *(float4*)(slot + 320 + (cq & 3) * 4) = make_float4(vf[0], vf[1], vf[2], vf[3]);
        if (cq == 0 && qr == 0) RK[(rowbase + (size_t)c * 16 + tok) * 16 + h] = rks;
      };
      pload(0);
      pproc(0);
      pload(1);
      __syncthreads();
      for (int c = 0; c < 256; ++c) {
        if (c + 1 < 256) pproc(c + 1);
        if (c + 2 < 256) pload(c + 2);
        __syncthreads();
      }
    } else {
      const int rl = tid >> 4, cgp = tid & 15;
      float s0 = 0.f, s1 = 0.f, s2 = 0.f, s3 = 0.f;
      __syncthreads();
      for (int c = 0; c < 256; ++c) {
        if (c > 0) {
          const float yv = ybuf[((c - 1) & 1) * 256 + tid];
          Y[(rowbase + (size_t)(c - 1) * 16 + rl) * 1024 + h * 64 + qr * 16 + cgp] = f2bf(yv);
        }
        const float* bufp = ring + (c & 1) * RING_BUF;
        float* yb = ybuf + (c & 1) * 256;
#pragma unroll 4
        for (int tk = 0; tk < 16; ++tk) {
          const float* slot = bufp + tk * RING_TS;
          const float4 a4 = *(const float4*)(slot + cgp * 4);
          const float4 w4 = *(const float4*)(slot + 64 + cgp * 4);
          const float4 b4 = *(const float4*)(slot + 128 + cgp * 4);
          const float4 k4 = *(const float4*)(slot + 192 + cgp * 4);
          const float4 r4 = *(const float4*)(slot + 256 + cgp * 4);
          const float vv = slot[320 + rl];
          float sa = s0 * a4.x + s1 * a4.y + s2 * a4.z + s3 * a4.w;
          sa = rowsum16(sa);
          s0 = s0 * w4.x + sa * b4.x + vv * k4.x;
          s1 = s1 * w4.y + sa * b4.y + vv * k4.y;
          s2 = s2 * w4.z + sa * b4.z + vv * k4.z;
          s3 = s3 * w4.w + sa * b4.w + vv * k4.w;
          float y = s0 * r4.x + s1 * r4.y + s2 * r4.z + s3 * r4.w;
          y = rowsum16(y);
          if (cgp == 0) yb[tk * 16 + rl] = y;
        }
        __syncthreads();
      }
      {
        const float yv = ybuf[(255 & 1) * 256 + tid];
        Y[(rowbase + (size_t)255 * 16 + rl) * 1024 + h * 64 + qr * 16 + cgp] = f2bf(yv);
      }
      float* wo = p.out + O_WKVP + (((size_t)(b * 16 + h) * 64) + qr * 16 + rl) * 64 + cgp * 4;
      *(float4*)wo = make_float4(s0, s1, s2, s3);
    }
  }
  float* sl = (float*)lds;
  for (int chain = blockIdx.x; chain < 2048; chain += gridDim.x) {
    const int b = chain >> 4, h = chain & 15;
    const size_t row = (size_t)NP + b;
    __syncthreads();
    if (w == 0) {
      const int ch = h * 64 + lane;
      const size_t off = row * 1024 + ch;
      const float rf = bf2f(R[off]), kf = bf2f(Kk[off]), vf = bf2f(V[off]), af = bf2f(Aa[off]), ef = h2f(EW[off]);
      const float kkr = kf * p.rw_kk[ch];
      const float ss = wavesum(kkr * kkr);
      const float inv = 1.f / fmaxf(sqrtf(ss), 1e-12f);
      const float kp = kf * (1.f + (af - 1.f) * p.rw_ka[ch]);
      const float rks = wavesum(rf * kp * p.rw_rk[ch]);
      sl[lane] = -kkr * inv;
      sl[64 + lane] = __expf(-ef);
      sl[128 + lane] = kkr * inv * af;
      sl[192 + lane] = kp;
      sl[256 + lane] = rf;
      sl[320 + lane] = vf;
      if (lane == 0) RK[row * 16 + h] = rks;
    }
    __syncthreads();
    const int i = tid >> 3, c8 = tid & 7;
    const float* sp = p.state_wkv + (((size_t)(b * 16 + h) * 64) + i) * 64 + c8 * 8;
    float4 sA = *(const float4*)sp, sB = *(const float4*)(sp + 4);
    float s[8] = {sA.x, sA.y, sA.z, sA.w, sB.x, sB.y, sB.z, sB.w};
    float sa = 0.f;
#pragma unroll
    for (int j = 0; j < 8; ++j) sa += s[j] * sl[c8 * 8 + j];
    sa += __shfl_xor(sa, 1);
    sa += __shfl_xor(sa, 2);
    sa += __shfl_xor(sa, 4);
    const float vv = sl[320 + i];
    float y = 0.f;
#pragma unroll
    for (int j = 0; j < 8; ++j) {
      const int cj = c8 * 8 + j;
      s[j] = s[j] * sl[64 + cj] + sa * sl[128 + cj] + vv * sl[192 + cj];
      y += s[j] * sl[256 + cj];
    }
    y += __shfl_xor(y, 1);
    y += __shfl_xor(y, 2);
    y += __shfl_xor(y, 4);
    float* wo = p.out + O_WKVS + (((size_t)(b * 16 + h) * 64) + i) * 64 + c8 * 8;
    *(float4*)wo = make_float4(s[0], s[1], s[2], s[3]);
    *(float4*)(wo + 4) = make_float4(s[4], s[5], s[6], s[7]);
    if (c8 == 0) Y[row * 1024 + h * 64 + i] = f2bf(y);
  }
}

__device__ __forceinline__ void phase_gate(const Params& p, char* lds) {
  GEMM_LANE_VARS
  const u16* wt = (const u16*)(p.ws + WS_WT);
  const u16* GH = (const u16*)(p.ws + S_GH);
  const u16* V = (const u16*)(p.ws + S_V);
  const float* RK = (const float*)(p.ws + WS_RK);
  u16* Y = (u16*)(p.ws + WS_H);
  MixSrc ms{nullptr, nullptr, nullptr};
  for (int t = blockIdx.x; t < 65 * 8; t += gridDim.x) {
    const int mt = t >> 3, nt = t & 7;
    const int m0 = mt * 256, n0 = nt * 128;
    gemm_tile<false>(GH, 128, ms, wt + WT_G2, 1024, 128, m0, n0, lds, [&](f32x4(&acc)[4][4]) {
      const int hh = (n0 + wn * 64) >> 6;
#pragma unroll
      for (int mi = 0; mi < 4; ++mi)
#pragma unroll
        for (int r = 0; r < 4; ++r) {
          const int row = m0 + wm * 64 + mi * 16 + lg * 4 + r;
          const int rowc = row < MROWS ? row : MROWS - 1;
          float yv[4], sum = 0.f;
#pragma unroll
          for (int ni = 0; ni < 4; ++ni) {
            yv[ni] = bf2f(Y[(size_t)rowc * 1024 + hh * 64 + ni * 16 + lr]);
            sum += yv[ni];
          }
          sum = rowsum16(sum);
          const float mu = sum * (1.f / 64.f);
          float vs = 0.f;
#pragma unroll
          for (int ni = 0; ni < 4; ++ni) {
            const float d = yv[ni] - mu;
            vs += d * d;
          }
          vs = rowsum16(vs);
          const float rstd = rsqrtf(vs * (1.f / 64.f) + 64e-5f);
          const float rk = RK[(size_t)rowc * 16 + hh];
#pragma unroll
          for (int ni = 0; ni < 4; ++ni) {
            const int col = hh * 64 + ni * 16 + lr;
            const float vv = bf2f(V[(size_t)rowc * 1024 + col]);
            const float o = ((yv[ni] - mu) * rstd * p.rw_lnx_g[col] + p.rw_lnx_b[col] + rk * vv) * acc[mi][ni][r];
            if (row < MROWS) Y[(size_t)row * 1024 + col] = f2bf(o);
          }
        }
    });
  }
}

__device__ __forceinline__ void phase_oproj(const Params& p, char* lds, const u16* A, int K, const u16* Bt, int layer, int gidx, bool first) {
  GEMM_LANE_VARS
  const float* mod = (const float*)(p.ws + WS_MOD);
  MixSrc ms{nullptr, nullptr, nullptr};
  for (int t = blockIdx.x; t < 65 * 8; t += gridDim.x) {
    const int mt = t >> 3, nt = t & 7;
    const int m0 = mt * 256, n0 = nt * 128;
    gemm_tile<false>(A, K, ms, Bt, 1024, K, m0, n0, lds, [&](f32x4(&acc)[4][4]) {
      EPI_FOREACH(acc, if (row < MROWS) {
        const float gt = mod[((size_t)layer * 132 + bidx_of(row)) * 6144 + gidx * 1024 + col];
        float* xp = p.out + (size_t)row * 1024 + col;
        float xo;
        if (first) xo = row < NP ? p.x_prompt[(size_t)row * 1024 + col] : p.x_sample[(size_t)(row - NP) * 1024 + col];
        else xo = *xp;
        *xp = xo + gt * v;
      })
    });
  }
}

__device__ __forceinline__ void phase_up(const Params& p, char* lds, const u16* Bt) {
  GEMM_LANE_VARS
  const u16* H = (const u16*)(p.ws + WS_H);
  u16* UP = (u16*)(p.ws + S_UP);
  MixSrc ms{nullptr, nullptr, nullptr};
  for (int t = blockIdx.x; t < 65 * 32; t += gridDim.x) {
    const int mt = t >> 5, nt = t & 31;
    const int m0 = mt * 256, n0 = nt * 128;
    gemm_tile<false>(H, 1024, ms, Bt, 4096, 1024, m0, n0, lds, [&](f32x4(&acc)[4][4]) {
      EPI_FOREACH(acc, if (row < MROWS) {
        const float rl = fmaxf(v, 0.f);
        UP[(size_t)row * 4096 + col] = f2bf(rl * rl);
      })
    });
  }
}

__device__ __forceinline__ void phase_qkv(const Params& p, char* lds) {
  GEMM_LANE_VARS
  const u16* H = (const u16*)(p.ws + WS_H);
  const u16* wt = (const u16*)(p.ws + WS_WT);
  const float2* tab = (const float2*)(p.ws + WS_TAB);
  u16* Qb = (u16*)(p.ws + S_Q);
  u16* Kb = (u16*)(p.ws + S_KB);
  u16* Vt = (u16*)(p.ws + S_VT);
  MixSrc ms{nullptr, nullptr, nullptr};
  for (int t = blockIdx.x; t < 65 * 12; t += gridDim.x) {
    const int mt = t / 12, nt = t % 12;
    const int m0 = mt * 256, n0 = nt * 128;
    gemm_tile<false>(H, 1024, ms, wt + WT_QKV, 1536, 1024, m0, n0, lds, [&](f32x4(&acc)[4][4]) {
      const int hc0 = n0 + wn * 64;
#pragma unroll
      for (int mi = 0; mi < 4; ++mi)
#pragma unroll
        for (int r = 0; r < 4; ++r) {
          const int row = m0 + wm * 64 + mi * 16 + lg * 4 + r;
          const bool valid = row < MROWS;
          const bool isp = row < NP;
          const int pos = row & 4095;
          const int bq = isp ? (row >> 12) : (row - NP);
          const int posidx = isp ? pos : 4096;
#pragma unroll
          for (int ni = 0; ni < 4; ++ni) {
            const int col = hc0 + ni * 16 + lr;
            float v = acc[mi][ni][r] + p.at_bqkv[col];
            if (ni == 0 && hc0 < 1280) {
              const float pv = dppf<0x128>(v);
              const float2 cs = tab[posidx * 8 + (lr & 7)];
              v = (lr < 8) ? (v * cs.x - pv * cs.y) : (v * cs.x + pv * cs.y);
            }
            if (valid) {
              if (hc0 < 1024) {
                Qb[(size_t)row * 1024 + col] = f2bf(v);
              } else if (hc0 < 1280) {
                const int c2 = col - 1024;
                Kb[(size_t)row * 256 + c2] = f2bf(v);
                if (isp) {
                  if (pos >= 3968) p.out[O_KP + ((size_t)(bq * 128 + pos - 3968)) * 256 + c2] = v;
                } else {
                  p.out[O_KS + ((size_t)(bq * 128 + 127)) * 256 + c2] = v;
                }
              } else {
                const int c3 = col - 1280;
                if (isp) {
                  Vt[((size_t)(bq * 4 + (c3 >> 6)) * 64 + (c3 & 63)) * 4096 + pos] = f2bf(v);
                  if (pos >= 3968) p.out[O_VP + ((size_t)(bq * 128 + pos - 3968)) * 256 + c3] = v;
                } else {
                  p.out[O_VS + ((size_t)(bq * 128 + 127)) * 256 + c3] = v;
                }
              }
            }
          }
        }
    });
  }
}

constexpr int AT_KS = 0, AT_VS = 36864, AT_PS = 36864 + 35840, AT_PW = 5376;

__device__ __forceinline__ void phase_attn(const Params& p, char* lds) {
  const int tid = threadIdx.x, lane = tid & 63, w = tid >> 6, lr = lane & 15, lg = lane >> 4;
  const u16* Qb = (const u16*)(p.ws + S_Q);
  const u16* Kb = (const u16*)(p.ws + S_KB);
  const u16* Vt = (const u16*)(p.ws + S_VT);
  u16* O = (u16*)(p.ws + S_O);
  char* Ks = lds + AT_KS;
  char* Vs = lds + AT_VS;
  char* Ps = lds + AT_PS + w * AT_PW;
  for (int u = blockIdx.x; u < 512; u += gridDim.x) {
    const int b = u >> 7, n = (u >> 2) & 31, kvh = u & 3;
    __syncthreads();
#pragma unroll
    for (int i = 0; i < 4; ++i) {
      const int c = tid + 512 * i;
      {
        const int key = c >> 3, kc = c & 7;
        const int pos = n * 128 - 128 + key;
        uint4 v = {0u, 0u, 0u, 0u};
        if (pos >= 0) v = *(const uint4*)(Kb + ((size_t)b * 4096 + pos) * 256 + kvh * 64 + kc * 8);
        *(uint4*)(Ks + key * 144 + kc * 16) = v;
      }
      {
        const int d = c >> 5, kc = c & 31;
        const int pos0 = n * 128 - 128 + kc * 8;
        uint4 v = {0u, 0u, 0u, 0u};
        if (pos0 >= 0) v = *(const uint4*)(Vt + ((size_t)(b * 4 + kvh) * 64 + d) * 4096 + pos0);
        *(uint4*)(Vs + d * 560 + kc * 16) = v;
      }
    }
    if (tid < 192) {
      const int d = tid / 3, c = tid % 3;
      *(uint4*)(Vs + d * 560 + 512 + c * 16) = uint4{0u, 0u, 0u, 0u};
    }
    {
      const int prow = lane >> 2, pc = 144 + (lane & 3) * 4;
      *(uint2*)(Ps + prow * 336 + pc * 2) = uint2{0u, 0u};
    }
    __syncthreads();
    const int g = w >> 1, hf = w & 1;
    const int qh = kvh * 4 + g;
    const float sink = p.at_sink[qh];
#pragma unroll 1
    for (int i = 0; i < 4; ++i) {
      const int q0 = hf * 64 + i * 16;
      const size_t tok = (size_t)b * 4096 + n * 128 + q0 + lr;
      const bf16x8 qf0 = *(const bf16x8*)(Qb + tok * 1024 + qh * 64 + lg * 8);
      const bf16x8 qf1 = *(const bf16x8*)(Qb + tok * 1024 + qh * 64 + 32 + lg * 8);
      f32x4 s[9];
#pragma unroll
      for (int j = 0; j < 9; ++j) {
        const char* kp = Ks + (q0 + j * 16 + lr) * 144 + lg * 16;
        const bf16x8 k0 = *(const bf16x8*)kp;
        const bf16x8 k1 = *(const bf16x8*)(kp + 64);
        f32x4 z = {0.f, 0.f, 0.f, 0.f};
        z = __builtin_amdgcn_mfma_f32_16x16x32_bf16(qf0, k0, z, 0, 0, 0);
        z = __builtin_amdgcn_mfma_f32_16x16x32_bf16(qf1, k1, z, 0, 0, 0);
        s[j] = z;
      }
      float mx[4], sum[4];
#pragma unroll
      for (int r = 0; r < 4; ++r) {
        const int ql = lg * 4 + r;
        float m = sink;
#pragma unroll
        for (int j = 0; j < 9; ++j) {
          float v = s[j][r] * 0.125f;
          bool ok = true;
          if (j == 0) ok = (lr >= ql);
          if (j == 8) ok = (lr <= ql);
          if (n == 0 && (q0 + j * 16 + lr) < 128) ok = false;
          v = ok ? v : -INFINITY;
          s[j][r] = v;
          m = fmaxf(m, v);
        }
        mx[r] = rowmax16(m);
      }
#pragma unroll
      for (int r = 0; r < 4; ++r) {
        float sm = 0.f;
#pragma unroll
        for (int j = 0; j < 9; ++j) {
          const float e = __expf(s[j][r] - mx[r]);
          s[j][r] = e;
          sm += e;
        }
        sm = rowsum16(sm);
        sum[r] = sm + __expf(sink - mx[r]);
      }
      u16* P = (u16*)Ps;
#pragma unroll
      for (int j = 0; j < 9; ++j)
#pragma unroll
        for (int r = 0; r < 4; ++r) P[(lg * 4 + r) * 168 + j * 16 + lr] = f2bf(s[j][r]);
      __builtin_amdgcn_wave_barrier();
      f32x4 o[4];
#pragma unroll
      for (int nd = 0; nd < 4; ++nd) o[nd] = f32x4{0.f, 0.f, 0.f, 0.f};
#pragma unroll
      for (int kk = 0; kk < 5; ++kk) {
        const bf16x8 pf = *(const bf16x8*)(Ps + lr * 336 + kk * 64 + lg * 16);
#pragma unroll
        for (int nd = 0; nd < 4; ++nd) {
          const bf16x8 vf = *(const bf16x8*)(Vs + (nd * 16 + lr) * 560 + (q0 + kk * 32 + lg * 8) * 2);
          o[nd] = __builtin_amdgcn_mfma_f32_16x16x32_bf16(pf, vf, o[nd], 0, 0, 0);
        }
      }
#pragma unroll
      for (int nd = 0; nd < 4; ++nd)
#pragma unroll
        for (int r = 0; r < 4; ++r) {
          const float v = o[nd][r] / sum[r];
          O[((size_t)b * 4096 + n * 128 + q0 + lg * 4 + r) * 1024 + qh * 64 + nd * 16 + lr] = f2bf(v);
        }
      __builtin_amdgcn_wave_barrier();
    }
  }
  float* qs = (float*)lds;
  float* sc = (float*)(lds + 1024);
  float* part = (float*)(lds + 1024 + 2112);
  for (int it = blockIdx.x; it < 512; it += gridDim.x) {
    const int b = it >> 2, kvh = it & 3;
    const size_t row = (size_t)NP + b;
    __syncthreads();
    if (tid < 256) qs[tid] = bf2f(Qb[row * 1024 + kvh * 256 + tid]);
    __syncthreads();
    {
      const int key = tid >> 2, g = tid & 3;
      const float* kp = p.cache_k + (((size_t)b * 128 + key) * 4 + kvh) * 64;
      float dot = 0.f;
#pragma unroll
      for (int d4 = 0; d4 < 16; ++d4) {
        const float4 kv = *(const float4*)(kp + d4 * 4);
        const float* q = qs + g * 64 + d4 * 4;
        dot += kv.x * q[0] + kv.y * q[1] + kv.z * q[2] + kv.w * q[3];
      }
      sc[g * 132 + key] = dot * 0.125f;
      if (key >= 1) {
        float* dst = p.out + O_KS + (((size_t)b * 128 + key - 1) * 4 + kvh) * 64 + g * 16;
        const float* src = kp + g * 16;
#pragma unroll
        for (int d4 = 0; d4 < 4; ++d4) *(float4*)(dst + d4 * 4) = *(const float4*)(src + d4 * 4);
      }
      if (tid < 4) {
        const float* kn = p.out + O_KS + (((size_t)b * 128 + 127) * 4 + kvh) * 64;
        float d2 = 0.f;
        for (int d = 0; d < 64; ++d) d2 += kn[d] * qs[tid * 64 + d];
        sc[tid * 132 + 128] = d2 * 0.125f;
      }
    }
    __syncthreads();
    if (w < 4) {
      const float sink = p.at_sink[kvh * 4 + w];
      float* s = sc + w * 132;
      const float v0 = s[lane], v1 = s[64 + lane], v2 = lane == 0 ? s[128] : -INFINITY;
      float m = fmaxf(fmaxf(v0, v1), fmaxf(v2, sink));
      m = wavemax(m);
      const float e0 = __expf(v0 - m), e1 = __expf(v1 - m), e2 = lane == 0 ? __expf(v2 - m) : 0.f;
      float sm = wavesum(e0 + e1 + e2) + __expf(sink - m);
      const float inv = 1.f / sm;
      s[lane] = e0 * inv;
      s[64 + lane] = e1 * inv;
      if (lane == 0) s[128] = e2 * inv;
    }
    __syncthreads();
    {
      const int d = tid & 63, g = (tid >> 6) & 3, half = tid >> 8;
      const float* vp = p.cache_v + (((size_t)b * 128) * 4 + kvh) * 64 + d;
      float accv = 0.f;
      for (int key = half * 64; key < half * 64 + 64; ++key) {
        const float vv = vp[(size_t)key * 256];
        accv += sc[g * 132 + key] * vv;
        if (g == 0 && key >= 1) p.out[O_VS + (((size_t)b * 128 + key - 1) * 4 + kvh) * 64 + d] = vv;
      }
      if (half == 1) accv += sc[g * 132 + 128] * p.out[O_VS + (((size_t)b * 128 + 127) * 4 + kvh) * 64 + d];
      part[(half * 4 + g) * 64 + d] = accv;
    }
    __syncthreads();
    if (tid < 256) {
      const int d = tid & 63, g = tid >> 6;
      O[row * 1024 + (kvh * 4 + g) * 64 + d] = f2bf(part[g * 64 + d] + part[(4 + g) * 64 + d]);
    }
  }
}

__global__ void __launch_bounds__(NTHR) mega(Params p) {
  extern __shared__ __attribute__((aligned(16))) char lds[];
  cg::grid_group grid = cg::this_grid();
  volatile LAS unsigned* xst = (volatile LAS unsigned*)(lds + LDS_BYTES);
  if (threadIdx.x == 0) { xst[0] = 0u; xst[1] = 0u; }
  __syncthreads();
  const XcdBarrier xb = xcd_barrier_post((unsigned*)(p.ws + WS_BAR), xst);
  const u16* wt = (const u16*)(p.ws + WS_WT);
  phase0(p, lds);
  grid.sync();
  phase_ada(p, lds);
  xcd_barrier(xb);
  phase_norm(p, 0, 0, true, true);
  xcd_barrier(xb);
  phase_rwkv_proj(p, lds);
  xcd_barrier(xb);
  phase_rwkv_lora2(p, lds);
  xcd_barrier(xb);
  phase_scan(p, lds);
  xcd_barrier(xb);
  phase_gate(p, lds);
  xcd_barrier(xb);
  phase_oproj(p, lds, (const u16*)(p.ws + WS_H), 1024, wt + WT_WO, 0, 2, true);
  xcd_barrier(xb);
  phase_norm(p, 0, 1, false, false);
  xcd_barrier(xb);
  phase_up(p, lds, wt + WT_UP0);
  xcd_barrier(xb);
  phase_oproj(p, lds, (const u16*)(p.ws + S_UP), 4096, wt + WT_DN0, 0, 5, false);
  xcd_barrier(xb);
  phase_norm(p, 1, 0, false, false);
  xcd_barrier(xb);
  phase_qkv(p, lds);
  xcd_barrier(xb);
  phase_attn(p, lds);
  xcd_barrier(xb);
  phase_oproj(p, lds, (const u16*)(p.ws + S_O), 1024, wt + WT_WO1, 1, 2, false);
  xcd_barrier(xb);
  phase_norm(p, 1, 1, false, false);
  xcd_barrier(xb);
  phase_up(p, lds, wt + WT_UP1);
  xcd_barrier(xb);
  phase_oproj(p, lds, (const u16*)(p.ws + S_UP), 4096, wt + WT_DN1, 1, 5, false);
  xcd_barrier(xb);
  phase_final(p);
}

extern "C" void kernel_launch(void* const* d_in, const int* in_sizes, int n_in, void* d_out, int out_size, void* d_ws,
                              size_t ws_size, hipStream_t stream) {
  static int grid_blocks = 0;
  if (grid_blocks == 0) {
    if (ws_size < WS_END) {
      fprintf(stderr, "kernel_launch: workspace too small: %zu < %zu\n", ws_size, (size_t)WS_END);
      grid_blocks = -1;
      return;
    }
    int dev = 0, cus = 0, per_cu = 0;
    hipGetDevice(&dev);
    hipDeviceGetAttribute(&cus, hipDeviceAttributeMultiprocessorCount, dev);
    hipFuncSetAttribute((const void*)mega, hipFuncAttributeMaxDynamicSharedMemorySize, LDS_BYTES + 16);
    hipOccupancyMaxActiveBlocksPerMultiprocessor(&per_cu, (const void*)mega, NTHR, LDS_BYTES + 16);
    if (per_cu < 1) per_cu = 1;
    grid_blocks = cus * per_cu;
  }
  if (grid_blocks < 0) return;
  Params p{};
  const float** pp = (const float**)&p;
  for (int i = 0; i < 37; ++i) pp[i] = (const float*)d_in[i];
  p.out = (float*)d_out;
  p.ws = (char*)d_ws;
  hipMemsetAsync((char*)d_ws + WS_BAR, 0, 16384, stream);
  void* args[] = {&p};
  hipError_t e = hipLaunchCooperativeKernel((const void*)mega, dim3(grid_blocks), dim3(NTHR), args, LDS_BYTES + 16, stream);
  if (e != hipSuccess) fprintf(stderr, "cooperative launch failed: %s (grid %d)\n", hipGetErrorString(e), grid_blocks);
}
```

```cpp
#include <hip/hip_runtime.h>
#include <hip/hip_cooperative_groups.h>
#include <cstdio>
namespace cg = cooperative_groups;

typedef unsigned short u16;
typedef __attribute__((ext_vector_type(8))) short bf16x8;
typedef __attribute__((ext_vector_type(4))) float f32x4;

constexpr int NP = 16384, MROWS = 16512, MPAD = 16640;
constexpr int NTHR = 512;
constexpr size_t MEG = 1048576;
constexpr int LDH = 1088, LDU = 4160;

constexpr size_t O_Y = 0, O_WKVP = 16908288, O_WKVS = 17170432, O_SHP = 25559040, O_SHS = 25563136,
                 O_KP = 25694208, O_KS = 25825280, O_VP = 30019584, O_VS = 30150656;

constexpr size_t WT_WR = 0, WT_WK = WT_WR + 1024 * LDH, WT_WV = WT_WK + 1024 * LDH, WT_WO = WT_WV + 1024 * LDH,
                 WT_W1 = WT_WO + 1024 * LDH, WT_A1 = WT_W1 + 64 * LDH, WT_G1 = WT_A1 + 64 * LDH, WT_W2 = WT_G1 + 128 * LDH,
                 WT_A2 = WT_W2 + 65536, WT_G2 = WT_A2 + 65536, WT_UP0 = WT_G2 + 131072, WT_DN0 = WT_UP0 + 4096 * LDH,
                 WT_QKV = WT_DN0 + 1024 * LDU, WT_WO1 = WT_QKV + 1536 * LDH, WT_UP1 = WT_WO1 + 1024 * LDH,
                 WT_DN1 = WT_UP1 + 4096 * LDH, WT_END = WT_DN1 + 1024 * LDU;
constexpr size_t WS_WT = 0;
constexpr size_t WS_H = WS_WT + WT_END * 2;
constexpr size_t WS_ZR = WS_H + (size_t)MPAD * LDH * 2;
constexpr size_t WS_MOD = WS_ZR + (size_t)LDH * 2;
constexpr size_t WS_TAB = WS_MOD + (size_t)2 * 132 * 6144 * 4;
constexpr size_t WS_HS = WS_H + (size_t)MROWS * LDH * 2;
constexpr size_t WS_RK = WS_TAB + (size_t)4097 * 8 * 8;
constexpr size_t WS_BAR = WS_RK + (size_t)MPAD * 16 * 4;
constexpr size_t WS_S = WS_BAR + 16384;
constexpr size_t RSZ = (size_t)MROWS * 1024 * 2;
constexpr size_t S_ADAWT = WS_S, S_SILUC = S_ADAWT + (size_t)2 * 6144 * LDH * 2;
constexpr size_t S_R = WS_S, S_K = S_R + RSZ, S_V = S_K + RSZ, S_EW = S_V + RSZ, S_A = S_EW + RSZ,
                 S_WH = S_A + RSZ, S_AH = S_WH + (size_t)MPAD * 64 * 2, S_GH = S_AH + (size_t)MPAD * 64 * 2,
                 S_RW_END = S_GH + (size_t)MPAD * 128 * 2;
constexpr size_t S_UP = WS_S;
constexpr size_t S_Q = WS_S, S_O = S_Q + (size_t)MPAD * 1024 * 2, S_KB = S_O + (size_t)MPAD * LDH * 2,
                 S_VT = S_KB + (size_t)MPAD * 256 * 2;
constexpr size_t WS_END = S_RW_END;
static_assert(S_UP + (size_t)MPAD * LDU * 2 <= WS_END, "up fits");
static_assert(S_VT + (size_t)16 * 64 * 4096 * 2 <= WS_END, "attn fits");
static_assert(WS_END <= 282000000, "ws fits sum of inputs");

constexpr int LDS_ROW = 144;
constexpr int LDS_A_BYTES = 256 * LDS_ROW;
constexpr int LDS_B_BYTES = 128 * LDS_ROW;
constexpr int LDS_STAGE = LDS_A_BYTES + LDS_B_BYTES;
constexpr int LDS_BYTES = 115712;

struct Params {
  const float *x_prompt, *x_sample, *c_prompt, *c_sample, *state_wkv, *state_shift, *cache_k, *cache_v;
  const float *norm1_g, *norm2_g, *ada_w, *ada_b, *mlp_up, *mlp_down, *final_g;
  const float *rw_mix, *rw_wr, *rw_wk, *rw_wv, *rw_wo, *rw_w0, *rw_w1, *rw_w2, *rw_a0, *rw_a1, *rw_a2, *rw_g1, *rw_g2,
      *rw_kk, *rw_ka, *rw_rk, *rw_lnx_g, *rw_lnx_b;
  const float *at_wqkv, *at_bqkv, *at_wo, *at_sink;
  float* out;
  char* ws;
};

__device__ __forceinline__ u16 f2bf(float f) {
  unsigned u = __float_as_uint(f);
  u += 0x7fffu + ((u >> 16) & 1u);
  return (u16)(u >> 16);
}
__device__ __forceinline__ float bf2f(u16 h) { return __uint_as_float(((unsigned)h) << 16); }
__device__ __forceinline__ float bflo(unsigned w) { return __uint_as_float(w << 16); }
__device__ __forceinline__ float bfhi(unsigned w) { return __uint_as_float(w & 0xffff0000u); }
__device__ __forceinline__ unsigned pack2(float a, float b) {
  unsigned r;
  asm volatile("v_cvt_pk_bf16_f32 %0, %1, %2" : "=v"(r) : "v"(a), "v"(b));
  return r;
}
__device__ __forceinline__ uint2 pack4(f32x4 v) { return uint2{pack2(v[0], v[1]), pack2(v[2], v[3])}; }
__device__ __forceinline__ float h2f(u16 h) { return (float)__builtin_bit_cast(_Float16, h); }
__device__ __forceinline__ u16 f2h(float f) { return __builtin_bit_cast(u16, (_Float16)f); }
__device__ __forceinline__ float sigmoidf_(float x) { return 1.f / (1.f + __expf(-x)); }

template <int CTRL>
__device__ __forceinline__ float dppf(float x) {
  return __int_as_float(__builtin_amdgcn_update_dpp(0, __float_as_int(x), CTRL, 0xf, 0xf, true));
}
__device__ __forceinline__ float rowsum16(float x) {
  x += dppf<0xB1>(x);
  x += dppf<0x4E>(x);
  x += dppf<0x124>(x);
  x += dppf<0x128>(x);
  return x;
}
__device__ __forceinline__ float rowmax16(float x) {
  x = fmaxf(x, dppf<0xB1>(x));
  x = fmaxf(x, dppf<0x4E>(x));
  x = fmaxf(x, dppf<0x124>(x));
  x = fmaxf(x, dppf<0x128>(x));
  return x;
}
__device__ __forceinline__ float wavesum(float x) {
#pragma unroll
  for (int o = 32; o > 0; o >>= 1) x += __shfl_xor(x, o);
  return x;
}
__device__ __forceinline__ float wavemax(float x) {
#pragma unroll
  for (int o = 32; o > 0; o >>= 1) x = fmaxf(x, __shfl_xor(x, o));
  return x;
}
__device__ __forceinline__ int bidx_of(int row) { return row < NP ? (row >> 12) : (4 + row - NP); }

#define XB_TMO      128
#define XB_XCNT(j)  (256  + 64 * (j))
#define XB_XSUB(j)  (1280 + 64 * (j))
#define XB_XGEN(j)  (2304 + 64 * (j))
#define XB_TOP      3328
#define XB_TOPGEN   3392
#define XCD_BAR_WORDS 3456
#define XB_SPIN_CAP (1u << 22)
#define LAS __attribute__((address_space(3)))
__device__ __forceinline__ unsigned xb_ld(unsigned* p) { return __hip_atomic_load(p, __ATOMIC_RELAXED, __HIP_MEMORY_SCOPE_AGENT); }
__device__ __forceinline__ unsigned xb_add(unsigned* p, unsigned v) { return __hip_atomic_fetch_add(p, v, __ATOMIC_RELAXED, __HIP_MEMORY_SCOPE_AGENT); }
__device__ __forceinline__ unsigned xb_xcc_id() { return (unsigned)__builtin_amdgcn_s_getreg((3 << 11) | 20) & 0xFu; }
#define XB_SPIN(cond, bar) do { unsigned _sp = 0; while (cond) { __builtin_amdgcn_s_sleep(1); \
    if ((++_sp & 255u) == 0u) { if (xb_ld(&(bar)[XB_TMO])) break; if (_sp > XB_SPIN_CAP) { atomicAdd(&(bar)[XB_TMO], 1u); break; } } } } while (0)
struct XcdBarrier {
  unsigned* bar;
  unsigned x;
  volatile LAS unsigned* st;
};
__device__ __forceinline__ XcdBarrier xcd_barrier_post(unsigned* bar, volatile LAS unsigned* st) {
  XcdBarrier b;
  b.bar = bar;
  b.x = xb_xcc_id();
  b.st = st;
  if (threadIdx.x == 0) (void)xb_add(&bar[XB_XCNT(b.x)], 1u);
  return b;
}
__device__ __forceinline__ void xcd_barrier_complete(unsigned* bar, unsigned x, unsigned& nloc, unsigned& nx) {
  const unsigned G = gridDim.x * gridDim.y * gridDim.z;
  unsigned sum, cnt, mine, sp = 0u;
  for (;;) {
    sum = 0u; cnt = 0u; mine = 0u;
#pragma unroll
    for (unsigned j = 0; j < 16; ++j) {
      const unsigned c = xb_ld(&bar[XB_XCNT(j)]);
      sum += c;
      cnt += (c > 0u) ? 1u : 0u;
      mine = (j == x) ? c : mine;
    }
    if (sum == G) break;
    __builtin_amdgcn_s_sleep(1);
    if ((++sp & 255u) == 0u) {
      if (xb_ld(&bar[XB_TMO])) break;
      if (sp > XB_SPIN_CAP) { atomicAdd(&bar[XB_TMO], 1u); break; }
    }
  }
  nloc = mine > 0u ? mine : 1u;
  nx = cnt > 0u ? cnt : 1u;
}
__device__ __forceinline__ void xcd_barrier(const XcdBarrier& b) {
  asm volatile("s_waitcnt vmcnt(0)" ::: "memory");
  __syncthreads();
  if (threadIdx.x == 0) {
    unsigned* bar = b.bar;
    __builtin_amdgcn_s_waitcnt(0);
    unsigned nloc = b.st[0], nx = b.st[1];
    if (nloc == 0u) { xcd_barrier_complete(bar, b.x, nloc, nx); b.st[0] = nloc; b.st[1] = nx; }
    const unsigned old = xb_add(&bar[XB_XSUB(b.x)], 1u);
    const unsigned gen = old / nloc;
    if (old + 1u == (gen + 1u) * nloc) {
      __builtin_amdgcn_fence(__ATOMIC_RELEASE, "agent");
      asm volatile("s_waitcnt vmcnt(0)" ::: "memory");
      const unsigned og = xb_add(&bar[XB_TOP], 1u);
      const unsigned tg = og / nx;
      if (og + 1u == (tg + 1u) * nx) xb_add(&bar[XB_TOPGEN], 1u);
      else XB_SPIN(xb_ld(&bar[XB_TOPGEN]) == tg, bar);
      __builtin_amdgcn_fence(__ATOMIC_ACQUIRE, "agent");
      xb_add(&bar[XB_XGEN(b.x)], 1u);
      asm volatile("s_waitcnt vmcnt(0)" ::: "memory");
    } else {
      XB_SPIN(xb_ld(&bar[XB_XGEN(b.x)]) == gen, bar);
      __builtin_amdgcn_fence(__ATOMIC_ACQUIRE, "agent");
      asm volatile("s_waitcnt vmcnt(0)" ::: "memory");
    }
  }
  __syncthreads();
}

#define BAR_SYNC() do { asm volatile("s_waitcnt lgkmcnt(0)" ::: "memory"); __builtin_amdgcn_s_barrier(); asm volatile("" ::: "memory"); } while (0)

__device__ __forceinline__ unsigned mix2(unsigned h, unsigned p, float m0, float m1) {
  float h0 = bflo(h), h1 = bfhi(h), p0 = bflo(p), p1 = bfhi(p);
  return pack2(h0 + (p0 - h0) * m0, h1 + (p1 - h1) * m1);
}

template <bool MIX, class Epi>
__device__ __forceinline__ void gemm_tile(const u16* __restrict__ A, int lda, const float* __restrict__ mixv,
                                          const u16* __restrict__ Bt, int ldb, int N, int K, int m0, int n0, char* lds, Epi&& epi) {
  const int tid = threadIdx.x, lane = tid & 63, w = tid >> 6;
  const int nk = K >> 6;
  if (w >= 4) {
    const int pt = tid - 256, kc = pt & 7, pr = pt >> 3;
    const u16* Ab = A + (size_t)m0 * lda + (size_t)pr * lda + kc * 8;
    int poff[8];
#pragma unroll
    for (int i = 0; i < 8; ++i) {
      poff[i] = 0;
      if (MIX) {
        const int row = m0 + pr + 32 * i;
        const int prow = row < NP ? ((row & 4095) ? row - 1 : MPAD) : (row < MROWS ? row + 128 : MPAD);
        poff[i] = prow * LDH + kc * 8;
      }
    }
    bool bv[4];
    const u16* bp[4];
#pragma unroll
    for (int j = 0; j < 4; ++j) {
      const int n = n0 + pr + 32 * j;
      bv[j] = n < N;
      bp[j] = Bt + (size_t)(bv[j] ? n : 0) * ldb + kc * 8;
    }
    struct RSet {
      uint4 ra[8], rp[8], rb[4];
      float4 mx0, mx1;
    };
    RSet SA, SB;
    auto gload = [&](RSet& S, int kt) {
      const int ko = kt * 64;
#pragma unroll
      for (int i = 0; i < 8; ++i) {
        S.ra[i] = *(const uint4*)(Ab + (size_t)(32 * i) * lda + ko);
        if (MIX) S.rp[i] = *(const uint4*)(A + poff[i] + ko);
      }
      if (MIX) {
        S.mx0 = *(const float4*)(mixv + ko + kc * 8);
        S.mx1 = *(const float4*)(mixv + ko + kc * 8 + 4);
      }
#pragma unroll
      for (int j = 0; j < 4; ++j) {
        uint4 z = {0u, 0u, 0u, 0u};
        if (bv[j]) z = *(const uint4*)(bp[j] + ko);
        S.rb[j] = z;
      }
    };
    auto lstore = [&](RSet& S, int s) {
      char* base = lds + s * LDS_STAGE + pr * LDS_ROW + kc * 16;
#pragma unroll
      for (int i = 0; i < 8; ++i) {
        uint4 v = S.ra[i];
        if (MIX) {
          v.x = mix2(S.ra[i].x, S.rp[i].x, S.mx0.x, S.mx0.y);
          v.y = mix2(S.ra[i].y, S.rp[i].y, S.mx0.z, S.mx0.w);
          v.z = mix2(S.ra[i].z, S.rp[i].z, S.mx1.x, S.mx1.y);
          v.w = mix2(S.ra[i].w, S.rp[i].w, S.mx1.z, S.mx1.w);
        }
        *(uint4*)(base + (32 * i) * LDS_ROW) = v;
      }
#pragma unroll
      for (int j = 0; j < 4; ++j) *(uint4*)(base + LDS_A_BYTES + (32 * j) * LDS_ROW) = S.rb[j];
    };
    if constexpr (!MIX) {
      gload(SB, 0);
      if (nk > 1) gload(SA, 1);
      lstore(SB, 0);
      if (nk > 2) gload(SB, 2);
      BAR_SYNC();
#pragma unroll 1
      for (int kt = 0; kt < nk; kt += 2) {
        if (kt + 1 < nk) {
          lstore(SA, 1);
          if (kt + 3 < nk) gload(SA, kt + 3);
        }
        BAR_SYNC();
        if (kt + 1 < nk) {
          if (kt + 2 < nk) {
            lstore(SB, 0);
            if (kt + 4 < nk) gload(SB, kt + 4);
          }
          BAR_SYNC();
        }
      }
    } else {
      gload(SA, 0);
      lstore(SA, 0);
      if (nk > 1) gload(SA, 1);
      BAR_SYNC();
#pragma unroll 1
      for (int kt = 0; kt < nk; ++kt) {
        if (kt + 1 < nk) {
          lstore(SA, (kt + 1) & 1);
          if (kt + 2 < nk) gload(SA, kt + 2);
        }
        BAR_SYNC();
      }
    }
  } else {
    const int wm = w >> 1, wn = w & 1, lr = lane & 15, lg = lane >> 4;
    f32x4 acc[8][4];
#pragma unroll
    for (int i = 0; i < 8; ++i)
#pragma unroll
      for (int j = 0; j < 4; ++j) acc[i][j] = f32x4{0.f, 0.f, 0.f, 0.f};
    BAR_SYNC();
#pragma unroll 1
    for (int kt = 0; kt < nk; ++kt) {
      const char* sa = lds + (kt & 1) * LDS_STAGE + (wm * 128 + lr) * LDS_ROW + lg * 16;
      const char* sb = lds + (kt & 1) * LDS_STAGE + LDS_A_BYTES + (wn * 64 + lr) * LDS_ROW + lg * 16;
      bf16x8 bq[2][4], aq[3];
#pragma unroll
      for (int ni = 0; ni < 4; ++ni) bq[0][ni] = *(const bf16x8*)(sb + ni * 16 * LDS_ROW);
      aq[0] = *(const bf16x8*)(sa);
      aq[1] = *(const bf16x8*)(sa + 16 * LDS_ROW);
#pragma unroll
      for (int ni = 0; ni < 4; ++ni) bq[1][ni] = *(const bf16x8*)(sb + ni * 16 * LDS_ROW + 64);
#pragma unroll
      for (int st = 0; st < 16; ++st) {
        if (st + 2 < 16) aq[(st + 2) % 3] = *(const bf16x8*)(sa + ((st + 2) & 7) * 16 * LDS_ROW + ((st + 2) >> 3) * 64);
#pragma unroll
        for (int ni = 0; ni < 4; ++ni)
          acc[st & 7][ni] = __builtin_amdgcn_mfma_f32_16x16x32_bf16(bq[st >> 3][ni], aq[st % 3], acc[st & 7][ni], 0, 0, 0);
        __builtin_amdgcn_sched_barrier(0);
      }
      BAR_SYNC();
    }
    epi(acc, wm, wn, lr, lg);
  }
}

#define EPI_FOREACH(acc, ...)                                    \
  _Pragma("unroll") for (int mi = 0; mi < 8; ++mi) {             \
    const int row = m0 + wm * 128 + mi * 16 + lr;                \
    _Pragma("unroll") for (int ni = 0; ni < 4; ++ni) {           \
      const int col0 = n0 + wn * 64 + ni * 16 + lg * 4;          \
      const f32x4 v = acc[mi][ni];                               \
      __VA_ARGS__                                                \
    }                                                            \
    __builtin_amdgcn_sched_barrier(0);                           \
  }
#define EPI_ARGS f32x4(&acc)[8][4], int wm, int wn, int lr, int lg

__device__ __forceinline__ void conv_job(const float* __restrict__ src, u16* __restrict__ dst, int K, int N, int ldk, float* tl, int rot) {
  const int tid = threadIdx.x;
  const int tn = N >> 6, nt = (K >> 6) * tn;
  const int G = gridDim.x;
  int start = ((int)blockIdx.x + G - (rot % G)) % G;
  for (int t = start; t < nt; t += G) {
    const int k0 = (t / tn) << 6, n0 = (t % tn) << 6;
#pragma unroll
    for (int i = 0; i < 8; ++i) {
      int e = tid + 512 * i;
      tl[(e >> 6) * 65 + (e & 63)] = src[(size_t)(k0 + (e >> 6)) * N + n0 + (e & 63)];
    }
    __syncthreads();
    const int n = tid >> 3, kc = tid & 7;
    float f[8];
#pragma unroll
    for (int j = 0; j < 8; ++j) f[j] = tl[(kc * 8 + j) * 65 + n];
    uint4 v;
    v.x = pack2(f[0], f[1]);
    v.y = pack2(f[2], f[3]);
    v.z = pack2(f[4], f[5]);
    v.w = pack2(f[6], f[7]);
    *(uint4*)(dst + (size_t)(n0 + n) * ldk + k0 + kc * 8) = v;
    __syncthreads();
  }
}

__device__ __forceinline__ void phase0(const Params& p, char* lds) {
  float* tl = (float*)lds;
  u16* wt = (u16*)(p.ws + WS_WT);
  u16* adawt = (u16*)(p.ws + S_ADAWT);
  int rot = 0;
#define CJ(SRC, DST, K, N)            \
  conv_job(SRC, DST, K, N, ((K) == 1024 ? LDH : (K) == 4096 ? LDU : (K)), tl, rot);  \
  rot += ((K) >> 6) * ((N) >> 6);
  CJ(p.ada_w, adawt, 1024, 6144)
  CJ(p.ada_w + (size_t)1024 * 6144, adawt + (size_t)6144 * LDH, 1024, 6144)
  CJ(p.rw_wr, wt + WT_WR, 1024, 1024)
  CJ(p.rw_wk, wt + WT_WK, 1024, 1024)
  CJ(p.rw_wv, wt + WT_WV, 1024, 1024)
  CJ(p.rw_wo, wt + WT_WO, 1024, 1024)
  CJ(p.rw_w1, wt + WT_W1, 1024, 64)
  CJ(p.rw_a1, wt + WT_A1, 1024, 64)
  CJ(p.rw_g1, wt + WT_G1, 1024, 128)
  CJ(p.rw_w2, wt + WT_W2, 64, 1024)
  CJ(p.rw_a2, wt + WT_A2, 64, 1024)
  CJ(p.rw_g2, wt + WT_G2, 128, 1024)
  CJ(p.mlp_up, wt + WT_UP0, 1024, 4096)
  CJ(p.mlp_down, wt + WT_DN0, 4096, 1024)
  CJ(p.at_wqkv, wt + WT_QKV, 1024, 1536)
  CJ(p.at_wo, wt + WT_WO1, 1024, 1024)
  CJ(p.mlp_up + (size_t)4 * MEG, wt + WT_UP1, 1024, 4096)
  CJ(p.mlp_down + (size_t)4 * MEG, wt + WT_DN1, 4096, 1024)
#undef CJ
  const int gtid = blockIdx.x * NTHR + threadIdx.x, gsz = gridDim.x * NTHR;
  u16* siluc = (u16*)(p.ws + S_SILUC);
  for (int i = gtid; i < 256 * 1024; i += gsz) {
    int row = i >> 10, col = i & 1023;
    float c = 0.f;
    if (row < 4) c = p.c_prompt[row * 1024 + col];
    else if (row < 132) c = p.c_sample[(row - 4) * 1024 + col];
    siluc[i] = f2bf(c * sigmoidf_(c));
  }
  u16* hs = (u16*)(p.ws + WS_HS);
  for (int i = gtid; i < 128 * 1024; i += gsz) hs[(size_t)(i >> 10) * LDH + (i & 1023)] = f2bf(p.state_shift[i]);
  u16* zr = (u16*)(p.ws + WS_ZR);
  for (int i = gtid; i < LDH; i += gsz) zr[i] = 0;
  float2* tab = (float2*)(p.ws + WS_TAB);
  for (int i = gtid; i < 4097 * 8; i += gsz) {
    int pi = i >> 3, f = i & 7;
    float pos = pi < 4096 ? (float)pi : 8192.f;
    float inv = f == 0 ? 1.0f : f == 1 ? 0.1939227432012558f : f == 2 ? 0.03760603070259094f : f == 3 ? 0.007292664609849453f
              : f == 4 ? 0.0014142135623842478f : f == 5 ? 0.00027424818836152554f : f == 6 ? 5.318296098266728e-05f
              : 1.0313386155758053e-05f;
    float ang = pos * inv;
    double t = (double)ang * 0.15915494309189535;
    t -= rint(t);
    float fr = (float)t;
    tab[i] = make_float2(__builtin_amdgcn_cosf(fr), __builtin_amdgcn_sinf(fr));
  }
}

__device__ __forceinline__ void phase_ada(const Params& p, char* lds) {
  const u16* siluc = (const u16*)(p.ws + S_SILUC);
  const u16* adawt = (const u16*)(p.ws + S_ADAWT);
  float* mod = (float*)(p.ws + WS_MOD);
  for (int t = blockIdx.x; t < 96; t += gridDim.x) {
    const int layer = t / 48, nt = t % 48;
    const int m0 = 0, n0 = nt * 128;
    const float* bias = p.ada_b + layer * 6144;
    float* mo = mod + (size_t)layer * 132 * 6144;
    gemm_tile<false>(siluc, 1024, nullptr, adawt + (size_t)layer * 6144 * LDH, LDH, 6144, 1024, m0, n0, lds, [&](EPI_ARGS) {
      EPI_FOREACH(acc, if (row < 132) {
        const float4 b4 = *(const float4*)(bias + col0);
        *(float4*)(mo + (size_t)row * 6144 + col0) = make_float4(v[0] + b4.x, v[1] + b4.y, v[2] + b4.z, v[3] + b4.w);
      })
    });
  }
}

__device__ __forceinline__ void phase_norm(const Params& p, int layer, int which, bool from_input, bool shift_out) {
  const int lane = threadIdx.x & 63, w = threadIdx.x >> 6;
  const float* mod = (const float*)(p.ws + WS_MOD);
  u16* H = (u16*)(p.ws + WS_H);
  const float* g = (which ? p.norm2_g : p.norm1_g) + layer * 1024;
  const int nw = gridDim.x * 8;
  for (int row = blockIdx.x * 8 + w; row < MROWS; row += nw) {
    const float* xr = from_input ? (row < NP ? p.x_prompt + (size_t)row * 1024 : p.x_sample + (size_t)(row - NP) * 1024)
                                 : p.out + (size_t)row * 1024;
    float4 x[4];
    float ss = 0.f;
#pragma unroll
    for (int i = 0; i < 4; ++i) {
      x[i] = *(const float4*)(xr + lane * 4 + 256 * i);
      ss += x[i].x * x[i].x + x[i].y * x[i].y + x[i].z * x[i].z + x[i].w * x[i].w;
    }
    ss = wavesum(ss);
    const float rs = rsqrtf(ss * (1.f / 1024.f) + 1e-6f);
    const int bi = bidx_of(row);
    const float* mb = mod + ((size_t)layer * 132 + bi) * 6144;
    const float* sh = mb + (which ? 3 : 0) * 1024;
    const float* sc = mb + (which ? 4 : 1) * 1024;
    const bool so = shift_out && (row >= NP || (row & 4095) == 4095);
    float* sop = row >= NP ? p.out + O_SHS + (size_t)(row - NP) * 1024 : p.out + O_SHP + (size_t)(row >> 12) * 1024;
#pragma unroll
    for (int i = 0; i < 4; ++i) {
      const int c = lane * 4 + 256 * i;
      float4 gg = *(const float4*)(g + c), s4 = *(const float4*)(sh + c), c4 = *(const float4*)(sc + c);
      float4 h;
      h.x = x[i].x * rs * gg.x * (1.f + c4.x) + s4.x;
      h.y = x[i].y * rs * gg.y * (1.f + c4.y) + s4.y;
      h.z = x[i].z * rs * gg.z * (1.f + c4.z) + s4.z;
      h.w = x[i].w * rs * gg.w * (1.f + c4.w) + s4.w;
      uint2 pk;
      pk.x = pack2(h.x, h.y);
      pk.y = pack2(h.z, h.w);
      *(uint2*)(H + (size_t)row * LDH + c) = pk;
      if (so) *(float4*)(sop + c) = h;
      if (from_input && row >= NP) *(float4*)(p.out + (size_t)row * 1024 + c) = x[i];
    }
  }
}

__device__ __forceinline__ void phase_final(const Params& p) {
  const int lane = threadIdx.x & 63, w = threadIdx.x >> 6;
  const int nw = gridDim.x * 8;
  for (int row = blockIdx.x * 8 + w; row < MROWS; row += nw) {
    float* xr = p.out + (size_t)row * 1024;
    float4 x[4];
    float ss = 0.f;
#pragma unroll
    for (int i = 0; i < 4; ++i) {
      x[i] = *(const float4*)(xr + lane * 4 + 256 * i);
      ss += x[i].x * x[i].x + x[i].y * x[i].y + x[i].z * x[i].z + x[i].w * x[i].w;
    }
    ss = wavesum(ss);
    const float rs = rsqrtf(ss * (1.f / 1024.f) + 1e-6f);
#pragma unroll
    for (int i = 0; i < 4; ++i) {
      const int c = lane * 4 + 256 * i;
      float4 gg = *(const float4*)(p.final_g + c);
      float4 h;
      h.x = x[i].x * rs * gg.x;
      h.y = x[i].y * rs * gg.y;
      h.z = x[i].z * rs * gg.z;
      h.w = x[i].w * rs * gg.w;
      *(float4*)(xr + c) = h;
    }
  }
}

__device__ __forceinline__ void phase_rwkv_proj(const Params& p, char* lds) {
  const u16* H = (const u16*)(p.ws + WS_H);
  const u16* wt = (const u16*)(p.ws + WS_WT);
  u16* R = (u16*)(p.ws + S_R);
  u16* Kk = (u16*)(p.ws + S_K);
  u16* V = (u16*)(p.ws + S_V);
  u16* WH = (u16*)(p.ws + S_WH);
  u16* AH = (u16*)(p.ws + S_AH);
  u16* GH = (u16*)(p.ws + S_GH);
  for (int t = blockIdx.x; t < 65 * 27; t += gridDim.x) {
    const int mt = t / 27, j = t % 27;
    const int m0 = mt * 256;
    int kind, n0, N, mixi;
    const u16* Bt;
    if (j < 8) { kind = 0; n0 = j * 128; N = 1024; mixi = 0; Bt = wt + WT_WR; }
    else if (j < 16) { kind = 1; n0 = (j - 8) * 128; N = 1024; mixi = 2; Bt = wt + WT_WK; }
    else if (j < 24) { kind = 2; n0 = (j - 16) * 128; N = 1024; mixi = 3; Bt = wt + WT_WV; }
    else if (j == 24) { kind = 3; n0 = 0; N = 64; mixi = 1; Bt = wt + WT_W1; }
    else if (j == 25) { kind = 4; n0 = 0; N = 64; mixi = 4; Bt = wt + WT_A1; }
    else { kind = 5; n0 = 0; N = 128; mixi = 5; Bt = wt + WT_G1; }
    gemm_tile<true>(H, LDH, p.rw_mix + mixi * 1024, Bt, LDH, N, 1024, m0, n0, lds, [&](EPI_ARGS) {
      u16* dst = kind == 0 ? R : kind == 1 ? Kk : kind == 2 ? V : kind == 3 ? WH : kind == 4 ? AH : GH;
      const int ld = kind < 3 ? 1024 : (kind == 5 ? 128 : 64);
      EPI_FOREACH(acc, if (row < MROWS && col0 < ld) {
        f32x4 o = v;
        if (kind == 3) {
          _Pragma("unroll") for (int q = 0; q < 4; ++q) o[q] = 1.f - 2.f / (__expf(2.f * v[q]) + 1.f);
        } else if (kind == 5) {
          _Pragma("unroll") for (int q = 0; q < 4; ++q) o[q] = sigmoidf_(v[q]);
        }
        *(uint2*)(dst + (size_t)row * ld + col0) = pack4(o);
      })
    });
  }
}

__device__ __forceinline__ void phase_rwkv_lora2(const Params& p, char* lds) {
  const u16* wt = (const u16*)(p.ws + WS_WT);
  const u16* WH = (const u16*)(p.ws + S_WH);
  const u16* AH = (const u16*)(p.ws + S_AH);
  u16* EW = (u16*)(p.ws + S_EW);
  u16* Aa = (u16*)(p.ws + S_A);
  for (int t = blockIdx.x; t < 65 * 16; t += gridDim.x) {
    const int mt = t >> 4, j = t & 15;
    const int m0 = mt * 256, n0 = (j & 7) * 128;
    const bool isw = j < 8;
    gemm_tile<false>(isw ? WH : AH, 64, nullptr, wt + (isw ? WT_W2 : WT_A2), 64, 1024, 64, m0, n0, lds, [&](EPI_ARGS) {
      const float* b0 = isw ? p.rw_w0 : p.rw_a0;
      EPI_FOREACH(acc, if (row < MROWS) {
        const float4 b4 = *(const float4*)(b0 + col0);
        const float s0 = sigmoidf_(v[0] + b4.x), s1 = sigmoidf_(v[1] + b4.y), s2 = sigmoidf_(v[2] + b4.z), s3 = sigmoidf_(v[3] + b4.w);
        if (isw) {
          const float c = 0.6065306597126334f;
          uint2 o;
          o.x = (unsigned)f2h(c * s0) | ((unsigned)f2h(c * s1) << 16);
          o.y = (unsigned)f2h(c * s2) | ((unsigned)f2h(c * s3) << 16);
          *(uint2*)(EW + (size_t)row * 1024 + col0) = o;
        } else {
          uint2 o;
          o.x = pack2(s0, s1);
          o.y = pack2(s2, s3);
          *(uint2*)(Aa + (size_t)row * 1024 + col0) = o;
        }
      })
    });
  }
}

constexpr int RING_TS = 344;
constexpr int RING_BUF = 16 * RING_TS;

__device__ __forceinline__ void phase_scan(const Params& p, char* lds) {
  const int tid = threadIdx.x, lane = tid & 63, w = tid >> 6;
  const u16* R = (const u16*)(p.ws + S_R);
  const u16* Kk = (const u16*)(p.ws + S_K);
  const u16* V = (const u16*)(p.ws + S_V);
  const u16* EW = (const u16*)(p.ws + S_EW);
  const u16* Aa = (const u16*)(p.ws + S_A);
  u16* Y = (u16*)(p.ws + WS_H);
  float* RK = (float*)(p.ws + WS_RK);
  float* ring = (float*)lds;
  float* ybuf = (float*)(lds + 2 * RING_BUF * 4);
  for (int item = blockIdx.x; item < 256; item += gridDim.x) {
    const int chain = item >> 2, qr = item & 3, b = chain >> 4, h = chain & 15;
    const size_t rowbase = (size_t)b * 4096;
    __syncthreads();
    if (tid >= 256) {
      const int pt = tid - 256, tok = pt >> 4, cq = pt & 15;
      const int ch = h * 64 + cq * 4;
      const float4 kk4 = *(const float4*)(p.rw_kk + ch), ka4 = *(const float4*)(p.rw_ka + ch), rk4 = *(const float4*)(p.rw_rk + ch);
      struct PS {
        uint2 rr, rk_, rv, ra_, re;
      };
      PS S0, S1;
      auto pload = [&](PS& S, int c) {
        const size_t off = (rowbase + (size_t)c * 16 + tok) * 1024 + ch;
        S.rr = *(const uint2*)(R + off);
        S.rk_ = *(const uint2*)(Kk + off);
        S.rv = *(const uint2*)(V + off);
        S.ra_ = *(const uint2*)(Aa + off);
        S.re = *(const uint2*)(EW + off);
      };
      auto pproc = [&](PS& S, int c) {
        const uint2 rr = S.rr, rk_ = S.rk_, rv = S.rv, ra_ = S.ra_, re = S.re;
        float rf[4] = {bflo(rr.x), bfhi(rr.x), bflo(rr.y), bfhi(rr.y)};
        float kf[4] = {bflo(rk_.x), bfhi(rk_.x), bflo(rk_.y), bfhi(rk_.y)};
        float vf[4] = {bflo(rv.x), bfhi(rv.x), bflo(rv.y), bfhi(rv.y)};
        float af[4] = {bflo(ra_.x), bfhi(ra_.x), bflo(ra_.y), bfhi(ra_.y)};
        float ef[4] = {h2f((u16)(re.x & 0xffff)), h2f((u16)(re.x >> 16)), h2f((u16)(re.y & 0xffff)), h2f((u16)(re.y >> 16))};
        const float kkw[4] = {kk4.x, kk4.y, kk4.z, kk4.w}, kaw[4] = {ka4.x, ka4.y, ka4.z, ka4.w}, rkw[4] = {rk4.x, rk4.y, rk4.z, rk4.w};
        float kkr[4], kp[4], ss = 0.f, rks = 0.f;
#pragma unroll
        for (int j = 0; j < 4; ++j) {
          kkr[j] = kf[j] * kkw[j];
          ss += kkr[j] * kkr[j];
          kp[j] = kf[j] * (1.f + (af[j] - 1.f) * kaw[j]);
          rks += rf[j] * kp[j] * rkw[j];
        }
        ss = rowsum16(ss);
        rks = rowsum16(rks);
        const float inv = 1.f / fmaxf(sqrtf(ss), 1e-12f);
        float* slot = ring + (c & 1) * RING_BUF + tok * RING_TS;
        float am[4], dc[4], bm[4], wr[4], br = 0.f, kr = 0.f;
#pragma unroll
        for (int j = 0; j < 4; ++j) {
          am[j] = -kkr[j] * inv;
          dc[j] = __expf(-ef[j]);
          bm[j] = kkr[j] * inv * af[j];
          wr[j] = dc[j] * rf[j];
          br += bm[j] * rf[j];
          kr += kp[j] * rf[j];
        }
        br = rowsum16(br);
        kr = rowsum16(kr);
        *(float4*)(slot + cq * 4) = make_float4(am[0], am[1], am[2], am[3]);
        *(float4*)(slot + 64 + cq * 4) = make_float4(dc[0], dc[1], dc[2], dc[3]);
        *(float4*)(slot + 128 + cq * 4) = make_float4(bm[0], bm[1], bm[2], bm[3]);
        *(float4*)(slot + 192 + cq * 4) = make_float4(kp[0], kp[1], kp[2], kp[3]);
        *(float4*)(slot + 256 + cq * 4) = make_float4(wr[0], wr[1], wr[2], wr[3]);
        if (cq == 0) *(float2*)(slot + 336) = make_float2(br, kr);
        if ((cq >> 2) == qr) *(float4*)(slot + 320 + (cq & 3) * 4) = make_float4(vf[0], vf[1], vf[2], vf[3]);
        if (cq == 0 && qr == 0) RK[(rowbase + (size_t)c * 16 + tok) * 16 + h] = rks;
      };
      pload(S0, 0);
      pproc(S0, 0);
      pload(S1, 1);
      pload(S0, 2);
      BAR_SYNC();
#pragma unroll 1
      for (int c = 0; c < 256; c += 2) {
        pproc(S1, c + 1);
        if (c + 3 < 256) pload(S1, c + 3);
        BAR_SYNC();
        if (c + 2 < 256) pproc(S0, c + 2);
        if (c + 4 < 256) pload(S0, c + 4);
        BAR_SYNC();
      }
    } else {
      const int rl = tid >> 4, cgp = tid & 15;
      float s0 = 0.f, s1 = 0.f, s2 = 0.f, s3 = 0.f;
      BAR_SYNC();
      for (int c = 0; c < 256; ++c) {
        if (c > 0) {
          const float yv = ybuf[((c - 1) & 1) * 256 + tid];
          Y[(rowbase + (size_t)(c - 1) * 16 + rl) * LDH + h * 64 + qr * 16 + cgp] = f2bf(yv);
        }
        const float* bufp = ring + (c & 1) * RING_BUF;
        float* yb = ybuf + (c & 1) * 256;
        struct SV {
          float4 a, w, b, k, wr;
          float v;
          float2 bk;
        };
        auto ldstep = [&](const float* slot) {
          SV r;
          r.a = *(const float4*)(slot + cgp * 4);
          r.w = *(const float4*)(slot + 64 + cgp * 4);
          r.b = *(const float4*)(slot + 128 + cgp * 4);
          r.k = *(const float4*)(slot + 192 + cgp * 4);
          r.wr = *(const float4*)(slot + 256 + cgp * 4);
          r.v = slot[320 + rl];
          r.bk = *(const float2*)(slot + 336);
          return r;
        };
        SV cur = ldstep(bufp);
#pragma unroll
        for (int tk = 0; tk < 16; ++tk) {
          SV nxt = cur;
          if (tk + 1 < 16) nxt = ldstep(bufp + (tk + 1) * RING_TS);
          float sa = s0 * cur.a.x + s1 * cur.a.y + s2 * cur.a.z + s3 * cur.a.w;
          float yw = s0 * cur.wr.x + s1 * cur.wr.y + s2 * cur.wr.z + s3 * cur.wr.w;
          const float t0 = s0 * cur.w.x + cur.v * cur.k.x;
          const float t1 = s1 * cur.w.y + cur.v * cur.k.y;
          const float t2 = s2 * cur.w.z + cur.v * cur.k.z;
          const float t3 = s3 * cur.w.w + cur.v * cur.k.w;
          sa = rowsum16(sa);
          yw = rowsum16(yw);
          s0 = t0 + sa * cur.b.x;
          s1 = t1 + sa * cur.b.y;
          s2 = t2 + sa * cur.b.z;
          s3 = t3 + sa * cur.b.w;
          const float y = yw + sa * cur.bk.x + cur.v * cur.bk.y;
          if (cgp == 0) yb[tk * 16 + rl] = y;
          cur = nxt;
        }
        BAR_SYNC();
      }
      {
        const float yv = ybuf[(255 & 1) * 256 + tid];
        Y[(rowbase + (size_t)255 * 16 + rl) * LDH + h * 64 + qr * 16 + cgp] = f2bf(yv);
      }
      float* wo = p.out + O_WKVP + (((size_t)(b * 16 + h) * 64) + qr * 16 + rl) * 64 + cgp * 4;
      *(float4*)wo = make_float4(s0, s1, s2, s3);
    }
  }
  float* sl = (float*)lds;
  for (int chain = blockIdx.x; chain < 2048; chain += gridDim.x) {
    const int b = chain >> 4, h = chain & 15;
    const size_t row = (size_t)NP + b;
    __syncthreads();
    if (w == 0) {
      const int ch = h * 64 + lane;
      const size_t off = row * 1024 + ch;
      const float rf = bf2f(R[off]), kf = bf2f(Kk[off]), vf = bf2f(V[off]), af = bf2f(Aa[off]), ef = h2f(EW[off]);
      const float kkr = kf * p.rw_kk[ch];
      const float ss = wavesum(kkr * kkr);
      const float inv = 1.f / fmaxf(sqrtf(ss), 1e-12f);
      const float kp = kf * (1.f + (af - 1.f) * p.rw_ka[ch]);
      const float rks = wavesum(rf * kp * p.rw_rk[ch]);
      sl[lane] = -kkr * inv;
      sl[64 + lane] = __expf(-ef);
      sl[128 + lane] = kkr * inv * af;
      sl[192 + lane] = kp;
      sl[256 + lane] = rf;
      sl[320 + lane] = vf;
      if (lane == 0) RK[row * 16 + h] = rks;
    }
    __syncthreads();
    const int i = tid >> 3, c8 = tid & 7;
    const float* sp = p.state_wkv + (((size_t)(b * 16 + h) * 64) + i) * 64 + c8 * 8;
    float4 sA = *(const float4*)sp, sB = *(const float4*)(sp + 4);
    float s[8] = {sA.x, sA.y, sA.z, sA.w, sB.x, sB.y, sB.z, sB.w};
    float sa = 0.f;
#pragma unroll
    for (int j = 0; j < 8; ++j) sa += s[j] * sl[c8 * 8 + j];
    sa += __shfl_xor(sa, 1);
    sa += __shfl_xor(sa, 2);
    sa += __shfl_xor(sa, 4);
    const float vv = sl[320 + i];
    float y = 0.f;
#pragma unroll
    for (int j = 0; j < 8; ++j) {
      const int cj = c8 * 8 + j;
      s[j] = s[j] * sl[64 + cj] + sa * sl[128 + cj] + vv * sl[192 + cj];
      y += s[j] * sl[256 + cj];
    }
    y += __shfl_xor(y, 1);
    y += __shfl_xor(y, 2);
    y += __shfl_xor(y, 4);
    float* wo = p.out + O_WKVS + (((size_t)(b * 16 + h) * 64) + i) * 64 + c8 * 8;
    *(float4*)wo = make_float4(s[0], s[1], s[2], s[3]);
    *(float4*)(wo + 4) = make_float4(s[4], s[5], s[6], s[7]);
    if (c8 == 0) Y[row * LDH + h * 64 + i] = f2bf(y);
  }
}

__device__ __forceinline__ void phase_gate(const Params& p, char* lds) {
  const u16* wt = (const u16*)(p.ws + WS_WT);
  const u16* GH = (const u16*)(p.ws + S_GH);
  const u16* V = (const u16*)(p.ws + S_V);
  const float* RK = (const float*)(p.ws + WS_RK);
  u16* Y = (u16*)(p.ws + WS_H);
  for (int t = blockIdx.x; t < 65 * 8; t += gridDim.x) {
    const int mt = t >> 3, nt = t & 7;
    const int m0 = mt * 256, n0 = nt * 128;
    gemm_tile<false>(GH, 128, nullptr, wt + WT_G2, 128, 1024, 128, m0, n0, lds, [&](EPI_ARGS) {
      const int hh = (n0 + wn * 64) >> 6;
#pragma unroll
      for (int mi = 0; mi < 8; ++mi) {
        const int row = m0 + wm * 128 + mi * 16 + lr;
        const int rowc = row < MROWS ? row : MROWS - 1;
        float yv[4][4];
        float sum = 0.f;
#pragma unroll
        for (int ni = 0; ni < 4; ++ni) {
          const uint2 yy = *(const uint2*)(Y + (size_t)rowc * LDH + hh * 64 + ni * 16 + lg * 4);
          yv[ni][0] = bflo(yy.x); yv[ni][1] = bfhi(yy.x); yv[ni][2] = bflo(yy.y); yv[ni][3] = bfhi(yy.y);
          sum += yv[ni][0] + yv[ni][1] + yv[ni][2] + yv[ni][3];
        }
        sum += __shfl_xor(sum, 16);
        sum += __shfl_xor(sum, 32);
        const float mu = sum * (1.f / 64.f);
        float vs = 0.f;
#pragma unroll
        for (int ni = 0; ni < 4; ++ni)
#pragma unroll
          for (int q = 0; q < 4; ++q) {
            const float d = yv[ni][q] - mu;
            vs += d * d;
          }
        vs += __shfl_xor(vs, 16);
        vs += __shfl_xor(vs, 32);
        const float rstd = rsqrtf(vs * (1.f / 64.f) + 64e-5f);
        const float rk = RK[(size_t)rowc * 16 + hh];
#pragma unroll
        for (int ni = 0; ni < 4; ++ni) {
          const int col0 = hh * 64 + ni * 16 + lg * 4;
          const uint2 vv = *(const uint2*)(V + (size_t)rowc * 1024 + col0);
          const float vf[4] = {bflo(vv.x), bfhi(vv.x), bflo(vv.y), bfhi(vv.y)};
          const float4 g4 = *(const float4*)(p.rw_lnx_g + col0), b4 = *(const float4*)(p.rw_lnx_b + col0);
          const float gg[4] = {g4.x, g4.y, g4.z, g4.w}, bb[4] = {b4.x, b4.y, b4.z, b4.w};
          f32x4 o;
#pragma unroll
          for (int q = 0; q < 4; ++q) o[q] = ((yv[ni][q] - mu) * rstd * gg[q] + bb[q] + rk * vf[q]) * acc[mi][ni][q];
          if (row < MROWS) *(uint2*)(Y + (size_t)row * LDH + col0) = pack4(o);
        }
        __builtin_amdgcn_sched_barrier(0);
      }
    });
  }
}

__device__ __forceinline__ void phase_oproj(const Params& p, char* lds, const u16* A, int K, const u16* Bt, int layer, int gidx, bool first) {
  const int ldab = K == 1024 ? LDH : LDU;
  const float* mod = (const float*)(p.ws + WS_MOD);
  for (int u = blockIdx.x; u < 576; u += gridDim.x) {
    const bool split = u >= 512;
    const int s = u - 512;
    const int m0 = split ? NP : (u >> 3) * 256, n0 = (split ? (s & 7) : (u & 7)) * 128;
    const int klen = split ? (K >> 3) : K, kbeg = split ? (s >> 3) * klen : 0;
    gemm_tile<false>(A + kbeg, ldab, nullptr, Bt + kbeg, ldab, 1024, klen, m0, n0, lds, [&](EPI_ARGS) {
      EPI_FOREACH(acc, if (row < MROWS) {
        const float4 gt = *(const float4*)(mod + ((size_t)layer * 132 + bidx_of(row)) * 6144 + gidx * 1024 + col0);
        float* xp = p.out + (size_t)row * 1024 + col0;
        if (split) {
          unsafeAtomicAdd(xp + 0, gt.x * v[0]);
          unsafeAtomicAdd(xp + 1, gt.y * v[1]);
          unsafeAtomicAdd(xp + 2, gt.z * v[2]);
          unsafeAtomicAdd(xp + 3, gt.w * v[3]);
        } else {
          const float* xi = first ? p.x_prompt + (size_t)row * 1024 + col0 : xp;
          const float4 xo = *(const float4*)xi;
          *(float4*)xp = make_float4(xo.x + gt.x * v[0], xo.y + gt.y * v[1], xo.z + gt.z * v[2], xo.w + gt.w * v[3]);
        }
      })
    });
  }
}

__device__ __forceinline__ void phase_up(const Params& p, char* lds, const u16* Bt) {
  const u16* H = (const u16*)(p.ws + WS_H);
  u16* UP = (u16*)(p.ws + S_UP);
  for (int t = blockIdx.x; t < 65 * 32; t += gridDim.x) {
    const int mt = t >> 5, nt = t & 31;
    const int m0 = mt * 256, n0 = nt * 128;
    gemm_tile<false>(H, LDH, nullptr, Bt, LDH, 4096, 1024, m0, n0, lds, [&](EPI_ARGS) {
      EPI_FOREACH(acc, if (row < MROWS) {
        f32x4 o;
        _Pragma("unroll") for (int q = 0; q < 4; ++q) {
          const float rl = fmaxf(v[q], 0.f);
          o[q] = rl * rl;
        }
        *(uint2*)(UP + (size_t)row * LDU + col0) = pack4(o);
      })
    });
  }
}

__device__ __forceinline__ void phase_qkv(const Params& p, char* lds) {
  const u16* H = (const u16*)(p.ws + WS_H);
  const u16* wt = (const u16*)(p.ws + WS_WT);
  const float* tab = (const float*)(p.ws + WS_TAB);
  u16* Qb = (u16*)(p.ws + S_Q);
  u16* Kb = (u16*)(p.ws + S_KB);
  u16* Vt = (u16*)(p.ws + S_VT);
  for (int t = blockIdx.x; t < 65 * 12; t += gridDim.x) {
    const int mt = t / 12, nt = t % 12;
    const int m0 = mt * 256, n0 = nt * 128;
    gemm_tile<false>(H, LDH, nullptr, wt + WT_QKV, LDH, 1536, 1024, m0, n0, lds, [&](EPI_ARGS) {
      const int hc0 = n0 + wn * 64;
#pragma unroll
      for (int mi = 0; mi < 8; ++mi) {
        const int row = m0 + wm * 128 + mi * 16 + lr;
        const bool valid = row < MROWS;
        const bool isp = row < NP;
        const int pos = row & 4095;
        const int bq = isp ? (row >> 12) : (row - NP);
        const int posidx = isp ? pos : 4096;
#pragma unroll
        for (int ni = 0; ni < 4; ++ni) {
          const int col0 = hc0 + ni * 16 + lg * 4;
          const float4 b4 = *(const float4*)(p.at_bqkv + col0);
          f32x4 v = acc[mi][ni];
          v[0] += b4.x; v[1] += b4.y; v[2] += b4.z; v[3] += b4.w;
          if (ni == 0 && hc0 < 1280) {
            const float* tp = tab + (size_t)posidx * 16 + (lg & 1) * 8;
            const float4 t0 = *(const float4*)tp, t1 = *(const float4*)(tp + 4);
            const float cs[4] = {t0.x, t0.z, t1.x, t1.z}, sn[4] = {t0.y, t0.w, t1.y, t1.w};
#pragma unroll
            for (int q = 0; q < 4; ++q) {
              const float pv = __shfl_xor(v[q], 32);
              v[q] = (lg < 2) ? (v[q] * cs[q] - pv * sn[q]) : (v[q] * cs[q] + pv * sn[q]);
            }
          }
          if (valid) {
            if (hc0 < 1024) {
              *(uint2*)(Qb + (size_t)row * 1024 + col0) = pack4(v);
            } else if (hc0 < 1280) {
              const int c2 = col0 - 1024;
              *(uint2*)(Kb + (size_t)row * 256 + c2) = pack4(v);
              if (isp) {
                if (pos >= 3968) *(float4*)(p.out + O_KP + ((size_t)(bq * 128 + pos - 3968)) * 256 + c2) = make_float4(v[0], v[1], v[2], v[3]);
              } else {
                *(float4*)(p.out + O_KS + ((size_t)(bq * 128 + 127)) * 256 + c2) = make_float4(v[0], v[1], v[2], v[3]);
              }
            } else {
              const int c3 = col0 - 1280;
              if (isp) {
                u16* vp = Vt + ((size_t)(bq * 4 + (c3 >> 6)) * 64 + (c3 & 63)) * 4096 + pos;
#pragma unroll
                for (int q = 0; q < 4; ++q) vp[(size_t)q * 4096] = f2bf(v[q]);
                if (pos >= 3968) *(float4*)(p.out + O_VP + ((size_t)(bq * 128 + pos - 3968)) * 256 + c3) = make_float4(v[0], v[1], v[2], v[3]);
              } else {
                *(float4*)(p.out + O_VS + ((size_t)(bq * 128 + 127)) * 256 + c3) = make_float4(v[0], v[1], v[2], v[3]);
              }
            }
          }
        }
        __builtin_amdgcn_sched_barrier(0);
      }
    });
  }
}

constexpr int AT_KS = 0, AT_VS = 36864, AT_PS = 36864 + 35840, AT_PW = 5376;

__device__ __forceinline__ void phase_attn(const Params& p, char* lds) {
  const int tid = threadIdx.x, lane = tid & 63, w = tid >> 6, lr = lane & 15, lg = lane >> 4;
  const u16* Qb = (const u16*)(p.ws + S_Q);
  const u16* Kb = (const u16*)(p.ws + S_KB);
  const u16* Vt = (const u16*)(p.ws + S_VT);
  u16* O = (u16*)(p.ws + S_O);
  char* Ks = lds + AT_KS;
  char* Vs = lds + AT_VS;
  char* Ps = lds + AT_PS + w * AT_PW;
  for (int u = blockIdx.x; u < 512; u += gridDim.x) {
    const int b = u >> 7, n = (u >> 2) & 31, kvh = u & 3;
    __syncthreads();
#pragma unroll
    for (int i = 0; i < 4; ++i) {
      const int c = tid + 512 * i;
      {
        const int key = c >> 3, kc = c & 7;
        const int pos = n * 128 - 128 + key;
        uint4 v = {0u, 0u, 0u, 0u};
        if (pos >= 0) v = *(const uint4*)(Kb + ((size_t)b * 4096 + pos) * 256 + kvh * 64 + kc * 8);
        *(uint4*)(Ks + key * 144 + kc * 16) = v;
      }
      {
        const int d = c >> 5, kc = c & 31;
        const int pos0 = n * 128 - 128 + kc * 8;
        uint4 v = {0u, 0u, 0u, 0u};
        if (pos0 >= 0) v = *(const uint4*)(Vt + ((size_t)(b * 4 + kvh) * 64 + d) * 4096 + pos0);
        *(uint4*)(Vs + d * 560 + kc * 16) = v;
      }
    }
    if (tid < 192) {
      const int d = tid / 3, c = tid % 3;
      *(uint4*)(Vs + d * 560 + 512 + c * 16) = uint4{0u, 0u, 0u, 0u};
    }
    {
      const int prow = lane >> 2, pc = 144 + (lane & 3) * 4;
      *(uint2*)(Ps + prow * 336 + pc * 2) = uint2{0u, 0u};
    }
    __syncthreads();
    const int g = w >> 1, hf = w & 1;
    const int qh = kvh * 4 + g;
    const float sink = p.at_sink[qh];
#pragma unroll 1
    for (int i = 0; i < 4; ++i) {
      const int q0 = hf * 64 + i * 16;
      const size_t tok = (size_t)b * 4096 + n * 128 + q0 + lr;
      const bf16x8 qf0 = *(const bf16x8*)(Qb + tok * 1024 + qh * 64 + lg * 8);
      const bf16x8 qf1 = *(const bf16x8*)(Qb + tok * 1024 + qh * 64 + 32 + lg * 8);
      f32x4 s[9];
#pragma unroll
      for (int j = 0; j < 9; ++j) {
        const char* kp = Ks + (q0 + j * 16 + lr) * 144 + lg * 16;
        const bf16x8 k0 = *(const bf16x8*)kp;
        const bf16x8 k1 = *(const bf16x8*)(kp + 64);
        f32x4 z = {0.f, 0.f, 0.f, 0.f};
        z = __builtin_amdgcn_mfma_f32_16x16x32_bf16(qf0, k0, z, 0, 0, 0);
        z = __builtin_amdgcn_mfma_f32_16x16x32_bf16(qf1, k1, z, 0, 0, 0);
        s[j] = z;
      }
      float mx[4], sum[4];
#pragma unroll
      for (int r = 0; r < 4; ++r) {
        const int ql = lg * 4 + r;
        float m = sink;
#pragma unroll
        for (int j = 0; j < 9; ++j) {
          float v = s[j][r] * 0.125f;
          bool ok = true;
          if (j == 0) ok = (lr >= ql);
          if (j == 8) ok = (lr <= ql);
          if (n == 0 && (q0 + j * 16 + lr) < 128) ok = false;
          v = ok ? v : -INFINITY;
          s[j][r] = v;
          m = fmaxf(m, v);
        }
        mx[r] = rowmax16(m);
      }
#pragma unroll
      for (int r = 0; r < 4; ++r) {
        float sm = 0.f;
#pragma unroll
        for (int j = 0; j < 9; ++j) {
          const float e = __expf(s[j][r] - mx[r]);
          s[j][r] = e;
          sm += e;
        }
        sm = rowsum16(sm);
        sum[r] = sm + __expf(sink - mx[r]);
      }
      u16* P = (u16*)Ps;
#pragma unroll
      for (int j = 0; j < 9; ++j)
#pragma unroll
        for (int r = 0; r < 4; ++r) P[(lg * 4 + r) * 168 + j * 16 + lr] = f2bf(s[j][r]);
      __builtin_amdgcn_wave_barrier();
      f32x4 o[4];
#pragma unroll
      for (int nd = 0; nd < 4; ++nd) o[nd] = f32x4{0.f, 0.f, 0.f, 0.f};
#pragma unroll
      for (int kk = 0; kk < 5; ++kk) {
        const bf16x8 pf = *(const bf16x8*)(Ps + lr * 336 + kk * 64 + lg * 16);
#pragma unroll
        for (int nd = 0; nd < 4; ++nd) {
          const bf16x8 vf = *(const bf16x8*)(Vs + (nd * 16 + lr) * 560 + (q0 + kk * 32 + lg * 8) * 2);
          o[nd] = __builtin_amdgcn_mfma_f32_16x16x32_bf16(pf, vf, o[nd], 0, 0, 0);
        }
      }
#pragma unroll
      for (int nd = 0; nd < 4; ++nd)
#pragma unroll
        for (int r = 0; r < 4; ++r) {
          const float v = o[nd][r] / sum[r];
          O[((size_t)b * 4096 + n * 128 + q0 + lg * 4 + r) * LDH + qh * 64 + nd * 16 + lr] = f2bf(v);
        }
      __builtin_amdgcn_wave_barrier();
    }
  }
  float* qs = (float*)lds;
  float* sc = (float*)(lds + 1024);
  float* part = (float*)(lds + 1024 + 2112);
  for (int it = blockIdx.x; it < 512; it += gridDim.x) {
    const int b = it >> 2, kvh = it & 3;
    const size_t row = (size_t)NP + b;
    __syncthreads();
    if (tid < 256) qs[tid] = bf2f(Qb[row * 1024 + kvh * 256 + tid]);
    __syncthreads();
    {
      const int key = tid >> 2, g = tid & 3;
      const float* kp = p.cache_k + (((size_t)b * 128 + key) * 4 + kvh) * 64;
      float dot = 0.f;
#pragma unroll
      for (int d4 = 0; d4 < 16; ++d4) {
        const float4 kv = *(const float4*)(kp + d4 * 4);
        const float* q = qs + g * 64 + d4 * 4;
        dot += kv.x * q[0] + kv.y * q[1] + kv.z * q[2] + kv.w * q[3];
      }
      sc[g * 132 + key] = dot * 0.125f;
      if (key >= 1) {
        float* dst = p.out + O_KS + (((size_t)b * 128 + key - 1) * 4 + kvh) * 64 + g * 16;
        const float* src = kp + g * 16;
#pragma unroll
        for (int d4 = 0; d4 < 4; ++d4) *(float4*)(dst + d4 * 4) = *(const float4*)(src + d4 * 4);
      }
      if (tid < 4) {
        const float* kn = p.out + O_KS + (((size_t)b * 128 + 127) * 4 + kvh) * 64;
        float d2 = 0.f;
        for (int d = 0; d < 64; ++d) d2 += kn[d] * qs[tid * 64 + d];
        sc[tid * 132 + 128] = d2 * 0.125f;
      }
    }
    __syncthreads();
    if (w < 4) {
      const float sink = p.at_sink[kvh * 4 + w];
      float* s = sc + w * 132;
      const float v0 = s[lane], v1 = s[64 + lane], v2 = lane == 0 ? s[128] : -INFINITY;
      float m = fmaxf(fmaxf(v0, v1), fmaxf(v2, sink));
      m = wavemax(m);
      const float e0 = __expf(v0 - m), e1 = __expf(v1 - m), e2 = lane == 0 ? __expf(v2 - m) : 0.f;
      float sm = wavesum(e0 + e1 + e2) + __expf(sink - m);
      const float inv = 1.f / sm;
      s[lane] = e0 * inv;
      s[64 + lane] = e1 * inv;
      if (lane == 0) s[128] = e2 * inv;
    }
    __syncthreads();
    {
      const int d = tid & 63, g = (tid >> 6) & 3, half = tid >> 8;
      const float* vp = p.cache_v + (((size_t)b * 128) * 4 + kvh) * 64 + d;
      float accv = 0.f;
      for (int key = half * 64; key < half * 64 + 64; ++key) {
        const float vv = vp[(size_t)key * 256];
        accv += sc[g * 132 + key] * vv;
        if (g == 0 && key >= 1) p.out[O_VS + (((size_t)b * 128 + key - 1) * 4 + kvh) * 64 + d] = vv;
      }
      if (half == 1) accv += sc[g * 132 + 128] * p.out[O_VS + (((size_t)b * 128 + 127) * 4 + kvh) * 64 + d];
      part[(half * 4 + g) * 64 + d] = accv;
    }
    __syncthreads();
    if (tid < 256) {
      const int d = tid & 63, g = tid >> 6;
      O[row * LDH + (kvh * 4 + g) * 64 + d] = f2bf(part[g * 64 + d] + part[(4 + g) * 64 + d]);
    }
  }
}

__global__ void __launch_bounds__(NTHR) mega(Params p) {
  extern __shared__ __attribute__((aligned(16))) char lds[];
  cg::grid_group grid = cg::this_grid();
  volatile LAS unsigned* xst = (volatile LAS unsigned*)(lds + LDS_BYTES);
  if (threadIdx.x == 0) { xst[0] = 0u; xst[1] = 0u; }
  __syncthreads();
  const XcdBarrier xb = xcd_barrier_post((unsigned*)(p.ws + WS_BAR), xst);
  const u16* wt = (const u16*)(p.ws + WS_WT);
  phase0(p, lds);
  grid.sync();
  phase_ada(p, lds);
  xcd_barrier(xb);
  phase_norm(p, 0, 0, true, true);
  xcd_barrier(xb);
  phase_rwkv_proj(p, lds);
  xcd_barrier(xb);
  phase_rwkv_lora2(p, lds);
  xcd_barrier(xb);
  phase_scan(p, lds);
  xcd_barrier(xb);
  phase_gate(p, lds);
  xcd_barrier(xb);
  phase_oproj(p, lds, (const u16*)(p.ws + WS_H), 1024, wt + WT_WO, 0, 2, true);
  xcd_barrier(xb);
  phase_norm(p, 0, 1, false, false);
  xcd_barrier(xb);
  phase_up(p, lds, wt + WT_UP0);
  xcd_barrier(xb);
  phase_oproj(p, lds, (const u16*)(p.ws + S_UP), 4096, wt + WT_DN0, 0, 5, false);
  xcd_barrier(xb);
  phase_norm(p, 1, 0, false, false);
  xcd_barrier(xb);
  phase_qkv(p, lds);
  xcd_barrier(xb);
  phase_attn(p, lds);
  xcd_barrier(xb);
  phase_oproj(p, lds, (const u16*)(p.ws + S_O), 1024, wt + WT_WO1, 1, 2, false);
  xcd_barrier(xb);
  phase_norm(p, 1, 1, false, false);
  xcd_barrier(xb);
  phase_up(p, lds, wt + WT_UP1);
  xcd_barrier(xb);
  phase_oproj(p, lds, (const u16*)(p.ws + S_UP), 4096, wt + WT_DN1, 1, 5, false);
  xcd_barrier(xb);
  phase_final(p);
}

extern "C" void kernel_launch(void* const* d_in, const int* in_sizes, int n_in, void* d_out, int out_size, void* d_ws,
                              size_t ws_size, hipStream_t stream) {
  static int grid_blocks = 0;
  if (grid_blocks == 0) {
    if (ws_size < WS_END) {
      fprintf(stderr, "kernel_launch: workspace too small: %zu < %zu\n", ws_size, (size_t)WS_END);
      grid_blocks = -1;
      return;
    }
    int dev = 0, cus = 0, per_cu = 0;
    hipGetDevice(&dev);
    hipDeviceGetAttribute(&cus, hipDeviceAttributeMultiprocessorCount, dev);
    hipFuncSetAttribute((const void*)mega, hipFuncAttributeMaxDynamicSharedMemorySize, LDS_BYTES + 16);
    hipOccupancyMaxActiveBlocksPerMultiprocessor(&per_cu, (const void*)mega, NTHR, LDS_BYTES + 16);
    if (per_cu < 1) per_cu = 1;
    grid_blocks = cus * per_cu;
  }
  if (grid_blocks < 0) return;
  Params p{};
  const float** pp = (const float**)&p;
  for (int i = 0; i < 37; ++i) pp[i] = (const float*)d_in[i];
  p.out = (float*)d_out;
  p.ws = (char*)d_ws;
  hipMemsetAsync((char*)d_ws + WS_BAR, 0, 16384, stream);
  void* args[] = {&p};
  hipError_t e = hipLaunchCooperativeKernel((const void*)mega, dim3(grid_blocks), dim3(NTHR), args, LDS_BYTES + 16, stream);
  if (e != hipSuccess) fprintf(stderr, "cooperative launch failed: %s (grid %d)\n", hipGetErrorString(e), grid_blocks);
}
```

```cpp
#include <hip/hip_runtime.h>
#include <hip/hip_cooperative_groups.h>
#include <cstdio>
namespace cg = cooperative_groups;

typedef unsigned short u16;
typedef __attribute__((ext_vector_type(8))) short bf16x8;
typedef __attribute__((ext_vector_type(4))) float f32x4;

constexpr int NP = 16384, MROWS = 16512, MPAD = 16640;
constexpr int NTHR = 512;
constexpr size_t MEG = 1048576;
constexpr int LDH = 1088, LDU = 4160;

constexpr size_t O_Y = 0, O_WKVP = 16908288, O_WKVS = 17170432, O_SHP = 25559040, O_SHS = 25563136,
                 O_KP = 25694208, O_KS = 25825280, O_VP = 30019584, O_VS = 30150656;

constexpr size_t WT_WR = 0, WT_WK = WT_WR + 1024 * LDH, WT_WV = WT_WK + 1024 * LDH, WT_WO = WT_WV + 1024 * LDH,
                 WT_W1 = WT_WO + 1024 * LDH, WT_A1 = WT_W1 + 64 * LDH, WT_G1 = WT_A1 + 64 * LDH, WT_W2 = WT_G1 + 128 * LDH,
                 WT_A2 = WT_W2 + 65536, WT_G2 = WT_A2 + 65536, WT_UP0 = WT_G2 + 131072, WT_DN0 = WT_UP0 + 4096 * LDH,
                 WT_QKV = WT_DN0 + 1024 * LDU, WT_WO1 = WT_QKV + 1536 * LDH, WT_UP1 = WT_WO1 + 1024 * LDH,
                 WT_DN1 = WT_UP1 + 4096 * LDH, WT_END = WT_DN1 + 1024 * LDU;
constexpr size_t WS_WT = 0;
constexpr size_t WS_H = WS_WT + WT_END * 2;
constexpr size_t WS_ZR = WS_H + (size_t)MPAD * LDH * 2;
constexpr size_t WS_MOD = WS_ZR + (size_t)LDH * 2;
constexpr size_t WS_TAB = WS_MOD + (size_t)2 * 132 * 6144 * 4;
constexpr size_t WS_HS = WS_H + (size_t)MROWS * LDH * 2;
constexpr size_t WS_RK = WS_TAB + (size_t)4097 * 8 * 8;
constexpr size_t WS_BAR = WS_RK + (size_t)MPAD * 16 * 4;
constexpr size_t WS_S = WS_BAR + 16384;
constexpr size_t RSZ = (size_t)MROWS * 1024 * 2;
constexpr size_t S_ADAWT = WS_S, S_SILUC = S_ADAWT + (size_t)2 * 6144 * LDH * 2;
constexpr size_t S_R = WS_S, S_K = S_R + RSZ, S_V = S_K + RSZ, S_EW = S_V + RSZ, S_A = S_EW + RSZ,
                 S_WH = S_A + RSZ, S_AH = S_WH + (size_t)MPAD * 64 * 2, S_GH = S_AH + (size_t)MPAD * 64 * 2,
                 S_RW_END = S_GH + (size_t)MPAD * 128 * 2;
constexpr size_t S_UP = WS_S;
constexpr size_t S_Q = WS_S, S_O = S_Q + (size_t)MPAD * 1024 * 2, S_KB = S_O + (size_t)MPAD * LDH * 2,
                 S_VT = S_KB + (size_t)MPAD * 256 * 2;
constexpr size_t WS_END = S_RW_END;
static_assert(S_UP + (size_t)MPAD * LDU * 2 <= WS_END, "up fits");
static_assert(S_VT + (size_t)16 * 64 * 4096 * 2 <= WS_END, "attn fits");
static_assert(WS_END <= 282000000, "ws fits sum of inputs");

constexpr int LDS_ROW = 144;
constexpr int LDS_A_BYTES = 256 * LDS_ROW;
constexpr int LDS_B_BYTES = 128 * LDS_ROW;
constexpr int LDS_STAGE = LDS_A_BYTES + LDS_B_BYTES;
constexpr int LDS_BYTES = 147456;

struct Params {
  const float *x_prompt, *x_sample, *c_prompt, *c_sample, *state_wkv, *state_shift, *cache_k, *cache_v;
  const float *norm1_g, *norm2_g, *ada_w, *ada_b, *mlp_up, *mlp_down, *final_g;
  const float *rw_mix, *rw_wr, *rw_wk, *rw_wv, *rw_wo, *rw_w0, *rw_w1, *rw_w2, *rw_a0, *rw_a1, *rw_a2, *rw_g1, *rw_g2,
      *rw_kk, *rw_ka, *rw_rk, *rw_lnx_g, *rw_lnx_b;
  const float *at_wqkv, *at_bqkv, *at_wo, *at_sink;
  float* out;
  char* ws;
};

__device__ __forceinline__ u16 f2bf(float f) {
  unsigned u = __float_as_uint(f);
  u += 0x7fffu + ((u >> 16) & 1u);
  return (u16)(u >> 16);
}
__device__ __forceinline__ float bf2f(u16 h) { return __uint_as_float(((unsigned)h) << 16); }
__device__ __forceinline__ float bflo(unsigned w) { return __uint_as_float(w << 16); }
__device__ __forceinline__ float bfhi(unsigned w) { return __uint_as_float(w & 0xffff0000u); }
__device__ __forceinline__ unsigned pack2(float a, float b) {
  unsigned r;
  asm volatile("v_cvt_pk_bf16_f32 %0, %1, %2" : "=v"(r) : "v"(a), "v"(b));
  return r;
}
__device__ __forceinline__ uint2 pack4(f32x4 v) { return uint2{pack2(v[0], v[1]), pack2(v[2], v[3])}; }
__device__ __forceinline__ float h2f(u16 h) { return (float)__builtin_bit_cast(_Float16, h); }
__device__ __forceinline__ u16 f2h(float f) { return __builtin_bit_cast(u16, (_Float16)f); }
__device__ __forceinline__ float sigmoidf_(float x) { return 1.f / (1.f + __expf(-x)); }

template <int CTRL>
__device__ __forceinline__ float dppf(float x) {
  return __int_as_float(__builtin_amdgcn_update_dpp(0, __float_as_int(x), CTRL, 0xf, 0xf, true));
}
__device__ __forceinline__ float rowsum16(float x) {
  x += dppf<0xB1>(x);
  x += dppf<0x4E>(x);
  x += dppf<0x124>(x);
  x += dppf<0x128>(x);
  return x;
}
__device__ __forceinline__ float rowmax16(float x) {
  x = fmaxf(x, dppf<0xB1>(x));
  x = fmaxf(x, dppf<0x4E>(x));
  x = fmaxf(x, dppf<0x124>(x));
  x = fmaxf(x, dppf<0x128>(x));
  return x;
}
__device__ __forceinline__ float wavesum(float x) {
#pragma unroll
  for (int o = 32; o > 0; o >>= 1) x += __shfl_xor(x, o);
  return x;
}
__device__ __forceinline__ float wavemax(float x) {
#pragma unroll
  for (int o = 32; o > 0; o >>= 1) x = fmaxf(x, __shfl_xor(x, o));
  return x;
}
__device__ __forceinline__ int bidx_of(int row) { return row < NP ? (row >> 12) : (4 + row - NP); }

#define XB_TMO      128
#define XB_XCNT(j)  (256  + 64 * (j))
#define XB_XSUB(j)  (1280 + 64 * (j))
#define XB_XGEN(j)  (2304 + 64 * (j))
#define XB_TOP      3328
#define XB_TOPGEN   3392
#define XCD_BAR_WORDS 3456
#define XB_SPIN_CAP (1u << 22)
#define LAS __attribute__((address_space(3)))
__device__ __forceinline__ unsigned xb_ld(unsigned* p) { return __hip_atomic_load(p, __ATOMIC_RELAXED, __HIP_MEMORY_SCOPE_AGENT); }
__device__ __forceinline__ unsigned xb_add(unsigned* p, unsigned v) { return __hip_atomic_fetch_add(p, v, __ATOMIC_RELAXED, __HIP_MEMORY_SCOPE_AGENT); }
__device__ __forceinline__ unsigned xb_xcc_id() { return (unsigned)__builtin_amdgcn_s_getreg((3 << 11) | 20) & 0xFu; }
#define XB_SPIN(cond, bar) do { unsigned _sp = 0; while (cond) { __builtin_amdgcn_s_sleep(1); \
    if ((++_sp & 255u) == 0u) { if (xb_ld(&(bar)[XB_TMO])) break; if (_sp > XB_SPIN_CAP) { atomicAdd(&(bar)[XB_TMO], 1u); break; } } } } while (0)
struct XcdBarrier {
  unsigned* bar;
  unsigned x;
  volatile LAS unsigned* st;
};
__device__ __forceinline__ XcdBarrier xcd_barrier_post(unsigned* bar, volatile LAS unsigned* st) {
  XcdBarrier b;
  b.bar = bar;
  b.x = xb_xcc_id();
  b.st = st;
  if (threadIdx.x == 0) (void)xb_add(&bar[XB_XCNT(b.x)], 1u);
  return b;
}
__device__ __forceinline__ void xcd_barrier_complete(unsigned* bar, unsigned x, unsigned& nloc, unsigned& nx) {
  const unsigned G = gridDim.x * gridDim.y * gridDim.z;
  unsigned sum, cnt, mine, sp = 0u;
  for (;;) {
    sum = 0u; cnt = 0u; mine = 0u;
#pragma unroll
    for (unsigned j = 0; j < 16; ++j) {
      const unsigned c = xb_ld(&bar[XB_XCNT(j)]);
      sum += c;
      cnt += (c > 0u) ? 1u : 0u;
      mine = (j == x) ? c : mine;
    }
    if (sum == G) break;
    __builtin_amdgcn_s_sleep(1);
    if ((++sp & 255u) == 0u) {
      if (xb_ld(&bar[XB_TMO])) break;
      if (sp > XB_SPIN_CAP) { atomicAdd(&bar[XB_TMO], 1u); break; }
    }
  }
  nloc = mine > 0u ? mine : 1u;
  nx = cnt > 0u ? cnt : 1u;
}
__device__ __forceinline__ void xcd_barrier(const XcdBarrier& b) {
  asm volatile("s_waitcnt vmcnt(0)" ::: "memory");
  __syncthreads();
  if (threadIdx.x == 0) {
    unsigned* bar = b.bar;
    __builtin_amdgcn_s_waitcnt(0);
    unsigned nloc = b.st[0], nx = b.st[1];
    if (nloc == 0u) { xcd_barrier_complete(bar, b.x, nloc, nx); b.st[0] = nloc; b.st[1] = nx; }
    const unsigned old = xb_add(&bar[XB_XSUB(b.x)], 1u);
    const unsigned gen = old / nloc;
    if (old + 1u == (gen + 1u) * nloc) {
      __builtin_amdgcn_fence(__ATOMIC_RELEASE, "agent");
      asm volatile("s_waitcnt vmcnt(0)" ::: "memory");
      const unsigned og = xb_add(&bar[XB_TOP], 1u);
      const unsigned tg = og / nx;
      if (og + 1u == (tg + 1u) * nx) xb_add(&bar[XB_TOPGEN], 1u);
      else XB_SPIN(xb_ld(&bar[XB_TOPGEN]) == tg, bar);
      __builtin_amdgcn_fence(__ATOMIC_ACQUIRE, "agent");
      xb_add(&bar[XB_XGEN(b.x)], 1u);
      asm volatile("s_waitcnt vmcnt(0)" ::: "memory");
    } else {
      XB_SPIN(xb_ld(&bar[XB_XGEN(b.x)]) == gen, bar);
      __builtin_amdgcn_fence(__ATOMIC_ACQUIRE, "agent");
      asm volatile("s_waitcnt vmcnt(0)" ::: "memory");
    }
  }
  __syncthreads();
}

#define BAR_SYNC() do { asm volatile("s_waitcnt lgkmcnt(0)" ::: "memory"); __builtin_amdgcn_s_barrier(); asm volatile("" ::: "memory"); } while (0)

__device__ __forceinline__ unsigned mix2(unsigned h, unsigned p, float m0, float m1) {
  float h0 = bflo(h), h1 = bfhi(h), p0 = bflo(p), p1 = bfhi(p);
  return pack2(h0 + (p0 - h0) * m0, h1 + (p1 - h1) * m1);
}

template <bool MIX, class Epi>
__device__ __forceinline__ void gemm_tile(const u16* __restrict__ A, int lda, const float* __restrict__ mixv,
                                          const u16* __restrict__ Bt, int ldb, int N, int K, int m0, int n0, char* lds, Epi&& epi) {
  const int tid = threadIdx.x, lane = tid & 63, w = tid >> 6;
  const int nk = K >> 6;
  if (w >= 4) {
    const int pt = tid - 256, kc = pt & 7, pr = pt >> 3;
    const u16* Ab = A + (size_t)m0 * lda + (size_t)pr * lda + kc * 8;
    int poff[8];
#pragma unroll
    for (int i = 0; i < 8; ++i) {
      poff[i] = 0;
      if (MIX) {
        const int row = m0 + pr + 32 * i;
        const int prow = row < NP ? ((row & 4095) ? row - 1 : MPAD) : (row < MROWS ? row + 128 : MPAD);
        poff[i] = prow * LDH + kc * 8;
      }
    }
    bool bv[4];
    const u16* bp[4];
#pragma unroll
    for (int j = 0; j < 4; ++j) {
      const int n = n0 + pr + 32 * j;
      bv[j] = n < N;
      bp[j] = Bt + (size_t)(bv[j] ? n : 0) * ldb + kc * 8;
    }
    struct RSet {
      uint4 ra[8], rp[8], rb[4];
      float4 mx0, mx1;
    };
    RSet SA, SB;
    auto gload = [&](RSet& S, int kt) {
      const int ko = kt * 64;
#pragma unroll
      for (int i = 0; i < 8; ++i) {
        S.ra[i] = *(const uint4*)(Ab + (size_t)(32 * i) * lda + ko);
        if (MIX) S.rp[i] = *(const uint4*)(A + poff[i] + ko);
      }
      if (MIX) {
        S.mx0 = *(const float4*)(mixv + ko + kc * 8);
        S.mx1 = *(const float4*)(mixv + ko + kc * 8 + 4);
      }
#pragma unroll
      for (int j = 0; j < 4; ++j) {
        uint4 z = {0u, 0u, 0u, 0u};
        if (bv[j]) z = *(const uint4*)(bp[j] + ko);
        S.rb[j] = z;
      }
    };
    auto lstore = [&](RSet& S, int s) {
      char* base = lds + s * LDS_STAGE + pr * LDS_ROW + kc * 16;
#pragma unroll
      for (int i = 0; i < 8; ++i) {
        uint4 v = S.ra[i];
        if (MIX) {
          v.x = mix2(S.ra[i].x, S.rp[i].x, S.mx0.x, S.mx0.y);
          v.y = mix2(S.ra[i].y, S.rp[i].y, S.mx0.z, S.mx0.w);
          v.z = mix2(S.ra[i].z, S.rp[i].z, S.mx1.x, S.mx1.y);
          v.w = mix2(S.ra[i].w, S.rp[i].w, S.mx1.z, S.mx1.w);
        }
        *(uint4*)(base + (32 * i) * LDS_ROW) = v;
      }
#pragma unroll
      for (int j = 0; j < 4; ++j) *(uint4*)(base + LDS_A_BYTES + (32 * j) * LDS_ROW) = S.rb[j];
    };
    if constexpr (!MIX) {
      gload(SB, 0);
      if (nk > 1) gload(SA, 1);
      lstore(SB, 0);
      if (nk > 2) gload(SB, 2);
      BAR_SYNC();
#pragma unroll 1
      for (int kt = 0; kt < nk; kt += 2) {
        if (kt + 1 < nk) {
          lstore(SA, 1);
          if (kt + 3 < nk) gload(SA, kt + 3);
        }
        BAR_SYNC();
        if (kt + 1 < nk) {
          if (kt + 2 < nk) {
            lstore(SB, 0);
            if (kt + 4 < nk) gload(SB, kt + 4);
          }
          BAR_SYNC();
        }
      }
    } else {
      gload(SA, 0);
      lstore(SA, 0);
      if (nk > 1) gload(SA, 1);
      BAR_SYNC();
#pragma unroll 1
      for (int kt = 0; kt < nk; ++kt) {
        if (kt + 1 < nk) {
          lstore(SA, (kt + 1) & 1);
          if (kt + 2 < nk) gload(SA, kt + 2);
        }
        BAR_SYNC();
      }
    }
  } else {
    const int wm = w >> 1, wn = w & 1, lr = lane & 15, lg = lane >> 4;
    f32x4 acc[8][4];
#pragma unroll
    for (int i = 0; i < 8; ++i)
#pragma unroll
      for (int j = 0; j < 4; ++j) acc[i][j] = f32x4{0.f, 0.f, 0.f, 0.f};
    BAR_SYNC();
#pragma unroll 1
    for (int kt = 0; kt < nk; ++kt) {
      const char* sa = lds + (kt & 1) * LDS_STAGE + (wm * 128 + lr) * LDS_ROW + lg * 16;
      const char* sb = lds + (kt & 1) * LDS_STAGE + LDS_A_BYTES + (wn * 64 + lr) * LDS_ROW + lg * 16;
      bf16x8 bq[2][4], aq[3];
#pragma unroll
      for (int ni = 0; ni < 4; ++ni) bq[0][ni] = *(const bf16x8*)(sb + ni * 16 * LDS_ROW);
      aq[0] = *(const bf16x8*)(sa);
      aq[1] = *(const bf16x8*)(sa + 16 * LDS_ROW);
#pragma unroll
      for (int ni = 0; ni < 4; ++ni) bq[1][ni] = *(const bf16x8*)(sb + ni * 16 * LDS_ROW + 64);
#pragma unroll
      for (int st = 0; st < 16; ++st) {
        if (st + 2 < 16) aq[(st + 2) % 3] = *(const bf16x8*)(sa + ((st + 2) & 7) * 16 * LDS_ROW + ((st + 2) >> 3) * 64);
#pragma unroll
        for (int ni = 0; ni < 4; ++ni)
          acc[st & 7][ni] = __builtin_amdgcn_mfma_f32_16x16x32_bf16(bq[st >> 3][ni], aq[st % 3], acc[st & 7][ni], 0, 0, 0);
        __builtin_amdgcn_sched_barrier(0);
      }
      BAR_SYNC();
    }
    epi(acc, wm, wn, lr, lg);
  }
}

constexpr int LDS_STAGE2 = 2 * LDS_A_BYTES;
template <class Epi>
__device__ __forceinline__ void gemm_tile256(const u16* __restrict__ A, int lda, const u16* __restrict__ Bt, int ldb, int K, int m0,
                                             int n0, char* lds, Epi&& epi) {
  int tid = threadIdx.x;
  asm volatile("" : "+v"(tid));
  const int lane = tid & 63, w = __builtin_amdgcn_readfirstlane(tid >> 6);
  const int wm = w >> 2, wn = w & 3, lr = lane & 15, lg = lane >> 4;
  const int kc = tid & 7, r0 = tid >> 3;
  const int nk = K >> 6;
  const u16* Ab = A + (size_t)(m0 + r0) * lda + kc * 8;
  const u16* Bb = Bt + (size_t)(n0 + r0) * ldb + kc * 8;
  struct LSet {
    uint4 ra[4], rb[4];
  };
  LSet S;
  auto gload = [&](LSet& R, int kt) {
    const int ko = kt * 64;
#pragma unroll
    for (int i = 0; i < 4; ++i) {
      R.ra[i] = *(const uint4*)(Ab + (size_t)(64 * i) * lda + ko);
      R.rb[i] = *(const uint4*)(Bb + (size_t)(64 * i) * ldb + ko);
    }
  };
  auto lstore = [&](LSet& R, int s) {
    char* base = lds + s * LDS_STAGE2 + r0 * LDS_ROW + kc * 16;
#pragma unroll
    for (int i = 0; i < 4; ++i) {
      *(uint4*)(base + (64 * i) * LDS_ROW) = R.ra[i];
      *(uint4*)(base + LDS_A_BYTES + (64 * i) * LDS_ROW) = R.rb[i];
    }
  };
  f32x4 acc[8][4];
#pragma unroll
  for (int i = 0; i < 8; ++i)
#pragma unroll
    for (int j = 0; j < 4; ++j) acc[i][j] = f32x4{0.f, 0.f, 0.f, 0.f};
  gload(S, 0);
  lstore(S, 0);
  BAR_SYNC();
#pragma unroll 1
  for (int kt = 0; kt < nk; ++kt) {
    gload(S, kt + 1 < nk ? kt + 1 : kt);
    const char* sa = lds + (kt & 1) * LDS_STAGE2 + (wm * 128 + lr) * LDS_ROW + lg * 16;
    const char* sb = lds + (kt & 1) * LDS_STAGE2 + LDS_A_BYTES + (wn * 64 + lr) * LDS_ROW + lg * 16;
    bf16x8 bq[4], aq[3];
#pragma unroll
    for (int ni = 0; ni < 4; ++ni) bq[ni] = *(const bf16x8*)(sb + ni * 16 * LDS_ROW);
    aq[0] = *(const bf16x8*)(sa);
    aq[1] = *(const bf16x8*)(sa + 16 * LDS_ROW);
#pragma unroll
    for (int st = 0; st < 16; ++st) {
      if (st + 2 < 16) aq[(st + 2) % 3] = *(const bf16x8*)(sa + ((st + 2) & 7) * 16 * LDS_ROW + ((st + 2) >> 3) * 64);
#pragma unroll
      for (int ni = 0; ni < 4; ++ni)
        acc[st & 7][ni] = __builtin_amdgcn_mfma_f32_16x16x32_bf16(bq[ni], aq[st % 3], acc[st & 7][ni], 0, 0, 0);
      if (st == 7) {
#pragma unroll
        for (int ni = 0; ni < 4; ++ni) bq[ni] = *(const bf16x8*)(sb + ni * 16 * LDS_ROW + 64);
      }
      __builtin_amdgcn_sched_barrier(0);
    }
    lstore(S, (kt + 1) & 1);
    BAR_SYNC();
  }
  epi(acc, wm, wn, lr, lg);
}

#define EPI_FOREACH(acc, ...)                                    \
  _Pragma("unroll") for (int mi = 0; mi < 8; ++mi) {             \
    const int row = m0 + wm * 128 + mi * 16 + lr;                \
    _Pragma("unroll") for (int ni = 0; ni < 4; ++ni) {           \
      const int col0 = n0 + wn * 64 + ni * 16 + lg * 4;          \
      const f32x4 v = acc[mi][ni];                               \
      __VA_ARGS__                                                \
    }                                                            \
    __builtin_amdgcn_sched_barrier(0);                           \
  }
#define EPI_ARGS f32x4(&acc)[8][4], int wm, int wn, int lr, int lg

__device__ __forceinline__ void conv_job(const float* __restrict__ src, u16* __restrict__ dst, int K, int N, int ldk, float* tl, int rot) {
  const int tid = threadIdx.x;
  const int tn = N >> 6, nt = (K >> 6) * tn;
  const int G = gridDim.x;
  int start = ((int)blockIdx.x + G - (rot % G)) % G;
  for (int t = start; t < nt; t += G) {
    const int k0 = (t / tn) << 6, n0 = (t % tn) << 6;
#pragma unroll
    for (int i = 0; i < 8; ++i) {
      int e = tid + 512 * i;
      tl[(e >> 6) * 65 + (e & 63)] = src[(size_t)(k0 + (e >> 6)) * N + n0 + (e & 63)];
    }
    __syncthreads();
    const int n = tid >> 3, kc = tid & 7;
    float f[8];
#pragma unroll
    for (int j = 0; j < 8; ++j) f[j] = tl[(kc * 8 + j) * 65 + n];
    uint4 v;
    v.x = pack2(f[0], f[1]);
    v.y = pack2(f[2], f[3]);
    v.z = pack2(f[4], f[5]);
    v.w = pack2(f[6], f[7]);
    *(uint4*)(dst + (size_t)(n0 + n) * ldk + k0 + kc * 8) = v;
    __syncthreads();
  }
}

__device__ __forceinline__ void phase0(const Params& p, char* lds) {
  float* tl = (float*)lds;
  u16* wt = (u16*)(p.ws + WS_WT);
  u16* adawt = (u16*)(p.ws + S_ADAWT);
  int rot = 0;
#define CJ(SRC, DST, K, N)            \
  conv_job(SRC, DST, K, N, ((K) == 1024 ? LDH : (K) == 4096 ? LDU : (K)), tl, rot);  \
  rot += ((K) >> 6) * ((N) >> 6);
  CJ(p.ada_w, adawt, 1024, 6144)
  CJ(p.ada_w + (size_t)1024 * 6144, adawt + (size_t)6144 * LDH, 1024, 6144)
  CJ(p.rw_wr, wt + WT_WR, 1024, 1024)
  CJ(p.rw_wk, wt + WT_WK, 1024, 1024)
  CJ(p.rw_wv, wt + WT_WV, 1024, 1024)
  CJ(p.rw_wo, wt + WT_WO, 1024, 1024)
  CJ(p.rw_w1, wt + WT_W1, 1024, 64)
  CJ(p.rw_a1, wt + WT_A1, 1024, 64)
  CJ(p.rw_g1, wt + WT_G1, 1024, 128)
  CJ(p.rw_w2, wt + WT_W2, 64, 1024)
  CJ(p.rw_a2, wt + WT_A2, 64, 1024)
  CJ(p.rw_g2, wt + WT_G2, 128, 1024)
  CJ(p.mlp_up, wt + WT_UP0, 1024, 4096)
  CJ(p.mlp_down, wt + WT_DN0, 4096, 1024)
  CJ(p.at_wqkv, wt + WT_QKV, 1024, 1536)
  CJ(p.at_wo, wt + WT_WO1, 1024, 1024)
  CJ(p.mlp_up + (size_t)4 * MEG, wt + WT_UP1, 1024, 4096)
  CJ(p.mlp_down + (size_t)4 * MEG, wt + WT_DN1, 4096, 1024)
#undef CJ
  const int gtid = blockIdx.x * NTHR + threadIdx.x, gsz = gridDim.x * NTHR;
  u16* siluc = (u16*)(p.ws + S_SILUC);
  for (int i = gtid; i < 256 * 1024; i += gsz) {
    int row = i >> 10, col = i & 1023;
    float c = 0.f;
    if (row < 4) c = p.c_prompt[row * 1024 + col];
    else if (row < 132) c = p.c_sample[(row - 4) * 1024 + col];
    siluc[i] = f2bf(c * sigmoidf_(c));
  }
  u16* hs = (u16*)(p.ws + WS_HS);
  for (int i = gtid; i < 128 * 1024; i += gsz) hs[(size_t)(i >> 10) * LDH + (i & 1023)] = f2bf(p.state_shift[i]);
  u16* zr = (u16*)(p.ws + WS_ZR);
  for (int i = gtid; i < LDH; i += gsz) zr[i] = 0;
  float2* tab = (float2*)(p.ws + WS_TAB);
  for (int i = gtid; i < 4097 * 8; i += gsz) {
    int pi = i >> 3, f = i & 7;
    float pos = pi < 4096 ? (float)pi : 8192.f;
    float inv = f == 0 ? 1.0f : f == 1 ? 0.1939227432012558f : f == 2 ? 0.03760603070259094f : f == 3 ? 0.007292664609849453f
              : f == 4 ? 0.0014142135623842478f : f == 5 ? 0.00027424818836152554f : f == 6 ? 5.318296098266728e-05f
              : 1.0313386155758053e-05f;
    float ang = pos * inv;
    double t = (double)ang * 0.15915494309189535;
    t -= rint(t);
    float fr = (float)t;
    tab[i] = make_float2(__builtin_amdgcn_cosf(fr), __builtin_amdgcn_sinf(fr));
  }
}

__device__ __forceinline__ void phase_ada(const Params& p, char* lds) {
  const u16* siluc = (const u16*)(p.ws + S_SILUC);
  const u16* adawt = (const u16*)(p.ws + S_ADAWT);
  float* mod = (float*)(p.ws + WS_MOD);
  for (int t = blockIdx.x; t < 96; t += gridDim.x) {
    const int layer = t / 48, nt = t % 48;
    const int m0 = 0, n0 = nt * 128;
    const float* bias = p.ada_b + layer * 6144;
    float* mo = mod + (size_t)layer * 132 * 6144;
    gemm_tile<false>(siluc, 1024, nullptr, adawt + (size_t)layer * 6144 * LDH, LDH, 6144, 1024, m0, n0, lds, [&](EPI_ARGS) {
      EPI_FOREACH(acc, if (row < 132) {
        const float4 b4 = *(const float4*)(bias + col0);
        *(float4*)(mo + (size_t)row * 6144 + col0) = make_float4(v[0] + b4.x, v[1] + b4.y, v[2] + b4.z, v[3] + b4.w);
      })
    });
  }
}

__device__ __forceinline__ void phase_norm(const Params& p, int layer, int which, bool from_input, bool shift_out) {
  const int lane = threadIdx.x & 63, w = threadIdx.x >> 6;
  const float* mod = (const float*)(p.ws + WS_MOD);
  u16* H = (u16*)(p.ws + WS_H);
  const float* g = (which ? p.norm2_g : p.norm1_g) + layer * 1024;
  const int nw = gridDim.x * 8;
  for (int row = blockIdx.x * 8 + w; row < MROWS; row += nw) {
    const float* xr = from_input ? (row < NP ? p.x_prompt + (size_t)row * 1024 : p.x_sample + (size_t)(row - NP) * 1024)
                                 : p.out + (size_t)row * 1024;
    float4 x[4];
    float ss = 0.f;
#pragma unroll
    for (int i = 0; i < 4; ++i) {
      x[i] = *(const float4*)(xr + lane * 4 + 256 * i);
      ss += x[i].x * x[i].x + x[i].y * x[i].y + x[i].z * x[i].z + x[i].w * x[i].w;
    }
    ss = wavesum(ss);
    const float rs = rsqrtf(ss * (1.f / 1024.f) + 1e-6f);
    const int bi = bidx_of(row);
    const float* mb = mod + ((size_t)layer * 132 + bi) * 6144;
    const float* sh = mb + (which ? 3 : 0) * 1024;
    const float* sc = mb + (which ? 4 : 1) * 1024;
    const bool so = shift_out && (row >= NP || (row & 4095) == 4095);
    float* sop = row >= NP ? p.out + O_SHS + (size_t)(row - NP) * 1024 : p.out + O_SHP + (size_t)(row >> 12) * 1024;
#pragma unroll
    for (int i = 0; i < 4; ++i) {
      const int c = lane * 4 + 256 * i;
      float4 gg = *(const float4*)(g + c), s4 = *(const float4*)(sh + c), c4 = *(const float4*)(sc + c);
      float4 h;
      h.x = x[i].x * rs * gg.x * (1.f + c4.x) + s4.x;
      h.y = x[i].y * rs * gg.y * (1.f + c4.y) + s4.y;
      h.z = x[i].z * rs * gg.z * (1.f + c4.z) + s4.z;
      h.w = x[i].w * rs * gg.w * (1.f + c4.w) + s4.w;
      uint2 pk;
      pk.x = pack2(h.x, h.y);
      pk.y = pack2(h.z, h.w);
      *(uint2*)(H + (size_t)row * LDH + c) = pk;
      if (so) *(float4*)(sop + c) = h;
      if (from_input && row >= NP) *(float4*)(p.out + (size_t)row * 1024 + c) = x[i];
    }
  }
}

__device__ __forceinline__ void phase_final(const Params& p) {
  const int lane = threadIdx.x & 63, w = threadIdx.x >> 6;
  const int nw = gridDim.x * 8;
  for (int row = blockIdx.x * 8 + w; row < MROWS; row += nw) {
    float* xr = p.out + (size_t)row * 1024;
    float4 x[4];
    float ss = 0.f;
#pragma unroll
    for (int i = 0; i < 4; ++i) {
      x[i] = *(const float4*)(xr + lane * 4 + 256 * i);
      ss += x[i].x * x[i].x + x[i].y * x[i].y + x[i].z * x[i].z + x[i].w * x[i].w;
    }
    ss = wavesum(ss);
    const float rs = rsqrtf(ss * (1.f / 1024.f) + 1e-6f);
#pragma unroll
    for (int i = 0; i < 4; ++i) {
      const int c = lane * 4 + 256 * i;
      float4 gg = *(const float4*)(p.final_g + c);
      float4 h;
      h.x = x[i].x * rs * gg.x;
      h.y = x[i].y * rs * gg.y;
      h.z = x[i].z * rs * gg.z;
      h.w = x[i].w * rs * gg.w;
      *(float4*)(xr + c) = h;
    }
  }
}

__device__ __forceinline__ void phase_rwkv_proj(const Params& p, char* lds) {
  const u16* H = (const u16*)(p.ws + WS_H);
  const u16* wt = (const u16*)(p.ws + WS_WT);
  u16* R = (u16*)(p.ws + S_R);
  u16* Kk = (u16*)(p.ws + S_K);
  u16* V = (u16*)(p.ws + S_V);
  u16* WH = (u16*)(p.ws + S_WH);
  u16* AH = (u16*)(p.ws + S_AH);
  u16* GH = (u16*)(p.ws + S_GH);
  for (int t = blockIdx.x; t < 65 * 27; t += gridDim.x) {
    const int mt = t / 27, j = t % 27;
    const int m0 = mt * 256;
    int kind, n0, N, mixi;
    const u16* Bt;
    if (j < 8) { kind = 0; n0 = j * 128; N = 1024; mixi = 0; Bt = wt + WT_WR; }
    else if (j < 16) { kind = 1; n0 = (j - 8) * 128; N = 1024; mixi = 2; Bt = wt + WT_WK; }
    else if (j < 24) { kind = 2; n0 = (j - 16) * 128; N = 1024; mixi = 3; Bt = wt + WT_WV; }
    else if (j == 24) { kind = 3; n0 = 0; N = 64; mixi = 1; Bt = wt + WT_W1; }
    else if (j == 25) { kind = 4; n0 = 0; N = 64; mixi = 4; Bt = wt + WT_A1; }
    else { kind = 5; n0 = 0; N = 128; mixi = 5; Bt = wt + WT_G1; }
    gemm_tile<true>(H, LDH, p.rw_mix + mixi * 1024, Bt, LDH, N, 1024, m0, n0, lds, [&](EPI_ARGS) {
      u16* dst = kind == 0 ? R : kind == 1 ? Kk : kind == 2 ? V : kind == 3 ? WH : kind == 4 ? AH : GH;
      const int ld = kind < 3 ? 1024 : (kind == 5 ? 128 : 64);
      EPI_FOREACH(acc, if (row < MROWS && col0 < ld) {
        f32x4 o = v;
        if (kind == 3) {
          _Pragma("unroll") for (int q = 0; q < 4; ++q) o[q] = 1.f - 2.f / (__expf(2.f * v[q]) + 1.f);
        } else if (kind == 5) {
          _Pragma("unroll") for (int q = 0; q < 4; ++q) o[q] = sigmoidf_(v[q]);
        }
        *(uint2*)(dst + (size_t)row * ld + col0) = pack4(o);
      })
    });
  }
}

__device__ __forceinline__ void phase_rwkv_lora2(const Params& p, char* lds) {
  const u16* wt = (const u16*)(p.ws + WS_WT);
  const u16* WH = (const u16*)(p.ws + S_WH);
  const u16* AH = (const u16*)(p.ws + S_AH);
  u16* EW = (u16*)(p.ws + S_EW);
  u16* Aa = (u16*)(p.ws + S_A);
  for (int t = blockIdx.x; t < 65 * 16; t += gridDim.x) {
    const int mt = t >> 4, j = t & 15;
    const int m0 = mt * 256, n0 = (j & 7) * 128;
    const bool isw = j < 8;
    gemm_tile<false>(isw ? WH : AH, 64, nullptr, wt + (isw ? WT_W2 : WT_A2), 64, 1024, 64, m0, n0, lds, [&](EPI_ARGS) {
      const float* b0 = isw ? p.rw_w0 : p.rw_a0;
      EPI_FOREACH(acc, if (row < MROWS) {
        const float4 b4 = *(const float4*)(b0 + col0);
        const float s0 = sigmoidf_(v[0] + b4.x), s1 = sigmoidf_(v[1] + b4.y), s2 = sigmoidf_(v[2] + b4.z), s3 = sigmoidf_(v[3] + b4.w);
        if (isw) {
          const float c = 0.6065306597126334f;
          uint2 o;
          o.x = (unsigned)f2h(c * s0) | ((unsigned)f2h(c * s1) << 16);
          o.y = (unsigned)f2h(c * s2) | ((unsigned)f2h(c * s3) << 16);
          *(uint2*)(EW + (size_t)row * 1024 + col0) = o;
        } else {
          uint2 o;
          o.x = pack2(s0, s1);
          o.y = pack2(s2, s3);
          *(uint2*)(Aa + (size_t)row * 1024 + col0) = o;
        }
      })
    });
  }
}

constexpr int RING_TS = 344;
constexpr int RING_BUF = 16 * RING_TS;

__device__ __forceinline__ void phase_scan(const Params& p, char* lds) {
  const int tid = threadIdx.x, lane = tid & 63, w = tid >> 6;
  const u16* R = (const u16*)(p.ws + S_R);
  const u16* Kk = (const u16*)(p.ws + S_K);
  const u16* V = (const u16*)(p.ws + S_V);
  const u16* EW = (const u16*)(p.ws + S_EW);
  const u16* Aa = (const u16*)(p.ws + S_A);
  u16* Y = (u16*)(p.ws + WS_H);
  float* RK = (float*)(p.ws + WS_RK);
  float* ring = (float*)lds;
  float* ybuf = (float*)(lds + 2 * RING_BUF * 4);
  for (int item = blockIdx.x; item < 256; item += gridDim.x) {
    const int chain = item >> 2, qr = item & 3, b = chain >> 4, h = chain & 15;
    const size_t rowbase = (size_t)b * 4096;
    __syncthreads();
    if (tid >= 256) {
      const int pt = tid - 256, tok = pt >> 4, cq = pt & 15;
      const int ch = h * 64 + cq * 4;
      const float4 kk4 = *(const float4*)(p.rw_kk + ch), ka4 = *(const float4*)(p.rw_ka + ch), rk4 = *(const float4*)(p.rw_rk + ch);
      struct PS {
        uint2 rr, rk_, rv, ra_, re;
      };
      PS S0, S1;
      auto pload = [&](PS& S, int c) {
        const size_t off = (rowbase + (size_t)c * 16 + tok) * 1024 + ch;
        S.rr = *(const uint2*)(R + off);
        S.rk_ = *(const uint2*)(Kk + off);
        S.rv = *(const uint2*)(V + off);
        S.ra_ = *(const uint2*)(Aa + off);
        S.re = *(const uint2*)(EW + off);
      };
      auto pproc = [&](PS& S, int c) {
        const uint2 rr = S.rr, rk_ = S.rk_, rv = S.rv, ra_ = S.ra_, re = S.re;
        float rf[4] = {bflo(rr.x), bfhi(rr.x), bflo(rr.y), bfhi(rr.y)};
        float kf[4] = {bflo(rk_.x), bfhi(rk_.x), bflo(rk_.y), bfhi(rk_.y)};
        float vf[4] = {bflo(rv.x), bfhi(rv.x), bflo(rv.y), bfhi(rv.y)};
        float af[4] = {bflo(ra_.x), bfhi(ra_.x), bflo(ra_.y), bfhi(ra_.y)};
        float ef[4] = {h2f((u16)(re.x & 0xffff)), h2f((u16)(re.x >> 16)), h2f((u16)(re.y & 0xffff)), h2f((u16)(re.y >> 16))};
        const float kkw[4] = {kk4.x, kk4.y, kk4.z, kk4.w}, kaw[4] = {ka4.x, ka4.y, ka4.z, ka4.w}, rkw[4] = {rk4.x, rk4.y, rk4.z, rk4.w};
        float kkr[4], kp[4], ss = 0.f, rks = 0.f;
#pragma unroll
        for (int j = 0; j < 4; ++j) {
          kkr[j] = kf[j] * kkw[j];
          ss += kkr[j] * kkr[j];
          kp[j] = kf[j] * (1.f + (af[j] - 1.f) * kaw[j]);
          rks += rf[j] * kp[j] * rkw[j];
        }
        ss = rowsum16(ss);
        rks = rowsum16(rks);
        const float inv = 1.f / fmaxf(sqrtf(ss), 1e-12f);
        float* slot = ring + (c & 1) * RING_BUF + tok * RING_TS;
        float am[4], dc[4], bm[4], wr[4], br = 0.f, kr = 0.f;
#pragma unroll
        for (int j = 0; j < 4; ++j) {
          am[j] = -kkr[j] * inv;
          dc[j] = __expf(-ef[j]);
          bm[j] = kkr[j] * inv * af[j];
          wr[j] = dc[j] * rf[j];
          br += bm[j] * rf[j];
          kr += kp[j] * rf[j];
        }
        br = rowsum16(br);
        kr = rowsum16(kr);
        *(float4*)(slot + cq * 4) = make_float4(am[0], am[1], am[2], am[3]);
        *(float4*)(slot + 64 + cq * 4) = make_float4(dc[0], dc[1], dc[2], dc[3]);
        *(float4*)(slot + 128 + cq * 4) = make_float4(bm[0], bm[1], bm[2], bm[3]);
        *(float4*)(slot + 192 + cq * 4) = make_float4(kp[0], kp[1], kp[2], kp[3]);
        *(float4*)(slot + 256 + cq * 4) = make_float4(wr[0], wr[1], wr[2], wr[3]);
        if (cq == 0) *(float2*)(slot + 336) = make_float2(br, kr);
        if ((cq >> 2) == qr) *(float4*)(slot + 320 + (cq & 3) * 4) = make_float4(vf[0], vf[1], vf[2], vf[3]);
        if (cq == 0 && qr == 0) RK[(rowbase + (size_t)c * 16 + tok) * 16 + h] = rks;
      };
      pload(S0, 0);
      pproc(S0, 0);
      pload(S1, 1);
      pload(S0, 2);
      BAR_SYNC();
#pragma unroll 1
      for (int c = 0; c < 256; c += 2) {
        pproc(S1, c + 1);
        if (c + 3 < 256) pload(S1, c + 3);
        BAR_SYNC();
        if (c + 2 < 256) pproc(S0, c + 2);
        if (c + 4 < 256) pload(S0, c + 4);
        BAR_SYNC();
      }
    } else {
      const int rl = tid >> 4, cgp = tid & 15;
      float s0 = 0.f, s1 = 0.f, s2 = 0.f, s3 = 0.f;
      BAR_SYNC();
      for (int c = 0; c < 256; ++c) {
        if (c > 0) {
          const float yv = ybuf[((c - 1) & 1) * 256 + tid];
          Y[(rowbase + (size_t)(c - 1) * 16 + rl) * LDH + h * 64 + qr * 16 + cgp] = f2bf(yv);
        }
        const float* bufp = ring + (c & 1) * RING_BUF;
        float* yb = ybuf + (c & 1) * 256;
        struct SV {
          float4 a, w, b, k, wr;
          float v;
          float2 bk;
        };
        auto ldstep = [&](const float* slot) {
          SV r;
          r.a = *(const float4*)(slot + cgp * 4);
          r.w = *(const float4*)(slot + 64 + cgp * 4);
          r.b = *(const float4*)(slot + 128 + cgp * 4);
          r.k = *(const float4*)(slot + 192 + cgp * 4);
          r.wr = *(const float4*)(slot + 256 + cgp * 4);
          r.v = slot[320 + rl];
          r.bk = *(const float2*)(slot + 336);
          return r;
        };
        SV cur = ldstep(bufp);
#pragma unroll
        for (int tk = 0; tk < 16; ++tk) {
          SV nxt = cur;
          if (tk + 1 < 16) nxt = ldstep(bufp + (tk + 1) * RING_TS);
          float sa = s0 * cur.a.x + s1 * cur.a.y + s2 * cur.a.z + s3 * cur.a.w;
          float yw = s0 * cur.wr.x + s1 * cur.wr.y + s2 * cur.wr.z + s3 * cur.wr.w;
          const float t0 = s0 * cur.w.x + cur.v * cur.k.x;
          const float t1 = s1 * cur.w.y + cur.v * cur.k.y;
          const float t2 = s2 * cur.w.z + cur.v * cur.k.z;
          const float t3 = s3 * cur.w.w + cur.v * cur.k.w;
          sa = rowsum16(sa);
          yw = rowsum16(yw);
          s0 = t0 + sa * cur.b.x;
          s1 = t1 + sa * cur.b.y;
          s2 = t2 + sa * cur.b.z;
          s3 = t3 + sa * cur.b.w;
          const float y = yw + sa * cur.bk.x + cur.v * cur.bk.y;
          if (cgp == 0) yb[tk * 16 + rl] = y;
          cur = nxt;
        }
        BAR_SYNC();
      }
      {
        const float yv = ybuf[(255 & 1) * 256 + tid];
        Y[(rowbase + (size_t)255 * 16 + rl) * LDH + h * 64 + qr * 16 + cgp] = f2bf(yv);
      }
      float* wo = p.out + O_WKVP + (((size_t)(b * 16 + h) * 64) + qr * 16 + rl) * 64 + cgp * 4;
      *(float4*)wo = make_float4(s0, s1, s2, s3);
    }
  }
  float* sl = (float*)lds;
  for (int chain = blockIdx.x; chain < 2048; chain += gridDim.x) {
    const int b = chain >> 4, h = chain & 15;
    const size_t row = (size_t)NP + b;
    __syncthreads();
    if (w == 0) {
      const int ch = h * 64 + lane;
      const size_t off = row * 1024 + ch;
      const float rf = bf2f(R[off]), kf = bf2f(Kk[off]), vf = bf2f(V[off]), af = bf2f(Aa[off]), ef = h2f(EW[off]);
      const float kkr = kf * p.rw_kk[ch];
      const float ss = wavesum(kkr * kkr);
      const float inv = 1.f / fmaxf(sqrtf(ss), 1e-12f);
      const float kp = kf * (1.f + (af - 1.f) * p.rw_ka[ch]);
      const float rks = wavesum(rf * kp * p.rw_rk[ch]);
      sl[lane] = -kkr * inv;
      sl[64 + lane] = __expf(-ef);
      sl[128 + lane] = kkr * inv * af;
      sl[192 + lane] = kp;
      sl[256 + lane] = rf;
      sl[320 + lane] = vf;
      if (lane == 0) RK[row * 16 + h] = rks;
    }
    __syncthreads();
    const int i = tid >> 3, c8 = tid & 7;
    const float* sp = p.state_wkv + (((size_t)(b * 16 + h) * 64) + i) * 64 + c8 * 8;
    float4 sA = *(const float4*)sp, sB = *(const float4*)(sp + 4);
    float s[8] = {sA.x, sA.y, sA.z, sA.w, sB.x, sB.y, sB.z, sB.w};
    float sa = 0.f;
#pragma unroll
    for (int j = 0; j < 8; ++j) sa += s[j] * sl[c8 * 8 + j];
    sa += __shfl_xor(sa, 1);
    sa += __shfl_xor(sa, 2);
    sa += __shfl_xor(sa, 4);
    const float vv = sl[320 + i];
    float y = 0.f;
#pragma unroll
    for (int j = 0; j < 8; ++j) {
      const int cj = c8 * 8 + j;
      s[j] = s[j] * sl[64 + cj] + sa * sl[128 + cj] + vv * sl[192 + cj];
      y += s[j] * sl[256 + cj];
    }
    y += __shfl_xor(y, 1);
    y += __shfl_xor(y, 2);
    y += __shfl_xor(y, 4);
    float* wo = p.out + O_WKVS + (((size_t)(b * 16 + h) * 64) + i) * 64 + c8 * 8;
    *(float4*)wo = make_float4(s[0], s[1], s[2], s[3]);
    *(float4*)(wo + 4) = make_float4(s[4], s[5], s[6], s[7]);
    if (c8 == 0) Y[row * LDH + h * 64 + i] = f2bf(y);
  }
}

__device__ __forceinline__ void phase_gate(const Params& p, char* lds) {
  const u16* wt = (const u16*)(p.ws + WS_WT);
  const u16* GH = (const u16*)(p.ws + S_GH);
  const u16* V = (const u16*)(p.ws + S_V);
  const float* RK = (const float*)(p.ws + WS_RK);
  u16* Y = (u16*)(p.ws + WS_H);
  for (int t = blockIdx.x; t < 65 * 8; t += gridDim.x) {
    const int mt = t >> 3, nt = t & 7;
    const int m0 = mt * 256, n0 = nt * 128;
    gemm_tile<false>(GH, 128, nullptr, wt + WT_G2, 128, 1024, 128, m0, n0, lds, [&](EPI_ARGS) {
      const int hh = (n0 + wn * 64) >> 6;
#pragma unroll
      for (int mi = 0; mi < 8; ++mi) {
        const int row = m0 + wm * 128 + mi * 16 + lr;
        const int rowc = row < MROWS ? row : MROWS - 1;
        float yv[4][4];
        float sum = 0.f;
#pragma unroll
        for (int ni = 0; ni < 4; ++ni) {
          const uint2 yy = *(const uint2*)(Y + (size_t)rowc * LDH + hh * 64 + ni * 16 + lg * 4);
          yv[ni][0] = bflo(yy.x); yv[ni][1] = bfhi(yy.x); yv[ni][2] = bflo(yy.y); yv[ni][3] = bfhi(yy.y);
          sum += yv[ni][0] + yv[ni][1] + yv[ni][2] + yv[ni][3];
        }
        sum += __shfl_xor(sum, 16);
        sum += __shfl_xor(sum, 32);
        const float mu = sum * (1.f / 64.f);
        float vs = 0.f;
#pragma unroll
        for (int ni = 0; ni < 4; ++ni)
#pragma unroll
          for (int q = 0; q < 4; ++q) {
            const float d = yv[ni][q] - mu;
            vs += d * d;
          }
        vs += __shfl_xor(vs, 16);
        vs += __shfl_xor(vs, 32);
        const float rstd = rsqrtf(vs * (1.f / 64.f) + 64e-5f);
        const float rk = RK[(size_t)rowc * 16 + hh];
#pragma unroll
        for (int ni = 0; ni < 4; ++ni) {
          const int col0 = hh * 64 + ni * 16 + lg * 4;
          const uint2 vv = *(const uint2*)(V + (size_t)rowc * 1024 + col0);
          const float vf[4] = {bflo(vv.x), bfhi(vv.x), bflo(vv.y), bfhi(vv.y)};
          const float4 g4 = *(const float4*)(p.rw_lnx_g + col0), b4 = *(const float4*)(p.rw_lnx_b + col0);
          const float gg[4] = {g4.x, g4.y, g4.z, g4.w}, bb[4] = {b4.x, b4.y, b4.z, b4.w};
          f32x4 o;
#pragma unroll
          for (int q = 0; q < 4; ++q) o[q] = ((yv[ni][q] - mu) * rstd * gg[q] + bb[q] + rk * vf[q]) * acc[mi][ni][q];
          if (row < MROWS) *(uint2*)(Y + (size_t)row * LDH + col0) = pack4(o);
        }
        __builtin_amdgcn_sched_barrier(0);
      }
    });
  }
}

__device__ __forceinline__ void phase_oproj(const Params& p, char* lds, const u16* A, int K, const u16* Bt, int layer, int gidx, bool first) {
  const int ldab = K == 1024 ? LDH : LDU;
  const float* mod = (const float*)(p.ws + WS_MOD);
  for (int u = blockIdx.x; u < 320; u += gridDim.x) {
    const bool split = u >= 256;
    const int s = u - 256;
    const int m0 = split ? NP : (u >> 2) * 256, n0 = (split ? (s & 3) : (u & 3)) * 256;
    const int klen = split ? (K >> 4) : K, kbeg = split ? (s >> 2) * klen : 0;
    gemm_tile256(A + kbeg, ldab, Bt + kbeg, ldab, klen, m0, n0, lds, [&](EPI_ARGS) {
      EPI_FOREACH(acc, if (row < MROWS) {
        const float4 gt = *(const float4*)(mod + ((size_t)layer * 132 + bidx_of(row)) * 6144 + gidx * 1024 + col0);
        float* xp = p.out + (size_t)row * 1024 + col0;
        if (split) {
          unsafeAtomicAdd(xp + 0, gt.x * v[0]);
          unsafeAtomicAdd(xp + 1, gt.y * v[1]);
          unsafeAtomicAdd(xp + 2, gt.z * v[2]);
          unsafeAtomicAdd(xp + 3, gt.w * v[3]);
        } else {
          const float* xi = first ? p.x_prompt + (size_t)row * 1024 + col0 : xp;
          const float4 xo = *(const float4*)xi;
          *(float4*)xp = make_float4(xo.x + gt.x * v[0], xo.y + gt.y * v[1], xo.z + gt.z * v[2], xo.w + gt.w * v[3]);
        }
      })
    });
  }
}

__device__ __forceinline__ void phase_up(const Params& p, char* lds, const u16* Bt) {
  const u16* H = (const u16*)(p.ws + WS_H);
  u16* UP = (u16*)(p.ws + S_UP);
  for (int t = blockIdx.x; t < 65 * 16; t += gridDim.x) {
    const int mt = t >> 4, nt = t & 15;
    const int m0 = mt * 256, n0 = nt * 256;
    gemm_tile256(H, LDH, Bt, LDH, 1024, m0, n0, lds, [&](EPI_ARGS) {
      EPI_FOREACH(acc, if (row < MROWS) {
        f32x4 o;
        _Pragma("unroll") for (int q = 0; q < 4; ++q) {
          const float rl = fmaxf(v[q], 0.f);
          o[q] = rl * rl;
        }
        *(uint2*)(UP + (size_t)row * LDU + col0) = pack4(o);
      })
    });
  }
}

__device__ __forceinline__ void phase_qkv(const Params& p, char* lds) {
  const u16* H = (const u16*)(p.ws + WS_H);
  const u16* wt = (const u16*)(p.ws + WS_WT);
  const float* tab = (const float*)(p.ws + WS_TAB);
  u16* Qb = (u16*)(p.ws + S_Q);
  u16* Kb = (u16*)(p.ws + S_KB);
  u16* Vt = (u16*)(p.ws + S_VT);
  for (int t = blockIdx.x; t < 65 * 12; t += gridDim.x) {
    const int mt = t / 12, nt = t % 12;
    const int m0 = mt * 256, n0 = nt * 128;
    gemm_tile<false>(H, LDH, nullptr, wt + WT_QKV, LDH, 1536, 1024, m0, n0, lds, [&](EPI_ARGS) {
      const int hc0 = n0 + wn * 64;
#pragma unroll
      for (int mi = 0; mi < 8; ++mi) {
        const int row = m0 + wm * 128 + mi * 16 + lr;
        const bool valid = row < MROWS;
        const bool isp = row < NP;
        const int pos = row & 4095;
        const int bq = isp ? (row >> 12) : (row - NP);
        const int posidx = isp ? pos : 4096;
#pragma unroll
        for (int ni = 0; ni < 4; ++ni) {
          const int col0 = hc0 + ni * 16 + lg * 4;
          const float4 b4 = *(const float4*)(p.at_bqkv + col0);
          f32x4 v = acc[mi][ni];
          v[0] += b4.x; v[1] += b4.y; v[2] += b4.z; v[3] += b4.w;
          if (ni == 0 && hc0 < 1280) {
            const float* tp = tab + (size_t)posidx * 16 + (lg & 1) * 8;
            const float4 t0 = *(const float4*)tp, t1 = *(const float4*)(tp + 4);
            const float cs[4] = {t0.x, t0.z, t1.x, t1.z}, sn[4] = {t0.y, t0.w, t1.y, t1.w};
#pragma unroll
            for (int q = 0; q < 4; ++q) {
              const float pv = __shfl_xor(v[q], 32);
              v[q] = (lg < 2) ? (v[q] * cs[q] - pv * sn[q]) : (v[q] * cs[q] + pv * sn[q]);
            }
          }
          if (valid) {
            if (hc0 < 1024) {
              *(uint2*)(Qb + (size_t)row * 1024 + col0) = pack4(v);
            } else if (hc0 < 1280) {
              const int c2 = col0 - 1024;
              *(uint2*)(Kb + (size_t)row * 256 + c2) = pack4(v);
              if (isp) {
                if (pos >= 3968) *(float4*)(p.out + O_KP + ((size_t)(bq * 128 + pos - 3968)) * 256 + c2) = make_float4(v[0], v[1], v[2], v[3]);
              } else {
                *(float4*)(p.out + O_KS + ((size_t)(bq * 128 + 127)) * 256 + c2) = make_float4(v[0], v[1], v[2], v[3]);
              }
            } else {
              const int c3 = col0 - 1280;
              if (isp) {
                u16* vp = Vt + ((size_t)(bq * 4 + (c3 >> 6)) * 64 + (c3 & 63)) * 4096 + pos;
#pragma unroll
                for (int q = 0; q < 4; ++q) vp[(size_t)q * 4096] = f2bf(v[q]);
                if (pos >= 3968) *(float4*)(p.out + O_VP + ((size_t)(bq * 128 + pos - 3968)) * 256 + c3) = make_float4(v[0], v[1], v[2], v[3]);
              } else {
                *(float4*)(p.out + O_VS + ((size_t)(bq * 128 + 127)) * 256 + c3) = make_float4(v[0], v[1], v[2], v[3]);
              }
            }
          }
        }
        __builtin_amdgcn_sched_barrier(0);
      }
    });
  }
}

constexpr int AT_KS = 0, AT_VS = 36864, AT_PS = 36864 + 35840, AT_PW = 5376;

__device__ __forceinline__ void phase_attn(const Params& p, char* lds) {
  const int tid = threadIdx.x, lane = tid & 63, w = tid >> 6, lr = lane & 15, lg = lane >> 4;
  const u16* Qb = (const u16*)(p.ws + S_Q);
  const u16* Kb = (const u16*)(p.ws + S_KB);
  const u16* Vt = (const u16*)(p.ws + S_VT);
  u16* O = (u16*)(p.ws + S_O);
  char* Ks = lds + AT_KS;
  char* Vs = lds + AT_VS;
  char* Ps = lds + AT_PS + w * AT_PW;
  for (int u = blockIdx.x; u < 512; u += gridDim.x) {
    const int b = u >> 7, n = (u >> 2) & 31, kvh = u & 3;
    __syncthreads();
#pragma unroll
    for (int i = 0; i < 4; ++i) {
      const int c = tid + 512 * i;
      {
        const int key = c >> 3, kc = c & 7;
        const int pos = n * 128 - 128 + key;
        uint4 v = {0u, 0u, 0u, 0u};
        if (pos >= 0) v = *(const uint4*)(Kb + ((size_t)b * 4096 + pos) * 256 + kvh * 64 + kc * 8);
        *(uint4*)(Ks + key * 144 + kc * 16) = v;
      }
      {
        const int d = c >> 5, kc = c & 31;
        const int pos0 = n * 128 - 128 + kc * 8;
        uint4 v = {0u, 0u, 0u, 0u};
        if (pos0 >= 0) v = *(const uint4*)(Vt + ((size_t)(b * 4 + kvh) * 64 + d) * 4096 + pos0);
        *(uint4*)(Vs + d * 560 + kc * 16) = v;
      }
    }
    if (tid < 192) {
      const int d = tid / 3, c = tid % 3;
      *(uint4*)(Vs + d * 560 + 512 + c * 16) = uint4{0u, 0u, 0u, 0u};
    }
    {
      const int prow = lane >> 2, pc = 144 + (lane & 3) * 4;
      *(uint2*)(Ps + prow * 336 + pc * 2) = uint2{0u, 0u};
    }
    __syncthreads();
    const int g = w >> 1, hf = w & 1;
    const int qh = kvh * 4 + g;
    const float sink = p.at_sink[qh];
#pragma unroll 1
    for (int i = 0; i < 4; ++i) {
      const int q0 = hf * 64 + i * 16;
      const size_t tok = (size_t)b * 4096 + n * 128 + q0 + lr;
      const bf16x8 qf0 = *(const bf16x8*)(Qb + tok * 1024 + qh * 64 + lg * 8);
      const bf16x8 qf1 = *(const bf16x8*)(Qb + tok * 1024 + qh * 64 + 32 + lg * 8);
      f32x4 s[9];
#pragma unroll
      for (int j = 0; j < 9; ++j) {
        const char* kp = Ks + (q0 + j * 16 + lr) * 144 + lg * 16;
        const bf16x8 k0 = *(const bf16x8*)kp;
        const bf16x8 k1 = *(const bf16x8*)(kp + 64);
        f32x4 z = {0.f, 0.f, 0.f, 0.f};
        z = __builtin_amdgcn_mfma_f32_16x16x32_bf16(qf0, k0, z, 0, 0, 0);
        z = __builtin_amdgcn_mfma_f32_16x16x32_bf16(qf1, k1, z, 0, 0, 0);
        s[j] = z;
      }
      float mx[4], sum[4];
#pragma unroll
      for (int r = 0; r < 4; ++r) {
        const int ql = lg * 4 + r;
        float m = sink;
#pragma unroll
        for (int j = 0; j < 9; ++j) {
          float v = s[j][r] * 0.125f;
          bool ok = true;
          if (j == 0) ok = (lr >= ql);
          if (j == 8) ok = (lr <= ql);
          if (n == 0 && (q0 + j * 16 + lr) < 128) ok = false;
          v = ok ? v : -INFINITY;
          s[j][r] = v;
          m = fmaxf(m, v);
        }
        mx[r] = rowmax16(m);
      }
#pragma unroll
      for (int r = 0; r < 4; ++r) {
        float sm = 0.f;
#pragma unroll
        for (int j = 0; j < 9; ++j) {
          const float e = __expf(s[j][r] - mx[r]);
          s[j][r] = e;
          sm += e;
        }
        sm = rowsum16(sm);
        sum[r] = sm + __expf(sink - mx[r]);
      }
      u16* P = (u16*)Ps;
#pragma unroll
      for (int j = 0; j < 9; ++j)
#pragma unroll
        for (int r = 0; r < 4; ++r) P[(lg * 4 + r) * 168 + j * 16 + lr] = f2bf(s[j][r]);
      __builtin_amdgcn_wave_barrier();
      f32x4 o[4];
#pragma unroll
      for (int nd = 0; nd < 4; ++nd) o[nd] = f32x4{0.f, 0.f, 0.f, 0.f};
#pragma unroll
      for (int kk = 0; kk < 5; ++kk) {
        const bf16x8 pf = *(const bf16x8*)(Ps + lr * 336 + kk * 64 + lg * 16);
#pragma unroll
        for (int nd = 0; nd < 4; ++nd) {
          const bf16x8 vf = *(const bf16x8*)(Vs + (nd * 16 + lr) * 560 + (q0 + kk * 32 + lg * 8) * 2);
          o[nd] = __builtin_amdgcn_mfma_f32_16x16x32_bf16(pf, vf, o[nd], 0, 0, 0);
        }
      }
#pragma unroll
      for (int nd = 0; nd < 4; ++nd)
#pragma unroll
        for (int r = 0; r < 4; ++r) {
          const float v = o[nd][r] / sum[r];
          O[((size_t)b * 4096 + n * 128 + q0 + lg * 4 + r) * LDH + qh * 64 + nd * 16 + lr] = f2bf(v);
        }
      __builtin_amdgcn_wave_barrier();
    }
  }
  float* qs = (float*)lds;
  float* sc = (float*)(lds + 1024);
  float* part = (float*)(lds + 1024 + 2112);
  for (int it = blockIdx.x; it < 512; it += gridDim.x) {
    const int b = it >> 2, kvh = it & 3;
    const size_t row = (size_t)NP + b;
    __syncthreads();
    if (tid < 256) qs[tid] = bf2f(Qb[row * 1024 + kvh * 256 + tid]);
    __syncthreads();
    {
      const int key = tid >> 2, g = tid & 3;
      const float* kp = p.cache_k + (((size_t)b * 128 + key) * 4 + kvh) * 64;
      float dot = 0.f;
#pragma unroll
      for (int d4 = 0; d4 < 16; ++d4) {
        const float4 kv = *(const float4*)(kp + d4 * 4);
        const float* q = qs + g * 64 + d4 * 4;
        dot += kv.x * q[0] + kv.y * q[1] + kv.z * q[2] + kv.w * q[3];
      }
      sc[g * 132 + key] = dot * 0.125f;
      if (key >= 1) {
        float* dst = p.out + O_KS + (((size_t)b * 128 + key - 1) * 4 + kvh) * 64 + g * 16;
        const float* src = kp + g * 16;
#pragma unroll
        for (int d4 = 0; d4 < 4; ++d4) *(float4*)(dst + d4 * 4) = *(const float4*)(src + d4 * 4);
      }
      if (tid < 4) {
        const float* kn = p.out + O_KS + (((size_t)b * 128 + 127) * 4 + kvh) * 64;
        float d2 = 0.f;
        for (int d = 0; d < 64; ++d) d2 += kn[d] * qs[tid * 64 + d];
        sc[tid * 132 + 128] = d2 * 0.125f;
      }
    }
    __syncthreads();
    if (w < 4) {
      const float sink = p.at_sink[kvh * 4 + w];
      float* s = sc + w * 132;
      const float v0 = s[lane], v1 = s[64 + lane], v2 = lane == 0 ? s[128] : -INFINITY;
      float m = fmaxf(fmaxf(v0, v1), fmaxf(v2, sink));
      m = wavemax(m);
      const float e0 = __expf(v0 - m), e1 = __expf(v1 - m), e2 = lane == 0 ? __expf(v2 - m) : 0.f;
      float sm = wavesum(e0 + e1 + e2) + __expf(sink - m);
      const float inv = 1.f / sm;
      s[lane] = e0 * inv;
      s[64 + lane] = e1 * inv;
      if (lane == 0) s[128] = e2 * inv;
    }
    __syncthreads();
    {
      const int d = tid & 63, g = (tid >> 6) & 3, half = tid >> 8;
      const float* vp = p.cache_v + (((size_t)b * 128) * 4 + kvh) * 64 + d;
      float accv = 0.f;
      for (int key = half * 64; key < half * 64 + 64; ++key) {
        const float vv = vp[(size_t)key * 256];
        accv += sc[g * 132 + key] * vv;
        if (g == 0 && key >= 1) p.out[O_VS + (((size_t)b * 128 + key - 1) * 4 + kvh) * 64 + d] = vv;
      }
      if (half == 1) accv += sc[g * 132 + 128] * p.out[O_VS + (((size_t)b * 128 + 127) * 4 + kvh) * 64 + d];
      part[(half * 4 + g) * 64 + d] = accv;
    }
    __syncthreads();
    if (tid < 256) {
      const int d = tid & 63, g = tid >> 6;
      O[row * LDH + (kvh * 4 + g) * 64 + d] = f2bf(part[g * 64 + d] + part[(4 + g) * 64 + d]);
    }
  }
}

__global__ void __launch_bounds__(NTHR) mega(Params p) {
  extern __shared__ __attribute__((aligned(16))) char lds[];
  cg::grid_group grid = cg::this_grid();
  volatile LAS unsigned* xst = (volatile LAS unsigned*)(lds + LDS_BYTES);
  if (threadIdx.x == 0) { xst[0] = 0u; xst[1] = 0u; }
  __syncthreads();
  const XcdBarrier xb = xcd_barrier_post((unsigned*)(p.ws + WS_BAR), xst);
  const u16* wt = (const u16*)(p.ws + WS_WT);
  phase0(p, lds);
  grid.sync();
  phase_ada(p, lds);
  xcd_barrier(xb);
  phase_norm(p, 0, 0, true, true);
  xcd_barrier(xb);
  phase_rwkv_proj(p, lds);
  xcd_barrier(xb);
  phase_rwkv_lora2(p, lds);
  xcd_barrier(xb);
  phase_scan(p, lds);
  xcd_barrier(xb);
  phase_gate(p, lds);
  xcd_barrier(xb);
  phase_oproj(p, lds, (const u16*)(p.ws + WS_H), 1024, wt + WT_WO, 0, 2, true);
  xcd_barrier(xb);
  phase_norm(p, 0, 1, false, false);
  xcd_barrier(xb);
  phase_up(p, lds, wt + WT_UP0);
  xcd_barrier(xb);
  phase_oproj(p, lds, (const u16*)(p.ws + S_UP), 4096, wt + WT_DN0, 0, 5, false);
  xcd_barrier(xb);
  phase_norm(p, 1, 0, false, false);
  xcd_barrier(xb);
  phase_qkv(p, lds);
  xcd_barrier(xb);
  phase_attn(p, lds);
  xcd_barrier(xb);
  phase_oproj(p, lds, (const u16*)(p.ws + S_O), 1024, wt + WT_WO1, 1, 2, false);
  xcd_barrier(xb);
  phase_norm(p, 1, 1, false, false);
  xcd_barrier(xb);
  phase_up(p, lds, wt + WT_UP1);
  xcd_barrier(xb);
  phase_oproj(p, lds, (const u16*)(p.ws + S_UP), 4096, wt + WT_DN1, 1, 5, false);
  xcd_barrier(xb);
  phase_final(p);
}

extern "C" void kernel_launch(void* const* d_in, const int* in_sizes, int n_in, void* d_out, int out_size, void* d_ws,
                              size_t ws_size, hipStream_t stream) {
  static int grid_blocks = 0;
  if (grid_blocks == 0) {
    if (ws_size < WS_END) {
      fprintf(stderr, "kernel_launch: workspace too small: %zu < %zu\n", ws_size, (size_t)WS_END);
      grid_blocks = -1;
      return;
    }
    int dev = 0, cus = 0, per_cu = 0;
    hipGetDevice(&dev);
    hipDeviceGetAttribute(&cus, hipDeviceAttributeMultiprocessorCount, dev);
    hipFuncSetAttribute((const void*)mega, hipFuncAttributeMaxDynamicSharedMemorySize, LDS_BYTES + 16);
    hipOccupancyMaxActiveBlocksPerMultiprocessor(&per_cu, (const void*)mega, NTHR, LDS_BYTES + 16);
    if (per_cu < 1) per_cu = 1;
    grid_blocks = cus * per_cu;
  }
  if (grid_blocks < 0) return;
  Params p{};
  const float** pp = (const float**)&p;
  for (int i = 0; i < 37; ++i) pp[i] = (const float*)d_in[i];
  p.out = (float*)d_out;
  p.ws = (char*)d_ws;
  hipMemsetAsync((char*)d_ws + WS_BAR, 0, 16384, stream);
  void* args[] = {&p};
  hipError_t e = hipLaunchCooperativeKernel((const void*)mega, dim3(grid_blocks), dim3(NTHR), args, LDS_BYTES + 16, stream);
  if (e != hipSuccess) fprintf(stderr, "cooperative launch failed: %s (grid %d)\n", hipGetErrorString(e), grid_blocks);
}
```

```cpp
#include <hip/hip_runtime.h>
#include <hip/hip_cooperative_groups.h>
#include <cstdio>
namespace cg = cooperative_groups;

typedef unsigned short u16;
typedef __attribute__((ext_vector_type(8))) short bf16x8;
typedef __attribute__((ext_vector_type(4))) float f32x4;

constexpr int NP = 16384, MROWS = 16512, MPAD = 16640;
constexpr int NTHR = 512;
constexpr size_t MEG = 1048576;
constexpr int LDH = 1088, LDU = 4160;

constexpr size_t O_Y = 0, O_WKVP = 16908288, O_WKVS = 17170432, O_SHP = 25559040, O_SHS = 25563136,
                 O_KP = 25694208, O_KS = 25825280, O_VP = 30019584, O_VS = 30150656;

constexpr size_t WT_WR = 0, WT_WK = WT_WR + 1024 * LDH, WT_WV = WT_WK + 1024 * LDH, WT_WO = WT_WV + 1024 * LDH,
                 WT_W1 = WT_WO + 1024 * LDH, WT_A1 = WT_W1 + 64 * LDH, WT_G1 = WT_A1 + 64 * LDH, WT_W2 = WT_G1 + 128 * LDH,
                 WT_A2 = WT_W2 + 65536, WT_G2 = WT_A2 + 65536, WT_UP0 = WT_G2 + 131072, WT_DN0 = WT_UP0 + 4096 * LDH,
                 WT_QKV = WT_DN0 + 1024 * LDU, WT_WO1 = WT_QKV + 1536 * LDH, WT_UP1 = WT_WO1 + 1024 * LDH,
                 WT_DN1 = WT_UP1 + 4096 * LDH, WT_END = WT_DN1 + 1024 * LDU;
constexpr size_t WS_WT = 0;
constexpr size_t WS_H = WS_WT + WT_END * 2;
constexpr size_t WS_ZR = WS_H + (size_t)MPAD * LDH * 2;
constexpr size_t WS_MOD = WS_ZR + (size_t)LDH * 2;
constexpr size_t WS_TAB = WS_MOD + (size_t)2 * 132 * 6144 * 4;
constexpr size_t WS_HS = WS_H + (size_t)MROWS * LDH * 2;
constexpr size_t WS_RK = WS_TAB + (size_t)4097 * 8 * 8;
constexpr size_t WS_BAR = WS_RK + (size_t)MPAD * 16 * 4;
constexpr size_t WS_S = WS_BAR + 16384;
constexpr size_t RSZ = (size_t)MROWS * 1024 * 2;
constexpr size_t S_ADAWT = WS_S, S_SILUC = S_ADAWT + (size_t)2 * 6144 * LDH * 2;
constexpr size_t S_R = WS_S, S_K = S_R + RSZ, S_V = S_K + RSZ, S_EW = S_V + RSZ, S_A = S_EW + RSZ,
                 S_WH = S_A + RSZ, S_AH = S_WH + (size_t)MPAD * 64 * 2, S_GH = S_AH + (size_t)MPAD * 64 * 2,
                 S_RW_END = S_GH + (size_t)MPAD * 128 * 2;
constexpr size_t S_UP = WS_S;
constexpr size_t S_Q = WS_S, S_O = S_Q + (size_t)MPAD * 1024 * 2, S_KB = S_O + (size_t)MPAD * LDH * 2,
                 S_VT = S_KB + (size_t)MPAD * 256 * 2;
constexpr size_t WS_END = S_RW_END;
static_assert(S_UP + (size_t)MPAD * LDU * 2 <= WS_END, "up fits");
static_assert(S_VT + (size_t)16 * 64 * 4096 * 2 <= WS_END, "attn fits");
static_assert(WS_END <= 282000000, "ws fits sum of inputs");

constexpr int LDS_ROW = 144;
constexpr int LDS_A_BYTES = 256 * LDS_ROW;
constexpr int LDS_B_BYTES = 128 * LDS_ROW;
constexpr int LDS_STAGE = LDS_A_BYTES + LDS_B_BYTES;
constexpr int LDS_BYTES = 147456;

struct Params {
  const float *x_prompt, *x_sample, *c_prompt, *c_sample, *state_wkv, *state_shift, *cache_k, *cache_v;
  const float *norm1_g, *norm2_g, *ada_w, *ada_b, *mlp_up, *mlp_down, *final_g;
  const float *rw_mix, *rw_wr, *rw_wk, *rw_wv, *rw_wo, *rw_w0, *rw_w1, *rw_w2, *rw_a0, *rw_a1, *rw_a2, *rw_g1, *rw_g2,
      *rw_kk, *rw_ka, *rw_rk, *rw_lnx_g, *rw_lnx_b;
  const float *at_wqkv, *at_bqkv, *at_wo, *at_sink;
  float* out;
  char* ws;
};

__device__ __forceinline__ u16 f2bf(float f) {
  unsigned u = __float_as_uint(f);
  u += 0x7fffu + ((u >> 16) & 1u);
  return (u16)(u >> 16);
}
__device__ __forceinline__ float bf2f(u16 h) { return __uint_as_float(((unsigned)h) << 16); }
__device__ __forceinline__ float bflo(unsigned w) { return __uint_as_float(w << 16); }
__device__ __forceinline__ float bfhi(unsigned w) { return __uint_as_float(w & 0xffff0000u); }
__device__ __forceinline__ unsigned pack2(float a, float b) {
  unsigned r;
  asm volatile("v_cvt_pk_bf16_f32 %0, %1, %2" : "=v"(r) : "v"(a), "v"(b));
  return r;
}
__device__ __forceinline__ uint2 pack4(f32x4 v) { return uint2{pack2(v[0], v[1]), pack2(v[2], v[3])}; }
__device__ __forceinline__ float h2f(u16 h) { return (float)__builtin_bit_cast(_Float16, h); }
__device__ __forceinline__ u16 f2h(float f) { return __builtin_bit_cast(u16, (_Float16)f); }
__device__ __forceinline__ float sigmoidf_(float x) { return 1.f / (1.f + __expf(-x)); }

template <int CTRL>
__device__ __forceinline__ float dppf(float x) {
  return __int_as_float(__builtin_amdgcn_update_dpp(0, __float_as_int(x), CTRL, 0xf, 0xf, true));
}
__device__ __forceinline__ float rowsum16(float x) {
  x += dppf<0xB1>(x);
  x += dppf<0x4E>(x);
  x += dppf<0x124>(x);
  x += dppf<0x128>(x);
  return x;
}
__device__ __forceinline__ float rowmax16(float x) {
  x = fmaxf(x, dppf<0xB1>(x));
  x = fmaxf(x, dppf<0x4E>(x));
  x = fmaxf(x, dppf<0x124>(x));
  x = fmaxf(x, dppf<0x128>(x));
  return x;
}
__device__ __forceinline__ float wavesum(float x) {
#pragma unroll
  for (int o = 32; o > 0; o >>= 1) x += __shfl_xor(x, o);
  return x;
}
__device__ __forceinline__ float wavemax(float x) {
#pragma unroll
  for (int o = 32; o > 0; o >>= 1) x = fmaxf(x, __shfl_xor(x, o));
  return x;
}
__device__ __forceinline__ int bidx_of(int row) { return row < NP ? (row >> 12) : (4 + row - NP); }

#define XB_TMO      128
#define XB_XCNT(j)  (256  + 64 * (j))
#define XB_XSUB(j)  (1280 + 64 * (j))
#define XB_XGEN(j)  (2304 + 64 * (j))
#define XB_TOP      3328
#define XB_TOPGEN   3392
#define XCD_BAR_WORDS 3456
#define XB_SPIN_CAP (1u << 22)
#define LAS __attribute__((address_space(3)))
__device__ __forceinline__ unsigned xb_ld(unsigned* p) { return __hip_atomic_load(p, __ATOMIC_RELAXED, __HIP_MEMORY_SCOPE_AGENT); }
__device__ __forceinline__ unsigned xb_add(unsigned* p, unsigned v) { return __hip_atomic_fetch_add(p, v, __ATOMIC_RELAXED, __HIP_MEMORY_SCOPE_AGENT); }
__device__ __forceinline__ unsigned xb_xcc_id() { return (unsigned)__builtin_amdgcn_s_getreg((3 << 11) | 20) & 0xFu; }
#define XB_SPIN(cond, bar) do { unsigned _sp = 0; while (cond) { __builtin_amdgcn_s_sleep(1); \
    if ((++_sp & 255u) == 0u) { if (xb_ld(&(bar)[XB_TMO])) break; if (_sp > XB_SPIN_CAP) { atomicAdd(&(bar)[XB_TMO], 1u); break; } } } } while (0)
struct XcdBarrier {
  unsigned* bar;
  unsigned x;
  volatile LAS unsigned* st;
};
__device__ __forceinline__ XcdBarrier xcd_barrier_post(unsigned* bar, volatile LAS unsigned* st) {
  XcdBarrier b;
  b.bar = bar;
  b.x = xb_xcc_id();
  b.st = st;
  if (threadIdx.x == 0) (void)xb_add(&bar[XB_XCNT(b.x)], 1u);
  return b;
}
__device__ __forceinline__ void xcd_barrier_complete(unsigned* bar, unsigned x, unsigned& nloc, unsigned& nx) {
  const unsigned G = gridDim.x * gridDim.y * gridDim.z;
  unsigned sum, cnt, mine, sp = 0u;
  for (;;) {
    sum = 0u; cnt = 0u; mine = 0u;
#pragma unroll
    for (unsigned j = 0; j < 16; ++j) {
      const unsigned c = xb_ld(&bar[XB_XCNT(j)]);
      sum += c;
      cnt += (c > 0u) ? 1u : 0u;
      mine = (j == x) ? c : mine;
    }
    if (sum == G) break;
    __builtin_amdgcn_s_sleep(1);
    if ((++sp & 255u) == 0u) {
      if (xb_ld(&bar[XB_TMO])) break;
      if (sp > XB_SPIN_CAP) { atomicAdd(&bar[XB_TMO], 1u); break; }
    }
  }
  nloc = mine > 0u ? mine : 1u;
  nx = cnt > 0u ? cnt : 1u;
}
__device__ __forceinline__ void xcd_barrier(const XcdBarrier& b) {
  asm volatile("s_waitcnt vmcnt(0)" ::: "memory");
  __syncthreads();
  if (threadIdx.x == 0) {
    unsigned* bar = b.bar;
    __builtin_amdgcn_s_waitcnt(0);
    unsigned nloc = b.st[0], nx = b.st[1];
    if (nloc == 0u) { xcd_barrier_complete(bar, b.x, nloc, nx); b.st[0] = nloc; b.st[1] = nx; }
    const unsigned old = xb_add(&bar[XB_XSUB(b.x)], 1u);
    const unsigned gen = old / nloc;
    if (old + 1u == (gen + 1u) * nloc) {
      __builtin_amdgcn_fence(__ATOMIC_RELEASE, "agent");
      asm volatile("s_waitcnt vmcnt(0)" ::: "memory");
      const unsigned og = xb_add(&bar[XB_TOP], 1u);
      const unsigned tg = og / nx;
      if (og + 1u == (tg + 1u) * nx) xb_add(&bar[XB_TOPGEN], 1u);
      else XB_SPIN(xb_ld(&bar[XB_TOPGEN]) == tg, bar);
      __builtin_amdgcn_fence(__ATOMIC_ACQUIRE, "agent");
      xb_add(&bar[XB_XGEN(b.x)], 1u);
      asm volatile("s_waitcnt vmcnt(0)" ::: "memory");
    } else {
      XB_SPIN(xb_ld(&bar[XB_XGEN(b.x)]) == gen, bar);
      __builtin_amdgcn_fence(__ATOMIC_ACQUIRE, "agent");
      asm volatile("s_waitcnt vmcnt(0)" ::: "memory");
    }
  }
  __syncthreads();
}

#define BAR_SYNC() do { asm volatile("s_waitcnt lgkmcnt(0)" ::: "memory"); __builtin_amdgcn_s_barrier(); asm volatile("" ::: "memory"); } while (0)

__device__ __forceinline__ unsigned mix2(unsigned h, unsigned p, float m0, float m1) {
  float h0 = bflo(h), h1 = bfhi(h), p0 = bflo(p), p1 = bfhi(p);
  return pack2(h0 + (p0 - h0) * m0, h1 + (p1 - h1) * m1);
}

template <bool MIX, class Epi>
__device__ __forceinline__ void gemm_tile(const u16* __restrict__ A, int lda, const float* __restrict__ mixv,
                                          const u16* __restrict__ Bt, int ldb, int N, int K, int m0, int n0, char* lds, Epi&& epi) {
  const int tid = threadIdx.x, lane = tid & 63, w = tid >> 6;
  const int nk = K >> 6;
  if (w >= 4) {
    const int pt = tid - 256, kc = pt & 7, pr = pt >> 3;
    const u16* Ab = A + (size_t)m0 * lda + (size_t)pr * lda + kc * 8;
    int poff[8];
#pragma unroll
    for (int i = 0; i < 8; ++i) {
      poff[i] = 0;
      if (MIX) {
        const int row = m0 + pr + 32 * i;
        const int prow = row < NP ? ((row & 4095) ? row - 1 : MPAD) : (row < MROWS ? row + 128 : MPAD);
        poff[i] = prow * LDH + kc * 8;
      }
    }
    bool bv[4];
    const u16* bp[4];
#pragma unroll
    for (int j = 0; j < 4; ++j) {
      const int n = n0 + pr + 32 * j;
      bv[j] = n < N;
      bp[j] = Bt + (size_t)(bv[j] ? n : 0) * ldb + kc * 8;
    }
    struct RSet {
      uint4 ra[8], rp[8], rb[4];
      float4 mx0, mx1;
    };
    RSet SA, SB;
    auto gload = [&](RSet& S, int kt) {
      const int ko = kt * 64;
#pragma unroll
      for (int i = 0; i < 8; ++i) {
        S.ra[i] = *(const uint4*)(Ab + (size_t)(32 * i) * lda + ko);
        if (MIX) S.rp[i] = *(const uint4*)(A + poff[i] + ko);
      }
      if (MIX) {
        S.mx0 = *(const float4*)(mixv + ko + kc * 8);
        S.mx1 = *(const float4*)(mixv + ko + kc * 8 + 4);
      }
#pragma unroll
      for (int j = 0; j < 4; ++j) {
        uint4 z = {0u, 0u, 0u, 0u};
        if (bv[j]) z = *(const uint4*)(bp[j] + ko);
        S.rb[j] = z;
      }
    };
    auto lstore = [&](RSet& S, int s) {
      char* base = lds + s * LDS_STAGE + pr * LDS_ROW + kc * 16;
#pragma unroll
      for (int i = 0; i < 8; ++i) {
        uint4 v = S.ra[i];
        if (MIX) {
          v.x = mix2(S.ra[i].x, S.rp[i].x, S.mx0.x, S.mx0.y);
          v.y = mix2(S.ra[i].y, S.rp[i].y, S.mx0.z, S.mx0.w);
          v.z = mix2(S.ra[i].z, S.rp[i].z, S.mx1.x, S.mx1.y);
          v.w = mix2(S.ra[i].w, S.rp[i].w, S.mx1.z, S.mx1.w);
        }
        *(uint4*)(base + (32 * i) * LDS_ROW) = v;
      }
#pragma unroll
      for (int j = 0; j < 4; ++j) *(uint4*)(base + LDS_A_BYTES + (32 * j) * LDS_ROW) = S.rb[j];
    };
    if constexpr (!MIX) {
      gload(SB, 0);
      if (nk > 1) gload(SA, 1);
      lstore(SB, 0);
      if (nk > 2) gload(SB, 2);
      BAR_SYNC();
#pragma unroll 1
      for (int kt = 0; kt < nk; kt += 2) {
        if (kt + 1 < nk) {
          lstore(SA, 1);
          if (kt + 3 < nk) gload(SA, kt + 3);
        }
        BAR_SYNC();
        if (kt + 1 < nk) {
          if (kt + 2 < nk) {
            lstore(SB, 0);
            if (kt + 4 < nk) gload(SB, kt + 4);
          }
          BAR_SYNC();
        }
      }
    } else {
      gload(SA, 0);
      lstore(SA, 0);
      if (nk > 1) gload(SA, 1);
      BAR_SYNC();
#pragma unroll 1
      for (int kt = 0; kt < nk; ++kt) {
        if (kt + 1 < nk) {
          lstore(SA, (kt + 1) & 1);
          if (kt + 2 < nk) gload(SA, kt + 2);
        }
        BAR_SYNC();
      }
    }
  } else {
    const int wm = w >> 1, wn = w & 1, lr = lane & 15, lg = lane >> 4;
    f32x4 acc[8][4];
#pragma unroll
    for (int i = 0; i < 8; ++i)
#pragma unroll
      for (int j = 0; j < 4; ++j) acc[i][j] = f32x4{0.f, 0.f, 0.f, 0.f};
    BAR_SYNC();
#pragma unroll 1
    for (int kt = 0; kt < nk; ++kt) {
      const char* sa = lds + (kt & 1) * LDS_STAGE + (wm * 128 + lr) * LDS_ROW + lg * 16;
      const char* sb = lds + (kt & 1) * LDS_STAGE + LDS_A_BYTES + (wn * 64 + lr) * LDS_ROW + lg * 16;
      bf16x8 bq[2][4], aq[3];
#pragma unroll
      for (int ni = 0; ni < 4; ++ni) bq[0][ni] = *(const bf16x8*)(sb + ni * 16 * LDS_ROW);
      aq[0] = *(const bf16x8*)(sa);
      aq[1] = *(const bf16x8*)(sa + 16 * LDS_ROW);
#pragma unroll
      for (int ni = 0; ni < 4; ++ni) bq[1][ni] = *(const bf16x8*)(sb + ni * 16 * LDS_ROW + 64);
#pragma unroll
      for (int st = 0; st < 16; ++st) {
        if (st + 2 < 16) aq[(st + 2) % 3] = *(const bf16x8*)(sa + ((st + 2) & 7) * 16 * LDS_ROW + ((st + 2) >> 3) * 64);
#pragma unroll
        for (int ni = 0; ni < 4; ++ni)
          acc[st & 7][ni] = __builtin_amdgcn_mfma_f32_16x16x32_bf16(bq[st >> 3][ni], aq[st % 3], acc[st & 7][ni], 0, 0, 0);
        __builtin_amdgcn_sched_barrier(0);
      }
      BAR_SYNC();
    }
    epi(acc, wm, wn, lr, lg);
  }
}

constexpr int LDS_STAGE2 = 2 * LDS_A_BYTES;
template <class Epi>
__device__ __forceinline__ void gemm_tile256(const u16* __restrict__ A, int lda, const u16* __restrict__ Bt, int ldb, int K, int m0,
                                             int n0, char* lds, Epi&& epi) {
  int tid = threadIdx.x;
  asm volatile("" : "+v"(tid));
  const int lane = tid & 63, w = __builtin_amdgcn_readfirstlane(tid >> 6);
  const int wm = w >> 2, wn = w & 3, lr = lane & 15, lg = lane >> 4;
  const int kc = tid & 7, r0 = tid >> 3;
  const int nk = K >> 6;
  const u16* Ab = A + (size_t)(m0 + r0) * lda + kc * 8;
  const u16* Bb = Bt + (size_t)(n0 + r0) * ldb + kc * 8;
  struct LSet {
    uint4 ra[4], rb[4];
  };
  LSet S;
  auto gload = [&](LSet& R, int kt) {
    const int ko = kt * 64;
#pragma unroll
    for (int i = 0; i < 4; ++i) {
      R.ra[i] = *(const uint4*)(Ab + (size_t)(64 * i) * lda + ko);
      R.rb[i] = *(const uint4*)(Bb + (size_t)(64 * i) * ldb + ko);
    }
  };
  auto lstore = [&](LSet& R, int s) {
    char* base = lds + s * LDS_STAGE2 + r0 * LDS_ROW + kc * 16;
#pragma unroll
    for (int i = 0; i < 4; ++i) {
      *(uint4*)(base + (64 * i) * LDS_ROW) = R.ra[i];
      *(uint4*)(base + LDS_A_BYTES + (64 * i) * LDS_ROW) = R.rb[i];
    }
  };
  f32x4 acc[8][4];
#pragma unroll
  for (int i = 0; i < 8; ++i)
#pragma unroll
    for (int j = 0; j < 4; ++j) acc[i][j] = f32x4{0.f, 0.f, 0.f, 0.f};
  gload(S, 0);
  lstore(S, 0);
  BAR_SYNC();
#pragma unroll 1
  for (int kt = 0; kt < nk; ++kt) {
    gload(S, kt + 1 < nk ? kt + 1 : kt);
    const char* sa = lds + (kt & 1) * LDS_STAGE2 + (wm * 128 + lr) * LDS_ROW + lg * 16;
    const char* sb = lds + (kt & 1) * LDS_STAGE2 + LDS_A_BYTES + (wn * 64 + lr) * LDS_ROW + lg * 16;
    bf16x8 bq[4], aq[3];
#pragma unroll
    for (int ni = 0; ni < 4; ++ni) bq[ni] = *(const bf16x8*)(sb + ni * 16 * LDS_ROW);
    aq[0] = *(const bf16x8*)(sa);
    aq[1] = *(const bf16x8*)(sa + 16 * LDS_ROW);
#pragma unroll
    for (int st = 0; st < 16; ++st) {
      if (st + 2 < 16) aq[(st + 2) % 3] = *(const bf16x8*)(sa + ((st + 2) & 7) * 16 * LDS_ROW + ((st + 2) >> 3) * 64);
#pragma unroll
      for (int ni = 0; ni < 4; ++ni)
        acc[st & 7][ni] = __builtin_amdgcn_mfma_f32_16x16x32_bf16(bq[ni], aq[st % 3], acc[st & 7][ni], 0, 0, 0);
      if (st == 7) {
#pragma unroll
        for (int ni = 0; ni < 4; ++ni) bq[ni] = *(const bf16x8*)(sb + ni * 16 * LDS_ROW + 64);
      }
      __builtin_amdgcn_sched_barrier(0);
    }
    lstore(S, (kt + 1) & 1);
    BAR_SYNC();
  }
  epi(acc, wm, wn, lr, lg);
}

#define EPI_FOREACH(acc, ...)                                    \
  _Pragma("unroll") for (int mi = 0; mi < 8; ++mi) {             \
    const int row = m0 + wm * 128 + mi * 16 + lr;                \
    _Pragma("unroll") for (int ni = 0; ni < 4; ++ni) {           \
      const int col0 = n0 + wn * 64 + ni * 16 + lg * 4;          \
      const f32x4 v = acc[mi][ni];                               \
      __VA_ARGS__                                                \
    }                                                            \
    __builtin_amdgcn_sched_barrier(0);                           \
  }
#define EPI_ARGS f32x4(&acc)[8][4], int wm, int wn, int lr, int lg

__device__ __forceinline__ void conv_job(const float* __restrict__ src, u16* __restrict__ dst, int K, int N, int ldk, float* tl, int rot) {
  int tid = threadIdx.x;
  asm volatile("" : "+v"(tid));
  const int tn = N >> 6, nt = (K >> 6) * tn;
  const int G = gridDim.x;
  int t = ((int)blockIdx.x + G - (rot % G)) % G;
  float v[8];
  auto ldtile = [&](int tt) {
    const int k0 = (tt / tn) << 6, n0 = (tt % tn) << 6;
#pragma unroll
    for (int i = 0; i < 8; ++i) {
      const int e = tid + 512 * i;
      v[i] = src[(size_t)(k0 + (e >> 6)) * N + n0 + (e & 63)];
    }
  };
  if (t < nt) ldtile(t);
  while (t < nt) {
    const int k0 = (t / tn) << 6, n0 = (t % tn) << 6;
#pragma unroll
    for (int i = 0; i < 8; ++i) {
      const int e = tid + 512 * i;
      tl[(e >> 6) * 65 + (e & 63)] = v[i];
    }
    const int tnx = t + G;
    if (tnx < nt) ldtile(tnx);
    __syncthreads();
    const int n = tid >> 3, kc = tid & 7;
    float f[8];
#pragma unroll
    for (int j = 0; j < 8; ++j) f[j] = tl[(kc * 8 + j) * 65 + n];
    uint4 o;
    o.x = pack2(f[0], f[1]);
    o.y = pack2(f[2], f[3]);
    o.z = pack2(f[4], f[5]);
    o.w = pack2(f[6], f[7]);
    *(uint4*)(dst + (size_t)(n0 + n) * ldk + k0 + kc * 8) = o;
    __syncthreads();
    t = tnx;
  }
}

__device__ __forceinline__ void phase0(const Params& p, char* lds) {
  float* tl = (float*)lds;
  u16* wt = (u16*)(p.ws + WS_WT);
  u16* adawt = (u16*)(p.ws + S_ADAWT);
  int rot = 0;
#define CJ(SRC, DST, K, N)            \
  conv_job(SRC, DST, K, N, ((K) == 1024 ? LDH : (K) == 4096 ? LDU : (K)), tl, rot);  \
  rot += ((K) >> 6) * ((N) >> 6);
  CJ(p.ada_w, adawt, 1024, 6144)
  CJ(p.ada_w + (size_t)1024 * 6144, adawt + (size_t)6144 * LDH, 1024, 6144)
  CJ(p.rw_wr, wt + WT_WR, 1024, 1024)
  CJ(p.rw_wk, wt + WT_WK, 1024, 1024)
  CJ(p.rw_wv, wt + WT_WV, 1024, 1024)
  CJ(p.rw_wo, wt + WT_WO, 1024, 1024)
  CJ(p.rw_w1, wt + WT_W1, 1024, 64)
  CJ(p.rw_a1, wt + WT_A1, 1024, 64)
  CJ(p.rw_g1, wt + WT_G1, 1024, 128)
  CJ(p.rw_w2, wt + WT_W2, 64, 1024)
  CJ(p.rw_a2, wt + WT_A2, 64, 1024)
  CJ(p.rw_g2, wt + WT_G2, 128, 1024)
  CJ(p.mlp_up, wt + WT_UP0, 1024, 4096)
  CJ(p.mlp_down, wt + WT_DN0, 4096, 1024)
  CJ(p.at_wqkv, wt + WT_QKV, 1024, 1536)
  CJ(p.at_wo, wt + WT_WO1, 1024, 1024)
  CJ(p.mlp_up + (size_t)4 * MEG, wt + WT_UP1, 1024, 4096)
  CJ(p.mlp_down + (size_t)4 * MEG, wt + WT_DN1, 4096, 1024)
#undef CJ
  const int gtid = blockIdx.x * NTHR + threadIdx.x, gsz = gridDim.x * NTHR;
  u16* siluc = (u16*)(p.ws + S_SILUC);
  for (int i = gtid; i < 256 * 1024; i += gsz) {
    int row = i >> 10, col = i & 1023;
    float c = 0.f;
    if (row < 4) c = p.c_prompt[row * 1024 + col];
    else if (row < 132) c = p.c_sample[(row - 4) * 1024 + col];
    siluc[i] = f2bf(c * sigmoidf_(c));
  }
  u16* hs = (u16*)(p.ws + WS_HS);
  for (int i = gtid; i < 128 * 1024; i += gsz) hs[(size_t)(i >> 10) * LDH + (i & 1023)] = f2bf(p.state_shift[i]);
  u16* zr = (u16*)(p.ws + WS_ZR);
  for (int i = gtid; i < LDH; i += gsz) zr[i] = 0;
  float2* tab = (float2*)(p.ws + WS_TAB);
  for (int i = gtid; i < 4097 * 8; i += gsz) {
    int pi = i >> 3, f = i & 7;
    float pos = pi < 4096 ? (float)pi : 8192.f;
    float inv = f == 0 ? 1.0f : f == 1 ? 0.1939227432012558f : f == 2 ? 0.03760603070259094f : f == 3 ? 0.007292664609849453f
              : f == 4 ? 0.0014142135623842478f : f == 5 ? 0.00027424818836152554f : f == 6 ? 5.318296098266728e-05f
              : 1.0313386155758053e-05f;
    float ang = pos * inv;
    double t = (double)ang * 0.15915494309189535;
    t -= rint(t);
    float fr = (float)t;
    tab[i] = make_float2(__builtin_amdgcn_cosf(fr), __builtin_amdgcn_sinf(fr));
  }
}

__device__ __forceinline__ void phase_ada(const Params& p, char* lds) {
  const u16* siluc = (const u16*)(p.ws + S_SILUC);
  const u16* adawt = (const u16*)(p.ws + S_ADAWT);
  float* mod = (float*)(p.ws + WS_MOD);
  for (int t = blockIdx.x; t < 96; t += gridDim.x) {
    const int layer = t / 48, nt = t % 48;
    const int m0 = 0, n0 = nt * 128;
    const float* bias = p.ada_b + layer * 6144;
    float* mo = mod + (size_t)layer * 132 * 6144;
    gemm_tile<false>(siluc, 1024, nullptr, adawt + (size_t)layer * 6144 * LDH, LDH, 6144, 1024, m0, n0, lds, [&](EPI_ARGS) {
      EPI_FOREACH(acc, if (row < 132) {
        const float4 b4 = *(const float4*)(bias + col0);
        *(float4*)(mo + (size_t)row * 6144 + col0) = make_float4(v[0] + b4.x, v[1] + b4.y, v[2] + b4.z, v[3] + b4.w);
      })
    });
  }
}

__device__ __forceinline__ void phase_norm(const Params& p, int layer, int which, bool from_input, bool shift_out) {
  const int lane = threadIdx.x & 63, w = threadIdx.x >> 6;
  const float* mod = (const float*)(p.ws + WS_MOD);
  u16* H = (u16*)(p.ws + WS_H);
  const float* g = (which ? p.norm2_g : p.norm1_g) + layer * 1024;
  const int nw = gridDim.x * 8;
  auto xrow = [&](int row) {
    return from_input ? (row < NP ? p.x_prompt + (size_t)row * 1024 : p.x_sample + (size_t)(row - NP) * 1024)
                      : (const float*)p.out + (size_t)row * 1024;
  };
  float4 gg[4];
#pragma unroll
  for (int i = 0; i < 4; ++i) gg[i] = *(const float4*)(g + lane * 4 + 256 * i);
  int row = blockIdx.x * 8 + w;
  float4 xn[4];
  if (row < MROWS) {
    const float* xr = xrow(row);
#pragma unroll
    for (int i = 0; i < 4; ++i) xn[i] = *(const float4*)(xr + lane * 4 + 256 * i);
  }
  while (row < MROWS) {
    float4 x[4];
#pragma unroll
    for (int i = 0; i < 4; ++i) x[i] = xn[i];
    const int nrow = row + nw;
    if (nrow < MROWS) {
      const float* xr = xrow(nrow);
#pragma unroll
      for (int i = 0; i < 4; ++i) xn[i] = *(const float4*)(xr + lane * 4 + 256 * i);
    }
    const int bi = bidx_of(row);
    const float* mb = mod + ((size_t)layer * 132 + bi) * 6144;
    const float* sh = mb + (which ? 3 : 0) * 1024;
    const float* sc = mb + (which ? 4 : 1) * 1024;
    float4 s4[4], c4[4];
#pragma unroll
    for (int i = 0; i < 4; ++i) {
      s4[i] = *(const float4*)(sh + lane * 4 + 256 * i);
      c4[i] = *(const float4*)(sc + lane * 4 + 256 * i);
    }
    float ss = 0.f;
#pragma unroll
    for (int i = 0; i < 4; ++i) ss += x[i].x * x[i].x + x[i].y * x[i].y + x[i].z * x[i].z + x[i].w * x[i].w;
    ss = wavesum(ss);
    const float rs = rsqrtf(ss * (1.f / 1024.f) + 1e-6f);
    const bool so = shift_out && (row >= NP || (row & 4095) == 4095);
    float* sop = row >= NP ? p.out + O_SHS + (size_t)(row - NP) * 1024 : p.out + O_SHP + (size_t)(row >> 12) * 1024;
#pragma unroll
    for (int i = 0; i < 4; ++i) {
      const int c = lane * 4 + 256 * i;
      float4 h;
      h.x = x[i].x * rs * gg[i].x * (1.f + c4[i].x) + s4[i].x;
      h.y = x[i].y * rs * gg[i].y * (1.f + c4[i].y) + s4[i].y;
      h.z = x[i].z * rs * gg[i].z * (1.f + c4[i].z) + s4[i].z;
      h.w = x[i].w * rs * gg[i].w * (1.f + c4[i].w) + s4[i].w;
      uint2 pk;
      pk.x = pack2(h.x, h.y);
      pk.y = pack2(h.z, h.w);
      *(uint2*)(H + (size_t)row * LDH + c) = pk;
      if (so) *(float4*)(sop + c) = h;
      if (from_input && row >= NP) *(float4*)(p.out + (size_t)row * 1024 + c) = x[i];
    }
    row = nrow;
  }
}

__device__ __forceinline__ void phase_final(const Params& p) {
  const int lane = threadIdx.x & 63, w = threadIdx.x >> 6;
  const int nw = gridDim.x * 8;
  for (int row = blockIdx.x * 8 + w; row < MROWS; row += nw) {
    float* xr = p.out + (size_t)row * 1024;
    float4 x[4];
    float ss = 0.f;
#pragma unroll
    for (int i = 0; i < 4; ++i) {
      x[i] = *(const float4*)(xr + lane * 4 + 256 * i);
      ss += x[i].x * x[i].x + x[i].y * x[i].y + x[i].z * x[i].z + x[i].w * x[i].w;
    }
    ss = wavesum(ss);
    const float rs = rsqrtf(ss * (1.f / 1024.f) + 1e-6f);
#pragma unroll
    for (int i = 0; i < 4; ++i) {
      const int c = lane * 4 + 256 * i;
      float4 gg = *(const float4*)(p.final_g + c);
      float4 h;
      h.x = x[i].x * rs * gg.x;
      h.y = x[i].y * rs * gg.y;
      h.z = x[i].z * rs * gg.z;
      h.w = x[i].w * rs * gg.w;
      *(float4*)(xr + c) = h;
    }
  }
}

__device__ __forceinline__ void phase_rwkv_proj(const Params& p, char* lds) {
  const u16* H = (const u16*)(p.ws + WS_H);
  const u16* wt = (const u16*)(p.ws + WS_WT);
  u16* R = (u16*)(p.ws + S_R);
  u16* Kk = (u16*)(p.ws + S_K);
  u16* V = (u16*)(p.ws + S_V);
  u16* WH = (u16*)(p.ws + S_WH);
  u16* AH = (u16*)(p.ws + S_AH);
  u16* GH = (u16*)(p.ws + S_GH);
  for (int t = blockIdx.x; t < 65 * 27; t += gridDim.x) {
    const int mt = t / 27, j = t % 27;
    const int m0 = mt * 256;
    int kind, n0, N, mixi;
    const u16* Bt;
    if (j < 8) { kind = 0; n0 = j * 128; N = 1024; mixi = 0; Bt = wt + WT_WR; }
    else if (j < 16) { kind = 1; n0 = (j - 8) * 128; N = 1024; mixi = 2; Bt = wt + WT_WK; }
    else if (j < 24) { kind = 2; n0 = (j - 16) * 128; N = 1024; mixi = 3; Bt = wt + WT_WV; }
    else if (j == 24) { kind = 3; n0 = 0; N = 64; mixi = 1; Bt = wt + WT_W1; }
    else if (j == 25) { kind = 4; n0 = 0; N = 64; mixi = 4; Bt = wt + WT_A1; }
    else { kind = 5; n0 = 0; N = 128; mixi = 5; Bt = wt + WT_G1; }
    gemm_tile<true>(H, LDH, p.rw_mix + mixi * 1024, Bt, LDH, N, 1024, m0, n0, lds, [&](EPI_ARGS) {
      u16* dst = kind == 0 ? R : kind == 1 ? Kk : kind == 2 ? V : kind == 3 ? WH : kind == 4 ? AH : GH;
      const int ld = kind < 3 ? 1024 : (kind == 5 ? 128 : 64);
      EPI_FOREACH(acc, if (row < MROWS && col0 < ld) {
        f32x4 o = v;
        if (kind == 3) {
          _Pragma("unroll") for (int q = 0; q < 4; ++q) o[q] = 1.f - 2.f / (__expf(2.f * v[q]) + 1.f);
        } else if (kind == 5) {
          _Pragma("unroll") for (int q = 0; q < 4; ++q) o[q] = sigmoidf_(v[q]);
        }
        *(uint2*)(dst + (size_t)row * ld + col0) = pack4(o);
      })
    });
  }
}

__device__ __forceinline__ void phase_rwkv_lora2(const Params& p, char* lds) {
  const u16* wt = (const u16*)(p.ws + WS_WT);
  const u16* WH = (const u16*)(p.ws + S_WH);
  const u16* AH = (const u16*)(p.ws + S_AH);
  u16* EW = (u16*)(p.ws + S_EW);
  u16* Aa = (u16*)(p.ws + S_A);
  for (int t = blockIdx.x; t < 65 * 16; t += gridDim.x) {
    const int mt = t >> 4, j = t & 15;
    const int m0 = mt * 256, n0 = (j & 7) * 128;
    const bool isw = j < 8;
    gemm_tile<false>(isw ? WH : AH, 64, nullptr, wt + (isw ? WT_W2 : WT_A2), 64, 1024, 64, m0, n0, lds, [&](EPI_ARGS) {
      const float* b0 = isw ? p.rw_w0 : p.rw_a0;
      EPI_FOREACH(acc, if (row < MROWS) {
        const float4 b4 = *(const float4*)(b0 + col0);
        const float s0 = sigmoidf_(v[0] + b4.x), s1 = sigmoidf_(v[1] + b4.y), s2 = sigmoidf_(v[2] + b4.z), s3 = sigmoidf_(v[3] + b4.w);
        if (isw) {
          const float c = 0.6065306597126334f;
          uint2 o;
          o.x = (unsigned)f2h(c * s0) | ((unsigned)f2h(c * s1) << 16);
          o.y = (unsigned)f2h(c * s2) | ((unsigned)f2h(c * s3) << 16);
          *(uint2*)(EW + (size_t)row * 1024 + col0) = o;
        } else {
          uint2 o;
          o.x = pack2(s0, s1);
          o.y = pack2(s2, s3);
          *(uint2*)(Aa + (size_t)row * 1024 + col0) = o;
        }
      })
    });
  }
}

constexpr int RING_TS = 344;
constexpr int RING_BUF = 16 * RING_TS;

__device__ __forceinline__ void phase_scan(const Params& p, char* lds) {
  const int tid = threadIdx.x, lane = tid & 63, w = tid >> 6;
  const u16* R = (const u16*)(p.ws + S_R);
  const u16* Kk = (const u16*)(p.ws + S_K);
  const u16* V = (const u16*)(p.ws + S_V);
  const u16* EW = (const u16*)(p.ws + S_EW);
  const u16* Aa = (const u16*)(p.ws + S_A);
  u16* Y = (u16*)(p.ws + WS_H);
  float* RK = (float*)(p.ws + WS_RK);
  float* ring = (float*)lds;
  float* ybuf = (float*)(lds + 2 * RING_BUF * 4);
  for (int item = blockIdx.x; item < 256; item += gridDim.x) {
    const int chain = item >> 2, qr = item & 3, b = chain >> 4, h = chain & 15;
    const size_t rowbase = (size_t)b * 4096;
    __syncthreads();
    if (tid >= 256) {
      const int pt = tid - 256, tok = pt >> 4, cq = pt & 15;
      const int ch = h * 64 + cq * 4;
      const float4 kk4 = *(const float4*)(p.rw_kk + ch), ka4 = *(const float4*)(p.rw_ka + ch), rk4 = *(const float4*)(p.rw_rk + ch);
      struct PS {
        uint2 rr, rk_, rv, ra_, re;
      };
      PS S0, S1;
      auto pload = [&](PS& S, int c) {
        const size_t off = (rowbase + (size_t)c * 16 + tok) * 1024 + ch;
        S.rr = *(const uint2*)(R + off);
        S.rk_ = *(const uint2*)(Kk + off);
        S.rv = *(const uint2*)(V + off);
        S.ra_ = *(const uint2*)(Aa + off);
        S.re = *(const uint2*)(EW + off);
      };
      auto pproc = [&](PS& S, int c) {
        const uint2 rr = S.rr, rk_ = S.rk_, rv = S.rv, ra_ = S.ra_, re = S.re;
        float rf[4] = {bflo(rr.x), bfhi(rr.x), bflo(rr.y), bfhi(rr.y)};
        float kf[4] = {bflo(rk_.x), bfhi(rk_.x), bflo(rk_.y), bfhi(rk_.y)};
        float vf[4] = {bflo(rv.x), bfhi(rv.x), bflo(rv.y), bfhi(rv.y)};
        float af[4] = {bflo(ra_.x), bfhi(ra_.x), bflo(ra_.y), bfhi(ra_.y)};
        float ef[4] = {h2f((u16)(re.x & 0xffff)), h2f((u16)(re.x >> 16)), h2f((u16)(re.y & 0xffff)), h2f((u16)(re.y >> 16))};
        const float kkw[4] = {kk4.x, kk4.y, kk4.z, kk4.w}, kaw[4] = {ka4.x, ka4.y, ka4.z, ka4.w}, rkw[4] = {rk4.x, rk4.y, rk4.z, rk4.w};
        float kkr[4], kp[4], ss = 0.f, rks = 0.f;
#pragma unroll
        for (int j = 0; j < 4; ++j) {
          kkr[j] = kf[j] * kkw[j];
          ss += kkr[j] * kkr[j];
          kp[j] = kf[j] * (1.f + (af[j] - 1.f) * kaw[j]);
          rks += rf[j] * kp[j] * rkw[j];
        }
        ss = rowsum16(ss);
        rks = rowsum16(rks);
        const float inv = 1.f / fmaxf(sqrtf(ss), 1e-12f);
        float* slot = ring + (c & 1) * RING_BUF + tok * RING_TS;
        float am[4], dc[4], bm[4], wr[4], br = 0.f, kr = 0.f;
#pragma unroll
        for (int j = 0; j < 4; ++j) {
          am[j] = -kkr[j] * inv;
          dc[j] = __expf(-ef[j]);
          bm[j] = kkr[j] * inv * af[j];
          wr[j] = dc[j] * rf[j];
          br += bm[j] * rf[j];
          kr += kp[j] * rf[j];
        }
        br = rowsum16(br);
        kr = rowsum16(kr);
        *(float4*)(slot + cq * 4) = make_float4(am[0], am[1], am[2], am[3]);
        *(float4*)(slot + 64 + cq * 4) = make_float4(dc[0], dc[1], dc[2], dc[3]);
        *(float4*)(slot + 128 + cq * 4) = make_float4(bm[0], bm[1], bm[2], bm[3]);
        *(float4*)(slot + 192 + cq * 4) = make_float4(kp[0], kp[1], kp[2], kp[3]);
        *(float4*)(slot + 256 + cq * 4) = make_float4(wr[0], wr[1], wr[2], wr[3]);
        if (cq == 0) *(float2*)(slot + 336) = make_float2(br, kr);
        if ((cq >> 2) == qr) *(float4*)(slot + 320 + (cq & 3) * 4) = make_float4(vf[0], vf[1], vf[2], vf[3]);
        if (cq == 0 && qr == 0) RK[(rowbase + (size_t)c * 16 + tok) * 16 + h] = rks;
      };
      pload(S0, 0);
      pproc(S0, 0);
      pload(S1, 1);
      pload(S0, 2);
      BAR_SYNC();
#pragma unroll 1
      for (int c = 0; c < 256; c += 2) {
        pproc(S1, c + 1);
        if (c + 3 < 256) pload(S1, c + 3);
        BAR_SYNC();
        if (c + 2 < 256) pproc(S0, c + 2);
        if (c + 4 < 256) pload(S0, c + 4);
        BAR_SYNC();
      }
    } else {
      const int rl = tid >> 4, cgp = tid & 15;
      float s0 = 0.f, s1 = 0.f, s2 = 0.f, s3 = 0.f;
      BAR_SYNC();
      for (int c = 0; c < 256; ++c) {
        if (c > 0) {
          const float yv = ybuf[((c - 1) & 1) * 256 + tid];
          Y[(rowbase + (size_t)(c - 1) * 16 + rl) * LDH + h * 64 + qr * 16 + cgp] = f2bf(yv);
        }
        const float* bufp = ring + (c & 1) * RING_BUF;
        float* yb = ybuf + (c & 1) * 256;
        struct SV {
          float4 a, w, b, k, wr;
          float v;
          float2 bk;
        };
        auto ldstep = [&](const float* slot) {
          SV r;
          r.a = *(const float4*)(slot + cgp * 4);
          r.w = *(const float4*)(slot + 64 + cgp * 4);
          r.b = *(const float4*)(slot + 128 + cgp * 4);
          r.k = *(const float4*)(slot + 192 + cgp * 4);
          r.wr = *(const float4*)(slot + 256 + cgp * 4);
          r.v = slot[320 + rl];
          r.bk = *(const float2*)(slot + 336);
          return r;
        };
        SV cur = ldstep(bufp);
#pragma unroll
        for (int tk = 0; tk < 16; ++tk) {
          SV nxt = cur;
          if (tk + 1 < 16) nxt = ldstep(bufp + (tk + 1) * RING_TS);
          float sa = s0 * cur.a.x + s1 * cur.a.y + s2 * cur.a.z + s3 * cur.a.w;
          float yw = s0 * cur.wr.x + s1 * cur.wr.y + s2 * cur.wr.z + s3 * cur.wr.w;
          const float t0 = s0 * cur.w.x + cur.v * cur.k.x;
          const float t1 = s1 * cur.w.y + cur.v * cur.k.y;
          const float t2 = s2 * cur.w.z + cur.v * cur.k.z;
          const float t3 = s3 * cur.w.w + cur.v * cur.k.w;
          sa = rowsum16(sa);
          yw = rowsum16(yw);
          s0 = t0 + sa * cur.b.x;
          s1 = t1 + sa * cur.b.y;
          s2 = t2 + sa * cur.b.z;
          s3 = t3 + sa * cur.b.w;
          const float y = yw + sa * cur.bk.x + cur.v * cur.bk.y;
          if (cgp == 0) yb[tk * 16 + rl] = y;
          cur = nxt;
        }
        BAR_SYNC();
      }
      {
        const float yv = ybuf[(255 & 1) * 256 + tid];
        Y[(rowbase + (size_t)255 * 16 + rl) * LDH + h * 64 + qr * 16 + cgp] = f2bf(yv);
      }
      float* wo = p.out + O_WKVP + (((size_t)(b * 16 + h) * 64) + qr * 16 + rl) * 64 + cgp * 4;
      *(float4*)wo = make_float4(s0, s1, s2, s3);
    }
  }
  float* sl = (float*)lds;
  for (int chain = blockIdx.x; chain < 2048; chain += gridDim.x) {
    const int b = chain >> 4, h = chain & 15;
    const size_t row = (size_t)NP + b;
    __syncthreads();
    if (w == 0) {
      const int ch = h * 64 + lane;
      const size_t off = row * 1024 + ch;
      const float rf = bf2f(R[off]), kf = bf2f(Kk[off]), vf = bf2f(V[off]), af = bf2f(Aa[off]), ef = h2f(EW[off]);
      const float kkr = kf * p.rw_kk[ch];
      const float ss = wavesum(kkr * kkr);
      const float inv = 1.f / fmaxf(sqrtf(ss), 1e-12f);
      const float kp = kf * (1.f + (af - 1.f) * p.rw_ka[ch]);
      const float rks = wavesum(rf * kp * p.rw_rk[ch]);
      sl[lane] = -kkr * inv;
      sl[64 + lane] = __expf(-ef);
      sl[128 + lane] = kkr * inv * af;
      sl[192 + lane] = kp;
      sl[256 + lane] = rf;
      sl[320 + lane] = vf;
      if (lane == 0) RK[row * 16 + h] = rks;
    }
    __syncthreads();
    const int i = tid >> 3, c8 = tid & 7;
    const float* sp = p.state_wkv + (((size_t)(b * 16 + h) * 64) + i) * 64 + c8 * 8;
    float4 sA = *(const float4*)sp, sB = *(const float4*)(sp + 4);
    float s[8] = {sA.x, sA.y, sA.z, sA.w, sB.x, sB.y, sB.z, sB.w};
    float sa = 0.f;
#pragma unroll
    for (int j = 0; j < 8; ++j) sa += s[j] * sl[c8 * 8 + j];
    sa += __shfl_xor(sa, 1);
    sa += __shfl_xor(sa, 2);
    sa += __shfl_xor(sa, 4);
    const float vv = sl[320 + i];
    float y = 0.f;
#pragma unroll
    for (int j = 0; j < 8; ++j) {
      const int cj = c8 * 8 + j;
      s[j] = s[j] * sl[64 + cj] + sa * sl[128 + cj] + vv * sl[192 + cj];
      y += s[j] * sl[256 + cj];
    }
    y += __shfl_xor(y, 1);
    y += __shfl_xor(y, 2);
    y += __shfl_xor(y, 4);
    float* wo = p.out + O_WKVS + (((size_t)(b * 16 + h) * 64) + i) * 64 + c8 * 8;
    *(float4*)wo = make_float4(s[0], s[1], s[2], s[3]);
    *(float4*)(wo + 4) = make_float4(s[4], s[5], s[6], s[7]);
    if (c8 == 0) Y[row * LDH + h * 64 + i] = f2bf(y);
  }
}

__device__ __forceinline__ void phase_gate(const Params& p, char* lds) {
  const u16* wt = (const u16*)(p.ws + WS_WT);
  const u16* GH = (const u16*)(p.ws + S_GH);
  const u16* V = (const u16*)(p.ws + S_V);
  const float* RK = (const float*)(p.ws + WS_RK);
  u16* Y = (u16*)(p.ws + WS_H);
  for (int t = blockIdx.x; t < 65 * 8; t += gridDim.x) {
    const int mt = t >> 3, nt = t & 7;
    const int m0 = mt * 256, n0 = nt * 128;
    gemm_tile<false>(GH, 128, nullptr, wt + WT_G2, 128, 1024, 128, m0, n0, lds, [&](EPI_ARGS) {
      const int hh = (n0 + wn * 64) >> 6;
#pragma unroll
      for (int mi = 0; mi < 8; ++mi) {
        const int row = m0 + wm * 128 + mi * 16 + lr;
        const int rowc = row < MROWS ? row : MROWS - 1;
        float yv[4][4];
        float sum = 0.f;
#pragma unroll
        for (int ni = 0; ni < 4; ++ni) {
          const uint2 yy = *(const uint2*)(Y + (size_t)rowc * LDH + hh * 64 + ni * 16 + lg * 4);
          yv[ni][0] = bflo(yy.x); yv[ni][1] = bfhi(yy.x); yv[ni][2] = bflo(yy.y); yv[ni][3] = bfhi(yy.y);
          sum += yv[ni][0] + yv[ni][1] + yv[ni][2] + yv[ni][3];
        }
        sum += __shfl_xor(sum, 16);
        sum += __shfl_xor(sum, 32);
        const float mu = sum * (1.f / 64.f);
        float vs = 0.f;
#pragma unroll
        for (int ni = 0; ni < 4; ++ni)
#pragma unroll
          for (int q = 0; q < 4; ++q) {
            const float d = yv[ni][q] - mu;
            vs += d * d;
          }
        vs += __shfl_xor(vs, 16);
        vs += __shfl_xor(vs, 32);
        const float rstd = rsqrtf(vs * (1.f / 64.f) + 64e-5f);
        const float rk = RK[(size_t)rowc * 16 + hh];
#pragma unroll
        for (int ni = 0; ni < 4; ++ni) {
          const int col0 = hh * 64 + ni * 16 + lg * 4;
          const uint2 vv = *(const uint2*)(V + (size_t)rowc * 1024 + col0);
          const float vf[4] = {bflo(vv.x), bfhi(vv.x), bflo(vv.y), bfhi(vv.y)};
          const float4 g4 = *(const float4*)(p.rw_lnx_g + col0), b4 = *(const float4*)(p.rw_lnx_b + col0);
          const float gg[4] = {g4.x, g4.y, g4.z, g4.w}, bb[4] = {b4.x, b4.y, b4.z, b4.w};
          f32x4 o;
#pragma unroll
          for (int q = 0; q < 4; ++q) o[q] = ((yv[ni][q] - mu) * rstd * gg[q] + bb[q] + rk * vf[q]) * acc[mi][ni][q];
          if (row < MROWS) *(uint2*)(Y + (size_t)row * LDH + col0) = pack4(o);
        }
        __builtin_amdgcn_sched_barrier(0);
      }
    });
  }
}

__device__ __forceinline__ void phase_oproj(const Params& p, char* lds, const u16* A, int K, const u16* Bt, int layer, int gidx, bool first) {
  const int ldab = K == 1024 ? LDH : LDU;
  const float* mod = (const float*)(p.ws + WS_MOD);
  for (int u = blockIdx.x; u < 320; u += gridDim.x) {
    const bool split = u >= 256;
    const int s = u - 256;
    const int m0 = split ? NP : (u >> 2) * 256, n0 = (split ? (s & 3) : (u & 3)) * 256;
    const int klen = split ? (K >> 4) : K, kbeg = split ? (s >> 2) * klen : 0;
    gemm_tile256(A + kbeg, ldab, Bt + kbeg, ldab, klen, m0, n0, lds, [&](EPI_ARGS) {
      EPI_FOREACH(acc, if (row < MROWS) {
        const float4 gt = *(const float4*)(mod + ((size_t)layer * 132 + bidx_of(row)) * 6144 + gidx * 1024 + col0);
        float* xp = p.out + (size_t)row * 1024 + col0;
        if (split) {
          unsafeAtomicAdd(xp + 0, gt.x * v[0]);
          unsafeAtomicAdd(xp + 1, gt.y * v[1]);
          unsafeAtomicAdd(xp + 2, gt.z * v[2]);
          unsafeAtomicAdd(xp + 3, gt.w * v[3]);
        } else {
          const float* xi = first ? p.x_prompt + (size_t)row * 1024 + col0 : xp;
          const float4 xo = *(const float4*)xi;
          *(float4*)xp = make_float4(xo.x + gt.x * v[0], xo.y + gt.y * v[1], xo.z + gt.z * v[2], xo.w + gt.w * v[3]);
        }
      })
    });
  }
}

__device__ __forceinline__ void phase_up(const Params& p, char* lds, const u16* Bt) {
  const u16* H = (const u16*)(p.ws + WS_H);
  u16* UP = (u16*)(p.ws + S_UP);
  for (int t = blockIdx.x; t < 65 * 16; t += gridDim.x) {
    const int mt = t >> 4, nt = t & 15;
    const int m0 = mt * 256, n0 = nt * 256;
    gemm_tile256(H, LDH, Bt, LDH, 1024, m0, n0, lds, [&](EPI_ARGS) {
      EPI_FOREACH(acc, if (row < MROWS) {
        f32x4 o;
        _Pragma("unroll") for (int q = 0; q < 4; ++q) {
          const float rl = fmaxf(v[q], 0.f);
          o[q] = rl * rl;
        }
        *(uint2*)(UP + (size_t)row * LDU + col0) = pack4(o);
      })
    });
  }
}

__device__ __forceinline__ void phase_qkv(const Params& p, char* lds) {
  const u16* H = (const u16*)(p.ws + WS_H);
  const u16* wt = (const u16*)(p.ws + WS_WT);
  const float* tab = (const float*)(p.ws + WS_TAB);
  u16* Qb = (u16*)(p.ws + S_Q);
  u16* Kb = (u16*)(p.ws + S_KB);
  u16* Vt = (u16*)(p.ws + S_VT);
  for (int t = blockIdx.x; t < 65 * 12; t += gridDim.x) {
    const int mt = t / 12, nt = t % 12;
    const int m0 = mt * 256, n0 = nt * 128;
    gemm_tile<false>(H, LDH, nullptr, wt + WT_QKV, LDH, 1536, 1024, m0, n0, lds, [&](EPI_ARGS) {
      const int hc0 = n0 + wn * 64;
#pragma unroll
      for (int mi = 0; mi < 8; ++mi) {
        const int row = m0 + wm * 128 + mi * 16 + lr;
        const bool valid = row < MROWS;
        const bool isp = row < NP;
        const int pos = row & 4095;
        const int bq = isp ? (row >> 12) : (row - NP);
        const int posidx = isp ? pos : 4096;
#pragma unroll
        for (int ni = 0; ni < 4; ++ni) {
          const int col0 = hc0 + ni * 16 + lg * 4;
          const float4 b4 = *(const float4*)(p.at_bqkv + col0);
          f32x4 v = acc[mi][ni];
          v[0] += b4.x; v[1] += b4.y; v[2] += b4.z; v[3] += b4.w;
          if (ni == 0 && hc0 < 1280) {
            const float* tp = tab + (size_t)posidx * 16 + (lg & 1) * 8;
            const float4 t0 = *(const float4*)tp, t1 = *(const float4*)(tp + 4);
            const float cs[4] = {t0.x, t0.z, t1.x, t1.z}, sn[4] = {t0.y, t0.w, t1.y, t1.w};
#pragma unroll
            for (int q = 0; q < 4; ++q) {
              const float pv = __shfl_xor(v[q], 32);
              v[q] = (lg < 2) ? (v[q] * cs[q] - pv * sn[q]) : (v[q] * cs[q] + pv * sn[q]);
            }
          }
          if (valid) {
            if (hc0 < 1024) {
              *(uint2*)(Qb + (size_t)row * 1024 + col0) = pack4(v);
            } else if (hc0 < 1280) {
              const int c2 = col0 - 1024;
              *(uint2*)(Kb + (size_t)row * 256 + c2) = pack4(v);
              if (isp) {
                if (pos >= 3968) *(float4*)(p.out + O_KP + ((size_t)(bq * 128 + pos - 3968)) * 256 + c2) = make_float4(v[0], v[1], v[2], v[3]);
              } else {
                *(float4*)(p.out + O_KS + ((size_t)(bq * 128 + 127)) * 256 + c2) = make_float4(v[0], v[1], v[2], v[3]);
              }
            } else {
              const int c3 = col0 - 1280;
              if (isp) {
                u16* vp = Vt + ((size_t)(bq * 4 + (c3 >> 6)) * 64 + (c3 & 63)) * 4096 + pos;
#pragma unroll
                for (int q = 0; q < 4; ++q) vp[(size_t)q * 4096] = f2bf(v[q]);
                if (pos >= 3968) *(float4*)(p.out + O_VP + ((size_t)(bq * 128 + pos - 3968)) * 256 + c3) = make_float4(v[0], v[1], v[2], v[3]);
              } else {
                *(float4*)(p.out + O_VS + ((size_t)(bq * 128 + 127)) * 256 + c3) = make_float4(v[0], v[1], v[2], v[3]);
              }
            }
          }
        }
        __builtin_amdgcn_sched_barrier(0);
      }
    });
  }
}

constexpr int AT_KS = 0, AT_VS = 36864, AT_PS = 36864 + 35840, AT_PW = 5376;

__device__ __forceinline__ void phase_attn(const Params& p, char* lds) {
  const int tid = threadIdx.x, lane = tid & 63, w = tid >> 6, lr = lane & 15, lg = lane >> 4;
  const u16* Qb = (const u16*)(p.ws + S_Q);
  const u16* Kb = (const u16*)(p.ws + S_KB);
  const u16* Vt = (const u16*)(p.ws + S_VT);
  u16* O = (u16*)(p.ws + S_O);
  char* Ks = lds + AT_KS;
  char* Vs = lds + AT_VS;
  char* Ps = lds + AT_PS + w * AT_PW;
  for (int u = blockIdx.x; u < 512; u += gridDim.x) {
    const int b = u >> 7, n = (u >> 2) & 31, kvh = u & 3;
    bf16x8 qfa[4][2];
    {
      const int g_ = w >> 1, hf_ = w & 1, qh_ = kvh * 4 + g_;
#pragma unroll
      for (int i = 0; i < 4; ++i) {
        const size_t tok = (size_t)b * 4096 + n * 128 + hf_ * 64 + i * 16 + lr;
        qfa[i][0] = *(const bf16x8*)(Qb + tok * 1024 + qh_ * 64 + lg * 8);
        qfa[i][1] = *(const bf16x8*)(Qb + tok * 1024 + qh_ * 64 + 32 + lg * 8);
      }
    }
    __syncthreads();
#pragma unroll
    for (int i = 0; i < 4; ++i) {
      const int c = tid + 512 * i;
      {
        const int key = c >> 3, kc = c & 7;
        const int pos = n * 128 - 128 + key;
        uint4 v = {0u, 0u, 0u, 0u};
        if (pos >= 0) v = *(const uint4*)(Kb + ((size_t)b * 4096 + pos) * 256 + kvh * 64 + kc * 8);
        *(uint4*)(Ks + key * 144 + kc * 16) = v;
      }
      {
        const int d = c >> 5, kc = c & 31;
        const int pos0 = n * 128 - 128 + kc * 8;
        uint4 v = {0u, 0u, 0u, 0u};
        if (pos0 >= 0) v = *(const uint4*)(Vt + ((size_t)(b * 4 + kvh) * 64 + d) * 4096 + pos0);
        *(uint4*)(Vs + d * 560 + kc * 16) = v;
      }
    }
    if (tid < 192) {
      const int d = tid / 3, c = tid % 3;
      *(uint4*)(Vs + d * 560 + 512 + c * 16) = uint4{0u, 0u, 0u, 0u};
    }
    {
      const int prow = lane >> 2, pc = 144 + (lane & 3) * 4;
      *(uint2*)(Ps + prow * 336 + pc * 2) = uint2{0u, 0u};
    }
    __syncthreads();
    const int g = w >> 1, hf = w & 1;
    const int qh = kvh * 4 + g;
    const float sink = p.at_sink[qh];
#pragma unroll
    for (int i = 0; i < 4; ++i) {
      const int q0 = hf * 64 + i * 16;
      const bf16x8 qf0 = qfa[i][0];
      const bf16x8 qf1 = qfa[i][1];
      f32x4 s[9];
#pragma unroll
      for (int j = 0; j < 9; ++j) {
        const char* kp = Ks + (q0 + j * 16 + lr) * 144 + lg * 16;
        const bf16x8 k0 = *(const bf16x8*)kp;
        const bf16x8 k1 = *(const bf16x8*)(kp + 64);
        f32x4 z = {0.f, 0.f, 0.f, 0.f};
        z = __builtin_amdgcn_mfma_f32_16x16x32_bf16(qf0, k0, z, 0, 0, 0);
        z = __builtin_amdgcn_mfma_f32_16x16x32_bf16(qf1, k1, z, 0, 0, 0);
        s[j] = z;
      }
      float mx[4], sum[4];
#pragma unroll
      for (int r = 0; r < 4; ++r) {
        const int ql = lg * 4 + r;
        float m = sink;
#pragma unroll
        for (int j = 0; j < 9; ++j) {
          float v = s[j][r] * 0.125f;
          bool ok = true;
          if (j == 0) ok = (lr >= ql);
          if (j == 8) ok = (lr <= ql);
          if (n == 0 && (q0 + j * 16 + lr) < 128) ok = false;
          v = ok ? v : -INFINITY;
          s[j][r] = v;
          m = fmaxf(m, v);
        }
        mx[r] = rowmax16(m);
      }
#pragma unroll
      for (int r = 0; r < 4; ++r) {
        float sm = 0.f;
#pragma unroll
        for (int j = 0; j < 9; ++j) {
          const float e = __expf(s[j][r] - mx[r]);
          s[j][r] = e;
          sm += e;
        }
        sm = rowsum16(sm);
        sum[r] = sm + __expf(sink - mx[r]);
      }
      u16* P = (u16*)Ps;
#pragma unroll
      for (int j = 0; j < 9; ++j)
#pragma unroll
        for (int r = 0; r < 4; ++r) P[(lg * 4 + r) * 168 + j * 16 + lr] = f2bf(s[j][r]);
      __builtin_amdgcn_wave_barrier();
      f32x4 o[4];
#pragma unroll
      for (int nd = 0; nd < 4; ++nd) o[nd] = f32x4{0.f, 0.f, 0.f, 0.f};
#pragma unroll
      for (int kk = 0; kk < 5; ++kk) {
        const bf16x8 pf = *(const bf16x8*)(Ps + lr * 336 + kk * 64 + lg * 16);
#pragma unroll
        for (int nd = 0; nd < 4; ++nd) {
          const bf16x8 vf = *(const bf16x8*)(Vs + (nd * 16 + lr) * 560 + (q0 + kk * 32 + lg * 8) * 2);
          o[nd] = __builtin_amdgcn_mfma_f32_16x16x32_bf16(pf, vf, o[nd], 0, 0, 0);
        }
      }
#pragma unroll
      for (int nd = 0; nd < 4; ++nd)
#pragma unroll
        for (int r = 0; r < 4; ++r) {
          const float v = o[nd][r] / sum[r];
          O[((size_t)b * 4096 + n * 128 + q0 + lg * 4 + r) * LDH + qh * 64 + nd * 16 + lr] = f2bf(v);
        }
      __builtin_amdgcn_wave_barrier();
    }
  }
  float* qs = (float*)lds;
  float* sc = (float*)(lds + 1024);
  float* part = (float*)(lds + 1024 + 2112);
  for (int it = blockIdx.x; it < 512; it += gridDim.x) {
    const int b = it >> 2, kvh = it & 3;
    const size_t row = (size_t)NP + b;
    __syncthreads();
    if (tid < 256) qs[tid] = bf2f(Qb[row * 1024 + kvh * 256 + tid]);
    __syncthreads();
    {
      const int key = tid >> 2, g = tid & 3;
      const float* kp = p.cache_k + (((size_t)b * 128 + key) * 4 + kvh) * 64;
      float dot = 0.f;
#pragma unroll
      for (int d4 = 0; d4 < 16; ++d4) {
        const float4 kv = *(const float4*)(kp + d4 * 4);
        const float* q = qs + g * 64 + d4 * 4;
        dot += kv.x * q[0] + kv.y * q[1] + kv.z * q[2] + kv.w * q[3];
      }
      sc[g * 132 + key] = dot * 0.125f;
      if (key >= 1) {
        float* dst = p.out + O_KS + (((size_t)b * 128 + key - 1) * 4 + kvh) * 64 + g * 16;
        const float* src = kp + g * 16;
#pragma unroll
        for (int d4 = 0; d4 < 4; ++d4) *(float4*)(dst + d4 * 4) = *(const float4*)(src + d4 * 4);
      }
      if (tid < 4) {
        const float* kn = p.out + O_KS + (((size_t)b * 128 + 127) * 4 + kvh) * 64;
        float d2 = 0.f;
        for (int d = 0; d < 64; ++d) d2 += kn[d] * qs[tid * 64 + d];
        sc[tid * 132 + 128] = d2 * 0.125f;
      }
    }
    __syncthreads();
    if (w < 4) {
      const float sink = p.at_sink[kvh * 4 + w];
      float* s = sc + w * 132;
      const float v0 = s[lane], v1 = s[64 + lane], v2 = lane == 0 ? s[128] : -INFINITY;
      float m = fmaxf(fmaxf(v0, v1), fmaxf(v2, sink));
      m = wavemax(m);
      const float e0 = __expf(v0 - m), e1 = __expf(v1 - m), e2 = lane == 0 ? __expf(v2 - m) : 0.f;
      float sm = wavesum(e0 + e1 + e2) + __expf(sink - m);
      const float inv = 1.f / sm;
      s[lane] = e0 * inv;
      s[64 + lane] = e1 * inv;
      if (lane == 0) s[128] = e2 * inv;
    }
    __syncthreads();
    {
      const int d = tid & 63, g = (tid >> 6) & 3, half = tid >> 8;
      const float* vp = p.cache_v + (((size_t)b * 128) * 4 + kvh) * 64 + d;
      float accv = 0.f;
      for (int key = half * 64; key < half * 64 + 64; ++key) {
        const float vv = vp[(size_t)key * 256];
        accv += sc[g * 132 + key] * vv;
        if (g == 0 && key >= 1) p.out[O_VS + (((size_t)b * 128 + key - 1) * 4 + kvh) * 64 + d] = vv;
      }
      if (half == 1) accv += sc[g * 132 + 128] * p.out[O_VS + (((size_t)b * 128 + 127) * 4 + kvh) * 64 + d];
      part[(half * 4 + g) * 64 + d] = accv;
    }
    __syncthreads();
    if (tid < 256) {
      const int d = tid & 63, g = tid >> 6;
      O[row * LDH + (kvh * 4 + g) * 64 + d] = f2bf(part[g * 64 + d] + part[(4 + g) * 64 + d]);
    }
  }
}

__global__ void __launch_bounds__(NTHR) mega(Params p) {
  extern __shared__ __attribute__((aligned(16))) char lds[];
  cg::grid_group grid = cg::this_grid();
  volatile LAS unsigned* xst = (volatile LAS unsigned*)(lds + LDS_BYTES);
  if (threadIdx.x == 0) { xst[0] = 0u; xst[1] = 0u; }
  __syncthreads();
  const XcdBarrier xb = xcd_barrier_post((unsigned*)(p.ws + WS_BAR), xst);
  const u16* wt = (const u16*)(p.ws + WS_WT);
  phase0(p, lds);
  if (p.out == nullptr) grid.sync();
  xcd_barrier(xb);
  phase_ada(p, lds);
  xcd_barrier(xb);
  phase_norm(p, 0, 0, true, true);
  xcd_barrier(xb);
  phase_rwkv_proj(p, lds);
  xcd_barrier(xb);
  phase_rwkv_lora2(p, lds);
  xcd_barrier(xb);
  phase_scan(p, lds);
  xcd_barrier(xb);
  phase_gate(p, lds);
  xcd_barrier(xb);
  phase_oproj(p, lds, (const u16*)(p.ws + WS_H), 1024, wt + WT_WO, 0, 2, true);
  xcd_barrier(xb);
  phase_norm(p, 0, 1, false, false);
  xcd_barrier(xb);
  phase_up(p, lds, wt + WT_UP0);
  xcd_barrier(xb);
  phase_oproj(p, lds, (const u16*)(p.ws + S_UP), 4096, wt + WT_DN0, 0, 5, false);
  xcd_barrier(xb);
  phase_norm(p, 1, 0, false, false);
  xcd_barrier(xb);
  phase_qkv(p, lds);
  xcd_barrier(xb);
  phase_attn(p, lds);
  xcd_barrier(xb);
  phase_oproj(p, lds, (const u16*)(p.ws + S_O), 1024, wt + WT_WO1, 1, 2, false);
  xcd_barrier(xb);
  phase_norm(p, 1, 1, false, false);
  xcd_barrier(xb);
  phase_up(p, lds, wt + WT_UP1);
  xcd_barrier(xb);
  phase_oproj(p, lds, (const u16*)(p.ws + S_UP), 4096, wt + WT_DN1, 1, 5, false);
  xcd_barrier(xb);
  phase_final(p);
}

extern "C" void kernel_launch(void* const* d_in, const int* in_sizes, int n_in, void* d_out, int out_size, void* d_ws,
                              size_t ws_size, hipStream_t stream) {
  static int grid_blocks = 0;
  if (grid_blocks == 0) {
    if (ws_size < WS_END) {
      fprintf(stderr, "kernel_launch: workspace too small: %zu < %zu\n", ws_size, (size_t)WS_END);
      grid_blocks = -1;
      return;
    }
    int dev = 0, cus = 0, per_cu = 0;
    hipGetDevice(&dev);
    hipDeviceGetAttribute(&cus, hipDeviceAttributeMultiprocessorCount, dev);
    hipFuncSetAttribute((const void*)mega, hipFuncAttributeMaxDynamicSharedMemorySize, LDS_BYTES + 16);
    hipOccupancyMaxActiveBlocksPerMultiprocessor(&per_cu, (const void*)mega, NTHR, LDS_BYTES + 16);
    if (per_cu < 1) per_cu = 1;
    grid_blocks = cus * per_cu;
  }
  if (grid_blocks < 0) return;
  Params p{};
  const float** pp = (const float**)&p;
  for (int i = 0; i < 37; ++i) pp[i] = (const float*)d_in[i];
  p.out = (float*)d_out;
  p.ws = (char*)d_ws;
  hipMemsetAsync((char*)d_ws + WS_BAR, 0, 16384, stream);
  void* args[] = {&p};
  hipError_t e = hipLaunchCooperativeKernel((const void*)mega, dim3(grid_blocks), dim3(NTHR), args, LDS_BYTES + 16, stream);
  if (e != hipSuccess) fprintf(stderr, "cooperative launch failed: %s (grid %d)\n", hipGetErrorString(e), grid_blocks);
}
```

```cpp
#include <hip/hip_runtime.h>
#include <hip/hip_cooperative_groups.h>
#include <cstdio>
namespace cg = cooperative_groups;

typedef unsigned short u16;
typedef __attribute__((ext_vector_type(8))) short bf16x8;
typedef __attribute__((ext_vector_type(4))) float f32x4;

constexpr int NP = 16384, MROWS = 16512, MPAD = 16640;
constexpr int NTHR = 512;
constexpr size_t MEG = 1048576;
constexpr int LDH = 1088, LDU = 4160;

constexpr size_t O_Y = 0, O_WKVP = 16908288, O_WKVS = 17170432, O_SHP = 25559040, O_SHS = 25563136,
                 O_KP = 25694208, O_KS = 25825280, O_VP = 30019584, O_VS = 30150656;

constexpr size_t WT_WR = 0, WT_WK = WT_WR + 1024 * LDH, WT_WV = WT_WK + 1024 * LDH, WT_WO = WT_WV + 1024 * LDH,
                 WT_W1 = WT_WO + 1024 * LDH, WT_A1 = WT_W1 + 64 * LDH, WT_G1 = WT_A1 + 64 * LDH, WT_W2 = WT_G1 + 128 * LDH,
                 WT_A2 = WT_W2 + 65536, WT_G2 = WT_A2 + 65536, WT_UP0 = WT_G2 + 131072, WT_DN0 = WT_UP0 + 4096 * LDH,
                 WT_QKV = WT_DN0 + 1024 * LDU, WT_WO1 = WT_QKV + 1536 * LDH, WT_UP1 = WT_WO1 + 1024 * LDH,
                 WT_DN1 = WT_UP1 + 4096 * LDH, WT_END = WT_DN1 + 1024 * LDU;
constexpr size_t WS_WT = 0;
constexpr size_t WS_H = WS_WT + WT_END * 2;
constexpr size_t WS_ZR = WS_H + (size_t)MPAD * LDH * 2;
constexpr size_t WS_MOD = WS_ZR + (size_t)LDH * 2;
constexpr size_t WS_TAB = WS_MOD + (size_t)2 * 132 * 6144 * 4;
constexpr size_t WS_HS = WS_H + (size_t)MROWS * LDH * 2;
constexpr size_t WS_RK = WS_TAB + (size_t)4097 * 8 * 8;
constexpr size_t WS_BAR = WS_RK + (size_t)MPAD * 16 * 4;
constexpr size_t WS_S = WS_BAR + 16384;
constexpr size_t RSZ = (size_t)MROWS * 1024 * 2;
constexpr size_t S_ADAWT = WS_S, S_SILUC = S_ADAWT + (size_t)2 * 6144 * LDH * 2;
constexpr size_t S_R = WS_S, S_K = S_R + RSZ, S_V = S_K + RSZ, S_EW = S_V + RSZ, S_A = S_EW + RSZ,
                 S_WH = S_A + RSZ, S_AH = S_WH + (size_t)MPAD * 64 * 2, S_GH = S_AH + (size_t)MPAD * 64 * 2,
                 S_RW_END = S_GH + (size_t)MPAD * 128 * 2;
constexpr size_t S_UP = WS_S;
constexpr size_t S_Q = WS_S, S_O = S_Q + (size_t)MPAD * 1024 * 2, S_KB = S_O + (size_t)MPAD * LDH * 2,
                 S_VT = S_KB + (size_t)MPAD * 256 * 2;
constexpr size_t WS_END = S_RW_END;
static_assert(S_UP + (size_t)MPAD * LDU * 2 <= WS_END, "up fits");
static_assert(S_VT + (size_t)16 * 64 * 4096 * 2 <= WS_END, "attn fits");
static_assert(WS_END <= 282000000, "ws fits sum of inputs");

constexpr int LDS_ROW = 144;
constexpr int LDS_A_BYTES = 256 * LDS_ROW;
constexpr int LDS_B_BYTES = 128 * LDS_ROW;
constexpr int LDS_STAGE = LDS_A_BYTES + LDS_B_BYTES;
constexpr int LDS_BYTES = 147456;

struct Params {
  const float *x_prompt, *x_sample, *c_prompt, *c_sample, *state_wkv, *state_shift, *cache_k, *cache_v;
  const float *norm1_g, *norm2_g, *ada_w, *ada_b, *mlp_up, *mlp_down, *final_g;
  const float *rw_mix, *rw_wr, *rw_wk, *rw_wv, *rw_wo, *rw_w0, *rw_w1, *rw_w2, *rw_a0, *rw_a1, *rw_a2, *rw_g1, *rw_g2,
      *rw_kk, *rw_ka, *rw_rk, *rw_lnx_g, *rw_lnx_b;
  const float *at_wqkv, *at_bqkv, *at_wo, *at_sink;
  float* out;
  char* ws;
};

__device__ __forceinline__ u16 f2bf(float f) {
  unsigned u = __float_as_uint(f);
  u += 0x7fffu + ((u >> 16) & 1u);
  return (u16)(u >> 16);
}
__device__ __forceinline__ float bf2f(u16 h) { return __uint_as_float(((unsigned)h) << 16); }
__device__ __forceinline__ float bflo(unsigned w) { return __uint_as_float(w << 16); }
__device__ __forceinline__ float bfhi(unsigned w) { return __uint_as_float(w & 0xffff0000u); }
__device__ __forceinline__ unsigned pack2(float a, float b) {
  unsigned r;
  asm volatile("v_cvt_pk_bf16_f32 %0, %1, %2" : "=v"(r) : "v"(a), "v"(b));
  return r;
}
__device__ __forceinline__ uint2 pack4(f32x4 v) { return uint2{pack2(v[0], v[1]), pack2(v[2], v[3])}; }
__device__ __forceinline__ float h2f(u16 h) { return (float)__builtin_bit_cast(_Float16, h); }
__device__ __forceinline__ u16 f2h(float f) { return __builtin_bit_cast(u16, (_Float16)f); }
__device__ __forceinline__ float sigmoidf_(float x) { return 1.f / (1.f + __expf(-x)); }

template <int CTRL>
__device__ __forceinline__ float dppf(float x) {
  return __int_as_float(__builtin_amdgcn_update_dpp(0, __float_as_int(x), CTRL, 0xf, 0xf, true));
}
__device__ __forceinline__ float rowsum16(float x) {
  x += dppf<0xB1>(x);
  x += dppf<0x4E>(x);
  x += dppf<0x124>(x);
  x += dppf<0x128>(x);
  return x;
}
__device__ __forceinline__ float rowmax16(float x) {
  x = fmaxf(x, dppf<0xB1>(x));
  x = fmaxf(x, dppf<0x4E>(x));
  x = fmaxf(x, dppf<0x124>(x));
  x = fmaxf(x, dppf<0x128>(x));
  return x;
}
__device__ __forceinline__ float wavesum(float x) {
#pragma unroll
  for (int o = 32; o > 0; o >>= 1) x += __shfl_xor(x, o);
  return x;
}
__device__ __forceinline__ float wavemax(float x) {
#pragma unroll
  for (int o = 32; o > 0; o >>= 1) x = fmaxf(x, __shfl_xor(x, o));
  return x;
}
__device__ __forceinline__ int bidx_of(int row) { return row < NP ? (row >> 12) : (4 + row - NP); }

#define XB_TMO      128
#define XB_XCNT(j)  (256  + 64 * (j))
#define XB_XSUB(j)  (1280 + 64 * (j))
#define XB_XGEN(j)  (2304 + 64 * (j))
#define XB_TOP      3328
#define XB_TOPGEN   3392
#define XCD_BAR_WORDS 3456
#define XB_SPIN_CAP (1u << 22)
#define LAS __attribute__((address_space(3)))
__device__ __forceinline__ unsigned xb_ld(unsigned* p) { return __hip_atomic_load(p, __ATOMIC_RELAXED, __HIP_MEMORY_SCOPE_AGENT); }
__device__ __forceinline__ unsigned xb_add(unsigned* p, unsigned v) { return __hip_atomic_fetch_add(p, v, __ATOMIC_RELAXED, __HIP_MEMORY_SCOPE_AGENT); }
__device__ __forceinline__ unsigned xb_xcc_id() { return (unsigned)__builtin_amdgcn_s_getreg((3 << 11) | 20) & 0xFu; }
#define XB_SPIN(cond, bar) do { unsigned _sp = 0; while (cond) { __builtin_amdgcn_s_sleep(1); \
    if ((++_sp & 255u) == 0u) { if (xb_ld(&(bar)[XB_TMO])) break; if (_sp > XB_SPIN_CAP) { atomicAdd(&(bar)[XB_TMO], 1u); break; } } } } while (0)
struct XcdBarrier {
  unsigned* bar;
  unsigned x;
  volatile LAS unsigned* st;
};
__device__ __forceinline__ XcdBarrier xcd_barrier_post(unsigned* bar, volatile LAS unsigned* st) {
  XcdBarrier b;
  b.bar = bar;
  b.x = xb_xcc_id();
  b.st = st;
  if (threadIdx.x == 0) (void)xb_add(&bar[XB_XCNT(b.x)], 1u);
  return b;
}
__device__ __forceinline__ void xcd_barrier_complete(unsigned* bar, unsigned x, unsigned& nloc, unsigned& nx) {
  const unsigned G = gridDim.x * gridDim.y * gridDim.z;
  unsigned sum, cnt, mine, sp = 0u;
  for (;;) {
    sum = 0u; cnt = 0u; mine = 0u;
#pragma unroll
    for (unsigned j = 0; j < 16; ++j) {
      const unsigned c = xb_ld(&bar[XB_XCNT(j)]);
      sum += c;
      cnt += (c > 0u) ? 1u : 0u;
      mine = (j == x) ? c : mine;
    }
    if (sum == G) break;
    __builtin_amdgcn_s_sleep(1);
    if ((++sp & 255u) == 0u) {
      if (xb_ld(&bar[XB_TMO])) break;
      if (sp > XB_SPIN_CAP) { atomicAdd(&bar[XB_TMO], 1u); break; }
    }
  }
  nloc = mine > 0u ? mine : 1u;
  nx = cnt > 0u ? cnt : 1u;
}
__device__ __forceinline__ void xcd_barrier(const XcdBarrier& b) {
  asm volatile("s_waitcnt vmcnt(0)" ::: "memory");
  __syncthreads();
  if (threadIdx.x == 0) {
    unsigned* bar = b.bar;
    __builtin_amdgcn_s_waitcnt(0);
    unsigned nloc = b.st[0], nx = b.st[1];
    if (nloc == 0u) { xcd_barrier_complete(bar, b.x, nloc, nx); b.st[0] = nloc; b.st[1] = nx; }
    const unsigned old = xb_add(&bar[XB_XSUB(b.x)], 1u);
    const unsigned gen = old / nloc;
    if (old + 1u == (gen + 1u) * nloc) {
      __builtin_amdgcn_fence(__ATOMIC_RELEASE, "agent");
      asm volatile("s_waitcnt vmcnt(0)" ::: "memory");
      const unsigned og = xb_add(&bar[XB_TOP], 1u);
      const unsigned tg = og / nx;
      if (og + 1u == (tg + 1u) * nx) xb_add(&bar[XB_TOPGEN], 1u);
      else XB_SPIN(xb_ld(&bar[XB_TOPGEN]) == tg, bar);
      __builtin_amdgcn_fence(__ATOMIC_ACQUIRE, "agent");
      xb_add(&bar[XB_XGEN(b.x)], 1u);
      asm volatile("s_waitcnt vmcnt(0)" ::: "memory");
    } else {
      XB_SPIN(xb_ld(&bar[XB_XGEN(b.x)]) == gen, bar);
      __builtin_amdgcn_fence(__ATOMIC_ACQUIRE, "agent");
      asm volatile("s_waitcnt vmcnt(0)" ::: "memory");
    }
  }
  __syncthreads();
}

#define BAR_SYNC() do { asm volatile("s_waitcnt lgkmcnt(0)" ::: "memory"); __builtin_amdgcn_s_barrier(); asm volatile("" ::: "memory"); } while (0)

__device__ __forceinline__ unsigned mix2(unsigned h, unsigned p, float m0, float m1) {
  float h0 = bflo(h), h1 = bfhi(h), p0 = bflo(p), p1 = bfhi(p);
  return pack2(h0 + (p0 - h0) * m0, h1 + (p1 - h1) * m1);
}

template <bool MIX, class Epi>
__device__ __forceinline__ void gemm_tile(const u16* __restrict__ A, int lda, const float* __restrict__ mixv,
                                          const u16* __restrict__ Bt, int ldb, int N, int K, int m0, int n0, char* lds, Epi&& epi) {
  const int tid = threadIdx.x, lane = tid & 63, w = tid >> 6;
  const int nk = K >> 6;
  if (w >= 4) {
    const int pt = tid - 256, kc = pt & 7, pr = pt >> 3;
    const u16* Ab = A + (size_t)m0 * lda + (size_t)pr * lda + kc * 8;
    int poff[8];
#pragma unroll
    for (int i = 0; i < 8; ++i) {
      poff[i] = 0;
      if (MIX) {
        const int row = m0 + pr + 32 * i;
        const int prow = row < NP ? ((row & 4095) ? row - 1 : MPAD) : (row < MROWS ? row + 128 : MPAD);
        poff[i] = prow * LDH + kc * 8;
      }
    }
    bool bv[4];
    const u16* bp[4];
#pragma unroll
    for (int j = 0; j < 4; ++j) {
      const int n = n0 + pr + 32 * j;
      bv[j] = n < N;
      bp[j] = Bt + (size_t)(bv[j] ? n : 0) * ldb + kc * 8;
    }
    struct RSet {
      uint4 ra[8], rp[8], rb[4];
      float4 mx0, mx1;
    };
    RSet SA, SB;
    auto gload = [&](RSet& S, int kt) {
      const int ko = kt * 64;
#pragma unroll
      for (int i = 0; i < 8; ++i) {
        S.ra[i] = *(const uint4*)(Ab + (size_t)(32 * i) * lda + ko);
        if (MIX) S.rp[i] = *(const uint4*)(A + poff[i] + ko);
      }
      if (MIX) {
        S.mx0 = *(const float4*)(mixv + ko + kc * 8);
        S.mx1 = *(const float4*)(mixv + ko + kc * 8 + 4);
      }
#pragma unroll
      for (int j = 0; j < 4; ++j) {
        uint4 z = {0u, 0u, 0u, 0u};
        if (bv[j]) z = *(const uint4*)(bp[j] + ko);
        S.rb[j] = z;
      }
    };
    auto lstore = [&](RSet& S, int s) {
      char* base = lds + s * LDS_STAGE + pr * LDS_ROW + kc * 16;
#pragma unroll
      for (int i = 0; i < 8; ++i) {
        uint4 v = S.ra[i];
        if (MIX) {
          v.x = mix2(S.ra[i].x, S.rp[i].x, S.mx0.x, S.mx0.y);
          v.y = mix2(S.ra[i].y, S.rp[i].y, S.mx0.z, S.mx0.w);
          v.z = mix2(S.ra[i].z, S.rp[i].z, S.mx1.x, S.mx1.y);
          v.w = mix2(S.ra[i].w, S.rp[i].w, S.mx1.z, S.mx1.w);
        }
        *(uint4*)(base + (32 * i) * LDS_ROW) = v;
      }
#pragma unroll
      for (int j = 0; j < 4; ++j) *(uint4*)(base + LDS_A_BYTES + (32 * j) * LDS_ROW) = S.rb[j];
    };
    if constexpr (!MIX) {
      gload(SB, 0);
      if (nk > 1) gload(SA, 1);
      lstore(SB, 0);
      if (nk > 2) gload(SB, 2);
      BAR_SYNC();
#pragma unroll 1
      for (int kt = 0; kt < nk; kt += 2) {
        if (kt + 1 < nk) {
          lstore(SA, 1);
          if (kt + 3 < nk) gload(SA, kt + 3);
        }
        BAR_SYNC();
        if (kt + 1 < nk) {
          if (kt + 2 < nk) {
            lstore(SB, 0);
            if (kt + 4 < nk) gload(SB, kt + 4);
          }
          BAR_SYNC();
        }
      }
    } else {
      gload(SA, 0);
      lstore(SA, 0);
      if (nk > 1) gload(SA, 1);
      BAR_SYNC();
#pragma unroll 1
      for (int kt = 0; kt < nk; ++kt) {
        if (kt + 1 < nk) {
          lstore(SA, (kt + 1) & 1);
          if (kt + 2 < nk) gload(SA, kt + 2);
        }
        BAR_SYNC();
      }
    }
  } else {
    const int wm = w >> 1, wn = w & 1, lr = lane & 15, lg = lane >> 4;
    f32x4 acc[8][4];
#pragma unroll
    for (int i = 0; i < 8; ++i)
#pragma unroll
      for (int j = 0; j < 4; ++j) acc[i][j] = f32x4{0.f, 0.f, 0.f, 0.f};
    BAR_SYNC();
#pragma unroll 1
    for (int kt = 0; kt < nk; ++kt) {
      const char* sa = lds + (kt & 1) * LDS_STAGE + (wm * 128 + lr) * LDS_ROW + lg * 16;
      const char* sb = lds + (kt & 1) * LDS_STAGE + LDS_A_BYTES + (wn * 64 + lr) * LDS_ROW + lg * 16;
      bf16x8 bq[2][4], aq[3];
#pragma unroll
      for (int ni = 0; ni < 4; ++ni) bq[0][ni] = *(const bf16x8*)(sb + ni * 16 * LDS_ROW);
      aq[0] = *(const bf16x8*)(sa);
      aq[1] = *(const bf16x8*)(sa + 16 * LDS_ROW);
#pragma unroll
      for (int ni = 0; ni < 4; ++ni) bq[1][ni] = *(const bf16x8*)(sb + ni * 16 * LDS_ROW + 64);
#pragma unroll
      for (int st = 0; st < 16; ++st) {
        if (st + 2 < 16) aq[(st + 2) % 3] = *(const bf16x8*)(sa + ((st + 2) & 7) * 16 * LDS_ROW + ((st + 2) >> 3) * 64);
#pragma unroll
        for (int ni = 0; ni < 4; ++ni)
          acc[st & 7][ni] = __builtin_amdgcn_mfma_f32_16x16x32_bf16(bq[st >> 3][ni], aq[st % 3], acc[st & 7][ni], 0, 0, 0);
        __builtin_amdgcn_sched_barrier(0);
      }
      BAR_SYNC();
    }
    epi(acc, wm, wn, lr, lg);
  }
}

constexpr int LDS_STAGE2 = 2 * LDS_A_BYTES;
template <class Epi>
__device__ __forceinline__ void gemm_tile256(const u16* __restrict__ A, int lda, const u16* __restrict__ Bt, int ldb, int K, int m0,
                                             int n0, char* lds, bool half, Epi&& epi) {
  int tid = threadIdx.x;
  asm volatile("" : "+v"(tid));
  const int lane = tid & 63, w = __builtin_amdgcn_readfirstlane(tid >> 6);
  const int wm = w >> 2, wn = w & 3, lr = lane & 15, lg = lane >> 4;
  const int kc = tid & 7, r0 = tid >> 3;
  const int nk = K >> 6;
  const u16* Ab = A + (size_t)(m0 + r0) * lda + kc * 8;
  const u16* Bb = Bt + (size_t)(n0 + r0) * ldb + kc * 8;
  struct LSet {
    uint4 ra[4], rb[4];
  };
  LSet S;
  auto gload = [&](LSet& R, int kt) {
    const int ko = kt * 64;
#pragma unroll
    for (int i = 0; i < 4; ++i) {
      R.ra[i] = *(const uint4*)(Ab + (size_t)(64 * i) * lda + ko);
      R.rb[i] = *(const uint4*)(Bb + (size_t)(64 * i) * ldb + ko);
    }
  };
  auto lstore = [&](LSet& R, int s) {
    char* base = lds + s * LDS_STAGE2 + r0 * LDS_ROW + kc * 16;
#pragma unroll
    for (int i = 0; i < 4; ++i) {
      *(uint4*)(base + (64 * i) * LDS_ROW) = R.ra[i];
      *(uint4*)(base + LDS_A_BYTES + (64 * i) * LDS_ROW) = R.rb[i];
    }
  };
  f32x4 acc[8][4];
#pragma unroll
  for (int i = 0; i < 8; ++i)
#pragma unroll
    for (int j = 0; j < 4; ++j) acc[i][j] = f32x4{0.f, 0.f, 0.f, 0.f};
  gload(S, 0);
  lstore(S, 0);
  BAR_SYNC();
#pragma unroll 1
  for (int kt = 0; kt < nk; ++kt) {
    gload(S, kt + 1 < nk ? kt + 1 : kt);
    const char* sa = lds + (kt & 1) * LDS_STAGE2 + (wm * 128 + lr) * LDS_ROW + lg * 16;
    const char* sb = lds + (kt & 1) * LDS_STAGE2 + LDS_A_BYTES + (wn * 64 + lr) * LDS_ROW + lg * 16;
    if (!(half && wm == 1)) {
      bf16x8 bq[4], aq[3];
#pragma unroll
      for (int ni = 0; ni < 4; ++ni) bq[ni] = *(const bf16x8*)(sb + ni * 16 * LDS_ROW);
      aq[0] = *(const bf16x8*)(sa);
      aq[1] = *(const bf16x8*)(sa + 16 * LDS_ROW);
#pragma unroll
      for (int st = 0; st < 16; ++st) {
        if (st + 2 < 16) aq[(st + 2) % 3] = *(const bf16x8*)(sa + ((st + 2) & 7) * 16 * LDS_ROW + ((st + 2) >> 3) * 64);
#pragma unroll
        for (int ni = 0; ni < 4; ++ni)
          acc[st & 7][ni] = __builtin_amdgcn_mfma_f32_16x16x32_bf16(bq[ni], aq[st % 3], acc[st & 7][ni], 0, 0, 0);
        if (st == 7) {
#pragma unroll
          for (int ni = 0; ni < 4; ++ni) bq[ni] = *(const bf16x8*)(sb + ni * 16 * LDS_ROW + 64);
        }
        __builtin_amdgcn_sched_barrier(0);
      }
    }
    lstore(S, (kt + 1) & 1);
    BAR_SYNC();
  }
  epi(acc, wm, wn, lr, lg);
}

#define EPI_FOREACH(acc, ...)                                    \
  _Pragma("unroll") for (int mi = 0; mi < 8; ++mi) {             \
    const int row = m0 + wm * 128 + mi * 16 + lr;                \
    _Pragma("unroll") for (int ni = 0; ni < 4; ++ni) {           \
      const int col0 = n0 + wn * 64 + ni * 16 + lg * 4;          \
      const f32x4 v = acc[mi][ni];                               \
      __VA_ARGS__                                                \
    }                                                            \
    __builtin_amdgcn_sched_barrier(0);                           \
  }
#define EPI_ARGS f32x4(&acc)[8][4], int wm, int wn, int lr, int lg

__device__ __forceinline__ void conv_job(const float* __restrict__ src, u16* __restrict__ dst, int K, int N, int ldk, float* tl, int rot) {
  int tid = threadIdx.x;
  asm volatile("" : "+v"(tid));
  const int tn = N >> 6, nt = (K >> 6) * tn;
  const int G = gridDim.x;
  int t = ((int)blockIdx.x + G - (rot % G)) % G;
  float v[8];
  auto ldtile = [&](int tt) {
    const int k0 = (tt / tn) << 6, n0 = (tt % tn) << 6;
#pragma unroll
    for (int i = 0; i < 8; ++i) {
      const int e = tid + 512 * i;
      v[i] = src[(size_t)(k0 + (e >> 6)) * N + n0 + (e & 63)];
    }
  };
  if (t < nt) ldtile(t);
  while (t < nt) {
    const int k0 = (t / tn) << 6, n0 = (t % tn) << 6;
#pragma unroll
    for (int i = 0; i < 8; ++i) {
      const int e = tid + 512 * i;
      tl[(e >> 6) * 65 + (e & 63)] = v[i];
    }
    const int tnx = t + G;
    if (tnx < nt) ldtile(tnx);
    __syncthreads();
    const int n = tid >> 3, kc = tid & 7;
    float f[8];
#pragma unroll
    for (int j = 0; j < 8; ++j) f[j] = tl[(kc * 8 + j) * 65 + n];
    uint4 o;
    o.x = pack2(f[0], f[1]);
    o.y = pack2(f[2], f[3]);
    o.z = pack2(f[4], f[5]);
    o.w = pack2(f[6], f[7]);
    *(uint4*)(dst + (size_t)(n0 + n) * ldk + k0 + kc * 8) = o;
    __syncthreads();
    t = tnx;
  }
}

__device__ __forceinline__ void phase0(const Params& p, char* lds) {
  float* tl = (float*)lds;
  u16* wt = (u16*)(p.ws + WS_WT);
  u16* adawt = (u16*)(p.ws + S_ADAWT);
  int rot = 0;
#define CJ(SRC, DST, K, N)            \
  conv_job(SRC, DST, K, N, ((K) == 1024 ? LDH : (K) == 4096 ? LDU : (K)), tl, rot);  \
  rot += ((K) >> 6) * ((N) >> 6);
  CJ(p.ada_w, adawt, 1024, 6144)
  CJ(p.ada_w + (size_t)1024 * 6144, adawt + (size_t)6144 * LDH, 1024, 6144)
  CJ(p.rw_wr, wt + WT_WR, 1024, 1024)
  CJ(p.rw_wk, wt + WT_WK, 1024, 1024)
  CJ(p.rw_wv, wt + WT_WV, 1024, 1024)
  CJ(p.rw_wo, wt + WT_WO, 1024, 1024)
  CJ(p.rw_w1, wt + WT_W1, 1024, 64)
  CJ(p.rw_a1, wt + WT_A1, 1024, 64)
  CJ(p.rw_g1, wt + WT_G1, 1024, 128)
  CJ(p.rw_w2, wt + WT_W2, 64, 1024)
  CJ(p.rw_a2, wt + WT_A2, 64, 1024)
  CJ(p.rw_g2, wt + WT_G2, 128, 1024)
  CJ(p.mlp_up, wt + WT_UP0, 1024, 4096)
  CJ(p.mlp_down, wt + WT_DN0, 4096, 1024)
  CJ(p.at_wqkv, wt + WT_QKV, 1024, 1536)
  CJ(p.at_wo, wt + WT_WO1, 1024, 1024)
  CJ(p.mlp_up + (size_t)4 * MEG, wt + WT_UP1, 1024, 4096)
  CJ(p.mlp_down + (size_t)4 * MEG, wt + WT_DN1, 4096, 1024)
#undef CJ
  const int gtid = blockIdx.x * NTHR + threadIdx.x, gsz = gridDim.x * NTHR;
  u16* siluc = (u16*)(p.ws + S_SILUC);
  for (int i = gtid; i < 256 * 1024; i += gsz) {
    int row = i >> 10, col = i & 1023;
    float c = 0.f;
    if (row < 4) c = p.c_prompt[row * 1024 + col];
    else if (row < 132) c = p.c_sample[(row - 4) * 1024 + col];
    siluc[i] = f2bf(c * sigmoidf_(c));
  }
  u16* hs = (u16*)(p.ws + WS_HS);
  for (int i = gtid; i < 128 * 1024; i += gsz) hs[(size_t)(i >> 10) * LDH + (i & 1023)] = f2bf(p.state_shift[i]);
  u16* zr = (u16*)(p.ws + WS_ZR);
  for (int i = gtid; i < LDH; i += gsz) zr[i] = 0;
  float2* tab = (float2*)(p.ws + WS_TAB);
  for (int i = gtid; i < 4097 * 8; i += gsz) {
    int pi = i >> 3, f = i & 7;
    float pos = pi < 4096 ? (float)pi : 8192.f;
    float inv = f == 0 ? 1.0f : f == 1 ? 0.1939227432012558f : f == 2 ? 0.03760603070259094f : f == 3 ? 0.007292664609849453f
              : f == 4 ? 0.0014142135623842478f : f == 5 ? 0.00027424818836152554f : f == 6 ? 5.318296098266728e-05f
              : 1.0313386155758053e-05f;
    float ang = pos * inv;
    double t = (double)ang * 0.15915494309189535;
    t -= rint(t);
    float fr = (float)t;
    tab[i] = make_float2(__builtin_amdgcn_cosf(fr), __builtin_amdgcn_sinf(fr));
  }
}

__device__ __forceinline__ void phase_ada(const Params& p, char* lds) {
  const u16* siluc = (const u16*)(p.ws + S_SILUC);
  const u16* adawt = (const u16*)(p.ws + S_ADAWT);
  float* mod = (float*)(p.ws + WS_MOD);
  for (int t = blockIdx.x; t < 96; t += gridDim.x) {
    const int layer = t / 48, nt = t % 48;
    const int m0 = 0, n0 = nt * 128;
    const float* bias = p.ada_b + layer * 6144;
    float* mo = mod + (size_t)layer * 132 * 6144;
    gemm_tile<false>(siluc, 1024, nullptr, adawt + (size_t)layer * 6144 * LDH, LDH, 6144, 1024, m0, n0, lds, [&](EPI_ARGS) {
      EPI_FOREACH(acc, if (row < 132) {
        const float4 b4 = *(const float4*)(bias + col0);
        *(float4*)(mo + (size_t)row * 6144 + col0) = make_float4(v[0] + b4.x, v[1] + b4.y, v[2] + b4.z, v[3] + b4.w);
      })
    });
  }
}

__device__ __forceinline__ void phase_norm(const Params& p, int layer, int which, bool from_input, bool shift_out) {
  const int lane = threadIdx.x & 63, w = threadIdx.x >> 6;
  const float* mod = (const float*)(p.ws + WS_MOD);
  u16* H = (u16*)(p.ws + WS_H);
  const float* g = (which ? p.norm2_g : p.norm1_g) + layer * 1024;
  const int nw = gridDim.x * 8;
  auto xrow = [&](int row) {
    return from_input ? (row < NP ? p.x_prompt + (size_t)row * 1024 : p.x_sample + (size_t)(row - NP) * 1024)
                      : (const float*)p.out + (size_t)row * 1024;
  };
  float4 gg[4];
#pragma unroll
  for (int i = 0; i < 4; ++i) gg[i] = *(const float4*)(g + lane * 4 + 256 * i);
  int row = blockIdx.x * 8 + w;
  float4 xn[4];
  if (row < MROWS) {
    const float* xr = xrow(row);
#pragma unroll
    for (int i = 0; i < 4; ++i) xn[i] = *(const float4*)(xr + lane * 4 + 256 * i);
  }
  while (row < MROWS) {
    float4 x[4];
#pragma unroll
    for (int i = 0; i < 4; ++i) x[i] = xn[i];
    const int nrow = row + nw;
    if (nrow < MROWS) {
      const float* xr = xrow(nrow);
#pragma unroll
      for (int i = 0; i < 4; ++i) xn[i] = *(const float4*)(xr + lane * 4 + 256 * i);
    }
    const int bi = bidx_of(row);
    const float* mb = mod + ((size_t)layer * 132 + bi) * 6144;
    const float* sh = mb + (which ? 3 : 0) * 1024;
    const float* sc = mb + (which ? 4 : 1) * 1024;
    float4 s4[4], c4[4];
#pragma unroll
    for (int i = 0; i < 4; ++i) {
      s4[i] = *(const float4*)(sh + lane * 4 + 256 * i);
      c4[i] = *(const float4*)(sc + lane * 4 + 256 * i);
    }
    float ss = 0.f;
#pragma unroll
    for (int i = 0; i < 4; ++i) ss += x[i].x * x[i].x + x[i].y * x[i].y + x[i].z * x[i].z + x[i].w * x[i].w;
    ss = wavesum(ss);
    const float rs = rsqrtf(ss * (1.f / 1024.f) + 1e-6f);
    const bool so = shift_out && (row >= NP || (row & 4095) == 4095);
    float* sop = row >= NP ? p.out + O_SHS + (size_t)(row - NP) * 1024 : p.out + O_SHP + (size_t)(row >> 12) * 1024;
#pragma unroll
    for (int i = 0; i < 4; ++i) {
      const int c = lane * 4 + 256 * i;
      float4 h;
      h.x = x[i].x * rs * gg[i].x * (1.f + c4[i].x) + s4[i].x;
      h.y = x[i].y * rs * gg[i].y * (1.f + c4[i].y) + s4[i].y;
      h.z = x[i].z * rs * gg[i].z * (1.f + c4[i].z) + s4[i].z;
      h.w = x[i].w * rs * gg[i].w * (1.f + c4[i].w) + s4[i].w;
      uint2 pk;
      pk.x = pack2(h.x, h.y);
      pk.y = pack2(h.z, h.w);
      *(uint2*)(H + (size_t)row * LDH + c) = pk;
      if (so) *(float4*)(sop + c) = h;
      if (from_input && row >= NP) *(float4*)(p.out + (size_t)row * 1024 + c) = x[i];
    }
    row = nrow;
  }
}

__device__ __forceinline__ void phase_final(const Params& p) {
  const int lane = threadIdx.x & 63, w = threadIdx.x >> 6;
  const int nw = gridDim.x * 8;
  for (int row = blockIdx.x * 8 + w; row < MROWS; row += nw) {
    float* xr = p.out + (size_t)row * 1024;
    float4 x[4];
    float ss = 0.f;
#pragma unroll
    for (int i = 0; i < 4; ++i) {
      x[i] = *(const float4*)(xr + lane * 4 + 256 * i);
      ss += x[i].x * x[i].x + x[i].y * x[i].y + x[i].z * x[i].z + x[i].w * x[i].w;
    }
    ss = wavesum(ss);
    const float rs = rsqrtf(ss * (1.f / 1024.f) + 1e-6f);
#pragma unroll
    for (int i = 0; i < 4; ++i) {
      const int c = lane * 4 + 256 * i;
      float4 gg = *(const float4*)(p.final_g + c);
      float4 h;
      h.x = x[i].x * rs * gg.x;
      h.y = x[i].y * rs * gg.y;
      h.z = x[i].z * rs * gg.z;
      h.w = x[i].w * rs * gg.w;
      *(float4*)(xr + c) = h;
    }
  }
}

__device__ __forceinline__ void phase_rwkv_proj(const Params& p, char* lds) {
  const u16* H = (const u16*)(p.ws + WS_H);
  const u16* wt = (const u16*)(p.ws + WS_WT);
  u16* R = (u16*)(p.ws + S_R);
  u16* Kk = (u16*)(p.ws + S_K);
  u16* V = (u16*)(p.ws + S_V);
  u16* WH = (u16*)(p.ws + S_WH);
  u16* AH = (u16*)(p.ws + S_AH);
  u16* GH = (u16*)(p.ws + S_GH);
  for (int t = blockIdx.x; t < 65 * 27; t += gridDim.x) {
    const int mt = t / 27, j = t % 27;
    const int m0 = mt * 256;
    int kind, n0, N, mixi;
    const u16* Bt;
    if (j < 8) { kind = 0; n0 = j * 128; N = 1024; mixi = 0; Bt = wt + WT_WR; }
    else if (j < 16) { kind = 1; n0 = (j - 8) * 128; N = 1024; mixi = 2; Bt = wt + WT_WK; }
    else if (j < 24) { kind = 2; n0 = (j - 16) * 128; N = 1024; mixi = 3; Bt = wt + WT_WV; }
    else if (j == 24) { kind = 3; n0 = 0; N = 64; mixi = 1; Bt = wt + WT_W1; }
    else if (j == 25) { kind = 4; n0 = 0; N = 64; mixi = 4; Bt = wt + WT_A1; }
    else { kind = 5; n0 = 0; N = 128; mixi = 5; Bt = wt + WT_G1; }
    gemm_tile<true>(H, LDH, p.rw_mix + mixi * 1024, Bt, LDH, N, 1024, m0, n0, lds, [&](EPI_ARGS) {
      u16* dst = kind == 0 ? R : kind == 1 ? Kk : kind == 2 ? V : kind == 3 ? WH : kind == 4 ? AH : GH;
      const int ld = kind < 3 ? 1024 : (kind == 5 ? 128 : 64);
      EPI_FOREACH(acc, if (row < MROWS && col0 < ld) {
        f32x4 o = v;
        if (kind == 3) {
          _Pragma("unroll") for (int q = 0; q < 4; ++q) o[q] = 1.f - 2.f / (__expf(2.f * v[q]) + 1.f);
        } else if (kind == 5) {
          _Pragma("unroll") for (int q = 0; q < 4; ++q) o[q] = sigmoidf_(v[q]);
        }
        *(uint2*)(dst + (size_t)row * ld + col0) = pack4(o);
      })
    });
  }
}

__device__ __forceinline__ void phase_rwkv_lora2(const Params& p, char* lds) {
  const u16* wt = (const u16*)(p.ws + WS_WT);
  const u16* WH = (const u16*)(p.ws + S_WH);
  const u16* AH = (const u16*)(p.ws + S_AH);
  u16* EW = (u16*)(p.ws + S_EW);
  u16* Aa = (u16*)(p.ws + S_A);
  for (int t = blockIdx.x; t < 65 * 16; t += gridDim.x) {
    const int mt = t >> 4, j = t & 15;
    const int m0 = mt * 256, n0 = (j & 7) * 128;
    const bool isw = j < 8;
    gemm_tile<false>(isw ? WH : AH, 64, nullptr, wt + (isw ? WT_W2 : WT_A2), 64, 1024, 64, m0, n0, lds, [&](EPI_ARGS) {
      const float* b0 = isw ? p.rw_w0 : p.rw_a0;
      EPI_FOREACH(acc, if (row < MROWS) {
        const float4 b4 = *(const float4*)(b0 + col0);
        const float s0 = sigmoidf_(v[0] + b4.x), s1 = sigmoidf_(v[1] + b4.y), s2 = sigmoidf_(v[2] + b4.z), s3 = sigmoidf_(v[3] + b4.w);
        if (isw) {
          const float c = 0.6065306597126334f;
          uint2 o;
          o.x = (unsigned)f2h(c * s0) | ((unsigned)f2h(c * s1) << 16);
          o.y = (unsigned)f2h(c * s2) | ((unsigned)f2h(c * s3) << 16);
          *(uint2*)(EW + (size_t)row * 1024 + col0) = o;
        } else {
          uint2 o;
          o.x = pack2(s0, s1);
          o.y = pack2(s2, s3);
          *(uint2*)(Aa + (size_t)row * 1024 + col0) = o;
        }
      })
    });
  }
}

constexpr int RING_TS = 344;
constexpr int RING_BUF = 16 * RING_TS;

__device__ __forceinline__ void phase_scan(const Params& p, char* lds) {
  const int tid = threadIdx.x, lane = tid & 63, w = tid >> 6;
  const u16* R = (const u16*)(p.ws + S_R);
  const u16* Kk = (const u16*)(p.ws + S_K);
  const u16* V = (const u16*)(p.ws + S_V);
  const u16* EW = (const u16*)(p.ws + S_EW);
  const u16* Aa = (const u16*)(p.ws + S_A);
  u16* Y = (u16*)(p.ws + WS_H);
  float* RK = (float*)(p.ws + WS_RK);
  float* ring = (float*)lds;
  float* ybuf = (float*)(lds + 2 * RING_BUF * 4);
  for (int item = blockIdx.x; item < 256; item += gridDim.x) {
    const int chain = item >> 2, qr = item & 3, b = chain >> 4, h = chain & 15;
    const size_t rowbase = (size_t)b * 4096;
    __syncthreads();
    if (tid >= 256) {
      const int pt = tid - 256, tok = pt >> 4, cq = pt & 15;
      const int ch = h * 64 + cq * 4;
      const float4 kk4 = *(const float4*)(p.rw_kk + ch), ka4 = *(const float4*)(p.rw_ka + ch), rk4 = *(const float4*)(p.rw_rk + ch);
      struct PS {
        uint2 rr, rk_, rv, ra_, re;
      };
      PS S0, S1;
      auto pload = [&](PS& S, int c) {
        const size_t off = (rowbase + (size_t)c * 16 + tok) * 1024 + ch;
        S.rr = *(const uint2*)(R + off);
        S.rk_ = *(const uint2*)(Kk + off);
        S.rv = *(const uint2*)(V + off);
        S.ra_ = *(const uint2*)(Aa + off);
        S.re = *(const uint2*)(EW + off);
      };
      auto pproc = [&](PS& S, int c) {
        const uint2 rr = S.rr, rk_ = S.rk_, rv = S.rv, ra_ = S.ra_, re = S.re;
        float rf[4] = {bflo(rr.x), bfhi(rr.x), bflo(rr.y), bfhi(rr.y)};
        float kf[4] = {bflo(rk_.x), bfhi(rk_.x), bflo(rk_.y), bfhi(rk_.y)};
        float vf[4] = {bflo(rv.x), bfhi(rv.x), bflo(rv.y), bfhi(rv.y)};
        float af[4] = {bflo(ra_.x), bfhi(ra_.x), bflo(ra_.y), bfhi(ra_.y)};
        float ef[4] = {h2f((u16)(re.x & 0xffff)), h2f((u16)(re.x >> 16)), h2f((u16)(re.y & 0xffff)), h2f((u16)(re.y >> 16))};
        const float kkw[4] = {kk4.x, kk4.y, kk4.z, kk4.w}, kaw[4] = {ka4.x, ka4.y, ka4.z, ka4.w}, rkw[4] = {rk4.x, rk4.y, rk4.z, rk4.w};
        float kkr[4], kp[4], ss = 0.f, rks = 0.f;
#pragma unroll
        for (int j = 0; j < 4; ++j) {
          kkr[j] = kf[j] * kkw[j];
          ss += kkr[j] * kkr[j];
          kp[j] = kf[j] * (1.f + (af[j] - 1.f) * kaw[j]);
          rks += rf[j] * kp[j] * rkw[j];
        }
        ss = rowsum16(ss);
        rks = rowsum16(rks);
        const float inv = 1.f / fmaxf(sqrtf(ss), 1e-12f);
        float* slot = ring + (c & 1) * RING_BUF + tok * RING_TS;
        float am[4], dc[4], bm[4], wr[4], br = 0.f, kr = 0.f;
#pragma unroll
        for (int j = 0; j < 4; ++j) {
          am[j] = -kkr[j] * inv;
          dc[j] = __expf(-ef[j]);
          bm[j] = kkr[j] * inv * af[j];
          wr[j] = dc[j] * rf[j];
          br += bm[j] * rf[j];
          kr += kp[j] * rf[j];
        }
        br = rowsum16(br);
        kr = rowsum16(kr);
        *(float4*)(slot + cq * 4) = make_float4(am[0], am[1], am[2], am[3]);
        *(float4*)(slot + 64 + cq * 4) = make_float4(dc[0], dc[1], dc[2], dc[3]);
        *(float4*)(slot + 128 + cq * 4) = make_float4(bm[0], bm[1], bm[2], bm[3]);
        *(float4*)(slot + 192 + cq * 4) = make_float4(kp[0], kp[1], kp[2], kp[3]);
        *(float4*)(slot + 256 + cq * 4) = make_float4(wr[0], wr[1], wr[2], wr[3]);
        if (cq == 0) *(float2*)(slot + 336) = make_float2(br, kr);
        if ((cq >> 2) == qr) *(float4*)(slot + 320 + (cq & 3) * 4) = make_float4(vf[0], vf[1], vf[2], vf[3]);
        if (cq == 0 && qr == 0) RK[(rowbase + (size_t)c * 16 + tok) * 16 + h] = rks;
      };
      pload(S0, 0);
      pproc(S0, 0);
      pload(S1, 1);
      pload(S0, 2);
      BAR_SYNC();
#pragma unroll 1
      for (int c = 0; c < 256; c += 2) {
        pproc(S1, c + 1);
        if (c + 3 < 256) pload(S1, c + 3);
        BAR_SYNC();
        if (c + 2 < 256) pproc(S0, c + 2);
        if (c + 4 < 256) pload(S0, c + 4);
        BAR_SYNC();
      }
    } else {
      const int rl = tid >> 4, cgp = tid & 15;
      float s0 = 0.f, s1 = 0.f, s2 = 0.f, s3 = 0.f;
      BAR_SYNC();
      for (int c = 0; c < 256; ++c) {
        if (c > 0) {
          const float yv = ybuf[((c - 1) & 1) * 256 + tid];
          Y[(rowbase + (size_t)(c - 1) * 16 + rl) * LDH + h * 64 + qr * 16 + cgp] = f2bf(yv);
        }
        const float* bufp = ring + (c & 1) * RING_BUF;
        float* yb = ybuf + (c & 1) * 256;
        struct SV {
          float4 a, w, b, k, wr;
          float v;
          float2 bk;
        };
        auto ldstep = [&](const float* slot) {
          SV r;
          r.a = *(const float4*)(slot + cgp * 4);
          r.w = *(const float4*)(slot + 64 + cgp * 4);
          r.b = *(const float4*)(slot + 128 + cgp * 4);
          r.k = *(const float4*)(slot + 192 + cgp * 4);
          r.wr = *(const float4*)(slot + 256 + cgp * 4);
          r.v = slot[320 + rl];
          r.bk = *(const float2*)(slot + 336);
          return r;
        };
        SV cur = ldstep(bufp);
#pragma unroll
        for (int tk = 0; tk < 16; ++tk) {
          SV nxt = cur;
          if (tk + 1 < 16) nxt = ldstep(bufp + (tk + 1) * RING_TS);
          float sa = s0 * cur.a.x + s1 * cur.a.y + s2 * cur.a.z + s3 * cur.a.w;
          float yw = s0 * cur.wr.x + s1 * cur.wr.y + s2 * cur.wr.z + s3 * cur.wr.w;
          const float t0 = s0 * cur.w.x + cur.v * cur.k.x;
          const float t1 = s1 * cur.w.y + cur.v * cur.k.y;
          const float t2 = s2 * cur.w.z + cur.v * cur.k.z;
          const float t3 = s3 * cur.w.w + cur.v * cur.k.w;
          sa = rowsum16(sa);
          yw = rowsum16(yw);
          s0 = t0 + sa * cur.b.x;
          s1 = t1 + sa * cur.b.y;
          s2 = t2 + sa * cur.b.z;
          s3 = t3 + sa * cur.b.w;
          const float y = yw + sa * cur.bk.x + cur.v * cur.bk.y;
          if (cgp == 0) yb[tk * 16 + rl] = y;
          cur = nxt;
        }
        BAR_SYNC();
      }
      {
        const float yv = ybuf[(255 & 1) * 256 + tid];
        Y[(rowbase + (size_t)255 * 16 + rl) * LDH + h * 64 + qr * 16 + cgp] = f2bf(yv);
      }
      float* wo = p.out + O_WKVP + (((size_t)(b * 16 + h) * 64) + qr * 16 + rl) * 64 + cgp * 4;
      *(float4*)wo = make_float4(s0, s1, s2, s3);
    }
  }
  float* sl = (float*)lds;
  for (int chain = blockIdx.x; chain < 2048; chain += gridDim.x) {
    const int b = chain >> 4, h = chain & 15;
    const size_t row = (size_t)NP + b;
    __syncthreads();
    if (w == 0) {
      const int ch = h * 64 + lane;
      const size_t off = row * 1024 + ch;
      const float rf = bf2f(R[off]), kf = bf2f(Kk[off]), vf = bf2f(V[off]), af = bf2f(Aa[off]), ef = h2f(EW[off]);
      const float kkr = kf * p.rw_kk[ch];
      const float ss = wavesum(kkr * kkr);
      const float inv = 1.f / fmaxf(sqrtf(ss), 1e-12f);
      const float kp = kf * (1.f + (af - 1.f) * p.rw_ka[ch]);
      const float rks = wavesum(rf * kp * p.rw_rk[ch]);
      sl[lane] = -kkr * inv;
      sl[64 + lane] = __expf(-ef);
      sl[128 + lane] = kkr * inv * af;
      sl[192 + lane] = kp;
      sl[256 + lane] = rf;
      sl[320 + lane] = vf;
      if (lane == 0) RK[row * 16 + h] = rks;
    }
    __syncthreads();
    const int i = tid >> 3, c8 = tid & 7;
    const float* sp = p.state_wkv + (((size_t)(b * 16 + h) * 64) + i) * 64 + c8 * 8;
    float4 sA = *(const float4*)sp, sB = *(const float4*)(sp + 4);
    float s[8] = {sA.x, sA.y, sA.z, sA.w, sB.x, sB.y, sB.z, sB.w};
    float sa = 0.f;
#pragma unroll
    for (int j = 0; j < 8; ++j) sa += s[j] * sl[c8 * 8 + j];
    sa += __shfl_xor(sa, 1);
    sa += __shfl_xor(sa, 2);
    sa += __shfl_xor(sa, 4);
    const float vv = sl[320 + i];
    float y = 0.f;
#pragma unroll
    for (int j = 0; j < 8; ++j) {
      const int cj = c8 * 8 + j;
      s[j] = s[j] * sl[64 + cj] + sa * sl[128 + cj] + vv * sl[192 + cj];
      y += s[j] * sl[256 + cj];
    }
    y += __shfl_xor(y, 1);
    y += __shfl_xor(y, 2);
    y += __shfl_xor(y, 4);
    float* wo = p.out + O_WKVS + (((size_t)(b * 16 + h) * 64) + i) * 64 + c8 * 8;
    *(float4*)wo = make_float4(s[0], s[1], s[2], s[3]);
    *(float4*)(wo + 4) = make_float4(s[4], s[5], s[6], s[7]);
    if (c8 == 0) Y[row * LDH + h * 64 + i] = f2bf(y);
  }
}

__device__ __forceinline__ void phase_gate(const Params& p, char* lds) {
  const u16* wt = (const u16*)(p.ws + WS_WT);
  const u16* GH = (const u16*)(p.ws + S_GH);
  const u16* V = (const u16*)(p.ws + S_V);
  const float* RK = (const float*)(p.ws + WS_RK);
  u16* Y = (u16*)(p.ws + WS_H);
  for (int t = blockIdx.x; t < 65 * 8; t += gridDim.x) {
    const int mt = t >> 3, nt = t & 7;
    const int m0 = mt * 256, n0 = nt * 128;
    gemm_tile<false>(GH, 128, nullptr, wt + WT_G2, 128, 1024, 128, m0, n0, lds, [&](EPI_ARGS) {
      const int hh = (n0 + wn * 64) >> 6;
#pragma unroll
      for (int mi = 0; mi < 8; ++mi) {
        const int row = m0 + wm * 128 + mi * 16 + lr;
        const int rowc = row < MROWS ? row : MROWS - 1;
        float yv[4][4];
        float sum = 0.f;
#pragma unroll
        for (int ni = 0; ni < 4; ++ni) {
          const uint2 yy = *(const uint2*)(Y + (size_t)rowc * LDH + hh * 64 + ni * 16 + lg * 4);
          yv[ni][0] = bflo(yy.x); yv[ni][1] = bfhi(yy.x); yv[ni][2] = bflo(yy.y); yv[ni][3] = bfhi(yy.y);
          sum += yv[ni][0] + yv[ni][1] + yv[ni][2] + yv[ni][3];
        }
        sum += __shfl_xor(sum, 16);
        sum += __shfl_xor(sum, 32);
        const float mu = sum * (1.f / 64.f);
        float vs = 0.f;
#pragma unroll
        for (int ni = 0; ni < 4; ++ni)
#pragma unroll
          for (int q = 0; q < 4; ++q) {
            const float d = yv[ni][q] - mu;
            vs += d * d;
          }
        vs += __shfl_xor(vs, 16);
        vs += __shfl_xor(vs, 32);
        const float rstd = rsqrtf(vs * (1.f / 64.f) + 64e-5f);
        const float rk = RK[(size_t)rowc * 16 + hh];
#pragma unroll
        for (int ni = 0; ni < 4; ++ni) {
          const int col0 = hh * 64 + ni * 16 + lg * 4;
          const uint2 vv = *(const uint2*)(V + (size_t)rowc * 1024 + col0);
          const float vf[4] = {bflo(vv.x), bfhi(vv.x), bflo(vv.y), bfhi(vv.y)};
          const float4 g4 = *(const float4*)(p.rw_lnx_g + col0), b4 = *(const float4*)(p.rw_lnx_b + col0);
          const float gg[4] = {g4.x, g4.y, g4.z, g4.w}, bb[4] = {b4.x, b4.y, b4.z, b4.w};
          f32x4 o;
#pragma unroll
          for (int q = 0; q < 4; ++q) o[q] = ((yv[ni][q] - mu) * rstd * gg[q] + bb[q] + rk * vf[q]) * acc[mi][ni][q];
          if (row < MROWS) *(uint2*)(Y + (size_t)row * LDH + col0) = pack4(o);
        }
        __builtin_amdgcn_sched_barrier(0);
      }
    });
  }
}

__device__ __forceinline__ void phase_oproj(const Params& p, char* lds, const u16* A, int K, const u16* Bt, int layer, int gidx, bool first) {
  const int ldab = K == 1024 ? LDH : LDU;
  const float* mod = (const float*)(p.ws + WS_MOD);
  for (int u = blockIdx.x; u < 320; u += gridDim.x) {
    const bool split = u >= 256;
    const int s = u - 256;
    const int m0 = split ? NP : (u >> 2) * 256, n0 = (split ? (s & 3) : (u & 3)) * 256;
    const int klen = split ? (K >> 4) : K, kbeg = split ? (s >> 2) * klen : 0;
    gemm_tile256(A + kbeg, ldab, Bt + kbeg, ldab, klen, m0, n0, lds, split, [&](EPI_ARGS) {
      EPI_FOREACH(acc, if (row < MROWS) {
        const float4 gt = *(const float4*)(mod + ((size_t)layer * 132 + bidx_of(row)) * 6144 + gidx * 1024 + col0);
        float* xp = p.out + (size_t)row * 1024 + col0;
        if (split) {
          unsafeAtomicAdd(xp + 0, gt.x * v[0]);
          unsafeAtomicAdd(xp + 1, gt.y * v[1]);
          unsafeAtomicAdd(xp + 2, gt.z * v[2]);
          unsafeAtomicAdd(xp + 3, gt.w * v[3]);
        } else {
          const float* xi = first ? p.x_prompt + (size_t)row * 1024 + col0 : xp;
          const float4 xo = *(const float4*)xi;
          *(float4*)xp = make_float4(xo.x + gt.x * v[0], xo.y + gt.y * v[1], xo.z + gt.z * v[2], xo.w + gt.w * v[3]);
        }
      })
    });
  }
}

__device__ __forceinline__ void phase_up(const Params& p, char* lds, const u16* Bt) {
  const u16* H = (const u16*)(p.ws + WS_H);
  u16* UP = (u16*)(p.ws + S_UP);
  for (int t = blockIdx.x; t < 65 * 16; t += gridDim.x) {
    const int mt = t >> 4, nt = t & 15;
    const int m0 = mt * 256, n0 = nt * 256;
    gemm_tile256(H, LDH, Bt, LDH, 1024, m0, n0, lds, mt == 64, [&](EPI_ARGS) {
      EPI_FOREACH(acc, if (row < MROWS) {
        f32x4 o;
        _Pragma("unroll") for (int q = 0; q < 4; ++q) {
          const float rl = fmaxf(v[q], 0.f);
          o[q] = rl * rl;
        }
        *(uint2*)(UP + (size_t)row * LDU + col0) = pack4(o);
      })
    });
  }
}

__device__ __forceinline__ void phase_qkv(const Params& p, char* lds) {
  const u16* H = (const u16*)(p.ws + WS_H);
  const u16* wt = (const u16*)(p.ws + WS_WT);
  const float* tab = (const float*)(p.ws + WS_TAB);
  u16* Qb = (u16*)(p.ws + S_Q);
  u16* Kb = (u16*)(p.ws + S_KB);
  u16* Vt = (u16*)(p.ws + S_VT);
  for (int t = blockIdx.x; t < 65 * 12; t += gridDim.x) {
    const int mt = t / 12, nt = t % 12;
    const int m0 = mt * 256, n0 = nt * 128;
    gemm_tile<false>(H, LDH, nullptr, wt + WT_QKV, LDH, 1536, 1024, m0, n0, lds, [&](EPI_ARGS) {
      const int hc0 = n0 + wn * 64;
#pragma unroll
      for (int mi = 0; mi < 8; ++mi) {
        const int row = m0 + wm * 128 + mi * 16 + lr;
        const bool valid = row < MROWS;
        const bool isp = row < NP;
        const int pos = row & 4095;
        const int bq = isp ? (row >> 12) : (row - NP);
        const int posidx = isp ? pos : 4096;
#pragma unroll
        for (int ni = 0; ni < 4; ++ni) {
          const int col0 = hc0 + ni * 16 + lg * 4;
          const float4 b4 = *(const float4*)(p.at_bqkv + col0);
          f32x4 v = acc[mi][ni];
          v[0] += b4.x; v[1] += b4.y; v[2] += b4.z; v[3] += b4.w;
          if (ni == 0 && hc0 < 1280) {
            const float* tp = tab + (size_t)posidx * 16 + (lg & 1) * 8;
            const float4 t0 = *(const float4*)tp, t1 = *(const float4*)(tp + 4);
            const float cs[4] = {t0.x, t0.z, t1.x, t1.z}, sn[4] = {t0.y, t0.w, t1.y, t1.w};
#pragma unroll
            for (int q = 0; q < 4; ++q) {
              const float pv = __shfl_xor(v[q], 32);
              v[q] = (lg < 2) ? (v[q] * cs[q] - pv * sn[q]) : (v[q] * cs[q] + pv * sn[q]);
            }
          }
          if (valid) {
            if (hc0 < 1024) {
              *(uint2*)(Qb + (size_t)row * 1024 + col0) = pack4(v);
            } else if (hc0 < 1280) {
              const int c2 = col0 - 1024;
              *(uint2*)(Kb + (size_t)row * 256 + c2) = pack4(v);
              if (isp) {
                if (pos >= 3968) *(float4*)(p.out + O_KP + ((size_t)(bq * 128 + pos - 3968)) * 256 + c2) = make_float4(v[0], v[1], v[2], v[3]);
              } else {
                *(float4*)(p.out + O_KS + ((size_t)(bq * 128 + 127)) * 256 + c2) = make_float4(v[0], v[1], v[2], v[3]);
              }
            } else {
              const int c3 = col0 - 1280;
              if (isp) {
                u16* vp = Vt + ((size_t)(bq * 4 + (c3 >> 6)) * 64 + (c3 & 63)) * 4096 + pos;
#pragma unroll
                for (int q = 0; q < 4; ++q) vp[(size_t)q * 4096] = f2bf(v[q]);
                if (pos >= 3968) *(float4*)(p.out + O_VP + ((size_t)(bq * 128 + pos - 3968)) * 256 + c3) = make_float4(v[0], v[1], v[2], v[3]);
              } else {
                *(float4*)(p.out + O_VS + ((size_t)(bq * 128 + 127)) * 256 + c3) = make_float4(v[0], v[1], v[2], v[3]);
              }
            }
          }
        }
        __builtin_amdgcn_sched_barrier(0);
      }
    });
  }
}

constexpr int AT_KS = 0, AT_VS = 36864, AT_PS = 36864 + 35840, AT_PW = 5376;

__device__ __forceinline__ void phase_attn(const Params& p, char* lds) {
  const int tid = threadIdx.x, lane = tid & 63, w = tid >> 6, lr = lane & 15, lg = lane >> 4;
  const u16* Qb = (const u16*)(p.ws + S_Q);
  const u16* Kb = (const u16*)(p.ws + S_KB);
  const u16* Vt = (const u16*)(p.ws + S_VT);
  u16* O = (u16*)(p.ws + S_O);
  char* Ks = lds + AT_KS;
  char* Vs = lds + AT_VS;
  char* Ps = lds + AT_PS + w * AT_PW;
  for (int u = blockIdx.x; u < 512; u += gridDim.x) {
    const int b = u >> 7, n = (u >> 2) & 31, kvh = u & 3;
    bf16x8 qfa[4][2];
    {
      const int g_ = w >> 1, hf_ = w & 1, qh_ = kvh * 4 + g_;
#pragma unroll
      for (int i = 0; i < 4; ++i) {
        const size_t tok = (size_t)b * 4096 + n * 128 + hf_ * 64 + i * 16 + lr;
        qfa[i][0] = *(const bf16x8*)(Qb + tok * 1024 + qh_ * 64 + lg * 8);
        qfa[i][1] = *(const bf16x8*)(Qb + tok * 1024 + qh_ * 64 + 32 + lg * 8);
      }
    }
    __syncthreads();
#pragma unroll
    for (int i = 0; i < 4; ++i) {
      const int c = tid + 512 * i;
      {
        const int key = c >> 3, kc = c & 7;
        const int pos = n * 128 - 128 + key;
        uint4 v = {0u, 0u, 0u, 0u};
        if (pos >= 0) v = *(const uint4*)(Kb + ((size_t)b * 4096 + pos) * 256 + kvh * 64 + kc * 8);
        *(uint4*)(Ks + key * 144 + kc * 16) = v;
      }
      {
        const int d = c >> 5, kc = c & 31;
        const int pos0 = n * 128 - 128 + kc * 8;
        uint4 v = {0u, 0u, 0u, 0u};
        if (pos0 >= 0) v = *(const uint4*)(Vt + ((size_t)(b * 4 + kvh) * 64 + d) * 4096 + pos0);
        *(uint4*)(Vs + d * 560 + kc * 16) = v;
      }
    }
    if (tid < 192) {
      const int d = tid / 3, c = tid % 3;
      *(uint4*)(Vs + d * 560 + 512 + c * 16) = uint4{0u, 0u, 0u, 0u};
    }
    {
      const int prow = lane >> 2, pc = 144 + (lane & 3) * 4;
      *(uint2*)(Ps + prow * 336 + pc * 2) = uint2{0u, 0u};
    }
    __syncthreads();
    const int g = w >> 1, hf = w & 1;
    const int qh = kvh * 4 + g;
    const float sink = p.at_sink[qh];
#pragma unroll
    for (int i = 0; i < 4; ++i) {
      const int q0 = hf * 64 + i * 16;
      const bf16x8 qf0 = qfa[i][0];
      const bf16x8 qf1 = qfa[i][1];
      f32x4 s[9];
#pragma unroll
      for (int j = 0; j < 9; ++j) {
        const char* kp = Ks + (q0 + j * 16 + lr) * 144 + lg * 16;
        const bf16x8 k0 = *(const bf16x8*)kp;
        const bf16x8 k1 = *(const bf16x8*)(kp + 64);
        f32x4 z = {0.f, 0.f, 0.f, 0.f};
        z = __builtin_amdgcn_mfma_f32_16x16x32_bf16(qf0, k0, z, 0, 0, 0);
        z = __builtin_amdgcn_mfma_f32_16x16x32_bf16(qf1, k1, z, 0, 0, 0);
        s[j] = z;
      }
      float mx[4], sum[4];
#pragma unroll
      for (int r = 0; r < 4; ++r) {
        const int ql = lg * 4 + r;
        float m = sink;
#pragma unroll
        for (int j = 0; j < 9; ++j) {
          float v = s[j][r] * 0.125f;
          bool ok = true;
          if (j == 0) ok = (lr >= ql);
          if (j == 8) ok = (lr <= ql);
          if (n == 0 && (q0 + j * 16 + lr) < 128) ok = false;
          v = ok ? v : -INFINITY;
          s[j][r] = v;
          m = fmaxf(m, v);
        }
        mx[r] = rowmax16(m);
      }
#pragma unroll
      for (int r = 0; r < 4; ++r) {
        float sm = 0.f;
#pragma unroll
        for (int j = 0; j < 9; ++j) {
          const float e = __expf(s[j][r] - mx[r]);
          s[j][r] = e;
          sm += e;
        }
        sm = rowsum16(sm);
        sum[r] = sm + __expf(sink - mx[r]);
      }
      u16* P = (u16*)Ps;
#pragma unroll
      for (int j = 0; j < 9; ++j)
#pragma unroll
        for (int r = 0; r < 4; ++r) P[(lg * 4 + r) * 168 + j * 16 + lr] = f2bf(s[j][r]);
      __builtin_amdgcn_wave_barrier();
      f32x4 o[4];
#pragma unroll
      for (int nd = 0; nd < 4; ++nd) o[nd] = f32x4{0.f, 0.f, 0.f, 0.f};
#pragma unroll
      for (int kk = 0; kk < 5; ++kk) {
        const bf16x8 pf = *(const bf16x8*)(Ps + lr * 336 + kk * 64 + lg * 16);
#pragma unroll
        for (int nd = 0; nd < 4; ++nd) {
          const bf16x8 vf = *(const bf16x8*)(Vs + (nd * 16 + lr) * 560 + (q0 + kk * 32 + lg * 8) * 2);
          o[nd] = __builtin_amdgcn_mfma_f32_16x16x32_bf16(pf, vf, o[nd], 0, 0, 0);
        }
      }
#pragma unroll
      for (int nd = 0; nd < 4; ++nd)
#pragma unroll
        for (int r = 0; r < 4; ++r) {
          const float v = o[nd][r] / sum[r];
          O[((size_t)b * 4096 + n * 128 + q0 + lg * 4 + r) * LDH + qh * 64 + nd * 16 + lr] = f2bf(v);
        }
      __builtin_amdgcn_wave_barrier();
    }
  }
  float* qs = (float*)lds;
  float* sc = (float*)(lds + 1024);
  float* part = (float*)(lds + 1024 + 2112);
  for (int it = blockIdx.x; it < 512; it += gridDim.x) {
    const int b = it >> 2, kvh = it & 3;
    const size_t row = (size_t)NP + b;
    __syncthreads();
    if (tid < 256) qs[tid] = bf2f(Qb[row * 1024 + kvh * 256 + tid]);
    __syncthreads();
    {
      const int key = tid >> 2, g = tid & 3;
      const float* kp = p.cache_k + (((size_t)b * 128 + key) * 4 + kvh) * 64;
      float dot = 0.f;
#pragma unroll
      for (int d4 = 0; d4 < 16; ++d4) {
        const float4 kv = *(const float4*)(kp + d4 * 4);
        const float* q = qs + g * 64 + d4 * 4;
        dot += kv.x * q[0] + kv.y * q[1] + kv.z * q[2] + kv.w * q[3];
      }
      sc[g * 132 + key] = dot * 0.125f;
      if (key >= 1) {
        float* dst = p.out + O_KS + (((size_t)b * 128 + key - 1) * 4 + kvh) * 64 + g * 16;
        const float* src = kp + g * 16;
#pragma unroll
        for (int d4 = 0; d4 < 4; ++d4) *(float4*)(dst + d4 * 4) = *(const float4*)(src + d4 * 4);
      }
      if (tid < 4) {
        const float* kn = p.out + O_KS + (((size_t)b * 128 + 127) * 4 + kvh) * 64;
        float d2 = 0.f;
        for (int d = 0; d < 64; ++d) d2 += kn[d] * qs[tid * 64 + d];
        sc[tid * 132 + 128] = d2 * 0.125f;
      }
    }
    __syncthreads();
    if (w < 4) {
      const float sink = p.at_sink[kvh * 4 + w];
      float* s = sc + w * 132;
      const float v0 = s[lane], v1 = s[64 + lane], v2 = lane == 0 ? s[128] : -INFINITY;
      float m = fmaxf(fmaxf(v0, v1), fmaxf(v2, sink));
      m = wavemax(m);
      const float e0 = __expf(v0 - m), e1 = __expf(v1 - m), e2 = lane == 0 ? __expf(v2 - m) : 0.f;
      float sm = wavesum(e0 + e1 + e2) + __expf(sink - m);
      const float inv = 1.f / sm;
      s[lane] = e0 * inv;
      s[64 + lane] = e1 * inv;
      if (lane == 0) s[128] = e2 * inv;
    }
    __syncthreads();
    {
      const int d = tid & 63, g = (tid >> 6) & 3, half = tid >> 8;
      const float* vp = p.cache_v + (((size_t)b * 128) * 4 + kvh) * 64 + d;
      float accv = 0.f;
      for (int key = half * 64; key < half * 64 + 64; ++key) {
        const float vv = vp[(size_t)key * 256];
        accv += sc[g * 132 + key] * vv;
        if (g == 0 && key >= 1) p.out[O_VS + (((size_t)b * 128 + key - 1) * 4 + kvh) * 64 + d] = vv;
      }
      if (half == 1) accv += sc[g * 132 + 128] * p.out[O_VS + (((size_t)b * 128 + 127) * 4 + kvh) * 64 + d];
      part[(half * 4 + g) * 64 + d] = accv;
    }
    __syncthreads();
    if (tid < 256) {
      const int d = tid & 63, g = tid >> 6;
      O[row * LDH + (kvh * 4 + g) * 64 + d] = f2bf(part[g * 64 + d] + part[(4 + g) * 64 + d]);
    }
  }
}

__global__ void __launch_bounds__(NTHR) mega(Params p) {
  extern __shared__ __attribute__((aligned(16))) char lds[];
  cg::grid_group grid = cg::this_grid();
  volatile LAS unsigned* xst = (volatile LAS unsigned*)(lds + LDS_BYTES);
  if (threadIdx.x == 0) { xst[0] = 0u; xst[1] = 0u; }
  __syncthreads();
  const XcdBarrier xb = xcd_barrier_post((unsigned*)(p.ws + WS_BAR), xst);
  const u16* wt = (const u16*)(p.ws + WS_WT);
  phase0(p, lds);
  if (p.out == nullptr) grid.sync();
  xcd_barrier(xb);
  phase_ada(p, lds);
  xcd_barrier(xb);
  phase_norm(p, 0, 0, true, true);
  xcd_barrier(xb);
  phase_rwkv_proj(p, lds);
  xcd_barrier(xb);
  phase_rwkv_lora2(p, lds);
  xcd_barrier(xb);
  phase_scan(p, lds);
  xcd_barrier(xb);
  phase_gate(p, lds);
  xcd_barrier(xb);
  phase_oproj(p, lds, (const u16*)(p.ws + WS_H), 1024, wt + WT_WO, 0, 2, true);
  xcd_barrier(xb);
  phase_norm(p, 0, 1, false, false);
  xcd_barrier(xb);
  phase_up(p, lds, wt + WT_UP0);
  xcd_barrier(xb);
  phase_oproj(p, lds, (const u16*)(p.ws + S_UP), 4096, wt + WT_DN0, 0, 5, false);
  xcd_barrier(xb);
  phase_norm(p, 1, 0, false, false);
  xcd_barrier(xb);
  phase_qkv(p, lds);
  xcd_barrier(xb);
  phase_attn(p, lds);
  xcd_barrier(xb);
  phase_oproj(p, lds, (const u16*)(p.ws + S_O), 1024, wt + WT_WO1, 1, 2, false);
  xcd_barrier(xb);
  phase_norm(p, 1, 1, false, false);
  xcd_barrier(xb);
  phase_up(p, lds, wt + WT_UP1);
  xcd_barrier(xb);
  phase_oproj(p, lds, (const u16*)(p.ws + S_UP), 4096, wt + WT_DN1, 1, 5, false);
  xcd_barrier(xb);
  phase_final(p);
}

extern "C" void kernel_launch(void* const* d_in, const int* in_sizes, int n_in, void* d_out, int out_size, void* d_ws,
                              size_t ws_size, hipStream_t stream) {
  static int grid_blocks = 0;
  if (grid_blocks == 0) {
    if (ws_size < WS_END) {
      fprintf(stderr, "kernel_launch: workspace too small: %zu < %zu\n", ws_size, (size_t)WS_END);
      grid_blocks = -1;
      return;
    }
    int dev = 0, cus = 0, per_cu = 0;
    hipGetDevice(&dev);
    hipDeviceGetAttribute(&cus, hipDeviceAttributeMultiprocessorCount, dev);
    hipFuncSetAttribute((const void*)mega, hipFuncAttributeMaxDynamicSharedMemorySize, LDS_BYTES + 16);
    hipOccupancyMaxActiveBlocksPerMultiprocessor(&per_cu, (const void*)mega, NTHR, LDS_BYTES + 16);
    if (per_cu < 1) per_cu = 1;
    grid_blocks = cus * per_cu;
  }
  if (grid_blocks < 0) return;
  Params p{};
  const float** pp = (const float**)&p;
  for (int i = 0; i < 37; ++i) pp[i] = (const float*)d_in[i];
  p.out = (float*)d_out;
  p.ws = (char*)d_ws;
  hipMemsetAsync((char*)d_ws + WS_BAR, 0, 16384, stream);
  void* args[] = {&p};
  hipError_t e = hipLaunchCooperativeKernel((const void*)mega, dim3(grid_blocks), dim3(NTHR), args, LDS_BYTES + 16, stream);
  if (e != hipSuccess) fprintf(stderr, "cooperative launch failed: %s (grid %d)\n", hipGetErrorString(e), grid_blocks);
}
```

```cpp
#include <hip/hip_runtime.h>
#include <hip/hip_cooperative_groups.h>
#include <cstdio>
namespace cg = cooperative_groups;

typedef unsigned short u16;
typedef __attribute__((ext_vector_type(8))) short bf16x8;
typedef __attribute__((ext_vector_type(4))) float f32x4;

constexpr int NP = 16384, MROWS = 16512, MPAD = 16640;
constexpr int NTHR = 512;
constexpr size_t MEG = 1048576;
constexpr int LDH = 1088, LDU = 4160;

constexpr size_t O_Y = 0, O_WKVP = 16908288, O_WKVS = 17170432, O_SHP = 25559040, O_SHS = 25563136,
                 O_KP = 25694208, O_KS = 25825280, O_VP = 30019584, O_VS = 30150656;

constexpr size_t WT_WR = 0, WT_WK = WT_WR + 1024 * LDH, WT_WV = WT_WK + 1024 * LDH, WT_WO = WT_WV + 1024 * LDH,
                 WT_W1 = WT_WO + 1024 * LDH, WT_A1 = WT_W1 + 64 * LDH, WT_G1 = WT_A1 + 64 * LDH, WT_W2 = WT_G1 + 128 * LDH,
                 WT_A2 = WT_W2 + 65536, WT_G2 = WT_A2 + 65536, WT_UP0 = WT_G2 + 131072, WT_DN0 = WT_UP0 + 4096 * LDH,
                 WT_QKV = WT_DN0 + 1024 * LDU, WT_WO1 = WT_QKV + 1536 * LDH, WT_UP1 = WT_WO1 + 1024 * LDH,
                 WT_DN1 = WT_UP1 + 4096 * LDH, WT_END = WT_DN1 + 1024 * LDU;
constexpr size_t WS_WT = 0;
constexpr size_t WS_H = WS_WT + WT_END * 2;
constexpr size_t WS_ZR = WS_H + (size_t)MPAD * LDH * 2;
constexpr size_t WS_MOD = WS_ZR + (size_t)LDH * 2;
constexpr size_t WS_TAB = WS_MOD + (size_t)2 * 132 * 6144 * 4;
constexpr size_t WS_HS = WS_H + (size_t)MROWS * LDH * 2;
constexpr size_t WS_RK = WS_TAB + (size_t)4097 * 8 * 8;
constexpr size_t WS_BAR = WS_RK + (size_t)MPAD * 16 * 4;
constexpr size_t WS_S = WS_BAR + 16384;
constexpr size_t RSZ = (size_t)MROWS * 1024 * 2;
constexpr size_t S_ADAWT = WS_S, S_SILUC = S_ADAWT + (size_t)2 * 6144 * LDH * 2;
constexpr size_t S_R = WS_S, S_K = S_R + RSZ, S_V = S_K + RSZ, S_EW = S_V + RSZ, S_A = S_EW + RSZ,
                 S_WH = S_A + RSZ, S_AH = S_WH + (size_t)MPAD * 64 * 2, S_GH = S_AH + (size_t)MPAD * 64 * 2,
                 S_RW_END = S_GH + (size_t)MPAD * 128 * 2;
constexpr size_t S_UP = WS_S;
constexpr size_t S_Q = WS_S, S_O = S_Q + (size_t)MPAD * 1024 * 2, S_KB = S_O + (size_t)MPAD * LDH * 2,
                 S_VT = S_KB + (size_t)MPAD * 256 * 2;
constexpr size_t WS_END = S_RW_END;
static_assert(S_UP + (size_t)MPAD * LDU * 2 <= WS_END, "up fits");
static_assert(S_VT + (size_t)16 * 64 * 4096 * 2 <= WS_END, "attn fits");
static_assert(WS_END <= 282000000, "ws fits sum of inputs");

constexpr int LDS_ROW = 144;
constexpr int LDS_A_BYTES = 256 * LDS_ROW;
constexpr int LDS_B_BYTES = 128 * LDS_ROW;
constexpr int LDS_STAGE = LDS_A_BYTES + LDS_B_BYTES;
constexpr int LDS_BYTES = 147456;

struct Params {
  const float *x_prompt, *x_sample, *c_prompt, *c_sample, *state_wkv, *state_shift, *cache_k, *cache_v;
  const float *norm1_g, *norm2_g, *ada_w, *ada_b, *mlp_up, *mlp_down, *final_g;
  const float *rw_mix, *rw_wr, *rw_wk, *rw_wv, *rw_wo, *rw_w0, *rw_w1, *rw_w2, *rw_a0, *rw_a1, *rw_a2, *rw_g1, *rw_g2,
      *rw_kk, *rw_ka, *rw_rk, *rw_lnx_g, *rw_lnx_b;
  const float *at_wqkv, *at_bqkv, *at_wo, *at_sink;
  float* out;
  char* ws;
};

__device__ __forceinline__ u16 f2bf(float f) {
  unsigned u = __float_as_uint(f);
  u += 0x7fffu + ((u >> 16) & 1u);
  return (u16)(u >> 16);
}
__device__ __forceinline__ float bf2f(u16 h) { return __uint_as_float(((unsigned)h) << 16); }
__device__ __forceinline__ float bflo(unsigned w) { return __uint_as_float(w << 16); }
__device__ __forceinline__ float bfhi(unsigned w) { return __uint_as_float(w & 0xffff0000u); }
__device__ __forceinline__ unsigned pack2(float a, float b) {
  unsigned r;
  asm volatile("v_cvt_pk_bf16_f32 %0, %1, %2" : "=v"(r) : "v"(a), "v"(b));
  return r;
}
__device__ __forceinline__ uint2 pack4(f32x4 v) { return uint2{pack2(v[0], v[1]), pack2(v[2], v[3])}; }
__device__ __forceinline__ float h2f(u16 h) { return (float)__builtin_bit_cast(_Float16, h); }
__device__ __forceinline__ u16 f2h(float f) { return __builtin_bit_cast(u16, (_Float16)f); }
__device__ __forceinline__ float sigmoidf_(float x) { return 1.f / (1.f + __expf(-x)); }

template <int CTRL>
__device__ __forceinline__ float dppf(float x) {
  return __int_as_float(__builtin_amdgcn_update_dpp(0, __float_as_int(x), CTRL, 0xf, 0xf, true));
}
__device__ __forceinline__ float rowsum16(float x) {
  x += dppf<0xB1>(x);
  x += dppf<0x4E>(x);
  x += dppf<0x124>(x);
  x += dppf<0x128>(x);
  return x;
}
__device__ __forceinline__ float rowmax16(float x) {
  x = fmaxf(x, dppf<0xB1>(x));
  x = fmaxf(x, dppf<0x4E>(x));
  x = fmaxf(x, dppf<0x124>(x));
  x = fmaxf(x, dppf<0x128>(x));
  return x;
}
__device__ __forceinline__ float wavesum(float x) {
#pragma unroll
  for (int o = 32; o > 0; o >>= 1) x += __shfl_xor(x, o);
  return x;
}
__device__ __forceinline__ float wavemax(float x) {
#pragma unroll
  for (int o = 32; o > 0; o >>= 1) x = fmaxf(x, __shfl_xor(x, o));
  return x;
}
__device__ __forceinline__ int bidx_of(int row) { return row < NP ? (row >> 12) : (4 + row - NP); }

#define XB_TMO      128
#define XB_XCNT(j)  (256  + 64 * (j))
#define XB_XSUB(j)  (1280 + 64 * (j))
#define XB_XGEN(j)  (2304 + 64 * (j))
#define XB_TOP      3328
#define XB_TOPGEN   3392
#define XCD_BAR_WORDS 3456
#define XB_SPIN_CAP (1u << 22)
#define LAS __attribute__((address_space(3)))
__device__ __forceinline__ unsigned xb_ld(unsigned* p) { return __hip_atomic_load(p, __ATOMIC_RELAXED, __HIP_MEMORY_SCOPE_AGENT); }
__device__ __forceinline__ unsigned xb_add(unsigned* p, unsigned v) { return __hip_atomic_fetch_add(p, v, __ATOMIC_RELAXED, __HIP_MEMORY_SCOPE_AGENT); }
__device__ __forceinline__ unsigned xb_xcc_id() { return (unsigned)__builtin_amdgcn_s_getreg((3 << 11) | 20) & 0xFu; }
#define XB_SPIN(cond, bar) do { unsigned _sp = 0; while (cond) { __builtin_amdgcn_s_sleep(1); \
    if ((++_sp & 255u) == 0u) { if (xb_ld(&(bar)[XB_TMO])) break; if (_sp > XB_SPIN_CAP) { atomicAdd(&(bar)[XB_TMO], 1u); break; } } } } while (0)
struct XcdBarrier {
  unsigned* bar;
  unsigned x;
  volatile LAS unsigned* st;
};
__device__ __forceinline__ XcdBarrier xcd_barrier_post(unsigned* bar, volatile LAS unsigned* st) {
  XcdBarrier b;
  b.bar = bar;
  b.x = xb_xcc_id();
  b.st = st;
  if (threadIdx.x == 0) (void)xb_add(&bar[XB_XCNT(b.x)], 1u);
  return b;
}
__device__ __forceinline__ void xcd_barrier_complete(unsigned* bar, unsigned x, unsigned& nloc, unsigned& nx) {
  const unsigned G = gridDim.x * gridDim.y * gridDim.z;
  unsigned sum, cnt, mine, sp = 0u;
  for (;;) {
    sum = 0u; cnt = 0u; mine = 0u;
#pragma unroll
    for (unsigned j = 0; j < 16; ++j) {
      const unsigned c = xb_ld(&bar[XB_XCNT(j)]);
      sum += c;
      cnt += (c > 0u) ? 1u : 0u;
      mine = (j == x) ? c : mine;
    }
    if (sum == G) break;
    __builtin_amdgcn_s_sleep(1);
    if ((++sp & 255u) == 0u) {
      if (xb_ld(&bar[XB_TMO])) break;
      if (sp > XB_SPIN_CAP) { atomicAdd(&bar[XB_TMO], 1u); break; }
    }
  }
  nloc = mine > 0u ? mine : 1u;
  nx = cnt > 0u ? cnt : 1u;
}
__device__ __forceinline__ void xcd_barrier(const XcdBarrier& b) {
  asm volatile("s_waitcnt vmcnt(0)" ::: "memory");
  __syncthreads();
  if (threadIdx.x == 0) {
    unsigned* bar = b.bar;
    __builtin_amdgcn_s_waitcnt(0);
    unsigned nloc = b.st[0], nx = b.st[1];
    if (nloc == 0u) { xcd_barrier_complete(bar, b.x, nloc, nx); b.st[0] = nloc; b.st[1] = nx; }
    const unsigned old = xb_add(&bar[XB_XSUB(b.x)], 1u);
    const unsigned gen = old / nloc;
    if (old + 1u == (gen + 1u) * nloc) {
      __builtin_amdgcn_fence(__ATOMIC_RELEASE, "agent");
      asm volatile("s_waitcnt vmcnt(0)" ::: "memory");
      const unsigned og = xb_add(&bar[XB_TOP], 1u);
      const unsigned tg = og / nx;
      if (og + 1u == (tg + 1u) * nx) xb_add(&bar[XB_TOPGEN], 1u);
      else XB_SPIN(xb_ld(&bar[XB_TOPGEN]) == tg, bar);
      __builtin_amdgcn_fence(__ATOMIC_ACQUIRE, "agent");
      xb_add(&bar[XB_XGEN(b.x)], 1u);
      asm volatile("s_waitcnt vmcnt(0)" ::: "memory");
    } else {
      XB_SPIN(xb_ld(&bar[XB_XGEN(b.x)]) == gen, bar);
      __builtin_amdgcn_fence(__ATOMIC_ACQUIRE, "agent");
      asm volatile("s_waitcnt vmcnt(0)" ::: "memory");
    }
  }
  __syncthreads();
}

#define BAR_SYNC() do { asm volatile("s_waitcnt lgkmcnt(0)" ::: "memory"); __builtin_amdgcn_s_barrier(); asm volatile("" ::: "memory"); } while (0)

__device__ __forceinline__ unsigned mix2(unsigned h, unsigned p, float m0, float m1) {
  float h0 = bflo(h), h1 = bfhi(h), p0 = bflo(p), p1 = bfhi(p);
  return pack2(h0 + (p0 - h0) * m0, h1 + (p1 - h1) * m1);
}

template <bool MIX, class Epi>
__device__ __forceinline__ void gemm_tile(const u16* __restrict__ A, int lda, const float* __restrict__ mixv,
                                          const u16* __restrict__ Bt, int ldb, int N, int K, int m0, int n0, char* lds, Epi&& epi) {
  const int tid = threadIdx.x, lane = tid & 63, w = tid >> 6;
  const int nk = K >> 6;
  if (w >= 4) {
    const int pt = tid - 256, kc = pt & 7, pr = pt >> 3;
    const u16* Ab = A + (size_t)m0 * lda + (size_t)pr * lda + kc * 8;
    int poff[8];
#pragma unroll
    for (int i = 0; i < 8; ++i) {
      poff[i] = 0;
      if (MIX) {
        const int row = m0 + pr + 32 * i;
        const int prow = row < NP ? ((row & 4095) ? row - 1 : MPAD) : (row < MROWS ? row + 128 : MPAD);
        poff[i] = prow * LDH + kc * 8;
      }
    }
    bool bv[4];
    const u16* bp[4];
#pragma unroll
    for (int j = 0; j < 4; ++j) {
      const int n = n0 + pr + 32 * j;
      bv[j] = n < N;
      bp[j] = Bt + (size_t)(bv[j] ? n : 0) * ldb + kc * 8;
    }
    struct RSet {
      uint4 ra[8], rp[8], rb[4];
      float4 mx0, mx1;
    };
    RSet SA, SB;
    auto gload = [&](RSet& S, int kt) {
      const int ko = kt * 64;
#pragma unroll
      for (int i = 0; i < 8; ++i) {
        S.ra[i] = *(const uint4*)(Ab + (size_t)(32 * i) * lda + ko);
        if (MIX) S.rp[i] = *(const uint4*)(A + poff[i] + ko);
      }
      if (MIX) {
        S.mx0 = *(const float4*)(mixv + ko + kc * 8);
        S.mx1 = *(const float4*)(mixv + ko + kc * 8 + 4);
      }
#pragma unroll
      for (int j = 0; j < 4; ++j) {
        uint4 z = {0u, 0u, 0u, 0u};
        if (bv[j]) z = *(const uint4*)(bp[j] + ko);
        S.rb[j] = z;
      }
    };
    auto lstore = [&](RSet& S, int s) {
      char* base = lds + s * LDS_STAGE + pr * LDS_ROW + kc * 16;
#pragma unroll
      for (int i = 0; i < 8; ++i) {
        uint4 v = S.ra[i];
        if (MIX) {
          v.x = mix2(S.ra[i].x, S.rp[i].x, S.mx0.x, S.mx0.y);
          v.y = mix2(S.ra[i].y, S.rp[i].y, S.mx0.z, S.mx0.w);
          v.z = mix2(S.ra[i].z, S.rp[i].z, S.mx1.x, S.mx1.y);
          v.w = mix2(S.ra[i].w, S.rp[i].w, S.mx1.z, S.mx1.w);
        }
        *(uint4*)(base + (32 * i) * LDS_ROW) = v;
      }
#pragma unroll
      for (int j = 0; j < 4; ++j) *(uint4*)(base + LDS_A_BYTES + (32 * j) * LDS_ROW) = S.rb[j];
    };
    if constexpr (!MIX) {
      gload(SB, 0);
      if (nk > 1) gload(SA, 1);
      lstore(SB, 0);
      if (nk > 2) gload(SB, 2);
      BAR_SYNC();
#pragma unroll 1
      for (int kt = 0; kt < nk; kt += 2) {
        if (kt + 1 < nk) {
          lstore(SA, 1);
          if (kt + 3 < nk) gload(SA, kt + 3);
        }
        BAR_SYNC();
        if (kt + 1 < nk) {
          if (kt + 2 < nk) {
            lstore(SB, 0);
            if (kt + 4 < nk) gload(SB, kt + 4);
          }
          BAR_SYNC();
        }
      }
    } else {
      gload(SA, 0);
      lstore(SA, 0);
      if (nk > 1) gload(SA, 1);
      BAR_SYNC();
#pragma unroll 1
      for (int kt = 0; kt < nk; ++kt) {
        if (kt + 1 < nk) {
          lstore(SA, (kt + 1) & 1);
          if (kt + 2 < nk) gload(SA, kt + 2);
        }
        BAR_SYNC();
      }
    }
  } else {
    const int wm = w >> 1, wn = w & 1, lr = lane & 15, lg = lane >> 4;
    f32x4 acc[8][4];
#pragma unroll
    for (int i = 0; i < 8; ++i)
#pragma unroll
      for (int j = 0; j < 4; ++j) acc[i][j] = f32x4{0.f, 0.f, 0.f, 0.f};
    BAR_SYNC();
#pragma unroll 1
    for (int kt = 0; kt < nk; ++kt) {
      const char* sa = lds + (kt & 1) * LDS_STAGE + (wm * 128 + lr) * LDS_ROW + lg * 16;
      const char* sb = lds + (kt & 1) * LDS_STAGE + LDS_A_BYTES + (wn * 64 + lr) * LDS_ROW + lg * 16;
      bf16x8 bq[2][4], aq[3];
#pragma unroll
      for (int ni = 0; ni < 4; ++ni) bq[0][ni] = *(const bf16x8*)(sb + ni * 16 * LDS_ROW);
      aq[0] = *(const bf16x8*)(sa);
      aq[1] = *(const bf16x8*)(sa + 16 * LDS_ROW);
#pragma unroll
      for (int ni = 0; ni < 4; ++ni) bq[1][ni] = *(const bf16x8*)(sb + ni * 16 * LDS_ROW + 64);
#pragma unroll
      for (int st = 0; st < 16; ++st) {
        if (st + 2 < 16) aq[(st + 2) % 3] = *(const bf16x8*)(sa + ((st + 2) & 7) * 16 * LDS_ROW + ((st + 2) >> 3) * 64);
#pragma unroll
        for (int ni = 0; ni < 4; ++ni)
          acc[st & 7][ni] = __builtin_amdgcn_mfma_f32_16x16x32_bf16(bq[st >> 3][ni], aq[st % 3], acc[st & 7][ni], 0, 0, 0);
        __builtin_amdgcn_sched_barrier(0);
      }
      BAR_SYNC();
    }
    epi(acc, wm, wn, lr, lg);
  }
}

constexpr int LDS_STAGE2 = 2 * LDS_A_BYTES;
template <class Epi>
__device__ __forceinline__ void gemm_tile256(const u16* __restrict__ A, int lda, const u16* __restrict__ Bt, int ldb, int K, int m0,
                                             int n0, char* lds, bool half, Epi&& epi) {
  int tid = threadIdx.x;
  asm volatile("" : "+v"(tid));
  const int lane = tid & 63, w = __builtin_amdgcn_readfirstlane(tid >> 6);
  const int wm = w >> 2, wn = w & 3, lr = lane & 15, lg = lane >> 4;
  const int nk = K >> 5;
  const int drow = lane >> 2, dch = (lane & 3) ^ ((lane >> 4) & 3);
  const u16* As0 = A + (size_t)(m0 + w * 16 + drow) * lda + dch * 8;
  const u16* As1 = A + (size_t)(m0 + (w + 8) * 16 + drow) * lda + dch * 8;
  const u16* Bs0 = Bt + (size_t)(n0 + w * 16 + drow) * ldb + dch * 8;
  const u16* Bs1 = Bt + (size_t)(n0 + (w + 8) * 16 + drow) * ldb + dch * 8;
  auto dma = [&](int kt, int stg) __attribute__((always_inline)) {
    char* sbase = lds + stg * 32768;
    const int ko = kt * 32;
    __builtin_amdgcn_global_load_lds((const unsigned*)(As0 + ko), (unsigned*)(sbase + w * 1024), 16, 0, 0);
    __builtin_amdgcn_global_load_lds((const unsigned*)(As1 + ko), (unsigned*)(sbase + (w + 8) * 1024), 16, 0, 0);
    __builtin_amdgcn_global_load_lds((const unsigned*)(Bs0 + ko), (unsigned*)(sbase + 16384 + w * 1024), 16, 0, 0);
    __builtin_amdgcn_global_load_lds((const unsigned*)(Bs1 + ko), (unsigned*)(sbase + 16384 + (w + 8) * 1024), 16, 0, 0);
  };
  f32x4 acc[8][4];
#pragma unroll
  for (int i = 0; i < 8; ++i)
#pragma unroll
    for (int j = 0; j < 4; ++j) acc[i][j] = f32x4{0.f, 0.f, 0.f, 0.f};
  const int swz = (lg ^ ((lr >> 2) & 3)) * 16;
  const int aoff = (wm * 128 + lr) * 64 + swz, boff = 16384 + (wn * 64 + lr) * 64 + swz;
  const bool skipm = half && wm == 1;
  dma(0, 0);
  dma(nk > 1 ? 1 : nk - 1, 1);
  dma(nk > 2 ? 2 : nk - 1, 2);
  asm volatile("s_waitcnt vmcnt(8)" ::: "memory");
  BAR_SYNC();
#pragma unroll 1
  for (int kt = 0; kt < nk; ++kt) {
    dma(kt + 3 < nk ? kt + 3 : nk - 1, (kt + 3) & 3);
    if (!skipm) {
      const char* sa = lds + (kt & 3) * 32768 + aoff;
      const char* sb = lds + (kt & 3) * 32768 + boff;
      bf16x8 bq[4], aq[3];
#pragma unroll
      for (int ni = 0; ni < 4; ++ni) bq[ni] = *(const bf16x8*)(sb + ni * 1024);
      aq[0] = *(const bf16x8*)(sa);
      aq[1] = *(const bf16x8*)(sa + 1024);
#pragma unroll
      for (int st = 0; st < 8; ++st) {
        if (st + 2 < 8) aq[(st + 2) % 3] = *(const bf16x8*)(sa + (st + 2) * 1024);
#pragma unroll
        for (int ni = 0; ni < 4; ++ni)
          acc[st][ni] = __builtin_amdgcn_mfma_f32_16x16x32_bf16(bq[ni], aq[st % 3], acc[st][ni], 0, 0, 0);
        __builtin_amdgcn_sched_barrier(0);
      }
    }
    asm volatile("s_waitcnt vmcnt(8)" ::: "memory");
    BAR_SYNC();
  }
  asm volatile("s_waitcnt vmcnt(0)" ::: "memory");
  BAR_SYNC();
  epi(acc, wm, wn, lr, lg);
}

#define EPI_FOREACH(acc, ...)                                    \
  _Pragma("unroll") for (int mi = 0; mi < 8; ++mi) {             \
    const int row = m0 + wm * 128 + mi * 16 + lr;                \
    _Pragma("unroll") for (int ni = 0; ni < 4; ++ni) {           \
      const int col0 = n0 + wn * 64 + ni * 16 + lg * 4;          \
      const f32x4 v = acc[mi][ni];                               \
      __VA_ARGS__                                                \
    }                                                            \
    __builtin_amdgcn_sched_barrier(0);                           \
  }
#define EPI_ARGS f32x4(&acc)[8][4], int wm, int wn, int lr, int lg

__device__ __forceinline__ void conv_job(const float* __restrict__ src, u16* __restrict__ dst, int K, int N, int ldk, float* tl, int rot) {
  int tid = threadIdx.x;
  asm volatile("" : "+v"(tid));
  const int tn = N >> 6, nt = (K >> 6) * tn;
  const int G = gridDim.x;
  int t = ((int)blockIdx.x + G - (rot % G)) % G;
  float v[8];
  auto ldtile = [&](int tt) {
    const int k0 = (tt / tn) << 6, n0 = (tt % tn) << 6;
#pragma unroll
    for (int i = 0; i < 8; ++i) {
      const int e = tid + 512 * i;
      v[i] = src[(size_t)(k0 + (e >> 6)) * N + n0 + (e & 63)];
    }
  };
  if (t < nt) ldtile(t);
  while (t < nt) {
    const int k0 = (t / tn) << 6, n0 = (t % tn) << 6;
#pragma unroll
    for (int i = 0; i < 8; ++i) {
      const int e = tid + 512 * i;
      tl[(e >> 6) * 65 + (e & 63)] = v[i];
    }
    const int tnx = t + G;
    if (tnx < nt) ldtile(tnx);
    __syncthreads();
    const int n = tid >> 3, kc = tid & 7;
    float f[8];
#pragma unroll
    for (int j = 0; j < 8; ++j) f[j] = tl[(kc * 8 + j) * 65 + n];
    uint4 o;
    o.x = pack2(f[0], f[1]);
    o.y = pack2(f[2], f[3]);
    o.z = pack2(f[4], f[5]);
    o.w = pack2(f[6], f[7]);
    *(uint4*)(dst + (size_t)(n0 + n) * ldk + k0 + kc * 8) = o;
    __syncthreads();
    t = tnx;
  }
}

__device__ __forceinline__ void phase0(const Params& p, char* lds) {
  float* tl = (float*)lds;
  u16* wt = (u16*)(p.ws + WS_WT);
  u16* adawt = (u16*)(p.ws + S_ADAWT);
  int rot = 0;
#define CJ(SRC, DST, K, N)            \
  conv_job(SRC, DST, K, N, ((K) == 1024 ? LDH : (K) == 4096 ? LDU : (K)), tl, rot);  \
  rot += ((K) >> 6) * ((N) >> 6);
  CJ(p.ada_w, adawt, 1024, 6144)
  CJ(p.ada_w + (size_t)1024 * 6144, adawt + (size_t)6144 * LDH, 1024, 6144)
  CJ(p.rw_wr, wt + WT_WR, 1024, 1024)
  CJ(p.rw_wk, wt + WT_WK, 1024, 1024)
  CJ(p.rw_wv, wt + WT_WV, 1024, 1024)
  CJ(p.rw_wo, wt + WT_WO, 1024, 1024)
  CJ(p.rw_w1, wt + WT_W1, 1024, 64)
  CJ(p.rw_a1, wt + WT_A1, 1024, 64)
  CJ(p.rw_g1, wt + WT_G1, 1024, 128)
  CJ(p.rw_w2, wt + WT_W2, 64, 1024)
  CJ(p.rw_a2, wt + WT_A2, 64, 1024)
  CJ(p.rw_g2, wt + WT_G2, 128, 1024)
  CJ(p.mlp_up, wt + WT_UP0, 1024, 4096)
  CJ(p.mlp_down, wt + WT_DN0, 4096, 1024)
  CJ(p.at_wqkv, wt + WT_QKV, 1024, 1536)
  CJ(p.at_wo, wt + WT_WO1, 1024, 1024)
  CJ(p.mlp_up + (size_t)4 * MEG, wt + WT_UP1, 1024, 4096)
  CJ(p.mlp_down + (size_t)4 * MEG, wt + WT_DN1, 4096, 1024)
#undef CJ
  const int gtid = blockIdx.x * NTHR + threadIdx.x, gsz = gridDim.x * NTHR;
  u16* siluc = (u16*)(p.ws + S_SILUC);
  for (int i = gtid; i < 256 * 1024; i += gsz) {
    int row = i >> 10, col = i & 1023;
    float c = 0.f;
    if (row < 4) c = p.c_prompt[row * 1024 + col];
    else if (row < 132) c = p.c_sample[(row - 4) * 1024 + col];
    siluc[i] = f2bf(c * sigmoidf_(c));
  }
  u16* hs = (u16*)(p.ws + WS_HS);
  for (int i = gtid; i < 128 * 1024; i += gsz) hs[(size_t)(i >> 10) * LDH + (i & 1023)] = f2bf(p.state_shift[i]);
  u16* zr = (u16*)(p.ws + WS_ZR);
  for (int i = gtid; i < LDH; i += gsz) zr[i] = 0;
  float2* tab = (float2*)(p.ws + WS_TAB);
  for (int i = gtid; i < 4097 * 8; i += gsz) {
    int pi = i >> 3, f = i & 7;
    float pos = pi < 4096 ? (float)pi : 8192.f;
    float inv = f == 0 ? 1.0f : f == 1 ? 0.1939227432012558f : f == 2 ? 0.03760603070259094f : f == 3 ? 0.007292664609849453f
              : f == 4 ? 0.0014142135623842478f : f == 5 ? 0.00027424818836152554f : f == 6 ? 5.318296098266728e-05f
              : 1.0313386155758053e-05f;
    float ang = pos * inv;
    double t = (double)ang * 0.15915494309189535;
    t -= rint(t);
    float fr = (float)t;
    tab[i] = make_float2(__builtin_amdgcn_cosf(fr), __builtin_amdgcn_sinf(fr));
  }
}

__device__ __forceinline__ void phase_ada(const Params& p, char* lds) {
  const u16* siluc = (const u16*)(p.ws + S_SILUC);
  const u16* adawt = (const u16*)(p.ws + S_ADAWT);
  float* mod = (float*)(p.ws + WS_MOD);
  for (int t = blockIdx.x; t < 96; t += gridDim.x) {
    const int layer = t / 48, nt = t % 48;
    const int m0 = 0, n0 = nt * 128;
    const float* bias = p.ada_b + layer * 6144;
    float* mo = mod + (size_t)layer * 132 * 6144;
    gemm_tile<false>(siluc, 1024, nullptr, adawt + (size_t)layer * 6144 * LDH, LDH, 6144, 1024, m0, n0, lds, [&](EPI_ARGS) {
      EPI_FOREACH(acc, if (row < 132) {
        const float4 b4 = *(const float4*)(bias + col0);
        *(float4*)(mo + (size_t)row * 6144 + col0) = make_float4(v[0] + b4.x, v[1] + b4.y, v[2] + b4.z, v[3] + b4.w);
      })
    });
  }
}

__device__ __forceinline__ void phase_norm(const Params& p, int layer, int which, bool from_input, bool shift_out) {
  const int lane = threadIdx.x & 63, w = threadIdx.x >> 6;
  const float* mod = (const float*)(p.ws + WS_MOD);
  u16* H = (u16*)(p.ws + WS_H);
  const float* g = (which ? p.norm2_g : p.norm1_g) + layer * 1024;
  const int nw = gridDim.x * 8;
  auto xrow = [&](int row) {
    return from_input ? (row < NP ? p.x_prompt + (size_t)row * 1024 : p.x_sample + (size_t)(row - NP) * 1024)
                      : (const float*)p.out + (size_t)row * 1024;
  };
  float4 gg[4];
#pragma unroll
  for (int i = 0; i < 4; ++i) gg[i] = *(const float4*)(g + lane * 4 + 256 * i);
  int row = blockIdx.x * 8 + w;
  float4 xn[4];
  if (row < MROWS) {
    const float* xr = xrow(row);
#pragma unroll
    for (int i = 0; i < 4; ++i) xn[i] = *(const float4*)(xr + lane * 4 + 256 * i);
  }
  while (row < MROWS) {
    float4 x[4];
#pragma unroll
    for (int i = 0; i < 4; ++i) x[i] = xn[i];
    const int nrow = row + nw;
    if (nrow < MROWS) {
      const float* xr = xrow(nrow);
#pragma unroll
      for (int i = 0; i < 4; ++i) xn[i] = *(const float4*)(xr + lane * 4 + 256 * i);
    }
    const int bi = bidx_of(row);
    const float* mb = mod + ((size_t)layer * 132 + bi) * 6144;
    const float* sh = mb + (which ? 3 : 0) * 1024;
    const float* sc = mb + (which ? 4 : 1) * 1024;
    float4 s4[4], c4[4];
#pragma unroll
    for (int i = 0; i < 4; ++i) {
      s4[i] = *(const float4*)(sh + lane * 4 + 256 * i);
      c4[i] = *(const float4*)(sc + lane * 4 + 256 * i);
    }
    float ss = 0.f;
#pragma unroll
    for (int i = 0; i < 4; ++i) ss += x[i].x * x[i].x + x[i].y * x[i].y + x[i].z * x[i].z + x[i].w * x[i].w;
    ss = wavesum(ss);
    const float rs = rsqrtf(ss * (1.f / 1024.f) + 1e-6f);
    const bool so = shift_out && (row >= NP || (row & 4095) == 4095);
    float* sop = row >= NP ? p.out + O_SHS + (size_t)(row - NP) * 1024 : p.out + O_SHP + (size_t)(row >> 12) * 1024;
#pragma unroll
    for (int i = 0; i < 4; ++i) {
      const int c = lane * 4 + 256 * i;
      float4 h;
      h.x = x[i].x * rs * gg[i].x * (1.f + c4[i].x) + s4[i].x;
      h.y = x[i].y * rs * gg[i].y * (1.f + c4[i].y) + s4[i].y;
      h.z = x[i].z * rs * gg[i].z * (1.f + c4[i].z) + s4[i].z;
      h.w = x[i].w * rs * gg[i].w * (1.f + c4[i].w) + s4[i].w;
      uint2 pk;
      pk.x = pack2(h.x, h.y);
      pk.y = pack2(h.z, h.w);
      *(uint2*)(H + (size_t)row * LDH + c) = pk;
      if (so) *(float4*)(sop + c) = h;
      if (from_input && row >= NP) *(float4*)(p.out + (size_t)row * 1024 + c) = x[i];
    }
    row = nrow;
  }
}

__device__ __forceinline__ void phase_final(const Params& p) {
  const int lane = threadIdx.x & 63, w = threadIdx.x >> 6;
  const int nw = gridDim.x * 8;
  for (int row = blockIdx.x * 8 + w; row < MROWS; row += nw) {
    float* xr = p.out + (size_t)row * 1024;
    float4 x[4];
    float ss = 0.f;
#pragma unroll
    for (int i = 0; i < 4; ++i) {
      x[i] = *(const float4*)(xr + lane * 4 + 256 * i);
      ss += x[i].x * x[i].x + x[i].y * x[i].y + x[i].z * x[i].z + x[i].w * x[i].w;
    }
    ss = wavesum(ss);
    const float rs = rsqrtf(ss * (1.f / 1024.f) + 1e-6f);
#pragma unroll
    for (int i = 0; i < 4; ++i) {
      const int c = lane * 4 + 256 * i;
      float4 gg = *(const float4*)(p.final_g + c);
      float4 h;
      h.x = x[i].x * rs * gg.x;
      h.y = x[i].y * rs * gg.y;
      h.z = x[i].z * rs * gg.z;
      h.w = x[i].w * rs * gg.w;
      *(float4*)(xr + c) = h;
    }
  }
}

__device__ __forceinline__ void phase_rwkv_proj(const Params& p, char* lds) {
  const u16* H = (const u16*)(p.ws + WS_H);
  const u16* wt = (const u16*)(p.ws + WS_WT);
  u16* R = (u16*)(p.ws + S_R);
  u16* Kk = (u16*)(p.ws + S_K);
  u16* V = (u16*)(p.ws + S_V);
  u16* WH = (u16*)(p.ws + S_WH);
  u16* AH = (u16*)(p.ws + S_AH);
  u16* GH = (u16*)(p.ws + S_GH);
  for (int t = blockIdx.x; t < 65 * 27; t += gridDim.x) {
    const int mt = t / 27, j = t % 27;
    const int m0 = mt * 256;
    int kind, n0, N, mixi;
    const u16* Bt;
    if (j < 8) { kind = 0; n0 = j * 128; N = 1024; mixi = 0; Bt = wt + WT_WR; }
    else if (j < 16) { kind = 1; n0 = (j - 8) * 128; N = 1024; mixi = 2; Bt = wt + WT_WK; }
    else if (j < 24) { kind = 2; n0 = (j - 16) * 128; N = 1024; mixi = 3; Bt = wt + WT_WV; }
    else if (j == 24) { kind = 3; n0 = 0; N = 64; mixi = 1; Bt = wt + WT_W1; }
    else if (j == 25) { kind = 4; n0 = 0; N = 64; mixi = 4; Bt = wt + WT_A1; }
    else { kind = 5; n0 = 0; N = 128; mixi = 5; Bt = wt + WT_G1; }
    gemm_tile<true>(H, LDH, p.rw_mix + mixi * 1024, Bt, LDH, N, 1024, m0, n0, lds, [&](EPI_ARGS) {
      u16* dst = kind == 0 ? R : kind == 1 ? Kk : kind == 2 ? V : kind == 3 ? WH : kind == 4 ? AH : GH;
      const int ld = kind < 3 ? 1024 : (kind == 5 ? 128 : 64);
      EPI_FOREACH(acc, if (row < MROWS && col0 < ld) {
        f32x4 o = v;
        if (kind == 3) {
          _Pragma("unroll") for (int q = 0; q < 4; ++q) o[q] = 1.f - 2.f / (__expf(2.f * v[q]) + 1.f);
        } else if (kind == 5) {
          _Pragma("unroll") for (int q = 0; q < 4; ++q) o[q] = sigmoidf_(v[q]);
        }
        *(uint2*)(dst + (size_t)row * ld + col0) = pack4(o);
      })
    });
  }
}

__device__ __forceinline__ void phase_rwkv_lora2(const Params& p, char* lds) {
  const u16* wt = (const u16*)(p.ws + WS_WT);
  const u16* WH = (const u16*)(p.ws + S_WH);
  const u16* AH = (const u16*)(p.ws + S_AH);
  u16* EW = (u16*)(p.ws + S_EW);
  u16* Aa = (u16*)(p.ws + S_A);
  for (int t = blockIdx.x; t < 65 * 16; t += gridDim.x) {
    const int mt = t >> 4, j = t & 15;
    const int m0 = mt * 256, n0 = (j & 7) * 128;
    const bool isw = j < 8;
    gemm_tile<false>(isw ? WH : AH, 64, nullptr, wt + (isw ? WT_W2 : WT_A2), 64, 1024, 64, m0, n0, lds, [&](EPI_ARGS) {
      const float* b0 = isw ? p.rw_w0 : p.rw_a0;
      EPI_FOREACH(acc, if (row < MROWS) {
        const float4 b4 = *(const float4*)(b0 + col0);
        const float s0 = sigmoidf_(v[0] + b4.x), s1 = sigmoidf_(v[1] + b4.y), s2 = sigmoidf_(v[2] + b4.z), s3 = sigmoidf_(v[3] + b4.w);
        if (isw) {
          const float c = 0.6065306597126334f;
          uint2 o;
          o.x = (unsigned)f2h(c * s0) | ((unsigned)f2h(c * s1) << 16);
          o.y = (unsigned)f2h(c * s2) | ((unsigned)f2h(c * s3) << 16);
          *(uint2*)(EW + (size_t)row * 1024 + col0) = o;
        } else {
          uint2 o;
          o.x = pack2(s0, s1);
          o.y = pack2(s2, s3);
          *(uint2*)(Aa + (size_t)row * 1024 + col0) = o;
        }
      })
    });
  }
}

constexpr int RING_TS = 344;
constexpr int RING_BUF = 16 * RING_TS;

__device__ __forceinline__ void phase_scan(const Params& p, char* lds) {
  const int tid = threadIdx.x, lane = tid & 63, w = tid >> 6;
  const u16* R = (const u16*)(p.ws + S_R);
  const u16* Kk = (const u16*)(p.ws + S_K);
  const u16* V = (const u16*)(p.ws + S_V);
  const u16* EW = (const u16*)(p.ws + S_EW);
  const u16* Aa = (const u16*)(p.ws + S_A);
  u16* Y = (u16*)(p.ws + WS_H);
  float* RK = (float*)(p.ws + WS_RK);
  float* ring = (float*)lds;
  float* ybuf = (float*)(lds + 2 * RING_BUF * 4);
  for (int item = blockIdx.x; item < 256; item += gridDim.x) {
    const int chain = item >> 2, qr = item & 3, b = chain >> 4, h = chain & 15;
    const size_t rowbase = (size_t)b * 4096;
    __syncthreads();
    if (tid >= 256) {
      const int pt = tid - 256, tok = pt >> 4, cq = pt & 15;
      const int ch = h * 64 + cq * 4;
      const float4 kk4 = *(const float4*)(p.rw_kk + ch), ka4 = *(const float4*)(p.rw_ka + ch), rk4 = *(const float4*)(p.rw_rk + ch);
      struct PS {
        uint2 rr, rk_, rv, ra_, re;
      };
      PS S0, S1;
      auto pload = [&](PS& S, int c) {
        const size_t off = (rowbase + (size_t)c * 16 + tok) * 1024 + ch;
        S.rr = *(const uint2*)(R + off);
        S.rk_ = *(const uint2*)(Kk + off);
        S.rv = *(const uint2*)(V + off);
        S.ra_ = *(const uint2*)(Aa + off);
        S.re = *(const uint2*)(EW + off);
      };
      auto pproc = [&](PS& S, int c) {
        const uint2 rr = S.rr, rk_ = S.rk_, rv = S.rv, ra_ = S.ra_, re = S.re;
        float rf[4] = {bflo(rr.x), bfhi(rr.x), bflo(rr.y), bfhi(rr.y)};
        float kf[4] = {bflo(rk_.x), bfhi(rk_.x), bflo(rk_.y), bfhi(rk_.y)};
        float vf[4] = {bflo(rv.x), bfhi(rv.x), bflo(rv.y), bfhi(rv.y)};
        float af[4] = {bflo(ra_.x), bfhi(ra_.x), bflo(ra_.y), bfhi(ra_.y)};
        float ef[4] = {h2f((u16)(re.x & 0xffff)), h2f((u16)(re.x >> 16)), h2f((u16)(re.y & 0xffff)), h2f((u16)(re.y >> 16))};
        const float kkw[4] = {kk4.x, kk4.y, kk4.z, kk4.w}, kaw[4] = {ka4.x, ka4.y, ka4.z, ka4.w}, rkw[4] = {rk4.x, rk4.y, rk4.z, rk4.w};
        float kkr[4], kp[4], ss = 0.f, rks = 0.f;
#pragma unroll
        for (int j = 0; j < 4; ++j) {
          kkr[j] = kf[j] * kkw[j];
          ss += kkr[j] * kkr[j];
          kp[j] = kf[j] * (1.f + (af[j] - 1.f) * kaw[j]);
          rks += rf[j] * kp[j] * rkw[j];
        }
        ss = rowsum16(ss);
        rks = rowsum16(rks);
        const float inv = 1.f / fmaxf(sqrtf(ss), 1e-12f);
        float* slot = ring + (c & 1) * RING_BUF + tok * RING_TS;
        float am[4], dc[4], bm[4], wr[4], br = 0.f, kr = 0.f;
#pragma unroll
        for (int j = 0; j < 4; ++j) {
          am[j] = -kkr[j] * inv;
          dc[j] = __expf(-ef[j]);
          bm[j] = kkr[j] * inv * af[j];
          wr[j] = dc[j] * rf[j];
          br += bm[j] * rf[j];
          kr += kp[j] * rf[j];
        }
        br = rowsum16(br);
        kr = rowsum16(kr);
        *(float4*)(slot + cq * 4) = make_float4(am[0], am[1], am[2], am[3]);
        *(float4*)(slot + 64 + cq * 4) = make_float4(dc[0], dc[1], dc[2], dc[3]);
        *(float4*)(slot + 128 + cq * 4) = make_float4(bm[0], bm[1], bm[2], bm[3]);
        *(float4*)(slot + 192 + cq * 4) = make_float4(kp[0], kp[1], kp[2], kp[3]);
        *(float4*)(slot + 256 + cq * 4) = make_float4(wr[0], wr[1], wr[2], wr[3]);
        if (cq == 0) *(float2*)(slot + 336) = make_float2(br, kr);
        if ((cq >> 2) == qr) *(float4*)(slot + 320 + (cq & 3) * 4) = make_float4(vf[0], vf[1], vf[2], vf[3]);
        if (cq == 0 && qr == 0) RK[(rowbase + (size_t)c * 16 + tok) * 16 + h] = rks;
      };
      pload(S0, 0);
      pproc(S0, 0);
      pload(S1, 1);
      pload(S0, 2);
      BAR_SYNC();
#pragma unroll 1
      for (int c = 0; c < 256; c += 2) {
        pproc(S1, c + 1);
        if (c + 3 < 256) pload(S1, c + 3);
        BAR_SYNC();
        if (c + 2 < 256) pproc(S0, c + 2);
        if (c + 4 < 256) pload(S0, c + 4);
        BAR_SYNC();
      }
    } else {
      const int rl = tid >> 4, cgp = tid & 15;
      float s0 = 0.f, s1 = 0.f, s2 = 0.f, s3 = 0.f;
      BAR_SYNC();
      for (int c = 0; c < 256; ++c) {
        if (c > 0) {
          const float yv = ybuf[((c - 1) & 1) * 256 + tid];
          Y[(rowbase + (size_t)(c - 1) * 16 + rl) * LDH + h * 64 + qr * 16 + cgp] = f2bf(yv);
        }
        const float* bufp = ring + (c & 1) * RING_BUF;
        float* yb = ybuf + (c & 1) * 256;
        struct SV {
          float4 a, w, b, k, wr;
          float v;
          float2 bk;
        };
        auto ldstep = [&](const float* slot) {
          SV r;
          r.a = *(const float4*)(slot + cgp * 4);
          r.w = *(const float4*)(slot + 64 + cgp * 4);
          r.b = *(const float4*)(slot + 128 + cgp * 4);
          r.k = *(const float4*)(slot + 192 + cgp * 4);
          r.wr = *(const float4*)(slot + 256 + cgp * 4);
          r.v = slot[320 + rl];
          r.bk = *(const float2*)(slot + 336);
          return r;
        };
        SV cur = ldstep(bufp);
#pragma unroll
        for (int tk = 0; tk < 16; ++tk) {
          SV nxt = cur;
          if (tk + 1 < 16) nxt = ldstep(bufp + (tk + 1) * RING_TS);
          float sa = s0 * cur.a.x + s1 * cur.a.y + s2 * cur.a.z + s3 * cur.a.w;
          float yw = s0 * cur.wr.x + s1 * cur.wr.y + s2 * cur.wr.z + s3 * cur.wr.w;
          const float t0 = s0 * cur.w.x + cur.v * cur.k.x;
          const float t1 = s1 * cur.w.y + cur.v * cur.k.y;
          const float t2 = s2 * cur.w.z + cur.v * cur.k.z;
          const float t3 = s3 * cur.w.w + cur.v * cur.k.w;
          sa = rowsum16(sa);
          yw = rowsum16(yw);
          s0 = t0 + sa * cur.b.x;
          s1 = t1 + sa * cur.b.y;
          s2 = t2 + sa * cur.b.z;
          s3 = t3 + sa * cur.b.w;
          const float y = yw + sa * cur.bk.x + cur.v * cur.bk.y;
          if (cgp == 0) yb[tk * 16 + rl] = y;
          cur = nxt;
        }
        BAR_SYNC();
      }
      {
        const float yv = ybuf[(255 & 1) * 256 + tid];
        Y[(rowbase + (size_t)255 * 16 + rl) * LDH + h * 64 + qr * 16 + cgp] = f2bf(yv);
      }
      float* wo = p.out + O_WKVP + (((size_t)(b * 16 + h) * 64) + qr * 16 + rl) * 64 + cgp * 4;
      *(float4*)wo = make_float4(s0, s1, s2, s3);
    }
  }
  float* sl = (float*)lds;
  for (int chain = blockIdx.x; chain < 2048; chain += gridDim.x) {
    const int b = chain >> 4, h = chain & 15;
    const size_t row = (size_t)NP + b;
    __syncthreads();
    if (w == 0) {
      const int ch = h * 64 + lane;
      const size_t off = row * 1024 + ch;
      const float rf = bf2f(R[off]), kf = bf2f(Kk[off]), vf = bf2f(V[off]), af = bf2f(Aa[off]), ef = h2f(EW[off]);
      const float kkr = kf * p.rw_kk[ch];
      const float ss = wavesum(kkr * kkr);
      const float inv = 1.f / fmaxf(sqrtf(ss), 1e-12f);
      const float kp = kf * (1.f + (af - 1.f) * p.rw_ka[ch]);
      const float rks = wavesum(rf * kp * p.rw_rk[ch]);
      sl[lane] = -kkr * inv;
      sl[64 + lane] = __expf(-ef);
      sl[128 + lane] = kkr * inv * af;
      sl[192 + lane] = kp;
      sl[256 + lane] = rf;
      sl[320 + lane] = vf;
      if (lane == 0) RK[row * 16 + h] = rks;
    }
    __syncthreads();
    const int i = tid >> 3, c8 = tid & 7;
    const float* sp = p.state_wkv + (((size_t)(b * 16 + h) * 64) + i) * 64 + c8 * 8;
    float4 sA = *(const float4*)sp, sB = *(const float4*)(sp + 4);
    float s[8] = {sA.x, sA.y, sA.z, sA.w, sB.x, sB.y, sB.z, sB.w};
    float sa = 0.f;
#pragma unroll
    for (int j = 0; j < 8; ++j) sa += s[j] * sl[c8 * 8 + j];
    sa += __shfl_xor(sa, 1);
    sa += __shfl_xor(sa, 2);
    sa += __shfl_xor(sa, 4);
    const float vv = sl[320 + i];
    float y = 0.f;
#pragma unroll
    for (int j = 0; j < 8; ++j) {
      const int cj = c8 * 8 + j;
      s[j] = s[j] * sl[64 + cj] + sa * sl[128 + cj] + vv * sl[192 + cj];
      y += s[j] * sl[256 + cj];
    }
    y += __shfl_xor(y, 1);
    y += __shfl_xor(y, 2);
    y += __shfl_xor(y, 4);
    float* wo = p.out + O_WKVS + (((size_t)(b * 16 + h) * 64) + i) * 64 + c8 * 8;
    *(float4*)wo = make_float4(s[0], s[1], s[2], s[3]);
    *(float4*)(wo + 4) = make_float4(s[4], s[5], s[6], s[7]);
    if (c8 == 0) Y[row * LDH + h * 64 + i] = f2bf(y);
  }
}

__device__ __forceinline__ void phase_gate(const Params& p, char* lds) {
  const u16* wt = (const u16*)(p.ws + WS_WT);
  const u16* GH = (const u16*)(p.ws + S_GH);
  const u16* V = (const u16*)(p.ws + S_V);
  const float* RK = (const float*)(p.ws + WS_RK);
  u16* Y = (u16*)(p.ws + WS_H);
  for (int t = blockIdx.x; t < 65 * 8; t += gridDim.x) {
    const int mt = t >> 3, nt = t & 7;
    const int m0 = mt * 256, n0 = nt * 128;
    gemm_tile<false>(GH, 128, nullptr, wt + WT_G2, 128, 1024, 128, m0, n0, lds, [&](EPI_ARGS) {
      const int hh = (n0 + wn * 64) >> 6;
#pragma unroll
      for (int mi = 0; mi < 8; ++mi) {
        const int row = m0 + wm * 128 + mi * 16 + lr;
        const int rowc = row < MROWS ? row : MROWS - 1;
        float yv[4][4];
        float sum = 0.f;
#pragma unroll
        for (int ni = 0; ni < 4; ++ni) {
          const uint2 yy = *(const uint2*)(Y + (size_t)rowc * LDH + hh * 64 + ni * 16 + lg * 4);
          yv[ni][0] = bflo(yy.x); yv[ni][1] = bfhi(yy.x); yv[ni][2] = bflo(yy.y); yv[ni][3] = bfhi(yy.y);
          sum += yv[ni][0] + yv[ni][1] + yv[ni][2] + yv[ni][3];
        }
        sum += __shfl_xor(sum, 16);
        sum += __shfl_xor(sum, 32);
        const float mu = sum * (1.f / 64.f);
        float vs = 0.f;
#pragma unroll
        for (int ni = 0; ni < 4; ++ni)
#pragma unroll
          for (int q = 0; q < 4; ++q) {
            const float d = yv[ni][q] - mu;
            vs += d * d;
          }
        vs += __shfl_xor(vs, 16);
        vs += __shfl_xor(vs, 32);
        const float rstd = rsqrtf(vs * (1.f / 64.f) + 64e-5f);
        const float rk = RK[(size_t)rowc * 16 + hh];
#pragma unroll
        for (int ni = 0; ni < 4; ++ni) {
          const int col0 = hh * 64 + ni * 16 + lg * 4;
          const uint2 vv = *(const uint2*)(V + (size_t)rowc * 1024 + col0);
          const float vf[4] = {bflo(vv.x), bfhi(vv.x), bflo(vv.y), bfhi(vv.y)};
          const float4 g4 = *(const float4*)(p.rw_lnx_g + col0), b4 = *(const float4*)(p.rw_lnx_b + col0);
          const float gg[4] = {g4.x, g4.y, g4.z, g4.w}, bb[4] = {b4.x, b4.y, b4.z, b4.w};
          f32x4 o;
#pragma unroll
          for (int q = 0; q < 4; ++q) o[q] = ((yv[ni][q] - mu) * rstd * gg[q] + bb[q] + rk * vf[q]) * acc[mi][ni][q];
          if (row < MROWS) *(uint2*)(Y + (size_t)row * LDH + col0) = pack4(o);
        }
        __builtin_amdgcn_sched_barrier(0);
      }
    });
  }
}

__device__ __forceinline__ void phase_oproj(const Params& p, char* lds, const u16* A, int K, const u16* Bt, int layer, int gidx, bool first) {
  const int ldab = K == 1024 ? LDH : LDU;
  const float* mod = (const float*)(p.ws + WS_MOD);
  for (int u = blockIdx.x; u < 320; u += gridDim.x) {
    const bool split = u >= 256;
    const int s = u - 256;
    const int m0 = split ? NP : (u >> 2) * 256, n0 = (split ? (s & 3) : (u & 3)) * 256;
    const int klen = split ? (K >> 4) : K, kbeg = split ? (s >> 2) * klen : 0;
    gemm_tile256(A + kbeg, ldab, Bt + kbeg, ldab, klen, m0, n0, lds, split, [&](EPI_ARGS) {
      EPI_FOREACH(acc, if (row < MROWS) {
        const float4 gt = *(const float4*)(mod + ((size_t)layer * 132 + bidx_of(row)) * 6144 + gidx * 1024 + col0);
        float* xp = p.out + (size_t)row * 1024 + col0;
        if (split) {
          unsafeAtomicAdd(xp + 0, gt.x * v[0]);
          unsafeAtomicAdd(xp + 1, gt.y * v[1]);
          unsafeAtomicAdd(xp + 2, gt.z * v[2]);
          unsafeAtomicAdd(xp + 3, gt.w * v[3]);
        } else {
          const float* xi = first ? p.x_prompt + (size_t)row * 1024 + col0 : xp;
          const float4 xo = *(const float4*)xi;
          *(float4*)xp = make_float4(xo.x + gt.x * v[0], xo.y + gt.y * v[1], xo.z + gt.z * v[2], xo.w + gt.w * v[3]);
        }
      })
    });
  }
}

__device__ __forceinline__ void phase_up(const Params& p, char* lds, const u16* Bt) {
  const u16* H = (const u16*)(p.ws + WS_H);
  u16* UP = (u16*)(p.ws + S_UP);
  for (int t = blockIdx.x; t < 65 * 16; t += gridDim.x) {
    const int mt = t >> 4, nt = t & 15;
    const int m0 = mt * 256, n0 = nt * 256;
    gemm_tile256(H, LDH, Bt, LDH, 1024, m0, n0, lds, mt == 64, [&](EPI_ARGS) {
      EPI_FOREACH(acc, if (row < MROWS) {
        f32x4 o;
        _Pragma("unroll") for (int q = 0; q < 4; ++q) {
          const float rl = fmaxf(v[q], 0.f);
          o[q] = rl * rl;
        }
        *(uint2*)(UP + (size_t)row * LDU + col0) = pack4(o);
      })
    });
  }
}

__device__ __forceinline__ void phase_qkv(const Params& p, char* lds) {
  const u16* H = (const u16*)(p.ws + WS_H);
  const u16* wt = (const u16*)(p.ws + WS_WT);
  const float* tab = (const float*)(p.ws + WS_TAB);
  u16* Qb = (u16*)(p.ws + S_Q);
  u16* Kb = (u16*)(p.ws + S_KB);
  u16* Vt = (u16*)(p.ws + S_VT);
  for (int t = blockIdx.x; t < 65 * 12; t += gridDim.x) {
    const int mt = t / 12, nt = t % 12;
    const int m0 = mt * 256, n0 = nt * 128;
    gemm_tile<false>(H, LDH, nullptr, wt + WT_QKV, LDH, 1536, 1024, m0, n0, lds, [&](EPI_ARGS) {
      const int hc0 = n0 + wn * 64;
#pragma unroll
      for (int mi = 0; mi < 8; ++mi) {
        const int row = m0 + wm * 128 + mi * 16 + lr;
        const bool valid = row < MROWS;
        const bool isp = row < NP;
        const int pos = row & 4095;
        const int bq = isp ? (row >> 12) : (row - NP);
        const int posidx = isp ? pos : 4096;
#pragma unroll
        for (int ni = 0; ni < 4; ++ni) {
          const int col0 = hc0 + ni * 16 + lg * 4;
          const float4 b4 = *(const float4*)(p.at_bqkv + col0);
          f32x4 v = acc[mi][ni];
          v[0] += b4.x; v[1] += b4.y; v[2] += b4.z; v[3] += b4.w;
          if (ni == 0 && hc0 < 1280) {
            const float* tp = tab + (size_t)posidx * 16 + (lg & 1) * 8;
            const float4 t0 = *(const float4*)tp, t1 = *(const float4*)(tp + 4);
            const float cs[4] = {t0.x, t0.z, t1.x, t1.z}, sn[4] = {t0.y, t0.w, t1.y, t1.w};
#pragma unroll
            for (int q = 0; q < 4; ++q) {
              const float pv = __shfl_xor(v[q], 32);
              v[q] = (lg < 2) ? (v[q] * cs[q] - pv * sn[q]) : (v[q] * cs[q] + pv * sn[q]);
            }
          }
          if (valid) {
            if (hc0 < 1024) {
              *(uint2*)(Qb + (size_t)row * 1024 + col0) = pack4(v);
            } else if (hc0 < 1280) {
              const int c2 = col0 - 1024;
              *(uint2*)(Kb + (size_t)row * 256 + c2) = pack4(v);
              if (isp) {
                if (pos >= 3968) *(float4*)(p.out + O_KP + ((size_t)(bq * 128 + pos - 3968)) * 256 + c2) = make_float4(v[0], v[1], v[2], v[3]);
              } else {
                *(float4*)(p.out + O_KS + ((size_t)(bq * 128 + 127)) * 256 + c2) = make_float4(v[0], v[1], v[2], v[3]);
              }
            } else {
              const int c3 = col0 - 1280;
              if (isp) {
                u16* vp = Vt + ((size_t)(bq * 4 + (c3 >> 6)) * 64 + (c3 & 63)) * 4096 + pos;
#pragma unroll
                for (int q = 0; q < 4; ++q) vp[(size_t)q * 4096] = f2bf(v[q]);
                if (pos >= 3968) *(float4*)(p.out + O_VP + ((size_t)(bq * 128 + pos - 3968)) * 256 + c3) = make_float4(v[0], v[1], v[2], v[3]);
              } else {
                *(float4*)(p.out + O_VS + ((size_t)(bq * 128 + 127)) * 256 + c3) = make_float4(v[0], v[1], v[2], v[3]);
              }
            }
          }
        }
        __builtin_amdgcn_sched_barrier(0);
      }
    });
  }
}

constexpr int AT_KS = 0, AT_VS = 36864, AT_PS = 36864 + 35840, AT_PW = 5376;

__device__ __forceinline__ void phase_attn(const Params& p, char* lds) {
  const int tid = threadIdx.x, lane = tid & 63, w = tid >> 6, lr = lane & 15, lg = lane >> 4;
  const u16* Qb = (const u16*)(p.ws + S_Q);
  const u16* Kb = (const u16*)(p.ws + S_KB);
  const u16* Vt = (const u16*)(p.ws + S_VT);
  u16* O = (u16*)(p.ws + S_O);
  char* Ks = lds + AT_KS;
  char* Vs = lds + AT_VS;
  char* Ps = lds + AT_PS + w * AT_PW;
  for (int u = blockIdx.x; u < 512; u += gridDim.x) {
    const int b = u >> 7, n = (u >> 2) & 31, kvh = u & 3;
    bf16x8 qfa[4][2];
    {
      const int g_ = w >> 1, hf_ = w & 1, qh_ = kvh * 4 + g_;
#pragma unroll
      for (int i = 0; i < 4; ++i) {
        const size_t tok = (size_t)b * 4096 + n * 128 + hf_ * 64 + i * 16 + lr;
        qfa[i][0] = *(const bf16x8*)(Qb + tok * 1024 + qh_ * 64 + lg * 8);
        qfa[i][1] = *(const bf16x8*)(Qb + tok * 1024 + qh_ * 64 + 32 + lg * 8);
      }
    }
    __syncthreads();
#pragma unroll
    for (int i = 0; i < 4; ++i) {
      const int c = tid + 512 * i;
      {
        const int key = c >> 3, kc = c & 7;
        const int pos = n * 128 - 128 + key;
        uint4 v = {0u, 0u, 0u, 0u};
        if (pos >= 0) v = *(const uint4*)(Kb + ((size_t)b * 4096 + pos) * 256 + kvh * 64 + kc * 8);
        *(uint4*)(Ks + key * 144 + kc * 16) = v;
      }
      {
        const int d = c >> 5, kc = c & 31;
        const int pos0 = n * 128 - 128 + kc * 8;
        uint4 v = {0u, 0u, 0u, 0u};
        if (pos0 >= 0) v = *(const uint4*)(Vt + ((size_t)(b * 4 + kvh) * 64 + d) * 4096 + pos0);
        *(uint4*)(Vs + d * 560 + kc * 16) = v;
      }
    }
    if (tid < 192) {
      const int d = tid / 3, c = tid % 3;
      *(uint4*)(Vs + d * 560 + 512 + c * 16) = uint4{0u, 0u, 0u, 0u};
    }
    {
      const int prow = lane >> 2, pc = 144 + (lane & 3) * 4;
      *(uint2*)(Ps + prow * 336 + pc * 2) = uint2{0u, 0u};
    }
    __syncthreads();
    const int g = w >> 1, hf = w & 1;
    const int qh = kvh * 4 + g;
    const float sink = p.at_sink[qh];
#pragma unroll
    for (int i = 0; i < 4; ++i) {
      const int q0 = hf * 64 + i * 16;
      const bf16x8 qf0 = qfa[i][0];
      const bf16x8 qf1 = qfa[i][1];
      f32x4 s[9];
#pragma unroll
      for (int j = 0; j < 9; ++j) {
        const char* kp = Ks + (q0 + j * 16 + lr) * 144 + lg * 16;
        const bf16x8 k0 = *(const bf16x8*)kp;
        const bf16x8 k1 = *(const bf16x8*)(kp + 64);
        f32x4 z = {0.f, 0.f, 0.f, 0.f};
        z = __builtin_amdgcn_mfma_f32_16x16x32_bf16(qf0, k0, z, 0, 0, 0);
        z = __builtin_amdgcn_mfma_f32_16x16x32_bf16(qf1, k1, z, 0, 0, 0);
        s[j] = z;
      }
      float mx[4], sum[4];
#pragma unroll
      for (int r = 0; r < 4; ++r) {
        const int ql = lg * 4 + r;
        float m = sink;
#pragma unroll
        for (int j = 0; j < 9; ++j) {
          float v = s[j][r] * 0.125f;
          bool ok = true;
          if (j == 0) ok = (lr >= ql);
          if (j == 8) ok = (lr <= ql);
          if (n == 0 && (q0 + j * 16 + lr) < 128) ok = false;
          v = ok ? v : -INFINITY;
          s[j][r] = v;
          m = fmaxf(m, v);
        }
        mx[r] = rowmax16(m);
      }
#pragma unroll
      for (int r = 0; r < 4; ++r) {
        float sm = 0.f;
#pragma unroll
        for (int j = 0; j < 9; ++j) {
          const float e = __expf(s[j][r] - mx[r]);
          s[j][r] = e;
          sm += e;
        }
        sm = rowsum16(sm);
        sum[r] = sm + __expf(sink - mx[r]);
      }
      u16* P = (u16*)Ps;
#pragma unroll
      for (int j = 0; j < 9; ++j)
#pragma unroll
        for (int r = 0; r < 4; ++r) P[(lg * 4 + r) * 168 + j * 16 + lr] = f2bf(s[j][r]);
      __builtin_amdgcn_wave_barrier();
      f32x4 o[4];
#pragma unroll
      for (int nd = 0; nd < 4; ++nd) o[nd] = f32x4{0.f, 0.f, 0.f, 0.f};
#pragma unroll
      for (int kk = 0; kk < 5; ++kk) {
        const bf16x8 pf = *(const bf16x8*)(Ps + lr * 336 + kk * 64 + lg * 16);
#pragma unroll
        for (int nd = 0; nd < 4; ++nd) {
          const bf16x8 vf = *(const bf16x8*)(Vs + (nd * 16 + lr) * 560 + (q0 + kk * 32 + lg * 8) * 2);
          o[nd] = __builtin_amdgcn_mfma_f32_16x16x32_bf16(pf, vf, o[nd], 0, 0, 0);
        }
      }
#pragma unroll
      for (int nd = 0; nd < 4; ++nd)
#pragma unroll
        for (int r = 0; r < 4; ++r) {
          const float v = o[nd][r] / sum[r];
          O[((size_t)b * 4096 + n * 128 + q0 + lg * 4 + r) * LDH + qh * 64 + nd * 16 + lr] = f2bf(v);
        }
      __builtin_amdgcn_wave_barrier();
    }
  }
  float* qs = (float*)lds;
  float* sc = (float*)(lds + 1024);
  float* part = (float*)(lds + 1024 + 2112);
  for (int it = blockIdx.x; it < 512; it += gridDim.x) {
    const int b = it >> 2, kvh = it & 3;
    const size_t row = (size_t)NP + b;
    __syncthreads();
    if (tid < 256) qs[tid] = bf2f(Qb[row * 1024 + kvh * 256 + tid]);
    __syncthreads();
    {
      const int key = tid >> 2, g = tid & 3;
      const float* kp = p.cache_k + (((size_t)b * 128 + key) * 4 + kvh) * 64;
      float dot = 0.f;
#pragma unroll
      for (int d4 = 0; d4 < 16; ++d4) {
        const float4 kv = *(const float4*)(kp + d4 * 4);
        const float* q = qs + g * 64 + d4 * 4;
        dot += kv.x * q[0] + kv.y * q[1] + kv.z * q[2] + kv.w * q[3];
      }
      sc[g * 132 + key] = dot * 0.125f;
      if (key >= 1) {
        float* dst = p.out + O_KS + (((size_t)b * 128 + key - 1) * 4 + kvh) * 64 + g * 16;
        const float* src = kp + g * 16;
#pragma unroll
        for (int d4 = 0; d4 < 4; ++d4) *(float4*)(dst + d4 * 4) = *(const float4*)(src + d4 * 4);
      }
      if (tid < 4) {
        const float* kn = p.out + O_KS + (((size_t)b * 128 + 127) * 4 + kvh) * 64;
        float d2 = 0.f;
        for (int d = 0; d < 64; ++d) d2 += kn[d] * qs[tid * 64 + d];
        sc[tid * 132 + 128] = d2 * 0.125f;
      }
    }
    __syncthreads();
    if (w < 4) {
      const float sink = p.at_sink[kvh * 4 + w];
      float* s = sc + w * 132;
      const float v0 = s[lane], v1 = s[64 + lane], v2 = lane == 0 ? s[128] : -INFINITY;
      float m = fmaxf(fmaxf(v0, v1), fmaxf(v2, sink));
      m = wavemax(m);
      const float e0 = __expf(v0 - m), e1 = __expf(v1 - m), e2 = lane == 0 ? __expf(v2 - m) : 0.f;
      float sm = wavesum(e0 + e1 + e2) + __expf(sink - m);
      const float inv = 1.f / sm;
      s[lane] = e0 * inv;
      s[64 + lane] = e1 * inv;
      if (lane == 0) s[128] = e2 * inv;
    }
    __syncthreads();
    {
      const int d = tid & 63, g = (tid >> 6) & 3, half = tid >> 8;
      const float* vp = p.cache_v + (((size_t)b * 128) * 4 + kvh) * 64 + d;
      float accv = 0.f;
      for (int key = half * 64; key < half * 64 + 64; ++key) {
        const float vv = vp[(size_t)key * 256];
        accv += sc[g * 132 + key] * vv;
        if (g == 0 && key >= 1) p.out[O_VS + (((size_t)b * 128 + key - 1) * 4 + kvh) * 64 + d] = vv;
      }
      if (half == 1) accv += sc[g * 132 + 128] * p.out[O_VS + (((size_t)b * 128 + 127) * 4 + kvh) * 64 + d];
      part[(half * 4 + g) * 64 + d] = accv;
    }
    __syncthreads();
    if (tid < 256) {
      const int d = tid & 63, g = tid >> 6;
      O[row * LDH + (kvh * 4 + g) * 64 + d] = f2bf(part[g * 64 + d] + part[(4 + g) * 64 + d]);
    }
  }
}

__global__ void __launch_bounds__(NTHR) mega(Params p) {
  extern __shared__ __attribute__((aligned(16))) char lds[];
  cg::grid_group grid = cg::this_grid();
  volatile LAS unsigned* xst = (volatile LAS unsigned*)(lds + LDS_BYTES);
  if (threadIdx.x == 0) { xst[0] = 0u; xst[1] = 0u; }
  __syncthreads();
  const XcdBarrier xb = xcd_barrier_post((unsigned*)(p.ws + WS_BAR), xst);
  const u16* wt = (const u16*)(p.ws + WS_WT);
  phase0(p, lds);
  if (p.out == nullptr) grid.sync();
  xcd_barrier(xb);
  phase_ada(p, lds);
  xcd_barrier(xb);
  phase_norm(p, 0, 0, true, true);
  xcd_barrier(xb);
  phase_rwkv_proj(p, lds);
  xcd_barrier(xb);
  phase_rwkv_lora2(p, lds);
  xcd_barrier(xb);
  phase_scan(p, lds);
  xcd_barrier(xb);
  phase_gate(p, lds);
  xcd_barrier(xb);
  phase_oproj(p, lds, (const u16*)(p.ws + WS_H), 1024, wt + WT_WO, 0, 2, true);
  xcd_barrier(xb);
  phase_norm(p, 0, 1, false, false);
  xcd_barrier(xb);
  phase_up(p, lds, wt + WT_UP0);
  xcd_barrier(xb);
  phase_oproj(p, lds, (const u16*)(p.ws + S_UP), 4096, wt + WT_DN0, 0, 5, false);
  xcd_barrier(xb);
  phase_norm(p, 1, 0, false, false);
  xcd_barrier(xb);
  phase_qkv(p, lds);
  xcd_barrier(xb);
  phase_attn(p, lds);
  xcd_barrier(xb);
  phase_oproj(p, lds, (const u16*)(p.ws + S_O), 1024, wt + WT_WO1, 1, 2, false);
  xcd_barrier(xb);
  phase_norm(p, 1, 1, false, false);
  xcd_barrier(xb);
  phase_up(p, lds, wt + WT_UP1);
  xcd_barrier(xb);
  phase_oproj(p, lds, (const u16*)(p.ws + S_UP), 4096, wt + WT_DN1, 1, 5, false);
  xcd_barrier(xb);
  phase_final(p);
}

extern "C" void kernel_launch(void* const* d_in, const int* in_sizes, int n_in, void* d_out, int out_size, void* d_ws,
                              size_t ws_size, hipStream_t stream) {
  static int grid_blocks = 0;
  if (grid_blocks == 0) {
    if (ws_size < WS_END) {
      fprintf(stderr, "kernel_launch: workspace too small: %zu < %zu\n", ws_size, (size_t)WS_END);
      grid_blocks = -1;
      return;
    }
    int dev = 0, cus = 0, per_cu = 0;
    hipGetDevice(&dev);
    hipDeviceGetAttribute(&cus, hipDeviceAttributeMultiprocessorCount, dev);
    hipFuncSetAttribute((const void*)mega, hipFuncAttributeMaxDynamicSharedMemorySize, LDS_BYTES + 16);
    hipOccupancyMaxActiveBlocksPerMultiprocessor(&per_cu, (const void*)mega, NTHR, LDS_BYTES + 16);
    if (per_cu < 1) per_cu = 1;
    grid_blocks = cus * per_cu;
  }
  if (grid_blocks < 0) return;
  Params p{};
  const float** pp = (const float**)&p;
  for (int i = 0; i < 37; ++i) pp[i] = (const float*)d_in[i];
  p.out = (float*)d_out;
  p.ws = (char*)d_ws;
  hipMemsetAsync((char*)d_ws + WS_BAR, 0, 16384, stream);
  void* args[] = {&p};
  hipError_t e = hipLaunchCooperativeKernel((const void*)mega, dim3(grid_blocks), dim3(NTHR), args, LDS_BYTES + 16, stream);
  if (e != hipSuccess) fprintf(stderr, "cooperative launch failed: %s (grid %d)\n", hipGetErrorString(e), grid_blocks);
}
```

```cpp
#include <hip/hip_runtime.h>
#include <hip/hip_cooperative_groups.h>
#include <cstdio>
namespace cg = cooperative_groups;

typedef unsigned short u16;
typedef __attribute__((ext_vector_type(8))) short bf16x8;
typedef __attribute__((ext_vector_type(4))) float f32x4;

constexpr int NP = 16384, MROWS = 16512, MPAD = 16640;
constexpr int NTHR = 512;
constexpr size_t MEG = 1048576;
constexpr int LDH = 1088, LDU = 4160;

constexpr size_t O_Y = 0, O_WKVP = 16908288, O_WKVS = 17170432, O_SHP = 25559040, O_SHS = 25563136,
                 O_KP = 25694208, O_KS = 25825280, O_VP = 30019584, O_VS = 30150656;

constexpr size_t WT_WR = 0, WT_WK = WT_WR + 1024 * LDH, WT_WV = WT_WK + 1024 * LDH, WT_WO = WT_WV + 1024 * LDH,
                 WT_W1 = WT_WO + 1024 * LDH, WT_A1 = WT_W1 + 64 * LDH, WT_G1 = WT_A1 + 64 * LDH, WT_W2 = WT_G1 + 128 * LDH,
                 WT_A2 = WT_W2 + 65536, WT_G2 = WT_A2 + 65536, WT_UP0 = WT_G2 + 131072, WT_DN0 = WT_UP0 + 4096 * LDH,
                 WT_QKV = WT_DN0 + 1024 * LDU, WT_WO1 = WT_QKV + 1536 * LDH, WT_UP1 = WT_WO1 + 1024 * LDH,
                 WT_DN1 = WT_UP1 + 4096 * LDH, WT_END = WT_DN1 + 1024 * LDU;
constexpr size_t WS_WT = 0;
constexpr size_t WS_H = WS_WT + WT_END * 2;
constexpr size_t WS_ZR = WS_H + (size_t)MPAD * LDH * 2;
constexpr size_t WS_MOD = WS_ZR + (size_t)LDH * 2;
constexpr size_t WS_TAB = WS_MOD + (size_t)2 * 132 * 6144 * 4;
constexpr size_t WS_HS = WS_H + (size_t)MROWS * LDH * 2;
constexpr size_t WS_RK = WS_TAB + (size_t)4097 * 8 * 8;
constexpr size_t WS_BAR = WS_RK + (size_t)MPAD * 16 * 4;
constexpr size_t WS_S = WS_BAR + 16384;
constexpr size_t RSZ = (size_t)MROWS * 1024 * 2;
constexpr size_t S_ADAWT = WS_S, S_SILUC = S_ADAWT + (size_t)2 * 6144 * LDH * 2;
constexpr size_t S_R = WS_S, S_K = S_R + RSZ, S_V = S_K + RSZ, S_EW = S_V + RSZ, S_A = S_EW + RSZ,
                 S_WH = S_A + RSZ, S_AH = S_WH + (size_t)MPAD * 64 * 2, S_GH = S_AH + (size_t)MPAD * 64 * 2,
                 S_RW_END = S_GH + (size_t)MPAD * 128 * 2;
constexpr size_t S_UP = WS_S;
constexpr size_t S_Q = WS_S, S_O = S_Q + (size_t)MPAD * 1024 * 2, S_KB = S_O + (size_t)MPAD * LDH * 2,
                 S_VT = S_KB + (size_t)MPAD * 256 * 2;
constexpr size_t WS_END = S_RW_END;
static_assert(S_UP + (size_t)MPAD * LDU * 2 <= WS_END, "up fits");
static_assert(S_VT + (size_t)16 * 64 * 4096 * 2 <= WS_END, "attn fits");
static_assert(WS_END <= 282000000, "ws fits sum of inputs");

constexpr int LDS_ROW = 144;
constexpr int LDS_A_BYTES = 256 * LDS_ROW;
constexpr int LDS_B_BYTES = 128 * LDS_ROW;
constexpr int LDS_STAGE = LDS_A_BYTES + LDS_B_BYTES;
constexpr int LDS_BYTES = 147456;

struct Params {
  const float *x_prompt, *x_sample, *c_prompt, *c_sample, *state_wkv, *state_shift, *cache_k, *cache_v;
  const float *norm1_g, *norm2_g, *ada_w, *ada_b, *mlp_up, *mlp_down, *final_g;
  const float *rw_mix, *rw_wr, *rw_wk, *rw_wv, *rw_wo, *rw_w0, *rw_w1, *rw_w2, *rw_a0, *rw_a1, *rw_a2, *rw_g1, *rw_g2,
      *rw_kk, *rw_ka, *rw_rk, *rw_lnx_g, *rw_lnx_b;
  const float *at_wqkv, *at_bqkv, *at_wo, *at_sink;
  float* out;
  char* ws;
};

__device__ __forceinline__ u16 f2bf(float f) {
  unsigned u = __float_as_uint(f);
  u += 0x7fffu + ((u >> 16) & 1u);
  return (u16)(u >> 16);
}
__device__ __forceinline__ float bf2f(u16 h) { return __uint_as_float(((unsigned)h) << 16); }
__device__ __forceinline__ float bflo(unsigned w) { return __uint_as_float(w << 16); }
__device__ __forceinline__ float bfhi(unsigned w) { return __uint_as_float(w & 0xffff0000u); }
__device__ __forceinline__ unsigned pack2(float a, float b) {
  unsigned r;
  asm volatile("v_cvt_pk_bf16_f32 %0, %1, %2" : "=v"(r) : "v"(a), "v"(b));
  return r;
}
__device__ __forceinline__ uint2 pack4(f32x4 v) { return uint2{pack2(v[0], v[1]), pack2(v[2], v[3])}; }
__device__ __forceinline__ float h2f(u16 h) { return (float)__builtin_bit_cast(_Float16, h); }
__device__ __forceinline__ u16 f2h(float f) { return __builtin_bit_cast(u16, (_Float16)f); }
__device__ __forceinline__ float sigmoidf_(float x) { return 1.f / (1.f + __expf(-x)); }

template <int CTRL>
__device__ __forceinline__ float dppf(float x) {
  return __int_as_float(__builtin_amdgcn_update_dpp(0, __float_as_int(x), CTRL, 0xf, 0xf, true));
}
__device__ __forceinline__ float rowsum16(float x) {
  x += dppf<0xB1>(x);
  x += dppf<0x4E>(x);
  x += dppf<0x124>(x);
  x += dppf<0x128>(x);
  return x;
}
__device__ __forceinline__ float rowmax16(float x) {
  x = fmaxf(x, dppf<0xB1>(x));
  x = fmaxf(x, dppf<0x4E>(x));
  x = fmaxf(x, dppf<0x124>(x));
  x = fmaxf(x, dppf<0x128>(x));
  return x;
}
__device__ __forceinline__ float wavesum(float x) {
#pragma unroll
  for (int o = 32; o > 0; o >>= 1) x += __shfl_xor(x, o);
  return x;
}
__device__ __forceinline__ float wavemax(float x) {
#pragma unroll
  for (int o = 32; o > 0; o >>= 1) x = fmaxf(x, __shfl_xor(x, o));
  return x;
}
__device__ __forceinline__ int bidx_of(int row) { return row < NP ? (row >> 12) : (4 + row - NP); }

#define XB_TMO      128
#define XB_XCNT(j)  (256  + 64 * (j))
#define XB_XSUB(j)  (1280 + 64 * (j))
#define XB_XGEN(j)  (2304 + 64 * (j))
#define XB_TOP      3328
#define XB_TOPGEN   3392
#define XCD_BAR_WORDS 3456
#define XB_SPIN_CAP (1u << 22)
#define LAS __attribute__((address_space(3)))
__device__ __forceinline__ unsigned xb_ld(unsigned* p) { return __hip_atomic_load(p, __ATOMIC_RELAXED, __HIP_MEMORY_SCOPE_AGENT); }
__device__ __forceinline__ unsigned xb_add(unsigned* p, unsigned v) { return __hip_atomic_fetch_add(p, v, __ATOMIC_RELAXED, __HIP_MEMORY_SCOPE_AGENT); }
__device__ __forceinline__ unsigned xb_xcc_id() { return (unsigned)__builtin_amdgcn_s_getreg((3 << 11) | 20) & 0xFu; }
#define XB_SPIN(cond, bar) do { unsigned _sp = 0; while (cond) { __builtin_amdgcn_s_sleep(1); \
    if ((++_sp & 255u) == 0u) { if (xb_ld(&(bar)[XB_TMO])) break; if (_sp > XB_SPIN_CAP) { atomicAdd(&(bar)[XB_TMO], 1u); break; } } } } while (0)
struct XcdBarrier {
  unsigned* bar;
  unsigned x;
  volatile LAS unsigned* st;
};
__device__ __forceinline__ XcdBarrier xcd_barrier_post(unsigned* bar, volatile LAS unsigned* st) {
  XcdBarrier b;
  b.bar = bar;
  b.x = xb_xcc_id();
  b.st = st;
  if (threadIdx.x == 0) (void)xb_add(&bar[XB_XCNT(b.x)], 1u);
  return b;
}
__device__ __forceinline__ void xcd_barrier_complete(unsigned* bar, unsigned x, unsigned& nloc, unsigned& nx) {
  const unsigned G = gridDim.x * gridDim.y * gridDim.z;
  unsigned sum, cnt, mine, sp = 0u;
  for (;;) {
    sum = 0u; cnt = 0u; mine = 0u;
#pragma unroll
    for (unsigned j = 0; j < 16; ++j) {
      const unsigned c = xb_ld(&bar[XB_XCNT(j)]);
      sum += c;
      cnt += (c > 0u) ? 1u : 0u;
      mine = (j == x) ? c : mine;
    }
    if (sum == G) break;
    __builtin_amdgcn_s_sleep(1);
    if ((++sp & 255u) == 0u) {
      if (xb_ld(&bar[XB_TMO])) break;
      if (sp > XB_SPIN_CAP) { atomicAdd(&bar[XB_TMO], 1u); break; }
    }
  }
  nloc = mine > 0u ? mine : 1u;
  nx = cnt > 0u ? cnt : 1u;
}
__device__ __forceinline__ void xcd_barrier(const XcdBarrier& b) {
  asm volatile("s_waitcnt vmcnt(0)" ::: "memory");
  __syncthreads();
  if (threadIdx.x == 0) {
    unsigned* bar = b.bar;
    __builtin_amdgcn_s_waitcnt(0);
    unsigned nloc = b.st[0], nx = b.st[1];
    if (nloc == 0u) { xcd_barrier_complete(bar, b.x, nloc, nx); b.st[0] = nloc; b.st[1] = nx; }
    const unsigned old = xb_add(&bar[XB_XSUB(b.x)], 1u);
    const unsigned gen = old / nloc;
    if (old + 1u == (gen + 1u) * nloc) {
      __builtin_amdgcn_fence(__ATOMIC_RELEASE, "agent");
      asm volatile("s_waitcnt vmcnt(0)" ::: "memory");
      const unsigned og = xb_add(&bar[XB_TOP], 1u);
      const unsigned tg = og / nx;
      if (og + 1u == (tg + 1u) * nx) xb_add(&bar[XB_TOPGEN], 1u);
      else XB_SPIN(xb_ld(&bar[XB_TOPGEN]) == tg, bar);
      __builtin_amdgcn_fence(__ATOMIC_ACQUIRE, "agent");
      xb_add(&bar[XB_XGEN(b.x)], 1u);
      asm volatile("s_waitcnt vmcnt(0)" ::: "memory");
    } else {
      XB_SPIN(xb_ld(&bar[XB_XGEN(b.x)]) == gen, bar);
      __builtin_amdgcn_fence(__ATOMIC_ACQUIRE, "agent");
      asm volatile("s_waitcnt vmcnt(0)" ::: "memory");
    }
  }
  __syncthreads();
}

#define BAR_SYNC() do { asm volatile("s_waitcnt lgkmcnt(0)" ::: "memory"); __builtin_amdgcn_s_barrier(); asm volatile("" ::: "memory"); } while (0)

__device__ __forceinline__ unsigned mix2(unsigned h, unsigned p, float m0, float m1) {
  float h0 = bflo(h), h1 = bfhi(h), p0 = bflo(p), p1 = bfhi(p);
  return pack2(h0 + (p0 - h0) * m0, h1 + (p1 - h1) * m1);
}

template <bool MIX, class Epi>
__device__ __forceinline__ void gemm_tile(const u16* __restrict__ A, int lda, const float* __restrict__ mixv,
                                          const u16* __restrict__ Bt, int ldb, int N, int K, int m0, int n0, char* lds, Epi&& epi) {
  const int tid = threadIdx.x, lane = tid & 63, w = tid >> 6;
  const int nk = K >> 6;
  if (w >= 4) {
    const int pt = tid - 256, kc = pt & 7, pr = pt >> 3;
    const u16* Ab = A + (size_t)m0 * lda + (size_t)pr * lda + kc * 8;
    int poff[8];
#pragma unroll
    for (int i = 0; i < 8; ++i) {
      poff[i] = 0;
      if (MIX) {
        const int row = m0 + pr + 32 * i;
        const int prow = row < NP ? ((row & 4095) ? row - 1 : MPAD) : (row < MROWS ? row + 128 : MPAD);
        poff[i] = prow * LDH + kc * 8;
      }
    }
    bool bv[4];
    const u16* bp[4];
#pragma unroll
    for (int j = 0; j < 4; ++j) {
      const int n = n0 + pr + 32 * j;
      bv[j] = n < N;
      bp[j] = Bt + (size_t)(bv[j] ? n : 0) * ldb + kc * 8;
    }
    struct RSet {
      uint4 ra[8], rp[8], rb[4];
      float4 mx0, mx1;
    };
    RSet SA, SB;
    auto gload = [&](RSet& S, int kt) {
      const int ko = kt * 64;
#pragma unroll
      for (int i = 0; i < 8; ++i) {
        S.ra[i] = *(const uint4*)(Ab + (size_t)(32 * i) * lda + ko);
        if (MIX) S.rp[i] = *(const uint4*)(A + poff[i] + ko);
      }
      if (MIX) {
        S.mx0 = *(const float4*)(mixv + ko + kc * 8);
        S.mx1 = *(const float4*)(mixv + ko + kc * 8 + 4);
      }
#pragma unroll
      for (int j = 0; j < 4; ++j) {
        uint4 z = {0u, 0u, 0u, 0u};
        if (bv[j]) z = *(const uint4*)(bp[j] + ko);
        S.rb[j] = z;
      }
    };
    auto lstore = [&](RSet& S, int s) {
      char* base = lds + s * LDS_STAGE + pr * LDS_ROW + kc * 16;
#pragma unroll
      for (int i = 0; i < 8; ++i) {
        uint4 v = S.ra[i];
        if (MIX) {
          v.x = mix2(S.ra[i].x, S.rp[i].x, S.mx0.x, S.mx0.y);
          v.y = mix2(S.ra[i].y, S.rp[i].y, S.mx0.z, S.mx0.w);
          v.z = mix2(S.ra[i].z, S.rp[i].z, S.mx1.x, S.mx1.y);
          v.w = mix2(S.ra[i].w, S.rp[i].w, S.mx1.z, S.mx1.w);
        }
        *(uint4*)(base + (32 * i) * LDS_ROW) = v;
      }
#pragma unroll
      for (int j = 0; j < 4; ++j) *(uint4*)(base + LDS_A_BYTES + (32 * j) * LDS_ROW) = S.rb[j];
    };
    if constexpr (!MIX) {
      gload(SB, 0);
      if (nk > 1) gload(SA, 1);
      lstore(SB, 0);
      if (nk > 2) gload(SB, 2);
      BAR_SYNC();
#pragma unroll 1
      for (int kt = 0; kt < nk; kt += 2) {
        if (kt + 1 < nk) {
          lstore(SA, 1);
          if (kt + 3 < nk) gload(SA, kt + 3);
        }
        BAR_SYNC();
        if (kt + 1 < nk) {
          if (kt + 2 < nk) {
            lstore(SB, 0);
            if (kt + 4 < nk) gload(SB, kt + 4);
          }
          BAR_SYNC();
        }
      }
    } else {
      gload(SA, 0);
      lstore(SA, 0);
      if (nk > 1) gload(SA, 1);
      BAR_SYNC();
#pragma unroll 1
      for (int kt = 0; kt < nk; ++kt) {
        if (kt + 1 < nk) {
          lstore(SA, (kt + 1) & 1);
          if (kt + 2 < nk) gload(SA, kt + 2);
        }
        BAR_SYNC();
      }
    }
  } else {
    const int wm = w >> 1, wn = w & 1, lr = lane & 15, lg = lane >> 4;
    f32x4 acc[8][4];
#pragma unroll
    for (int i = 0; i < 8; ++i)
#pragma unroll
      for (int j = 0; j < 4; ++j) acc[i][j] = f32x4{0.f, 0.f, 0.f, 0.f};
    BAR_SYNC();
#pragma unroll 1
    for (int kt = 0; kt < nk; ++kt) {
      const char* sa = lds + (kt & 1) * LDS_STAGE + (wm * 128 + lr) * LDS_ROW + lg * 16;
      const char* sb = lds + (kt & 1) * LDS_STAGE + LDS_A_BYTES + (wn * 64 + lr) * LDS_ROW + lg * 16;
      bf16x8 bq[2][4], aq[3];
#pragma unroll
      for (int ni = 0; ni < 4; ++ni) bq[0][ni] = *(const bf16x8*)(sb + ni * 16 * LDS_ROW);
      aq[0] = *(const bf16x8*)(sa);
      aq[1] = *(const bf16x8*)(sa + 16 * LDS_ROW);
#pragma unroll
      for (int ni = 0; ni < 4; ++ni) bq[1][ni] = *(const bf16x8*)(sb + ni * 16 * LDS_ROW + 64);
#pragma unroll
      for (int st = 0; st < 16; ++st) {
        if (st + 2 < 16) aq[(st + 2) % 3] = *(const bf16x8*)(sa + ((st + 2) & 7) * 16 * LDS_ROW + ((st + 2) >> 3) * 64);
#pragma unroll
        for (int ni = 0; ni < 4; ++ni)
          acc[st & 7][ni] = __builtin_amdgcn_mfma_f32_16x16x32_bf16(bq[st >> 3][ni], aq[st % 3], acc[st & 7][ni], 0, 0, 0);
        __builtin_amdgcn_sched_barrier(0);
      }
      BAR_SYNC();
    }
    epi(acc, wm, wn, lr, lg);
  }
}

constexpr int LDS_STAGE2 = 2 * LDS_A_BYTES;
template <class Epi>
__device__ __forceinline__ void gemm_tile256(const u16* __restrict__ A, int lda, const u16* __restrict__ Bt, int ldb, int K, int m0,
                                             int n0, char* lds, bool half, Epi&& epi) {
  int tid = threadIdx.x;
  asm volatile("" : "+v"(tid));
  const int lane = tid & 63, w = __builtin_amdgcn_readfirstlane(tid >> 6);
  const int wm = w >> 2, wn = w & 3, lr = lane & 15, lg = lane >> 4;
  const int nk = K >> 5;
  const int drow = lane >> 2, dch = (lane & 3) ^ ((lane >> 4) & 3);
  const u16* As0 = A + (size_t)(m0 + w * 16 + drow) * lda + dch * 8;
  const u16* As1 = A + (size_t)(m0 + (w + 8) * 16 + drow) * lda + dch * 8;
  const u16* Bs0 = Bt + (size_t)(n0 + w * 16 + drow) * ldb + dch * 8;
  const u16* Bs1 = Bt + (size_t)(n0 + (w + 8) * 16 + drow) * ldb + dch * 8;
  auto dma = [&](int kt, int stg) __attribute__((always_inline)) {
    char* sbase = lds + stg * 32768;
    const int ko = kt * 32;
    __builtin_amdgcn_global_load_lds((const unsigned*)(As0 + ko), (unsigned*)(sbase + w * 1024), 16, 0, 0);
    __builtin_amdgcn_global_load_lds((const unsigned*)(As1 + ko), (unsigned*)(sbase + (w + 8) * 1024), 16, 0, 0);
    __builtin_amdgcn_global_load_lds((const unsigned*)(Bs0 + ko), (unsigned*)(sbase + 16384 + w * 1024), 16, 0, 0);
    __builtin_amdgcn_global_load_lds((const unsigned*)(Bs1 + ko), (unsigned*)(sbase + 16384 + (w + 8) * 1024), 16, 0, 0);
  };
  f32x4 acc[8][4];
#pragma unroll
  for (int i = 0; i < 8; ++i)
#pragma unroll
    for (int j = 0; j < 4; ++j) acc[i][j] = f32x4{0.f, 0.f, 0.f, 0.f};
  const int swz = (lg ^ ((lr >> 2) & 3)) * 16;
  const int aoff = (wm * 128 + lr) * 64 + swz, boff = 16384 + (wn * 64 + lr) * 64 + swz;
  const bool skipm = half && wm == 1;
  dma(0, 0);
  dma(nk > 1 ? 1 : nk - 1, 1);
  dma(nk > 2 ? 2 : nk - 1, 2);
  asm volatile("s_waitcnt vmcnt(8)" ::: "memory");
  BAR_SYNC();
#pragma unroll 1
  for (int kt = 0; kt < nk; ++kt) {
    dma(kt + 3 < nk ? kt + 3 : nk - 1, (kt + 3) & 3);
    if (!skipm) {
      const char* sa = lds + (kt & 3) * 32768 + aoff;
      const char* sb = lds + (kt & 3) * 32768 + boff;
      bf16x8 bq[4], aq[3];
#pragma unroll
      for (int ni = 0; ni < 4; ++ni) bq[ni] = *(const bf16x8*)(sb + ni * 1024);
      aq[0] = *(const bf16x8*)(sa);
      aq[1] = *(const bf16x8*)(sa + 1024);
#pragma unroll
      for (int st = 0; st < 8; ++st) {
        if (st + 2 < 8) aq[(st + 2) % 3] = *(const bf16x8*)(sa + (st + 2) * 1024);
#pragma unroll
        for (int ni = 0; ni < 4; ++ni)
          acc[st][ni] = __builtin_amdgcn_mfma_f32_16x16x32_bf16(bq[ni], aq[st % 3], acc[st][ni], 0, 0, 0);
        __builtin_amdgcn_sched_barrier(0);
      }
    }
    asm volatile("s_waitcnt vmcnt(8)" ::: "memory");
    BAR_SYNC();
  }
  asm volatile("s_waitcnt vmcnt(0)" ::: "memory");
  BAR_SYNC();
  epi(acc, wm, wn, lr, lg);
}

#define EPI_FOREACH(acc, ...)                                    \
  _Pragma("unroll") for (int mi = 0; mi < 8; ++mi) {             \
    const int row = m0 + wm * 128 + mi * 16 + lr;                \
    _Pragma("unroll") for (int ni = 0; ni < 4; ++ni) {           \
      const int col0 = n0 + wn * 64 + ni * 16 + lg * 4;          \
      const f32x4 v = acc[mi][ni];                               \
      __VA_ARGS__                                                \
    }                                                            \
    __builtin_amdgcn_sched_barrier(0);                           \
  }
#define EPI_ARGS f32x4(&acc)[8][4], int wm, int wn, int lr, int lg

__device__ __forceinline__ void conv_job(const float* __restrict__ src, u16* __restrict__ dst, int K, int N, int ldk, float* tl, int rot) {
  int tid = threadIdx.x;
  asm volatile("" : "+v"(tid));
  const int tn = N >> 6, nt = (K >> 6) * tn;
  const int G = gridDim.x;
  int t = ((int)blockIdx.x + G - (rot % G)) % G;
  float v[8];
  auto ldtile = [&](int tt) {
    const int k0 = (tt / tn) << 6, n0 = (tt % tn) << 6;
#pragma unroll
    for (int i = 0; i < 8; ++i) {
      const int e = tid + 512 * i;
      v[i] = src[(size_t)(k0 + (e >> 6)) * N + n0 + (e & 63)];
    }
  };
  if (t < nt) ldtile(t);
  while (t < nt) {
    const int k0 = (t / tn) << 6, n0 = (t % tn) << 6;
#pragma unroll
    for (int i = 0; i < 8; ++i) {
      const int e = tid + 512 * i;
      tl[(e >> 6) * 65 + (e & 63)] = v[i];
    }
    const int tnx = t + G;
    if (tnx < nt) ldtile(tnx);
    __syncthreads();
    const int n = tid >> 3, kc = tid & 7;
    float f[8];
#pragma unroll
    for (int j = 0; j < 8; ++j) f[j] = tl[(kc * 8 + j) * 65 + n];
    uint4 o;
    o.x = pack2(f[0], f[1]);
    o.y = pack2(f[2], f[3]);
    o.z = pack2(f[4], f[5]);
    o.w = pack2(f[6], f[7]);
    *(uint4*)(dst + (size_t)(n0 + n) * ldk + k0 + kc * 8) = o;
    __syncthreads();
    t = tnx;
  }
}

__device__ __forceinline__ void phase0(const Params& p, char* lds) {
  float* tl = (float*)lds;
  u16* wt = (u16*)(p.ws + WS_WT);
  u16* adawt = (u16*)(p.ws + S_ADAWT);
  int rot = 0;
#define CJ(SRC, DST, K, N)            \
  conv_job(SRC, DST, K, N, ((K) == 1024 ? LDH : (K) == 4096 ? LDU : (K)), tl, rot);  \
  rot += ((K) >> 6) * ((N) >> 6);
  CJ(p.ada_w, adawt, 1024, 6144)
  CJ(p.ada_w + (size_t)1024 * 6144, adawt + (size_t)6144 * LDH, 1024, 6144)
  CJ(p.rw_wr, wt + WT_WR, 1024, 1024)
  CJ(p.rw_wk, wt + WT_WK, 1024, 1024)
  CJ(p.rw_wv, wt + WT_WV, 1024, 1024)
  CJ(p.rw_wo, wt + WT_WO, 1024, 1024)
  CJ(p.rw_w1, wt + WT_W1, 1024, 64)
  CJ(p.rw_a1, wt + WT_A1, 1024, 64)
  CJ(p.rw_g1, wt + WT_G1, 1024, 128)
  CJ(p.rw_w2, wt + WT_W2, 64, 1024)
  CJ(p.rw_a2, wt + WT_A2, 64, 1024)
  CJ(p.rw_g2, wt + WT_G2, 128, 1024)
  CJ(p.mlp_up, wt + WT_UP0, 1024, 4096)
  CJ(p.mlp_down, wt + WT_DN0, 4096, 1024)
  CJ(p.at_wqkv, wt + WT_QKV, 1024, 1536)
  CJ(p.at_wo, wt + WT_WO1, 1024, 1024)
  CJ(p.mlp_up + (size_t)4 * MEG, wt + WT_UP1, 1024, 4096)
  CJ(p.mlp_down + (size_t)4 * MEG, wt + WT_DN1, 4096, 1024)
#undef CJ
  const int gtid = blockIdx.x * NTHR + threadIdx.x, gsz = gridDim.x * NTHR;
  u16* siluc = (u16*)(p.ws + S_SILUC);
  for (int i = gtid; i < 256 * 1024; i += gsz) {
    int row = i >> 10, col = i & 1023;
    float c = 0.f;
    if (row < 4) c = p.c_prompt[row * 1024 + col];
    else if (row < 132) c = p.c_sample[(row - 4) * 1024 + col];
    siluc[i] = f2bf(c * sigmoidf_(c));
  }
  u16* hs = (u16*)(p.ws + WS_HS);
  for (int i = gtid; i < 128 * 1024; i += gsz) hs[(size_t)(i >> 10) * LDH + (i & 1023)] = f2bf(p.state_shift[i]);
  u16* zr = (u16*)(p.ws + WS_ZR);
  for (int i = gtid; i < LDH; i += gsz) zr[i] = 0;
  float2* tab = (float2*)(p.ws + WS_TAB);
  for (int i = gtid; i < 4097 * 8; i += gsz) {
    int pi = i >> 3, f = i & 7;
    float pos = pi < 4096 ? (float)pi : 8192.f;
    float inv = f == 0 ? 1.0f : f == 1 ? 0.1939227432012558f : f == 2 ? 0.03760603070259094f : f == 3 ? 0.007292664609849453f
              : f == 4 ? 0.0014142135623842478f : f == 5 ? 0.00027424818836152554f : f == 6 ? 5.318296098266728e-05f
              : 1.0313386155758053e-05f;
    float ang = pos * inv;
    double t = (double)ang * 0.15915494309189535;
    t -= rint(t);
    float fr = (float)t;
    tab[i] = make_float2(__builtin_amdgcn_cosf(fr), __builtin_amdgcn_sinf(fr));
  }
}

__device__ __forceinline__ void phase_ada(const Params& p, char* lds) {
  const u16* siluc = (const u16*)(p.ws + S_SILUC);
  const u16* adawt = (const u16*)(p.ws + S_ADAWT);
  float* mod = (float*)(p.ws + WS_MOD);
  for (int t = blockIdx.x; t < 96; t += gridDim.x) {
    const int layer = t / 48, nt = t % 48;
    const int m0 = 0, n0 = nt * 128;
    const float* bias = p.ada_b + layer * 6144;
    float* mo = mod + (size_t)layer * 132 * 6144;
    gemm_tile<false>(siluc, 1024, nullptr, adawt + (size_t)layer * 6144 * LDH, LDH, 6144, 1024, m0, n0, lds, [&](EPI_ARGS) {
      EPI_FOREACH(acc, if (row < 132) {
        const float4 b4 = *(const float4*)(bias + col0);
        *(float4*)(mo + (size_t)row * 6144 + col0) = make_float4(v[0] + b4.x, v[1] + b4.y, v[2] + b4.z, v[3] + b4.w);
      })
    });
  }
}

__device__ __forceinline__ void phase_norm(const Params& p, int layer, int which, bool from_input, bool shift_out) {
  const int lane = threadIdx.x & 63, w = threadIdx.x >> 6;
  const float* mod = (const float*)(p.ws + WS_MOD);
  u16* H = (u16*)(p.ws + WS_H);
  const float* g = (which ? p.norm2_g : p.norm1_g) + layer * 1024;
  const int nw = gridDim.x * 8;
  auto xrow = [&](int row) {
    return from_input ? (row < NP ? p.x_prompt + (size_t)row * 1024 : p.x_sample + (size_t)(row - NP) * 1024)
                      : (const float*)p.out + (size_t)row * 1024;
  };
  float4 gg[4];
#pragma unroll
  for (int i = 0; i < 4; ++i) gg[i] = *(const float4*)(g + lane * 4 + 256 * i);
  int row = blockIdx.x * 8 + w;
  float4 xn[4];
  if (row < MROWS) {
    const float* xr = xrow(row);
#pragma unroll
    for (int i = 0; i < 4; ++i) xn[i] = *(const float4*)(xr + lane * 4 + 256 * i);
  }
  while (row < MROWS) {
    float4 x[4];
#pragma unroll
    for (int i = 0; i < 4; ++i) x[i] = xn[i];
    const int nrow = row + nw;
    if (nrow < MROWS) {
      const float* xr = xrow(nrow);
#pragma unroll
      for (int i = 0; i < 4; ++i) xn[i] = *(const float4*)(xr + lane * 4 + 256 * i);
    }
    const int bi = bidx_of(row);
    const float* mb = mod + ((size_t)layer * 132 + bi) * 6144;
    const float* sh = mb + (which ? 3 : 0) * 1024;
    const float* sc = mb + (which ? 4 : 1) * 1024;
    float4 s4[4], c4[4];
#pragma unroll
    for (int i = 0; i < 4; ++i) {
      s4[i] = *(const float4*)(sh + lane * 4 + 256 * i);
      c4[i] = *(const float4*)(sc + lane * 4 + 256 * i);
    }
    float ss = 0.f;
#pragma unroll
    for (int i = 0; i < 4; ++i) ss += x[i].x * x[i].x + x[i].y * x[i].y + x[i].z * x[i].z + x[i].w * x[i].w;
    ss = wavesum(ss);
    const float rs = rsqrtf(ss * (1.f / 1024.f) + 1e-6f);
    const bool so = shift_out && (row >= NP || (row & 4095) == 4095);
    float* sop = row >= NP ? p.out + O_SHS + (size_t)(row - NP) * 1024 : p.out + O_SHP + (size_t)(row >> 12) * 1024;
#pragma unroll
    for (int i = 0; i < 4; ++i) {
      const int c = lane * 4 + 256 * i;
      float4 h;
      h.x = x[i].x * rs * gg[i].x * (1.f + c4[i].x) + s4[i].x;
      h.y = x[i].y * rs * gg[i].y * (1.f + c4[i].y) + s4[i].y;
      h.z = x[i].z * rs * gg[i].z * (1.f + c4[i].z) + s4[i].z;
      h.w = x[i].w * rs * gg[i].w * (1.f + c4[i].w) + s4[i].w;
      uint2 pk;
      pk.x = pack2(h.x, h.y);
      pk.y = pack2(h.z, h.w);
      *(uint2*)(H + (size_t)row * LDH + c) = pk;
      if (so) *(float4*)(sop + c) = h;
      if (from_input && row >= NP) *(float4*)(p.out + (size_t)row * 1024 + c) = x[i];
    }
    row = nrow;
  }
}

__device__ __forceinline__ void phase_final(const Params& p) {
  const int lane = threadIdx.x & 63, w = threadIdx.x >> 6;
  const int nw = gridDim.x * 8;
  for (int row = blockIdx.x * 8 + w; row < MROWS; row += nw) {
    float* xr = p.out + (size_t)row * 1024;
    float4 x[4];
    float ss = 0.f;
#pragma unroll
    for (int i = 0; i < 4; ++i) {
      x[i] = *(const float4*)(xr + lane * 4 + 256 * i);
      ss += x[i].x * x[i].x + x[i].y * x[i].y + x[i].z * x[i].z + x[i].w * x[i].w;
    }
    ss = wavesum(ss);
    const float rs = rsqrtf(ss * (1.f / 1024.f) + 1e-6f);
#pragma unroll
    for (int i = 0; i < 4; ++i) {
      const int c = lane * 4 + 256 * i;
      float4 gg = *(const float4*)(p.final_g + c);
      float4 h;
      h.x = x[i].x * rs * gg.x;
      h.y = x[i].y * rs * gg.y;
      h.z = x[i].z * rs * gg.z;
      h.w = x[i].w * rs * gg.w;
      *(float4*)(xr + c) = h;
    }
  }
}

__device__ __forceinline__ void phase_rwkv_proj(const Params& p, char* lds) {
  const u16* H = (const u16*)(p.ws + WS_H);
  const u16* wt = (const u16*)(p.ws + WS_WT);
  u16* R = (u16*)(p.ws + S_R);
  u16* Kk = (u16*)(p.ws + S_K);
  u16* V = (u16*)(p.ws + S_V);
  u16* WH = (u16*)(p.ws + S_WH);
  u16* AH = (u16*)(p.ws + S_AH);
  u16* GH = (u16*)(p.ws + S_GH);
  for (int t = blockIdx.x; t < 65 * 27; t += gridDim.x) {
    const int mt = t / 27, j = t % 27;
    const int m0 = mt * 256;
    int kind, n0, N, mixi;
    const u16* Bt;
    if (j < 8) { kind = 0; n0 = j * 128; N = 1024; mixi = 0; Bt = wt + WT_WR; }
    else if (j < 16) { kind = 1; n0 = (j - 8) * 128; N = 1024; mixi = 2; Bt = wt + WT_WK; }
    else if (j < 24) { kind = 2; n0 = (j - 16) * 128; N = 1024; mixi = 3; Bt = wt + WT_WV; }
    else if (j == 24) { kind = 3; n0 = 0; N = 64; mixi = 1; Bt = wt + WT_W1; }
    else if (j == 25) { kind = 4; n0 = 0; N = 64; mixi = 4; Bt = wt + WT_A1; }
    else { kind = 5; n0 = 0; N = 128; mixi = 5; Bt = wt + WT_G1; }
    gemm_tile<true>(H, LDH, p.rw_mix + mixi * 1024, Bt, LDH, N, 1024, m0, n0, lds, [&](EPI_ARGS) {
      u16* dst = kind == 0 ? R : kind == 1 ? Kk : kind == 2 ? V : kind == 3 ? WH : kind == 4 ? AH : GH;
      const int ld = kind < 3 ? 1024 : (kind == 5 ? 128 : 64);
      EPI_FOREACH(acc, if (row < MROWS && col0 < ld) {
        f32x4 o = v;
        if (kind == 3) {
          _Pragma("unroll") for (int q = 0; q < 4; ++q) o[q] = 1.f - 2.f / (__expf(2.f * v[q]) + 1.f);
        } else if (kind == 5) {
          _Pragma("unroll") for (int q = 0; q < 4; ++q) o[q] = sigmoidf_(v[q]);
        }
        *(uint2*)(dst + (size_t)row * ld + col0) = pack4(o);
      })
    });
  }
}

__device__ __forceinline__ void phase_rwkv_lora2(const Params& p, char* lds) {
  const u16* wt = (const u16*)(p.ws + WS_WT);
  const u16* WH = (const u16*)(p.ws + S_WH);
  const u16* AH = (const u16*)(p.ws + S_AH);
  u16* EW = (u16*)(p.ws + S_EW);
  u16* Aa = (u16*)(p.ws + S_A);
  for (int t = blockIdx.x; t < 65 * 8; t += gridDim.x) {
    const int mt = t >> 3, j = t & 7;
    const int m0 = mt * 256, n0 = (j & 3) * 256;
    const bool isw = j < 4;
    gemm_tile256(isw ? WH : AH, 64, wt + (isw ? WT_W2 : WT_A2), 64, 64, m0, n0, lds, mt == 64, [&](EPI_ARGS) {
      const float* b0 = isw ? p.rw_w0 : p.rw_a0;
      EPI_FOREACH(acc, if (row < MROWS) {
        const float4 b4 = *(const float4*)(b0 + col0);
        const float s0 = sigmoidf_(v[0] + b4.x), s1 = sigmoidf_(v[1] + b4.y), s2 = sigmoidf_(v[2] + b4.z), s3 = sigmoidf_(v[3] + b4.w);
        if (isw) {
          const float c = 0.6065306597126334f;
          uint2 o;
          o.x = (unsigned)f2h(c * s0) | ((unsigned)f2h(c * s1) << 16);
          o.y = (unsigned)f2h(c * s2) | ((unsigned)f2h(c * s3) << 16);
          *(uint2*)(EW + (size_t)row * 1024 + col0) = o;
        } else {
          uint2 o;
          o.x = pack2(s0, s1);
          o.y = pack2(s2, s3);
          *(uint2*)(Aa + (size_t)row * 1024 + col0) = o;
        }
      })
    });
  }
}

constexpr int PAIR_TS = 624;
constexpr int PAIR_BUF = 8 * PAIR_TS;

__device__ __forceinline__ void phase_scan(const Params& p, char* lds) {
  const int tid = threadIdx.x, lane = tid & 63, w = tid >> 6;
  const u16* R = (const u16*)(p.ws + S_R);
  const u16* Kk = (const u16*)(p.ws + S_K);
  const u16* V = (const u16*)(p.ws + S_V);
  const u16* EW = (const u16*)(p.ws + S_EW);
  const u16* Aa = (const u16*)(p.ws + S_A);
  u16* Y = (u16*)(p.ws + WS_H);
  float* RK = (float*)(p.ws + WS_RK);
  float* ring = (float*)lds;
  float* ybuf = (float*)(lds + 2 * PAIR_BUF * 4);
  for (int item = blockIdx.x; item < 256; item += gridDim.x) {
    const int chain = item >> 2, qr = item & 3, b = chain >> 4, h = chain & 15;
    const size_t rowbase = (size_t)b * 4096;
    __syncthreads();
    if (tid >= 256) {
      const int pt = tid - 256, grp = pt >> 7, pair = (pt & 127) >> 4, cq = pt & 15;
      const int ch = h * 64 + cq * 4;
      const float4 kk4 = *(const float4*)(p.rw_kk + ch), ka4 = *(const float4*)(p.rw_ka + ch), rk4 = *(const float4*)(p.rw_rk + ch);
      struct PS {
        uint2 rr[2], rk_[2], rv[2], ra_[2], re[2];
      };
      PS S0, S1;
      auto pload = [&](PS& S, int c) __attribute__((always_inline)) {
#pragma unroll
        for (int q = 0; q < 2; ++q) {
          const size_t off = (rowbase + (size_t)c * 16 + pair * 2 + q) * 1024 + ch;
          S.rr[q] = *(const uint2*)(R + off);
          S.rk_[q] = *(const uint2*)(Kk + off);
          S.rv[q] = *(const uint2*)(V + off);
          S.ra_[q] = *(const uint2*)(Aa + off);
          S.re[q] = *(const uint2*)(EW + off);
        }
      };
      auto pproc = [&](PS& S, int c) __attribute__((always_inline)) {
        const float kkw[4] = {kk4.x, kk4.y, kk4.z, kk4.w}, kaw[4] = {ka4.x, ka4.y, ka4.z, ka4.w}, rkw[4] = {rk4.x, rk4.y, rk4.z, rk4.w};
        float am[2][4], dc[2][4], bm[2][4], kp[2][4], rf[2][4], vf[2][4];
#pragma unroll
        for (int q = 0; q < 2; ++q) {
          const uint2 rr = S.rr[q], rk_ = S.rk_[q], rv = S.rv[q], ra_ = S.ra_[q], re = S.re[q];
          const float rfx[4] = {bflo(rr.x), bfhi(rr.x), bflo(rr.y), bfhi(rr.y)};
          const float kf[4] = {bflo(rk_.x), bfhi(rk_.x), bflo(rk_.y), bfhi(rk_.y)};
          const float vfx[4] = {bflo(rv.x), bfhi(rv.x), bflo(rv.y), bfhi(rv.y)};
          const float af[4] = {bflo(ra_.x), bfhi(ra_.x), bflo(ra_.y), bfhi(ra_.y)};
          const float ef[4] = {h2f((u16)(re.x & 0xffff)), h2f((u16)(re.x >> 16)), h2f((u16)(re.y & 0xffff)), h2f((u16)(re.y >> 16))};
          float kkr[4], ss = 0.f, rks = 0.f;
#pragma unroll
          for (int j = 0; j < 4; ++j) {
            kkr[j] = kf[j] * kkw[j];
            ss += kkr[j] * kkr[j];
            kp[q][j] = kf[j] * (1.f + (af[j] - 1.f) * kaw[j]);
            rks += rfx[j] * kp[q][j] * rkw[j];
            rf[q][j] = rfx[j];
            vf[q][j] = vfx[j];
          }
          ss = rowsum16(ss);
          rks = rowsum16(rks);
          const float inv = 1.f / fmaxf(sqrtf(ss), 1e-12f);
#pragma unroll
          for (int j = 0; j < 4; ++j) {
            am[q][j] = -kkr[j] * inv;
            dc[q][j] = __expf(-ef[j]);
            bm[q][j] = kkr[j] * inv * af[j];
          }
          if (cq == 0 && qr == 0) RK[(rowbase + (size_t)c * 16 + pair * 2 + q) * 16 + h] = rks;
        }
        float aw[4], w12[4], b1w[4], k1w[4], wr1[4], wr2[4];
        float cba = 0.f, cka = 0.f, br1 = 0.f, kr1 = 0.f, br12 = 0.f, kr12 = 0.f, br2 = 0.f, kr2 = 0.f;
#pragma unroll
        for (int j = 0; j < 4; ++j) {
          aw[j] = dc[0][j] * am[1][j];
          w12[j] = dc[0][j] * dc[1][j];
          b1w[j] = bm[0][j] * dc[1][j];
          k1w[j] = kp[0][j] * dc[1][j];
          wr1[j] = dc[0][j] * rf[0][j];
          wr2[j] = w12[j] * rf[1][j];
          cba += bm[0][j] * am[1][j];
          cka += kp[0][j] * am[1][j];
          br1 += bm[0][j] * rf[0][j];
          kr1 += kp[0][j] * rf[0][j];
          br12 += b1w[j] * rf[1][j];
          kr12 += k1w[j] * rf[1][j];
          br2 += bm[1][j] * rf[1][j];
          kr2 += kp[1][j] * rf[1][j];
        }
        cba = rowsum16(cba);
        cka = rowsum16(cka);
        br1 = rowsum16(br1);
        kr1 = rowsum16(kr1);
        br12 = rowsum16(br12);
        kr12 = rowsum16(kr12);
        br2 = rowsum16(br2);
        kr2 = rowsum16(kr2);
        float* slot = ring + (c & 1) * PAIR_BUF + pair * PAIR_TS;
        *(float4*)(slot + cq * 4) = make_float4(am[0][0], am[0][1], am[0][2], am[0][3]);
        *(float4*)(slot + 64 + cq * 4) = make_float4(aw[0], aw[1], aw[2], aw[3]);
        *(float4*)(slot + 128 + cq * 4) = make_float4(w12[0], w12[1], w12[2], w12[3]);
        *(float4*)(slot + 192 + cq * 4) = make_float4(b1w[0], b1w[1], b1w[2], b1w[3]);
        *(float4*)(slot + 256 + cq * 4) = make_float4(k1w[0], k1w[1], k1w[2], k1w[3]);
        *(float4*)(slot + 320 + cq * 4) = make_float4(bm[1][0], bm[1][1], bm[1][2], bm[1][3]);
        *(float4*)(slot + 384 + cq * 4) = make_float4(kp[1][0], kp[1][1], kp[1][2], kp[1][3]);
        *(float4*)(slot + 448 + cq * 4) = make_float4(wr1[0], wr1[1], wr1[2], wr1[3]);
        *(float4*)(slot + 512 + cq * 4) = make_float4(wr2[0], wr2[1], wr2[2], wr2[3]);
        if ((cq >> 2) == qr) {
          *(float4*)(slot + 576 + (cq & 3) * 4) = make_float4(vf[0][0], vf[0][1], vf[0][2], vf[0][3]);
          *(float4*)(slot + 592 + (cq & 3) * 4) = make_float4(vf[1][0], vf[1][1], vf[1][2], vf[1][3]);
        }
        if (cq == 0) {
          *(float4*)(slot + 608) = make_float4(cba, cka, br1, kr1);
          *(float4*)(slot + 612) = make_float4(br12, kr12, br2, kr2);
        }
      };
      if (grp == 0) {
        pload(S0, 0);
        pproc(S0, 0);
        pload(S1, 2);
        pload(S0, 4);
      } else {
        pload(S0, 1);
        pload(S1, 3);
      }
      BAR_SYNC();
#pragma unroll 1
      for (int c = 0; c < 256; c += 4) {
        if (grp == 1) {
          pproc(S0, c + 1);
          if (c + 5 < 256) pload(S0, c + 5);
        }
        BAR_SYNC();
        if (grp == 0) {
          pproc(S1, c + 2);
          if (c + 6 < 256) pload(S1, c + 6);
        }
        BAR_SYNC();
        if (grp == 1) {
          pproc(S1, c + 3);
          if (c + 7 < 256) pload(S1, c + 7);
        }
        BAR_SYNC();
        if (grp == 0) {
          if (c + 4 < 256) pproc(S0, c + 4);
          if (c + 8 < 256) pload(S0, c + 8);
        }
        BAR_SYNC();
      }
    } else {
      const int rl = tid >> 4, cgp = tid & 15;
      float s0 = 0.f, s1 = 0.f, s2 = 0.f, s3 = 0.f;
      BAR_SYNC();
      for (int c = 0; c < 256; ++c) {
        if (c > 0) {
          const float4* yp = (const float4*)(ybuf + ((c - 1) & 1) * 4096 + tid * 16);
          const float4 y0 = yp[0], y1 = yp[1], y2 = yp[2], y3 = yp[3];
          const float yv = ((y0.x + y0.y) + (y0.z + y0.w)) + ((y1.x + y1.y) + (y1.z + y1.w)) + ((y2.x + y2.y) + (y2.z + y2.w)) + ((y3.x + y3.y) + (y3.z + y3.w));
          Y[(rowbase + (size_t)(c - 1) * 16 + rl) * LDH + h * 64 + qr * 16 + cgp] = f2bf(yv);
        }
        const float* bufp = ring + (c & 1) * PAIR_BUF;
        float* yb = ybuf + (c & 1) * 4096;
        struct PV {
          float4 a1, aw, w12, b1w, k1w, b2, k2, wr1, wr2, sc0, sc1;
          float v1, v2;
        };
        auto ldpair = [&](const float* slot) __attribute__((always_inline)) {
          PV r;
          r.a1 = *(const float4*)(slot + cgp * 4);
          r.aw = *(const float4*)(slot + 64 + cgp * 4);
          r.w12 = *(const float4*)(slot + 128 + cgp * 4);
          r.b1w = *(const float4*)(slot + 192 + cgp * 4);
          r.k1w = *(const float4*)(slot + 256 + cgp * 4);
          r.b2 = *(const float4*)(slot + 320 + cgp * 4);
          r.k2 = *(const float4*)(slot + 384 + cgp * 4);
          r.wr1 = *(const float4*)(slot + 448 + cgp * 4);
          r.wr2 = *(const float4*)(slot + 512 + cgp * 4);
          r.v1 = slot[576 + rl];
          r.v2 = slot[592 + rl];
          r.sc0 = *(const float4*)(slot + 608);
          r.sc1 = *(const float4*)(slot + 612);
          return r;
        };
        PV cur = ldpair(bufp);
#pragma unroll
        for (int pr = 0; pr < 8; ++pr) {
          PV nxt = cur;
          if (pr + 1 < 8) nxt = ldpair(bufp + (pr + 1) * PAIR_TS);
          float d1 = s0 * cur.a1.x + s1 * cur.a1.y + s2 * cur.a1.z + s3 * cur.a1.w;
          float d2 = s0 * cur.aw.x + s1 * cur.aw.y + s2 * cur.aw.z + s3 * cur.aw.w;
          const float e1 = s0 * cur.wr1.x + s1 * cur.wr1.y + s2 * cur.wr1.z + s3 * cur.wr1.w;
          const float e2 = s0 * cur.wr2.x + s1 * cur.wr2.y + s2 * cur.wr2.z + s3 * cur.wr2.w;
          const float t0 = s0 * cur.w12.x + cur.v1 * cur.k1w.x + cur.v2 * cur.k2.x;
          const float t1 = s1 * cur.w12.y + cur.v1 * cur.k1w.y + cur.v2 * cur.k2.y;
          const float t2 = s2 * cur.w12.z + cur.v1 * cur.k1w.z + cur.v2 * cur.k2.z;
          const float t3 = s3 * cur.w12.w + cur.v1 * cur.k1w.w + cur.v2 * cur.k2.w;
          d1 = rowsum16(d1);
          d2 = rowsum16(d2);
          const float sa1 = d1;
          const float sa2 = d2 + sa1 * cur.sc0.x + cur.v1 * cur.sc0.y;
          s0 = t0 + sa1 * cur.b1w.x + sa2 * cur.b2.x;
          s1 = t1 + sa1 * cur.b1w.y + sa2 * cur.b2.y;
          s2 = t2 + sa1 * cur.b1w.z + sa2 * cur.b2.z;
          s3 = t3 + sa1 * cur.b1w.w + sa2 * cur.b2.w;
          yb[(2 * pr) * 256 + tid] = e1 + 0.0625f * (sa1 * cur.sc0.z + cur.v1 * cur.sc0.w);
          yb[(2 * pr + 1) * 256 + tid] = e2 + 0.0625f * (sa1 * cur.sc1.x + cur.v1 * cur.sc1.y + sa2 * cur.sc1.z + cur.v2 * cur.sc1.w);
          cur = nxt;
        }
        BAR_SYNC();
      }
      {
        const float4* yp = (const float4*)(ybuf + (255 & 1) * 4096 + tid * 16);
        const float4 y0 = yp[0], y1 = yp[1], y2 = yp[2], y3 = yp[3];
        const float yv = ((y0.x + y0.y) + (y0.z + y0.w)) + ((y1.x + y1.y) + (y1.z + y1.w)) + ((y2.x + y2.y) + (y2.z + y2.w)) + ((y3.x + y3.y) + (y3.z + y3.w));
        Y[(rowbase + (size_t)255 * 16 + rl) * LDH + h * 64 + qr * 16 + cgp] = f2bf(yv);
      }
      float* wo = p.out + O_WKVP + (((size_t)(b * 16 + h) * 64) + qr * 16 + rl) * 64 + cgp * 4;
      *(float4*)wo = make_float4(s0, s1, s2, s3);
    }
  }
  float* sl = (float*)lds;
  for (int chain = blockIdx.x; chain < 2048; chain += gridDim.x) {
    const int b = chain >> 4, h = chain & 15;
    const size_t row = (size_t)NP + b;
    __syncthreads();
    if (w == 0) {
      const int ch = h * 64 + lane;
      const size_t off = row * 1024 + ch;
      const float rf = bf2f(R[off]), kf = bf2f(Kk[off]), vf = bf2f(V[off]), af = bf2f(Aa[off]), ef = h2f(EW[off]);
      const float kkr = kf * p.rw_kk[ch];
      const float ss = wavesum(kkr * kkr);
      const float inv = 1.f / fmaxf(sqrtf(ss), 1e-12f);
      const float kp = kf * (1.f + (af - 1.f) * p.rw_ka[ch]);
      const float rks = wavesum(rf * kp * p.rw_rk[ch]);
      sl[lane] = -kkr * inv;
      sl[64 + lane] = __expf(-ef);
      sl[128 + lane] = kkr * inv * af;
      sl[192 + lane] = kp;
      sl[256 + lane] = rf;
      sl[320 + lane] = vf;
      if (lane == 0) RK[row * 16 + h] = rks;
    }
    __syncthreads();
    const int i = tid >> 3, c8 = tid & 7;
    const float* sp = p.state_wkv + (((size_t)(b * 16 + h) * 64) + i) * 64 + c8 * 8;
    float4 sA = *(const float4*)sp, sB = *(const float4*)(sp + 4);
    float s[8] = {sA.x, sA.y, sA.z, sA.w, sB.x, sB.y, sB.z, sB.w};
    float sa = 0.f;
#pragma unroll
    for (int j = 0; j < 8; ++j) sa += s[j] * sl[c8 * 8 + j];
    sa += __shfl_xor(sa, 1);
    sa += __shfl_xor(sa, 2);
    sa += __shfl_xor(sa, 4);
    const float vv = sl[320 + i];
    float y = 0.f;
#pragma unroll
    for (int j = 0; j < 8; ++j) {
      const int cj = c8 * 8 + j;
      s[j] = s[j] * sl[64 + cj] + sa * sl[128 + cj] + vv * sl[192 + cj];
      y += s[j] * sl[256 + cj];
    }
    y += __shfl_xor(y, 1);
    y += __shfl_xor(y, 2);
    y += __shfl_xor(y, 4);
    float* wo = p.out + O_WKVS + (((size_t)(b * 16 + h) * 64) + i) * 64 + c8 * 8;
    *(float4*)wo = make_float4(s[0], s[1], s[2], s[3]);
    *(float4*)(wo + 4) = make_float4(s[4], s[5], s[6], s[7]);
    if (c8 == 0) Y[row * LDH + h * 64 + i] = f2bf(y);
  }
}

__device__ __forceinline__ void phase_gate(const Params& p, char* lds) {
  const u16* wt = (const u16*)(p.ws + WS_WT);
  const u16* GH = (const u16*)(p.ws + S_GH);
  const u16* V = (const u16*)(p.ws + S_V);
  const float* RK = (const float*)(p.ws + WS_RK);
  u16* Y = (u16*)(p.ws + WS_H);
  for (int t = blockIdx.x; t < 65 * 4; t += gridDim.x) {
    const int mt = t >> 2, nt = t & 3;
    const int m0 = mt * 256, n0 = nt * 256;
    gemm_tile256(GH, 128, wt + WT_G2, 128, 128, m0, n0, lds, mt == 64, [&](EPI_ARGS) {
      const int hh = (n0 + wn * 64) >> 6;
#pragma unroll
      for (int mi = 0; mi < 8; ++mi) {
        const int row = m0 + wm * 128 + mi * 16 + lr;
        const int rowc = row < MROWS ? row : MROWS - 1;
        float yv[4][4];
        float sum = 0.f;
#pragma unroll
        for (int ni = 0; ni < 4; ++ni) {
          const uint2 yy = *(const uint2*)(Y + (size_t)rowc * LDH + hh * 64 + ni * 16 + lg * 4);
          yv[ni][0] = bflo(yy.x); yv[ni][1] = bfhi(yy.x); yv[ni][2] = bflo(yy.y); yv[ni][3] = bfhi(yy.y);
          sum += yv[ni][0] + yv[ni][1] + yv[ni][2] + yv[ni][3];
        }
        sum += __shfl_xor(sum, 16);
        sum += __shfl_xor(sum, 32);
        const float mu = sum * (1.f / 64.f);
        float vs = 0.f;
#pragma unroll
        for (int ni = 0; ni < 4; ++ni)
#pragma unroll
          for (int q = 0; q < 4; ++q) {
            const float d = yv[ni][q] - mu;
            vs += d * d;
          }
        vs += __shfl_xor(vs, 16);
        vs += __shfl_xor(vs, 32);
        const float rstd = rsqrtf(vs * (1.f / 64.f) + 64e-5f);
        const float rk = RK[(size_t)rowc * 16 + hh];
#pragma unroll
        for (int ni = 0; ni < 4; ++ni) {
          const int col0 = hh * 64 + ni * 16 + lg * 4;
          const uint2 vv = *(const uint2*)(V + (size_t)rowc * 1024 + col0);
          const float vf[4] = {bflo(vv.x), bfhi(vv.x), bflo(vv.y), bfhi(vv.y)};
          const float4 g4 = *(const float4*)(p.rw_lnx_g + col0), b4 = *(const float4*)(p.rw_lnx_b + col0);
          const float gg[4] = {g4.x, g4.y, g4.z, g4.w}, bb[4] = {b4.x, b4.y, b4.z, b4.w};
          f32x4 o;
#pragma unroll
          for (int q = 0; q < 4; ++q) o[q] = ((yv[ni][q] - mu) * rstd * gg[q] + bb[q] + rk * vf[q]) * acc[mi][ni][q];
          if (row < MROWS) *(uint2*)(Y + (size_t)row * LDH + col0) = pack4(o);
        }
        __builtin_amdgcn_sched_barrier(0);
      }
    });
  }
}

__device__ __forceinline__ void phase_oproj(const Params& p, char* lds, const u16* A, int K, const u16* Bt, int layer, int gidx, bool first) {
  const int ldab = K == 1024 ? LDH : LDU;
  const float* mod = (const float*)(p.ws + WS_MOD);
  for (int u = blockIdx.x; u < 320; u += gridDim.x) {
    const bool split = u >= 256;
    const int s = u - 256;
    const int m0 = split ? NP : (u >> 2) * 256, n0 = (split ? (s & 3) : (u & 3)) * 256;
    const int klen = split ? (K >> 4) : K, kbeg = split ? (s >> 2) * klen : 0;
    gemm_tile256(A + kbeg, ldab, Bt + kbeg, ldab, klen, m0, n0, lds, split, [&](EPI_ARGS) {
      EPI_FOREACH(acc, if (row < MROWS) {
        const float4 gt = *(const float4*)(mod + ((size_t)layer * 132 + bidx_of(row)) * 6144 + gidx * 1024 + col0);
        float* xp = p.out + (size_t)row * 1024 + col0;
        if (split) {
          unsafeAtomicAdd(xp + 0, gt.x * v[0]);
          unsafeAtomicAdd(xp + 1, gt.y * v[1]);
          unsafeAtomicAdd(xp + 2, gt.z * v[2]);
          unsafeAtomicAdd(xp + 3, gt.w * v[3]);
        } else {
          const float* xi = first ? p.x_prompt + (size_t)row * 1024 + col0 : xp;
          const float4 xo = *(const float4*)xi;
          *(float4*)xp = make_float4(xo.x + gt.x * v[0], xo.y + gt.y * v[1], xo.z + gt.z * v[2], xo.w + gt.w * v[3]);
        }
      })
    });
  }
}

__device__ __forceinline__ void phase_up(const Params& p, char* lds, const u16* Bt) {
  const u16* H = (const u16*)(p.ws + WS_H);
  u16* UP = (u16*)(p.ws + S_UP);
  for (int t = blockIdx.x; t < 65 * 16; t += gridDim.x) {
    const int mt = t >> 4, nt = t & 15;
    const int m0 = mt * 256, n0 = nt * 256;
    gemm_tile256(H, LDH, Bt, LDH, 1024, m0, n0, lds, mt == 64, [&](EPI_ARGS) {
      EPI_FOREACH(acc, if (row < MROWS) {
        f32x4 o;
        _Pragma("unroll") for (int q = 0; q < 4; ++q) {
          const float rl = fmaxf(v[q], 0.f);
          o[q] = rl * rl;
        }
        *(uint2*)(UP + (size_t)row * LDU + col0) = pack4(o);
      })
    });
  }
}

__device__ __forceinline__ void phase_qkv(const Params& p, char* lds) {
  const u16* H = (const u16*)(p.ws + WS_H);
  const u16* wt = (const u16*)(p.ws + WS_WT);
  const float* tab = (const float*)(p.ws + WS_TAB);
  u16* Qb = (u16*)(p.ws + S_Q);
  u16* Kb = (u16*)(p.ws + S_KB);
  u16* Vt = (u16*)(p.ws + S_VT);
  for (int t = blockIdx.x; t < 65 * 6; t += gridDim.x) {
    const int mt = t / 6, nt = t % 6;
    const int m0 = mt * 256, n0 = nt * 256;
    gemm_tile256(H, LDH, wt + WT_QKV, LDH, 1024, m0, n0, lds, mt == 64, [&](EPI_ARGS) {
      const int hc0 = n0 + wn * 64;
#pragma unroll
      for (int mi = 0; mi < 8; ++mi) {
        const int row = m0 + wm * 128 + mi * 16 + lr;
        const bool valid = row < MROWS;
        const bool isp = row < NP;
        const int pos = row & 4095;
        const int bq = isp ? (row >> 12) : (row - NP);
        const int posidx = isp ? pos : 4096;
#pragma unroll
        for (int ni = 0; ni < 4; ++ni) {
          const int col0 = hc0 + ni * 16 + lg * 4;
          const float4 b4 = *(const float4*)(p.at_bqkv + col0);
          f32x4 v = acc[mi][ni];
          v[0] += b4.x; v[1] += b4.y; v[2] += b4.z; v[3] += b4.w;
          if (ni == 0 && hc0 < 1280) {
            const float* tp = tab + (size_t)posidx * 16 + (lg & 1) * 8;
            const float4 t0 = *(const float4*)tp, t1 = *(const float4*)(tp + 4);
            const float cs[4] = {t0.x, t0.z, t1.x, t1.z}, sn[4] = {t0.y, t0.w, t1.y, t1.w};
#pragma unroll
            for (int q = 0; q < 4; ++q) {
              const float pv = __shfl_xor(v[q], 32);
              v[q] = (lg < 2) ? (v[q] * cs[q] - pv * sn[q]) : (v[q] * cs[q] + pv * sn[q]);
            }
          }
          if (valid) {
            if (hc0 < 1024) {
              *(uint2*)(Qb + (size_t)row * 1024 + col0) = pack4(v);
            } else if (hc0 < 1280) {
              const int c2 = col0 - 1024;
              *(uint2*)(Kb + (size_t)row * 256 + c2) = pack4(v);
              if (isp) {
                if (pos >= 3968) *(float4*)(p.out + O_KP + ((size_t)(bq * 128 + pos - 3968)) * 256 + c2) = make_float4(v[0], v[1], v[2], v[3]);
              } else {
                *(float4*)(p.out + O_KS + ((size_t)(bq * 128 + 127)) * 256 + c2) = make_float4(v[0], v[1], v[2], v[3]);
              }
            } else {
              const int c3 = col0 - 1280;
              if (isp) {
                u16* vp = Vt + ((size_t)(bq * 4 + (c3 >> 6)) * 64 + (c3 & 63)) * 4096 + pos;
#pragma unroll
                for (int q = 0; q < 4; ++q) vp[(size_t)q * 4096] = f2bf(v[q]);
                if (pos >= 3968) *(float4*)(p.out + O_VP + ((size_t)(bq * 128 + pos - 3968)) * 256 + c3) = make_float4(v[0], v[1], v[2], v[3]);
              } else {
                *(float4*)(p.out + O_VS + ((size_t)(bq * 128 + 127)) * 256 + c3) = make_float4(v[0], v[1], v[2], v[3]);
              }
            }
          }
        }
        __builtin_amdgcn_sched_barrier(0);
      }
    });
  }
}

constexpr int AT_KS = 0, AT_VS = 36864, AT_PS = 36864 + 35840, AT_PW = 5376;

__device__ __forceinline__ void phase_attn(const Params& p, char* lds) {
  const int tid = threadIdx.x, lane = tid & 63, w = tid >> 6, lr = lane & 15, lg = lane >> 4;
  const u16* Qb = (const u16*)(p.ws + S_Q);
  const u16* Kb = (const u16*)(p.ws + S_KB);
  const u16* Vt = (const u16*)(p.ws + S_VT);
  u16* O = (u16*)(p.ws + S_O);
  char* Ks = lds + AT_KS;
  char* Vs = lds + AT_VS;
  char* Ps = lds + AT_PS + w * AT_PW;
  for (int u = blockIdx.x; u < 512; u += gridDim.x) {
    const int b = u >> 7, n = (u >> 2) & 31, kvh = u & 3;
    bf16x8 qfa[4][2];
    {
      const int g_ = w >> 1, hf_ = w & 1, qh_ = kvh * 4 + g_;
#pragma unroll
      for (int i = 0; i < 4; ++i) {
        const size_t tok = (size_t)b * 4096 + n * 128 + hf_ * 64 + i * 16 + lr;
        qfa[i][0] = *(const bf16x8*)(Qb + tok * 1024 + qh_ * 64 + lg * 8);
        qfa[i][1] = *(const bf16x8*)(Qb + tok * 1024 + qh_ * 64 + 32 + lg * 8);
      }
    }
    __syncthreads();
#pragma unroll
    for (int i = 0; i < 4; ++i) {
      const int c = tid + 512 * i;
      {
        const int key = c >> 3, kc = c & 7;
        const int pos = n * 128 - 128 + key;
        uint4 v = {0u, 0u, 0u, 0u};
        if (pos >= 0) v = *(const uint4*)(Kb + ((size_t)b * 4096 + pos) * 256 + kvh * 64 + kc * 8);
        *(uint4*)(Ks + key * 144 + kc * 16) = v;
      }
      {
        const int d = c >> 5, kc = c & 31;
        const int pos0 = n * 128 - 128 + kc * 8;
        uint4 v = {0u, 0u, 0u, 0u};
        if (pos0 >= 0) v = *(const uint4*)(Vt + ((size_t)(b * 4 + kvh) * 64 + d) * 4096 + pos0);
        *(uint4*)(Vs + d * 560 + kc * 16) = v;
      }
    }
    if (tid < 192) {
      const int d = tid / 3, c = tid % 3;
      *(uint4*)(Vs + d * 560 + 512 + c * 16) = uint4{0u, 0u, 0u, 0u};
    }
    {
      const int prow = lane >> 2, pc = 144 + (lane & 3) * 4;
      *(uint2*)(Ps + prow * 336 + pc * 2) = uint2{0u, 0u};
    }
    __syncthreads();
    const int g = w >> 1, hf = w & 1;
    const int qh = kvh * 4 + g;
    const float sink = p.at_sink[qh];
#pragma unroll
    for (int i = 0; i < 4; ++i) {
      const int q0 = hf * 64 + i * 16;
      const bf16x8 qf0 = qfa[i][0];
      const bf16x8 qf1 = qfa[i][1];
      f32x4 s[9];
#pragma unroll
      for (int j = 0; j < 9; ++j) {
        const char* kp = Ks + (q0 + j * 16 + lr) * 144 + lg * 16;
        const bf16x8 k0 = *(const bf16x8*)kp;
        const bf16x8 k1 = *(const bf16x8*)(kp + 64);
        f32x4 z = {0.f, 0.f, 0.f, 0.f};
        z = __builtin_amdgcn_mfma_f32_16x16x32_bf16(qf0, k0, z, 0, 0, 0);
        z = __builtin_amdgcn_mfma_f32_16x16x32_bf16(qf1, k1, z, 0, 0, 0);
        s[j] = z;
      }
      float mx[4], sum[4];
#pragma unroll
      for (int r = 0; r < 4; ++r) {
        const int ql = lg * 4 + r;
        float m = sink;
#pragma unroll
        for (int j = 0; j < 9; ++j) {
          float v = s[j][r] * 0.125f;
          bool ok = true;
          if (j == 0) ok = (lr >= ql);
          if (j == 8) ok = (lr <= ql);
          if (n == 0 && (q0 + j * 16 + lr) < 128) ok = false;
          v = ok ? v : -INFINITY;
          s[j][r] = v;
          m = fmaxf(m, v);
        }
        mx[r] = rowmax16(m);
      }
#pragma unroll
      for (int r = 0; r < 4; ++r) {
        float sm = 0.f;
#pragma unroll
        for (int j = 0; j < 9; ++j) {
          const float e = __expf(s[j][r] - mx[r]);
          s[j][r] = e;
          sm += e;
        }
        sm = rowsum16(sm);
        sum[r] = sm + __expf(sink - mx[r]);
      }
      u16* P = (u16*)Ps;
#pragma unroll
      for (int j = 0; j < 9; ++j)
#pragma unroll
        for (int r = 0; r < 4; ++r) P[(lg * 4 + r) * 168 + j * 16 + lr] = f2bf(s[j][r]);
      __builtin_amdgcn_wave_barrier();
      f32x4 o[4];
#pragma unroll
      for (int nd = 0; nd < 4; ++nd) o[nd] = f32x4{0.f, 0.f, 0.f, 0.f};
#pragma unroll
      for (int kk = 0; kk < 5; ++kk) {
        const bf16x8 pf = *(const bf16x8*)(Ps + lr * 336 + kk * 64 + lg * 16);
#pragma unroll
        for (int nd = 0; nd < 4; ++nd) {
          const bf16x8 vf = *(const bf16x8*)(Vs + (nd * 16 + lr) * 560 + (q0 + kk * 32 + lg * 8) * 2);
          o[nd] = __builtin_amdgcn_mfma_f32_16x16x32_bf16(pf, vf, o[nd], 0, 0, 0);
        }
      }
#pragma unroll
      for (int nd = 0; nd < 4; ++nd)
#pragma unroll
        for (int r = 0; r < 4; ++r) {
          const float v = o[nd][r] / sum[r];
          O[((size_t)b * 4096 + n * 128 + q0 + lg * 4 + r) * LDH + qh * 64 + nd * 16 + lr] = f2bf(v);
        }
      __builtin_amdgcn_wave_barrier();
    }
  }
  float* qs = (float*)lds;
  float* sc = (float*)(lds + 1024);
  float* part = (float*)(lds + 1024 + 2112);
  for (int it = blockIdx.x; it < 512; it += gridDim.x) {
    const int b = it >> 2, kvh = it & 3;
    const size_t row = (size_t)NP + b;
    __syncthreads();
    if (tid < 256) qs[tid] = bf2f(Qb[row * 1024 + kvh * 256 + tid]);
    __syncthreads();
    {
      const int key = tid >> 2, g = tid & 3;
      const float* kp = p.cache_k + (((size_t)b * 128 + key) * 4 + kvh) * 64;
      float dot = 0.f;
#pragma unroll
      for (int d4 = 0; d4 < 16; ++d4) {
        const float4 kv = *(const float4*)(kp + d4 * 4);
        const float* q = qs + g * 64 + d4 * 4;
        dot += kv.x * q[0] + kv.y * q[1] + kv.z * q[2] + kv.w * q[3];
      }
      sc[g * 132 + key] = dot * 0.125f;
      if (key >= 1) {
        float* dst = p.out + O_KS + (((size_t)b * 128 + key - 1) * 4 + kvh) * 64 + g * 16;
        const float* src = kp + g * 16;
#pragma unroll
        for (int d4 = 0; d4 < 4; ++d4) *(float4*)(dst + d4 * 4) = *(const float4*)(src + d4 * 4);
      }
      if (tid < 4) {
        const float* kn = p.out + O_KS + (((size_t)b * 128 + 127) * 4 + kvh) * 64;
        float d2 = 0.f;
        for (int d = 0; d < 64; ++d) d2 += kn[d] * qs[tid * 64 + d];
        sc[tid * 132 + 128] = d2 * 0.125f;
      }
    }
    __syncthreads();
    if (w < 4) {
      const float sink = p.at_sink[kvh * 4 + w];
      float* s = sc + w * 132;
      const float v0 = s[lane], v1 = s[64 + lane], v2 = lane == 0 ? s[128] : -INFINITY;
      float m = fmaxf(fmaxf(v0, v1), fmaxf(v2, sink));
      m = wavemax(m);
      const float e0 = __expf(v0 - m), e1 = __expf(v1 - m), e2 = lane == 0 ? __expf(v2 - m) : 0.f;
      float sm = wavesum(e0 + e1 + e2) + __expf(sink - m);
      const float inv = 1.f / sm;
      s[lane] = e0 * inv;
      s[64 + lane] = e1 * inv;
      if (lane == 0) s[128] = e2 * inv;
    }
    __syncthreads();
    {
      const int d = tid & 63, g = (tid >> 6) & 3, half = tid >> 8;
      const float* vp = p.cache_v + (((size_t)b * 128) * 4 + kvh) * 64 + d;
      float accv = 0.f;
      for (int key = half * 64; key < half * 64 + 64; ++key) {
        const float vv = vp[(size_t)key * 256];
        accv += sc[g * 132 + key] * vv;
        if (g == 0 && key >= 1) p.out[O_VS + (((size_t)b * 128 + key - 1) * 4 + kvh) * 64 + d] = vv;
      }
      if (half == 1) accv += sc[g * 132 + 128] * p.out[O_VS + (((size_t)b * 128 + 127) * 4 + kvh) * 64 + d];
      part[(half * 4 + g) * 64 + d] = accv;
    }
    __syncthreads();
    if (tid < 256) {
      const int d = tid & 63, g = tid >> 6;
      O[row * LDH + (kvh * 4 + g) * 64 + d] = f2bf(part[g * 64 + d] + part[(4 + g) * 64 + d]);
    }
  }
}

__global__ void __launch_bounds__(NTHR) mega(Params p) {
  extern __shared__ __attribute__((aligned(16))) char lds[];
  cg::grid_group grid = cg::this_grid();
  volatile LAS unsigned* xst = (volatile LAS unsigned*)(lds + LDS_BYTES);
  if (threadIdx.x == 0) { xst[0] = 0u; xst[1] = 0u; }
  __syncthreads();
  const XcdBarrier xb = xcd_barrier_post((unsigned*)(p.ws + WS_BAR), xst);
  const u16* wt = (const u16*)(p.ws + WS_WT);
  phase0(p, lds);
  if (p.out == nullptr) grid.sync();
  xcd_barrier(xb);
  phase_ada(p, lds);
  xcd_barrier(xb);
  phase_norm(p, 0, 0, true, true);
  xcd_barrier(xb);
  phase_rwkv_proj(p, lds);
  xcd_barrier(xb);
  phase_rwkv_lora2(p, lds);
  xcd_barrier(xb);
  phase_scan(p, lds);
  xcd_barrier(xb);
  phase_gate(p, lds);
  xcd_barrier(xb);
  phase_oproj(p, lds, (const u16*)(p.ws + WS_H), 1024, wt + WT_WO, 0, 2, true);
  xcd_barrier(xb);
  phase_norm(p, 0, 1, false, false);
  xcd_barrier(xb);
  phase_up(p, lds, wt + WT_UP0);
  xcd_barrier(xb);
  phase_oproj(p, lds, (const u16*)(p.ws + S_UP), 4096, wt + WT_DN0, 0, 5, false);
  xcd_barrier(xb);
  phase_norm(p, 1, 0, false, false);
  xcd_barrier(xb);
  phase_qkv(p, lds);
  xcd_barrier(xb);
  phase_attn(p, lds);
  xcd_barrier(xb);
  phase_oproj(p, lds, (const u16*)(p.ws + S_O), 1024, wt + WT_WO1, 1, 2, false);
  xcd_barrier(xb);
  phase_norm(p, 1, 1, false, false);
  xcd_barrier(xb);
  phase_up(p, lds, wt + WT_UP1);
  xcd_barrier(xb);
  phase_oproj(p, lds, (const u16*)(p.ws + S_UP), 4096, wt + WT_DN1, 1, 5, false);
  xcd_barrier(xb);
  phase_final(p);
}

extern "C" void kernel_launch(void* const* d_in, const int* in_sizes, int n_in, void* d_out, int out_size, void* d_ws,
                              size_t ws_size, hipStream_t stream) {
  static int grid_blocks = 0;
  if (grid_blocks == 0) {
    if (ws_size < WS_END) {
      fprintf(stderr, "kernel_launch: workspace too small: %zu < %zu\n", ws_size, (size_t)WS_END);
      grid_blocks = -1;
      return;
    }
    int dev = 0, cus = 0, per_cu = 0;
    hipGetDevice(&dev);
    hipDeviceGetAttribute(&cus, hipDeviceAttributeMultiprocessorCount, dev);
    hipFuncSetAttribute((const void*)mega, hipFuncAttributeMaxDynamicSharedMemorySize, LDS_BYTES + 16);
    hipOccupancyMaxActiveBlocksPerMultiprocessor(&per_cu, (const void*)mega, NTHR, LDS_BYTES + 16);
    if (per_cu < 1) per_cu = 1;
    grid_blocks = cus * per_cu;
  }
  if (grid_blocks < 0) return;
  Params p{};
  const float** pp = (const float**)&p;
  for (int i = 0; i < 37; ++i) pp[i] = (const float*)d_in[i];
  p.out = (float*)d_out;
  p.ws = (char*)d_ws;
  hipMemsetAsync((char*)d_ws + WS_BAR, 0, 16384, stream);
  void* args[] = {&p};
  hipError_t e = hipLaunchCooperativeKernel((const void*)mega, dim3(grid_blocks), dim3(NTHR), args, LDS_BYTES + 16, stream);
  if (e != hipSuccess) fprintf(stderr, "cooperative launch failed: %s (grid %d)\n", hipGetErrorString(e), grid_blocks);
}
```

```cpp
#include <hip/hip_runtime.h>
#include <hip/hip_cooperative_groups.h>
#include <cstdio>
namespace cg = cooperative_groups;

typedef unsigned short u16;
typedef __attribute__((ext_vector_type(8))) short bf16x8;
typedef __attribute__((ext_vector_type(4))) float f32x4;

constexpr int NP = 16384, MROWS = 16512, MPAD = 16640;
constexpr int NTHR = 512;
constexpr size_t MEG = 1048576;
constexpr int LDH = 1088, LDU = 4160;

constexpr size_t O_Y = 0, O_WKVP = 16908288, O_WKVS = 17170432, O_SHP = 25559040, O_SHS = 25563136,
                 O_KP = 25694208, O_KS = 25825280, O_VP = 30019584, O_VS = 30150656;

constexpr size_t WT_WR = 0, WT_WK = WT_WR + 1024 * LDH, WT_WV = WT_WK + 1024 * LDH, WT_WO = WT_WV + 1024 * LDH,
                 WT_W1 = WT_WO + 1024 * LDH, WT_A1 = WT_W1 + 64 * LDH, WT_G1 = WT_A1 + 64 * LDH, WT_W2 = WT_G1 + 128 * LDH,
                 WT_A2 = WT_W2 + 65536, WT_G2 = WT_A2 + 65536, WT_UP0 = WT_G2 + 131072, WT_DN0 = WT_UP0 + 4096 * LDH,
                 WT_QKV = WT_DN0 + 1024 * LDU, WT_WO1 = WT_QKV + 1536 * LDH, WT_UP1 = WT_WO1 + 1024 * LDH,
                 WT_DN1 = WT_UP1 + 4096 * LDH, WT_END = WT_DN1 + 1024 * LDU;
constexpr size_t WS_WT = 0;
constexpr size_t WS_H = WS_WT + WT_END * 2;
constexpr size_t WS_ZR = WS_H + (size_t)MPAD * LDH * 2;
constexpr size_t WS_MOD = WS_ZR + (size_t)LDH * 2;
constexpr size_t WS_TAB = WS_MOD + (size_t)2 * 132 * 6144 * 4;
constexpr size_t WS_HS = WS_H + (size_t)MROWS * LDH * 2;
constexpr size_t WS_RK = WS_TAB + (size_t)4097 * 8 * 8;
constexpr size_t WS_BAR = WS_RK + (size_t)MPAD * 16 * 4;
constexpr size_t WS_S = WS_BAR + 16384;
constexpr size_t RSZ = (size_t)MROWS * 1024 * 2;
constexpr size_t S_ADAWT = WS_S, S_SILUC = S_ADAWT + (size_t)2 * 6144 * LDH * 2;
constexpr size_t S_R = WS_S, S_K = S_R + RSZ, S_V = S_K + RSZ, S_EW = S_V + RSZ, S_A = S_EW + RSZ,
                 S_WH = S_A + RSZ, S_AH = S_WH + (size_t)MPAD * 64 * 2, S_GH = S_AH + (size_t)MPAD * 64 * 2,
                 S_RW_END = S_GH + (size_t)MPAD * 128 * 2;
constexpr size_t S_UP = WS_S;
constexpr size_t S_Q = WS_S, S_O = S_Q + (size_t)MPAD * 1024 * 2, S_KB = S_O + (size_t)MPAD * LDH * 2,
                 S_VT = S_KB + (size_t)MPAD * 256 * 2;
constexpr size_t WS_END = S_RW_END;
static_assert(S_UP + (size_t)MPAD * LDU * 2 <= WS_END, "up fits");
static_assert(S_VT + (size_t)16 * 64 * 4096 * 2 <= WS_END, "attn fits");
static_assert(WS_END <= 282000000, "ws fits sum of inputs");

constexpr int LDS_ROW = 144;
constexpr int LDS_A_BYTES = 256 * LDS_ROW;
constexpr int LDS_B_BYTES = 128 * LDS_ROW;
constexpr int LDS_STAGE = LDS_A_BYTES + LDS_B_BYTES;
constexpr int LDS_BYTES = 147456;

struct Params {
  const float *x_prompt, *x_sample, *c_prompt, *c_sample, *state_wkv, *state_shift, *cache_k, *cache_v;
  const float *norm1_g, *norm2_g, *ada_w, *ada_b, *mlp_up, *mlp_down, *final_g;
  const float *rw_mix, *rw_wr, *rw_wk, *rw_wv, *rw_wo, *rw_w0, *rw_w1, *rw_w2, *rw_a0, *rw_a1, *rw_a2, *rw_g1, *rw_g2,
      *rw_kk, *rw_ka, *rw_rk, *rw_lnx_g, *rw_lnx_b;
  const float *at_wqkv, *at_bqkv, *at_wo, *at_sink;
  float* out;
  char* ws;
};

__device__ __forceinline__ u16 f2bf(float f) {
  unsigned u = __float_as_uint(f);
  u += 0x7fffu + ((u >> 16) & 1u);
  return (u16)(u >> 16);
}
__device__ __forceinline__ float bf2f(u16 h) { return __uint_as_float(((unsigned)h) << 16); }
__device__ __forceinline__ float bflo(unsigned w) { return __uint_as_float(w << 16); }
__device__ __forceinline__ float bfhi(unsigned w) { return __uint_as_float(w & 0xffff0000u); }
__device__ __forceinline__ unsigned pack2(float a, float b) {
  unsigned r;
  asm volatile("v_cvt_pk_bf16_f32 %0, %1, %2" : "=v"(r) : "v"(a), "v"(b));
  return r;
}
__device__ __forceinline__ uint2 pack4(f32x4 v) { return uint2{pack2(v[0], v[1]), pack2(v[2], v[3])}; }
__device__ __forceinline__ float h2f(u16 h) { return (float)__builtin_bit_cast(_Float16, h); }
__device__ __forceinline__ u16 f2h(float f) { return __builtin_bit_cast(u16, (_Float16)f); }
__device__ __forceinline__ float sigmoidf_(float x) { return 1.f / (1.f + __expf(-x)); }

template <int CTRL>
__device__ __forceinline__ float dppf(float x) {
  return __int_as_float(__builtin_amdgcn_update_dpp(0, __float_as_int(x), CTRL, 0xf, 0xf, true));
}
__device__ __forceinline__ float rowsum16(float x) {
  x += dppf<0xB1>(x);
  x += dppf<0x4E>(x);
  x += dppf<0x124>(x);
  x += dppf<0x128>(x);
  return x;
}
__device__ __forceinline__ float rowmax16(float x) {
  x = fmaxf(x, dppf<0xB1>(x));
  x = fmaxf(x, dppf<0x4E>(x));
  x = fmaxf(x, dppf<0x124>(x));
  x = fmaxf(x, dppf<0x128>(x));
  return x;
}
__device__ __forceinline__ float wavesum(float x) {
#pragma unroll
  for (int o = 32; o > 0; o >>= 1) x += __shfl_xor(x, o);
  return x;
}
__device__ __forceinline__ float wavemax(float x) {
#pragma unroll
  for (int o = 32; o > 0; o >>= 1) x = fmaxf(x, __shfl_xor(x, o));
  return x;
}
__device__ __forceinline__ int bidx_of(int row) { return row < NP ? (row >> 12) : (4 + row - NP); }

#define XB_TMO      128
#define XB_XCNT(j)  (256  + 64 * (j))
#define XB_XSUB(j)  (1280 + 64 * (j))
#define XB_XGEN(j)  (2304 + 64 * (j))
#define XB_TOP      3328
#define XB_TOPGEN   3392
#define XCD_BAR_WORDS 3456
#define XB_SPIN_CAP (1u << 22)
#define LAS __attribute__((address_space(3)))
__device__ __forceinline__ unsigned xb_ld(unsigned* p) { return __hip_atomic_load(p, __ATOMIC_RELAXED, __HIP_MEMORY_SCOPE_AGENT); }
__device__ __forceinline__ unsigned xb_add(unsigned* p, unsigned v) { return __hip_atomic_fetch_add(p, v, __ATOMIC_RELAXED, __HIP_MEMORY_SCOPE_AGENT); }
__device__ __forceinline__ unsigned xb_xcc_id() { return (unsigned)__builtin_amdgcn_s_getreg((3 << 11) | 20) & 0xFu; }
#define XB_SPIN(cond, bar) do { unsigned _sp = 0; while (cond) { __builtin_amdgcn_s_sleep(1); \
    if ((++_sp & 255u) == 0u) { if (xb_ld(&(bar)[XB_TMO])) break; if (_sp > XB_SPIN_CAP) { atomicAdd(&(bar)[XB_TMO], 1u); break; } } } } while (0)
struct XcdBarrier {
  unsigned* bar;
  unsigned x;
  volatile LAS unsigned* st;
};
__device__ __forceinline__ XcdBarrier xcd_barrier_post(unsigned* bar, volatile LAS unsigned* st) {
  XcdBarrier b;
  b.bar = bar;
  b.x = xb_xcc_id();
  b.st = st;
  if (threadIdx.x == 0) (void)xb_add(&bar[XB_XCNT(b.x)], 1u);
  return b;
}
__device__ __forceinline__ void xcd_barrier_complete(unsigned* bar, unsigned x, unsigned& nloc, unsigned& nx) {
  const unsigned G = gridDim.x * gridDim.y * gridDim.z;
  unsigned sum, cnt, mine, sp = 0u;
  for (;;) {
    sum = 0u; cnt = 0u; mine = 0u;
#pragma unroll
    for (unsigned j = 0; j < 16; ++j) {
      const unsigned c = xb_ld(&bar[XB_XCNT(j)]);
      sum += c;
      cnt += (c > 0u) ? 1u : 0u;
      mine = (j == x) ? c : mine;
    }
    if (sum == G) break;
    __builtin_amdgcn_s_sleep(1);
    if ((++sp & 255u) == 0u) {
      if (xb_ld(&bar[XB_TMO])) break;
      if (sp > XB_SPIN_CAP) { atomicAdd(&bar[XB_TMO], 1u); break; }
    }
  }
  nloc = mine > 0u ? mine : 1u;
  nx = cnt > 0u ? cnt : 1u;
}
__device__ __forceinline__ void xcd_barrier(const XcdBarrier& b) {
  asm volatile("s_waitcnt vmcnt(0)" ::: "memory");
  __syncthreads();
  if (threadIdx.x == 0) {
    unsigned* bar = b.bar;
    __builtin_amdgcn_s_waitcnt(0);
    unsigned nloc = b.st[0], nx = b.st[1];
    if (nloc == 0u) { xcd_barrier_complete(bar, b.x, nloc, nx); b.st[0] = nloc; b.st[1] = nx; }
    const unsigned old = xb_add(&bar[XB_XSUB(b.x)], 1u);
    const unsigned gen = old / nloc;
    if (old + 1u == (gen + 1u) * nloc) {
      __builtin_amdgcn_fence(__ATOMIC_RELEASE, "agent");
      asm volatile("s_waitcnt vmcnt(0)" ::: "memory");
      const unsigned og = xb_add(&bar[XB_TOP], 1u);
      const unsigned tg = og / nx;
      if (og + 1u == (tg + 1u) * nx) xb_add(&bar[XB_TOPGEN], 1u);
      else XB_SPIN(xb_ld(&bar[XB_TOPGEN]) == tg, bar);
      __builtin_amdgcn_fence(__ATOMIC_ACQUIRE, "agent");
      xb_add(&bar[XB_XGEN(b.x)], 1u);
      asm volatile("s_waitcnt vmcnt(0)" ::: "memory");
    } else {
      XB_SPIN(xb_ld(&bar[XB_XGEN(b.x)]) == gen, bar);
      __builtin_amdgcn_fence(__ATOMIC_ACQUIRE, "agent");
      asm volatile("s_waitcnt vmcnt(0)" ::: "memory");
    }
  }
  __syncthreads();
}

#define BAR_SYNC() do { asm volatile("s_waitcnt lgkmcnt(0)" ::: "memory"); __builtin_amdgcn_s_barrier(); asm volatile("" ::: "memory"); } while (0)

__device__ __forceinline__ unsigned mix2(unsigned h, unsigned p, float m0, float m1) {
  float h0 = bflo(h), h1 = bfhi(h), p0 = bflo(p), p1 = bfhi(p);
  return pack2(h0 + (p0 - h0) * m0, h1 + (p1 - h1) * m1);
}

template <bool MIX, class Epi>
__device__ __forceinline__ void gemm_tile(const u16* __restrict__ A, int lda, const float* __restrict__ mixv,
                                          const u16* __restrict__ Bt, int ldb, int N, int K, int m0, int n0, char* lds, Epi&& epi) {
  const int tid = threadIdx.x, lane = tid & 63, w = tid >> 6;
  const int nk = K >> 6;
  if (w >= 4) {
    const int pt = tid - 256, kc = pt & 7, pr = pt >> 3;
    const u16* Ab = A + (size_t)m0 * lda + (size_t)pr * lda + kc * 8;
    int poff[8];
#pragma unroll
    for (int i = 0; i < 8; ++i) {
      poff[i] = 0;
      if (MIX) {
        const int row = m0 + pr + 32 * i;
        const int prow = row < NP ? ((row & 4095) ? row - 1 : MPAD) : (row < MROWS ? row + 128 : MPAD);
        poff[i] = prow * LDH + kc * 8;
      }
    }
    bool bv[4];
    const u16* bp[4];
#pragma unroll
    for (int j = 0; j < 4; ++j) {
      const int n = n0 + pr + 32 * j;
      bv[j] = n < N;
      bp[j] = Bt + (size_t)(bv[j] ? n : 0) * ldb + kc * 8;
    }
    struct RSet {
      uint4 ra[8], rp[8], rb[4];
      float4 mx0, mx1;
    };
    RSet SA, SB;
    auto gload = [&](RSet& S, int kt) {
      const int ko = kt * 64;
#pragma unroll
      for (int i = 0; i < 8; ++i) {
        S.ra[i] = *(const uint4*)(Ab + (size_t)(32 * i) * lda + ko);
        if (MIX) S.rp[i] = *(const uint4*)(A + poff[i] + ko);
      }
      if (MIX) {
        S.mx0 = *(const float4*)(mixv + ko + kc * 8);
        S.mx1 = *(const float4*)(mixv + ko + kc * 8 + 4);
      }
#pragma unroll
      for (int j = 0; j < 4; ++j) {
        uint4 z = {0u, 0u, 0u, 0u};
        if (bv[j]) z = *(const uint4*)(bp[j] + ko);
        S.rb[j] = z;
      }
    };
    auto lstore = [&](RSet& S, int s) {
      char* base = lds + s * LDS_STAGE + pr * LDS_ROW + kc * 16;
#pragma unroll
      for (int i = 0; i < 8; ++i) {
        uint4 v = S.ra[i];
        if (MIX) {
          v.x = mix2(S.ra[i].x, S.rp[i].x, S.mx0.x, S.mx0.y);
          v.y = mix2(S.ra[i].y, S.rp[i].y, S.mx0.z, S.mx0.w);
          v.z = mix2(S.ra[i].z, S.rp[i].z, S.mx1.x, S.mx1.y);
          v.w = mix2(S.ra[i].w, S.rp[i].w, S.mx1.z, S.mx1.w);
        }
        *(uint4*)(base + (32 * i) * LDS_ROW) = v;
      }
#pragma unroll
      for (int j = 0; j < 4; ++j) *(uint4*)(base + LDS_A_BYTES + (32 * j) * LDS_ROW) = S.rb[j];
    };
    if constexpr (!MIX) {
      gload(SB, 0);
      if (nk > 1) gload(SA, 1);
      lstore(SB, 0);
      if (nk > 2) gload(SB, 2);
      BAR_SYNC();
#pragma unroll 1
      for (int kt = 0; kt < nk; kt += 2) {
        if (kt + 1 < nk) {
          lstore(SA, 1);
          if (kt + 3 < nk) gload(SA, kt + 3);
        }
        BAR_SYNC();
        if (kt + 1 < nk) {
          if (kt + 2 < nk) {
            lstore(SB, 0);
            if (kt + 4 < nk) gload(SB, kt + 4);
          }
          BAR_SYNC();
        }
      }
    } else {
      gload(SA, 0);
      lstore(SA, 0);
      if (nk > 1) gload(SA, 1);
      BAR_SYNC();
#pragma unroll 1
      for (int kt = 0; kt < nk; ++kt) {
        if (kt + 1 < nk) {
          lstore(SA, (kt + 1) & 1);
          if (kt + 2 < nk) gload(SA, kt + 2);
        }
        BAR_SYNC();
      }
    }
  } else {
    const int wm = w >> 1, wn = w & 1, lr = lane & 15, lg = lane >> 4;
    f32x4 acc[8][4];
#pragma unroll
    for (int i = 0; i < 8; ++i)
#pragma unroll
      for (int j = 0; j < 4; ++j) acc[i][j] = f32x4{0.f, 0.f, 0.f, 0.f};
    BAR_SYNC();
#pragma unroll 1
    for (int kt = 0; kt < nk; ++kt) {
      const char* sa = lds + (kt & 1) * LDS_STAGE + (wm * 128 + lr) * LDS_ROW + lg * 16;
      const char* sb = lds + (kt & 1) * LDS_STAGE + LDS_A_BYTES + (wn * 64 + lr) * LDS_ROW + lg * 16;
      bf16x8 bq[2][4], aq[3];
#pragma unroll
      for (int ni = 0; ni < 4; ++ni) bq[0][ni] = *(const bf16x8*)(sb + ni * 16 * LDS_ROW);
      aq[0] = *(const bf16x8*)(sa);
      aq[1] = *(const bf16x8*)(sa + 16 * LDS_ROW);
#pragma unroll
      for (int ni = 0; ni < 4; ++ni) bq[1][ni] = *(const bf16x8*)(sb + ni * 16 * LDS_ROW + 64);
#pragma unroll
      for (int st = 0; st < 16; ++st) {
        if (st + 2 < 16) aq[(st + 2) % 3] = *(const bf16x8*)(sa + ((st + 2) & 7) * 16 * LDS_ROW + ((st + 2) >> 3) * 64);
#pragma unroll
        for (int ni = 0; ni < 4; ++ni)
          acc[st & 7][ni] = __builtin_amdgcn_mfma_f32_16x16x32_bf16(bq[st >> 3][ni], aq[st % 3], acc[st & 7][ni], 0, 0, 0);
        __builtin_amdgcn_sched_barrier(0);
      }
      BAR_SYNC();
    }
    epi(acc, wm, wn, lr, lg);
  }
}

constexpr int LDS_STAGE2 = 2 * LDS_A_BYTES;
template <class Epi>
__device__ __forceinline__ void gemm_tile256(const u16* __restrict__ A, int lda, const u16* __restrict__ Bt, int ldb, int K, int m0,
                                             int n0, char* lds, bool half, Epi&& epi) {
  int tid = threadIdx.x;
  asm volatile("" : "+v"(tid));
  const int lane = tid & 63, w = __builtin_amdgcn_readfirstlane(tid >> 6);
  const int wm = w >> 2, wn = w & 3, lr = lane & 15, lg = lane >> 4;
  const int nk = K >> 5;
  const int drow = lane >> 2, dch = (lane & 3) ^ ((lane >> 4) & 3);
  const u16* As0 = A + (size_t)(m0 + w * 16 + drow) * lda + dch * 8;
  const u16* As1 = A + (size_t)(m0 + (w + 8) * 16 + drow) * lda + dch * 8;
  const u16* Bs0 = Bt + (size_t)(n0 + w * 16 + drow) * ldb + dch * 8;
  const u16* Bs1 = Bt + (size_t)(n0 + (w + 8) * 16 + drow) * ldb + dch * 8;
  auto dma = [&](int kt, int stg) __attribute__((always_inline)) {
    char* sbase = lds + stg * 32768;
    const int ko = kt * 32;
    __builtin_amdgcn_global_load_lds((const unsigned*)(As0 + ko), (unsigned*)(sbase + w * 1024), 16, 0, 0);
    __builtin_amdgcn_global_load_lds((const unsigned*)(As1 + ko), (unsigned*)(sbase + (w + 8) * 1024), 16, 0, 0);
    __builtin_amdgcn_global_load_lds((const unsigned*)(Bs0 + ko), (unsigned*)(sbase + 16384 + w * 1024), 16, 0, 0);
    __builtin_amdgcn_global_load_lds((const unsigned*)(Bs1 + ko), (unsigned*)(sbase + 16384 + (w + 8) * 1024), 16, 0, 0);
  };
  f32x4 acc[8][4];
#pragma unroll
  for (int i = 0; i < 8; ++i)
#pragma unroll
    for (int j = 0; j < 4; ++j) acc[i][j] = f32x4{0.f, 0.f, 0.f, 0.f};
  const int swz = (lg ^ ((lr >> 2) & 3)) * 16;
  const int aoff = (wm * 128 + lr) * 64 + swz, boff = 16384 + (wn * 64 + lr) * 64 + swz;
  const bool skipm = half && wm == 1;
  dma(0, 0);
  dma(nk > 1 ? 1 : nk - 1, 1);
  dma(nk > 2 ? 2 : nk - 1, 2);
  asm volatile("s_waitcnt vmcnt(8)" ::: "memory");
  BAR_SYNC();
#pragma unroll 1
  for (int kt = 0; kt < nk; ++kt) {
    dma(kt + 3 < nk ? kt + 3 : nk - 1, (kt + 3) & 3);
    if (!skipm) {
      const char* sa = lds + (kt & 3) * 32768 + aoff;
      const char* sb = lds + (kt & 3) * 32768 + boff;
      bf16x8 bq[4], aq[3];
#pragma unroll
      for (int ni = 0; ni < 4; ++ni) bq[ni] = *(const bf16x8*)(sb + ni * 1024);
      aq[0] = *(const bf16x8*)(sa);
      aq[1] = *(const bf16x8*)(sa + 1024);
#pragma unroll
      for (int st = 0; st < 8; ++st) {
        if (st + 2 < 8) aq[(st + 2) % 3] = *(const bf16x8*)(sa + (st + 2) * 1024);
#pragma unroll
        for (int ni = 0; ni < 4; ++ni)
          acc[st][ni] = __builtin_amdgcn_mfma_f32_16x16x32_bf16(bq[ni], aq[st % 3], acc[st][ni], 0, 0, 0);
        __builtin_amdgcn_sched_barrier(0);
      }
    }
    asm volatile("s_waitcnt vmcnt(8)" ::: "memory");
    BAR_SYNC();
  }
  asm volatile("s_waitcnt vmcnt(0)" ::: "memory");
  BAR_SYNC();
  epi(acc, wm, wn, lr, lg);
}

#define EPI_FOREACH(acc, ...)                                    \
  _Pragma("unroll") for (int mi = 0; mi < 8; ++mi) {             \
    const int row = m0 + wm * 128 + mi * 16 + lr;                \
    _Pragma("unroll") for (int ni = 0; ni < 4; ++ni) {           \
      const int col0 = n0 + wn * 64 + ni * 16 + lg * 4;          \
      const f32x4 v = acc[mi][ni];                               \
      __VA_ARGS__                                                \
    }                                                            \
    __builtin_amdgcn_sched_barrier(0);                           \
  }
#define EPI_ARGS f32x4(&acc)[8][4], int wm, int wn, int lr, int lg

__device__ __forceinline__ void conv_job(const float* __restrict__ src, u16* __restrict__ dst, int K, int N, int ldk, float* tl, int rot) {
  int tid = threadIdx.x;
  asm volatile("" : "+v"(tid));
  const int tn = N >> 6, nt = (K >> 6) * tn;
  const int G = gridDim.x;
  int t = ((int)blockIdx.x + G - (rot % G)) % G;
  float v[8];
  auto ldtile = [&](int tt) {
    const int k0 = (tt / tn) << 6, n0 = (tt % tn) << 6;
#pragma unroll
    for (int i = 0; i < 8; ++i) {
      const int e = tid + 512 * i;
      v[i] = src[(size_t)(k0 + (e >> 6)) * N + n0 + (e & 63)];
    }
  };
  if (t < nt) ldtile(t);
  while (t < nt) {
    const int k0 = (t / tn) << 6, n0 = (t % tn) << 6;
#pragma unroll
    for (int i = 0; i < 8; ++i) {
      const int e = tid + 512 * i;
      tl[(e >> 6) * 65 + (e & 63)] = v[i];
    }
    const int tnx = t + G;
    if (tnx < nt) ldtile(tnx);
    __syncthreads();
    const int n = tid >> 3, kc = tid & 7;
    float f[8];
#pragma unroll
    for (int j = 0; j < 8; ++j) f[j] = tl[(kc * 8 + j) * 65 + n];
    uint4 o;
    o.x = pack2(f[0], f[1]);
    o.y = pack2(f[2], f[3]);
    o.z = pack2(f[4], f[5]);
    o.w = pack2(f[6], f[7]);
    *(uint4*)(dst + (size_t)(n0 + n) * ldk + k0 + kc * 8) = o;
    __syncthreads();
    t = tnx;
  }
}

__device__ __forceinline__ void phase0(const Params& p, char* lds) {
  float* tl = (float*)lds;
  u16* wt = (u16*)(p.ws + WS_WT);
  u16* adawt = (u16*)(p.ws + S_ADAWT);
  int rot = 0;
#define CJ(SRC, DST, K, N)            \
  conv_job(SRC, DST, K, N, ((K) == 1024 ? LDH : (K) == 4096 ? LDU : (K)), tl, rot);  \
  rot += ((K) >> 6) * ((N) >> 6);
  CJ(p.ada_w, adawt, 1024, 6144)
  CJ(p.ada_w + (size_t)1024 * 6144, adawt + (size_t)6144 * LDH, 1024, 6144)
  CJ(p.rw_wr, wt + WT_WR, 1024, 1024)
  CJ(p.rw_wk, wt + WT_WK, 1024, 1024)
  CJ(p.rw_wv, wt + WT_WV, 1024, 1024)
  CJ(p.rw_wo, wt + WT_WO, 1024, 1024)
  CJ(p.rw_w1, wt + WT_W1, 1024, 64)
  CJ(p.rw_a1, wt + WT_A1, 1024, 64)
  CJ(p.rw_g1, wt + WT_G1, 1024, 128)
  CJ(p.rw_w2, wt + WT_W2, 64, 1024)
  CJ(p.rw_a2, wt + WT_A2, 64, 1024)
  CJ(p.rw_g2, wt + WT_G2, 128, 1024)
  CJ(p.mlp_up, wt + WT_UP0, 1024, 4096)
  CJ(p.mlp_down, wt + WT_DN0, 4096, 1024)
  CJ(p.at_wqkv, wt + WT_QKV, 1024, 1536)
  CJ(p.at_wo, wt + WT_WO1, 1024, 1024)
  CJ(p.mlp_up + (size_t)4 * MEG, wt + WT_UP1, 1024, 4096)
  CJ(p.mlp_down + (size_t)4 * MEG, wt + WT_DN1, 4096, 1024)
#undef CJ
  const int gtid = blockIdx.x * NTHR + threadIdx.x, gsz = gridDim.x * NTHR;
  u16* siluc = (u16*)(p.ws + S_SILUC);
  for (int i = gtid; i < 256 * 1024; i += gsz) {
    int row = i >> 10, col = i & 1023;
    float c = 0.f;
    if (row < 4) c = p.c_prompt[row * 1024 + col];
    else if (row < 132) c = p.c_sample[(row - 4) * 1024 + col];
    siluc[i] = f2bf(c * sigmoidf_(c));
  }
  u16* hs = (u16*)(p.ws + WS_HS);
  for (int i = gtid; i < 128 * 1024; i += gsz) hs[(size_t)(i >> 10) * LDH + (i & 1023)] = f2bf(p.state_shift[i]);
  u16* zr = (u16*)(p.ws + WS_ZR);
  for (int i = gtid; i < LDH; i += gsz) zr[i] = 0;
  float2* tab = (float2*)(p.ws + WS_TAB);
  for (int i = gtid; i < 4097 * 8; i += gsz) {
    int pi = i >> 3, f = i & 7;
    float pos = pi < 4096 ? (float)pi : 8192.f;
    float inv = f == 0 ? 1.0f : f == 1 ? 0.1939227432012558f : f == 2 ? 0.03760603070259094f : f == 3 ? 0.007292664609849453f
              : f == 4 ? 0.0014142135623842478f : f == 5 ? 0.00027424818836152554f : f == 6 ? 5.318296098266728e-05f
              : 1.0313386155758053e-05f;
    float ang = pos * inv;
    double t = (double)ang * 0.15915494309189535;
    t -= rint(t);
    float fr = (float)t;
    tab[i] = make_float2(__builtin_amdgcn_cosf(fr), __builtin_amdgcn_sinf(fr));
  }
}

__device__ __forceinline__ void phase_ada(const Params& p, char* lds) {
  const u16* siluc = (const u16*)(p.ws + S_SILUC);
  const u16* adawt = (const u16*)(p.ws + S_ADAWT);
  float* mod = (float*)(p.ws + WS_MOD);
  for (int t = blockIdx.x; t < 96; t += gridDim.x) {
    const int layer = t / 48, nt = t % 48;
    const int m0 = 0, n0 = nt * 128;
    const float* bias = p.ada_b + layer * 6144;
    float* mo = mod + (size_t)layer * 132 * 6144;
    gemm_tile<false>(siluc, 1024, nullptr, adawt + (size_t)layer * 6144 * LDH, LDH, 6144, 1024, m0, n0, lds, [&](EPI_ARGS) {
      EPI_FOREACH(acc, if (row < 132) {
        const float4 b4 = *(const float4*)(bias + col0);
        *(float4*)(mo + (size_t)row * 6144 + col0) = make_float4(v[0] + b4.x, v[1] + b4.y, v[2] + b4.z, v[3] + b4.w);
      })
    });
  }
}

__device__ __forceinline__ void phase_norm(const Params& p, int layer, int which, bool from_input, bool shift_out) {
  const int lane = threadIdx.x & 63, w = threadIdx.x >> 6;
  const float* mod = (const float*)(p.ws + WS_MOD);
  u16* H = (u16*)(p.ws + WS_H);
  const float* g = (which ? p.norm2_g : p.norm1_g) + layer * 1024;
  const int nw = gridDim.x * 8;
  auto xrow = [&](int row) {
    return from_input ? (row < NP ? p.x_prompt + (size_t)row * 1024 : p.x_sample + (size_t)(row - NP) * 1024)
                      : (const float*)p.out + (size_t)row * 1024;
  };
  float4 gg[4];
#pragma unroll
  for (int i = 0; i < 4; ++i) gg[i] = *(const float4*)(g + lane * 4 + 256 * i);
  int row = blockIdx.x * 8 + w;
  float4 xn[4];
  if (row < MROWS) {
    const float* xr = xrow(row);
#pragma unroll
    for (int i = 0; i < 4; ++i) xn[i] = *(const float4*)(xr + lane * 4 + 256 * i);
  }
  while (row < MROWS) {
    float4 x[4];
#pragma unroll
    for (int i = 0; i < 4; ++i) x[i] = xn[i];
    const int nrow = row + nw;
    if (nrow < MROWS) {
      const float* xr = xrow(nrow);
#pragma unroll
      for (int i = 0; i < 4; ++i) xn[i] = *(const float4*)(xr + lane * 4 + 256 * i);
    }
    const int bi = bidx_of(row);
    const float* mb = mod + ((size_t)layer * 132 + bi) * 6144;
    const float* sh = mb + (which ? 3 : 0) * 1024;
    const float* sc = mb + (which ? 4 : 1) * 1024;
    float4 s4[4], c4[4];
#pragma unroll
    for (int i = 0; i < 4; ++i) {
      s4[i] = *(const float4*)(sh + lane * 4 + 256 * i);
      c4[i] = *(const float4*)(sc + lane * 4 + 256 * i);
    }
    float ss = 0.f;
#pragma unroll
    for (int i = 0; i < 4; ++i) ss += x[i].x * x[i].x + x[i].y * x[i].y + x[i].z * x[i].z + x[i].w * x[i].w;
    ss = wavesum(ss);
    const float rs = rsqrtf(ss * (1.f / 1024.f) + 1e-6f);
    const bool so = shift_out && (row >= NP || (row & 4095) == 4095);
    float* sop = row >= NP ? p.out + O_SHS + (size_t)(row - NP) * 1024 : p.out + O_SHP + (size_t)(row >> 12) * 1024;
#pragma unroll
    for (int i = 0; i < 4; ++i) {
      const int c = lane * 4 + 256 * i;
      float4 h;
      h.x = x[i].x * rs * gg[i].x * (1.f + c4[i].x) + s4[i].x;
      h.y = x[i].y * rs * gg[i].y * (1.f + c4[i].y) + s4[i].y;
      h.z = x[i].z * rs * gg[i].z * (1.f + c4[i].z) + s4[i].z;
      h.w = x[i].w * rs * gg[i].w * (1.f + c4[i].w) + s4[i].w;
      uint2 pk;
      pk.x = pack2(h.x, h.y);
      pk.y = pack2(h.z, h.w);
      *(uint2*)(H + (size_t)row * LDH + c) = pk;
      if (so) *(float4*)(sop + c) = h;
    }
    row = nrow;
  }
}

__device__ __forceinline__ void phase_norm_mix(const Params& p) {
  const int lane = threadIdx.x & 63, w = threadIdx.x >> 6;
  const float* mod = (const float*)(p.ws + WS_MOD);
  u16* H = (u16*)(p.ws + WS_H);
  u16* XR = (u16*)p.out;
  u16* XK = XR + (size_t)MROWS * 1024;
  u16* XV = (u16*)(p.ws + S_EW);
  const float* g = p.norm1_g;
  const int nw = gridDim.x * 8;
  f32x4 gg[4], mr[4], mk[4], mv[4];
#pragma unroll
  for (int i = 0; i < 4; ++i) {
    const int c = lane * 4 + 256 * i;
    gg[i] = *(const f32x4*)(g + c);
    mr[i] = *(const f32x4*)(p.rw_mix + c);
    mk[i] = *(const f32x4*)(p.rw_mix + 2 * 1024 + c);
    mv[i] = *(const f32x4*)(p.rw_mix + 3 * 1024 + c);
  }
  auto xrow = [&](int row) { return row < NP ? p.x_prompt + (size_t)row * 1024 : p.x_sample + (size_t)(row - NP) * 1024; };
  auto hrow = [&](const f32x4 (&x)[4], int row, f32x4 (&h)[4]) __attribute__((always_inline)) {
    float ss = 0.f;
#pragma unroll
    for (int i = 0; i < 4; ++i) ss += x[i][0] * x[i][0] + x[i][1] * x[i][1] + x[i][2] * x[i][2] + x[i][3] * x[i][3];
    ss = wavesum(ss);
    const float rs = rsqrtf(ss * (1.f / 1024.f) + 1e-6f);
    const float* mb = mod + (size_t)bidx_of(row) * 6144;
#pragma unroll
    for (int i = 0; i < 4; ++i) {
      const int c = lane * 4 + 256 * i;
      const f32x4 s4 = *(const f32x4*)(mb + c), c4 = *(const f32x4*)(mb + 1024 + c);
      h[i] = x[i] * rs * gg[i] * (1.f + c4) + s4;
    }
  };
  for (int chunk = blockIdx.x * 8 + w; chunk < MROWS / 8; chunk += nw) {
    const int r0 = chunk * 8;
    f32x4 hp[4], x[4], xn[4];
    if (r0 < NP && (r0 & 4095) != 0) {
      const float* xr = xrow(r0 - 1);
#pragma unroll
      for (int i = 0; i < 4; ++i) x[i] = *(const f32x4*)(xr + lane * 4 + 256 * i);
      hrow(x, r0 - 1, hp);
    } else {
#pragma unroll
      for (int i = 0; i < 4; ++i) hp[i] = f32x4{0.f, 0.f, 0.f, 0.f};
    }
    {
      const float* xr = xrow(r0);
#pragma unroll
      for (int i = 0; i < 4; ++i) xn[i] = *(const f32x4*)(xr + lane * 4 + 256 * i);
    }
#pragma unroll 1
    for (int rr = 0; rr < 8; ++rr) {
      const int row = r0 + rr;
#pragma unroll
      for (int i = 0; i < 4; ++i) x[i] = xn[i];
      if (rr + 1 < 8) {
        const float* xr = xrow(row + 1);
#pragma unroll
        for (int i = 0; i < 4; ++i) xn[i] = *(const f32x4*)(xr + lane * 4 + 256 * i);
      }
      if (row >= NP) {
#pragma unroll
        for (int i = 0; i < 4; ++i) hp[i] = *(const f32x4*)(p.state_shift + (size_t)(row - NP) * 1024 + lane * 4 + 256 * i);
      }
      f32x4 h[4];
      hrow(x, row, h);
      const bool so = row >= NP || (row & 4095) == 4095;
      float* sop = row >= NP ? p.out + O_SHS + (size_t)(row - NP) * 1024 : p.out + O_SHP + (size_t)(row >> 12) * 1024;
#pragma unroll
      for (int i = 0; i < 4; ++i) {
        const int c = lane * 4 + 256 * i;
        *(uint2*)(H + (size_t)row * LDH + c) = pack4(h[i]);
        if (so) *(f32x4*)(sop + c) = h[i];
        const f32x4 dd = hp[i] - h[i];
        *(uint2*)(XR + (size_t)row * 1024 + c) = pack4(h[i] + dd * mr[i]);
        *(uint2*)(XK + (size_t)row * 1024 + c) = pack4(h[i] + dd * mk[i]);
        *(uint2*)(XV + (size_t)row * 1024 + c) = pack4(h[i] + dd * mv[i]);
        hp[i] = h[i];
      }
    }
  }
}

__device__ __forceinline__ void phase_final(const Params& p) {
  const int lane = threadIdx.x & 63, w = threadIdx.x >> 6;
  const int nw = gridDim.x * 8;
  for (int row = blockIdx.x * 8 + w; row < MROWS; row += nw) {
    float* xr = p.out + (size_t)row * 1024;
    float4 x[4];
    float ss = 0.f;
#pragma unroll
    for (int i = 0; i < 4; ++i) {
      x[i] = *(const float4*)(xr + lane * 4 + 256 * i);
      ss += x[i].x * x[i].x + x[i].y * x[i].y + x[i].z * x[i].z + x[i].w * x[i].w;
    }
    ss = wavesum(ss);
    const float rs = rsqrtf(ss * (1.f / 1024.f) + 1e-6f);
#pragma unroll
    for (int i = 0; i < 4; ++i) {
      const int c = lane * 4 + 256 * i;
      float4 gg = *(const float4*)(p.final_g + c);
      float4 h;
      h.x = x[i].x * rs * gg.x;
      h.y = x[i].y * rs * gg.y;
      h.z = x[i].z * rs * gg.z;
      h.w = x[i].w * rs * gg.w;
      *(float4*)(xr + c) = h;
    }
  }
}

__device__ __forceinline__ void phase_rwkv_proj(const Params& p, char* lds) {
  const u16* H = (const u16*)(p.ws + WS_H);
  const u16* wt = (const u16*)(p.ws + WS_WT);
  const u16* XR = (const u16*)p.out;
  const u16* XK = XR + (size_t)MROWS * 1024;
  const u16* XV = (const u16*)(p.ws + S_EW);
  u16* R = (u16*)(p.ws + S_R);
  u16* Kk = (u16*)(p.ws + S_K);
  u16* V = (u16*)(p.ws + S_V);
  u16* WH = (u16*)(p.ws + S_WH);
  u16* AH = (u16*)(p.ws + S_AH);
  u16* GH = (u16*)(p.ws + S_GH);
  for (int u = blockIdx.x; u < 780 + 195; u += gridDim.x) {
    if (u < 780) {
      const int kind = u / 260, t = u - kind * 260;
      const int mt = t >> 2, nt = t & 3;
      const int m0 = mt * 256, n0 = nt * 256;
      const u16* A = kind == 2 ? XV : XR + (size_t)kind * ((size_t)MROWS * 1024);
      const u16* Bt = wt + WT_WR + (size_t)kind * (1024 * LDH);
      u16* dst = R + (size_t)kind * (RSZ / 2);
      gemm_tile256(A, 1024, Bt, LDH, 1024, m0, n0, lds, mt == 64, [&](EPI_ARGS) {
        EPI_FOREACH(acc, if (row < MROWS) *(uint2*)(dst + (size_t)row * 1024 + col0) = pack4(v);)
      });
    } else {
      const int s_ = u - 780;
      const int mt = s_ / 3, kind = 3 + (s_ - mt * 3);
      const int m0 = mt * 256, n0 = 0;
      const int N = kind == 5 ? 128 : 64, mixi = kind == 3 ? 1 : kind;
      const u16* Bt = wt + WT_W1 + (size_t)(kind - 3) * (64 * LDH);
      gemm_tile<true>(H, LDH, p.rw_mix + mixi * 1024, Bt, LDH, N, 1024, m0, n0, lds, [&](EPI_ARGS) {
        u16* dst = WH + (size_t)(kind - 3) * ((size_t)MPAD * 64);
        const int ld = kind == 5 ? 128 : 64;
        EPI_FOREACH(acc, if (row < MROWS && col0 < ld) {
          f32x4 o = v;
          if (kind == 3) {
            _Pragma("unroll") for (int q = 0; q < 4; ++q) o[q] = 1.f - 2.f / (__expf(2.f * v[q]) + 1.f);
          } else if (kind == 5) {
            _Pragma("unroll") for (int q = 0; q < 4; ++q) o[q] = sigmoidf_(v[q]);
          }
          *(uint2*)(dst + (size_t)row * ld + col0) = pack4(o);
        })
      });
    }
  }
}

__device__ __forceinline__ void phase_rwkv_lora2(const Params& p, char* lds) {
  {
    const int gtid = blockIdx.x * NTHR + threadIdx.x, gsz = gridDim.x * NTHR;
    for (int i = gtid; i < 128 * 256; i += gsz) ((float4*)(p.out + (size_t)NP * 1024))[i] = ((const float4*)p.x_sample)[i];
  }
  const u16* wt = (const u16*)(p.ws + WS_WT);
  const u16* WH = (const u16*)(p.ws + S_WH);
  const u16* AH = (const u16*)(p.ws + S_AH);
  u16* EW = (u16*)(p.ws + S_EW);
  u16* Aa = (u16*)(p.ws + S_A);
  for (int t = blockIdx.x; t < 65 * 8; t += gridDim.x) {
    const int mt = t >> 3, j = t & 7;
    const int m0 = mt * 256, n0 = (j & 3) * 256;
    const bool isw = j < 4;
    gemm_tile256(isw ? WH : AH, 64, wt + (isw ? WT_W2 : WT_A2), 64, 64, m0, n0, lds, mt == 64, [&](EPI_ARGS) {
      const float* b0 = isw ? p.rw_w0 : p.rw_a0;
      EPI_FOREACH(acc, if (row < MROWS) {
        const float4 b4 = *(const float4*)(b0 + col0);
        const float s0 = sigmoidf_(v[0] + b4.x), s1 = sigmoidf_(v[1] + b4.y), s2 = sigmoidf_(v[2] + b4.z), s3 = sigmoidf_(v[3] + b4.w);
        if (isw) {
          const float c = 0.6065306597126334f;
          uint2 o;
          o.x = (unsigned)f2h(c * s0) | ((unsigned)f2h(c * s1) << 16);
          o.y = (unsigned)f2h(c * s2) | ((unsigned)f2h(c * s3) << 16);
          *(uint2*)(EW + (size_t)row * 1024 + col0) = o;
        } else {
          uint2 o;
          o.x = pack2(s0, s1);
          o.y = pack2(s2, s3);
          *(uint2*)(Aa + (size_t)row * 1024 + col0) = o;
        }
      })
    });
  }
}

constexpr int PAIR_TS = 624;
constexpr int PAIR_BUF = 8 * PAIR_TS;

__device__ __forceinline__ void phase_scan(const Params& p, char* lds) {
  const int tid = threadIdx.x, lane = tid & 63, w = tid >> 6;
  const u16* R = (const u16*)(p.ws + S_R);
  const u16* Kk = (const u16*)(p.ws + S_K);
  const u16* V = (const u16*)(p.ws + S_V);
  const u16* EW = (const u16*)(p.ws + S_EW);
  const u16* Aa = (const u16*)(p.ws + S_A);
  u16* Y = (u16*)(p.ws + WS_H);
  float* RK = (float*)(p.ws + WS_RK);
  float* ring = (float*)lds;
  float* ybuf = (float*)(lds + 2 * PAIR_BUF * 4);
  for (int item = blockIdx.x; item < 256; item += gridDim.x) {
    const int chain = item >> 2, qr = item & 3, b = chain >> 4, h = chain & 15;
    const size_t rowbase = (size_t)b * 4096;
    __syncthreads();
    if (tid >= 256) {
      const int pt = tid - 256, grp = pt >> 7, pair = (pt & 127) >> 4, cq = pt & 15;
      const int ch = h * 64 + cq * 4;
      const float4 kk4 = *(const float4*)(p.rw_kk + ch), ka4 = *(const float4*)(p.rw_ka + ch), rk4 = *(const float4*)(p.rw_rk + ch);
      struct PS {
        uint2 rr[2], rk_[2], rv[2], ra_[2], re[2];
      };
      PS S0, S1;
      auto pload = [&](PS& S, int c) __attribute__((always_inline)) {
#pragma unroll
        for (int q = 0; q < 2; ++q) {
          const size_t off = (rowbase + (size_t)c * 16 + pair * 2 + q) * 1024 + ch;
          S.rr[q] = *(const uint2*)(R + off);
          S.rk_[q] = *(const uint2*)(Kk + off);
          S.rv[q] = *(const uint2*)(V + off);
          S.ra_[q] = *(const uint2*)(Aa + off);
          S.re[q] = *(const uint2*)(EW + off);
        }
      };
      auto pproc = [&](PS& S, int c) __attribute__((always_inline)) {
        const float kkw[4] = {kk4.x, kk4.y, kk4.z, kk4.w}, kaw[4] = {ka4.x, ka4.y, ka4.z, ka4.w}, rkw[4] = {rk4.x, rk4.y, rk4.z, rk4.w};
        float am[2][4], dc[2][4], bm[2][4], kp[2][4], rf[2][4], vf[2][4];
#pragma unroll
        for (int q = 0; q < 2; ++q) {
          const uint2 rr = S.rr[q], rk_ = S.rk_[q], rv = S.rv[q], ra_ = S.ra_[q], re = S.re[q];
          const float rfx[4] = {bflo(rr.x), bfhi(rr.x), bflo(rr.y), bfhi(rr.y)};
          const float kf[4] = {bflo(rk_.x), bfhi(rk_.x), bflo(rk_.y), bfhi(rk_.y)};
          const float vfx[4] = {bflo(rv.x), bfhi(rv.x), bflo(rv.y), bfhi(rv.y)};
          const float af[4] = {bflo(ra_.x), bfhi(ra_.x), bflo(ra_.y), bfhi(ra_.y)};
          const float ef[4] = {h2f((u16)(re.x & 0xffff)), h2f((u16)(re.x >> 16)), h2f((u16)(re.y & 0xffff)), h2f((u16)(re.y >> 16))};
          float kkr[4], ss = 0.f, rks = 0.f;
#pragma unroll
          for (int j = 0; j < 4; ++j) {
            kkr[j] = kf[j] * kkw[j];
            ss += kkr[j] * kkr[j];
            kp[q][j] = kf[j] * (1.f + (af[j] - 1.f) * kaw[j]);
            rks += rfx[j] * kp[q][j] * rkw[j];
            rf[q][j] = rfx[j];
            vf[q][j] = vfx[j];
          }
          ss = rowsum16(ss);
          rks = rowsum16(rks);
          const float inv = 1.f / fmaxf(sqrtf(ss), 1e-12f);
#pragma unroll
          for (int j = 0; j < 4; ++j) {
            am[q][j] = -kkr[j] * inv;
            dc[q][j] = __expf(-ef[j]);
            bm[q][j] = kkr[j] * inv * af[j];
          }
          if (cq == 0 && qr == 0) RK[(rowbase + (size_t)c * 16 + pair * 2 + q) * 16 + h] = rks;
        }
        float aw[4], w12[4], b1w[4], k1w[4], wr1[4], wr2[4];
        float cba = 0.f, cka = 0.f, br1 = 0.f, kr1 = 0.f, br12 = 0.f, kr12 = 0.f, br2 = 0.f, kr2 = 0.f;
#pragma unroll
        for (int j = 0; j < 4; ++j) {
          aw[j] = dc[0][j] * am[1][j];
          w12[j] = dc[0][j] * dc[1][j];
          b1w[j] = bm[0][j] * dc[1][j];
          k1w[j] = kp[0][j] * dc[1][j];
          wr1[j] = dc[0][j] * rf[0][j];
          wr2[j] = w12[j] * rf[1][j];
          cba += bm[0][j] * am[1][j];
          cka += kp[0][j] * am[1][j];
          br1 += bm[0][j] * rf[0][j];
          kr1 += kp[0][j] * rf[0][j];
          br12 += b1w[j] * rf[1][j];
          kr12 += k1w[j] * rf[1][j];
          br2 += bm[1][j] * rf[1][j];
          kr2 += kp[1][j] * rf[1][j];
        }
        cba = rowsum16(cba);
        cka = rowsum16(cka);
        br1 = rowsum16(br1);
        kr1 = rowsum16(kr1);
        br12 = rowsum16(br12);
        kr12 = rowsum16(kr12);
        br2 = rowsum16(br2);
        kr2 = rowsum16(kr2);
        float* slot = ring + (c & 1) * PAIR_BUF + pair * PAIR_TS;
        *(float4*)(slot + cq * 4) = make_float4(am[0][0], am[0][1], am[0][2], am[0][3]);
        *(float4*)(slot + 64 + cq * 4) = make_float4(aw[0], aw[1], aw[2], aw[3]);
        *(float4*)(slot + 128 + cq * 4) = make_float4(w12[0], w12[1], w12[2], w12[3]);
        *(float4*)(slot + 192 + cq * 4) = make_float4(b1w[0], b1w[1], b1w[2], b1w[3]);
        *(float4*)(slot + 256 + cq * 4) = make_float4(k1w[0], k1w[1], k1w[2], k1w[3]);
        *(float4*)(slot + 320 + cq * 4) = make_float4(bm[1][0], bm[1][1], bm[1][2], bm[1][3]);
        *(float4*)(slot + 384 + cq * 4) = make_float4(kp[1][0], kp[1][1], kp[1][2], kp[1][3]);
        *(float4*)(slot + 448 + cq * 4) = make_float4(wr1[0], wr1[1], wr1[2], wr1[3]);
        *(float4*)(slot + 512 + cq * 4) = make_float4(wr2[0], wr2[1], wr2[2], wr2[3]);
        if ((cq >> 2) == qr) {
          *(float4*)(slot + 576 + (cq & 3) * 4) = make_float4(vf[0][0], vf[0][1], vf[0][2], vf[0][3]);
          *(float4*)(slot + 592 + (cq & 3) * 4) = make_float4(vf[1][0], vf[1][1], vf[1][2], vf[1][3]);
        }
        if (cq == 0) {
          *(float4*)(slot + 608) = make_float4(cba, cka, br1, kr1);
          *(float4*)(slot + 612) = make_float4(br12, kr12, br2, kr2);
        }
      };
      if (grp == 0) {
        pload(S0, 0);
        pproc(S0, 0);
        pload(S1, 2);
        pload(S0, 4);
      } else {
        pload(S0, 1);
        pload(S1, 3);
      }
      BAR_SYNC();
#pragma unroll 1
      for (int c = 0; c < 256; c += 4) {
        if (grp == 1) {
          pproc(S0, c + 1);
          if (c + 5 < 256) pload(S0, c + 5);
        }
        BAR_SYNC();
        if (grp == 0) {
          pproc(S1, c + 2);
          if (c + 6 < 256) pload(S1, c + 6);
        }
        BAR_SYNC();
        if (grp == 1) {
          pproc(S1, c + 3);
          if (c + 7 < 256) pload(S1, c + 7);
        }
        BAR_SYNC();
        if (grp == 0) {
          if (c + 4 < 256) pproc(S0, c + 4);
          if (c + 8 < 256) pload(S0, c + 8);
        }
        BAR_SYNC();
      }
    } else {
      const int rl = tid >> 4, cgp = tid & 15;
      float s0 = 0.f, s1 = 0.f, s2 = 0.f, s3 = 0.f;
      BAR_SYNC();
      for (int c = 0; c < 256; ++c) {
        if (c > 0) {
          const float4* yp = (const float4*)(ybuf + ((c - 1) & 1) * 4096 + tid * 16);
          const float4 y0 = yp[0], y1 = yp[1], y2 = yp[2], y3 = yp[3];
          const float yv = ((y0.x + y0.y) + (y0.z + y0.w)) + ((y1.x + y1.y) + (y1.z + y1.w)) + ((y2.x + y2.y) + (y2.z + y2.w)) + ((y3.x + y3.y) + (y3.z + y3.w));
          Y[(rowbase + (size_t)(c - 1) * 16 + rl) * LDH + h * 64 + qr * 16 + cgp] = f2bf(yv);
        }
        const float* bufp = ring + (c & 1) * PAIR_BUF;
        float* yb = ybuf + (c & 1) * 4096;
        struct PV {
          float4 a1, aw, w12, b1w, k1w, b2, k2, wr1, wr2, sc0, sc1;
          float v1, v2;
        };
        auto ldpair = [&](const float* slot) __attribute__((always_inline)) {
          PV r;
          r.a1 = *(const float4*)(slot + cgp * 4);
          r.aw = *(const float4*)(slot + 64 + cgp * 4);
          r.w12 = *(const float4*)(slot + 128 + cgp * 4);
          r.b1w = *(const float4*)(slot + 192 + cgp * 4);
          r.k1w = *(const float4*)(slot + 256 + cgp * 4);
          r.b2 = *(const float4*)(slot + 320 + cgp * 4);
          r.k2 = *(const float4*)(slot + 384 + cgp * 4);
          r.wr1 = *(const float4*)(slot + 448 + cgp * 4);
          r.wr2 = *(const float4*)(slot + 512 + cgp * 4);
          r.v1 = slot[576 + rl];
          r.v2 = slot[592 + rl];
          r.sc0 = *(const float4*)(slot + 608);
          r.sc1 = *(const float4*)(slot + 612);
          return r;
        };
        PV cur = ldpair(bufp);
#pragma unroll
        for (int pr = 0; pr < 8; ++pr) {
          PV nxt = cur;
          if (pr + 1 < 8) nxt = ldpair(bufp + (pr + 1) * PAIR_TS);
          float d1 = s0 * cur.a1.x + s1 * cur.a1.y + s2 * cur.a1.z + s3 * cur.a1.w;
          float d2 = s0 * cur.aw.x + s1 * cur.aw.y + s2 * cur.aw.z + s3 * cur.aw.w;
          const float e1 = s0 * cur.wr1.x + s1 * cur.wr1.y + s2 * cur.wr1.z + s3 * cur.wr1.w;
          const float e2 = s0 * cur.wr2.x + s1 * cur.wr2.y + s2 * cur.wr2.z + s3 * cur.wr2.w;
          const float t0 = s0 * cur.w12.x + cur.v1 * cur.k1w.x + cur.v2 * cur.k2.x;
          const float t1 = s1 * cur.w12.y + cur.v1 * cur.k1w.y + cur.v2 * cur.k2.y;
          const float t2 = s2 * cur.w12.z + cur.v1 * cur.k1w.z + cur.v2 * cur.k2.z;
          const float t3 = s3 * cur.w12.w + cur.v1 * cur.k1w.w + cur.v2 * cur.k2.w;
          d1 = rowsum16(d1);
          d2 = rowsum16(d2);
          const float sa1 = d1;
          const float sa2 = d2 + sa1 * cur.sc0.x + cur.v1 * cur.sc0.y;
          s0 = t0 + sa1 * cur.b1w.x + sa2 * cur.b2.x;
          s1 = t1 + sa1 * cur.b1w.y + sa2 * cur.b2.y;
          s2 = t2 + sa1 * cur.b1w.z + sa2 * cur.b2.z;
          s3 = t3 + sa1 * cur.b1w.w + sa2 * cur.b2.w;
          yb[(2 * pr) * 256 + tid] = e1 + 0.0625f * (sa1 * cur.sc0.z + cur.v1 * cur.sc0.w);
          yb[(2 * pr + 1) * 256 + tid] = e2 + 0.0625f * (sa1 * cur.sc1.x + cur.v1 * cur.sc1.y + sa2 * cur.sc1.z + cur.v2 * cur.sc1.w);
          cur = nxt;
        }
        BAR_SYNC();
      }
      {
        const float4* yp = (const float4*)(ybuf + (255 & 1) * 4096 + tid * 16);
        const float4 y0 = yp[0], y1 = yp[1], y2 = yp[2], y3 = yp[3];
        const float yv = ((y0.x + y0.y) + (y0.z + y0.w)) + ((y1.x + y1.y) + (y1.z + y1.w)) + ((y2.x + y2.y) + (y2.z + y2.w)) + ((y3.x + y3.y) + (y3.z + y3.w));
        Y[(rowbase + (size_t)255 * 16 + rl) * LDH + h * 64 + qr * 16 + cgp] = f2bf(yv);
      }
      float* wo = p.out + O_WKVP + (((size_t)(b * 16 + h) * 64) + qr * 16 + rl) * 64 + cgp * 4;
      *(float4*)wo = make_float4(s0, s1, s2, s3);
    }
  }
  float* sl = (float*)lds;
  for (int chain = blockIdx.x; chain < 2048; chain += gridDim.x) {
    const int b = chain >> 4, h = chain & 15;
    const size_t row = (size_t)NP + b;
    __syncthreads();
    if (w == 0) {
      const int ch = h * 64 + lane;
      const size_t off = row * 1024 + ch;
      const float rf = bf2f(R[off]), kf = bf2f(Kk[off]), vf = bf2f(V[off]), af = bf2f(Aa[off]), ef = h2f(EW[off]);
      const float kkr = kf * p.rw_kk[ch];
      const float ss = wavesum(kkr * kkr);
      const float inv = 1.f / fmaxf(sqrtf(ss), 1e-12f);
      const float kp = kf * (1.f + (af - 1.f) * p.rw_ka[ch]);
      const float rks = wavesum(rf * kp * p.rw_rk[ch]);
      sl[lane] = -kkr * inv;
      sl[64 + lane] = __expf(-ef);
      sl[128 + lane] = kkr * inv * af;
      sl[192 + lane] = kp;
      sl[256 + lane] = rf;
      sl[320 + lane] = vf;
      if (lane == 0) RK[row * 16 + h] = rks;
    }
    __syncthreads();
    const int i = tid >> 3, c8 = tid & 7;
    const float* sp = p.state_wkv + (((size_t)(b * 16 + h) * 64) + i) * 64 + c8 * 8;
    float4 sA = *(const float4*)sp, sB = *(const float4*)(sp + 4);
    float s[8] = {sA.x, sA.y, sA.z, sA.w, sB.x, sB.y, sB.z, sB.w};
    float sa = 0.f;
#pragma unroll
    for (int j = 0; j < 8; ++j) sa += s[j] * sl[c8 * 8 + j];
    sa += __shfl_xor(sa, 1);
    sa += __shfl_xor(sa, 2);
    sa += __shfl_xor(sa, 4);
    const float vv = sl[320 + i];
    float y = 0.f;
#pragma unroll
    for (int j = 0; j < 8; ++j) {
      const int cj = c8 * 8 + j;
      s[j] = s[j] * sl[64 + cj] + sa * sl[128 + cj] + vv * sl[192 + cj];
      y += s[j] * sl[256 + cj];
    }
    y += __shfl_xor(y, 1);
    y += __shfl_xor(y, 2);
    y += __shfl_xor(y, 4);
    float* wo = p.out + O_WKVS + (((size_t)(b * 16 + h) * 64) + i) * 64 + c8 * 8;
    *(float4*)wo = make_float4(s[0], s[1], s[2], s[3]);
    *(float4*)(wo + 4) = make_float4(s[4], s[5], s[6], s[7]);
    if (c8 == 0) Y[row * LDH + h * 64 + i] = f2bf(y);
  }
}

__device__ __forceinline__ void phase_gate(const Params& p, char* lds) {
  const u16* wt = (const u16*)(p.ws + WS_WT);
  const u16* GH = (const u16*)(p.ws + S_GH);
  const u16* V = (const u16*)(p.ws + S_V);
  const float* RK = (const float*)(p.ws + WS_RK);
  u16* Y = (u16*)(p.ws + WS_H);
  for (int t = blockIdx.x; t < 65 * 4; t += gridDim.x) {
    const int mt = t >> 2, nt = t & 3;
    const int m0 = mt * 256, n0 = nt * 256;
    gemm_tile256(GH, 128, wt + WT_G2, 128, 128, m0, n0, lds, mt == 64, [&](EPI_ARGS) {
      const int hh = (n0 + wn * 64) >> 6;
#pragma unroll
      for (int mi = 0; mi < 8; ++mi) {
        const int row = m0 + wm * 128 + mi * 16 + lr;
        const int rowc = row < MROWS ? row : MROWS - 1;
        float yv[4][4];
        float sum = 0.f;
#pragma unroll
        for (int ni = 0; ni < 4; ++ni) {
          const uint2 yy = *(const uint2*)(Y + (size_t)rowc * LDH + hh * 64 + ni * 16 + lg * 4);
          yv[ni][0] = bflo(yy.x); yv[ni][1] = bfhi(yy.x); yv[ni][2] = bflo(yy.y); yv[ni][3] = bfhi(yy.y);
          sum += yv[ni][0] + yv[ni][1] + yv[ni][2] + yv[ni][3];
        }
        sum += __shfl_xor(sum, 16);
        sum += __shfl_xor(sum, 32);
        const float mu = sum * (1.f / 64.f);
        float vs = 0.f;
#pragma unroll
        for (int ni = 0; ni < 4; ++ni)
#pragma unroll
          for (int q = 0; q < 4; ++q) {
            const float d = yv[ni][q] - mu;
            vs += d * d;
          }
        vs += __shfl_xor(vs, 16);
        vs += __shfl_xor(vs, 32);
        const float rstd = rsqrtf(vs * (1.f / 64.f) + 64e-5f);
        const float rk = RK[(size_t)rowc * 16 + hh];
#pragma unroll
        for (int ni = 0; ni < 4; ++ni) {
          const int col0 = hh * 64 + ni * 16 + lg * 4;
          const uint2 vv = *(const uint2*)(V + (size_t)rowc * 1024 + col0);
          const float vf[4] = {bflo(vv.x), bfhi(vv.x), bflo(vv.y), bfhi(vv.y)};
          const float4 g4 = *(const float4*)(p.rw_lnx_g + col0), b4 = *(const float4*)(p.rw_lnx_b + col0);
          const float gg[4] = {g4.x, g4.y, g4.z, g4.w}, bb[4] = {b4.x, b4.y, b4.z, b4.w};
          f32x4 o;
#pragma unroll
          for (int q = 0; q < 4; ++q) o[q] = ((yv[ni][q] - mu) * rstd * gg[q] + bb[q] + rk * vf[q]) * acc[mi][ni][q];
          if (row < MROWS) *(uint2*)(Y + (size_t)row * LDH + col0) = pack4(o);
        }
        __builtin_amdgcn_sched_barrier(0);
      }
    });
  }
}

__device__ __forceinline__ void phase_oproj(const Params& p, char* lds, const u16* A, int K, const u16* Bt, int layer, int gidx, bool first) {
  const int ldab = K == 1024 ? LDH : LDU;
  const float* mod = (const float*)(p.ws + WS_MOD);
  for (int u = blockIdx.x; u < 320; u += gridDim.x) {
    const bool split = u >= 256;
    const int s = u - 256;
    const int m0 = split ? NP : (u >> 2) * 256, n0 = (split ? (s & 3) : (u & 3)) * 256;
    const int klen = split ? (K >> 4) : K, kbeg = split ? (s >> 2) * klen : 0;
    gemm_tile256(A + kbeg, ldab, Bt + kbeg, ldab, klen, m0, n0, lds, split, [&](EPI_ARGS) {
      EPI_FOREACH(acc, if (row < MROWS) {
        const float4 gt = *(const float4*)(mod + ((size_t)layer * 132 + bidx_of(row)) * 6144 + gidx * 1024 + col0);
        float* xp = p.out + (size_t)row * 1024 + col0;
        if (split) {
          unsafeAtomicAdd(xp + 0, gt.x * v[0]);
          unsafeAtomicAdd(xp + 1, gt.y * v[1]);
          unsafeAtomicAdd(xp + 2, gt.z * v[2]);
          unsafeAtomicAdd(xp + 3, gt.w * v[3]);
        } else {
          const float* xi = first ? p.x_prompt + (size_t)row * 1024 + col0 : xp;
          const float4 xo = *(const float4*)xi;
          *(float4*)xp = make_float4(xo.x + gt.x * v[0], xo.y + gt.y * v[1], xo.z + gt.z * v[2], xo.w + gt.w * v[3]);
        }
      })
    });
  }
}

__device__ __forceinline__ void phase_up(const Params& p, char* lds, const u16* Bt) {
  const u16* H = (const u16*)(p.ws + WS_H);
  u16* UP = (u16*)(p.ws + S_UP);
  for (int t = blockIdx.x; t < 65 * 16; t += gridDim.x) {
    const int mt = t >> 4, nt = t & 15;
    const int m0 = mt * 256, n0 = nt * 256;
    gemm_tile256(H, LDH, Bt, LDH, 1024, m0, n0, lds, mt == 64, [&](EPI_ARGS) {
      EPI_FOREACH(acc, if (row < MROWS) {
        f32x4 o;
        _Pragma("unroll") for (int q = 0; q < 4; ++q) {
          const float rl = fmaxf(v[q], 0.f);
          o[q] = rl * rl;
        }
        *(uint2*)(UP + (size_t)row * LDU + col0) = pack4(o);
      })
    });
  }
}

__device__ __forceinline__ void phase_qkv(const Params& p, char* lds) {
  const u16* H = (const u16*)(p.ws + WS_H);
  const u16* wt = (const u16*)(p.ws + WS_WT);
  const float* tab = (const float*)(p.ws + WS_TAB);
  u16* Qb = (u16*)(p.ws + S_Q);
  u16* Kb = (u16*)(p.ws + S_KB);
  u16* Vt = (u16*)(p.ws + S_VT);
  for (int t = blockIdx.x; t < 65 * 6; t += gridDim.x) {
    const int mt = t / 6, nt = t % 6;
    const int m0 = mt * 256, n0 = nt * 256;
    gemm_tile256(H, LDH, wt + WT_QKV, LDH, 1024, m0, n0, lds, mt == 64, [&](EPI_ARGS) {
      const int hc0 = n0 + wn * 64;
#pragma unroll
      for (int mi = 0; mi < 8; ++mi) {
        const int row = m0 + wm * 128 + mi * 16 + lr;
        const bool valid = row < MROWS;
        const bool isp = row < NP;
        const int pos = row & 4095;
        const int bq = isp ? (row >> 12) : (row - NP);
        const int posidx = isp ? pos : 4096;
#pragma unroll
        for (int ni = 0; ni < 4; ++ni) {
          const int col0 = hc0 + ni * 16 + lg * 4;
          const float4 b4 = *(const float4*)(p.at_bqkv + col0);
          f32x4 v = acc[mi][ni];
          v[0] += b4.x; v[1] += b4.y; v[2] += b4.z; v[3] += b4.w;
          if (ni == 0 && hc0 < 1280) {
            const float* tp = tab + (size_t)posidx * 16 + (lg & 1) * 8;
            const float4 t0 = *(const float4*)tp, t1 = *(const float4*)(tp + 4);
            const float cs[4] = {t0.x, t0.z, t1.x, t1.z}, sn[4] = {t0.y, t0.w, t1.y, t1.w};
#pragma unroll
            for (int q = 0; q < 4; ++q) {
              const float pv = __shfl_xor(v[q], 32);
              v[q] = (lg < 2) ? (v[q] * cs[q] - pv * sn[q]) : (v[q] * cs[q] + pv * sn[q]);
            }
          }
          if (valid) {
            if (hc0 < 1024) {
              *(uint2*)(Qb + (size_t)row * 1024 + col0) = pack4(v);
            } else if (hc0 < 1280) {
              const int c2 = col0 - 1024;
              *(uint2*)(Kb + (size_t)row * 256 + c2) = pack4(v);
              if (isp) {
                if (pos >= 3968) *(float4*)(p.out + O_KP + ((size_t)(bq * 128 + pos - 3968)) * 256 + c2) = make_float4(v[0], v[1], v[2], v[3]);
              } else {
                *(float4*)(p.out + O_KS + ((size_t)(bq * 128 + 127)) * 256 + c2) = make_float4(v[0], v[1], v[2], v[3]);
              }
            } else {
              const int c3 = col0 - 1280;
              if (isp) {
                u16* vp = Vt + ((size_t)(bq * 4 + (c3 >> 6)) * 64 + (c3 & 63)) * 4096 + pos;
#pragma unroll
                for (int q = 0; q < 4; ++q) vp[(size_t)q * 4096] = f2bf(v[q]);
                if (pos >= 3968) *(float4*)(p.out + O_VP + ((size_t)(bq * 128 + pos - 3968)) * 256 + c3) = make_float4(v[0], v[1], v[2], v[3]);
              } else {
                *(float4*)(p.out + O_VS + ((size_t)(bq * 128 + 127)) * 256 + c3) = make_float4(v[0], v[1], v[2], v[3]);
              }
            }
          }
        }
        __builtin_amdgcn_sched_barrier(0);
      }
    });
  }
}

constexpr int AT_KS = 0, AT_VS = 36864, AT_PS = 36864 + 35840, AT_PW = 5376;

__device__ __forceinline__ void phase_attn(const Params& p, char* lds) {
  const int tid = threadIdx.x, lane = tid & 63, w = tid >> 6, lr = lane & 15, lg = lane >> 4;
  const u16* Qb = (const u16*)(p.ws + S_Q);
  const u16* Kb = (const u16*)(p.ws + S_KB);
  const u16* Vt = (const u16*)(p.ws + S_VT);
  u16* O = (u16*)(p.ws + S_O);
  char* Ks = lds + AT_KS;
  char* Vs = lds + AT_VS;
  char* Ps = lds + AT_PS + w * AT_PW;
  for (int u = blockIdx.x; u < 512; u += gridDim.x) {
    const int b = u >> 7, n = (u >> 2) & 31, kvh = u & 3;
    bf16x8 qfa[4][2];
    {
      const int g_ = w >> 1, hf_ = w & 1, qh_ = kvh * 4 + g_;
#pragma unroll
      for (int i = 0; i < 4; ++i) {
        const size_t tok = (size_t)b * 4096 + n * 128 + hf_ * 64 + i * 16 + lr;
        qfa[i][0] = *(const bf16x8*)(Qb + tok * 1024 + qh_ * 64 + lg * 8);
        qfa[i][1] = *(const bf16x8*)(Qb + tok * 1024 + qh_ * 64 + 32 + lg * 8);
      }
    }
    __syncthreads();
#pragma unroll
    for (int i = 0; i < 4; ++i) {
      const int c = tid + 512 * i;
      {
        const int key = c >> 3, kc = c & 7;
        const int pos = n * 128 - 128 + key;
        uint4 v = {0u, 0u, 0u, 0u};
        if (pos >= 0) v = *(const uint4*)(Kb + ((size_t)b * 4096 + pos) * 256 + kvh * 64 + kc * 8);
        *(uint4*)(Ks + key * 144 + kc * 16) = v;
      }
      {
        const int d = c >> 5, kc = c & 31;
        const int pos0 = n * 128 - 128 + kc * 8;
        uint4 v = {0u, 0u, 0u, 0u};
        if (pos0 >= 0) v = *(const uint4*)(Vt + ((size_t)(b * 4 + kvh) * 64 + d) * 4096 + pos0);
        *(uint4*)(Vs + d * 560 + kc * 16) = v;
      }
    }
    if (tid < 192) {
      const int d = tid / 3, c = tid % 3;
      *(uint4*)(Vs + d * 560 + 512 + c * 16) = uint4{0u, 0u, 0u, 0u};
    }
    {
      const int prow = lane >> 2, pc = 144 + (lane & 3) * 4;
      *(uint2*)(Ps + prow * 336 + pc * 2) = uint2{0u, 0u};
    }
    __syncthreads();
    const int g = w >> 1, hf = w & 1;
    const int qh = kvh * 4 + g;
    const float sink = p.at_sink[qh];
#pragma unroll
    for (int i = 0; i < 4; ++i) {
      const int q0 = hf * 64 + i * 16;
      const bf16x8 qf0 = qfa[i][0];
      const bf16x8 qf1 = qfa[i][1];
      f32x4 s[9];
#pragma unroll
      for (int j = 0; j < 9; ++j) {
        const char* kp = Ks + (q0 + j * 16 + lr) * 144 + lg * 16;
        const bf16x8 k0 = *(const bf16x8*)kp;
        const bf16x8 k1 = *(const bf16x8*)(kp + 64);
        f32x4 z = {0.f, 0.f, 0.f, 0.f};
        z = __builtin_amdgcn_mfma_f32_16x16x32_bf16(qf0, k0, z, 0, 0, 0);
        z = __builtin_amdgcn_mfma_f32_16x16x32_bf16(qf1, k1, z, 0, 0, 0);
        s[j] = z;
      }
      float mx[4], sum[4];
#pragma unroll
      for (int r = 0; r < 4; ++r) {
        const int ql = lg * 4 + r;
        float m = sink;
#pragma unroll
        for (int j = 0; j < 9; ++j) {
          float v = s[j][r] * 0.125f;
          bool ok = true;
          if (j == 0) ok = (lr >= ql);
          if (j == 8) ok = (lr <= ql);
          if (n == 0 && (q0 + j * 16 + lr) < 128) ok = false;
          v = ok ? v : -INFINITY;
          s[j][r] = v;
          m = fmaxf(m, v);
        }
        mx[r] = rowmax16(m);
      }
#pragma unroll
      for (int r = 0; r < 4; ++r) {
        float sm = 0.f;
#pragma unroll
        for (int j = 0; j < 9; ++j) {
          const float e = __expf(s[j][r] - mx[r]);
          s[j][r] = e;
          sm += e;
        }
        sm = rowsum16(sm);
        sum[r] = sm + __expf(sink - mx[r]);
      }
      u16* P = (u16*)Ps;
#pragma unroll
      for (int j = 0; j < 9; ++j)
#pragma unroll
        for (int r = 0; r < 4; ++r) P[(lg * 4 + r) * 168 + j * 16 + lr] = f2bf(s[j][r]);
      __builtin_amdgcn_wave_barrier();
      f32x4 o[4];
#pragma unroll
      for (int nd = 0; nd < 4; ++nd) o[nd] = f32x4{0.f, 0.f, 0.f, 0.f};
#pragma unroll
      for (int kk = 0; kk < 5; ++kk) {
        const bf16x8 pf = *(const bf16x8*)(Ps + lr * 336 + kk * 64 + lg * 16);
#pragma unroll
        for (int nd = 0; nd < 4; ++nd) {
          const bf16x8 vf = *(const bf16x8*)(Vs + (nd * 16 + lr) * 560 + (q0 + kk * 32 + lg * 8) * 2);
          o[nd] = __builtin_amdgcn_mfma_f32_16x16x32_bf16(pf, vf, o[nd], 0, 0, 0);
        }
      }
#pragma unroll
      for (int nd = 0; nd < 4; ++nd)
#pragma unroll
        for (int r = 0; r < 4; ++r) {
          const float v = o[nd][r] / sum[r];
          O[((size_t)b * 4096 + n * 128 + q0 + lg * 4 + r) * LDH + qh * 64 + nd * 16 + lr] = f2bf(v);
        }
      __builtin_amdgcn_wave_barrier();
    }
  }
  float* qs = (float*)lds;
  float* sc = (float*)(lds + 1024);
  float* part = (float*)(lds + 1024 + 2112);
  for (int it = blockIdx.x; it < 512; it += gridDim.x) {
    const int b = it >> 2, kvh = it & 3;
    const size_t row = (size_t)NP + b;
    __syncthreads();
    if (tid < 256) qs[tid] = bf2f(Qb[row * 1024 + kvh * 256 + tid]);
    __syncthreads();
    {
      const int key = tid >> 2, g = tid & 3;
      const float* kp = p.cache_k + (((size_t)b * 128 + key) * 4 + kvh) * 64;
      float dot = 0.f;
#pragma unroll
      for (int d4 = 0; d4 < 16; ++d4) {
        const float4 kv = *(const float4*)(kp + d4 * 4);
        const float* q = qs + g * 64 + d4 * 4;
        dot += kv.x * q[0] + kv.y * q[1] + kv.z * q[2] + kv.w * q[3];
      }
      sc[g * 132 + key] = dot * 0.125f;
      if (key >= 1) {
        float* dst = p.out + O_KS + (((size_t)b * 128 + key - 1) * 4 + kvh) * 64 + g * 16;
        const float* src = kp + g * 16;
#pragma unroll
        for (int d4 = 0; d4 < 4; ++d4) *(float4*)(dst + d4 * 4) = *(const float4*)(src + d4 * 4);
      }
      if (tid < 4) {
        const float* kn = p.out + O_KS + (((size_t)b * 128 + 127) * 4 + kvh) * 64;
        float d2 = 0.f;
        for (int d = 0; d < 64; ++d) d2 += kn[d] * qs[tid * 64 + d];
        sc[tid * 132 + 128] = d2 * 0.125f;
      }
    }
    __syncthreads();
    if (w < 4) {
      const float sink = p.at_sink[kvh * 4 + w];
      float* s = sc + w * 132;
      const float v0 = s[lane], v1 = s[64 + lane], v2 = lane == 0 ? s[128] : -INFINITY;
      float m = fmaxf(fmaxf(v0, v1), fmaxf(v2, sink));
      m = wavemax(m);
      const float e0 = __expf(v0 - m), e1 = __expf(v1 - m), e2 = lane == 0 ? __expf(v2 - m) : 0.f;
      float sm = wavesum(e0 + e1 + e2) + __expf(sink - m);
      const float inv = 1.f / sm;
      s[lane] = e0 * inv;
      s[64 + lane] = e1 * inv;
      if (lane == 0) s[128] = e2 * inv;
    }
    __syncthreads();
    {
      const int d = tid & 63, g = (tid >> 6) & 3, half = tid >> 8;
      const float* vp = p.cache_v + (((size_t)b * 128) * 4 + kvh) * 64 + d;
      float accv = 0.f;
      for (int key = half * 64; key < half * 64 + 64; ++key) {
        const float vv = vp[(size_t)key * 256];
        accv += sc[g * 132 + key] * vv;
        if (g == 0 && key >= 1) p.out[O_VS + (((size_t)b * 128 + key - 1) * 4 + kvh) * 64 + d] = vv;
      }
      if (half == 1) accv += sc[g * 132 + 128] * p.out[O_VS + (((size_t)b * 128 + 127) * 4 + kvh) * 64 + d];
      part[(half * 4 + g) * 64 + d] = accv;
    }
    __syncthreads();
    if (tid < 256) {
      const int d = tid & 63, g = tid >> 6;
      O[row * LDH + (kvh * 4 + g) * 64 + d] = f2bf(part[g * 64 + d] + part[(4 + g) * 64 + d]);
    }
  }
}

__global__ void __launch_bounds__(NTHR) mega(Params p) {
  extern __shared__ __attribute__((aligned(16))) char lds[];
  cg::grid_group grid = cg::this_grid();
  volatile LAS unsigned* xst = (volatile LAS unsigned*)(lds + LDS_BYTES);
  if (threadIdx.x == 0) { xst[0] = 0u; xst[1] = 0u; }
  __syncthreads();
  const XcdBarrier xb = xcd_barrier_post((unsigned*)(p.ws + WS_BAR), xst);
  const u16* wt = (const u16*)(p.ws + WS_WT);
  phase0(p, lds);
  if (p.out == nullptr) grid.sync();
  xcd_barrier(xb);
  phase_ada(p, lds);
  xcd_barrier(xb);
  phase_norm_mix(p);
  xcd_barrier(xb);
  phase_rwkv_proj(p, lds);
  xcd_barrier(xb);
  phase_rwkv_lora2(p, lds);
  xcd_barrier(xb);
  phase_scan(p, lds);
  xcd_barrier(xb);
  phase_gate(p, lds);
  xcd_barrier(xb);
  phase_oproj(p, lds, (const u16*)(p.ws + WS_H), 1024, wt + WT_WO, 0, 2, true);
  xcd_barrier(xb);
  phase_norm(p, 0, 1, false, false);
  xcd_barrier(xb);
  phase_up(p, lds, wt + WT_UP0);
  xcd_barrier(xb);
  phase_oproj(p, lds, (const u16*)(p.ws + S_UP), 4096, wt + WT_DN0, 0, 5, false);
  xcd_barrier(xb);
  phase_norm(p, 1, 0, false, false);
  xcd_barrier(xb);
  phase_qkv(p, lds);
  xcd_barrier(xb);
  phase_attn(p, lds);
  xcd_barrier(xb);
  phase_oproj(p, lds, (const u16*)(p.ws + S_O), 1024, wt + WT_WO1, 1, 2, false);
  xcd_barrier(xb);
  phase_norm(p, 1, 1, false, false);
  xcd_barrier(xb);
  phase_up(p, lds, wt + WT_UP1);
  xcd_barrier(xb);
  phase_oproj(p, lds, (const u16*)(p.ws + S_UP), 4096, wt + WT_DN1, 1, 5, false);
  xcd_barrier(xb);
  phase_final(p);
}

extern "C" void kernel_launch(void* const* d_in, const int* in_sizes, int n_in, void* d_out, int out_size, void* d_ws,
                              size_t ws_size, hipStream_t stream) {
  static int grid_blocks = 0;
  if (grid_blocks == 0) {
    if (ws_size < WS_END) {
      fprintf(stderr, "kernel_launch: workspace too small: %zu < %zu\n", ws_size, (size_t)WS_END);
      grid_blocks = -1;
      return;
    }
    int dev = 0, cus = 0, per_cu = 0;
    hipGetDevice(&dev);
    hipDeviceGetAttribute(&cus, hipDeviceAttributeMultiprocessorCount, dev);
    hipFuncSetAttribute((const void*)mega, hipFuncAttributeMaxDynamicSharedMemorySize, LDS_BYTES + 16);
    hipOccupancyMaxActiveBlocksPerMultiprocessor(&per_cu, (const void*)mega, NTHR, LDS_BYTES + 16);
    if (per_cu < 1) per_cu = 1;
    grid_blocks = cus * per_cu;
  }
  if (grid_blocks < 0) return;
  Params p{};
  const float** pp = (const float**)&p;
  for (int i = 0; i < 37; ++i) pp[i] = (const float*)d_in[i];
  p.out = (float*)d_out;
  p.ws = (char*)d_ws;
  hipMemsetAsync((char*)d_ws + WS_BAR, 0, 16384, stream);
  void* args[] = {&p};
  hipError_t e = hipLaunchCooperativeKernel((const void*)mega, dim3(grid_blocks), dim3(NTHR), args, LDS_BYTES + 16, stream);
  if (e != hipSuccess) fprintf(stderr, "cooperative launch failed: %s (grid %d)\n", hipGetErrorString(e), grid_blocks);
}
```

```cpp
#include <hip/hip_runtime.h>
#include <hip/hip_cooperative_groups.h>
#include <cstdio>
namespace cg = cooperative_groups;

typedef unsigned short u16;
typedef __attribute__((ext_vector_type(8))) short bf16x8;
typedef __attribute__((ext_vector_type(4))) float f32x4;

constexpr int NP = 16384, MROWS = 16512, MPAD = 16640;
constexpr int NTHR = 512;
constexpr size_t MEG = 1048576;
constexpr int LDH = 1088, LDU = 4160;

constexpr size_t O_Y = 0, O_WKVP = 16908288, O_WKVS = 17170432, O_SHP = 25559040, O_SHS = 25563136,
                 O_KP = 25694208, O_KS = 25825280, O_VP = 30019584, O_VS = 30150656;

constexpr size_t WT_WR = 0, WT_WK = WT_WR + 1024 * LDH, WT_WV = WT_WK + 1024 * LDH, WT_WO = WT_WV + 1024 * LDH,
                 WT_W1 = WT_WO + 1024 * LDH, WT_A1 = WT_W1 + 64 * LDH, WT_G1 = WT_A1 + 64 * LDH, WT_W2 = WT_G1 + 128 * LDH,
                 WT_A2 = WT_W2 + 65536, WT_G2 = WT_A2 + 65536, WT_UP0 = WT_G2 + 131072, WT_DN0 = WT_UP0 + 4096 * LDH,
                 WT_QKV = WT_DN0 + 1024 * LDU, WT_WO1 = WT_QKV + 1536 * LDH, WT_UP1 = WT_WO1 + 1024 * LDH,
                 WT_DN1 = WT_UP1 + 4096 * LDH, WT_END = WT_DN1 + 1024 * LDU;
constexpr size_t WS_WT = 0;
constexpr size_t WS_H = WS_WT + WT_END * 2;
constexpr size_t WS_ZR = WS_H + (size_t)MPAD * LDH * 2;
constexpr size_t WS_MOD = WS_ZR + (size_t)LDH * 2;
constexpr size_t WS_TAB = WS_MOD + (size_t)2 * 132 * 6144 * 4;
constexpr size_t WS_HS = WS_H + (size_t)MROWS * LDH * 2;
constexpr size_t WS_RK = WS_TAB + (size_t)4097 * 8 * 8;
constexpr size_t WS_BAR = WS_RK + (size_t)MPAD * 16 * 4;
constexpr size_t WS_S = WS_BAR + 16384;
constexpr size_t RSZ = (size_t)MROWS * 1024 * 2;
constexpr size_t S_ADAWT = WS_S, S_SILUC = S_ADAWT + (size_t)2 * 6144 * LDH * 2;
constexpr size_t S_R = WS_S, S_K = S_R + RSZ, S_V = S_K + RSZ, S_EW = S_V + RSZ, S_A = S_EW + RSZ,
                 S_WH = S_A + RSZ, S_AH = S_WH + (size_t)MPAD * 64 * 2, S_GH = S_AH + (size_t)MPAD * 64 * 2,
                 S_RW_END = S_GH + (size_t)MPAD * 128 * 2;
constexpr size_t S_UP = WS_S;
constexpr size_t S_Q = WS_S, S_O = S_Q + (size_t)MPAD * 1024 * 2, S_KB = S_O + (size_t)MPAD * LDH * 2,
                 S_VT = S_KB + (size_t)MPAD * 256 * 2;
constexpr size_t WS_END = S_RW_END;
static_assert(S_UP + (size_t)MPAD * LDU * 2 <= WS_END, "up fits");
static_assert(S_VT + (size_t)16 * 64 * 4096 * 2 <= WS_END, "attn fits");
static_assert(WS_END <= 282000000, "ws fits sum of inputs");

constexpr int LDS_ROW = 144;
constexpr int LDS_A_BYTES = 256 * LDS_ROW;
constexpr int LDS_B_BYTES = 128 * LDS_ROW;
constexpr int LDS_STAGE = LDS_A_BYTES + LDS_B_BYTES;
constexpr int LDS_BYTES = 147456;

struct Params {
  const float *x_prompt, *x_sample, *c_prompt, *c_sample, *state_wkv, *state_shift, *cache_k, *cache_v;
  const float *norm1_g, *norm2_g, *ada_w, *ada_b, *mlp_up, *mlp_down, *final_g;
  const float *rw_mix, *rw_wr, *rw_wk, *rw_wv, *rw_wo, *rw_w0, *rw_w1, *rw_w2, *rw_a0, *rw_a1, *rw_a2, *rw_g1, *rw_g2,
      *rw_kk, *rw_ka, *rw_rk, *rw_lnx_g, *rw_lnx_b;
  const float *at_wqkv, *at_bqkv, *at_wo, *at_sink;
  float* out;
  char* ws;
};

__device__ __forceinline__ u16 f2bf(float f) {
  unsigned u = __float_as_uint(f);
  u += 0x7fffu + ((u >> 16) & 1u);
  return (u16)(u >> 16);
}
__device__ __forceinline__ float bf2f(u16 h) { return __uint_as_float(((unsigned)h) << 16); }
__device__ __forceinline__ float bflo(unsigned w) { return __uint_as_float(w << 16); }
__device__ __forceinline__ float bfhi(unsigned w) { return __uint_as_float(w & 0xffff0000u); }
__device__ __forceinline__ unsigned pack2(float a, float b) {
  unsigned r;
  asm volatile("v_cvt_pk_bf16_f32 %0, %1, %2" : "=v"(r) : "v"(a), "v"(b));
  return r;
}
__device__ __forceinline__ uint2 pack4(f32x4 v) { return uint2{pack2(v[0], v[1]), pack2(v[2], v[3])}; }
__device__ __forceinline__ float h2f(u16 h) { return (float)__builtin_bit_cast(_Float16, h); }
__device__ __forceinline__ u16 f2h(float f) { return __builtin_bit_cast(u16, (_Float16)f); }
__device__ __forceinline__ float sigmoidf_(float x) { return 1.f / (1.f + __expf(-x)); }

template <int CTRL>
__device__ __forceinline__ float dppf(float x) {
  return __int_as_float(__builtin_amdgcn_update_dpp(0, __float_as_int(x), CTRL, 0xf, 0xf, true));
}
__device__ __forceinline__ float rowsum16(float x) {
  x += dppf<0xB1>(x);
  x += dppf<0x4E>(x);
  x += dppf<0x124>(x);
  x += dppf<0x128>(x);
  return x;
}
__device__ __forceinline__ float rowmax16(float x) {
  x = fmaxf(x, dppf<0xB1>(x));
  x = fmaxf(x, dppf<0x4E>(x));
  x = fmaxf(x, dppf<0x124>(x));
  x = fmaxf(x, dppf<0x128>(x));
  return x;
}
__device__ __forceinline__ float wavesum(float x) {
#pragma unroll
  for (int o = 32; o > 0; o >>= 1) x += __shfl_xor(x, o);
  return x;
}
__device__ __forceinline__ float wavemax(float x) {
#pragma unroll
  for (int o = 32; o > 0; o >>= 1) x = fmaxf(x, __shfl_xor(x, o));
  return x;
}
__device__ __forceinline__ int bidx_of(int row) { return row < NP ? (row >> 12) : (4 + row - NP); }

#define XB_TMO      128
#define XB_XCNT(j)  (256  + 64 * (j))
#define XB_XSUB(j)  (1280 + 64 * (j))
#define XB_XGEN(j)  (2304 + 64 * (j))
#define XB_TOP      3328
#define XB_TOPGEN   3392
#define XCD_BAR_WORDS 3456
#define XB_SPIN_CAP (1u << 22)
#define LAS __attribute__((address_space(3)))
__device__ __forceinline__ unsigned xb_ld(unsigned* p) { return __hip_atomic_load(p, __ATOMIC_RELAXED, __HIP_MEMORY_SCOPE_AGENT); }
__device__ __forceinline__ unsigned xb_add(unsigned* p, unsigned v) { return __hip_atomic_fetch_add(p, v, __ATOMIC_RELAXED, __HIP_MEMORY_SCOPE_AGENT); }
__device__ __forceinline__ unsigned xb_xcc_id() { return (unsigned)__builtin_amdgcn_s_getreg((3 << 11) | 20) & 0xFu; }
#define XB_SPIN(cond, bar) do { unsigned _sp = 0; while (cond) { __builtin_amdgcn_s_sleep(1); \
    if ((++_sp & 255u) == 0u) { if (xb_ld(&(bar)[XB_TMO])) break; if (_sp > XB_SPIN_CAP) { atomicAdd(&(bar)[XB_TMO], 1u); break; } } } } while (0)
struct XcdBarrier {
  unsigned* bar;
  unsigned x;
  volatile LAS unsigned* st;
};
__device__ __forceinline__ XcdBarrier xcd_barrier_post(unsigned* bar, volatile LAS unsigned* st) {
  XcdBarrier b;
  b.bar = bar;
  b.x = xb_xcc_id();
  b.st = st;
  if (threadIdx.x == 0) (void)xb_add(&bar[XB_XCNT(b.x)], 1u);
  return b;
}
__device__ __forceinline__ void xcd_barrier_complete(unsigned* bar, unsigned x, unsigned& nloc, unsigned& nx) {
  const unsigned G = gridDim.x * gridDim.y * gridDim.z;
  unsigned sum, cnt, mine, sp = 0u;
  for (;;) {
    sum = 0u; cnt = 0u; mine = 0u;
#pragma unroll
    for (unsigned j = 0; j < 16; ++j) {
      const unsigned c = xb_ld(&bar[XB_XCNT(j)]);
      sum += c;
      cnt += (c > 0u) ? 1u : 0u;
      mine = (j == x) ? c : mine;
    }
    if (sum == G) break;
    __builtin_amdgcn_s_sleep(1);
    if ((++sp & 255u) == 0u) {
      if (xb_ld(&bar[XB_TMO])) break;
      if (sp > XB_SPIN_CAP) { atomicAdd(&bar[XB_TMO], 1u); break; }
    }
  }
  nloc = mine > 0u ? mine : 1u;
  nx = cnt > 0u ? cnt : 1u;
}
__device__ __forceinline__ void xcd_barrier(const XcdBarrier& b) {
  asm volatile("s_waitcnt vmcnt(0)" ::: "memory");
  __syncthreads();
  if (threadIdx.x == 0) {
    unsigned* bar = b.bar;
    __builtin_amdgcn_s_waitcnt(0);
    unsigned nloc = b.st[0], nx = b.st[1];
    if (nloc == 0u) { xcd_barrier_complete(bar, b.x, nloc, nx); b.st[0] = nloc; b.st[1] = nx; }
    const unsigned old = xb_add(&bar[XB_XSUB(b.x)], 1u);
    const unsigned gen = old / nloc;
    if (old + 1u == (gen + 1u) * nloc) {
      __builtin_amdgcn_fence(__ATOMIC_RELEASE, "agent");
      asm volatile("s_waitcnt vmcnt(0)" ::: "memory");
      const unsigned og = xb_add(&bar[XB_TOP], 1u);
      const unsigned tg = og / nx;
      if (og + 1u == (tg + 1u) * nx) xb_add(&bar[XB_TOPGEN], 1u);
      else XB_SPIN(xb_ld(&bar[XB_TOPGEN]) == tg, bar);
      __builtin_amdgcn_fence(__ATOMIC_ACQUIRE, "agent");
      xb_add(&bar[XB_XGEN(b.x)], 1u);
      asm volatile("s_waitcnt vmcnt(0)" ::: "memory");
    } else {
      XB_SPIN(xb_ld(&bar[XB_XGEN(b.x)]) == gen, bar);
      __builtin_amdgcn_fence(__ATOMIC_ACQUIRE, "agent");
      asm volatile("s_waitcnt vmcnt(0)" ::: "memory");
    }
  }
  __syncthreads();
}

#define BAR_SYNC() do { asm volatile("s_waitcnt lgkmcnt(0)" ::: "memory"); __builtin_amdgcn_s_barrier(); asm volatile("" ::: "memory"); } while (0)

__device__ __forceinline__ unsigned mix2(unsigned h, unsigned p, float m0, float m1) {
  float h0 = bflo(h), h1 = bfhi(h), p0 = bflo(p), p1 = bfhi(p);
  return pack2(h0 + (p0 - h0) * m0, h1 + (p1 - h1) * m1);
}

template <bool MIX, class Epi>
__device__ __forceinline__ void gemm_tile(const u16* __restrict__ A, int lda, const float* __restrict__ mixv,
                                          const u16* __restrict__ Bt, int ldb, int N, int K, int m0, int n0, char* lds, Epi&& epi) {
  const int tid = threadIdx.x, lane = tid & 63, w = tid >> 6;
  const int nk = K >> 6;
  if (w >= 4) {
    const int pt = tid - 256, kc = pt & 7, pr = pt >> 3;
    const u16* Ab = A + (size_t)m0 * lda + (size_t)pr * lda + kc * 8;
    int poff[8];
#pragma unroll
    for (int i = 0; i < 8; ++i) {
      poff[i] = 0;
      if (MIX) {
        const int row = m0 + pr + 32 * i;
        const int prow = row < NP ? ((row & 4095) ? row - 1 : MPAD) : (row < MROWS ? row + 128 : MPAD);
        poff[i] = prow * LDH + kc * 8;
      }
    }
    bool bv[4];
    const u16* bp[4];
#pragma unroll
    for (int j = 0; j < 4; ++j) {
      const int n = n0 + pr + 32 * j;
      bv[j] = n < N;
      bp[j] = Bt + (size_t)(bv[j] ? n : 0) * ldb + kc * 8;
    }
    struct RSet {
      uint4 ra[8], rp[8], rb[4];
      float4 mx0, mx1;
    };
    RSet SA, SB;
    auto gload = [&](RSet& S, int kt) {
      const int ko = kt * 64;
#pragma unroll
      for (int i = 0; i < 8; ++i) {
        S.ra[i] = *(const uint4*)(Ab + (size_t)(32 * i) * lda + ko);
        if (MIX) S.rp[i] = *(const uint4*)(A + poff[i] + ko);
      }
      if (MIX) {
        S.mx0 = *(const float4*)(mixv + ko + kc * 8);
        S.mx1 = *(const float4*)(mixv + ko + kc * 8 + 4);
      }
#pragma unroll
      for (int j = 0; j < 4; ++j) {
        uint4 z = {0u, 0u, 0u, 0u};
        if (bv[j]) z = *(const uint4*)(bp[j] + ko);
        S.rb[j] = z;
      }
    };
    auto lstore = [&](RSet& S, int s) {
      char* base = lds + s * LDS_STAGE + pr * LDS_ROW + kc * 16;
#pragma unroll
      for (int i = 0; i < 8; ++i) {
        uint4 v = S.ra[i];
        if (MIX) {
          v.x = mix2(S.ra[i].x, S.rp[i].x, S.mx0.x, S.mx0.y);
          v.y = mix2(S.ra[i].y, S.rp[i].y, S.mx0.z, S.mx0.w);
          v.z = mix2(S.ra[i].z, S.rp[i].z, S.mx1.x, S.mx1.y);
          v.w = mix2(S.ra[i].w, S.rp[i].w, S.mx1.z, S.mx1.w);
        }
        *(uint4*)(base + (32 * i) * LDS_ROW) = v;
      }
#pragma unroll
      for (int j = 0; j < 4; ++j) *(uint4*)(base + LDS_A_BYTES + (32 * j) * LDS_ROW) = S.rb[j];
    };
    if constexpr (!MIX) {
      gload(SB, 0);
      if (nk > 1) gload(SA, 1);
      lstore(SB, 0);
      if (nk > 2) gload(SB, 2);
      BAR_SYNC();
#pragma unroll 1
      for (int kt = 0; kt < nk; kt += 2) {
        if (kt + 1 < nk) {
          lstore(SA, 1);
          if (kt + 3 < nk) gload(SA, kt + 3);
        }
        BAR_SYNC();
        if (kt + 1 < nk) {
          if (kt + 2 < nk) {
            lstore(SB, 0);
            if (kt + 4 < nk) gload(SB, kt + 4);
          }
          BAR_SYNC();
        }
      }
    } else {
      gload(SA, 0);
      lstore(SA, 0);
      if (nk > 1) gload(SA, 1);
      BAR_SYNC();
#pragma unroll 1
      for (int kt = 0; kt < nk; ++kt) {
        if (kt + 1 < nk) {
          lstore(SA, (kt + 1) & 1);
          if (kt + 2 < nk) gload(SA, kt + 2);
        }
        BAR_SYNC();
      }
    }
  } else {
    const int wm = w >> 1, wn = w & 1, lr = lane & 15, lg = lane >> 4;
    f32x4 acc[8][4];
#pragma unroll
    for (int i = 0; i < 8; ++i)
#pragma unroll
      for (int j = 0; j < 4; ++j) acc[i][j] = f32x4{0.f, 0.f, 0.f, 0.f};
    BAR_SYNC();
#pragma unroll 1
    for (int kt = 0; kt < nk; ++kt) {
      const char* sa = lds + (kt & 1) * LDS_STAGE + (wm * 128 + lr) * LDS_ROW + lg * 16;
      const char* sb = lds + (kt & 1) * LDS_STAGE + LDS_A_BYTES + (wn * 64 + lr) * LDS_ROW + lg * 16;
      bf16x8 bq[2][4], aq[3];
#pragma unroll
      for (int ni = 0; ni < 4; ++ni) bq[0][ni] = *(const bf16x8*)(sb + ni * 16 * LDS_ROW);
      aq[0] = *(const bf16x8*)(sa);
      aq[1] = *(const bf16x8*)(sa + 16 * LDS_ROW);
#pragma unroll
      for (int ni = 0; ni < 4; ++ni) bq[1][ni] = *(const bf16x8*)(sb + ni * 16 * LDS_ROW + 64);
#pragma unroll
      for (int st = 0; st < 16; ++st) {
        if (st + 2 < 16) aq[(st + 2) % 3] = *(const bf16x8*)(sa + ((st + 2) & 7) * 16 * LDS_ROW + ((st + 2) >> 3) * 64);
#pragma unroll
        for (int ni = 0; ni < 4; ++ni)
          acc[st & 7][ni] = __builtin_amdgcn_mfma_f32_16x16x32_bf16(bq[st >> 3][ni], aq[st % 3], acc[st & 7][ni], 0, 0, 0);
        __builtin_amdgcn_sched_barrier(0);
      }
      BAR_SYNC();
    }
    epi(acc, wm, wn, lr, lg);
  }
}

constexpr int LDS_STAGE2 = 2 * LDS_A_BYTES;
template <class Epi>
__device__ __forceinline__ void gemm_tile256(const u16* __restrict__ A, int lda, const u16* __restrict__ Bt, int ldb, int K, int m0,
                                             int n0, char* lds, bool half, Epi&& epi) {
  int tid = threadIdx.x;
  asm volatile("" : "+v"(tid));
  const int lane = tid & 63, w = __builtin_amdgcn_readfirstlane(tid >> 6);
  const int wm = w >> 2, wn = w & 3, lr = lane & 15, lg = lane >> 4;
  const int nk = K >> 5;
  const int drow = lane >> 2, dch = (lane & 3) ^ ((lane >> 4) & 3);
  const u16* As0 = A + (size_t)(m0 + w * 16 + drow) * lda + dch * 8;
  const u16* As1 = A + (size_t)(m0 + (w + 8) * 16 + drow) * lda + dch * 8;
  const u16* Bs0 = Bt + (size_t)(n0 + w * 16 + drow) * ldb + dch * 8;
  const u16* Bs1 = Bt + (size_t)(n0 + (w + 8) * 16 + drow) * ldb + dch * 8;
  auto dma = [&](int kt, int stg) __attribute__((always_inline)) {
    char* sbase = lds + stg * 32768;
    const int ko = kt * 32;
    __builtin_amdgcn_global_load_lds((const unsigned*)(As0 + ko), (unsigned*)(sbase + w * 1024), 16, 0, 0);
    __builtin_amdgcn_global_load_lds((const unsigned*)(As1 + ko), (unsigned*)(sbase + (w + 8) * 1024), 16, 0, 0);
    __builtin_amdgcn_global_load_lds((const unsigned*)(Bs0 + ko), (unsigned*)(sbase + 16384 + w * 1024), 16, 0, 0);
    __builtin_amdgcn_global_load_lds((const unsigned*)(Bs1 + ko), (unsigned*)(sbase + 16384 + (w + 8) * 1024), 16, 0, 0);
  };
  f32x4 acc[8][4];
#pragma unroll
  for (int i = 0; i < 8; ++i)
#pragma unroll
    for (int j = 0; j < 4; ++j) acc[i][j] = f32x4{0.f, 0.f, 0.f, 0.f};
  const int swz = (lg ^ ((lr >> 2) & 3)) * 16;
  const int aoff = (wm * 128 + lr) * 64 + swz, boff = 16384 + (wn * 64 + lr) * 64 + swz;
  const bool skipm = half && wm == 1;
  dma(0, 0);
  dma(nk > 1 ? 1 : nk - 1, 1);
  dma(nk > 2 ? 2 : nk - 1, 2);
  asm volatile("s_waitcnt vmcnt(8)" ::: "memory");
  BAR_SYNC();
#pragma unroll 1
  for (int kt = 0; kt < nk; ++kt) {
    dma(kt + 3 < nk ? kt + 3 : nk - 1, (kt + 3) & 3);
    if (!skipm) {
      const char* sa = lds + (kt & 3) * 32768 + aoff;
      const char* sb = lds + (kt & 3) * 32768 + boff;
      bf16x8 bq[4], aq[3];
#pragma unroll
      for (int ni = 0; ni < 4; ++ni) bq[ni] = *(const bf16x8*)(sb + ni * 1024);
      aq[0] = *(const bf16x8*)(sa);
      aq[1] = *(const bf16x8*)(sa + 1024);
#pragma unroll
      for (int st = 0; st < 8; ++st) {
        if (st + 2 < 8) aq[(st + 2) % 3] = *(const bf16x8*)(sa + (st + 2) * 1024);
#pragma unroll
        for (int ni = 0; ni < 4; ++ni)
          acc[st][ni] = __builtin_amdgcn_mfma_f32_16x16x32_bf16(bq[ni], aq[st % 3], acc[st][ni], 0, 0, 0);
        __builtin_amdgcn_sched_barrier(0);
      }
    }
    asm volatile("s_waitcnt vmcnt(8)" ::: "memory");
    BAR_SYNC();
  }
  asm volatile("s_waitcnt vmcnt(0)" ::: "memory");
  BAR_SYNC();
  epi(acc, wm, wn, lr, lg);
}

#define EPI_FOREACH(acc, ...)                                    \
  _Pragma("unroll") for (int mi = 0; mi < 8; ++mi) {             \
    const int row = m0 + wm * 128 + mi * 16 + lr;                \
    _Pragma("unroll") for (int ni = 0; ni < 4; ++ni) {           \
      const int col0 = n0 + wn * 64 + ni * 16 + lg * 4;          \
      const f32x4 v = acc[mi][ni];                               \
      __VA_ARGS__                                                \
    }                                                            \
    __builtin_amdgcn_sched_barrier(0);                           \
  }
#define EPI_ARGS f32x4(&acc)[8][4], int wm, int wn, int lr, int lg

__device__ __forceinline__ void conv_job(const float* __restrict__ src, u16* __restrict__ dst, int K, int N, int ldk, float* tl, int rot) {
  int tid = threadIdx.x;
  asm volatile("" : "+v"(tid));
  const int tn = N >> 6, nt = (K >> 6) * tn;
  const int G = gridDim.x;
  int t = ((int)blockIdx.x + G - (rot % G)) % G;
  float v[8];
  auto ldtile = [&](int tt) {
    const int k0 = (tt / tn) << 6, n0 = (tt % tn) << 6;
#pragma unroll
    for (int i = 0; i < 8; ++i) {
      const int e = tid + 512 * i;
      v[i] = src[(size_t)(k0 + (e >> 6)) * N + n0 + (e & 63)];
    }
  };
  if (t < nt) ldtile(t);
  while (t < nt) {
    const int k0 = (t / tn) << 6, n0 = (t % tn) << 6;
#pragma unroll
    for (int i = 0; i < 8; ++i) {
      const int e = tid + 512 * i;
      tl[(e >> 6) * 65 + (e & 63)] = v[i];
    }
    const int tnx = t + G;
    if (tnx < nt) ldtile(tnx);
    __syncthreads();
    const int n = tid >> 3, kc = tid & 7;
    float f[8];
#pragma unroll
    for (int j = 0; j < 8; ++j) f[j] = tl[(kc * 8 + j) * 65 + n];
    uint4 o;
    o.x = pack2(f[0], f[1]);
    o.y = pack2(f[2], f[3]);
    o.z = pack2(f[4], f[5]);
    o.w = pack2(f[6], f[7]);
    *(uint4*)(dst + (size_t)(n0 + n) * ldk + k0 + kc * 8) = o;
    __syncthreads();
    t = tnx;
  }
}

__device__ __forceinline__ void phase0(const Params& p, char* lds) {
  float* tl = (float*)lds;
  u16* wt = (u16*)(p.ws + WS_WT);
  u16* adawt = (u16*)(p.ws + S_ADAWT);
  int rot = 0;
#define CJ(SRC, DST, K, N)            \
  conv_job(SRC, DST, K, N, ((K) == 1024 ? LDH : (K) == 4096 ? LDU : (K)), tl, rot);  \
  rot += ((K) >> 6) * ((N) >> 6);
  CJ(p.ada_w, adawt, 1024, 6144)
  CJ(p.ada_w + (size_t)1024 * 6144, adawt + (size_t)6144 * LDH, 1024, 6144)
  CJ(p.rw_wr, wt + WT_WR, 1024, 1024)
  CJ(p.rw_wk, wt + WT_WK, 1024, 1024)
  CJ(p.rw_wv, wt + WT_WV, 1024, 1024)
  CJ(p.rw_wo, wt + WT_WO, 1024, 1024)
  CJ(p.rw_w1, wt + WT_W1, 1024, 64)
  CJ(p.rw_a1, wt + WT_A1, 1024, 64)
  CJ(p.rw_g1, wt + WT_G1, 1024, 128)
  CJ(p.rw_w2, wt + WT_W2, 64, 1024)
  CJ(p.rw_a2, wt + WT_A2, 64, 1024)
  CJ(p.rw_g2, wt + WT_G2, 128, 1024)
  CJ(p.mlp_up, wt + WT_UP0, 1024, 4096)
  CJ(p.mlp_down, wt + WT_DN0, 4096, 1024)
  CJ(p.at_wqkv, wt + WT_QKV, 1024, 1536)
  CJ(p.at_wo, wt + WT_WO1, 1024, 1024)
  CJ(p.mlp_up + (size_t)4 * MEG, wt + WT_UP1, 1024, 4096)
  CJ(p.mlp_down + (size_t)4 * MEG, wt + WT_DN1, 4096, 1024)
#undef CJ
  const int gtid = blockIdx.x * NTHR + threadIdx.x, gsz = gridDim.x * NTHR;
  u16* siluc = (u16*)(p.ws + S_SILUC);
  for (int i = gtid; i < 256 * 1024; i += gsz) {
    int row = i >> 10, col = i & 1023;
    float c = 0.f;
    if (row < 4) c = p.c_prompt[row * 1024 + col];
    else if (row < 132) c = p.c_sample[(row - 4) * 1024 + col];
    siluc[i] = f2bf(c * sigmoidf_(c));
  }
  u16* hs = (u16*)(p.ws + WS_HS);
  for (int i = gtid; i < 128 * 1024; i += gsz) hs[(size_t)(i >> 10) * LDH + (i & 1023)] = f2bf(p.state_shift[i]);
  u16* zr = (u16*)(p.ws + WS_ZR);
  for (int i = gtid; i < LDH; i += gsz) zr[i] = 0;
  float2* tab = (float2*)(p.ws + WS_TAB);
  for (int i = gtid; i < 4097 * 8; i += gsz) {
    int pi = i >> 3, f = i & 7;
    float pos = pi < 4096 ? (float)pi : 8192.f;
    float inv = f == 0 ? 1.0f : f == 1 ? 0.1939227432012558f : f == 2 ? 0.03760603070259094f : f == 3 ? 0.007292664609849453f
              : f == 4 ? 0.0014142135623842478f : f == 5 ? 0.00027424818836152554f : f == 6 ? 5.318296098266728e-05f
              : 1.0313386155758053e-05f;
    float ang = pos * inv;
    double t = (double)ang * 0.15915494309189535;
    t -= rint(t);
    float fr = (float)t;
    tab[i] = make_float2(__builtin_amdgcn_cosf(fr), __builtin_amdgcn_sinf(fr));
  }
}

__device__ __forceinline__ void phase_ada(const Params& p, char* lds) {
  const u16* siluc = (const u16*)(p.ws + S_SILUC);
  const u16* adawt = (const u16*)(p.ws + S_ADAWT);
  float* mod = (float*)(p.ws + WS_MOD);
  for (int t = blockIdx.x; t < 96; t += gridDim.x) {
    const int layer = t / 48, nt = t % 48;
    const int m0 = 0, n0 = nt * 128;
    const float* bias = p.ada_b + layer * 6144;
    float* mo = mod + (size_t)layer * 132 * 6144;
    gemm_tile<false>(siluc, 1024, nullptr, adawt + (size_t)layer * 6144 * LDH, LDH, 6144, 1024, m0, n0, lds, [&](EPI_ARGS) {
      EPI_FOREACH(acc, if (row < 132) {
        const float4 b4 = *(const float4*)(bias + col0);
        *(float4*)(mo + (size_t)row * 6144 + col0) = make_float4(v[0] + b4.x, v[1] + b4.y, v[2] + b4.z, v[3] + b4.w);
      })
    });
  }
}

__device__ __forceinline__ void phase_norm(const Params& p, int layer, int which, bool from_input, bool shift_out) {
  const int lane = threadIdx.x & 63, w = threadIdx.x >> 6;
  const float* mod = (const float*)(p.ws + WS_MOD);
  u16* H = (u16*)(p.ws + WS_H);
  const float* g = (which ? p.norm2_g : p.norm1_g) + layer * 1024;
  const int nw = gridDim.x * 8;
  auto xrow = [&](int row) {
    return from_input ? (row < NP ? p.x_prompt + (size_t)row * 1024 : p.x_sample + (size_t)(row - NP) * 1024)
                      : (const float*)p.out + (size_t)row * 1024;
  };
  float4 gg[4];
#pragma unroll
  for (int i = 0; i < 4; ++i) gg[i] = *(const float4*)(g + lane * 4 + 256 * i);
  int row = blockIdx.x * 8 + w;
  float4 xn[4];
  if (row < MROWS) {
    const float* xr = xrow(row);
#pragma unroll
    for (int i = 0; i < 4; ++i) xn[i] = *(const float4*)(xr + lane * 4 + 256 * i);
  }
  while (row < MROWS) {
    float4 x[4];
#pragma unroll
    for (int i = 0; i < 4; ++i) x[i] = xn[i];
    const int nrow = row + nw;
    if (nrow < MROWS) {
      const float* xr = xrow(nrow);
#pragma unroll
      for (int i = 0; i < 4; ++i) xn[i] = *(const float4*)(xr + lane * 4 + 256 * i);
    }
    const int bi = bidx_of(row);
    const float* mb = mod + ((size_t)layer * 132 + bi) * 6144;
    const float* sh = mb + (which ? 3 : 0) * 1024;
    const float* sc = mb + (which ? 4 : 1) * 1024;
    float4 s4[4], c4[4];
#pragma unroll
    for (int i = 0; i < 4; ++i) {
      s4[i] = *(const float4*)(sh + lane * 4 + 256 * i);
      c4[i] = *(const float4*)(sc + lane * 4 + 256 * i);
    }
    float ss = 0.f;
#pragma unroll
    for (int i = 0; i < 4; ++i) ss += x[i].x * x[i].x + x[i].y * x[i].y + x[i].z * x[i].z + x[i].w * x[i].w;
    ss = wavesum(ss);
    const float rs = rsqrtf(ss * (1.f / 1024.f) + 1e-6f);
    const bool so = shift_out && (row >= NP || (row & 4095) == 4095);
    float* sop = row >= NP ? p.out + O_SHS + (size_t)(row - NP) * 1024 : p.out + O_SHP + (size_t)(row >> 12) * 1024;
#pragma unroll
    for (int i = 0; i < 4; ++i) {
      const int c = lane * 4 + 256 * i;
      float4 h;
      h.x = x[i].x * rs * gg[i].x * (1.f + c4[i].x) + s4[i].x;
      h.y = x[i].y * rs * gg[i].y * (1.f + c4[i].y) + s4[i].y;
      h.z = x[i].z * rs * gg[i].z * (1.f + c4[i].z) + s4[i].z;
      h.w = x[i].w * rs * gg[i].w * (1.f + c4[i].w) + s4[i].w;
      uint2 pk;
      pk.x = pack2(h.x, h.y);
      pk.y = pack2(h.z, h.w);
      *(uint2*)(H + (size_t)row * LDH + c) = pk;
      if (so) *(float4*)(sop + c) = h;
    }
    row = nrow;
  }
}

__device__ __forceinline__ void phase_norm_mix(const Params& p) {
  const int lane = threadIdx.x & 63, w = threadIdx.x >> 6;
  const float* mod = (const float*)(p.ws + WS_MOD);
  u16* H = (u16*)(p.ws + WS_H);
  u16* XR = (u16*)p.out;
  u16* XK = XR + (size_t)MROWS * 1024;
  u16* XV = (u16*)(p.ws + S_EW);
  const float* g = p.norm1_g;
  const int nw = gridDim.x * 8;
  f32x4 gg[4], mr[4], mk[4], mv[4];
#pragma unroll
  for (int i = 0; i < 4; ++i) {
    const int c = lane * 4 + 256 * i;
    gg[i] = *(const f32x4*)(g + c);
    mr[i] = *(const f32x4*)(p.rw_mix + c);
    mk[i] = *(const f32x4*)(p.rw_mix + 2 * 1024 + c);
    mv[i] = *(const f32x4*)(p.rw_mix + 3 * 1024 + c);
  }
  auto xrow = [&](int row) { return row < NP ? p.x_prompt + (size_t)row * 1024 : p.x_sample + (size_t)(row - NP) * 1024; };
  auto hrow = [&](const f32x4 (&x)[4], int row, f32x4 (&h)[4]) __attribute__((always_inline)) {
    float ss = 0.f;
#pragma unroll
    for (int i = 0; i < 4; ++i) ss += x[i][0] * x[i][0] + x[i][1] * x[i][1] + x[i][2] * x[i][2] + x[i][3] * x[i][3];
    ss = wavesum(ss);
    const float rs = rsqrtf(ss * (1.f / 1024.f) + 1e-6f);
    const float* mb = mod + (size_t)bidx_of(row) * 6144;
#pragma unroll
    for (int i = 0; i < 4; ++i) {
      const int c = lane * 4 + 256 * i;
      const f32x4 s4 = *(const f32x4*)(mb + c), c4 = *(const f32x4*)(mb + 1024 + c);
      h[i] = x[i] * rs * gg[i] * (1.f + c4) + s4;
    }
  };
  for (int chunk = blockIdx.x * 8 + w; chunk < MROWS / 8; chunk += nw) {
    const int r0 = chunk * 8;
    f32x4 hp[4], x[4], xn[4];
    if (r0 < NP && (r0 & 4095) != 0) {
      const float* xr = xrow(r0 - 1);
#pragma unroll
      for (int i = 0; i < 4; ++i) x[i] = *(const f32x4*)(xr + lane * 4 + 256 * i);
      hrow(x, r0 - 1, hp);
    } else {
#pragma unroll
      for (int i = 0; i < 4; ++i) hp[i] = f32x4{0.f, 0.f, 0.f, 0.f};
    }
    {
      const float* xr = xrow(r0);
#pragma unroll
      for (int i = 0; i < 4; ++i) xn[i] = *(const f32x4*)(xr + lane * 4 + 256 * i);
    }
#pragma unroll 1
    for (int rr = 0; rr < 8; ++rr) {
      const int row = r0 + rr;
#pragma unroll
      for (int i = 0; i < 4; ++i) x[i] = xn[i];
      if (rr + 1 < 8) {
        const float* xr = xrow(row + 1);
#pragma unroll
        for (int i = 0; i < 4; ++i) xn[i] = *(const f32x4*)(xr + lane * 4 + 256 * i);
      }
      if (row >= NP) {
#pragma unroll
        for (int i = 0; i < 4; ++i) hp[i] = *(const f32x4*)(p.state_shift + (size_t)(row - NP) * 1024 + lane * 4 + 256 * i);
      }
      f32x4 h[4];
      hrow(x, row, h);
      const bool so = row >= NP || (row & 4095) == 4095;
      float* sop = row >= NP ? p.out + O_SHS + (size_t)(row - NP) * 1024 : p.out + O_SHP + (size_t)(row >> 12) * 1024;
#pragma unroll
      for (int i = 0; i < 4; ++i) {
        const int c = lane * 4 + 256 * i;
        *(uint2*)(H + (size_t)row * LDH + c) = pack4(h[i]);
        if (so) *(f32x4*)(sop + c) = h[i];
        const f32x4 dd = hp[i] - h[i];
        *(uint2*)(XR + (size_t)row * 1024 + c) = pack4(h[i] + dd * mr[i]);
        *(uint2*)(XK + (size_t)row * 1024 + c) = pack4(h[i] + dd * mk[i]);
        *(uint2*)(XV + (size_t)row * 1024 + c) = pack4(h[i] + dd * mv[i]);
        hp[i] = h[i];
      }
    }
  }
}

__device__ __forceinline__ void phase_final(const Params& p) {
  const int lane = threadIdx.x & 63, w = threadIdx.x >> 6;
  const int nw = gridDim.x * 8;
  for (int row = blockIdx.x * 8 + w; row < MROWS; row += nw) {
    float* xr = p.out + (size_t)row * 1024;
    float4 x[4];
    float ss = 0.f;
#pragma unroll
    for (int i = 0; i < 4; ++i) {
      x[i] = *(const float4*)(xr + lane * 4 + 256 * i);
      ss += x[i].x * x[i].x + x[i].y * x[i].y + x[i].z * x[i].z + x[i].w * x[i].w;
    }
    ss = wavesum(ss);
    const float rs = rsqrtf(ss * (1.f / 1024.f) + 1e-6f);
#pragma unroll
    for (int i = 0; i < 4; ++i) {
      const int c = lane * 4 + 256 * i;
      float4 gg = *(const float4*)(p.final_g + c);
      float4 h;
      h.x = x[i].x * rs * gg.x;
      h.y = x[i].y * rs * gg.y;
      h.z = x[i].z * rs * gg.z;
      h.w = x[i].w * rs * gg.w;
      *(float4*)(xr + c) = h;
    }
  }
}

__device__ __forceinline__ void phase_rwkv_proj(const Params& p, char* lds) {
  const u16* H = (const u16*)(p.ws + WS_H);
  const u16* wt = (const u16*)(p.ws + WS_WT);
  const u16* XR = (const u16*)p.out;
  const u16* XK = XR + (size_t)MROWS * 1024;
  const u16* XV = (const u16*)(p.ws + S_EW);
  u16* R = (u16*)(p.ws + S_R);
  u16* Kk = (u16*)(p.ws + S_K);
  u16* V = (u16*)(p.ws + S_V);
  u16* WH = (u16*)(p.ws + S_WH);
  u16* AH = (u16*)(p.ws + S_AH);
  u16* GH = (u16*)(p.ws + S_GH);
  for (int u = blockIdx.x; u < 780 + 195; u += gridDim.x) {
    if (u < 780) {
      const int kind = u / 260, t = u - kind * 260;
      const int mt = t >> 2, nt = t & 3;
      const int m0 = mt * 256, n0 = nt * 256;
      const u16* A = kind == 2 ? XV : XR + (size_t)kind * ((size_t)MROWS * 1024);
      const u16* Bt = wt + WT_WR + (size_t)kind * (1024 * LDH);
      u16* dst = R + (size_t)kind * (RSZ / 2);
      gemm_tile256(A, 1024, Bt, LDH, 1024, m0, n0, lds, mt == 64, [&](EPI_ARGS) {
        EPI_FOREACH(acc, if (row < MROWS) *(uint2*)(dst + (size_t)row * 1024 + col0) = pack4(v);)
      });
    } else {
      const int s_ = u - 780;
      const int mt = s_ / 3, kind = 3 + (s_ - mt * 3);
      const int m0 = mt * 256, n0 = 0;
      const int N = kind == 5 ? 128 : 64, mixi = kind == 3 ? 1 : kind;
      const u16* Bt = wt + WT_W1 + (size_t)(kind - 3) * (64 * LDH);
      gemm_tile<true>(H, LDH, p.rw_mix + mixi * 1024, Bt, LDH, N, 1024, m0, n0, lds, [&](EPI_ARGS) {
        u16* dst = WH + (size_t)(kind - 3) * ((size_t)MPAD * 64);
        const int ld = kind == 5 ? 128 : 64;
        EPI_FOREACH(acc, if (row < MROWS && col0 < ld) {
          f32x4 o = v;
          if (kind == 3) {
            _Pragma("unroll") for (int q = 0; q < 4; ++q) o[q] = 1.f - 2.f / (__expf(2.f * v[q]) + 1.f);
          } else if (kind == 5) {
            _Pragma("unroll") for (int q = 0; q < 4; ++q) o[q] = sigmoidf_(v[q]);
          }
          *(uint2*)(dst + (size_t)row * ld + col0) = pack4(o);
        })
      });
    }
  }
}

__device__ __forceinline__ void phase_rwkv_lora2(const Params& p, char* lds) {
  {
    const int gtid = blockIdx.x * NTHR + threadIdx.x, gsz = gridDim.x * NTHR;
    for (int i = gtid; i < 128 * 256; i += gsz) ((float4*)(p.out + (size_t)NP * 1024))[i] = ((const float4*)p.x_sample)[i];
  }
  const u16* wt = (const u16*)(p.ws + WS_WT);
  const u16* WH = (const u16*)(p.ws + S_WH);
  const u16* AH = (const u16*)(p.ws + S_AH);
  u16* EW = (u16*)(p.ws + S_EW);
  u16* Aa = (u16*)(p.ws + S_A);
  for (int t = blockIdx.x; t < 65 * 8; t += gridDim.x) {
    const int mt = t >> 3, j = t & 7;
    const int m0 = mt * 256, n0 = (j & 3) * 256;
    const bool isw = j < 4;
    gemm_tile256(isw ? WH : AH, 64, wt + (isw ? WT_W2 : WT_A2), 64, 64, m0, n0, lds, mt == 64, [&](EPI_ARGS) {
      const float* b0 = isw ? p.rw_w0 : p.rw_a0;
      EPI_FOREACH(acc, if (row < MROWS) {
        const float4 b4 = *(const float4*)(b0 + col0);
        const float s0 = sigmoidf_(v[0] + b4.x), s1 = sigmoidf_(v[1] + b4.y), s2 = sigmoidf_(v[2] + b4.z), s3 = sigmoidf_(v[3] + b4.w);
        if (isw) {
          const float c = 0.6065306597126334f;
          uint2 o;
          o.x = (unsigned)f2h(c * s0) | ((unsigned)f2h(c * s1) << 16);
          o.y = (unsigned)f2h(c * s2) | ((unsigned)f2h(c * s3) << 16);
          *(uint2*)(EW + (size_t)row * 1024 + col0) = o;
        } else {
          uint2 o;
          o.x = pack2(s0, s1);
          o.y = pack2(s2, s3);
          *(uint2*)(Aa + (size_t)row * 1024 + col0) = o;
        }
      })
    });
  }
}

__device__ __forceinline__ float fma_(float a, float b, float c) {
  float r;
  asm("v_fma_f32 %0, %1, %2, %3" : "=v"(r) : "v"(a), "v"(b), "v"(c));
  return r;
}
__device__ __forceinline__ float mul_(float a, float b) {
  float r;
  asm("v_mul_f32 %0, %1, %2" : "=v"(r) : "v"(a), "v"(b));
  return r;
}

constexpr int PAIR_TS = 624;
constexpr int PAIR_BUF = 8 * PAIR_TS;

__device__ __forceinline__ void phase_scan(const Params& p, char* lds) {
  const int tid = threadIdx.x, lane = tid & 63, w = tid >> 6;
  const u16* R = (const u16*)(p.ws + S_R);
  const u16* Kk = (const u16*)(p.ws + S_K);
  const u16* V = (const u16*)(p.ws + S_V);
  const u16* EW = (const u16*)(p.ws + S_EW);
  const u16* Aa = (const u16*)(p.ws + S_A);
  u16* Y = (u16*)(p.ws + WS_H);
  float* RK = (float*)(p.ws + WS_RK);
  float* ring = (float*)lds;
  float* ybuf = (float*)(lds + 2 * PAIR_BUF * 4);
  for (int item = blockIdx.x; item < 256; item += gridDim.x) {
    const int chain = item >> 2, qr = item & 3, b = chain >> 4, h = chain & 15;
    const size_t rowbase = (size_t)b * 4096;
    __syncthreads();
    if (tid >= 256) {
      const int pt = tid - 256, grp = pt >> 7, pair = (pt & 127) >> 4, cq = pt & 15;
      const int ch = h * 64 + cq * 4;
      const float4 kk4 = *(const float4*)(p.rw_kk + ch), ka4 = *(const float4*)(p.rw_ka + ch), rk4 = *(const float4*)(p.rw_rk + ch);
      struct PS {
        uint2 rr[2], rk_[2], rv[2], ra_[2], re[2];
      };
      PS S0, S1;
      auto pload = [&](PS& S, int c) __attribute__((always_inline)) {
#pragma unroll
        for (int q = 0; q < 2; ++q) {
          const size_t off = (rowbase + (size_t)c * 16 + pair * 2 + q) * 1024 + ch;
          S.rr[q] = *(const uint2*)(R + off);
          S.rk_[q] = *(const uint2*)(Kk + off);
          S.rv[q] = *(const uint2*)(V + off);
          S.ra_[q] = *(const uint2*)(Aa + off);
          S.re[q] = *(const uint2*)(EW + off);
        }
      };
      auto pproc = [&](PS& S, int c) __attribute__((always_inline)) {
        const float kkw[4] = {kk4.x, kk4.y, kk4.z, kk4.w}, kaw[4] = {ka4.x, ka4.y, ka4.z, ka4.w}, rkw[4] = {rk4.x, rk4.y, rk4.z, rk4.w};
        float am[2][4], dc[2][4], bm[2][4], kp[2][4], rf[2][4], vf[2][4];
#pragma unroll
        for (int q = 0; q < 2; ++q) {
          const uint2 rr = S.rr[q], rk_ = S.rk_[q], rv = S.rv[q], ra_ = S.ra_[q], re = S.re[q];
          const float rfx[4] = {bflo(rr.x), bfhi(rr.x), bflo(rr.y), bfhi(rr.y)};
          const float kf[4] = {bflo(rk_.x), bfhi(rk_.x), bflo(rk_.y), bfhi(rk_.y)};
          const float vfx[4] = {bflo(rv.x), bfhi(rv.x), bflo(rv.y), bfhi(rv.y)};
          const float af[4] = {bflo(ra_.x), bfhi(ra_.x), bflo(ra_.y), bfhi(ra_.y)};
          const float ef[4] = {h2f((u16)(re.x & 0xffff)), h2f((u16)(re.x >> 16)), h2f((u16)(re.y & 0xffff)), h2f((u16)(re.y >> 16))};
          float kkr[4], ss = 0.f, rks = 0.f;
#pragma unroll
          for (int j = 0; j < 4; ++j) {
            kkr[j] = kf[j] * kkw[j];
            ss += kkr[j] * kkr[j];
            kp[q][j] = kf[j] * (1.f + (af[j] - 1.f) * kaw[j]);
            rks += rfx[j] * kp[q][j] * rkw[j];
            rf[q][j] = rfx[j];
            vf[q][j] = vfx[j];
          }
          ss = rowsum16(ss);
          rks = rowsum16(rks);
          const float inv = 1.f / fmaxf(sqrtf(ss), 1e-12f);
#pragma unroll
          for (int j = 0; j < 4; ++j) {
            am[q][j] = -kkr[j] * inv;
            dc[q][j] = __expf(-ef[j]);
            bm[q][j] = kkr[j] * inv * af[j];
          }
          if (cq == 0 && qr == 0) RK[(rowbase + (size_t)c * 16 + pair * 2 + q) * 16 + h] = rks;
        }
        float aw[4], w12[4], b1w[4], k1w[4], wr1[4], wr2[4];
        float cba = 0.f, cka = 0.f, br1 = 0.f, kr1 = 0.f, br12 = 0.f, kr12 = 0.f, br2 = 0.f, kr2 = 0.f;
#pragma unroll
        for (int j = 0; j < 4; ++j) {
          aw[j] = dc[0][j] * am[1][j];
          w12[j] = dc[0][j] * dc[1][j];
          b1w[j] = bm[0][j] * dc[1][j];
          k1w[j] = kp[0][j] * dc[1][j];
          wr1[j] = dc[0][j] * rf[0][j];
          wr2[j] = w12[j] * rf[1][j];
          cba += bm[0][j] * am[1][j];
          cka += kp[0][j] * am[1][j];
          br1 += bm[0][j] * rf[0][j];
          kr1 += kp[0][j] * rf[0][j];
          br12 += b1w[j] * rf[1][j];
          kr12 += k1w[j] * rf[1][j];
          br2 += bm[1][j] * rf[1][j];
          kr2 += kp[1][j] * rf[1][j];
        }
        cba = rowsum16(cba);
        cka = rowsum16(cka);
        br1 = rowsum16(br1);
        kr1 = rowsum16(kr1);
        br12 = rowsum16(br12);
        kr12 = rowsum16(kr12);
        br2 = rowsum16(br2);
        kr2 = rowsum16(kr2);
        float* slot = ring + (c & 1) * PAIR_BUF + pair * PAIR_TS;
        *(float4*)(slot + cq * 4) = make_float4(am[0][0], am[0][1], am[0][2], am[0][3]);
        *(float4*)(slot + 64 + cq * 4) = make_float4(aw[0], aw[1], aw[2], aw[3]);
        *(float4*)(slot + 128 + cq * 4) = make_float4(w12[0], w12[1], w12[2], w12[3]);
        *(float4*)(slot + 192 + cq * 4) = make_float4(b1w[0], b1w[1], b1w[2], b1w[3]);
        *(float4*)(slot + 256 + cq * 4) = make_float4(k1w[0], k1w[1], k1w[2], k1w[3]);
        *(float4*)(slot + 320 + cq * 4) = make_float4(bm[1][0], bm[1][1], bm[1][2], bm[1][3]);
        *(float4*)(slot + 384 + cq * 4) = make_float4(kp[1][0], kp[1][1], kp[1][2], kp[1][3]);
        *(float4*)(slot + 448 + cq * 4) = make_float4(wr1[0], wr1[1], wr1[2], wr1[3]);
        *(float4*)(slot + 512 + cq * 4) = make_float4(wr2[0], wr2[1], wr2[2], wr2[3]);
        if ((cq >> 2) == qr) {
          *(float4*)(slot + 576 + (cq & 3) * 4) = make_float4(vf[0][0], vf[0][1], vf[0][2], vf[0][3]);
          *(float4*)(slot + 592 + (cq & 3) * 4) = make_float4(vf[1][0], vf[1][1], vf[1][2], vf[1][3]);
        }
        if (cq == 0) {
          *(float4*)(slot + 608) = make_float4(cba, cka, br1, kr1);
          *(float4*)(slot + 612) = make_float4(br12, kr12, br2, kr2);
        }
      };
      if (grp == 0) {
        pload(S0, 0);
        pproc(S0, 0);
        pload(S1, 2);
        pload(S0, 4);
      } else {
        pload(S0, 1);
        pload(S1, 3);
      }
      BAR_SYNC();
#pragma unroll 1
      for (int c = 0; c < 256; c += 4) {
        if (grp == 1) {
          pproc(S0, c + 1);
          if (c + 5 < 256) pload(S0, c + 5);
        }
        BAR_SYNC();
        if (grp == 0) {
          pproc(S1, c + 2);
          if (c + 6 < 256) pload(S1, c + 6);
        }
        BAR_SYNC();
        if (grp == 1) {
          pproc(S1, c + 3);
          if (c + 7 < 256) pload(S1, c + 7);
        }
        BAR_SYNC();
        if (grp == 0) {
          if (c + 4 < 256) pproc(S0, c + 4);
          if (c + 8 < 256) pload(S0, c + 8);
        }
        BAR_SYNC();
      }
    } else {
      const int rl = tid >> 4, cgp = tid & 15;
      float s0 = 0.f, s1 = 0.f, s2 = 0.f, s3 = 0.f;
      BAR_SYNC();
      for (int c = 0; c < 256; ++c) {
        if (c > 0) {
          const float4* yp = (const float4*)(ybuf + ((c - 1) & 1) * 4096 + tid * 16);
          const float4 y0 = yp[0], y1 = yp[1], y2 = yp[2], y3 = yp[3];
          const float yv = ((y0.x + y0.y) + (y0.z + y0.w)) + ((y1.x + y1.y) + (y1.z + y1.w)) + ((y2.x + y2.y) + (y2.z + y2.w)) + ((y3.x + y3.y) + (y3.z + y3.w));
          Y[(rowbase + (size_t)(c - 1) * 16 + rl) * LDH + h * 64 + qr * 16 + cgp] = f2bf(yv);
        }
        const float* bufp = ring + (c & 1) * PAIR_BUF;
        float* yb = ybuf + (c & 1) * 4096;
        struct PV {
          float4 a1, aw, w12, b1w, k1w, b2, k2, wr1, wr2, sc0, sc1;
          float v1, v2;
        };
        auto ldpair = [&](const float* slot) __attribute__((always_inline)) {
          PV r;
          r.a1 = *(const float4*)(slot + cgp * 4);
          r.aw = *(const float4*)(slot + 64 + cgp * 4);
          r.w12 = *(const float4*)(slot + 128 + cgp * 4);
          r.b1w = *(const float4*)(slot + 192 + cgp * 4);
          r.k1w = *(const float4*)(slot + 256 + cgp * 4);
          r.b2 = *(const float4*)(slot + 320 + cgp * 4);
          r.k2 = *(const float4*)(slot + 384 + cgp * 4);
          r.wr1 = *(const float4*)(slot + 448 + cgp * 4);
          r.wr2 = *(const float4*)(slot + 512 + cgp * 4);
          r.v1 = slot[576 + rl];
          r.v2 = slot[592 + rl];
          r.sc0 = *(const float4*)(slot + 608);
          r.sc1 = *(const float4*)(slot + 612);
          return r;
        };
        PV cur = ldpair(bufp);
#pragma unroll
        for (int pr = 0; pr < 8; ++pr) {
          PV nxt = cur;
          if (pr + 1 < 8) nxt = ldpair(bufp + (pr + 1) * PAIR_TS);
          float d1 = fma_(s3, cur.a1.w, fma_(s2, cur.a1.z, fma_(s1, cur.a1.y, mul_(s0, cur.a1.x))));
          float d2 = fma_(s3, cur.aw.w, fma_(s2, cur.aw.z, fma_(s1, cur.aw.y, mul_(s0, cur.aw.x))));
          const float e1 = fma_(s3, cur.wr1.w, fma_(s2, cur.wr1.z, fma_(s1, cur.wr1.y, mul_(s0, cur.wr1.x))));
          const float e2 = fma_(s3, cur.wr2.w, fma_(s2, cur.wr2.z, fma_(s1, cur.wr2.y, mul_(s0, cur.wr2.x))));
          const float t0 = fma_(cur.v2, cur.k2.x, fma_(cur.v1, cur.k1w.x, mul_(s0, cur.w12.x)));
          const float t1 = fma_(cur.v2, cur.k2.y, fma_(cur.v1, cur.k1w.y, mul_(s1, cur.w12.y)));
          const float t2 = fma_(cur.v2, cur.k2.z, fma_(cur.v1, cur.k1w.z, mul_(s2, cur.w12.z)));
          const float t3 = fma_(cur.v2, cur.k2.w, fma_(cur.v1, cur.k1w.w, mul_(s3, cur.w12.w)));
          d1 = rowsum16(d1);
          d2 = rowsum16(d2);
          const float sa1 = d1;
          const float sa2 = fma_(cur.v1, cur.sc0.y, fma_(sa1, cur.sc0.x, d2));
          s0 = fma_(sa2, cur.b2.x, fma_(sa1, cur.b1w.x, t0));
          s1 = fma_(sa2, cur.b2.y, fma_(sa1, cur.b1w.y, t1));
          s2 = fma_(sa2, cur.b2.z, fma_(sa1, cur.b1w.z, t2));
          s3 = fma_(sa2, cur.b2.w, fma_(sa1, cur.b1w.w, t3));
          yb[(2 * pr) * 256 + tid] = e1 + 0.0625f * (sa1 * cur.sc0.z + cur.v1 * cur.sc0.w);
          yb[(2 * pr + 1) * 256 + tid] = e2 + 0.0625f * (sa1 * cur.sc1.x + cur.v1 * cur.sc1.y + sa2 * cur.sc1.z + cur.v2 * cur.sc1.w);
          cur = nxt;
        }
        BAR_SYNC();
      }
      {
        const float4* yp = (const float4*)(ybuf + (255 & 1) * 4096 + tid * 16);
        const float4 y0 = yp[0], y1 = yp[1], y2 = yp[2], y3 = yp[3];
        const float yv = ((y0.x + y0.y) + (y0.z + y0.w)) + ((y1.x + y1.y) + (y1.z + y1.w)) + ((y2.x + y2.y) + (y2.z + y2.w)) + ((y3.x + y3.y) + (y3.z + y3.w));
        Y[(rowbase + (size_t)255 * 16 + rl) * LDH + h * 64 + qr * 16 + cgp] = f2bf(yv);
      }
      float* wo = p.out + O_WKVP + (((size_t)(b * 16 + h) * 64) + qr * 16 + rl) * 64 + cgp * 4;
      *(float4*)wo = make_float4(s0, s1, s2, s3);
    }
  }
  float* sl = (float*)lds;
  for (int chain = blockIdx.x; chain < 2048; chain += gridDim.x) {
    const int b = chain >> 4, h = chain & 15;
    const size_t row = (size_t)NP + b;
    __syncthreads();
    if (w == 0) {
      const int ch = h * 64 + lane;
      const size_t off = row * 1024 + ch;
      const float rf = bf2f(R[off]), kf = bf2f(Kk[off]), vf = bf2f(V[off]), af = bf2f(Aa[off]), ef = h2f(EW[off]);
      const float kkr = kf * p.rw_kk[ch];
      const float ss = wavesum(kkr * kkr);
      const float inv = 1.f / fmaxf(sqrtf(ss), 1e-12f);
      const float kp = kf * (1.f + (af - 1.f) * p.rw_ka[ch]);
      const float rks = wavesum(rf * kp * p.rw_rk[ch]);
      sl[lane] = -kkr * inv;
      sl[64 + lane] = __expf(-ef);
      sl[128 + lane] = kkr * inv * af;
      sl[192 + lane] = kp;
      sl[256 + lane] = rf;
      sl[320 + lane] = vf;
      if (lane == 0) RK[row * 16 + h] = rks;
    }
    __syncthreads();
    const int i = tid >> 3, c8 = tid & 7;
    const float* sp = p.state_wkv + (((size_t)(b * 16 + h) * 64) + i) * 64 + c8 * 8;
    float4 sA = *(const float4*)sp, sB = *(const float4*)(sp + 4);
    float s[8] = {sA.x, sA.y, sA.z, sA.w, sB.x, sB.y, sB.z, sB.w};
    float sa = 0.f;
#pragma unroll
    for (int j = 0; j < 8; ++j) sa += s[j] * sl[c8 * 8 + j];
    sa += __shfl_xor(sa, 1);
    sa += __shfl_xor(sa, 2);
    sa += __shfl_xor(sa, 4);
    const float vv = sl[320 + i];
    float y = 0.f;
#pragma unroll
    for (int j = 0; j < 8; ++j) {
      const int cj = c8 * 8 + j;
      s[j] = s[j] * sl[64 + cj] + sa * sl[128 + cj] + vv * sl[192 + cj];
      y += s[j] * sl[256 + cj];
    }
    y += __shfl_xor(y, 1);
    y += __shfl_xor(y, 2);
    y += __shfl_xor(y, 4);
    float* wo = p.out + O_WKVS + (((size_t)(b * 16 + h) * 64) + i) * 64 + c8 * 8;
    *(float4*)wo = make_float4(s[0], s[1], s[2], s[3]);
    *(float4*)(wo + 4) = make_float4(s[4], s[5], s[6], s[7]);
    if (c8 == 0) Y[row * LDH + h * 64 + i] = f2bf(y);
  }
}

__device__ __forceinline__ void phase_gate(const Params& p, char* lds) {
  const u16* wt = (const u16*)(p.ws + WS_WT);
  const u16* GH = (const u16*)(p.ws + S_GH);
  const u16* V = (const u16*)(p.ws + S_V);
  const float* RK = (const float*)(p.ws + WS_RK);
  u16* Y = (u16*)(p.ws + WS_H);
  for (int t = blockIdx.x; t < 65 * 4; t += gridDim.x) {
    const int mt = t >> 2, nt = t & 3;
    const int m0 = mt * 256, n0 = nt * 256;
    gemm_tile256(GH, 128, wt + WT_G2, 128, 128, m0, n0, lds, mt == 64, [&](EPI_ARGS) {
      const int hh = (n0 + wn * 64) >> 6;
#pragma unroll
      for (int mi = 0; mi < 8; ++mi) {
        const int row = m0 + wm * 128 + mi * 16 + lr;
        const int rowc = row < MROWS ? row : MROWS - 1;
        float yv[4][4];
        float sum = 0.f;
#pragma unroll
        for (int ni = 0; ni < 4; ++ni) {
          const uint2 yy = *(const uint2*)(Y + (size_t)rowc * LDH + hh * 64 + ni * 16 + lg * 4);
          yv[ni][0] = bflo(yy.x); yv[ni][1] = bfhi(yy.x); yv[ni][2] = bflo(yy.y); yv[ni][3] = bfhi(yy.y);
          sum += yv[ni][0] + yv[ni][1] + yv[ni][2] + yv[ni][3];
        }
        sum += __shfl_xor(sum, 16);
        sum += __shfl_xor(sum, 32);
        const float mu = sum * (1.f / 64.f);
        float vs = 0.f;
#pragma unroll
        for (int ni = 0; ni < 4; ++ni)
#pragma unroll
          for (int q = 0; q < 4; ++q) {
            const float d = yv[ni][q] - mu;
            vs += d * d;
          }
        vs += __shfl_xor(vs, 16);
        vs += __shfl_xor(vs, 32);
        const float rstd = rsqrtf(vs * (1.f / 64.f) + 64e-5f);
        const float rk = RK[(size_t)rowc * 16 + hh];
#pragma unroll
        for (int ni = 0; ni < 4; ++ni) {
          const int col0 = hh * 64 + ni * 16 + lg * 4;
          const uint2 vv = *(const uint2*)(V + (size_t)rowc * 1024 + col0);
          const float vf[4] = {bflo(vv.x), bfhi(vv.x), bflo(vv.y), bfhi(vv.y)};
          const float4 g4 = *(const float4*)(p.rw_lnx_g + col0), b4 = *(const float4*)(p.rw_lnx_b + col0);
          const float gg[4] = {g4.x, g4.y, g4.z, g4.w}, bb[4] = {b4.x, b4.y, b4.z, b4.w};
          f32x4 o;
#pragma unroll
          for (int q = 0; q < 4; ++q) o[q] = ((yv[ni][q] - mu) * rstd * gg[q] + bb[q] + rk * vf[q]) * acc[mi][ni][q];
          if (row < MROWS) *(uint2*)(Y + (size_t)row * LDH + col0) = pack4(o);
        }
        __builtin_amdgcn_sched_barrier(0);
      }
    });
  }
}

__device__ __forceinline__ void phase_oproj(const Params& p, char* lds, const u16* A, int K, const u16* Bt, int layer, int gidx, bool first) {
  const int ldab = K == 1024 ? LDH : LDU;
  const float* mod = (const float*)(p.ws + WS_MOD);
  for (int u = blockIdx.x; u < 320; u += gridDim.x) {
    const bool split = u >= 256;
    const int s = u - 256;
    const int m0 = split ? NP : (u >> 2) * 256, n0 = (split ? (s & 3) : (u & 3)) * 256;
    const int klen = split ? (K >> 4) : K, kbeg = split ? (s >> 2) * klen : 0;
    gemm_tile256(A + kbeg, ldab, Bt + kbeg, ldab, klen, m0, n0, lds, split, [&](EPI_ARGS) {
      EPI_FOREACH(acc, if (row < MROWS) {
        const float4 gt = *(const float4*)(mod + ((size_t)layer * 132 + bidx_of(row)) * 6144 + gidx * 1024 + col0);
        float* xp = p.out + (size_t)row * 1024 + col0;
        if (split) {
          unsafeAtomicAdd(xp + 0, gt.x * v[0]);
          unsafeAtomicAdd(xp + 1, gt.y * v[1]);
          unsafeAtomicAdd(xp + 2, gt.z * v[2]);
          unsafeAtomicAdd(xp + 3, gt.w * v[3]);
        } else {
          const float* xi = first ? p.x_prompt + (size_t)row * 1024 + col0 : xp;
          const float4 xo = *(const float4*)xi;
          *(float4*)xp = make_float4(xo.x + gt.x * v[0], xo.y + gt.y * v[1], xo.z + gt.z * v[2], xo.w + gt.w * v[3]);
        }
      })
    });
  }
}

__device__ __forceinline__ void phase_up(const Params& p, char* lds, const u16* Bt) {
  const u16* H = (const u16*)(p.ws + WS_H);
  u16* UP = (u16*)(p.ws + S_UP);
  for (int t = blockIdx.x; t < 65 * 16; t += gridDim.x) {
    const int mt = t >> 4, nt = t & 15;
    const int m0 = mt * 256, n0 = nt * 256;
    gemm_tile256(H, LDH, Bt, LDH, 1024, m0, n0, lds, mt == 64, [&](EPI_ARGS) {
      EPI_FOREACH(acc, if (row < MROWS) {
        f32x4 o;
        _Pragma("unroll") for (int q = 0; q < 4; ++q) {
          const float rl = fmaxf(v[q], 0.f);
          o[q] = rl * rl;
        }
        *(uint2*)(UP + (size_t)row * LDU + col0) = pack4(o);
      })
    });
  }
}

__device__ __forceinline__ void phase_qkv(const Params& p, char* lds) {
  const u16* H = (const u16*)(p.ws + WS_H);
  const u16* wt = (const u16*)(p.ws + WS_WT);
  const float* tab = (const float*)(p.ws + WS_TAB);
  u16* Qb = (u16*)(p.ws + S_Q);
  u16* Kb = (u16*)(p.ws + S_KB);
  u16* Vt = (u16*)(p.ws + S_VT);
  for (int t = blockIdx.x; t < 65 * 6; t += gridDim.x) {
    const int mt = t / 6, nt = t % 6;
    const int m0 = mt * 256, n0 = nt * 256;
    gemm_tile256(H, LDH, wt + WT_QKV, LDH, 1024, m0, n0, lds, mt == 64, [&](EPI_ARGS) {
      const int hc0 = n0 + wn * 64;
#pragma unroll
      for (int mi = 0; mi < 8; ++mi) {
        const int row = m0 + wm * 128 + mi * 16 + lr;
        const bool valid = row < MROWS;
        const bool isp = row < NP;
        const int pos = row & 4095;
        const int bq = isp ? (row >> 12) : (row - NP);
        const int posidx = isp ? pos : 4096;
#pragma unroll
        for (int ni = 0; ni < 4; ++ni) {
          const int col0 = hc0 + ni * 16 + lg * 4;
          const float4 b4 = *(const float4*)(p.at_bqkv + col0);
          f32x4 v = acc[mi][ni];
          v[0] += b4.x; v[1] += b4.y; v[2] += b4.z; v[3] += b4.w;
          if (ni == 0 && hc0 < 1280) {
            const float* tp = tab + (size_t)posidx * 16 + (lg & 1) * 8;
            const float4 t0 = *(const float4*)tp, t1 = *(const float4*)(tp + 4);
            const float cs[4] = {t0.x, t0.z, t1.x, t1.z}, sn[4] = {t0.y, t0.w, t1.y, t1.w};
#pragma unroll
            for (int q = 0; q < 4; ++q) {
              const float pv = __shfl_xor(v[q], 32);
              v[q] = (lg < 2) ? (v[q] * cs[q] - pv * sn[q]) : (v[q] * cs[q] + pv * sn[q]);
            }
          }
          if (valid) {
            if (hc0 < 1024) {
              *(uint2*)(Qb + (size_t)row * 1024 + col0) = pack4(v);
            } else if (hc0 < 1280) {
              const int c2 = col0 - 1024;
              *(uint2*)(Kb + (size_t)row * 256 + c2) = pack4(v);
              if (isp) {
                if (pos >= 3968) *(float4*)(p.out + O_KP + ((size_t)(bq * 128 + pos - 3968)) * 256 + c2) = make_float4(v[0], v[1], v[2], v[3]);
              } else {
                *(float4*)(p.out + O_KS + ((size_t)(bq * 128 + 127)) * 256 + c2) = make_float4(v[0], v[1], v[2], v[3]);
              }
            } else {
              const int c3 = col0 - 1280;
              if (isp) {
                u16* vp = Vt + ((size_t)(bq * 4 + (c3 >> 6)) * 64 + (c3 & 63)) * 4096 + pos;
#pragma unroll
                for (int q = 0; q < 4; ++q) vp[(size_t)q * 4096] = f2bf(v[q]);
                if (pos >= 3968) *(float4*)(p.out + O_VP + ((size_t)(bq * 128 + pos - 3968)) * 256 + c3) = make_float4(v[0], v[1], v[2], v[3]);
              } else {
                *(float4*)(p.out + O_VS + ((size_t)(bq * 128 + 127)) * 256 + c3) = make_float4(v[0], v[1], v[2], v[3]);
              }
            }
          }
        }
        __builtin_amdgcn_sched_barrier(0);
      }
    });
  }
}

constexpr int AT_KS = 0, AT_VS = 36864, AT_PS = 36864 + 35840, AT_PW = 5376;

__device__ __forceinline__ void phase_attn(const Params& p, char* lds) {
  const int tid = threadIdx.x, lane = tid & 63, w = tid >> 6, lr = lane & 15, lg = lane >> 4;
  const u16* Qb = (const u16*)(p.ws + S_Q);
  const u16* Kb = (const u16*)(p.ws + S_KB);
  const u16* Vt = (const u16*)(p.ws + S_VT);
  u16* O = (u16*)(p.ws + S_O);
  char* Ks = lds + AT_KS;
  char* Vs = lds + AT_VS;
  char* Ps = lds + AT_PS + w * AT_PW;
  for (int u = blockIdx.x; u < 512; u += gridDim.x) {
    const int b = u >> 7, n = (u >> 2) & 31, kvh = u & 3;
    bf16x8 qfa[4][2];
    {
      const int g_ = w >> 1, hf_ = w & 1, qh_ = kvh * 4 + g_;
#pragma unroll
      for (int i = 0; i < 4; ++i) {
        const size_t tok = (size_t)b * 4096 + n * 128 + hf_ * 64 + i * 16 + lr;
        qfa[i][0] = *(const bf16x8*)(Qb + tok * 1024 + qh_ * 64 + lg * 8);
        qfa[i][1] = *(const bf16x8*)(Qb + tok * 1024 + qh_ * 64 + 32 + lg * 8);
      }
    }
    __syncthreads();
#pragma unroll
    for (int i = 0; i < 4; ++i) {
      const int c = tid + 512 * i;
      {
        const int key = c >> 3, kc = c & 7;
        const int pos = n * 128 - 128 + key;
        uint4 v = {0u, 0u, 0u, 0u};
        if (pos >= 0) v = *(const uint4*)(Kb + ((size_t)b * 4096 + pos) * 256 + kvh * 64 + kc * 8);
        *(uint4*)(Ks + key * 144 + kc * 16) = v;
      }
      {
        const int d = c >> 5, kc = c & 31;
        const int pos0 = n * 128 - 128 + kc * 8;
        uint4 v = {0u, 0u, 0u, 0u};
        if (pos0 >= 0) v = *(const uint4*)(Vt + ((size_t)(b * 4 + kvh) * 64 + d) * 4096 + pos0);
        *(uint4*)(Vs + d * 560 + kc * 16) = v;
      }
    }
    if (tid < 192) {
      const int d = tid / 3, c = tid % 3;
      *(uint4*)(Vs + d * 560 + 512 + c * 16) = uint4{0u, 0u, 0u, 0u};
    }
    {
      const int prow = lane >> 2, pc = 144 + (lane & 3) * 4;
      *(uint2*)(Ps + prow * 336 + pc * 2) = uint2{0u, 0u};
    }
    __syncthreads();
    const int g = w >> 1, hf = w & 1;
    const int qh = kvh * 4 + g;
    const float sink = p.at_sink[qh];
#pragma unroll
    for (int i = 0; i < 4; ++i) {
      const int q0 = hf * 64 + i * 16;
      const bf16x8 qf0 = qfa[i][0];
      const bf16x8 qf1 = qfa[i][1];
      f32x4 s[9];
#pragma unroll
      for (int j = 0; j < 9; ++j) {
        const char* kp = Ks + (q0 + j * 16 + lr) * 144 + lg * 16;
        const bf16x8 k0 = *(const bf16x8*)kp;
        const bf16x8 k1 = *(const bf16x8*)(kp + 64);
        f32x4 z = {0.f, 0.f, 0.f, 0.f};
        z = __builtin_amdgcn_mfma_f32_16x16x32_bf16(qf0, k0, z, 0, 0, 0);
        z = __builtin_amdgcn_mfma_f32_16x16x32_bf16(qf1, k1, z, 0, 0, 0);
        s[j] = z;
      }
      float mx[4], sum[4];
#pragma unroll
      for (int r = 0; r < 4; ++r) {
        const int ql = lg * 4 + r;
        float m = sink;
#pragma unroll
        for (int j = 0; j < 9; ++j) {
          float v = s[j][r] * 0.125f;
          bool ok = true;
          if (j == 0) ok = (lr >= ql);
          if (j == 8) ok = (lr <= ql);
          if (n == 0 && (q0 + j * 16 + lr) < 128) ok = false;
          v = ok ? v : -INFINITY;
          s[j][r] = v;
          m = fmaxf(m, v);
        }
        mx[r] = rowmax16(m);
      }
#pragma unroll
      for (int r = 0; r < 4; ++r) {
        float sm = 0.f;
#pragma unroll
        for (int j = 0; j < 9; ++j) {
          const float e = __expf(s[j][r] - mx[r]);
          s[j][r] = e;
          sm += e;
        }
        sm = rowsum16(sm);
        sum[r] = sm + __expf(sink - mx[r]);
      }
      u16* P = (u16*)Ps;
#pragma unroll
      for (int j = 0; j < 9; ++j)
#pragma unroll
        for (int r = 0; r < 4; ++r) P[(lg * 4 + r) * 168 + j * 16 + lr] = f2bf(s[j][r]);
      __builtin_amdgcn_wave_barrier();
      f32x4 o[4];
#pragma unroll
      for (int nd = 0; nd < 4; ++nd) o[nd] = f32x4{0.f, 0.f, 0.f, 0.f};
#pragma unroll
      for (int kk = 0; kk < 5; ++kk) {
        const bf16x8 pf = *(const bf16x8*)(Ps + lr * 336 + kk * 64 + lg * 16);
#pragma unroll
        for (int nd = 0; nd < 4; ++nd) {
          const bf16x8 vf = *(const bf16x8*)(Vs + (nd * 16 + lr) * 560 + (q0 + kk * 32 + lg * 8) * 2);
          o[nd] = __builtin_amdgcn_mfma_f32_16x16x32_bf16(pf, vf, o[nd], 0, 0, 0);
        }
      }
#pragma unroll
      for (int nd = 0; nd < 4; ++nd)
#pragma unroll
        for (int r = 0; r < 4; ++r) {
          const float v = o[nd][r] / sum[r];
          O[((size_t)b * 4096 + n * 128 + q0 + lg * 4 + r) * LDH + qh * 64 + nd * 16 + lr] = f2bf(v);
        }
      __builtin_amdgcn_wave_barrier();
    }
  }
  float* qs = (float*)lds;
  float* sc = (float*)(lds + 1024);
  float* part = (float*)(lds + 1024 + 2112);
  for (int it = blockIdx.x; it < 512; it += gridDim.x) {
    const int b = it >> 2, kvh = it & 3;
    const size_t row = (size_t)NP + b;
    __syncthreads();
    if (tid < 256) qs[tid] = bf2f(Qb[row * 1024 + kvh * 256 + tid]);
    __syncthreads();
    {
      const int key = tid >> 2, g = tid & 3;
      const float* kp = p.cache_k + (((size_t)b * 128 + key) * 4 + kvh) * 64;
      float dot = 0.f;
#pragma unroll
      for (int d4 = 0; d4 < 16; ++d4) {
        const float4 kv = *(const float4*)(kp + d4 * 4);
        const float* q = qs + g * 64 + d4 * 4;
        dot += kv.x * q[0] + kv.y * q[1] + kv.z * q[2] + kv.w * q[3];
      }
      sc[g * 132 + key] = dot * 0.125f;
      if (key >= 1) {
        float* dst = p.out + O_KS + (((size_t)b * 128 + key - 1) * 4 + kvh) * 64 + g * 16;
        const float* src = kp + g * 16;
#pragma unroll
        for (int d4 = 0; d4 < 4; ++d4) *(float4*)(dst + d4 * 4) = *(const float4*)(src + d4 * 4);
      }
      if (tid < 4) {
        const float* kn = p.out + O_KS + (((size_t)b * 128 + 127) * 4 + kvh) * 64;
        float d2 = 0.f;
        for (int d = 0; d < 64; ++d) d2 += kn[d] * qs[tid * 64 + d];
        sc[tid * 132 + 128] = d2 * 0.125f;
      }
    }
    __syncthreads();
    if (w < 4) {
      const float sink = p.at_sink[kvh * 4 + w];
      float* s = sc + w * 132;
      const float v0 = s[lane], v1 = s[64 + lane], v2 = lane == 0 ? s[128] : -INFINITY;
      float m = fmaxf(fmaxf(v0, v1), fmaxf(v2, sink));
      m = wavemax(m);
      const float e0 = __expf(v0 - m), e1 = __expf(v1 - m), e2 = lane == 0 ? __expf(v2 - m) : 0.f;
      float sm = wavesum(e0 + e1 + e2) + __expf(sink - m);
      const float inv = 1.f / sm;
      s[lane] = e0 * inv;
      s[64 + lane] = e1 * inv;
      if (lane == 0) s[128] = e2 * inv;
    }
    __syncthreads();
    {
      const int d = tid & 63, g = (tid >> 6) & 3, half = tid >> 8;
      const float* vp = p.cache_v + (((size_t)b * 128) * 4 + kvh) * 64 + d;
      float accv = 0.f;
      for (int key = half * 64; key < half * 64 + 64; ++key) {
        const float vv = vp[(size_t)key * 256];
        accv += sc[g * 132 + key] * vv;
        if (g == 0 && key >= 1) p.out[O_VS + (((size_t)b * 128 + key - 1) * 4 + kvh) * 64 + d] = vv;
      }
      if (half == 1) accv += sc[g * 132 + 128] * p.out[O_VS + (((size_t)b * 128 + 127) * 4 + kvh) * 64 + d];
      part[(half * 4 + g) * 64 + d] = accv;
    }
    __syncthreads();
    if (tid < 256) {
      const int d = tid & 63, g = tid >> 6;
      O[row * LDH + (kvh * 4 + g) * 64 + d] = f2bf(part[g * 64 + d] + part[(4 + g) * 64 + d]);
    }
  }
}

__global__ void __launch_bounds__(NTHR) mega(Params p) {
  extern __shared__ __attribute__((aligned(16))) char lds[];
  cg::grid_group grid = cg::this_grid();
  volatile LAS unsigned* xst = (volatile LAS unsigned*)(lds + LDS_BYTES);
  if (threadIdx.x == 0) { xst[0] = 0u; xst[1] = 0u; }
  __syncthreads();
  const XcdBarrier xb = xcd_barrier_post((unsigned*)(p.ws + WS_BAR), xst);
  const u16* wt = (const u16*)(p.ws + WS_WT);
  phase0(p, lds);
  if (p.out == nullptr) grid.sync();
  xcd_barrier(xb);
  phase_ada(p, lds);
  xcd_barrier(xb);
  phase_norm_mix(p);
  xcd_barrier(xb);
  phase_rwkv_proj(p, lds);
  xcd_barrier(xb);
  phase_rwkv_lora2(p, lds);
  xcd_barrier(xb);
  phase_scan(p, lds);
  xcd_barrier(xb);
  phase_gate(p, lds);
  xcd_barrier(xb);
  phase_oproj(p, lds, (const u16*)(p.ws + WS_H), 1024, wt + WT_WO, 0, 2, true);
  xcd_barrier(xb);
  phase_norm(p, 0, 1, false, false);
  xcd_barrier(xb);
  phase_up(p, lds, wt + WT_UP0);
  xcd_barrier(xb);
  phase_oproj(p, lds, (const u16*)(p.ws + S_UP), 4096, wt + WT_DN0, 0, 5, false);
  xcd_barrier(xb);
  phase_norm(p, 1, 0, false, false);
  xcd_barrier(xb);
  phase_qkv(p, lds);
  xcd_barrier(xb);
  phase_attn(p, lds);
  xcd_barrier(xb);
  phase_oproj(p, lds, (const u16*)(p.ws + S_O), 1024, wt + WT_WO1, 1, 2, false);
  xcd_barrier(xb);
  phase_norm(p, 1, 1, false, false);
  xcd_barrier(xb);
  phase_up(p, lds, wt + WT_UP1);
  xcd_barrier(xb);
  phase_oproj(p, lds, (const u16*)(p.ws + S_UP), 4096, wt + WT_DN1, 1, 5, false);
  xcd_barrier(xb);
  phase_final(p);
}

extern "C" void kernel_launch(void* const* d_in, const int* in_sizes, int n_in, void* d_out, int out_size, void* d_ws,
                              size_t ws_size, hipStream_t stream) {
  static int grid_blocks = 0;
  if (grid_blocks == 0) {
    if (ws_size < WS_END) {
      fprintf(stderr, "kernel_launch: workspace too small: %zu < %zu\n", ws_size, (size_t)WS_END);
      grid_blocks = -1;
      return;
    }
    int dev = 0, cus = 0, per_cu = 0;
    hipGetDevice(&dev);
    hipDeviceGetAttribute(&cus, hipDeviceAttributeMultiprocessorCount, dev);
    hipFuncSetAttribute((const void*)mega, hipFuncAttributeMaxDynamicSharedMemorySize, LDS_BYTES + 16);
    hipOccupancyMaxActiveBlocksPerMultiprocessor(&per_cu, (const void*)mega, NTHR, LDS_BYTES + 16);
    if (per_cu < 1) per_cu = 1;
    grid_blocks = cus * per_cu;
  }
  if (grid_blocks < 0) return;
  Params p{};
  const float** pp = (const float**)&p;
  for (int i = 0; i < 37; ++i) pp[i] = (const float*)d_in[i];
  p.out = (float*)d_out;
  p.ws = (char*)d_ws;
  hipMemsetAsync((char*)d_ws + WS_BAR, 0, 16384, stream);
  void* args[] = {&p};
  hipError_t e = hipLaunchCooperativeKernel((const void*)mega, dim3(grid_blocks), dim3(NTHR), args, LDS_BYTES + 16, stream);
  if (e != hipSuccess) fprintf(stderr, "cooperative launch failed: %s (grid %d)\n", hipGetErrorString(e), grid_blocks);
}
```

```cpp
#include <hip/hip_runtime.h>
#include <hip/hip_cooperative_groups.h>
#include <cstdio>
namespace cg = cooperative_groups;

typedef unsigned short u16;
typedef __attribute__((ext_vector_type(8))) short bf16x8;
typedef __attribute__((ext_vector_type(4))) float f32x4;

constexpr int NP = 16384, MROWS = 16512, MPAD = 16640;
constexpr int NTHR = 512;
constexpr size_t MEG = 1048576;
constexpr int LDH = 1088, LDU = 4160;

constexpr size_t O_Y = 0, O_WKVP = 16908288, O_WKVS = 17170432, O_SHP = 25559040, O_SHS = 25563136,
                 O_KP = 25694208, O_KS = 25825280, O_VP = 30019584, O_VS = 30150656;

constexpr size_t WT_WR = 0, WT_WK = WT_WR + 1024 * LDH, WT_WV = WT_WK + 1024 * LDH, WT_WO = WT_WV + 1024 * LDH,
                 WT_W1 = WT_WO + 1024 * LDH, WT_A1 = WT_W1 + 64 * LDH, WT_G1 = WT_A1 + 64 * LDH, WT_W2 = WT_G1 + 128 * LDH,
                 WT_A2 = WT_W2 + 65536, WT_G2 = WT_A2 + 65536, WT_UP0 = WT_G2 + 131072, WT_DN0 = WT_UP0 + 4096 * LDH,
                 WT_QKV = WT_DN0 + 1024 * LDU, WT_WO1 = WT_QKV + 1536 * LDH, WT_UP1 = WT_WO1 + 1024 * LDH,
                 WT_DN1 = WT_UP1 + 4096 * LDH, WT_END = WT_DN1 + 1024 * LDU;
constexpr size_t WS_WT = 0;
constexpr size_t WS_H = WS_WT + WT_END * 2;
constexpr size_t WS_ZR = WS_H + (size_t)MPAD * LDH * 2;
constexpr size_t WS_MOD = WS_ZR + (size_t)LDH * 2;
constexpr size_t WS_TAB = WS_MOD + (size_t)2 * 132 * 6144 * 4;
constexpr size_t WS_HS = WS_H + (size_t)MROWS * LDH * 2;
constexpr size_t WS_RK = WS_TAB + (size_t)4097 * 8 * 8;
constexpr size_t WS_BAR = WS_RK + (size_t)MPAD * 16 * 4;
constexpr size_t WS_S = WS_BAR + 16384;
constexpr size_t RSZ = (size_t)MROWS * 1024 * 2;
constexpr size_t S_ADAWT = WS_S, S_SILUC = S_ADAWT + (size_t)2 * 6144 * LDH * 2;
constexpr size_t S_R = WS_S, S_K = S_R + RSZ, S_V = S_K + RSZ, S_EW = S_V + RSZ, S_A = S_EW + RSZ,
                 S_WH = S_A + RSZ, S_AH = S_WH + (size_t)MPAD * 64 * 2, S_GH = S_AH + (size_t)MPAD * 64 * 2,
                 S_RW_END = S_GH + (size_t)MPAD * 128 * 2;
constexpr size_t S_UP = WS_S;
constexpr size_t S_Q = WS_S, S_O = S_Q + (size_t)MPAD * 1024 * 2, S_KB = S_O + (size_t)MPAD * LDH * 2,
                 S_VT = S_KB + (size_t)MPAD * 256 * 2;
constexpr size_t WS_END = S_RW_END;
static_assert(S_UP + (size_t)MPAD * LDU * 2 <= WS_END, "up fits");
static_assert(S_VT + (size_t)16 * 64 * 4096 * 2 <= WS_END, "attn fits");
static_assert(WS_END <= 282000000, "ws fits sum of inputs");

constexpr int LDS_ROW = 144;
constexpr int LDS_A_BYTES = 256 * LDS_ROW;
constexpr int LDS_B_BYTES = 128 * LDS_ROW;
constexpr int LDS_STAGE = LDS_A_BYTES + LDS_B_BYTES;
constexpr int LDS_BYTES = 147456;

struct Params {
  const float *x_prompt, *x_sample, *c_prompt, *c_sample, *state_wkv, *state_shift, *cache_k, *cache_v;
  const float *norm1_g, *norm2_g, *ada_w, *ada_b, *mlp_up, *mlp_down, *final_g;
  const float *rw_mix, *rw_wr, *rw_wk, *rw_wv, *rw_wo, *rw_w0, *rw_w1, *rw_w2, *rw_a0, *rw_a1, *rw_a2, *rw_g1, *rw_g2,
      *rw_kk, *rw_ka, *rw_rk, *rw_lnx_g, *rw_lnx_b;
  const float *at_wqkv, *at_bqkv, *at_wo, *at_sink;
  float* out;
  char* ws;
};

__device__ __forceinline__ u16 f2bf(float f) {
  unsigned u = __float_as_uint(f);
  u += 0x7fffu + ((u >> 16) & 1u);
  return (u16)(u >> 16);
}
__device__ __forceinline__ float bf2f(u16 h) { return __uint_as_float(((unsigned)h) << 16); }
__device__ __forceinline__ float bflo(unsigned w) { return __uint_as_float(w << 16); }
__device__ __forceinline__ float bfhi(unsigned w) { return __uint_as_float(w & 0xffff0000u); }
__device__ __forceinline__ unsigned pack2(float a, float b) {
  unsigned r;
  asm volatile("v_cvt_pk_bf16_f32 %0, %1, %2" : "=v"(r) : "v"(a), "v"(b));
  return r;
}
__device__ __forceinline__ uint2 pack4(f32x4 v) { return uint2{pack2(v[0], v[1]), pack2(v[2], v[3])}; }
__device__ __forceinline__ float h2f(u16 h) { return (float)__builtin_bit_cast(_Float16, h); }
__device__ __forceinline__ u16 f2h(float f) { return __builtin_bit_cast(u16, (_Float16)f); }
__device__ __forceinline__ float sigmoidf_(float x) { return 1.f / (1.f + __expf(-x)); }

template <int CTRL>
__device__ __forceinline__ float dppf(float x) {
  return __int_as_float(__builtin_amdgcn_update_dpp(0, __float_as_int(x), CTRL, 0xf, 0xf, true));
}
__device__ __forceinline__ float rowsum16(float x) {
  x += dppf<0xB1>(x);
  x += dppf<0x4E>(x);
  x += dppf<0x124>(x);
  x += dppf<0x128>(x);
  return x;
}
__device__ __forceinline__ float rowmax16(float x) {
  x = fmaxf(x, dppf<0xB1>(x));
  x = fmaxf(x, dppf<0x4E>(x));
  x = fmaxf(x, dppf<0x124>(x));
  x = fmaxf(x, dppf<0x128>(x));
  return x;
}
__device__ __forceinline__ float wavesum(float x) {
#pragma unroll
  for (int o = 32; o > 0; o >>= 1) x += __shfl_xor(x, o);
  return x;
}
__device__ __forceinline__ float wavemax(float x) {
#pragma unroll
  for (int o = 32; o > 0; o >>= 1) x = fmaxf(x, __shfl_xor(x, o));
  return x;
}
__device__ __forceinline__ int bidx_of(int row) { return row < NP ? (row >> 12) : (4 + row - NP); }

#define XB_TMO      128
#define XB_XCNT(j)  (256  + 64 * (j))
#define XB_XSUB(j)  (1280 + 64 * (j))
#define XB_XGEN(j)  (2304 + 64 * (j))
#define XB_TOP      3328
#define XB_TOPGEN   3392
#define XCD_BAR_WORDS 3456
#define XB_SPIN_CAP (1u << 22)
#define LAS __attribute__((address_space(3)))
__device__ __forceinline__ unsigned xb_ld(unsigned* p) { return __hip_atomic_load(p, __ATOMIC_RELAXED, __HIP_MEMORY_SCOPE_AGENT); }
__device__ __forceinline__ unsigned xb_add(unsigned* p, unsigned v) { return __hip_atomic_fetch_add(p, v, __ATOMIC_RELAXED, __HIP_MEMORY_SCOPE_AGENT); }
__device__ __forceinline__ unsigned xb_xcc_id() { return (unsigned)__builtin_amdgcn_s_getreg((3 << 11) | 20) & 0xFu; }
#define XB_SPIN(cond, bar) do { unsigned _sp = 0; while (cond) { __builtin_amdgcn_s_sleep(1); \
    if ((++_sp & 255u) == 0u) { if (xb_ld(&(bar)[XB_TMO])) break; if (_sp > XB_SPIN_CAP) { atomicAdd(&(bar)[XB_TMO], 1u); break; } } } } while (0)
struct XcdBarrier {
  unsigned* bar;
  unsigned x;
  volatile LAS unsigned* st;
};
__device__ __forceinline__ XcdBarrier xcd_barrier_post(unsigned* bar, volatile LAS unsigned* st) {
  XcdBarrier b;
  b.bar = bar;
  b.x = xb_xcc_id();
  b.st = st;
  if (threadIdx.x == 0) (void)xb_add(&bar[XB_XCNT(b.x)], 1u);
  return b;
}
__device__ __forceinline__ void xcd_barrier_complete(unsigned* bar, unsigned x, unsigned& nloc, unsigned& nx) {
  const unsigned G = gridDim.x * gridDim.y * gridDim.z;
  unsigned sum, cnt, mine, sp = 0u;
  for (;;) {
    sum = 0u; cnt = 0u; mine = 0u;
#pragma unroll
    for (unsigned j = 0; j < 16; ++j) {
      const unsigned c = xb_ld(&bar[XB_XCNT(j)]);
      sum += c;
      cnt += (c > 0u) ? 1u : 0u;
      mine = (j == x) ? c : mine;
    }
    if (sum == G) break;
    __builtin_amdgcn_s_sleep(1);
    if ((++sp & 255u) == 0u) {
      if (xb_ld(&bar[XB_TMO])) break;
      if (sp > XB_SPIN_CAP) { atomicAdd(&bar[XB_TMO], 1u); break; }
    }
  }
  nloc = mine > 0u ? mine : 1u;
  nx = cnt > 0u ? cnt : 1u;
}
__device__ __forceinline__ void xcd_barrier(const XcdBarrier& b) {
  asm volatile("s_waitcnt vmcnt(0)" ::: "memory");
  __syncthreads();
  if (threadIdx.x == 0) {
    unsigned* bar = b.bar;
    __builtin_amdgcn_s_waitcnt(0);
    unsigned nloc = b.st[0], nx = b.st[1];
    if (nloc == 0u) { xcd_barrier_complete(bar, b.x, nloc, nx); b.st[0] = nloc; b.st[1] = nx; }
    const unsigned old = xb_add(&bar[XB_XSUB(b.x)], 1u);
    const unsigned gen = old / nloc;
    if (old + 1u == (gen + 1u) * nloc) {
      __builtin_amdgcn_fence(__ATOMIC_RELEASE, "agent");
      asm volatile("s_waitcnt vmcnt(0)" ::: "memory");
      const unsigned og = xb_add(&bar[XB_TOP], 1u);
      const unsigned tg = og / nx;
      if (og + 1u == (tg + 1u) * nx) xb_add(&bar[XB_TOPGEN], 1u);
      else XB_SPIN(xb_ld(&bar[XB_TOPGEN]) == tg, bar);
      __builtin_amdgcn_fence(__ATOMIC_ACQUIRE, "agent");
      xb_add(&bar[XB_XGEN(b.x)], 1u);
      asm volatile("s_waitcnt vmcnt(0)" ::: "memory");
    } else {
      XB_SPIN(xb_ld(&bar[XB_XGEN(b.x)]) == gen, bar);
      __builtin_amdgcn_fence(__ATOMIC_ACQUIRE, "agent");
      asm volatile("s_waitcnt vmcnt(0)" ::: "memory");
    }
  }
  __syncthreads();
}

#define BAR_SYNC() do { asm volatile("s_waitcnt lgkmcnt(0)" ::: "memory"); __builtin_amdgcn_s_barrier(); asm volatile("" ::: "memory"); } while (0)

__device__ __forceinline__ unsigned mix2(unsigned h, unsigned p, float m0, float m1) {
  float h0 = bflo(h), h1 = bfhi(h), p0 = bflo(p), p1 = bfhi(p);
  return pack2(h0 + (p0 - h0) * m0, h1 + (p1 - h1) * m1);
}

template <bool MIX, class Epi>
__device__ __forceinline__ void gemm_tile(const u16* __restrict__ A, int lda, const float* __restrict__ mixv,
                                          const u16* __restrict__ Bt, int ldb, int N, int K, int m0, int n0, char* lds, Epi&& epi) {
  const int tid = threadIdx.x, lane = tid & 63, w = tid >> 6;
  const int nk = K >> 6;
  if (w >= 4) {
    const int pt = tid - 256, kc = pt & 7, pr = pt >> 3;
    const u16* Ab = A + (size_t)m0 * lda + (size_t)pr * lda + kc * 8;
    int poff[8];
#pragma unroll
    for (int i = 0; i < 8; ++i) {
      poff[i] = 0;
      if (MIX) {
        const int row = m0 + pr + 32 * i;
        const int prow = row < NP ? ((row & 4095) ? row - 1 : MPAD) : (row < MROWS ? row + 128 : MPAD);
        poff[i] = prow * LDH + kc * 8;
      }
    }
    bool bv[4];
    const u16* bp[4];
#pragma unroll
    for (int j = 0; j < 4; ++j) {
      const int n = n0 + pr + 32 * j;
      bv[j] = n < N;
      bp[j] = Bt + (size_t)(bv[j] ? n : 0) * ldb + kc * 8;
    }
    struct RSet {
      uint4 ra[8], rp[8], rb[4];
      float4 mx0, mx1;
    };
    RSet SA, SB;
    auto gload = [&](RSet& S, int kt) {
      const int ko = kt * 64;
#pragma unroll
      for (int i = 0; i < 8; ++i) {
        S.ra[i] = *(const uint4*)(Ab + (size_t)(32 * i) * lda + ko);
        if (MIX) S.rp[i] = *(const uint4*)(A + poff[i] + ko);
      }
      if (MIX) {
        S.mx0 = *(const float4*)(mixv + ko + kc * 8);
        S.mx1 = *(const float4*)(mixv + ko + kc * 8 + 4);
      }
#pragma unroll
      for (int j = 0; j < 4; ++j) {
        uint4 z = {0u, 0u, 0u, 0u};
        if (bv[j]) z = *(const uint4*)(bp[j] + ko);
        S.rb[j] = z;
      }
    };
    auto lstore = [&](RSet& S, int s) {
      char* base = lds + s * LDS_STAGE + pr * LDS_ROW + kc * 16;
#pragma unroll
      for (int i = 0; i < 8; ++i) {
        uint4 v = S.ra[i];
        if (MIX) {
          v.x = mix2(S.ra[i].x, S.rp[i].x, S.mx0.x, S.mx0.y);
          v.y = mix2(S.ra[i].y, S.rp[i].y, S.mx0.z, S.mx0.w);
          v.z = mix2(S.ra[i].z, S.rp[i].z, S.mx1.x, S.mx1.y);
          v.w = mix2(S.ra[i].w, S.rp[i].w, S.mx1.z, S.mx1.w);
        }
        *(uint4*)(base + (32 * i) * LDS_ROW) = v;
      }
#pragma unroll
      for (int j = 0; j < 4; ++j) *(uint4*)(base + LDS_A_BYTES + (32 * j) * LDS_ROW) = S.rb[j];
    };
    if constexpr (!MIX) {
      gload(SB, 0);
      if (nk > 1) gload(SA, 1);
      lstore(SB, 0);
      if (nk > 2) gload(SB, 2);
      BAR_SYNC();
#pragma unroll 1
      for (int kt = 0; kt < nk; kt += 2) {
        if (kt + 1 < nk) {
          lstore(SA, 1);
          if (kt + 3 < nk) gload(SA, kt + 3);
        }
        BAR_SYNC();
        if (kt + 1 < nk) {
          if (kt + 2 < nk) {
            lstore(SB, 0);
            if (kt + 4 < nk) gload(SB, kt + 4);
          }
          BAR_SYNC();
        }
      }
    } else {
      gload(SA, 0);
      lstore(SA, 0);
      if (nk > 1) gload(SA, 1);
      BAR_SYNC();
#pragma unroll 1
      for (int kt = 0; kt < nk; ++kt) {
        if (kt + 1 < nk) {
          lstore(SA, (kt + 1) & 1);
          if (kt + 2 < nk) gload(SA, kt + 2);
        }
        BAR_SYNC();
      }
    }
  } else {
    const int wm = w >> 1, wn = w & 1, lr = lane & 15, lg = lane >> 4;
    f32x4 acc[8][4];
#pragma unroll
    for (int i = 0; i < 8; ++i)
#pragma unroll
      for (int j = 0; j < 4; ++j) acc[i][j] = f32x4{0.f, 0.f, 0.f, 0.f};
    BAR_SYNC();
#pragma unroll 1
    for (int kt = 0; kt < nk; ++kt) {
      const char* sa = lds + (kt & 1) * LDS_STAGE + (wm * 128 + lr) * LDS_ROW + lg * 16;
      const char* sb = lds + (kt & 1) * LDS_STAGE + LDS_A_BYTES + (wn * 64 + lr) * LDS_ROW + lg * 16;
      bf16x8 bq[2][4], aq[3];
#pragma unroll
      for (int ni = 0; ni < 4; ++ni) bq[0][ni] = *(const bf16x8*)(sb + ni * 16 * LDS_ROW);
      aq[0] = *(const bf16x8*)(sa);
      aq[1] = *(const bf16x8*)(sa + 16 * LDS_ROW);
#pragma unroll
      for (int ni = 0; ni < 4; ++ni) bq[1][ni] = *(const bf16x8*)(sb + ni * 16 * LDS_ROW + 64);
#pragma unroll
      for (int st = 0; st < 16; ++st) {
        if (st + 2 < 16) aq[(st + 2) % 3] = *(const bf16x8*)(sa + ((st + 2) & 7) * 16 * LDS_ROW + ((st + 2) >> 3) * 64);
#pragma unroll
        for (int ni = 0; ni < 4; ++ni)
          acc[st & 7][ni] = __builtin_amdgcn_mfma_f32_16x16x32_bf16(bq[st >> 3][ni], aq[st % 3], acc[st & 7][ni], 0, 0, 0);
        __builtin_amdgcn_sched_barrier(0);
      }
      BAR_SYNC();
    }
    epi(acc, wm, wn, lr, lg);
  }
}

constexpr int LDS_STAGE2 = 2 * LDS_A_BYTES;
template <class Epi>
__device__ __forceinline__ void gemm_tile256(const u16* __restrict__ A, int lda, const u16* __restrict__ Bt, int ldb, int K, int m0,
                                             int n0, char* lds, bool half, Epi&& epi) {
  int tid = threadIdx.x;
  asm volatile("" : "+v"(tid));
  const int lane = tid & 63, w = __builtin_amdgcn_readfirstlane(tid >> 6);
  const int wm = w >> 2, wn = w & 3, lr = lane & 15, lg = lane >> 4;
  const int nk = K >> 5;
  const int drow = lane >> 2, dch = (lane & 3) ^ ((lane >> 4) & 3);
  const u16* As0 = A + (size_t)(m0 + w * 16 + drow) * lda + dch * 8;
  const u16* As1 = A + (size_t)(m0 + (w + 8) * 16 + drow) * lda + dch * 8;
  const u16* Bs0 = Bt + (size_t)(n0 + w * 16 + drow) * ldb + dch * 8;
  const u16* Bs1 = Bt + (size_t)(n0 + (w + 8) * 16 + drow) * ldb + dch * 8;
  auto dma = [&](int kt, int stg) __attribute__((always_inline)) {
    char* sbase = lds + stg * 32768;
    const int ko = kt * 32;
    __builtin_amdgcn_global_load_lds((const unsigned*)(As0 + ko), (unsigned*)(sbase + w * 1024), 16, 0, 0);
    __builtin_amdgcn_global_load_lds((const unsigned*)(As1 + ko), (unsigned*)(sbase + (w + 8) * 1024), 16, 0, 0);
    __builtin_amdgcn_global_load_lds((const unsigned*)(Bs0 + ko), (unsigned*)(sbase + 16384 + w * 1024), 16, 0, 0);
    __builtin_amdgcn_global_load_lds((const unsigned*)(Bs1 + ko), (unsigned*)(sbase + 16384 + (w + 8) * 1024), 16, 0, 0);
  };
  f32x4 acc[8][4];
#pragma unroll
  for (int i = 0; i < 8; ++i)
#pragma unroll
    for (int j = 0; j < 4; ++j) acc[i][j] = f32x4{0.f, 0.f, 0.f, 0.f};
  const int swz = (lg ^ ((lr >> 2) & 3)) * 16;
  const int aoff = (wm * 128 + lr) * 64 + swz, boff = 16384 + (wn * 64 + lr) * 64 + swz;
  const bool skipm = half && wm == 1;
  dma(0, 0);
  dma(nk > 1 ? 1 : nk - 1, 1);
  dma(nk > 2 ? 2 : nk - 1, 2);
  asm volatile("s_waitcnt vmcnt(8)" ::: "memory");
  BAR_SYNC();
#pragma unroll 1
  for (int kt = 0; kt < nk; ++kt) {
    const char* sa = lds + (kt & 3) * 32768 + aoff;
    const char* sb = lds + (kt & 3) * 32768 + boff;
    bf16x8 bq[4], aq[3];
#pragma unroll
    for (int ni = 0; ni < 4; ++ni) bq[ni] = *(const bf16x8*)(sb + ni * 1024);
    aq[0] = *(const bf16x8*)(sa);
    aq[1] = *(const bf16x8*)(sa + 1024);
    dma(kt + 3 < nk ? kt + 3 : nk - 1, (kt + 3) & 3);
    if (!skipm) {
#pragma unroll
      for (int st = 0; st < 8; ++st) {
        if (st + 2 < 8) aq[(st + 2) % 3] = *(const bf16x8*)(sa + (st + 2) * 1024);
#pragma unroll
        for (int ni = 0; ni < 4; ++ni)
          acc[st][ni] = __builtin_amdgcn_mfma_f32_16x16x32_bf16(bq[ni], aq[st % 3], acc[st][ni], 0, 0, 0);
        __builtin_amdgcn_sched_barrier(0);
      }
    }
    asm volatile("s_waitcnt vmcnt(8)" ::: "memory");
    BAR_SYNC();
  }
  asm volatile("s_waitcnt vmcnt(0)" ::: "memory");
  BAR_SYNC();
  epi(acc, wm, wn, lr, lg);
}

#define EPI_FOREACH(acc, ...)                                    \
  _Pragma("unroll") for (int mi = 0; mi < 8; ++mi) {             \
    const int row = m0 + wm * 128 + mi * 16 + lr;                \
    _Pragma("unroll") for (int ni = 0; ni < 4; ++ni) {           \
      const int col0 = n0 + wn * 64 + ni * 16 + lg * 4;          \
      const f32x4 v = acc[mi][ni];                               \
      __VA_ARGS__                                                \
    }                                                            \
    __builtin_amdgcn_sched_barrier(0);                           \
  }
#define EPI_ARGS f32x4(&acc)[8][4], int wm, int wn, int lr, int lg

__device__ __forceinline__ void conv_job(const float* __restrict__ src, u16* __restrict__ dst, int K, int N, int ldk, float* tl, int rot) {
  int tid = threadIdx.x;
  asm volatile("" : "+v"(tid));
  const int tn = N >> 6, nt = (K >> 6) * tn;
  const int G = gridDim.x;
  int t = ((int)blockIdx.x + G - (rot % G)) % G;
  float v[8];
  auto ldtile = [&](int tt) {
    const int k0 = (tt / tn) << 6, n0 = (tt % tn) << 6;
#pragma unroll
    for (int i = 0; i < 8; ++i) {
      const int e = tid + 512 * i;
      v[i] = src[(size_t)(k0 + (e >> 6)) * N + n0 + (e & 63)];
    }
  };
  if (t < nt) ldtile(t);
  while (t < nt) {
    const int k0 = (t / tn) << 6, n0 = (t % tn) << 6;
#pragma unroll
    for (int i = 0; i < 8; ++i) {
      const int e = tid + 512 * i;
      tl[(e >> 6) * 65 + (e & 63)] = v[i];
    }
    const int tnx = t + G;
    if (tnx < nt) ldtile(tnx);
    __syncthreads();
    const int n = tid >> 3, kc = tid & 7;
    float f[8];
#pragma unroll
    for (int j = 0; j < 8; ++j) f[j] = tl[(kc * 8 + j) * 65 + n];
    uint4 o;
    o.x = pack2(f[0], f[1]);
    o.y = pack2(f[2], f[3]);
    o.z = pack2(f[4], f[5]);
    o.w = pack2(f[6], f[7]);
    *(uint4*)(dst + (size_t)(n0 + n) * ldk + k0 + kc * 8) = o;
    __syncthreads();
    t = tnx;
  }
}

__device__ __forceinline__ void phase0(const Params& p, char* lds) {
  float* tl = (float*)lds;
  u16* wt = (u16*)(p.ws + WS_WT);
  u16* adawt = (u16*)(p.ws + S_ADAWT);
  int rot = 0;
#define CJ(SRC, DST, K, N)            \
  conv_job(SRC, DST, K, N, ((K) == 1024 ? LDH : (K) == 4096 ? LDU : (K)), tl, rot);  \
  rot += ((K) >> 6) * ((N) >> 6);
  CJ(p.ada_w, adawt, 1024, 6144)
  CJ(p.ada_w + (size_t)1024 * 6144, adawt + (size_t)6144 * LDH, 1024, 6144)
  CJ(p.rw_wr, wt + WT_WR, 1024, 1024)
  CJ(p.rw_wk, wt + WT_WK, 1024, 1024)
  CJ(p.rw_wv, wt + WT_WV, 1024, 1024)
  CJ(p.rw_wo, wt + WT_WO, 1024, 1024)
  CJ(p.rw_w1, wt + WT_W1, 1024, 64)
  CJ(p.rw_a1, wt + WT_A1, 1024, 64)
  CJ(p.rw_g1, wt + WT_G1, 1024, 128)
  CJ(p.rw_w2, wt + WT_W2, 64, 1024)
  CJ(p.rw_a2, wt + WT_A2, 64, 1024)
  CJ(p.rw_g2, wt + WT_G2, 128, 1024)
  CJ(p.mlp_up, wt + WT_UP0, 1024, 4096)
  CJ(p.mlp_down, wt + WT_DN0, 4096, 1024)
  CJ(p.at_wqkv, wt + WT_QKV, 1024, 1536)
  CJ(p.at_wo, wt + WT_WO1, 1024, 1024)
  CJ(p.mlp_up + (size_t)4 * MEG, wt + WT_UP1, 1024, 4096)
  CJ(p.mlp_down + (size_t)4 * MEG, wt + WT_DN1, 4096, 1024)
#undef CJ
  const int gtid = blockIdx.x * NTHR + threadIdx.x, gsz = gridDim.x * NTHR;
  u16* siluc = (u16*)(p.ws + S_SILUC);
  for (int i = gtid; i < 256 * 1024; i += gsz) {
    int row = i >> 10, col = i & 1023;
    float c = 0.f;
    if (row < 4) c = p.c_prompt[row * 1024 + col];
    else if (row < 132) c = p.c_sample[(row - 4) * 1024 + col];
    siluc[i] = f2bf(c * sigmoidf_(c));
  }
  u16* hs = (u16*)(p.ws + WS_HS);
  for (int i = gtid; i < 128 * 1024; i += gsz) hs[(size_t)(i >> 10) * LDH + (i & 1023)] = f2bf(p.state_shift[i]);
  u16* zr = (u16*)(p.ws + WS_ZR);
  for (int i = gtid; i < LDH; i += gsz) zr[i] = 0;
  float2* tab = (float2*)(p.ws + WS_TAB);
  for (int i = gtid; i < 4097 * 8; i += gsz) {
    int pi = i >> 3, f = i & 7;
    float pos = pi < 4096 ? (float)pi : 8192.f;
    float inv = f == 0 ? 1.0f : f == 1 ? 0.1939227432012558f : f == 2 ? 0.03760603070259094f : f == 3 ? 0.007292664609849453f
              : f == 4 ? 0.0014142135623842478f : f == 5 ? 0.00027424818836152554f : f == 6 ? 5.318296098266728e-05f
              : 1.0313386155758053e-05f;
    float ang = pos * inv;
    double t = (double)ang * 0.15915494309189535;
    t -= rint(t);
    float fr = (float)t;
    tab[i] = make_float2(__builtin_amdgcn_cosf(fr), __builtin_amdgcn_sinf(fr));
  }
}

__device__ __forceinline__ void phase_ada(const Params& p, char* lds) {
  const u16* siluc = (const u16*)(p.ws + S_SILUC);
  const u16* adawt = (const u16*)(p.ws + S_ADAWT);
  float* mod = (float*)(p.ws + WS_MOD);
  for (int t = blockIdx.x; t < 96; t += gridDim.x) {
    const int layer = t / 48, nt = t % 48;
    const int m0 = 0, n0 = nt * 128;
    const float* bias = p.ada_b + layer * 6144;
    float* mo = mod + (size_t)layer * 132 * 6144;
    gemm_tile<false>(siluc, 1024, nullptr, adawt + (size_t)layer * 6144 * LDH, LDH, 6144, 1024, m0, n0, lds, [&](EPI_ARGS) {
      EPI_FOREACH(acc, if (row < 132) {
        const float4 b4 = *(const float4*)(bias + col0);
        *(float4*)(mo + (size_t)row * 6144 + col0) = make_float4(v[0] + b4.x, v[1] + b4.y, v[2] + b4.z, v[3] + b4.w);
      })
    });
  }
}

__device__ __forceinline__ void phase_norm(const Params& p, int layer, int which, bool from_input, bool shift_out) {
  const int lane = threadIdx.x & 63, w = threadIdx.x >> 6;
  const float* mod = (const float*)(p.ws + WS_MOD);
  u16* H = (u16*)(p.ws + WS_H);
  const float* g = (which ? p.norm2_g : p.norm1_g) + layer * 1024;
  const int nw = gridDim.x * 8;
  auto xrow = [&](int row) {
    return from_input ? (row < NP ? p.x_prompt + (size_t)row * 1024 : p.x_sample + (size_t)(row - NP) * 1024)
                      : (const float*)p.out + (size_t)row * 1024;
  };
  float4 gg[4];
#pragma unroll
  for (int i = 0; i < 4; ++i) gg[i] = *(const float4*)(g + lane * 4 + 256 * i);
  int row = blockIdx.x * 8 + w;
  float4 xn[4];
  if (row < MROWS) {
    const float* xr = xrow(row);
#pragma unroll
    for (int i = 0; i < 4; ++i) xn[i] = *(const float4*)(xr + lane * 4 + 256 * i);
  }
  while (row < MROWS) {
    float4 x[4];
#pragma unroll
    for (int i = 0; i < 4; ++i) x[i] = xn[i];
    const int nrow = row + nw;
    if (nrow < MROWS) {
      const float* xr = xrow(nrow);
#pragma unroll
      for (int i = 0; i < 4; ++i) xn[i] = *(const float4*)(xr + lane * 4 + 256 * i);
    }
    const int bi = bidx_of(row);
    const float* mb = mod + ((size_t)layer * 132 + bi) * 6144;
    const float* sh = mb + (which ? 3 : 0) * 1024;
    const float* sc = mb + (which ? 4 : 1) * 1024;
    float4 s4[4], c4[4];
#pragma unroll
    for (int i = 0; i < 4; ++i) {
      s4[i] = *(const float4*)(sh + lane * 4 + 256 * i);
      c4[i] = *(const float4*)(sc + lane * 4 + 256 * i);
    }
    float ss = 0.f;
#pragma unroll
    for (int i = 0; i < 4; ++i) ss += x[i].x * x[i].x + x[i].y * x[i].y + x[i].z * x[i].z + x[i].w * x[i].w;
    ss = wavesum(ss);
    const float rs = rsqrtf(ss * (1.f / 1024.f) + 1e-6f);
    const bool so = shift_out && (row >= NP || (row & 4095) == 4095);
    float* sop = row >= NP ? p.out + O_SHS + (size_t)(row - NP) * 1024 : p.out + O_SHP + (size_t)(row >> 12) * 1024;
#pragma unroll
    for (int i = 0; i < 4; ++i) {
      const int c = lane * 4 + 256 * i;
      float4 h;
      h.x = x[i].x * rs * gg[i].x * (1.f + c4[i].x) + s4[i].x;
      h.y = x[i].y * rs * gg[i].y * (1.f + c4[i].y) + s4[i].y;
      h.z = x[i].z * rs * gg[i].z * (1.f + c4[i].z) + s4[i].z;
      h.w = x[i].w * rs * gg[i].w * (1.f + c4[i].w) + s4[i].w;
      uint2 pk;
      pk.x = pack2(h.x, h.y);
      pk.y = pack2(h.z, h.w);
      *(uint2*)(H + (size_t)row * LDH + c) = pk;
      if (so) *(float4*)(sop + c) = h;
    }
    row = nrow;
  }
}

__device__ __forceinline__ void phase_norm_mix(const Params& p) {
  const int lane = threadIdx.x & 63, w = threadIdx.x >> 6;
  const float* mod = (const float*)(p.ws + WS_MOD);
  u16* H = (u16*)(p.ws + WS_H);
  u16* XR = (u16*)p.out;
  u16* XK = XR + (size_t)MROWS * 1024;
  u16* XV = (u16*)(p.ws + S_EW);
  const float* g = p.norm1_g;
  const int nw = gridDim.x * 8;
  f32x4 gg[4], mr[4], mk[4], mv[4];
#pragma unroll
  for (int i = 0; i < 4; ++i) {
    const int c = lane * 4 + 256 * i;
    gg[i] = *(const f32x4*)(g + c);
    mr[i] = *(const f32x4*)(p.rw_mix + c);
    mk[i] = *(const f32x4*)(p.rw_mix + 2 * 1024 + c);
    mv[i] = *(const f32x4*)(p.rw_mix + 3 * 1024 + c);
  }
  auto xrow = [&](int row) { return row < NP ? p.x_prompt + (size_t)row * 1024 : p.x_sample + (size_t)(row - NP) * 1024; };
  auto hrow = [&](const f32x4 (&x)[4], int row, f32x4 (&h)[4]) __attribute__((always_inline)) {
    float ss = 0.f;
#pragma unroll
    for (int i = 0; i < 4; ++i) ss += x[i][0] * x[i][0] + x[i][1] * x[i][1] + x[i][2] * x[i][2] + x[i][3] * x[i][3];
    ss = wavesum(ss);
    const float rs = rsqrtf(ss * (1.f / 1024.f) + 1e-6f);
    const float* mb = mod + (size_t)bidx_of(row) * 6144;
#pragma unroll
    for (int i = 0; i < 4; ++i) {
      const int c = lane * 4 + 256 * i;
      const f32x4 s4 = *(const f32x4*)(mb + c), c4 = *(const f32x4*)(mb + 1024 + c);
      h[i] = x[i] * rs * gg[i] * (1.f + c4) + s4;
    }
  };
  for (int chunk = blockIdx.x * 8 + w; chunk < MROWS / 8; chunk += nw) {
    const int r0 = chunk * 8;
    f32x4 hp[4], x[4], xn[4];
    if (r0 < NP && (r0 & 4095) != 0) {
      const float* xr = xrow(r0 - 1);
#pragma unroll
      for (int i = 0; i < 4; ++i) x[i] = *(const f32x4*)(xr + lane * 4 + 256 * i);
      hrow(x, r0 - 1, hp);
    } else {
#pragma unroll
      for (int i = 0; i < 4; ++i) hp[i] = f32x4{0.f, 0.f, 0.f, 0.f};
    }
    {
      const float* xr = xrow(r0);
#pragma unroll
      for (int i = 0; i < 4; ++i) xn[i] = *(const f32x4*)(xr + lane * 4 + 256 * i);
    }
#pragma unroll 1
    for (int rr = 0; rr < 8; ++rr) {
      const int row = r0 + rr;
#pragma unroll
      for (int i = 0; i < 4; ++i) x[i] = xn[i];
      if (rr + 1 < 8) {
        const float* xr = xrow(row + 1);
#pragma unroll
        for (int i = 0; i < 4; ++i) xn[i] = *(const f32x4*)(xr + lane * 4 + 256 * i);
      }
      if (row >= NP) {
#pragma unroll
        for (int i = 0; i < 4; ++i) hp[i] = *(const f32x4*)(p.state_shift + (size_t)(row - NP) * 1024 + lane * 4 + 256 * i);
      }
      f32x4 h[4];
      hrow(x, row, h);
      const bool so = row >= NP || (row & 4095) == 4095;
      float* sop = row >= NP ? p.out + O_SHS + (size_t)(row - NP) * 1024 : p.out + O_SHP + (size_t)(row >> 12) * 1024;
#pragma unroll
      for (int i = 0; i < 4; ++i) {
        const int c = lane * 4 + 256 * i;
        *(uint2*)(H + (size_t)row * LDH + c) = pack4(h[i]);
        if (so) *(f32x4*)(sop + c) = h[i];
        const f32x4 dd = hp[i] - h[i];
        *(uint2*)(XR + (size_t)row * 1024 + c) = pack4(h[i] + dd * mr[i]);
        *(uint2*)(XK + (size_t)row * 1024 + c) = pack4(h[i] + dd * mk[i]);
        *(uint2*)(XV + (size_t)row * 1024 + c) = pack4(h[i] + dd * mv[i]);
        hp[i] = h[i];
      }
    }
  }
}

__device__ __forceinline__ void phase_final(const Params& p) {
  const int lane = threadIdx.x & 63, w = threadIdx.x >> 6;
  const int nw = gridDim.x * 8;
  for (int row = blockIdx.x * 8 + w; row < MROWS; row += nw) {
    float* xr = p.out + (size_t)row * 1024;
    float4 x[4];
    float ss = 0.f;
#pragma unroll
    for (int i = 0; i < 4; ++i) {
      x[i] = *(const float4*)(xr + lane * 4 + 256 * i);
      ss += x[i].x * x[i].x + x[i].y * x[i].y + x[i].z * x[i].z + x[i].w * x[i].w;
    }
    ss = wavesum(ss);
    const float rs = rsqrtf(ss * (1.f / 1024.f) + 1e-6f);
#pragma unroll
    for (int i = 0; i < 4; ++i) {
      const int c = lane * 4 + 256 * i;
      float4 gg = *(const float4*)(p.final_g + c);
      float4 h;
      h.x = x[i].x * rs * gg.x;
      h.y = x[i].y * rs * gg.y;
      h.z = x[i].z * rs * gg.z;
      h.w = x[i].w * rs * gg.w;
      *(float4*)(xr + c) = h;
    }
  }
}

__device__ __forceinline__ void phase_rwkv_proj(const Params& p, char* lds) {
  const u16* H = (const u16*)(p.ws + WS_H);
  const u16* wt = (const u16*)(p.ws + WS_WT);
  const u16* XR = (const u16*)p.out;
  const u16* XK = XR + (size_t)MROWS * 1024;
  const u16* XV = (const u16*)(p.ws + S_EW);
  u16* R = (u16*)(p.ws + S_R);
  u16* Kk = (u16*)(p.ws + S_K);
  u16* V = (u16*)(p.ws + S_V);
  u16* WH = (u16*)(p.ws + S_WH);
  u16* AH = (u16*)(p.ws + S_AH);
  u16* GH = (u16*)(p.ws + S_GH);
  for (int u = blockIdx.x; u < 780 + 195; u += gridDim.x) {
    if (u < 780) {
      const int kind = u / 260, t = u - kind * 260;
      const int mt = t >> 2, nt = t & 3;
      const int m0 = mt * 256, n0 = nt * 256;
      const u16* A = kind == 2 ? XV : XR + (size_t)kind * ((size_t)MROWS * 1024);
      const u16* Bt = wt + WT_WR + (size_t)kind * (1024 * LDH);
      u16* dst = R + (size_t)kind * (RSZ / 2);
      gemm_tile256(A, 1024, Bt, LDH, 1024, m0, n0, lds, mt == 64, [&](EPI_ARGS) {
        EPI_FOREACH(acc, if (row < MROWS) *(uint2*)(dst + (size_t)row * 1024 + col0) = pack4(v);)
      });
    } else {
      const int s_ = u - 780;
      const int mt = s_ / 3, kind = 3 + (s_ - mt * 3);
      const int m0 = mt * 256, n0 = 0;
      const int N = kind == 5 ? 128 : 64, mixi = kind == 3 ? 1 : kind;
      const u16* Bt = wt + WT_W1 + (size_t)(kind - 3) * (64 * LDH);
      gemm_tile<true>(H, LDH, p.rw_mix + mixi * 1024, Bt, LDH, N, 1024, m0, n0, lds, [&](EPI_ARGS) {
        u16* dst = WH + (size_t)(kind - 3) * ((size_t)MPAD * 64);
        const int ld = kind == 5 ? 128 : 64;
        EPI_FOREACH(acc, if (row < MROWS && col0 < ld) {
          f32x4 o = v;
          if (kind == 3) {
            _Pragma("unroll") for (int q = 0; q < 4; ++q) o[q] = 1.f - 2.f / (__expf(2.f * v[q]) + 1.f);
          } else if (kind == 5) {
            _Pragma("unroll") for (int q = 0; q < 4; ++q) o[q] = sigmoidf_(v[q]);
          }
          *(uint2*)(dst + (size_t)row * ld + col0) = pack4(o);
        })
      });
    }
  }
}

__device__ __forceinline__ void phase_rwkv_lora2(const Params& p, char* lds) {
  {
    const int gtid = blockIdx.x * NTHR + threadIdx.x, gsz = gridDim.x * NTHR;
    for (int i = gtid; i < 128 * 256; i += gsz) ((float4*)(p.out + (size_t)NP * 1024))[i] = ((const float4*)p.x_sample)[i];
  }
  const u16* wt = (const u16*)(p.ws + WS_WT);
  const u16* WH = (const u16*)(p.ws + S_WH);
  const u16* AH = (const u16*)(p.ws + S_AH);
  u16* EW = (u16*)(p.ws + S_EW);
  u16* Aa = (u16*)(p.ws + S_A);
  for (int t = blockIdx.x; t < 65 * 8; t += gridDim.x) {
    const int mt = t >> 3, j = t & 7;
    const int m0 = mt * 256, n0 = (j & 3) * 256;
    const bool isw = j < 4;
    gemm_tile256(isw ? WH : AH, 64, wt + (isw ? WT_W2 : WT_A2), 64, 64, m0, n0, lds, mt == 64, [&](EPI_ARGS) {
      const float* b0 = isw ? p.rw_w0 : p.rw_a0;
      EPI_FOREACH(acc, if (row < MROWS) {
        const float4 b4 = *(const float4*)(b0 + col0);
        const float s0 = sigmoidf_(v[0] + b4.x), s1 = sigmoidf_(v[1] + b4.y), s2 = sigmoidf_(v[2] + b4.z), s3 = sigmoidf_(v[3] + b4.w);
        if (isw) {
          const float c = 0.6065306597126334f;
          uint2 o;
          o.x = (unsigned)f2h(c * s0) | ((unsigned)f2h(c * s1) << 16);
          o.y = (unsigned)f2h(c * s2) | ((unsigned)f2h(c * s3) << 16);
          *(uint2*)(EW + (size_t)row * 1024 + col0) = o;
        } else {
          uint2 o;
          o.x = pack2(s0, s1);
          o.y = pack2(s2, s3);
          *(uint2*)(Aa + (size_t)row * 1024 + col0) = o;
        }
      })
    });
  }
}

constexpr int PAIR_TS = 624;
constexpr int PAIR_BUF = 8 * PAIR_TS;

__device__ __forceinline__ void phase_scan(const Params& p, char* lds) {
  const int tid = threadIdx.x, lane = tid & 63, w = tid >> 6;
  const u16* R = (const u16*)(p.ws + S_R);
  const u16* Kk = (const u16*)(p.ws + S_K);
  const u16* V = (const u16*)(p.ws + S_V);
  const u16* EW = (const u16*)(p.ws + S_EW);
  const u16* Aa = (const u16*)(p.ws + S_A);
  u16* Y = (u16*)(p.ws + WS_H);
  float* RK = (float*)(p.ws + WS_RK);
  float* ring = (float*)lds;
  float* ybuf = (float*)(lds + 2 * PAIR_BUF * 4);
  for (int item = blockIdx.x; item < 256; item += gridDim.x) {
    const int chain = item >> 2, qr = item & 3, b = chain >> 4, h = chain & 15;
    const size_t rowbase = (size_t)b * 4096;
    __syncthreads();
    if (tid >= 256) {
      const int pt = tid - 256, grp = pt >> 7, pair = (pt & 127) >> 4, cq = pt & 15;
      const int ch = h * 64 + cq * 4;
      const float4 kk4 = *(const float4*)(p.rw_kk + ch), ka4 = *(const float4*)(p.rw_ka + ch), rk4 = *(const float4*)(p.rw_rk + ch);
      struct PS {
        uint2 rr[2], rk_[2], rv[2], ra_[2], re[2];
      };
      PS S0, S1;
      auto pload = [&](PS& S, int c) __attribute__((always_inline)) {
#pragma unroll
        for (int q = 0; q < 2; ++q) {
          const size_t off = (rowbase + (size_t)c * 16 + pair * 2 + q) * 1024 + ch;
          S.rr[q] = *(const uint2*)(R + off);
          S.rk_[q] = *(const uint2*)(Kk + off);
          S.rv[q] = *(const uint2*)(V + off);
          S.ra_[q] = *(const uint2*)(Aa + off);
          S.re[q] = *(const uint2*)(EW + off);
        }
      };
      auto pproc = [&](PS& S, int c) __attribute__((always_inline)) {
        const float kkw[4] = {kk4.x, kk4.y, kk4.z, kk4.w}, kaw[4] = {ka4.x, ka4.y, ka4.z, ka4.w}, rkw[4] = {rk4.x, rk4.y, rk4.z, rk4.w};
        float am[2][4], dc[2][4], bm[2][4], kp[2][4], rf[2][4], vf[2][4];
#pragma unroll
        for (int q = 0; q < 2; ++q) {
          const uint2 rr = S.rr[q], rk_ = S.rk_[q], rv = S.rv[q], ra_ = S.ra_[q], re = S.re[q];
          const float rfx[4] = {bflo(rr.x), bfhi(rr.x), bflo(rr.y), bfhi(rr.y)};
          const float kf[4] = {bflo(rk_.x), bfhi(rk_.x), bflo(rk_.y), bfhi(rk_.y)};
          const float vfx[4] = {bflo(rv.x), bfhi(rv.x), bflo(rv.y), bfhi(rv.y)};
          const float af[4] = {bflo(ra_.x), bfhi(ra_.x), bflo(ra_.y), bfhi(ra_.y)};
          const float ef[4] = {h2f((u16)(re.x & 0xffff)), h2f((u16)(re.x >> 16)), h2f((u16)(re.y & 0xffff)), h2f((u16)(re.y >> 16))};
          float kkr[4], ss = 0.f, rks = 0.f;
#pragma unroll
          for (int j = 0; j < 4; ++j) {
            kkr[j] = kf[j] * kkw[j];
            ss += kkr[j] * kkr[j];
            kp[q][j] = kf[j] * (1.f + (af[j] - 1.f) * kaw[j]);
            rks += rfx[j] * kp[q][j] * rkw[j];
            rf[q][j] = rfx[j];
            vf[q][j] = vfx[j];
          }
          ss = rowsum16(ss);
          rks = rowsum16(rks);
          const float inv = 1.f / fmaxf(sqrtf(ss), 1e-12f);
#pragma unroll
          for (int j = 0; j < 4; ++j) {
            am[q][j] = -kkr[j] * inv;
            dc[q][j] = __expf(-ef[j]);
            bm[q][j] = kkr[j] * inv * af[j];
          }
          if (cq == 0 && qr == 0) RK[(rowbase + (size_t)c * 16 + pair * 2 + q) * 16 + h] = rks;
        }
        float aw[4], w12[4], b1w[4], k1w[4], wr1[4], wr2[4];
        float cba = 0.f, cka = 0.f, br1 = 0.f, kr1 = 0.f, br12 = 0.f, kr12 = 0.f, br2 = 0.f, kr2 = 0.f;
#pragma unroll
        for (int j = 0; j < 4; ++j) {
          aw[j] = dc[0][j] * am[1][j];
          w12[j] = dc[0][j] * dc[1][j];
          b1w[j] = bm[0][j] * dc[1][j];
          k1w[j] = kp[0][j] * dc[1][j];
          wr1[j] = dc[0][j] * rf[0][j];
          wr2[j] = w12[j] * rf[1][j];
          cba += bm[0][j] * am[1][j];
          cka += kp[0][j] * am[1][j];
          br1 += bm[0][j] * rf[0][j];
          kr1 += kp[0][j] * rf[0][j];
          br12 += b1w[j] * rf[1][j];
          kr12 += k1w[j] * rf[1][j];
          br2 += bm[1][j] * rf[1][j];
          kr2 += kp[1][j] * rf[1][j];
        }
        cba = rowsum16(cba);
        cka = rowsum16(cka);
        br1 = rowsum16(br1);
        kr1 = rowsum16(kr1);
        br12 = rowsum16(br12);
        kr12 = rowsum16(kr12);
        br2 = rowsum16(br2);
        kr2 = rowsum16(kr2);
        float* slot = ring + (c & 1) * PAIR_BUF + pair * PAIR_TS;
        *(float4*)(slot + cq * 4) = make_float4(am[0][0], am[0][1], am[0][2], am[0][3]);
        *(float4*)(slot + 64 + cq * 4) = make_float4(aw[0], aw[1], aw[2], aw[3]);
        *(float4*)(slot + 128 + cq * 4) = make_float4(w12[0], w12[1], w12[2], w12[3]);
        *(float4*)(slot + 192 + cq * 4) = make_float4(b1w[0], b1w[1], b1w[2], b1w[3]);
        *(float4*)(slot + 256 + cq * 4) = make_float4(k1w[0], k1w[1], k1w[2], k1w[3]);
        *(float4*)(slot + 320 + cq * 4) = make_float4(bm[1][0], bm[1][1], bm[1][2], bm[1][3]);
        *(float4*)(slot + 384 + cq * 4) = make_float4(kp[1][0], kp[1][1], kp[1][2], kp[1][3]);
        *(float4*)(slot + 448 + cq * 4) = make_float4(wr1[0], wr1[1], wr1[2], wr1[3]);
        *(float4*)(slot + 512 + cq * 4) = make_float4(wr2[0], wr2[1], wr2[2], wr2[3]);
        if ((cq >> 2) == qr) {
          *(float4*)(slot + 576 + (cq & 3) * 4) = make_float4(vf[0][0], vf[0][1], vf[0][2], vf[0][3]);
          *(float4*)(slot + 592 + (cq & 3) * 4) = make_float4(vf[1][0], vf[1][1], vf[1][2], vf[1][3]);
        }
        if (cq == 0) {
          *(float4*)(slot + 608) = make_float4(cba, cka, br1, kr1);
          *(float4*)(slot + 612) = make_float4(br12, kr12, br2, kr2);
        }
      };
      if (grp == 0) {
        pload(S0, 0);
        pproc(S0, 0);
        pload(S1, 2);
        pload(S0, 4);
      } else {
        pload(S0, 1);
        pload(S1, 3);
      }
      BAR_SYNC();
#pragma unroll 1
      for (int c = 0; c < 256; c += 4) {
        if (grp == 1) {
          pproc(S0, c + 1);
          if (c + 5 < 256) pload(S0, c + 5);
        }
        BAR_SYNC();
        if (grp == 0) {
          pproc(S1, c + 2);
          if (c + 6 < 256) pload(S1, c + 6);
        }
        BAR_SYNC();
        if (grp == 1) {
          pproc(S1, c + 3);
          if (c + 7 < 256) pload(S1, c + 7);
        }
        BAR_SYNC();
        if (grp == 0) {
          if (c + 4 < 256) pproc(S0, c + 4);
          if (c + 8 < 256) pload(S0, c + 8);
        }
        BAR_SYNC();
      }
    } else {
      const int rl = tid >> 4, cgp = tid & 15;
      float s0 = 0.f, s1 = 0.f, s2 = 0.f, s3 = 0.f;
      BAR_SYNC();
      for (int c = 0; c < 256; ++c) {
        if (c > 0) {
          const float4* yp = (const float4*)(ybuf + ((c - 1) & 1) * 4096 + tid * 16);
          const float4 y0 = yp[0], y1 = yp[1], y2 = yp[2], y3 = yp[3];
          const float yv = ((y0.x + y0.y) + (y0.z + y0.w)) + ((y1.x + y1.y) + (y1.z + y1.w)) + ((y2.x + y2.y) + (y2.z + y2.w)) + ((y3.x + y3.y) + (y3.z + y3.w));
          Y[(rowbase + (size_t)(c - 1) * 16 + rl) * LDH + h * 64 + qr * 16 + cgp] = f2bf(yv);
        }
        const float* bufp = ring + (c & 1) * PAIR_BUF;
        float* yb = ybuf + (c & 1) * 4096;
        struct PV {
          float4 a1, aw, w12, b1w, k1w, b2, k2, wr1, wr2, sc0, sc1;
          float v1, v2;
        };
        auto ldpair = [&](const float* slot) __attribute__((always_inline)) {
          PV r;
          r.a1 = *(const float4*)(slot + cgp * 4);
          r.aw = *(const float4*)(slot + 64 + cgp * 4);
          r.w12 = *(const float4*)(slot + 128 + cgp * 4);
          r.b1w = *(const float4*)(slot + 192 + cgp * 4);
          r.k1w = *(const float4*)(slot + 256 + cgp * 4);
          r.b2 = *(const float4*)(slot + 320 + cgp * 4);
          r.k2 = *(const float4*)(slot + 384 + cgp * 4);
          r.wr1 = *(const float4*)(slot + 448 + cgp * 4);
          r.wr2 = *(const float4*)(slot + 512 + cgp * 4);
          r.v1 = slot[576 + rl];
          r.v2 = slot[592 + rl];
          r.sc0 = *(const float4*)(slot + 608);
          r.sc1 = *(const float4*)(slot + 612);
          return r;
        };
        PV cur = ldpair(bufp);
#pragma unroll
        for (int pr = 0; pr < 8; ++pr) {
          PV nxt = cur;
          if (pr + 1 < 8) nxt = ldpair(bufp + (pr + 1) * PAIR_TS);
          float d1 = s0 * cur.a1.x + s1 * cur.a1.y + s2 * cur.a1.z + s3 * cur.a1.w;
          float d2 = s0 * cur.aw.x + s1 * cur.aw.y + s2 * cur.aw.z + s3 * cur.aw.w;
          const float e1 = s0 * cur.wr1.x + s1 * cur.wr1.y + s2 * cur.wr1.z + s3 * cur.wr1.w;
          const float e2 = s0 * cur.wr2.x + s1 * cur.wr2.y + s2 * cur.wr2.z + s3 * cur.wr2.w;
          const float t0 = s0 * cur.w12.x + cur.v1 * cur.k1w.x + cur.v2 * cur.k2.x;
          const float t1 = s1 * cur.w12.y + cur.v1 * cur.k1w.y + cur.v2 * cur.k2.y;
          const float t2 = s2 * cur.w12.z + cur.v1 * cur.k1w.z + cur.v2 * cur.k2.z;
          const float t3 = s3 * cur.w12.w + cur.v1 * cur.k1w.w + cur.v2 * cur.k2.w;
          d1 = rowsum16(d1);
          d2 = rowsum16(d2);
          const float sa1 = d1;
          const float sa2 = d2 + sa1 * cur.sc0.x + cur.v1 * cur.sc0.y;
          s0 = t0 + sa1 * cur.b1w.x + sa2 * cur.b2.x;
          s1 = t1 + sa1 * cur.b1w.y + sa2 * cur.b2.y;
          s2 = t2 + sa1 * cur.b1w.z + sa2 * cur.b2.z;
          s3 = t3 + sa1 * cur.b1w.w + sa2 * cur.b2.w;
          yb[(2 * pr) * 256 + tid] = e1 + 0.0625f * (sa1 * cur.sc0.z + cur.v1 * cur.sc0.w);
          yb[(2 * pr + 1) * 256 + tid] = e2 + 0.0625f * (sa1 * cur.sc1.x + cur.v1 * cur.sc1.y + sa2 * cur.sc1.z + cur.v2 * cur.sc1.w);
          cur = nxt;
        }
        BAR_SYNC();
      }
      {
        const float4* yp = (const float4*)(ybuf + (255 & 1) * 4096 + tid * 16);
        const float4 y0 = yp[0], y1 = yp[1], y2 = yp[2], y3 = yp[3];
        const float yv = ((y0.x + y0.y) + (y0.z + y0.w)) + ((y1.x + y1.y) + (y1.z + y1.w)) + ((y2.x + y2.y) + (y2.z + y2.w)) + ((y3.x + y3.y) + (y3.z + y3.w));
        Y[(rowbase + (size_t)255 * 16 + rl) * LDH + h * 64 + qr * 16 + cgp] = f2bf(yv);
      }
      float* wo = p.out + O_WKVP + (((size_t)(b * 16 + h) * 64) + qr * 16 + rl) * 64 + cgp * 4;
      *(float4*)wo = make_float4(s0, s1, s2, s3);
    }
  }
  float* sl = (float*)lds;
  for (int chain = blockIdx.x; chain < 2048; chain += gridDim.x) {
    const int b = chain >> 4, h = chain & 15;
    const size_t row = (size_t)NP + b;
    __syncthreads();
    if (w == 0) {
      const int ch = h * 64 + lane;
      const size_t off = row * 1024 + ch;
      const float rf = bf2f(R[off]), kf = bf2f(Kk[off]), vf = bf2f(V[off]), af = bf2f(Aa[off]), ef = h2f(EW[off]);
      const float kkr = kf * p.rw_kk[ch];
      const float ss = wavesum(kkr * kkr);
      const float inv = 1.f / fmaxf(sqrtf(ss), 1e-12f);
      const float kp = kf * (1.f + (af - 1.f) * p.rw_ka[ch]);
      const float rks = wavesum(rf * kp * p.rw_rk[ch]);
      sl[lane] = -kkr * inv;
      sl[64 + lane] = __expf(-ef);
      sl[128 + lane] = kkr * inv * af;
      sl[192 + lane] = kp;
      sl[256 + lane] = rf;
      sl[320 + lane] = vf;
      if (lane == 0) RK[row * 16 + h] = rks;
    }
    __syncthreads();
    const int i = tid >> 3, c8 = tid & 7;
    const float* sp = p.state_wkv + (((size_t)(b * 16 + h) * 64) + i) * 64 + c8 * 8;
    float4 sA = *(const float4*)sp, sB = *(const float4*)(sp + 4);
    float s[8] = {sA.x, sA.y, sA.z, sA.w, sB.x, sB.y, sB.z, sB.w};
    float sa = 0.f;
#pragma unroll
    for (int j = 0; j < 8; ++j) sa += s[j] * sl[c8 * 8 + j];
    sa += __shfl_xor(sa, 1);
    sa += __shfl_xor(sa, 2);
    sa += __shfl_xor(sa, 4);
    const float vv = sl[320 + i];
    float y = 0.f;
#pragma unroll
    for (int j = 0; j < 8; ++j) {
      const int cj = c8 * 8 + j;
      s[j] = s[j] * sl[64 + cj] + sa * sl[128 + cj] + vv * sl[192 + cj];
      y += s[j] * sl[256 + cj];
    }
    y += __shfl_xor(y, 1);
    y += __shfl_xor(y, 2);
    y += __shfl_xor(y, 4);
    float* wo = p.out + O_WKVS + (((size_t)(b * 16 + h) * 64) + i) * 64 + c8 * 8;
    *(float4*)wo = make_float4(s[0], s[1], s[2], s[3]);
    *(float4*)(wo + 4) = make_float4(s[4], s[5], s[6], s[7]);
    if (c8 == 0) Y[row * LDH + h * 64 + i] = f2bf(y);
  }
}

__device__ __forceinline__ void phase_gate(const Params& p, char* lds) {
  const u16* wt = (const u16*)(p.ws + WS_WT);
  const u16* GH = (const u16*)(p.ws + S_GH);
  const u16* V = (const u16*)(p.ws + S_V);
  const float* RK = (const float*)(p.ws + WS_RK);
  u16* Y = (u16*)(p.ws + WS_H);
  for (int t = blockIdx.x; t < 65 * 4; t += gridDim.x) {
    const int mt = t >> 2, nt = t & 3;
    const int m0 = mt * 256, n0 = nt * 256;
    gemm_tile256(GH, 128, wt + WT_G2, 128, 128, m0, n0, lds, mt == 64, [&](EPI_ARGS) {
      const int hh = (n0 + wn * 64) >> 6;
#pragma unroll
      for (int mi = 0; mi < 8; ++mi) {
        const int row = m0 + wm * 128 + mi * 16 + lr;
        const int rowc = row < MROWS ? row : MROWS - 1;
        float yv[4][4];
        float sum = 0.f;
#pragma unroll
        for (int ni = 0; ni < 4; ++ni) {
          const uint2 yy = *(const uint2*)(Y + (size_t)rowc * LDH + hh * 64 + ni * 16 + lg * 4);
          yv[ni][0] = bflo(yy.x); yv[ni][1] = bfhi(yy.x); yv[ni][2] = bflo(yy.y); yv[ni][3] = bfhi(yy.y);
          sum += yv[ni][0] + yv[ni][1] + yv[ni][2] + yv[ni][3];
        }
        sum += __shfl_xor(sum, 16);
        sum += __shfl_xor(sum, 32);
        const float mu = sum * (1.f / 64.f);
        float vs = 0.f;
#pragma unroll
        for (int ni = 0; ni < 4; ++ni)
#pragma unroll
          for (int q = 0; q < 4; ++q) {
            const float d = yv[ni][q] - mu;
            vs += d * d;
          }
        vs += __shfl_xor(vs, 16);
        vs += __shfl_xor(vs, 32);
        const float rstd = rsqrtf(vs * (1.f / 64.f) + 64e-5f);
        const float rk = RK[(size_t)rowc * 16 + hh];
#pragma unroll
        for (int ni = 0; ni < 4; ++ni) {
          const int col0 = hh * 64 + ni * 16 + lg * 4;
          const uint2 vv = *(const uint2*)(V + (size_t)rowc * 1024 + col0);
          const float vf[4] = {bflo(vv.x), bfhi(vv.x), bflo(vv.y), bfhi(vv.y)};
          const float4 g4 = *(const float4*)(p.rw_lnx_g + col0), b4 = *(const float4*)(p.rw_lnx_b + col0);
          const float gg[4] = {g4.x, g4.y, g4.z, g4.w}, bb[4] = {b4.x, b4.y, b4.z, b4.w};
          f32x4 o;
#pragma unroll
          for (int q = 0; q < 4; ++q) o[q] = ((yv[ni][q] - mu) * rstd * gg[q] + bb[q] + rk * vf[q]) * acc[mi][ni][q];
          if (row < MROWS) *(uint2*)(Y + (size_t)row * LDH + col0) = pack4(o);
        }
        __builtin_amdgcn_sched_barrier(0);
      }
    });
  }
}

__device__ __forceinline__ void phase_oproj(const Params& p, char* lds, const u16* A, int K, const u16* Bt, int layer, int gidx, bool first) {
  const int ldab = K == 1024 ? LDH : LDU;
  const float* mod = (const float*)(p.ws + WS_MOD);
  for (int u = blockIdx.x; u < 320; u += gridDim.x) {
    const bool split = u >= 256;
    const int s = u - 256;
    const int m0 = split ? NP : (u >> 2) * 256, n0 = (split ? (s & 3) : (u & 3)) * 256;
    const int klen = split ? (K >> 4) : K, kbeg = split ? (s >> 2) * klen : 0;
    gemm_tile256(A + kbeg, ldab, Bt + kbeg, ldab, klen, m0, n0, lds, split, [&](EPI_ARGS) {
      EPI_FOREACH(acc, if (row < MROWS) {
        const float4 gt = *(const float4*)(mod + ((size_t)layer * 132 + bidx_of(row)) * 6144 + gidx * 1024 + col0);
        float* xp = p.out + (size_t)row * 1024 + col0;
        if (split) {
          unsafeAtomicAdd(xp + 0, gt.x * v[0]);
          unsafeAtomicAdd(xp + 1, gt.y * v[1]);
          unsafeAtomicAdd(xp + 2, gt.z * v[2]);
          unsafeAtomicAdd(xp + 3, gt.w * v[3]);
        } else {
          const float* xi = first ? p.x_prompt + (size_t)row * 1024 + col0 : xp;
          const float4 xo = *(const float4*)xi;
          *(float4*)xp = make_float4(xo.x + gt.x * v[0], xo.y + gt.y * v[1], xo.z + gt.z * v[2], xo.w + gt.w * v[3]);
        }
      })
    });
  }
}

__device__ __forceinline__ void phase_up(const Params& p, char* lds, const u16* Bt) {
  const u16* H = (const u16*)(p.ws + WS_H);
  u16* UP = (u16*)(p.ws + S_UP);
  for (int t = blockIdx.x; t < 65 * 16; t += gridDim.x) {
    const int mt = t >> 4, nt = t & 15;
    const int m0 = mt * 256, n0 = nt * 256;
    gemm_tile256(H, LDH, Bt, LDH, 1024, m0, n0, lds, mt == 64, [&](EPI_ARGS) {
      EPI_FOREACH(acc, if (row < MROWS) {
        f32x4 o;
        _Pragma("unroll") for (int q = 0; q < 4; ++q) {
          const float rl = fmaxf(v[q], 0.f);
          o[q] = rl * rl;
        }
        *(uint2*)(UP + (size_t)row * LDU + col0) = pack4(o);
      })
    });
  }
}

__device__ __forceinline__ void phase_qkv(const Params& p, char* lds) {
  const u16* H = (const u16*)(p.ws + WS_H);
  const u16* wt = (const u16*)(p.ws + WS_WT);
  const float* tab = (const float*)(p.ws + WS_TAB);
  u16* Qb = (u16*)(p.ws + S_Q);
  u16* Kb = (u16*)(p.ws + S_KB);
  u16* Vt = (u16*)(p.ws + S_VT);
  for (int t = blockIdx.x; t < 65 * 6; t += gridDim.x) {
    const int mt = t / 6, nt = t % 6;
    const int m0 = mt * 256, n0 = nt * 256;
    gemm_tile256(H, LDH, wt + WT_QKV, LDH, 1024, m0, n0, lds, mt == 64, [&](EPI_ARGS) {
      const int hc0 = n0 + wn * 64;
#pragma unroll
      for (int mi = 0; mi < 8; ++mi) {
        const int row = m0 + wm * 128 + mi * 16 + lr;
        const bool valid = row < MROWS;
        const bool isp = row < NP;
        const int pos = row & 4095;
        const int bq = isp ? (row >> 12) : (row - NP);
        const int posidx = isp ? pos : 4096;
#pragma unroll
        for (int ni = 0; ni < 4; ++ni) {
          const int col0 = hc0 + ni * 16 + lg * 4;
          const float4 b4 = *(const float4*)(p.at_bqkv + col0);
          f32x4 v = acc[mi][ni];
          v[0] += b4.x; v[1] += b4.y; v[2] += b4.z; v[3] += b4.w;
          if (ni == 0 && hc0 < 1280) {
            const float* tp = tab + (size_t)posidx * 16 + (lg & 1) * 8;
            const float4 t0 = *(const float4*)tp, t1 = *(const float4*)(tp + 4);
            const float cs[4] = {t0.x, t0.z, t1.x, t1.z}, sn[4] = {t0.y, t0.w, t1.y, t1.w};
#pragma unroll
            for (int q = 0; q < 4; ++q) {
              const float pv = __shfl_xor(v[q], 32);
              v[q] = (lg < 2) ? (v[q] * cs[q] - pv * sn[q]) : (v[q] * cs[q] + pv * sn[q]);
            }
          }
          if (valid) {
            if (hc0 < 1024) {
              *(uint2*)(Qb + (size_t)row * 1024 + col0) = pack4(v);
            } else if (hc0 < 1280) {
              const int c2 = col0 - 1024;
              *(uint2*)(Kb + (size_t)row * 256 + c2) = pack4(v);
              if (isp) {
                if (pos >= 3968) *(float4*)(p.out + O_KP + ((size_t)(bq * 128 + pos - 3968)) * 256 + c2) = make_float4(v[0], v[1], v[2], v[3]);
              } else {
                *(float4*)(p.out + O_KS + ((size_t)(bq * 128 + 127)) * 256 + c2) = make_float4(v[0], v[1], v[2], v[3]);
              }
            } else {
              const int c3 = col0 - 1280;
              if (isp) {
                u16* vp = Vt + ((size_t)(bq * 4 + (c3 >> 6)) * 64 + (c3 & 63)) * 4096 + pos;
#pragma unroll
                for (int q = 0; q < 4; ++q) vp[(size_t)q * 4096] = f2bf(v[q]);
                if (pos >= 3968) *(float4*)(p.out + O_VP + ((size_t)(bq * 128 + pos - 3968)) * 256 + c3) = make_float4(v[0], v[1], v[2], v[3]);
              } else {
                *(float4*)(p.out + O_VS + ((size_t)(bq * 128 + 127)) * 256 + c3) = make_float4(v[0], v[1], v[2], v[3]);
              }
            }
          }
        }
        __builtin_amdgcn_sched_barrier(0);
      }
    });
  }
}

constexpr int AT_KS = 0, AT_VS = 36864, AT_PS = 36864 + 35840, AT_PW = 5376;

__device__ __forceinline__ void phase_attn(const Params& p, char* lds) {
  const int tid = threadIdx.x, lane = tid & 63, w = tid >> 6, lr = lane & 15, lg = lane >> 4;
  const u16* Qb = (const u16*)(p.ws + S_Q);
  const u16* Kb = (const u16*)(p.ws + S_KB);
  const u16* Vt = (const u16*)(p.ws + S_VT);
  u16* O = (u16*)(p.ws + S_O);
  char* Ks = lds + AT_KS;
  char* Vs = lds + AT_VS;
  char* Ps = lds + AT_PS + w * AT_PW;
  for (int u = blockIdx.x; u < 512; u += gridDim.x) {
    const int b = u >> 7, n = (u >> 2) & 31, kvh = u & 3;
    bf16x8 qfa[4][2];
    {
      const int g_ = w >> 1, hf_ = w & 1, qh_ = kvh * 4 + g_;
#pragma unroll
      for (int i = 0; i < 4; ++i) {
        const size_t tok = (size_t)b * 4096 + n * 128 + hf_ * 64 + i * 16 + lr;
        qfa[i][0] = *(const bf16x8*)(Qb + tok * 1024 + qh_ * 64 + lg * 8);
        qfa[i][1] = *(const bf16x8*)(Qb + tok * 1024 + qh_ * 64 + 32 + lg * 8);
      }
    }
    __syncthreads();
#pragma unroll
    for (int i = 0; i < 4; ++i) {
      const int c = tid + 512 * i;
      {
        const int key = c >> 3, kc = c & 7;
        const int pos = n * 128 - 128 + key;
        uint4 v = {0u, 0u, 0u, 0u};
        if (pos >= 0) v = *(const uint4*)(Kb + ((size_t)b * 4096 + pos) * 256 + kvh * 64 + kc * 8);
        *(uint4*)(Ks + key * 144 + kc * 16) = v;
      }
      {
        const int d = c >> 5, kc = c & 31;
        const int pos0 = n * 128 - 128 + kc * 8;
        uint4 v = {0u, 0u, 0u, 0u};
        if (pos0 >= 0) v = *(const uint4*)(Vt + ((size_t)(b * 4 + kvh) * 64 + d) * 4096 + pos0);
        *(uint4*)(Vs + d * 560 + kc * 16) = v;
      }
    }
    if (tid < 192) {
      const int d = tid / 3, c = tid % 3;
      *(uint4*)(Vs + d * 560 + 512 + c * 16) = uint4{0u, 0u, 0u, 0u};
    }
    {
      const int prow = lane >> 2, pc = 144 + (lane & 3) * 4;
      *(uint2*)(Ps + prow * 336 + pc * 2) = uint2{0u, 0u};
    }
    __syncthreads();
    const int g = w >> 1, hf = w & 1;
    const int qh = kvh * 4 + g;
    const float sink = p.at_sink[qh];
#pragma unroll
    for (int i = 0; i < 4; ++i) {
      const int q0 = hf * 64 + i * 16;
      const bf16x8 qf0 = qfa[i][0];
      const bf16x8 qf1 = qfa[i][1];
      f32x4 s[9];
#pragma unroll
      for (int j = 0; j < 9; ++j) {
        const char* kp = Ks + (q0 + j * 16 + lr) * 144 + lg * 16;
        const bf16x8 k0 = *(const bf16x8*)kp;
        const bf16x8 k1 = *(const bf16x8*)(kp + 64);
        f32x4 z = {0.f, 0.f, 0.f, 0.f};
        z = __builtin_amdgcn_mfma_f32_16x16x32_bf16(qf0, k0, z, 0, 0, 0);
        z = __builtin_amdgcn_mfma_f32_16x16x32_bf16(qf1, k1, z, 0, 0, 0);
        s[j] = z;
      }
      float mx[4], sum[4];
#pragma unroll
      for (int r = 0; r < 4; ++r) {
        const int ql = lg * 4 + r;
        float m = sink;
#pragma unroll
        for (int j = 0; j < 9; ++j) {
          float v = s[j][r] * 0.125f;
          bool ok = true;
          if (j == 0) ok = (lr >= ql);
          if (j == 8) ok = (lr <= ql);
          if (n == 0 && (q0 + j * 16 + lr) < 128) ok = false;
          v = ok ? v : -INFINITY;
          s[j][r] = v;
          m = fmaxf(m, v);
        }
        mx[r] = rowmax16(m);
      }
#pragma unroll
      for (int r = 0; r < 4; ++r) {
        float sm = 0.f;
#pragma unroll
        for (int j = 0; j < 9; ++j) {
          const float e = __expf(s[j][r] - mx[r]);
          s[j][r] = e;
          sm += e;
        }
        sm = rowsum16(sm);
        sum[r] = sm + __expf(sink - mx[r]);
      }
      u16* P = (u16*)Ps;
#pragma unroll
      for (int j = 0; j < 9; ++j)
#pragma unroll
        for (int r = 0; r < 4; ++r) P[(lg * 4 + r) * 168 + j * 16 + lr] = f2bf(s[j][r]);
      __builtin_amdgcn_wave_barrier();
      f32x4 o[4];
#pragma unroll
      for (int nd = 0; nd < 4; ++nd) o[nd] = f32x4{0.f, 0.f, 0.f, 0.f};
#pragma unroll
      for (int kk = 0; kk < 5; ++kk) {
        const bf16x8 pf = *(const bf16x8*)(Ps + lr * 336 + kk * 64 + lg * 16);
#pragma unroll
        for (int nd = 0; nd < 4; ++nd) {
          const bf16x8 vf = *(const bf16x8*)(Vs + (nd * 16 + lr) * 560 + (q0 + kk * 32 + lg * 8) * 2);
          o[nd] = __builtin_amdgcn_mfma_f32_16x16x32_bf16(pf, vf, o[nd], 0, 0, 0);
        }
      }
#pragma unroll
      for (int nd = 0; nd < 4; ++nd)
#pragma unroll
        for (int r = 0; r < 4; ++r) {
          const float v = o[nd][r] / sum[r];
          O[((size_t)b * 4096 + n * 128 + q0 + lg * 4 + r) * LDH + qh * 64 + nd * 16 + lr] = f2bf(v);
        }
      __builtin_amdgcn_wave_barrier();
    }
  }
  float* qs = (float*)lds;
  float* sc = (float*)(lds + 1024);
  float* part = (float*)(lds + 1024 + 2112);
  for (int it = blockIdx.x; it < 512; it += gridDim.x) {
    const int b = it >> 2, kvh = it & 3;
    const size_t row = (size_t)NP + b;
    __syncthreads();
    if (tid < 256) qs[tid] = bf2f(Qb[row * 1024 + kvh * 256 + tid]);
    __syncthreads();
    {
      const int key = tid >> 2, g = tid & 3;
      const float* kp = p.cache_k + (((size_t)b * 128 + key) * 4 + kvh) * 64;
      float dot = 0.f;
#pragma unroll
      for (int d4 = 0; d4 < 16; ++d4) {
        const float4 kv = *(const float4*)(kp + d4 * 4);
        const float* q = qs + g * 64 + d4 * 4;
        dot += kv.x * q[0] + kv.y * q[1] + kv.z * q[2] + kv.w * q[3];
      }
      sc[g * 132 + key] = dot * 0.125f;
      if (key >= 1) {
        float* dst = p.out + O_KS + (((size_t)b * 128 + key - 1) * 4 + kvh) * 64 + g * 16;
        const float* src = kp + g * 16;
#pragma unroll
        for (int d4 = 0; d4 < 4; ++d4) *(float4*)(dst + d4 * 4) = *(const float4*)(src + d4 * 4);
      }
      if (tid < 4) {
        const float* kn = p.out + O_KS + (((size_t)b * 128 + 127) * 4 + kvh) * 64;
        float d2 = 0.f;
        for (int d = 0; d < 64; ++d) d2 += kn[d] * qs[tid * 64 + d];
        sc[tid * 132 + 128] = d2 * 0.125f;
      }
    }
    __syncthreads();
    if (w < 4) {
      const float sink = p.at_sink[kvh * 4 + w];
      float* s = sc + w * 132;
      const float v0 = s[lane], v1 = s[64 + lane], v2 = lane == 0 ? s[128] : -INFINITY;
      float m = fmaxf(fmaxf(v0, v1), fmaxf(v2, sink));
      m = wavemax(m);
      const float e0 = __expf(v0 - m), e1 = __expf(v1 - m), e2 = lane == 0 ? __expf(v2 - m) : 0.f;
      float sm = wavesum(e0 + e1 + e2) + __expf(sink - m);
      const float inv = 1.f / sm;
      s[lane] = e0 * inv;
      s[64 + lane] = e1 * inv;
      if (lane == 0) s[128] = e2 * inv;
    }
    __syncthreads();
    {
      const int d = tid & 63, g = (tid >> 6) & 3, half = tid >> 8;
      const float* vp = p.cache_v + (((size_t)b * 128) * 4 + kvh) * 64 + d;
      float accv = 0.f;
      for (int key = half * 64; key < half * 64 + 64; ++key) {
        const float vv = vp[(size_t)key * 256];
        accv += sc[g * 132 + key] * vv;
        if (g == 0 && key >= 1) p.out[O_VS + (((size_t)b * 128 + key - 1) * 4 + kvh) * 64 + d] = vv;
      }
      if (half == 1) accv += sc[g * 132 + 128] * p.out[O_VS + (((size_t)b * 128 + 127) * 4 + kvh) * 64 + d];
      part[(half * 4 + g) * 64 + d] = accv;
    }
    __syncthreads();
    if (tid < 256) {
      const int d = tid & 63, g = tid >> 6;
      O[row * LDH + (kvh * 4 + g) * 64 + d] = f2bf(part[g * 64 + d] + part[(4 + g) * 64 + d]);
    }
  }
}

__global__ void __launch_bounds__(NTHR) mega(Params p) {
  extern __shared__ __attribute__((aligned(16))) char lds[];
  cg::grid_group grid = cg::this_grid();
  volatile LAS unsigned* xst = (volatile LAS unsigned*)(lds + LDS_BYTES);
  if (threadIdx.x == 0) { xst[0] = 0u; xst[1] = 0u; }
  __syncthreads();
  const XcdBarrier xb = xcd_barrier_post((unsigned*)(p.ws + WS_BAR), xst);
  const u16* wt = (const u16*)(p.ws + WS_WT);
  phase0(p, lds);
  if (p.out == nullptr) grid.sync();
  xcd_barrier(xb);
  phase_ada(p, lds);
  xcd_barrier(xb);
  phase_norm_mix(p);
  xcd_barrier(xb);
  phase_rwkv_proj(p, lds);
  xcd_barrier(xb);
  phase_rwkv_lora2(p, lds);
  xcd_barrier(xb);
  phase_scan(p, lds);
  xcd_barrier(xb);
  phase_gate(p, lds);
  xcd_barrier(xb);
  phase_oproj(p, lds, (const u16*)(p.ws + WS_H), 1024, wt + WT_WO, 0, 2, true);
  xcd_barrier(xb);
  phase_norm(p, 0, 1, false, false);
  xcd_barrier(xb);
  phase_up(p, lds, wt + WT_UP0);
  xcd_barrier(xb);
  phase_oproj(p, lds, (const u16*)(p.ws + S_UP), 4096, wt + WT_DN0, 0, 5, false);
  xcd_barrier(xb);
  phase_norm(p, 1, 0, false, false);
  xcd_barrier(xb);
  phase_qkv(p, lds);
  xcd_barrier(xb);
  phase_attn(p, lds);
  xcd_barrier(xb);
  phase_oproj(p, lds, (const u16*)(p.ws + S_O), 1024, wt + WT_WO1, 1, 2, false);
  xcd_barrier(xb);
  phase_norm(p, 1, 1, false, false);
  xcd_barrier(xb);
  phase_up(p, lds, wt + WT_UP1);
  xcd_barrier(xb);
  phase_oproj(p, lds, (const u16*)(p.ws + S_UP), 4096, wt + WT_DN1, 1, 5, false);
  xcd_barrier(xb);
  phase_final(p);
}

extern "C" void kernel_launch(void* const* d_in, const int* in_sizes, int n_in, void* d_out, int out_size, void* d_ws,
                              size_t ws_size, hipStream_t stream) {
  static int grid_blocks = 0;
  if (grid_blocks == 0) {
    if (ws_size < WS_END) {
      fprintf(stderr, "kernel_launch: workspace too small: %zu < %zu\n", ws_size, (size_t)WS_END);
      grid_blocks = -1;
      return;
    }
    int dev = 0, cus = 0, per_cu = 0;
    hipGetDevice(&dev);
    hipDeviceGetAttribute(&cus, hipDeviceAttributeMultiprocessorCount, dev);
    hipFuncSetAttribute((const void*)mega, hipFuncAttributeMaxDynamicSharedMemorySize, LDS_BYTES + 16);
    hipOccupancyMaxActiveBlocksPerMultiprocessor(&per_cu, (const void*)mega, NTHR, LDS_BYTES + 16);
    if (per_cu < 1) per_cu = 1;
    grid_blocks = cus * per_cu;
  }
  if (grid_blocks < 0) return;
  Params p{};
  const float** pp = (const float**)&p;
  for (int i = 0; i < 37; ++i) pp[i] = (const float*)d_in[i];
  p.out = (float*)d_out;
  p.ws = (char*)d_ws;
  hipMemsetAsync((char*)d_ws + WS_BAR, 0, 16384, stream);
  void* args[] = {&p};
  hipError_t e = hipLaunchCooperativeKernel((const void*)mega, dim3(grid_blocks), dim3(NTHR), args, LDS_BYTES + 16, stream);
  if (e != hipSuccess) fprintf(stderr, "cooperative launch failed: %s (grid %d)\n", hipGetErrorString(e), grid_blocks);
}
```

```cpp
#include <hip/hip_runtime.h>
#include <hip/hip_cooperative_groups.h>
#include <cstdio>
namespace cg = cooperative_groups;

typedef unsigned short u16;
typedef __attribute__((ext_vector_type(8))) short bf16x8;
typedef __attribute__((ext_vector_type(4))) float f32x4;

constexpr int NP = 16384, MROWS = 16512, MPAD = 16640;
constexpr int NTHR = 512;
constexpr size_t MEG = 1048576;
constexpr int LDH = 1088, LDU = 4160;

constexpr size_t O_Y = 0, O_WKVP = 16908288, O_WKVS = 17170432, O_SHP = 25559040, O_SHS = 25563136,
                 O_KP = 25694208, O_KS = 25825280, O_VP = 30019584, O_VS = 30150656;

constexpr size_t WT_WR = 0, WT_WK = WT_WR + 1024 * LDH, WT_WV = WT_WK + 1024 * LDH, WT_WO = WT_WV + 1024 * LDH,
                 WT_W1 = WT_WO + 1024 * LDH, WT_A1 = WT_W1 + 64 * LDH, WT_G1 = WT_A1 + 64 * LDH, WT_W2 = WT_G1 + 128 * LDH,
                 WT_A2 = WT_W2 + 65536, WT_G2 = WT_A2 + 65536, WT_UP0 = WT_G2 + 131072, WT_DN0 = WT_UP0 + 4096 * LDH,
                 WT_QKV = WT_DN0 + 1024 * LDU, WT_WO1 = WT_QKV + 1536 * LDH, WT_UP1 = WT_WO1 + 1024 * LDH,
                 WT_DN1 = WT_UP1 + 4096 * LDH, WT_END = WT_DN1 + 1024 * LDU;
constexpr size_t WS_WT = 0;
constexpr size_t WS_H = WS_WT + WT_END * 2;
constexpr size_t WS_ZR = WS_H + (size_t)MPAD * LDH * 2;
constexpr size_t WS_MOD = WS_ZR + (size_t)LDH * 2;
constexpr size_t WS_TAB = WS_MOD + (size_t)2 * 132 * 6144 * 4;
constexpr size_t WS_HS = WS_H + (size_t)MROWS * LDH * 2;
constexpr size_t WS_RK = WS_TAB + (size_t)4097 * 8 * 8;
constexpr size_t WS_BAR = WS_RK + (size_t)MPAD * 16 * 4;
constexpr size_t WS_S = WS_BAR + 16384;
constexpr size_t RSZ = (size_t)MROWS * 1024 * 2;
constexpr size_t S_ADAWT = WS_S, S_SILUC = S_ADAWT + (size_t)2 * 6144 * LDH * 2;
constexpr size_t S_R = WS_S, S_K = S_R + RSZ, S_V = S_K + RSZ, S_EW = S_V + RSZ, S_A = S_EW + RSZ,
                 S_WH = S_A + RSZ, S_AH = S_WH + (size_t)MPAD * 64 * 2, S_GH = S_AH + (size_t)MPAD * 64 * 2,
                 S_RW_END = S_GH + (size_t)MPAD * 128 * 2;
constexpr size_t S_UP = WS_S;
constexpr size_t S_Q = WS_S, S_O = S_Q + (size_t)MPAD * 1024 * 2, S_KB = S_O + (size_t)MPAD * LDH * 2,
                 S_VT = S_KB + (size_t)MPAD * 256 * 2;
constexpr size_t WS_END = S_RW_END;
static_assert(S_UP + (size_t)MPAD * LDU * 2 <= WS_END, "up fits");
static_assert(S_VT + (size_t)16 * 64 * 4096 * 2 <= WS_END, "attn fits");
static_assert(WS_END <= 282000000, "ws fits sum of inputs");

constexpr int LDS_ROW = 144;
constexpr int LDS_A_BYTES = 256 * LDS_ROW;
constexpr int LDS_B_BYTES = 128 * LDS_ROW;
constexpr int LDS_STAGE = LDS_A_BYTES + LDS_B_BYTES;
constexpr int LDS_BYTES = 147456;

struct Params {
  const float *x_prompt, *x_sample, *c_prompt, *c_sample, *state_wkv, *state_shift, *cache_k, *cache_v;
  const float *norm1_g, *norm2_g, *ada_w, *ada_b, *mlp_up, *mlp_down, *final_g;
  const float *rw_mix, *rw_wr, *rw_wk, *rw_wv, *rw_wo, *rw_w0, *rw_w1, *rw_w2, *rw_a0, *rw_a1, *rw_a2, *rw_g1, *rw_g2,
      *rw_kk, *rw_ka, *rw_rk, *rw_lnx_g, *rw_lnx_b;
  const float *at_wqkv, *at_bqkv, *at_wo, *at_sink;
  float* out;
  char* ws;
};

__device__ __forceinline__ u16 f2bf(float f) {
  unsigned u = __float_as_uint(f);
  u += 0x7fffu + ((u >> 16) & 1u);
  return (u16)(u >> 16);
}
__device__ __forceinline__ float bf2f(u16 h) { return __uint_as_float(((unsigned)h) << 16); }
__device__ __forceinline__ float bflo(unsigned w) { return __uint_as_float(w << 16); }
__device__ __forceinline__ float bfhi(unsigned w) { return __uint_as_float(w & 0xffff0000u); }
__device__ __forceinline__ unsigned pack2(float a, float b) {
  unsigned r;
  asm volatile("v_cvt_pk_bf16_f32 %0, %1, %2" : "=v"(r) : "v"(a), "v"(b));
  return r;
}
__device__ __forceinline__ uint2 pack4(f32x4 v) { return uint2{pack2(v[0], v[1]), pack2(v[2], v[3])}; }
__device__ __forceinline__ float h2f(u16 h) { return (float)__builtin_bit_cast(_Float16, h); }
__device__ __forceinline__ u16 f2h(float f) { return __builtin_bit_cast(u16, (_Float16)f); }
__device__ __forceinline__ float sigmoidf_(float x) { return 1.f / (1.f + __expf(-x)); }

template <int CTRL>
__device__ __forceinline__ float dppf(float x) {
  return __int_as_float(__builtin_amdgcn_update_dpp(0, __float_as_int(x), CTRL, 0xf, 0xf, true));
}
__device__ __forceinline__ float rowsum16(float x) {
  x += dppf<0xB1>(x);
  x += dppf<0x4E>(x);
  x += dppf<0x124>(x);
  x += dppf<0x128>(x);
  return x;
}
__device__ __forceinline__ float rowmax16(float x) {
  x = fmaxf(x, dppf<0xB1>(x));
  x = fmaxf(x, dppf<0x4E>(x));
  x = fmaxf(x, dppf<0x124>(x));
  x = fmaxf(x, dppf<0x128>(x));
  return x;
}
__device__ __forceinline__ float wavesum(float x) {
#pragma unroll
  for (int o = 32; o > 0; o >>= 1) x += __shfl_xor(x, o);
  return x;
}
__device__ __forceinline__ float wavemax(float x) {
#pragma unroll
  for (int o = 32; o > 0; o >>= 1) x = fmaxf(x, __shfl_xor(x, o));
  return x;
}
__device__ __forceinline__ int bidx_of(int row) { return row < NP ? (row >> 12) : (4 + row - NP); }

#define XB_TMO      128
#define XB_XCNT(j)  (256  + 64 * (j))
#define XB_XSUB(j)  (1280 + 64 * (j))
#define XB_XGEN(j)  (2304 + 64 * (j))
#define XB_TOP      3328
#define XB_TOPGEN   3392
#define XCD_BAR_WORDS 3456
#define XB_SPIN_CAP (1u << 22)
#define LAS __attribute__((address_space(3)))
__device__ __forceinline__ unsigned xb_ld(unsigned* p) { return __hip_atomic_load(p, __ATOMIC_RELAXED, __HIP_MEMORY_SCOPE_AGENT); }
__device__ __forceinline__ unsigned xb_add(unsigned* p, unsigned v) { return __hip_atomic_fetch_add(p, v, __ATOMIC_RELAXED, __HIP_MEMORY_SCOPE_AGENT); }
__device__ __forceinline__ unsigned xb_xcc_id() { return (unsigned)__builtin_amdgcn_s_getreg((3 << 11) | 20) & 0xFu; }
#define XB_SPIN(cond, bar) do { unsigned _sp = 0; while (cond) { __builtin_amdgcn_s_sleep(1); \
    if ((++_sp & 255u) == 0u) { if (xb_ld(&(bar)[XB_TMO])) break; if (_sp > XB_SPIN_CAP) { atomicAdd(&(bar)[XB_TMO], 1u); break; } } } } while (0)
struct XcdBarrier {
  unsigned* bar;
  unsigned x;
  volatile LAS unsigned* st;
};
__device__ __forceinline__ XcdBarrier xcd_barrier_post(unsigned* bar, volatile LAS unsigned* st) {
  XcdBarrier b;
  b.bar = bar;
  b.x = xb_xcc_id();
  b.st = st;
  if (threadIdx.x == 0) (void)xb_add(&bar[XB_XCNT(b.x)], 1u);
  return b;
}
__device__ __forceinline__ void xcd_barrier_complete(unsigned* bar, unsigned x, unsigned& nloc, unsigned& nx) {
  const unsigned G = gridDim.x * gridDim.y * gridDim.z;
  unsigned sum, cnt, mine, sp = 0u;
  for (;;) {
    sum = 0u; cnt = 0u; mine = 0u;
#pragma unroll
    for (unsigned j = 0; j < 16; ++j) {
      const unsigned c = xb_ld(&bar[XB_XCNT(j)]);
      sum += c;
      cnt += (c > 0u) ? 1u : 0u;
      mine = (j == x) ? c : mine;
    }
    if (sum == G) break;
    __builtin_amdgcn_s_sleep(1);
    if ((++sp & 255u) == 0u) {
      if (xb_ld(&bar[XB_TMO])) break;
      if (sp > XB_SPIN_CAP) { atomicAdd(&bar[XB_TMO], 1u); break; }
    }
  }
  nloc = mine > 0u ? mine : 1u;
  nx = cnt > 0u ? cnt : 1u;
}
__device__ __forceinline__ void xcd_barrier(const XcdBarrier& b) {
  asm volatile("s_waitcnt vmcnt(0)" ::: "memory");
  __syncthreads();
  if (threadIdx.x == 0) {
    unsigned* bar = b.bar;
    __builtin_amdgcn_s_waitcnt(0);
    unsigned nloc = b.st[0], nx = b.st[1];
    if (nloc == 0u) { xcd_barrier_complete(bar, b.x, nloc, nx); b.st[0] = nloc; b.st[1] = nx; }
    const unsigned old = xb_add(&bar[XB_XSUB(b.x)], 1u);
    const unsigned gen = old / nloc;
    if (old + 1u == (gen + 1u) * nloc) {
      __builtin_amdgcn_fence(__ATOMIC_RELEASE, "agent");
      asm volatile("s_waitcnt vmcnt(0)" ::: "memory");
      const unsigned og = xb_add(&bar[XB_TOP], 1u);
      const unsigned tg = og / nx;
      if (og + 1u == (tg + 1u) * nx) xb_add(&bar[XB_TOPGEN], 1u);
      else XB_SPIN(xb_ld(&bar[XB_TOPGEN]) == tg, bar);
      __builtin_amdgcn_fence(__ATOMIC_ACQUIRE, "agent");
      xb_add(&bar[XB_XGEN(b.x)], 1u);
      asm volatile("s_waitcnt vmcnt(0)" ::: "memory");
    } else {
      XB_SPIN(xb_ld(&bar[XB_XGEN(b.x)]) == gen, bar);
      __builtin_amdgcn_fence(__ATOMIC_ACQUIRE, "agent");
      asm volatile("s_waitcnt vmcnt(0)" ::: "memory");
    }
  }
  __syncthreads();
}

#define BAR_SYNC() do { asm volatile("s_waitcnt lgkmcnt(0)" ::: "memory"); __builtin_amdgcn_s_barrier(); asm volatile("" ::: "memory"); } while (0)

__device__ __forceinline__ unsigned mix2(unsigned h, unsigned p, float m0, float m1) {
  float h0 = bflo(h), h1 = bfhi(h), p0 = bflo(p), p1 = bfhi(p);
  return pack2(h0 + (p0 - h0) * m0, h1 + (p1 - h1) * m1);
}

template <bool MIX, class Epi>
__device__ __forceinline__ void gemm_tile(const u16* __restrict__ A, int lda, const float* __restrict__ mixv,
                                          const u16* __restrict__ Bt, int ldb, int N, int K, int m0, int n0, char* lds, Epi&& epi) {
  const int tid = threadIdx.x, lane = tid & 63, w = tid >> 6;
  const int nk = K >> 6;
  if (w >= 4) {
    const int pt = tid - 256, kc = pt & 7, pr = pt >> 3;
    const u16* Ab = A + (size_t)m0 * lda + (size_t)pr * lda + kc * 8;
    int poff[8];
#pragma unroll
    for (int i = 0; i < 8; ++i) {
      poff[i] = 0;
      if (MIX) {
        const int row = m0 + pr + 32 * i;
        const int prow = row < NP ? ((row & 4095) ? row - 1 : MPAD) : (row < MROWS ? row + 128 : MPAD);
        poff[i] = prow * LDH + kc * 8;
      }
    }
    bool bv[4];
    const u16* bp[4];
#pragma unroll
    for (int j = 0; j < 4; ++j) {
      const int n = n0 + pr + 32 * j;
      bv[j] = n < N;
      bp[j] = Bt + (size_t)(bv[j] ? n : 0) * ldb + kc * 8;
    }
    struct RSet {
      uint4 ra[8], rp[8], rb[4];
      float4 mx0, mx1;
    };
    RSet SA, SB;
    auto gload = [&](RSet& S, int kt) {
      const int ko = kt * 64;
#pragma unroll
      for (int i = 0; i < 8; ++i) {
        S.ra[i] = *(const uint4*)(Ab + (size_t)(32 * i) * lda + ko);
        if (MIX) S.rp[i] = *(const uint4*)(A + poff[i] + ko);
      }
      if (MIX) {
        S.mx0 = *(const float4*)(mixv + ko + kc * 8);
        S.mx1 = *(const float4*)(mixv + ko + kc * 8 + 4);
      }
#pragma unroll
      for (int j = 0; j < 4; ++j) {
        uint4 z = {0u, 0u, 0u, 0u};
        if (bv[j]) z = *(const uint4*)(bp[j] + ko);
        S.rb[j] = z;
      }
    };
    auto lstore = [&](RSet& S, int s) {
      char* base = lds + s * LDS_STAGE + pr * LDS_ROW + kc * 16;
#pragma unroll
      for (int i = 0; i < 8; ++i) {
        uint4 v = S.ra[i];
        if (MIX) {
          v.x = mix2(S.ra[i].x, S.rp[i].x, S.mx0.x, S.mx0.y);
          v.y = mix2(S.ra[i].y, S.rp[i].y, S.mx0.z, S.mx0.w);
          v.z = mix2(S.ra[i].z, S.rp[i].z, S.mx1.x, S.mx1.y);
          v.w = mix2(S.ra[i].w, S.rp[i].w, S.mx1.z, S.mx1.w);
        }
        *(uint4*)(base + (32 * i) * LDS_ROW) = v;
      }
#pragma unroll
      for (int j = 0; j < 4; ++j) *(uint4*)(base + LDS_A_BYTES + (32 * j) * LDS_ROW) = S.rb[j];
    };
    if constexpr (!MIX) {
      gload(SB, 0);
      if (nk > 1) gload(SA, 1);
      lstore(SB, 0);
      if (nk > 2) gload(SB, 2);
      BAR_SYNC();
#pragma unroll 1
      for (int kt = 0; kt < nk; kt += 2) {
        if (kt + 1 < nk) {
          lstore(SA, 1);
          if (kt + 3 < nk) gload(SA, kt + 3);
        }
        BAR_SYNC();
        if (kt + 1 < nk) {
          if (kt + 2 < nk) {
            lstore(SB, 0);
            if (kt + 4 < nk) gload(SB, kt + 4);
          }
          BAR_SYNC();
        }
      }
    } else {
      gload(SA, 0);
      lstore(SA, 0);
      if (nk > 1) gload(SA, 1);
      BAR_SYNC();
#pragma unroll 1
      for (int kt = 0; kt < nk; ++kt) {
        if (kt + 1 < nk) {
          lstore(SA, (kt + 1) & 1);
          if (kt + 2 < nk) gload(SA, kt + 2);
        }
        BAR_SYNC();
      }
    }
  } else {
    const int wm = w >> 1, wn = w & 1, lr = lane & 15, lg = lane >> 4;
    f32x4 acc[8][4];
#pragma unroll
    for (int i = 0; i < 8; ++i)
#pragma unroll
      for (int j = 0; j < 4; ++j) acc[i][j] = f32x4{0.f, 0.f, 0.f, 0.f};
    BAR_SYNC();
#pragma unroll 1
    for (int kt = 0; kt < nk; ++kt) {
      const char* sa = lds + (kt & 1) * LDS_STAGE + (wm * 128 + lr) * LDS_ROW + lg * 16;
      const char* sb = lds + (kt & 1) * LDS_STAGE + LDS_A_BYTES + (wn * 64 + lr) * LDS_ROW + lg * 16;
      bf16x8 bq[2][4], aq[3];
#pragma unroll
      for (int ni = 0; ni < 4; ++ni) bq[0][ni] = *(const bf16x8*)(sb + ni * 16 * LDS_ROW);
      aq[0] = *(const bf16x8*)(sa);
      aq[1] = *(const bf16x8*)(sa + 16 * LDS_ROW);
#pragma unroll
      for (int ni = 0; ni < 4; ++ni) bq[1][ni] = *(const bf16x8*)(sb + ni * 16 * LDS_ROW + 64);
#pragma unroll
      for (int st = 0; st < 16; ++st) {
        if (st + 2 < 16) aq[(st + 2) % 3] = *(const bf16x8*)(sa + ((st + 2) & 7) * 16 * LDS_ROW + ((st + 2) >> 3) * 64);
#pragma unroll
        for (int ni = 0; ni < 4; ++ni)
          acc[st & 7][ni] = __builtin_amdgcn_mfma_f32_16x16x32_bf16(bq[st >> 3][ni], aq[st % 3], acc[st & 7][ni], 0, 0, 0);
        __builtin_amdgcn_sched_barrier(0);
      }
      BAR_SYNC();
    }
    epi(acc, wm, wn, lr, lg);
  }
}

constexpr int LDS_STAGE2 = 2 * LDS_A_BYTES;
template <class Epi>
__device__ __forceinline__ void gemm_tile256(const u16* __restrict__ A, int lda, const u16* __restrict__ Bt, int ldb, int K, int m0,
                                             int n0, char* lds, bool half, Epi&& epi) {
  int tid = threadIdx.x;
  asm volatile("" : "+v"(tid));
  const int lane = tid & 63, w = __builtin_amdgcn_readfirstlane(tid >> 6);
  const int wm = w >> 2, wn = w & 3, lr = lane & 15, lg = lane >> 4;
  const int nk = K >> 5;
  const int drow = lane >> 2, dch = (lane & 3) ^ ((lane >> 4) & 3);
  const u16* As0 = A + (size_t)(m0 + w * 16 + drow) * lda + dch * 8;
  const u16* As1 = A + (size_t)(m0 + (w + 8) * 16 + drow) * lda + dch * 8;
  const u16* Bs0 = Bt + (size_t)(n0 + w * 16 + drow) * ldb + dch * 8;
  const u16* Bs1 = Bt + (size_t)(n0 + (w + 8) * 16 + drow) * ldb + dch * 8;
  auto dma = [&](int kt, int stg) __attribute__((always_inline)) {
    char* sbase = lds + stg * 32768;
    const int ko = kt * 32;
    __builtin_amdgcn_global_load_lds((const unsigned*)(As0 + ko), (unsigned*)(sbase + w * 1024), 16, 0, 0);
    __builtin_amdgcn_global_load_lds((const unsigned*)(As1 + ko), (unsigned*)(sbase + (w + 8) * 1024), 16, 0, 0);
    __builtin_amdgcn_global_load_lds((const unsigned*)(Bs0 + ko), (unsigned*)(sbase + 16384 + w * 1024), 16, 0, 0);
    __builtin_amdgcn_global_load_lds((const unsigned*)(Bs1 + ko), (unsigned*)(sbase + 16384 + (w + 8) * 1024), 16, 0, 0);
  };
  f32x4 acc[8][4];
#pragma unroll
  for (int i = 0; i < 8; ++i)
#pragma unroll
    for (int j = 0; j < 4; ++j) acc[i][j] = f32x4{0.f, 0.f, 0.f, 0.f};
  const int swz = (lg ^ ((lr >> 2) & 3)) * 16;
  const int aoff = (wm * 128 + lr) * 64 + swz, boff = 16384 + (wn * 64 + lr) * 64 + swz;
  const bool skipm = half && wm == 1;
  dma(0, 0);
  dma(nk > 1 ? 1 : nk - 1, 1);
  dma(nk > 2 ? 2 : nk - 1, 2);
  asm volatile("s_waitcnt vmcnt(8)" ::: "memory");
  BAR_SYNC();
#pragma unroll 1
  for (int kt = 0; kt < nk; ++kt) {
    const char* sa = lds + (kt & 3) * 32768 + aoff;
    const char* sb = lds + (kt & 3) * 32768 + boff;
    bf16x8 bq[4], aq[3];
#pragma unroll
    for (int ni = 0; ni < 4; ++ni) bq[ni] = *(const bf16x8*)(sb + ni * 1024);
    aq[0] = *(const bf16x8*)(sa);
    aq[1] = *(const bf16x8*)(sa + 1024);
    dma(kt + 3 < nk ? kt + 3 : nk - 1, (kt + 3) & 3);
    if (!skipm) {
#pragma unroll
      for (int st = 0; st < 8; ++st) {
        if (st + 2 < 8) aq[(st + 2) % 3] = *(const bf16x8*)(sa + (st + 2) * 1024);
#pragma unroll
        for (int ni = 0; ni < 4; ++ni)
          acc[st][ni] = __builtin_amdgcn_mfma_f32_16x16x32_bf16(bq[ni], aq[st % 3], acc[st][ni], 0, 0, 0);
        __builtin_amdgcn_sched_barrier(0);
      }
    }
    asm volatile("s_waitcnt vmcnt(8)" ::: "memory");
    BAR_SYNC();
  }
  asm volatile("s_waitcnt vmcnt(0)" ::: "memory");
  BAR_SYNC();
  epi(acc, wm, wn, lr, lg);
}

#define EPI_FOREACH(acc, ...)                                    \
  _Pragma("unroll") for (int mi = 0; mi < 8; ++mi) {             \
    const int row = m0 + wm * 128 + mi * 16 + lr;                \
    _Pragma("unroll") for (int ni = 0; ni < 4; ++ni) {           \
      const int col0 = n0 + wn * 64 + ni * 16 + lg * 4;          \
      const f32x4 v = acc[mi][ni];                               \
      __VA_ARGS__                                                \
    }                                                            \
    __builtin_amdgcn_sched_barrier(0);                           \
  }
#define EPI_ARGS f32x4(&acc)[8][4], int wm, int wn, int lr, int lg

__device__ __forceinline__ void conv_job(const float* __restrict__ src, u16* __restrict__ dst, int K, int N, int ldk, float* tl, int rot) {
  int tid = threadIdx.x;
  asm volatile("" : "+v"(tid));
  const int tn = N >> 6, nt = (K >> 6) * tn;
  const int G = gridDim.x;
  int t = ((int)blockIdx.x + G - (rot % G)) % G;
  float v[8];
  auto ldtile = [&](int tt) {
    const int k0 = (tt / tn) << 6, n0 = (tt % tn) << 6;
#pragma unroll
    for (int i = 0; i < 8; ++i) {
      const int e = tid + 512 * i;
      v[i] = src[(size_t)(k0 + (e >> 6)) * N + n0 + (e & 63)];
    }
  };
  if (t < nt) ldtile(t);
  while (t < nt) {
    const int k0 = (t / tn) << 6, n0 = (t % tn) << 6;
#pragma unroll
    for (int i = 0; i < 8; ++i) {
      const int e = tid + 512 * i;
      tl[(e >> 6) * 65 + (e & 63)] = v[i];
    }
    const int tnx = t + G;
    if (tnx < nt) ldtile(tnx);
    __syncthreads();
    const int n = tid >> 3, kc = tid & 7;
    float f[8];
#pragma unroll
    for (int j = 0; j < 8; ++j) f[j] = tl[(kc * 8 + j) * 65 + n];
    uint4 o;
    o.x = pack2(f[0], f[1]);
    o.y = pack2(f[2], f[3]);
    o.z = pack2(f[4], f[5]);
    o.w = pack2(f[6], f[7]);
    *(uint4*)(dst + (size_t)(n0 + n) * ldk + k0 + kc * 8) = o;
    __syncthreads();
    t = tnx;
  }
}

__device__ __forceinline__ void phase0(const Params& p, char* lds) {
  float* tl = (float*)lds;
  u16* wt = (u16*)(p.ws + WS_WT);
  u16* adawt = (u16*)(p.ws + S_ADAWT);
  int rot = 0;
#define CJ(SRC, DST, K, N)            \
  conv_job(SRC, DST, K, N, ((K) == 1024 ? LDH : (K) == 4096 ? LDU : (K)), tl, rot);  \
  rot += ((K) >> 6) * ((N) >> 6);
  CJ(p.ada_w, adawt, 1024, 6144)
  CJ(p.ada_w + (size_t)1024 * 6144, adawt + (size_t)6144 * LDH, 1024, 6144)
  CJ(p.rw_wr, wt + WT_WR, 1024, 1024)
  CJ(p.rw_wk, wt + WT_WK, 1024, 1024)
  CJ(p.rw_wv, wt + WT_WV, 1024, 1024)
  CJ(p.rw_wo, wt + WT_WO, 1024, 1024)
  CJ(p.rw_w1, wt + WT_W1, 1024, 64)
  CJ(p.rw_a1, wt + WT_A1, 1024, 64)
  CJ(p.rw_g1, wt + WT_G1, 1024, 128)
  CJ(p.rw_w2, wt + WT_W2, 64, 1024)
  CJ(p.rw_a2, wt + WT_A2, 64, 1024)
  CJ(p.rw_g2, wt + WT_G2, 128, 1024)
  CJ(p.mlp_up, wt + WT_UP0, 1024, 4096)
  CJ(p.mlp_down, wt + WT_DN0, 4096, 1024)
  CJ(p.at_wqkv, wt + WT_QKV, 1024, 1536)
  CJ(p.at_wo, wt + WT_WO1, 1024, 1024)
  CJ(p.mlp_up + (size_t)4 * MEG, wt + WT_UP1, 1024, 4096)
  CJ(p.mlp_down + (size_t)4 * MEG, wt + WT_DN1, 4096, 1024)
#undef CJ
  const int gtid = blockIdx.x * NTHR + threadIdx.x, gsz = gridDim.x * NTHR;
  u16* siluc = (u16*)(p.ws + S_SILUC);
  for (int i = gtid; i < 256 * 1024; i += gsz) {
    int row = i >> 10, col = i & 1023;
    float c = 0.f;
    if (row < 4) c = p.c_prompt[row * 1024 + col];
    else if (row < 132) c = p.c_sample[(row - 4) * 1024 + col];
    siluc[i] = f2bf(c * sigmoidf_(c));
  }
  u16* hs = (u16*)(p.ws + WS_HS);
  for (int i = gtid; i < 128 * 1024; i += gsz) hs[(size_t)(i >> 10) * LDH + (i & 1023)] = f2bf(p.state_shift[i]);
  u16* zr = (u16*)(p.ws + WS_ZR);
  for (int i = gtid; i < LDH; i += gsz) zr[i] = 0;
  float2* tab = (float2*)(p.ws + WS_TAB);
  for (int i = gtid; i < 4097 * 8; i += gsz) {
    int pi = i >> 3, f = i & 7;
    float pos = pi < 4096 ? (float)pi : 8192.f;
    float inv = f == 0 ? 1.0f : f == 1 ? 0.1939227432012558f : f == 2 ? 0.03760603070259094f : f == 3 ? 0.007292664609849453f
              : f == 4 ? 0.0014142135623842478f : f == 5 ? 0.00027424818836152554f : f == 6 ? 5.318296098266728e-05f
              : 1.0313386155758053e-05f;
    float ang = pos * inv;
    double t = (double)ang * 0.15915494309189535;
    t -= rint(t);
    float fr = (float)t;
    tab[i] = make_float2(__builtin_amdgcn_cosf(fr), __builtin_amdgcn_sinf(fr));
  }
}

__device__ __forceinline__ void phase_ada(const Params& p, char* lds) {
  const u16* siluc = (const u16*)(p.ws + S_SILUC);
  const u16* adawt = (const u16*)(p.ws + S_ADAWT);
  float* mod = (float*)(p.ws + WS_MOD);
  for (int t = blockIdx.x; t < 96; t += gridDim.x) {
    const int layer = t / 48, nt = t % 48;
    const int m0 = 0, n0 = nt * 128;
    const float* bias = p.ada_b + layer * 6144;
    float* mo = mod + (size_t)layer * 132 * 6144;
    gemm_tile<false>(siluc, 1024, nullptr, adawt + (size_t)layer * 6144 * LDH, LDH, 6144, 1024, m0, n0, lds, [&](EPI_ARGS) {
      EPI_FOREACH(acc, if (row < 132) {
        const float4 b4 = *(const float4*)(bias + col0);
        *(float4*)(mo + (size_t)row * 6144 + col0) = make_float4(v[0] + b4.x, v[1] + b4.y, v[2] + b4.z, v[3] + b4.w);
      })
    });
  }
}

__device__ __forceinline__ void phase_norm(const Params& p, int layer, int which, bool from_input, bool shift_out) {
  const int lane = threadIdx.x & 63, w = threadIdx.x >> 6;
  const float* mod = (const float*)(p.ws + WS_MOD);
  u16* H = (u16*)(p.ws + WS_H);
  const float* g = (which ? p.norm2_g : p.norm1_g) + layer * 1024;
  const int nw = gridDim.x * 8;
  auto xrow = [&](int row) {
    return from_input ? (row < NP ? p.x_prompt + (size_t)row * 1024 : p.x_sample + (size_t)(row - NP) * 1024)
                      : (const float*)p.out + (size_t)row * 1024;
  };
  float4 gg[4];
#pragma unroll
  for (int i = 0; i < 4; ++i) gg[i] = *(const float4*)(g + lane * 4 + 256 * i);
  int row = blockIdx.x * 8 + w;
  float4 xn[4];
  if (row < MROWS) {
    const float* xr = xrow(row);
#pragma unroll
    for (int i = 0; i < 4; ++i) xn[i] = *(const float4*)(xr + lane * 4 + 256 * i);
  }
  while (row < MROWS) {
    float4 x[4];
#pragma unroll
    for (int i = 0; i < 4; ++i) x[i] = xn[i];
    const int nrow = row + nw;
    if (nrow < MROWS) {
      const float* xr = xrow(nrow);
#pragma unroll
      for (int i = 0; i < 4; ++i) xn[i] = *(const float4*)(xr + lane * 4 + 256 * i);
    }
    const int bi = bidx_of(row);
    const float* mb = mod + ((size_t)layer * 132 + bi) * 6144;
    const float* sh = mb + (which ? 3 : 0) * 1024;
    const float* sc = mb + (which ? 4 : 1) * 1024;
    float4 s4[4], c4[4];
#pragma unroll
    for (int i = 0; i < 4; ++i) {
      s4[i] = *(const float4*)(sh + lane * 4 + 256 * i);
      c4[i] = *(const float4*)(sc + lane * 4 + 256 * i);
    }
    float ss = 0.f;
#pragma unroll
    for (int i = 0; i < 4; ++i) ss += x[i].x * x[i].x + x[i].y * x[i].y + x[i].z * x[i].z + x[i].w * x[i].w;
    ss = wavesum(ss);
    const float rs = rsqrtf(ss * (1.f / 1024.f) + 1e-6f);
    const bool so = shift_out && (row >= NP || (row & 4095) == 4095);
    float* sop = row >= NP ? p.out + O_SHS + (size_t)(row - NP) * 1024 : p.out + O_SHP + (size_t)(row >> 12) * 1024;
#pragma unroll
    for (int i = 0; i < 4; ++i) {
      const int c = lane * 4 + 256 * i;
      float4 h;
      h.x = x[i].x * rs * gg[i].x * (1.f + c4[i].x) + s4[i].x;
      h.y = x[i].y * rs * gg[i].y * (1.f + c4[i].y) + s4[i].y;
      h.z = x[i].z * rs * gg[i].z * (1.f + c4[i].z) + s4[i].z;
      h.w = x[i].w * rs * gg[i].w * (1.f + c4[i].w) + s4[i].w;
      uint2 pk;
      pk.x = pack2(h.x, h.y);
      pk.y = pack2(h.z, h.w);
      *(uint2*)(H + (size_t)row * LDH + c) = pk;
      if (so) *(float4*)(sop + c) = h;
    }
    row = nrow;
  }
}

__device__ __forceinline__ void phase_norm_mix(const Params& p) {
  const int lane = threadIdx.x & 63, w = threadIdx.x >> 6;
  const float* mod = (const float*)(p.ws + WS_MOD);
  u16* H = (u16*)(p.ws + WS_H);
  u16* XR = (u16*)p.out;
  u16* XK = XR + (size_t)MROWS * 1024;
  u16* XV = (u16*)(p.ws + S_EW);
  const float* g = p.norm1_g;
  const int nw = gridDim.x * 8;
  f32x4 gg[4], mr[4], mk[4], mv[4];
#pragma unroll
  for (int i = 0; i < 4; ++i) {
    const int c = lane * 4 + 256 * i;
    gg[i] = *(const f32x4*)(g + c);
    mr[i] = *(const f32x4*)(p.rw_mix + c);
    mk[i] = *(const f32x4*)(p.rw_mix + 2 * 1024 + c);
    mv[i] = *(const f32x4*)(p.rw_mix + 3 * 1024 + c);
  }
  auto xrow = [&](int row) { return row < NP ? p.x_prompt + (size_t)row * 1024 : p.x_sample + (size_t)(row - NP) * 1024; };
  auto hrow = [&](const f32x4 (&x)[4], int row, f32x4 (&h)[4]) __attribute__((always_inline)) {
    float ss = 0.f;
#pragma unroll
    for (int i = 0; i < 4; ++i) ss += x[i][0] * x[i][0] + x[i][1] * x[i][1] + x[i][2] * x[i][2] + x[i][3] * x[i][3];
    ss = wavesum(ss);
    const float rs = rsqrtf(ss * (1.f / 1024.f) + 1e-6f);
    const float* mb = mod + (size_t)bidx_of(row) * 6144;
#pragma unroll
    for (int i = 0; i < 4; ++i) {
      const int c = lane * 4 + 256 * i;
      const f32x4 s4 = *(const f32x4*)(mb + c), c4 = *(const f32x4*)(mb + 1024 + c);
      h[i] = x[i] * rs * gg[i] * (1.f + c4) + s4;
    }
  };
  for (int chunk = blockIdx.x * 8 + w; chunk < MROWS / 8; chunk += nw) {
    const int r0 = chunk * 8;
    f32x4 hp[4], x[4], xn[4];
    if (r0 < NP && (r0 & 4095) != 0) {
      const float* xr = xrow(r0 - 1);
#pragma unroll
      for (int i = 0; i < 4; ++i) x[i] = *(const f32x4*)(xr + lane * 4 + 256 * i);
      hrow(x, r0 - 1, hp);
    } else {
#pragma unroll
      for (int i = 0; i < 4; ++i) hp[i] = f32x4{0.f, 0.f, 0.f, 0.f};
    }
    {
      const float* xr = xrow(r0);
#pragma unroll
      for (int i = 0; i < 4; ++i) xn[i] = *(const f32x4*)(xr + lane * 4 + 256 * i);
    }
#pragma unroll 1
    for (int rr = 0; rr < 8; ++rr) {
      const int row = r0 + rr;
#pragma unroll
      for (int i = 0; i < 4; ++i) x[i] = xn[i];
      if (rr + 1 < 8) {
        const float* xr = xrow(row + 1);
#pragma unroll
        for (int i = 0; i < 4; ++i) xn[i] = *(const f32x4*)(xr + lane * 4 + 256 * i);
      }
      if (row >= NP) {
#pragma unroll
        for (int i = 0; i < 4; ++i) hp[i] = *(const f32x4*)(p.state_shift + (size_t)(row - NP) * 1024 + lane * 4 + 256 * i);
      }
      f32x4 h[4];
      hrow(x, row, h);
      const bool so = row >= NP || (row & 4095) == 4095;
      float* sop = row >= NP ? p.out + O_SHS + (size_t)(row - NP) * 1024 : p.out + O_SHP + (size_t)(row >> 12) * 1024;
#pragma unroll
      for (int i = 0; i < 4; ++i) {
        const int c = lane * 4 + 256 * i;
        *(uint2*)(H + (size_t)row * LDH + c) = pack4(h[i]);
        if (so) *(f32x4*)(sop + c) = h[i];
        const f32x4 dd = hp[i] - h[i];
        *(uint2*)(XR + (size_t)row * 1024 + c) = pack4(h[i] + dd * mr[i]);
        *(uint2*)(XK + (size_t)row * 1024 + c) = pack4(h[i] + dd * mk[i]);
        *(uint2*)(XV + (size_t)row * 1024 + c) = pack4(h[i] + dd * mv[i]);
        hp[i] = h[i];
      }
    }
  }
}

__device__ __forceinline__ void phase_final(const Params& p) {
  const int lane = threadIdx.x & 63, w = threadIdx.x >> 6;
  const int nw = gridDim.x * 8;
  for (int row = blockIdx.x * 8 + w; row < MROWS; row += nw) {
    float* xr = p.out + (size_t)row * 1024;
    float4 x[4];
    float ss = 0.f;
#pragma unroll
    for (int i = 0; i < 4; ++i) {
      x[i] = *(const float4*)(xr + lane * 4 + 256 * i);
      ss += x[i].x * x[i].x + x[i].y * x[i].y + x[i].z * x[i].z + x[i].w * x[i].w;
    }
    ss = wavesum(ss);
    const float rs = rsqrtf(ss * (1.f / 1024.f) + 1e-6f);
#pragma unroll
    for (int i = 0; i < 4; ++i) {
      const int c = lane * 4 + 256 * i;
      float4 gg = *(const float4*)(p.final_g + c);
      float4 h;
      h.x = x[i].x * rs * gg.x;
      h.y = x[i].y * rs * gg.y;
      h.z = x[i].z * rs * gg.z;
      h.w = x[i].w * rs * gg.w;
      *(float4*)(xr + c) = h;
    }
  }
}

__device__ __forceinline__ void phase_rwkv_proj(const Params& p, char* lds) {
  const u16* H = (const u16*)(p.ws + WS_H);
  const u16* wt = (const u16*)(p.ws + WS_WT);
  const u16* XR = (const u16*)p.out;
  const u16* XK = XR + (size_t)MROWS * 1024;
  const u16* XV = (const u16*)(p.ws + S_EW);
  u16* R = (u16*)(p.ws + S_R);
  u16* Kk = (u16*)(p.ws + S_K);
  u16* V = (u16*)(p.ws + S_V);
  u16* WH = (u16*)(p.ws + S_WH);
  u16* AH = (u16*)(p.ws + S_AH);
  u16* GH = (u16*)(p.ws + S_GH);
  for (int u = blockIdx.x; u < 780 + 195; u += gridDim.x) {
    if (u < 780) {
      const int kind = u / 260, t = u - kind * 260;
      const int mt = t >> 2, nt = t & 3;
      const int m0 = mt * 256, n0 = nt * 256;
      const u16* A = kind == 2 ? XV : XR + (size_t)kind * ((size_t)MROWS * 1024);
      const u16* Bt = wt + WT_WR + (size_t)kind * (1024 * LDH);
      u16* dst = R + (size_t)kind * (RSZ / 2);
      gemm_tile256(A, 1024, Bt, LDH, 1024, m0, n0, lds, mt == 64, [&](EPI_ARGS) {
        EPI_FOREACH(acc, if (row < MROWS) *(uint2*)(dst + (size_t)row * 1024 + col0) = pack4(v);)
      });
    } else {
      const int s_ = u - 780;
      const int mt = s_ / 3, kind = 3 + (s_ - mt * 3);
      const int m0 = mt * 256, n0 = 0;
      const int N = kind == 5 ? 128 : 64, mixi = kind == 3 ? 1 : kind;
      const u16* Bt = wt + WT_W1 + (size_t)(kind - 3) * (64 * LDH);
      gemm_tile<true>(H, LDH, p.rw_mix + mixi * 1024, Bt, LDH, N, 1024, m0, n0, lds, [&](EPI_ARGS) {
        u16* dst = WH + (size_t)(kind - 3) * ((size_t)MPAD * 64);
        const int ld = kind == 5 ? 128 : 64;
        EPI_FOREACH(acc, if (row < MROWS && col0 < ld) {
          f32x4 o = v;
          if (kind == 3) {
            _Pragma("unroll") for (int q = 0; q < 4; ++q) o[q] = 1.f - 2.f / (__expf(2.f * v[q]) + 1.f);
          } else if (kind == 5) {
            _Pragma("unroll") for (int q = 0; q < 4; ++q) o[q] = sigmoidf_(v[q]);
          }
          *(uint2*)(dst + (size_t)row * ld + col0) = pack4(o);
        })
      });
    }
  }
}

__device__ __forceinline__ void phase_rwkv_lora2(const Params& p, char* lds) {
  {
    const int gtid = blockIdx.x * NTHR + threadIdx.x, gsz = gridDim.x * NTHR;
    for (int i = gtid; i < 128 * 256; i += gsz) ((float4*)(p.out + (size_t)NP * 1024))[i] = ((const float4*)p.x_sample)[i];
  }
  const u16* wt = (const u16*)(p.ws + WS_WT);
  const u16* WH = (const u16*)(p.ws + S_WH);
  const u16* AH = (const u16*)(p.ws + S_AH);
  u16* EW = (u16*)(p.ws + S_EW);
  u16* Aa = (u16*)(p.ws + S_A);
  for (int t = blockIdx.x; t < 65 * 8; t += gridDim.x) {
    const int mt = t >> 3, j = t & 7;
    const int m0 = mt * 256, n0 = (j & 3) * 256;
    const bool isw = j < 4;
    gemm_tile256(isw ? WH : AH, 64, wt + (isw ? WT_W2 : WT_A2), 64, 64, m0, n0, lds, mt == 64, [&](EPI_ARGS) {
      const float* b0 = isw ? p.rw_w0 : p.rw_a0;
      EPI_FOREACH(acc, if (row < MROWS) {
        const float4 b4 = *(const float4*)(b0 + col0);
        const float s0 = sigmoidf_(v[0] + b4.x), s1 = sigmoidf_(v[1] + b4.y), s2 = sigmoidf_(v[2] + b4.z), s3 = sigmoidf_(v[3] + b4.w);
        if (isw) {
          const float c = 0.6065306597126334f;
          uint2 o;
          o.x = (unsigned)f2h(c * s0) | ((unsigned)f2h(c * s1) << 16);
          o.y = (unsigned)f2h(c * s2) | ((unsigned)f2h(c * s3) << 16);
          *(uint2*)(EW + (size_t)row * 1024 + col0) = o;
        } else {
          uint2 o;
          o.x = pack2(s0, s1);
          o.y = pack2(s2, s3);
          *(uint2*)(Aa + (size_t)row * 1024 + col0) = o;
        }
      })
    });
  }
}

__device__ __forceinline__ float fma_(float a, float b, float c) {
  float r;
  asm("v_fma_f32 %0, %1, %2, %3" : "=v"(r) : "v"(a), "v"(b), "v"(c));
  return r;
}
__device__ __forceinline__ float mul_(float a, float b) {
  float r;
  asm("v_mul_f32 %0, %1, %2" : "=v"(r) : "v"(a), "v"(b));
  return r;
}

constexpr int PAIR_TS = 624;
constexpr int PAIR_BUF = 8 * PAIR_TS;

__device__ __forceinline__ void phase_scan(const Params& p, char* lds) {
  const int tid = threadIdx.x, lane = tid & 63, w = tid >> 6;
  const u16* R = (const u16*)(p.ws + S_R);
  const u16* Kk = (const u16*)(p.ws + S_K);
  const u16* V = (const u16*)(p.ws + S_V);
  const u16* EW = (const u16*)(p.ws + S_EW);
  const u16* Aa = (const u16*)(p.ws + S_A);
  u16* Y = (u16*)(p.ws + WS_H);
  float* RK = (float*)(p.ws + WS_RK);
  float* ring = (float*)lds;
  float* ybuf = (float*)(lds + 2 * PAIR_BUF * 4);
  for (int item = blockIdx.x; item < 256; item += gridDim.x) {
    const int chain = item >> 2, qr = item & 3, b = chain >> 4, h = chain & 15;
    const size_t rowbase = (size_t)b * 4096;
    __syncthreads();
    if (tid >= 256) {
      const int pt = tid - 256, grp = pt >> 7, pair = (pt & 127) >> 4, cq = pt & 15;
      const int ch = h * 64 + cq * 4;
      const float4 kk4 = *(const float4*)(p.rw_kk + ch), ka4 = *(const float4*)(p.rw_ka + ch), rk4 = *(const float4*)(p.rw_rk + ch);
      struct PS {
        uint2 rr[2], rk_[2], rv[2], ra_[2], re[2];
      };
      PS S0, S1;
      auto pload = [&](PS& S, int c) __attribute__((always_inline)) {
#pragma unroll
        for (int q = 0; q < 2; ++q) {
          const size_t off = (rowbase + (size_t)c * 16 + pair * 2 + q) * 1024 + ch;
          S.rr[q] = *(const uint2*)(R + off);
          S.rk_[q] = *(const uint2*)(Kk + off);
          S.rv[q] = *(const uint2*)(V + off);
          S.ra_[q] = *(const uint2*)(Aa + off);
          S.re[q] = *(const uint2*)(EW + off);
        }
      };
      auto pproc = [&](PS& S, int c) __attribute__((always_inline)) {
        const float kkw[4] = {kk4.x, kk4.y, kk4.z, kk4.w}, kaw[4] = {ka4.x, ka4.y, ka4.z, ka4.w}, rkw[4] = {rk4.x, rk4.y, rk4.z, rk4.w};
        float am[2][4], dc[2][4], bm[2][4], kp[2][4], rf[2][4], vf[2][4];
#pragma unroll
        for (int q = 0; q < 2; ++q) {
          const uint2 rr = S.rr[q], rk_ = S.rk_[q], rv = S.rv[q], ra_ = S.ra_[q], re = S.re[q];
          const float rfx[4] = {bflo(rr.x), bfhi(rr.x), bflo(rr.y), bfhi(rr.y)};
          const float kf[4] = {bflo(rk_.x), bfhi(rk_.x), bflo(rk_.y), bfhi(rk_.y)};
          const float vfx[4] = {bflo(rv.x), bfhi(rv.x), bflo(rv.y), bfhi(rv.y)};
          const float af[4] = {bflo(ra_.x), bfhi(ra_.x), bflo(ra_.y), bfhi(ra_.y)};
          const float ef[4] = {h2f((u16)(re.x & 0xffff)), h2f((u16)(re.x >> 16)), h2f((u16)(re.y & 0xffff)), h2f((u16)(re.y >> 16))};
          float kkr[4], ss = 0.f, rks = 0.f;
#pragma unroll
          for (int j = 0; j < 4; ++j) {
            kkr[j] = kf[j] * kkw[j];
            ss += kkr[j] * kkr[j];
            kp[q][j] = kf[j] * (1.f + (af[j] - 1.f) * kaw[j]);
            rks += rfx[j] * kp[q][j] * rkw[j];
            rf[q][j] = rfx[j];
            vf[q][j] = vfx[j];
          }
          ss = rowsum16(ss);
          rks = rowsum16(rks);
          const float inv = 1.f / fmaxf(sqrtf(ss), 1e-12f);
#pragma unroll
          for (int j = 0; j < 4; ++j) {
            am[q][j] = -kkr[j] * inv;
            dc[q][j] = __expf(-ef[j]);
            bm[q][j] = kkr[j] * inv * af[j];
          }
          if (cq == 0 && qr == 0) RK[(rowbase + (size_t)c * 16 + pair * 2 + q) * 16 + h] = rks;
        }
        float aw[4], w12[4], b1w[4], k1w[4], wr1[4], wr2[4];
        float cba = 0.f, cka = 0.f, br1 = 0.f, kr1 = 0.f, br12 = 0.f, kr12 = 0.f, br2 = 0.f, kr2 = 0.f;
#pragma unroll
        for (int j = 0; j < 4; ++j) {
          aw[j] = dc[0][j] * am[1][j];
          w12[j] = dc[0][j] * dc[1][j];
          b1w[j] = bm[0][j] * dc[1][j];
          k1w[j] = kp[0][j] * dc[1][j];
          wr1[j] = dc[0][j] * rf[0][j];
          wr2[j] = w12[j] * rf[1][j];
          cba += bm[0][j] * am[1][j];
          cka += kp[0][j] * am[1][j];
          br1 += bm[0][j] * rf[0][j];
          kr1 += kp[0][j] * rf[0][j];
          br12 += b1w[j] * rf[1][j];
          kr12 += k1w[j] * rf[1][j];
          br2 += bm[1][j] * rf[1][j];
          kr2 += kp[1][j] * rf[1][j];
        }
        cba = rowsum16(cba);
        cka = rowsum16(cka);
        br1 = rowsum16(br1);
        kr1 = rowsum16(kr1);
        br12 = rowsum16(br12);
        kr12 = rowsum16(kr12);
        br2 = rowsum16(br2);
        kr2 = rowsum16(kr2);
        float* slot = ring + (c & 1) * PAIR_BUF + pair * PAIR_TS;
        *(float4*)(slot + cq * 4) = make_float4(am[0][0], am[0][1], am[0][2], am[0][3]);
        *(float4*)(slot + 64 + cq * 4) = make_float4(aw[0], aw[1], aw[2], aw[3]);
        *(float4*)(slot + 128 + cq * 4) = make_float4(w12[0], w12[1], w12[2], w12[3]);
        *(float4*)(slot + 192 + cq * 4) = make_float4(b1w[0], b1w[1], b1w[2], b1w[3]);
        *(float4*)(slot + 256 + cq * 4) = make_float4(k1w[0], k1w[1], k1w[2], k1w[3]);
        *(float4*)(slot + 320 + cq * 4) = make_float4(bm[1][0], bm[1][1], bm[1][2], bm[1][3]);
        *(float4*)(slot + 384 + cq * 4) = make_float4(kp[1][0], kp[1][1], kp[1][2], kp[1][3]);
        *(float4*)(slot + 448 + cq * 4) = make_float4(wr1[0], wr1[1], wr1[2], wr1[3]);
        *(float4*)(slot + 512 + cq * 4) = make_float4(wr2[0], wr2[1], wr2[2], wr2[3]);
        if ((cq >> 2) == qr) {
          *(float4*)(slot + 576 + (cq & 3) * 4) = make_float4(vf[0][0], vf[0][1], vf[0][2], vf[0][3]);
          *(float4*)(slot + 592 + (cq & 3) * 4) = make_float4(vf[1][0], vf[1][1], vf[1][2], vf[1][3]);
        }
        if (cq == 0) {
          *(float4*)(slot + 608) = make_float4(cba, cka, br1, kr1);
          *(float4*)(slot + 612) = make_float4(br12, kr12, br2, kr2);
        }
      };
      if (grp == 0) {
        pload(S0, 0);
        pproc(S0, 0);
        pload(S1, 2);
        pload(S0, 4);
      } else {
        pload(S0, 1);
        pload(S1, 3);
      }
      BAR_SYNC();
#pragma unroll 1
      for (int c = 0; c < 256; c += 4) {
        if (grp == 1) {
          pproc(S0, c + 1);
          if (c + 5 < 256) pload(S0, c + 5);
        }
        BAR_SYNC();
        if (grp == 0) {
          pproc(S1, c + 2);
          if (c + 6 < 256) pload(S1, c + 6);
        }
        BAR_SYNC();
        if (grp == 1) {
          pproc(S1, c + 3);
          if (c + 7 < 256) pload(S1, c + 7);
        }
        BAR_SYNC();
        if (grp == 0) {
          if (c + 4 < 256) pproc(S0, c + 4);
          if (c + 8 < 256) pload(S0, c + 8);
        }
        BAR_SYNC();
      }
    } else {
      const int rl = tid >> 4, cgp = tid & 15;
      float s0 = 0.f, s1 = 0.f, s2 = 0.f, s3 = 0.f;
      BAR_SYNC();
      for (int c = 0; c < 256; ++c) {
        if (c > 0) {
          const float4* yp = (const float4*)(ybuf + ((c - 1) & 1) * 4096 + tid * 16);
          const float4 y0 = yp[0], y1 = yp[1], y2 = yp[2], y3 = yp[3];
          const float yv = ((y0.x + y0.y) + (y0.z + y0.w)) + ((y1.x + y1.y) + (y1.z + y1.w)) + ((y2.x + y2.y) + (y2.z + y2.w)) + ((y3.x + y3.y) + (y3.z + y3.w));
          Y[(rowbase + (size_t)(c - 1) * 16 + rl) * LDH + h * 64 + qr * 16 + cgp] = f2bf(yv);
        }
        const float* bufp = ring + (c & 1) * PAIR_BUF;
        float* yb = ybuf + (c & 1) * 4096;
        struct PV {
          float4 a1, aw, w12, b1w, k1w, b2, k2, wr1, wr2, sc0, sc1;
          float v1, v2;
        };
        auto ldpair = [&](const float* slot) __attribute__((always_inline)) {
          PV r;
          r.a1 = *(const float4*)(slot + cgp * 4);
          r.aw = *(const float4*)(slot + 64 + cgp * 4);
          r.w12 = *(const float4*)(slot + 128 + cgp * 4);
          r.b1w = *(const float4*)(slot + 192 + cgp * 4);
          r.k1w = *(const float4*)(slot + 256 + cgp * 4);
          r.b2 = *(const float4*)(slot + 320 + cgp * 4);
          r.k2 = *(const float4*)(slot + 384 + cgp * 4);
          r.wr1 = *(const float4*)(slot + 448 + cgp * 4);
          r.wr2 = *(const float4*)(slot + 512 + cgp * 4);
          r.v1 = slot[576 + rl];
          r.v2 = slot[592 + rl];
          r.sc0 = *(const float4*)(slot + 608);
          r.sc1 = *(const float4*)(slot + 612);
          return r;
        };
        PV cur = ldpair(bufp);
#pragma unroll
        for (int pr = 0; pr < 8; ++pr) {
          PV nxt = cur;
          if (pr + 1 < 8) nxt = ldpair(bufp + (pr + 1) * PAIR_TS);
          float d1 = fma_(s3, cur.a1.w, fma_(s2, cur.a1.z, fma_(s1, cur.a1.y, mul_(s0, cur.a1.x))));
          float d2 = fma_(s3, cur.aw.w, fma_(s2, cur.aw.z, fma_(s1, cur.aw.y, mul_(s0, cur.aw.x))));
          const float e1 = fma_(s3, cur.wr1.w, fma_(s2, cur.wr1.z, fma_(s1, cur.wr1.y, mul_(s0, cur.wr1.x))));
          const float e2 = fma_(s3, cur.wr2.w, fma_(s2, cur.wr2.z, fma_(s1, cur.wr2.y, mul_(s0, cur.wr2.x))));
          const float t0 = fma_(cur.v2, cur.k2.x, fma_(cur.v1, cur.k1w.x, mul_(s0, cur.w12.x)));
          const float t1 = fma_(cur.v2, cur.k2.y, fma_(cur.v1, cur.k1w.y, mul_(s1, cur.w12.y)));
          const float t2 = fma_(cur.v2, cur.k2.z, fma_(cur.v1, cur.k1w.z, mul_(s2, cur.w12.z)));
          const float t3 = fma_(cur.v2, cur.k2.w, fma_(cur.v1, cur.k1w.w, mul_(s3, cur.w12.w)));
          d1 = rowsum16(d1);
          d2 = rowsum16(d2);
          const float sa1 = d1;
          const float sa2 = fma_(cur.v1, cur.sc0.y, fma_(sa1, cur.sc0.x, d2));
          s0 = fma_(sa2, cur.b2.x, fma_(sa1, cur.b1w.x, t0));
          s1 = fma_(sa2, cur.b2.y, fma_(sa1, cur.b1w.y, t1));
          s2 = fma_(sa2, cur.b2.z, fma_(sa1, cur.b1w.z, t2));
          s3 = fma_(sa2, cur.b2.w, fma_(sa1, cur.b1w.w, t3));
          yb[(2 * pr) * 256 + tid] = e1 + 0.0625f * (sa1 * cur.sc0.z + cur.v1 * cur.sc0.w);
          yb[(2 * pr + 1) * 256 + tid] = e2 + 0.0625f * (sa1 * cur.sc1.x + cur.v1 * cur.sc1.y + sa2 * cur.sc1.z + cur.v2 * cur.sc1.w);
          cur = nxt;
        }
        BAR_SYNC();
      }
      {
        const float4* yp = (const float4*)(ybuf + (255 & 1) * 4096 + tid * 16);
        const float4 y0 = yp[0], y1 = yp[1], y2 = yp[2], y3 = yp[3];
        const float yv = ((y0.x + y0.y) + (y0.z + y0.w)) + ((y1.x + y1.y) + (y1.z + y1.w)) + ((y2.x + y2.y) + (y2.z + y2.w)) + ((y3.x + y3.y) + (y3.z + y3.w));
        Y[(rowbase + (size_t)255 * 16 + rl) * LDH + h * 64 + qr * 16 + cgp] = f2bf(yv);
      }
      float* wo = p.out + O_WKVP + (((size_t)(b * 16 + h) * 64) + qr * 16 + rl) * 64 + cgp * 4;
      *(float4*)wo = make_float4(s0, s1, s2, s3);
    }
  }
  float* sl = (float*)lds;
  for (int chain = blockIdx.x; chain < 2048; chain += gridDim.x) {
    const int b = chain >> 4, h = chain & 15;
    const size_t row = (size_t)NP + b;
    __syncthreads();
    if (w == 0) {
      const int ch = h * 64 + lane;
      const size_t off = row * 1024 + ch;
      const float rf = bf2f(R[off]), kf = bf2f(Kk[off]), vf = bf2f(V[off]), af = bf2f(Aa[off]), ef = h2f(EW[off]);
      const float kkr = kf * p.rw_kk[ch];
      const float ss = wavesum(kkr * kkr);
      const float inv = 1.f / fmaxf(sqrtf(ss), 1e-12f);
      const float kp = kf * (1.f + (af - 1.f) * p.rw_ka[ch]);
      const float rks = wavesum(rf * kp * p.rw_rk[ch]);
      sl[lane] = -kkr * inv;
      sl[64 + lane] = __expf(-ef);
      sl[128 + lane] = kkr * inv * af;
      sl[192 + lane] = kp;
      sl[256 + lane] = rf;
      sl[320 + lane] = vf;
      if (lane == 0) RK[row * 16 + h] = rks;
    }
    __syncthreads();
    const int i = tid >> 3, c8 = tid & 7;
    const float* sp = p.state_wkv + (((size_t)(b * 16 + h) * 64) + i) * 64 + c8 * 8;
    float4 sA = *(const float4*)sp, sB = *(const float4*)(sp + 4);
    float s[8] = {sA.x, sA.y, sA.z, sA.w, sB.x, sB.y, sB.z, sB.w};
    float sa = 0.f;
#pragma unroll
    for (int j = 0; j < 8; ++j) sa += s[j] * sl[c8 * 8 + j];
    sa += __shfl_xor(sa, 1);
    sa += __shfl_xor(sa, 2);
    sa += __shfl_xor(sa, 4);
    const float vv = sl[320 + i];
    float y = 0.f;
#pragma unroll
    for (int j = 0; j < 8; ++j) {
      const int cj = c8 * 8 + j;
      s[j] = s[j] * sl[64 + cj] + sa * sl[128 + cj] + vv * sl[192 + cj];
      y += s[j] * sl[256 + cj];
    }
    y += __shfl_xor(y, 1);
    y += __shfl_xor(y, 2);
    y += __shfl_xor(y, 4);
    float* wo = p.out + O_WKVS + (((size_t)(b * 16 + h) * 64) + i) * 64 + c8 * 8;
    *(float4*)wo = make_float4(s[0], s[1], s[2], s[3]);
    *(float4*)(wo + 4) = make_float4(s[4], s[5], s[6], s[7]);
    if (c8 == 0) Y[row * LDH + h * 64 + i] = f2bf(y);
  }
}

__device__ __forceinline__ void phase_gate(const Params& p, char* lds) {
  const u16* wt = (const u16*)(p.ws + WS_WT);
  const u16* GH = (const u16*)(p.ws + S_GH);
  const u16* V = (const u16*)(p.ws + S_V);
  const float* RK = (const float*)(p.ws + WS_RK);
  u16* Y = (u16*)(p.ws + WS_H);
  for (int t = blockIdx.x; t < 65 * 4; t += gridDim.x) {
    const int mt = t >> 2, nt = t & 3;
    const int m0 = mt * 256, n0 = nt * 256;
    gemm_tile256(GH, 128, wt + WT_G2, 128, 128, m0, n0, lds, mt == 64, [&](EPI_ARGS) {
      const int hh = (n0 + wn * 64) >> 6;
#pragma unroll
      for (int mi = 0; mi < 8; ++mi) {
        const int row = m0 + wm * 128 + mi * 16 + lr;
        const int rowc = row < MROWS ? row : MROWS - 1;
        float yv[4][4];
        float sum = 0.f;
#pragma unroll
        for (int ni = 0; ni < 4; ++ni) {
          const uint2 yy = *(const uint2*)(Y + (size_t)rowc * LDH + hh * 64 + ni * 16 + lg * 4);
          yv[ni][0] = bflo(yy.x); yv[ni][1] = bfhi(yy.x); yv[ni][2] = bflo(yy.y); yv[ni][3] = bfhi(yy.y);
          sum += yv[ni][0] + yv[ni][1] + yv[ni][2] + yv[ni][3];
        }
        sum += __shfl_xor(sum, 16);
        sum += __shfl_xor(sum, 32);
        const float mu = sum * (1.f / 64.f);
        float vs = 0.f;
#pragma unroll
        for (int ni = 0; ni < 4; ++ni)
#pragma unroll
          for (int q = 0; q < 4; ++q) {
            const float d = yv[ni][q] - mu;
            vs += d * d;
          }
        vs += __shfl_xor(vs, 16);
        vs += __shfl_xor(vs, 32);
        const float rstd = rsqrtf(vs * (1.f / 64.f) + 64e-5f);
        const float rk = RK[(size_t)rowc * 16 + hh];
#pragma unroll
        for (int ni = 0; ni < 4; ++ni) {
          const int col0 = hh * 64 + ni * 16 + lg * 4;
          const uint2 vv = *(const uint2*)(V + (size_t)rowc * 1024 + col0);
          const float vf[4] = {bflo(vv.x), bfhi(vv.x), bflo(vv.y), bfhi(vv.y)};
          const float4 g4 = *(const float4*)(p.rw_lnx_g + col0), b4 = *(const float4*)(p.rw_lnx_b + col0);
          const float gg[4] = {g4.x, g4.y, g4.z, g4.w}, bb[4] = {b4.x, b4.y, b4.z, b4.w};
          f32x4 o;
#pragma unroll
          for (int q = 0; q < 4; ++q) o[q] = ((yv[ni][q] - mu) * rstd * gg[q] + bb[q] + rk * vf[q]) * acc[mi][ni][q];
          if (row < MROWS) *(uint2*)(Y + (size_t)row * LDH + col0) = pack4(o);
        }
        __builtin_amdgcn_sched_barrier(0);
      }
    });
  }
}

__device__ __forceinline__ void phase_oproj(const Params& p, char* lds, const u16* A, int K, const u16* Bt, int layer, int gidx, bool first) {
  const int ldab = K == 1024 ? LDH : LDU;
  const float* mod = (const float*)(p.ws + WS_MOD);
  for (int u = blockIdx.x; u < 320; u += gridDim.x) {
    const bool split = u >= 256;
    const int s = u - 256;
    const int m0 = split ? NP : (u >> 2) * 256, n0 = (split ? (s & 3) : (u & 3)) * 256;
    const int klen = split ? (K >> 4) : K, kbeg = split ? (s >> 2) * klen : 0;
    gemm_tile256(A + kbeg, ldab, Bt + kbeg, ldab, klen, m0, n0, lds, split, [&](EPI_ARGS) {
      EPI_FOREACH(acc, if (row < MROWS) {
        const float4 gt = *(const float4*)(mod + ((size_t)layer * 132 + bidx_of(row)) * 6144 + gidx * 1024 + col0);
        float* xp = p.out + (size_t)row * 1024 + col0;
        if (split) {
          unsafeAtomicAdd(xp + 0, gt.x * v[0]);
          unsafeAtomicAdd(xp + 1, gt.y * v[1]);
          unsafeAtomicAdd(xp + 2, gt.z * v[2]);
          unsafeAtomicAdd(xp + 3, gt.w * v[3]);
        } else {
          const float* xi = first ? p.x_prompt + (size_t)row * 1024 + col0 : xp;
          const float4 xo = *(const float4*)xi;
          *(float4*)xp = make_float4(xo.x + gt.x * v[0], xo.y + gt.y * v[1], xo.z + gt.z * v[2], xo.w + gt.w * v[3]);
        }
      })
    });
  }
}

__device__ __forceinline__ void phase_up(const Params& p, char* lds, const u16* Bt) {
  const u16* H = (const u16*)(p.ws + WS_H);
  u16* UP = (u16*)(p.ws + S_UP);
  for (int t = blockIdx.x; t < 65 * 16; t += gridDim.x) {
    const int mt = t >> 4, nt = t & 15;
    const int m0 = mt * 256, n0 = nt * 256;
    gemm_tile256(H, LDH, Bt, LDH, 1024, m0, n0, lds, mt == 64, [&](EPI_ARGS) {
      EPI_FOREACH(acc, if (row < MROWS) {
        f32x4 o;
        _Pragma("unroll") for (int q = 0; q < 4; ++q) {
          const float rl = fmaxf(v[q], 0.f);
          o[q] = rl * rl;
        }
        *(uint2*)(UP + (size_t)row * LDU + col0) = pack4(o);
      })
    });
  }
}

__device__ __forceinline__ void phase_qkv(const Params& p, char* lds) {
  const u16* H = (const u16*)(p.ws + WS_H);
  const u16* wt = (const u16*)(p.ws + WS_WT);
  const float* tab = (const float*)(p.ws + WS_TAB);
  u16* Qb = (u16*)(p.ws + S_Q);
  u16* Kb = (u16*)(p.ws + S_KB);
  u16* Vt = (u16*)(p.ws + S_VT);
  for (int t = blockIdx.x; t < 65 * 6; t += gridDim.x) {
    const int mt = t / 6, nt = t % 6;
    const int m0 = mt * 256, n0 = nt * 256;
    gemm_tile256(H, LDH, wt + WT_QKV, LDH, 1024, m0, n0, lds, mt == 64, [&](EPI_ARGS) {
      const int hc0 = n0 + wn * 64;
#pragma unroll
      for (int mi = 0; mi < 8; ++mi) {
        const int row = m0 + wm * 128 + mi * 16 + lr;
        const bool valid = row < MROWS;
        const bool isp = row < NP;
        const int pos = row & 4095;
        const int bq = isp ? (row >> 12) : (row - NP);
        const int posidx = isp ? pos : 4096;
#pragma unroll
        for (int ni = 0; ni < 4; ++ni) {
          const int col0 = hc0 + ni * 16 + lg * 4;
          const float4 b4 = *(const float4*)(p.at_bqkv + col0);
          f32x4 v = acc[mi][ni];
          v[0] += b4.x; v[1] += b4.y; v[2] += b4.z; v[3] += b4.w;
          if (ni == 0 && hc0 < 1280) {
            const float* tp = tab + (size_t)posidx * 16 + (lg & 1) * 8;
            const float4 t0 = *(const float4*)tp, t1 = *(const float4*)(tp + 4);
            const float cs[4] = {t0.x, t0.z, t1.x, t1.z}, sn[4] = {t0.y, t0.w, t1.y, t1.w};
#pragma unroll
            for (int q = 0; q < 4; ++q) {
              const float pv = __shfl_xor(v[q], 32);
              v[q] = (lg < 2) ? (v[q] * cs[q] - pv * sn[q]) : (v[q] * cs[q] + pv * sn[q]);
            }
          }
          if (valid) {
            if (hc0 < 1024) {
              *(uint2*)(Qb + (size_t)row * 1024 + col0) = pack4(v);
            } else if (hc0 < 1280) {
              const int c2 = col0 - 1024;
              *(uint2*)(Kb + (size_t)row * 256 + c2) = pack4(v);
              if (isp) {
                if (pos >= 3968) *(float4*)(p.out + O_KP + ((size_t)(bq * 128 + pos - 3968)) * 256 + c2) = make_float4(v[0], v[1], v[2], v[3]);
              } else {
                *(float4*)(p.out + O_KS + ((size_t)(bq * 128 + 127)) * 256 + c2) = make_float4(v[0], v[1], v[2], v[3]);
              }
            } else {
              const int c3 = col0 - 1280;
              if (isp) {
                u16* vp = Vt + ((size_t)(bq * 4 + (c3 >> 6)) * 64 + (c3 & 63)) * 4096 + pos;
#pragma unroll
                for (int q = 0; q < 4; ++q) vp[(size_t)q * 4096] = f2bf(v[q]);
                if (pos >= 3968) *(float4*)(p.out + O_VP + ((size_t)(bq * 128 + pos - 3968)) * 256 + c3) = make_float4(v[0], v[1], v[2], v[3]);
              } else {
                *(float4*)(p.out + O_VS + ((size_t)(bq * 128 + 127)) * 256 + c3) = make_float4(v[0], v[1], v[2], v[3]);
              }
            }
          }
        }
        __builtin_amdgcn_sched_barrier(0);
      }
    });
  }
}

constexpr int AT_KS = 0, AT_VS = 36864, AT_PS = 36864 + 35840, AT_PW = 5376;

__device__ __forceinline__ void phase_attn(const Params& p, char* lds) {
  const int tid = threadIdx.x, lane = tid & 63, w = tid >> 6, lr = lane & 15, lg = lane >> 4;
  const u16* Qb = (const u16*)(p.ws + S_Q);
  const u16* Kb = (const u16*)(p.ws + S_KB);
  const u16* Vt = (const u16*)(p.ws + S_VT);
  u16* O = (u16*)(p.ws + S_O);
  char* Ks = lds + AT_KS;
  char* Vs = lds + AT_VS;
  char* Ps = lds + AT_PS + w * AT_PW;
  for (int u = blockIdx.x; u < 512; u += gridDim.x) {
    const int b = u >> 7, n = (u >> 2) & 31, kvh = u & 3;
    bf16x8 qfa[4][2];
    {
      const int g_ = w >> 1, hf_ = w & 1, qh_ = kvh * 4 + g_;
#pragma unroll
      for (int i = 0; i < 4; ++i) {
        const size_t tok = (size_t)b * 4096 + n * 128 + hf_ * 64 + i * 16 + lr;
        qfa[i][0] = *(const bf16x8*)(Qb + tok * 1024 + qh_ * 64 + lg * 8);
        qfa[i][1] = *(const bf16x8*)(Qb + tok * 1024 + qh_ * 64 + 32 + lg * 8);
      }
    }
    __syncthreads();
#pragma unroll
    for (int i = 0; i < 4; ++i) {
      const int c = tid + 512 * i;
      {
        const int key = c >> 3, kc = c & 7;
        const int pos = n * 128 - 128 + key;
        uint4 v = {0u, 0u, 0u, 0u};
        if (pos >= 0) v = *(const uint4*)(Kb + ((size_t)b * 4096 + pos) * 256 + kvh * 64 + kc * 8);
        *(uint4*)(Ks + key * 144 + kc * 16) = v;
      }
      {
        const int d = c >> 5, kc = c & 31;
        const int pos0 = n * 128 - 128 + kc * 8;
        uint4 v = {0u, 0u, 0u, 0u};
        if (pos0 >= 0) v = *(const uint4*)(Vt + ((size_t)(b * 4 + kvh) * 64 + d) * 4096 + pos0);
        *(uint4*)(Vs + d * 560 + kc * 16) = v;
      }
    }
    if (tid < 192) {
      const int d = tid / 3, c = tid % 3;
      *(uint4*)(Vs + d * 560 + 512 + c * 16) = uint4{0u, 0u, 0u, 0u};
    }
    {
      const int prow = lane >> 2, pc = 144 + (lane & 3) * 4;
      *(uint2*)(Ps + prow * 336 + pc * 2) = uint2{0u, 0u};
    }
    __syncthreads();
    const int g = w >> 1, hf = w & 1;
    const int qh = kvh * 4 + g;
    const float sink = p.at_sink[qh];
#pragma unroll
    for (int i = 0; i < 4; ++i) {
      const int q0 = hf * 64 + i * 16;
      const bf16x8 qf0 = qfa[i][0];
      const bf16x8 qf1 = qfa[i][1];
      f32x4 s[9];
#pragma unroll
      for (int j = 0; j < 9; ++j) {
        const char* kp = Ks + (q0 + j * 16 + lr) * 144 + lg * 16;
        const bf16x8 k0 = *(const bf16x8*)kp;
        const bf16x8 k1 = *(const bf16x8*)(kp + 64);
        f32x4 z = {0.f, 0.f, 0.f, 0.f};
        z = __builtin_amdgcn_mfma_f32_16x16x32_bf16(qf0, k0, z, 0, 0, 0);
        z = __builtin_amdgcn_mfma_f32_16x16x32_bf16(qf1, k1, z, 0, 0, 0);
        s[j] = z;
      }
      float mx[4], sum[4];
#pragma unroll
      for (int r = 0; r < 4; ++r) {
        const int ql = lg * 4 + r;
        float m = sink;
#pragma unroll
        for (int j = 0; j < 9; ++j) {
          float v = s[j][r] * 0.125f;
          bool ok = true;
          if (j == 0) ok = (lr >= ql);
          if (j == 8) ok = (lr <= ql);
          if (n == 0 && (q0 + j * 16 + lr) < 128) ok = false;
          v = ok ? v : -INFINITY;
          s[j][r] = v;
          m = fmaxf(m, v);
        }
        mx[r] = rowmax16(m);
      }
#pragma unroll
      for (int r = 0; r < 4; ++r) {
        float sm = 0.f;
#pragma unroll
        for (int j = 0; j < 9; ++j) {
          const float e = __expf(s[j][r] - mx[r]);
          s[j][r] = e;
          sm += e;
        }
        sm = rowsum16(sm);
        sum[r] = sm + __expf(sink - mx[r]);
      }
      u16* P = (u16*)Ps;
#pragma unroll
      for (int j = 0; j < 9; ++j)
#pragma unroll
        for (int r = 0; r < 4; ++r) P[(lg * 4 + r) * 168 + j * 16 + lr] = f2bf(s[j][r]);
      __builtin_amdgcn_wave_barrier();
      f32x4 o[4];
#pragma unroll
      for (int nd = 0; nd < 4; ++nd) o[nd] = f32x4{0.f, 0.f, 0.f, 0.f};
#pragma unroll
      for (int kk = 0; kk < 5; ++kk) {
        const bf16x8 pf = *(const bf16x8*)(Ps + lr * 336 + kk * 64 + lg * 16);
#pragma unroll
        for (int nd = 0; nd < 4; ++nd) {
          const bf16x8 vf = *(const bf16x8*)(Vs + (nd * 16 + lr) * 560 + (q0 + kk * 32 + lg * 8) * 2);
          o[nd] = __builtin_amdgcn_mfma_f32_16x16x32_bf16(pf, vf, o[nd], 0, 0, 0);
        }
      }
#pragma unroll
      for (int nd = 0; nd < 4; ++nd)
#pragma unroll
        for (int r = 0; r < 4; ++r) {
          const float v = o[nd][r] / sum[r];
          O[((size_t)b * 4096 + n * 128 + q0 + lg * 4 + r) * LDH + qh * 64 + nd * 16 + lr] = f2bf(v);
        }
      __builtin_amdgcn_wave_barrier();
    }
  }
  float* qs = (float*)lds;
  float* sc = (float*)(lds + 1024);
  float* part = (float*)(lds + 1024 + 2112);
  for (int it = blockIdx.x; it < 512; it += gridDim.x) {
    const int b = it >> 2, kvh = it & 3;
    const size_t row = (size_t)NP + b;
    __syncthreads();
    if (tid < 256) qs[tid] = bf2f(Qb[row * 1024 + kvh * 256 + tid]);
    __syncthreads();
    {
      const int key = tid >> 2, g = tid & 3;
      const float* kp = p.cache_k + (((size_t)b * 128 + key) * 4 + kvh) * 64;
      float dot = 0.f;
#pragma unroll
      for (int d4 = 0; d4 < 16; ++d4) {
        const float4 kv = *(const float4*)(kp + d4 * 4);
        const float* q = qs + g * 64 + d4 * 4;
        dot += kv.x * q[0] + kv.y * q[1] + kv.z * q[2] + kv.w * q[3];
      }
      sc[g * 132 + key] = dot * 0.125f;
      if (key >= 1) {
        float* dst = p.out + O_KS + (((size_t)b * 128 + key - 1) * 4 + kvh) * 64 + g * 16;
        const float* src = kp + g * 16;
#pragma unroll
        for (int d4 = 0; d4 < 4; ++d4) *(float4*)(dst + d4 * 4) = *(const float4*)(src + d4 * 4);
      }
      if (tid < 4) {
        const float* kn = p.out + O_KS + (((size_t)b * 128 + 127) * 4 + kvh) * 64;
        float d2 = 0.f;
        for (int d = 0; d < 64; ++d) d2 += kn[d] * qs[tid * 64 + d];
        sc[tid * 132 + 128] = d2 * 0.125f;
      }
    }
    __syncthreads();
    if (w < 4) {
      const float sink = p.at_sink[kvh * 4 + w];
      float* s = sc + w * 132;
      const float v0 = s[lane], v1 = s[64 + lane], v2 = lane == 0 ? s[128] : -INFINITY;
      float m = fmaxf(fmaxf(v0, v1), fmaxf(v2, sink));
      m = wavemax(m);
      const float e0 = __expf(v0 - m), e1 = __expf(v1 - m), e2 = lane == 0 ? __expf(v2 - m) : 0.f;
      float sm = wavesum(e0 + e1 + e2) + __expf(sink - m);
      const float inv = 1.f / sm;
      s[lane] = e0 * inv;
      s[64 + lane] = e1 * inv;
      if (lane == 0) s[128] = e2 * inv;
    }
    __syncthreads();
    {
      const int d = tid & 63, g = (tid >> 6) & 3, half = tid >> 8;
      const float* vp = p.cache_v + (((size_t)b * 128) * 4 + kvh) * 64 + d;
      float accv = 0.f;
      for (int key = half * 64; key < half * 64 + 64; ++key) {
        const float vv = vp[(size_t)key * 256];
        accv += sc[g * 132 + key] * vv;
        if (g == 0 && key >= 1) p.out[O_VS + (((size_t)b * 128 + key - 1) * 4 + kvh) * 64 + d] = vv;
      }
      if (half == 1) accv += sc[g * 132 + 128] * p.out[O_VS + (((size_t)b * 128 + 127) * 4 + kvh) * 64 + d];
      part[(half * 4 + g) * 64 + d] = accv;
    }
    __syncthreads();
    if (tid < 256) {
      const int d = tid & 63, g = tid >> 6;
      O[row * LDH + (kvh * 4 + g) * 64 + d] = f2bf(part[g * 64 + d] + part[(4 + g) * 64 + d]);
    }
  }
}

__global__ void __launch_bounds__(NTHR) mega(Params p) {
  extern __shared__ __attribute__((aligned(16))) char lds[];
  cg::grid_group grid = cg::this_grid();
  volatile LAS unsigned* xst = (volatile LAS unsigned*)(lds + LDS_BYTES);
  if (threadIdx.x == 0) { xst[0] = 0u; xst[1] = 0u; }
  __syncthreads();
  const XcdBarrier xb = xcd_barrier_post((unsigned*)(p.ws + WS_BAR), xst);
  const u16* wt = (const u16*)(p.ws + WS_WT);
  phase0(p, lds);
  if (p.out == nullptr) grid.sync();
  xcd_barrier(xb);
  phase_ada(p, lds);
  xcd_barrier(xb);
  phase_norm_mix(p);
  xcd_barrier(xb);
  phase_rwkv_proj(p, lds);
  xcd_barrier(xb);
  phase_rwkv_lora2(p, lds);
  xcd_barrier(xb);
  phase_scan(p, lds);
  xcd_barrier(xb);
  phase_gate(p, lds);
  xcd_barrier(xb);
  phase_oproj(p, lds, (const u16*)(p.ws + WS_H), 1024, wt + WT_WO, 0, 2, true);
  xcd_barrier(xb);
  phase_norm(p, 0, 1, false, false);
  xcd_barrier(xb);
  phase_up(p, lds, wt + WT_UP0);
  xcd_barrier(xb);
  phase_oproj(p, lds, (const u16*)(p.ws + S_UP), 4096, wt + WT_DN0, 0, 5, false);
  xcd_barrier(xb);
  phase_norm(p, 1, 0, false, false);
  xcd_barrier(xb);
  phase_qkv(p, lds);
  xcd_barrier(xb);
  phase_attn(p, lds);
  xcd_barrier(xb);
  phase_oproj(p, lds, (const u16*)(p.ws + S_O), 1024, wt + WT_WO1, 1, 2, false);
  xcd_barrier(xb);
  phase_norm(p, 1, 1, false, false);
  xcd_barrier(xb);
  phase_up(p, lds, wt + WT_UP1);
  xcd_barrier(xb);
  phase_oproj(p, lds, (const u16*)(p.ws + S_UP), 4096, wt + WT_DN1, 1, 5, false);
  xcd_barrier(xb);
  phase_final(p);
}

extern "C" void kernel_launch(void* const* d_in, const int* in_sizes, int n_in, void* d_out, int out_size, void* d_ws,
                              size_t ws_size, hipStream_t stream) {
  static int grid_blocks = 0;
  if (grid_blocks == 0) {
    if (ws_size < WS_END) {
      fprintf(stderr, "kernel_launch: workspace too small: %zu < %zu\n", ws_size, (size_t)WS_END);
      grid_blocks = -1;
      return;
    }
    int dev = 0, cus = 0, per_cu = 0;
    hipGetDevice(&dev);
    hipDeviceGetAttribute(&cus, hipDeviceAttributeMultiprocessorCount, dev);
    hipFuncSetAttribute((const void*)mega, hipFuncAttributeMaxDynamicSharedMemorySize, LDS_BYTES + 16);
    hipOccupancyMaxActiveBlocksPerMultiprocessor(&per_cu, (const void*)mega, NTHR, LDS_BYTES + 16);
    if (per_cu < 1) per_cu = 1;
    grid_blocks = cus * per_cu;
  }
  if (grid_blocks < 0) return;
  Params p{};
  const float** pp = (const float**)&p;
  for (int i = 0; i < 37; ++i) pp[i] = (const float*)d_in[i];
  p.out = (float*)d_out;
  p.ws = (char*)d_ws;
  hipMemsetAsync((char*)d_ws + WS_BAR, 0, 16384, stream);
  void* args[] = {&p};
  hipError_t e = hipLaunchCooperativeKernel((const void*)mega, dim3(grid_blocks), dim3(NTHR), args, LDS_BYTES + 16, stream);
  if (e != hipSuccess) fprintf(stderr, "cooperative launch failed: %s (grid %d)\n", hipGetErrorString(e), grid_blocks);
}
```

```cpp
#include <hip/hip_runtime.h>
#include <hip/hip_cooperative_groups.h>
#include <cstdio>
namespace cg = cooperative_groups;

typedef unsigned short u16;
typedef __attribute__((ext_vector_type(8))) short bf16x8;
typedef __attribute__((ext_vector_type(4))) float f32x4;

constexpr int NP = 16384, MROWS = 16512, MPAD = 16640;
constexpr int NTHR = 512;
constexpr size_t MEG = 1048576;
constexpr int LDH = 1088, LDU = 4160;

constexpr size_t O_Y = 0, O_WKVP = 16908288, O_WKVS = 17170432, O_SHP = 25559040, O_SHS = 25563136,
                 O_KP = 25694208, O_KS = 25825280, O_VP = 30019584, O_VS = 30150656;

constexpr size_t WT_WR = 0, WT_WK = WT_WR + 1024 * LDH, WT_WV = WT_WK + 1024 * LDH, WT_WO = WT_WV + 1024 * LDH,
                 WT_W1 = WT_WO + 1024 * LDH, WT_A1 = WT_W1 + 64 * LDH, WT_G1 = WT_A1 + 64 * LDH, WT_W2 = WT_G1 + 128 * LDH,
                 WT_A2 = WT_W2 + 65536, WT_G2 = WT_A2 + 65536, WT_UP0 = WT_G2 + 131072, WT_DN0 = WT_UP0 + 4096 * LDH,
                 WT_QKV = WT_DN0 + 1024 * LDU, WT_WO1 = WT_QKV + 1536 * LDH, WT_UP1 = WT_WO1 + 1024 * LDH,
                 WT_DN1 = WT_UP1 + 4096 * LDH, WT_END = WT_DN1 + 1024 * LDU;
constexpr size_t WS_WT = 0;
constexpr size_t WS_H = WS_WT + WT_END * 2;
constexpr size_t WS_ZR = WS_H + (size_t)MPAD * LDH * 2;
constexpr size_t WS_MOD = WS_ZR + (size_t)LDH * 2;
constexpr size_t WS_TAB = WS_MOD + (size_t)2 * 132 * 6144 * 4;
constexpr size_t WS_HS = WS_H + (size_t)MROWS * LDH * 2;
constexpr size_t WS_RK = WS_TAB + (size_t)4097 * 8 * 8;
constexpr size_t WS_BAR = WS_RK + (size_t)MPAD * 16 * 4;
constexpr size_t WS_S = WS_BAR + 16384;
constexpr size_t RSZ = (size_t)MROWS * 1024 * 2;
constexpr size_t S_ADAWT = WS_S, S_SILUC = S_ADAWT + (size_t)2 * 6144 * LDH * 2;
constexpr size_t S_R = WS_S, S_K = S_R + RSZ, S_V = S_K + RSZ, S_EW = S_V + RSZ, S_A = S_EW + RSZ,
                 S_WH = S_A + RSZ, S_AH = S_WH + (size_t)MPAD * 64 * 2, S_GH = S_AH + (size_t)MPAD * 64 * 2,
                 S_RW_END = S_GH + (size_t)MPAD * 128 * 2;
constexpr size_t S_UP = WS_S;
constexpr size_t S_Q = WS_S, S_O = S_Q + (size_t)MPAD * 1024 * 2, S_KB = S_O + (size_t)MPAD * LDH * 2,
                 S_VT = S_KB + (size_t)MPAD * 256 * 2;
constexpr size_t WS_END = S_RW_END;
static_assert(S_UP + (size_t)MPAD * LDU * 2 <= WS_END, "up fits");
static_assert(S_VT + (size_t)16 * 64 * 4096 * 2 <= WS_END, "attn fits");
static_assert(WS_END <= 282000000, "ws fits sum of inputs");

constexpr int LDS_ROW = 144;
constexpr int LDS_A_BYTES = 256 * LDS_ROW;
constexpr int LDS_B_BYTES = 128 * LDS_ROW;
constexpr int LDS_STAGE = LDS_A_BYTES + LDS_B_BYTES;
constexpr int LDS_BYTES = 147456;

struct Params {
  const float *x_prompt, *x_sample, *c_prompt, *c_sample, *state_wkv, *state_shift, *cache_k, *cache_v;
  const float *norm1_g, *norm2_g, *ada_w, *ada_b, *mlp_up, *mlp_down, *final_g;
  const float *rw_mix, *rw_wr, *rw_wk, *rw_wv, *rw_wo, *rw_w0, *rw_w1, *rw_w2, *rw_a0, *rw_a1, *rw_a2, *rw_g1, *rw_g2,
      *rw_kk, *rw_ka, *rw_rk, *rw_lnx_g, *rw_lnx_b;
  const float *at_wqkv, *at_bqkv, *at_wo, *at_sink;
  float* out;
  char* ws;
};

__device__ __forceinline__ u16 f2bf(float f) {
  unsigned u = __float_as_uint(f);
  u += 0x7fffu + ((u >> 16) & 1u);
  return (u16)(u >> 16);
}
__device__ __forceinline__ float bf2f(u16 h) { return __uint_as_float(((unsigned)h) << 16); }
__device__ __forceinline__ float bflo(unsigned w) { return __uint_as_float(w << 16); }
__device__ __forceinline__ float bfhi(unsigned w) { return __uint_as_float(w & 0xffff0000u); }
__device__ __forceinline__ unsigned pack2(float a, float b) {
  unsigned r;
  asm volatile("v_cvt_pk_bf16_f32 %0, %1, %2" : "=v"(r) : "v"(a), "v"(b));
  return r;
}
__device__ __forceinline__ uint2 pack4(f32x4 v) { return uint2{pack2(v[0], v[1]), pack2(v[2], v[3])}; }
__device__ __forceinline__ float h2f(u16 h) { return (float)__builtin_bit_cast(_Float16, h); }
__device__ __forceinline__ u16 f2h(float f) { return __builtin_bit_cast(u16, (_Float16)f); }
__device__ __forceinline__ float sigmoidf_(float x) { return 1.f / (1.f + __expf(-x)); }

template <int CTRL>
__device__ __forceinline__ float dppf(float x) {
  return __int_as_float(__builtin_amdgcn_update_dpp(0, __float_as_int(x), CTRL, 0xf, 0xf, true));
}
__device__ __forceinline__ float rowsum16(float x) {
  x += dppf<0xB1>(x);
  x += dppf<0x4E>(x);
  x += dppf<0x124>(x);
  x += dppf<0x128>(x);
  return x;
}
__device__ __forceinline__ float rowmax16(float x) {
  x = fmaxf(x, dppf<0xB1>(x));
  x = fmaxf(x, dppf<0x4E>(x));
  x = fmaxf(x, dppf<0x124>(x));
  x = fmaxf(x, dppf<0x128>(x));
  return x;
}
__device__ __forceinline__ float wavesum(float x) {
#pragma unroll
  for (int o = 32; o > 0; o >>= 1) x += __shfl_xor(x, o);
  return x;
}
__device__ __forceinline__ float wavemax(float x) {
#pragma unroll
  for (int o = 32; o > 0; o >>= 1) x = fmaxf(x, __shfl_xor(x, o));
  return x;
}
__device__ __forceinline__ int bidx_of(int row) { return row < NP ? (row >> 12) : (4 + row - NP); }

#define XB_TMO      128
#define XB_XCNT(j)  (256  + 64 * (j))
#define XB_XSUB(j)  (1280 + 64 * (j))
#define XB_XGEN(j)  (2304 + 64 * (j))
#define XB_TOP      3328
#define XB_TOPGEN   3392
#define XCD_BAR_WORDS 3456
#define XB_SPIN_CAP (1u << 22)
#define LAS __attribute__((address_space(3)))
__device__ __forceinline__ unsigned xb_ld(unsigned* p) { return __hip_atomic_load(p, __ATOMIC_RELAXED, __HIP_MEMORY_SCOPE_AGENT); }
__device__ __forceinline__ unsigned xb_add(unsigned* p, unsigned v) { return __hip_atomic_fetch_add(p, v, __ATOMIC_RELAXED, __HIP_MEMORY_SCOPE_AGENT); }
__device__ __forceinline__ unsigned xb_xcc_id() { return (unsigned)__builtin_amdgcn_s_getreg((3 << 11) | 20) & 0xFu; }
#define XB_SPIN(cond, bar) do { unsigned _sp = 0; while (cond) { __builtin_amdgcn_s_sleep(1); \
    if ((++_sp & 255u) == 0u) { if (xb_ld(&(bar)[XB_TMO])) break; if (_sp > XB_SPIN_CAP) { atomicAdd(&(bar)[XB_TMO], 1u); break; } } } } while (0)
struct XcdBarrier {
  unsigned* bar;
  unsigned x;
  volatile LAS unsigned* st;
};
__device__ __forceinline__ XcdBarrier xcd_barrier_post(unsigned* bar, volatile LAS unsigned* st) {
  XcdBarrier b;
  b.bar = bar;
  b.x = xb_xcc_id();
  b.st = st;
  if (threadIdx.x == 0) (void)xb_add(&bar[XB_XCNT(b.x)], 1u);
  return b;
}
__device__ __forceinline__ void xcd_barrier_complete(unsigned* bar, unsigned x, unsigned& nloc, unsigned& nx) {
  const unsigned G = gridDim.x * gridDim.y * gridDim.z;
  unsigned sum, cnt, mine, sp = 0u;
  for (;;) {
    sum = 0u; cnt = 0u; mine = 0u;
#pragma unroll
    for (unsigned j = 0; j < 16; ++j) {
      const unsigned c = xb_ld(&bar[XB_XCNT(j)]);
      sum += c;
      cnt += (c > 0u) ? 1u : 0u;
      mine = (j == x) ? c : mine;
    }
    if (sum == G) break;
    __builtin_amdgcn_s_sleep(1);
    if ((++sp & 255u) == 0u) {
      if (xb_ld(&bar[XB_TMO])) break;
      if (sp > XB_SPIN_CAP) { atomicAdd(&bar[XB_TMO], 1u); break; }
    }
  }
  nloc = mine > 0u ? mine : 1u;
  nx = cnt > 0u ? cnt : 1u;
}
__device__ __forceinline__ void xcd_barrier(const XcdBarrier& b) {
  asm volatile("s_waitcnt vmcnt(0)" ::: "memory");
  __syncthreads();
  if (threadIdx.x == 0) {
    unsigned* bar = b.bar;
    __builtin_amdgcn_s_waitcnt(0);
    unsigned nloc = b.st[0], nx = b.st[1];
    if (nloc == 0u) { xcd_barrier_complete(bar, b.x, nloc, nx); b.st[0] = nloc; b.st[1] = nx; }
    const unsigned old = xb_add(&bar[XB_XSUB(b.x)], 1u);
    const unsigned gen = old / nloc;
    if (old + 1u == (gen + 1u) * nloc) {
      __builtin_amdgcn_fence(__ATOMIC_RELEASE, "agent");
      asm volatile("s_waitcnt vmcnt(0)" ::: "memory");
      const unsigned og = xb_add(&bar[XB_TOP], 1u);
      const unsigned tg = og / nx;
      if (og + 1u == (tg + 1u) * nx) xb_add(&bar[XB_TOPGEN], 1u);
      else XB_SPIN(xb_ld(&bar[XB_TOPGEN]) == tg, bar);
      __builtin_amdgcn_fence(__ATOMIC_ACQUIRE, "agent");
      xb_add(&bar[XB_XGEN(b.x)], 1u);
      asm volatile("s_waitcnt vmcnt(0)" ::: "memory");
    } else {
      XB_SPIN(xb_ld(&bar[XB_XGEN(b.x)]) == gen, bar);
      __builtin_amdgcn_fence(__ATOMIC_ACQUIRE, "agent");
      asm volatile("s_waitcnt vmcnt(0)" ::: "memory");
    }
  }
  __syncthreads();
}

#define BAR_SYNC() do { asm volatile("s_waitcnt lgkmcnt(0)" ::: "memory"); __builtin_amdgcn_s_barrier(); asm volatile("" ::: "memory"); } while (0)

__device__ __forceinline__ unsigned mix2(unsigned h, unsigned p, float m0, float m1) {
  float h0 = bflo(h), h1 = bfhi(h), p0 = bflo(p), p1 = bfhi(p);
  return pack2(h0 + (p0 - h0) * m0, h1 + (p1 - h1) * m1);
}

template <bool MIX, class Epi>
__device__ __forceinline__ void gemm_tile(const u16* __restrict__ A, int lda, const float* __restrict__ mixv,
                                          const u16* __restrict__ Bt, int ldb, int N, int K, int m0, int n0, char* lds, Epi&& epi) {
  int tid_l = threadIdx.x;
  asm volatile("" : "+v"(tid_l));
  const int tid = tid_l, lane = tid & 63, w = tid >> 6;
  const int nk = K >> 6;
  if (w >= 4) {
    const int pt = tid - 256, kc = pt & 7, pr = pt >> 3;
    const u16* Ab = A + (size_t)m0 * lda + (size_t)pr * lda + kc * 8;
    int poff[8];
#pragma unroll
    for (int i = 0; i < 8; ++i) {
      poff[i] = 0;
      if (MIX) {
        const int row = m0 + pr + 32 * i;
        const int prow = row < NP ? ((row & 4095) ? row - 1 : MPAD) : (row < MROWS ? row + 128 : MPAD);
        poff[i] = prow * LDH + kc * 8;
      }
    }
    bool bv[4];
    const u16* bp[4];
#pragma unroll
    for (int j = 0; j < 4; ++j) {
      const int n = n0 + pr + 32 * j;
      bv[j] = n < N;
      bp[j] = Bt + (size_t)(bv[j] ? n : 0) * ldb + kc * 8;
    }
    struct RSet {
      uint4 ra[8], rp[8], rb[4];
      float4 mx0, mx1;
    };
    RSet SA, SB;
    auto gload = [&](RSet& S, int kt) {
      const int ko = kt * 64;
#pragma unroll
      for (int i = 0; i < 8; ++i) {
        S.ra[i] = *(const uint4*)(Ab + (size_t)(32 * i) * lda + ko);
        if (MIX) S.rp[i] = *(const uint4*)(A + poff[i] + ko);
      }
      if (MIX) {
        S.mx0 = *(const float4*)(mixv + ko + kc * 8);
        S.mx1 = *(const float4*)(mixv + ko + kc * 8 + 4);
      }
#pragma unroll
      for (int j = 0; j < 4; ++j) {
        uint4 z = {0u, 0u, 0u, 0u};
        if (bv[j]) z = *(const uint4*)(bp[j] + ko);
        S.rb[j] = z;
      }
    };
    auto lstore = [&](RSet& S, int s) {
      char* base = lds + s * LDS_STAGE + pr * LDS_ROW + kc * 16;
#pragma unroll
      for (int i = 0; i < 8; ++i) {
        uint4 v = S.ra[i];
        if (MIX) {
          v.x = mix2(S.ra[i].x, S.rp[i].x, S.mx0.x, S.mx0.y);
          v.y = mix2(S.ra[i].y, S.rp[i].y, S.mx0.z, S.mx0.w);
          v.z = mix2(S.ra[i].z, S.rp[i].z, S.mx1.x, S.mx1.y);
          v.w = mix2(S.ra[i].w, S.rp[i].w, S.mx1.z, S.mx1.w);
        }
        *(uint4*)(base + (32 * i) * LDS_ROW) = v;
      }
#pragma unroll
      for (int j = 0; j < 4; ++j) *(uint4*)(base + LDS_A_BYTES + (32 * j) * LDS_ROW) = S.rb[j];
    };
    if constexpr (!MIX) {
      gload(SB, 0);
      if (nk > 1) gload(SA, 1);
      lstore(SB, 0);
      if (nk > 2) gload(SB, 2);
      BAR_SYNC();
#pragma unroll 1
      for (int kt = 0; kt < nk; kt += 2) {
        if (kt + 1 < nk) {
          lstore(SA, 1);
          if (kt + 3 < nk) gload(SA, kt + 3);
        }
        BAR_SYNC();
        if (kt + 1 < nk) {
          if (kt + 2 < nk) {
            lstore(SB, 0);
            if (kt + 4 < nk) gload(SB, kt + 4);
          }
          BAR_SYNC();
        }
      }
    } else {
      gload(SA, 0);
      lstore(SA, 0);
      if (nk > 1) gload(SA, 1);
      BAR_SYNC();
#pragma unroll 1
      for (int kt = 0; kt < nk; ++kt) {
        if (kt + 1 < nk) {
          lstore(SA, (kt + 1) & 1);
          if (kt + 2 < nk) gload(SA, kt + 2);
        }
        BAR_SYNC();
      }
    }
  } else {
    const int wm = w >> 1, wn = w & 1, lr = lane & 15, lg = lane >> 4;
    f32x4 acc[8][4];
#pragma unroll
    for (int i = 0; i < 8; ++i)
#pragma unroll
      for (int j = 0; j < 4; ++j) acc[i][j] = f32x4{0.f, 0.f, 0.f, 0.f};
    BAR_SYNC();
#pragma unroll 1
    for (int kt = 0; kt < nk; ++kt) {
      const char* sa = lds + (kt & 1) * LDS_STAGE + (wm * 128 + lr) * LDS_ROW + lg * 16;
      const char* sb = lds + (kt & 1) * LDS_STAGE + LDS_A_BYTES + (wn * 64 + lr) * LDS_ROW + lg * 16;
      bf16x8 bq[2][4], aq[3];
#pragma unroll
      for (int ni = 0; ni < 4; ++ni) bq[0][ni] = *(const bf16x8*)(sb + ni * 16 * LDS_ROW);
      aq[0] = *(const bf16x8*)(sa);
      aq[1] = *(const bf16x8*)(sa + 16 * LDS_ROW);
#pragma unroll
      for (int ni = 0; ni < 4; ++ni) bq[1][ni] = *(const bf16x8*)(sb + ni * 16 * LDS_ROW + 64);
#pragma unroll
      for (int st = 0; st < 16; ++st) {
        if (st + 2 < 16) aq[(st + 2) % 3] = *(const bf16x8*)(sa + ((st + 2) & 7) * 16 * LDS_ROW + ((st + 2) >> 3) * 64);
#pragma unroll
        for (int ni = 0; ni < 4; ++ni)
          acc[st & 7][ni] = __builtin_amdgcn_mfma_f32_16x16x32_bf16(bq[st >> 3][ni], aq[st % 3], acc[st & 7][ni], 0, 0, 0);
        __builtin_amdgcn_sched_barrier(0);
      }
      BAR_SYNC();
    }
    epi(acc, wm, wn, lr, lg);
  }
}

constexpr int LDS_STAGE2 = 2 * LDS_A_BYTES;
template <class Epi>
__device__ __forceinline__ void gemm_tile256(const u16* __restrict__ A, int lda, const u16* __restrict__ Bt, int ldb, int K, int m0,
                                             int n0, char* lds, bool half, Epi&& epi) {
  int tid = threadIdx.x;
  asm volatile("" : "+v"(tid));
  const int lane = tid & 63, w = __builtin_amdgcn_readfirstlane(tid >> 6);
  const int wm = w >> 2, wn = w & 3, lr = lane & 15, lg = lane >> 4;
  const int nk = K >> 5;
  const int drow = lane >> 2, dch = (lane & 3) ^ ((lane >> 4) & 3);
  const u16* As0 = A + (size_t)(m0 + w * 16 + drow) * lda + dch * 8;
  const u16* As1 = A + (size_t)(m0 + (w + 8) * 16 + drow) * lda + dch * 8;
  const u16* Bs0 = Bt + (size_t)(n0 + w * 16 + drow) * ldb + dch * 8;
  const u16* Bs1 = Bt + (size_t)(n0 + (w + 8) * 16 + drow) * ldb + dch * 8;
  auto dma = [&](int kt, int stg) __attribute__((always_inline)) {
    char* sbase = lds + stg * 32768;
    const int ko = kt * 32;
    __builtin_amdgcn_global_load_lds((const unsigned*)(As0 + ko), (unsigned*)(sbase + w * 1024), 16, 0, 0);
    __builtin_amdgcn_global_load_lds((const unsigned*)(As1 + ko), (unsigned*)(sbase + (w + 8) * 1024), 16, 0, 0);
    __builtin_amdgcn_global_load_lds((const unsigned*)(Bs0 + ko), (unsigned*)(sbase + 16384 + w * 1024), 16, 0, 0);
    __builtin_amdgcn_global_load_lds((const unsigned*)(Bs1 + ko), (unsigned*)(sbase + 16384 + (w + 8) * 1024), 16, 0, 0);
  };
  f32x4 acc[8][4];
#pragma unroll
  for (int i = 0; i < 8; ++i)
#pragma unroll
    for (int j = 0; j < 4; ++j) acc[i][j] = f32x4{0.f, 0.f, 0.f, 0.f};
  const int swz = (lg ^ ((lr >> 2) & 3)) * 16;
  const int aoff = (wm * 128 + lr) * 64 + swz, boff = 16384 + (wn * 64 + lr) * 64 + swz;
  const bool skipm = half && wm == 1;
  dma(0, 0);
  dma(nk > 1 ? 1 : nk - 1, 1);
  dma(nk > 2 ? 2 : nk - 1, 2);
  asm volatile("s_waitcnt vmcnt(8)" ::: "memory");
  BAR_SYNC();
#pragma unroll 1
  for (int kt = 0; kt < nk; ++kt) {
    const char* sa = lds + (kt & 3) * 32768 + aoff;
    const char* sb = lds + (kt & 3) * 32768 + boff;
    bf16x8 bq[4], aq[4];
#pragma unroll
    for (int ni = 0; ni < 4; ++ni) bq[ni] = *(const bf16x8*)(sb + ni * 1024);
    aq[0] = *(const bf16x8*)(sa);
    aq[1] = *(const bf16x8*)(sa + 1024);
    aq[2] = *(const bf16x8*)(sa + 2048);
    dma(kt + 3 < nk ? kt + 3 : nk - 1, (kt + 3) & 3);
    if (!skipm) {
#pragma unroll
      for (int st = 0; st < 8; ++st) {
        if (st + 3 < 8) aq[(st + 3) & 3] = *(const bf16x8*)(sa + (st + 3) * 1024);
#pragma unroll
        for (int ni = 0; ni < 4; ++ni)
          acc[st][ni] = __builtin_amdgcn_mfma_f32_16x16x32_bf16(bq[ni], aq[st & 3], acc[st][ni], 0, 0, 0);
        __builtin_amdgcn_sched_barrier(0);
      }
    }
    asm volatile("s_waitcnt vmcnt(8)" ::: "memory");
    BAR_SYNC();
  }
  asm volatile("s_waitcnt vmcnt(0)" ::: "memory");
  BAR_SYNC();
  epi(acc, wm, wn, lr, lg);
}

#define EPI_FOREACH(acc, ...)                                    \
  _Pragma("unroll") for (int mi = 0; mi < 8; ++mi) {             \
    const int row = m0 + wm * 128 + mi * 16 + lr;                \
    _Pragma("unroll") for (int ni = 0; ni < 4; ++ni) {           \
      const int col0 = n0 + wn * 64 + ni * 16 + lg * 4;          \
      const f32x4 v = acc[mi][ni];                               \
      __VA_ARGS__                                                \
    }                                                            \
    __builtin_amdgcn_sched_barrier(0);                           \
  }
#define EPI_ARGS f32x4(&acc)[8][4], int wm, int wn, int lr, int lg

__device__ __forceinline__ void conv_job(const float* __restrict__ src, u16* __restrict__ dst, int K, int N, int ldk, float* tl, int rot) {
  int tid = threadIdx.x;
  asm volatile("" : "+v"(tid));
  const int tn = N >> 6, nt = (K >> 6) * tn;
  const int G = gridDim.x;
  int t = ((int)blockIdx.x + G - (rot % G)) % G;
  float v[8];
  auto ldtile = [&](int tt) {
    const int k0 = (tt / tn) << 6, n0 = (tt % tn) << 6;
#pragma unroll
    for (int i = 0; i < 8; ++i) {
      const int e = tid + 512 * i;
      v[i] = src[(size_t)(k0 + (e >> 6)) * N + n0 + (e & 63)];
    }
  };
  if (t < nt) ldtile(t);
  while (t < nt) {
    const int k0 = (t / tn) << 6, n0 = (t % tn) << 6;
#pragma unroll
    for (int i = 0; i < 8; ++i) {
      const int e = tid + 512 * i;
      tl[(e >> 6) * 65 + (e & 63)] = v[i];
    }
    const int tnx = t + G;
    if (tnx < nt) ldtile(tnx);
    __syncthreads();
    const int n = tid >> 3, kc = tid & 7;
    float f[8];
#pragma unroll
    for (int j = 0; j < 8; ++j) f[j] = tl[(kc * 8 + j) * 65 + n];
    uint4 o;
    o.x = pack2(f[0], f[1]);
    o.y = pack2(f[2], f[3]);
    o.z = pack2(f[4], f[5]);
    o.w = pack2(f[6], f[7]);
    *(uint4*)(dst + (size_t)(n0 + n) * ldk + k0 + kc * 8) = o;
    __syncthreads();
    t = tnx;
  }
}

__device__ __forceinline__ void phase0(const Params& p, char* lds) {
  float* tl = (float*)lds;
  u16* wt = (u16*)(p.ws + WS_WT);
  u16* adawt = (u16*)(p.ws + S_ADAWT);
  int rot = 0;
#define CJ(SRC, DST, K, N)            \
  conv_job(SRC, DST, K, N, ((K) == 1024 ? LDH : (K) == 4096 ? LDU : (K)), tl, rot);  \
  rot += ((K) >> 6) * ((N) >> 6);
  CJ(p.ada_w, adawt, 1024, 6144)
  CJ(p.ada_w + (size_t)1024 * 6144, adawt + (size_t)6144 * LDH, 1024, 6144)
  CJ(p.rw_wr, wt + WT_WR, 1024, 1024)
  CJ(p.rw_wk, wt + WT_WK, 1024, 1024)
  CJ(p.rw_wv, wt + WT_WV, 1024, 1024)
  CJ(p.rw_wo, wt + WT_WO, 1024, 1024)
  CJ(p.rw_w1, wt + WT_W1, 1024, 64)
  CJ(p.rw_a1, wt + WT_A1, 1024, 64)
  CJ(p.rw_g1, wt + WT_G1, 1024, 128)
  CJ(p.rw_w2, wt + WT_W2, 64, 1024)
  CJ(p.rw_a2, wt + WT_A2, 64, 1024)
  CJ(p.rw_g2, wt + WT_G2, 128, 1024)
  CJ(p.mlp_up, wt + WT_UP0, 1024, 4096)
  CJ(p.mlp_down, wt + WT_DN0, 4096, 1024)
  CJ(p.at_wqkv, wt + WT_QKV, 1024, 1536)
  CJ(p.at_wo, wt + WT_WO1, 1024, 1024)
  CJ(p.mlp_up + (size_t)4 * MEG, wt + WT_UP1, 1024, 4096)
  CJ(p.mlp_down + (size_t)4 * MEG, wt + WT_DN1, 4096, 1024)
#undef CJ
  const int gtid = blockIdx.x * NTHR + threadIdx.x, gsz = gridDim.x * NTHR;
  u16* siluc = (u16*)(p.ws + S_SILUC);
  for (int i = gtid; i < 256 * 1024; i += gsz) {
    int row = i >> 10, col = i & 1023;
    float c = 0.f;
    if (row < 4) c = p.c_prompt[row * 1024 + col];
    else if (row < 132) c = p.c_sample[(row - 4) * 1024 + col];
    siluc[i] = f2bf(c * sigmoidf_(c));
  }
  u16* hs = (u16*)(p.ws + WS_HS);
  for (int i = gtid; i < 128 * 1024; i += gsz) hs[(size_t)(i >> 10) * LDH + (i & 1023)] = f2bf(p.state_shift[i]);
  u16* zr = (u16*)(p.ws + WS_ZR);
  for (int i = gtid; i < LDH; i += gsz) zr[i] = 0;
  float2* tab = (float2*)(p.ws + WS_TAB);
  for (int i = gtid; i < 4097 * 8; i += gsz) {
    int pi = i >> 3, f = i & 7;
    float pos = pi < 4096 ? (float)pi : 8192.f;
    float inv = f == 0 ? 1.0f : f == 1 ? 0.1939227432012558f : f == 2 ? 0.03760603070259094f : f == 3 ? 0.007292664609849453f
              : f == 4 ? 0.0014142135623842478f : f == 5 ? 0.00027424818836152554f : f == 6 ? 5.318296098266728e-05f
              : 1.0313386155758053e-05f;
    float ang = pos * inv;
    double t = (double)ang * 0.15915494309189535;
    t -= rint(t);
    float fr = (float)t;
    tab[i] = make_float2(__builtin_amdgcn_cosf(fr), __builtin_amdgcn_sinf(fr));
  }
}

__device__ __forceinline__ void phase_ada(const Params& p, char* lds) {
  const u16* siluc = (const u16*)(p.ws + S_SILUC);
  const u16* adawt = (const u16*)(p.ws + S_ADAWT);
  float* mod = (float*)(p.ws + WS_MOD);
  for (int t = blockIdx.x; t < 96; t += gridDim.x) {
    const int layer = t / 48, nt = t % 48;
    const int m0 = 0, n0 = nt * 128;
    const float* bias = p.ada_b + layer * 6144;
    float* mo = mod + (size_t)layer * 132 * 6144;
    gemm_tile<false>(siluc, 1024, nullptr, adawt + (size_t)layer * 6144 * LDH, LDH, 6144, 1024, m0, n0, lds, [&](EPI_ARGS) {
      EPI_FOREACH(acc, if (row < 132) {
        const float4 b4 = *(const float4*)(bias + col0);
        *(float4*)(mo + (size_t)row * 6144 + col0) = make_float4(v[0] + b4.x, v[1] + b4.y, v[2] + b4.z, v[3] + b4.w);
      })
    });
  }
}

__device__ __forceinline__ void phase_norm(const Params& p, int layer, int which, bool from_input, bool shift_out) {
  int tid_l = threadIdx.x;
  asm volatile("" : "+v"(tid_l));
  const int lane = tid_l & 63, w = tid_l >> 6;
  const float* mod = (const float*)(p.ws + WS_MOD);
  u16* H = (u16*)(p.ws + WS_H);
  const float* g = (which ? p.norm2_g : p.norm1_g) + layer * 1024;
  const int nw = gridDim.x * 8;
  auto xrow = [&](int row) {
    return from_input ? (row < NP ? p.x_prompt + (size_t)row * 1024 : p.x_sample + (size_t)(row - NP) * 1024)
                      : (const float*)p.out + (size_t)row * 1024;
  };
  float4 gg[4];
#pragma unroll
  for (int i = 0; i < 4; ++i) gg[i] = *(const float4*)(g + lane * 4 + 256 * i);
  int row = blockIdx.x * 8 + w;
  float4 xn[4];
  if (row < MROWS) {
    const float* xr = xrow(row);
#pragma unroll
    for (int i = 0; i < 4; ++i) xn[i] = *(const float4*)(xr + lane * 4 + 256 * i);
  }
  while (row < MROWS) {
    float4 x[4];
#pragma unroll
    for (int i = 0; i < 4; ++i) x[i] = xn[i];
    const int nrow = row + nw;
    if (nrow < MROWS) {
      const float* xr = xrow(nrow);
#pragma unroll
      for (int i = 0; i < 4; ++i) xn[i] = *(const float4*)(xr + lane * 4 + 256 * i);
    }
    const int bi = bidx_of(row);
    const float* mb = mod + ((size_t)layer * 132 + bi) * 6144;
    const float* sh = mb + (which ? 3 : 0) * 1024;
    const float* sc = mb + (which ? 4 : 1) * 1024;
    float4 s4[4], c4[4];
#pragma unroll
    for (int i = 0; i < 4; ++i) {
      s4[i] = *(const float4*)(sh + lane * 4 + 256 * i);
      c4[i] = *(const float4*)(sc + lane * 4 + 256 * i);
    }
    float ss = 0.f;
#pragma unroll
    for (int i = 0; i < 4; ++i) ss += x[i].x * x[i].x + x[i].y * x[i].y + x[i].z * x[i].z + x[i].w * x[i].w;
    ss = wavesum(ss);
    const float rs = rsqrtf(ss * (1.f / 1024.f) + 1e-6f);
    const bool so = shift_out && (row >= NP || (row & 4095) == 4095);
    float* sop = row >= NP ? p.out + O_SHS + (size_t)(row - NP) * 1024 : p.out + O_SHP + (size_t)(row >> 12) * 1024;
#pragma unroll
    for (int i = 0; i < 4; ++i) {
      const int c = lane * 4 + 256 * i;
      float4 h;
      h.x = x[i].x * rs * gg[i].x * (1.f + c4[i].x) + s4[i].x;
      h.y = x[i].y * rs * gg[i].y * (1.f + c4[i].y) + s4[i].y;
      h.z = x[i].z * rs * gg[i].z * (1.f + c4[i].z) + s4[i].z;
      h.w = x[i].w * rs * gg[i].w * (1.f + c4[i].w) + s4[i].w;
      uint2 pk;
      pk.x = pack2(h.x, h.y);
      pk.y = pack2(h.z, h.w);
      *(uint2*)(H + (size_t)row * LDH + c) = pk;
      if (so) *(float4*)(sop + c) = h;
    }
    row = nrow;
  }
}

__device__ __forceinline__ void phase_norm_mix(const Params& p) {
  int tid_l = threadIdx.x;
  asm volatile("" : "+v"(tid_l));
  const int lane = tid_l & 63, w = tid_l >> 6;
  const float* mod = (const float*)(p.ws + WS_MOD);
  u16* H = (u16*)(p.ws + WS_H);
  u16* XR = (u16*)p.out;
  u16* XK = XR + (size_t)MROWS * 1024;
  u16* XV = (u16*)(p.ws + S_EW);
  const float* g = p.norm1_g;
  const int nw = gridDim.x * 8;
  f32x4 gg[4], mr[4], mk[4], mv[4];
#pragma unroll
  for (int i = 0; i < 4; ++i) {
    const int c = lane * 4 + 256 * i;
    gg[i] = *(const f32x4*)(g + c);
    mr[i] = *(const f32x4*)(p.rw_mix + c);
    mk[i] = *(const f32x4*)(p.rw_mix + 2 * 1024 + c);
    mv[i] = *(const f32x4*)(p.rw_mix + 3 * 1024 + c);
  }
  auto xrow = [&](int row) { return row < NP ? p.x_prompt + (size_t)row * 1024 : p.x_sample + (size_t)(row - NP) * 1024; };
  auto hrow = [&](const f32x4 (&x)[4], int row, f32x4 (&h)[4]) __attribute__((always_inline)) {
    float ss = 0.f;
#pragma unroll
    for (int i = 0; i < 4; ++i) ss += x[i][0] * x[i][0] + x[i][1] * x[i][1] + x[i][2] * x[i][2] + x[i][3] * x[i][3];
    ss = wavesum(ss);
    const float rs = rsqrtf(ss * (1.f / 1024.f) + 1e-6f);
    const float* mb = mod + (size_t)bidx_of(row) * 6144;
#pragma unroll
    for (int i = 0; i < 4; ++i) {
      const int c = lane * 4 + 256 * i;
      const f32x4 s4 = *(const f32x4*)(mb + c), c4 = *(const f32x4*)(mb + 1024 + c);
      h[i] = x[i] * rs * gg[i] * (1.f + c4) + s4;
    }
  };
  for (int chunk = blockIdx.x * 8 + w; chunk < MROWS / 8; chunk += nw) {
    const int r0 = chunk * 8;
    f32x4 hp[4], x[4], xn[4];
    if (r0 < NP && (r0 & 4095) != 0) {
      const float* xr = xrow(r0 - 1);
#pragma unroll
      for (int i = 0; i < 4; ++i) x[i] = *(const f32x4*)(xr + lane * 4 + 256 * i);
      hrow(x, r0 - 1, hp);
    } else {
#pragma unroll
      for (int i = 0; i < 4; ++i) hp[i] = f32x4{0.f, 0.f, 0.f, 0.f};
    }
    {
      const float* xr = xrow(r0);
#pragma unroll
      for (int i = 0; i < 4; ++i) xn[i] = *(const f32x4*)(xr + lane * 4 + 256 * i);
    }
#pragma unroll 1
    for (int rr = 0; rr < 8; ++rr) {
      const int row = r0 + rr;
#pragma unroll
      for (int i = 0; i < 4; ++i) x[i] = xn[i];
      if (rr + 1 < 8) {
        const float* xr = xrow(row + 1);
#pragma unroll
        for (int i = 0; i < 4; ++i) xn[i] = *(const f32x4*)(xr + lane * 4 + 256 * i);
      }
      if (row >= NP) {
#pragma unroll
        for (int i = 0; i < 4; ++i) hp[i] = *(const f32x4*)(p.state_shift + (size_t)(row - NP) * 1024 + lane * 4 + 256 * i);
      }
      f32x4 h[4];
      hrow(x, row, h);
      const bool so = row >= NP || (row & 4095) == 4095;
      float* sop = row >= NP ? p.out + O_SHS + (size_t)(row - NP) * 1024 : p.out + O_SHP + (size_t)(row >> 12) * 1024;
#pragma unroll
      for (int i = 0; i < 4; ++i) {
        const int c = lane * 4 + 256 * i;
        *(uint2*)(H + (size_t)row * LDH + c) = pack4(h[i]);
        if (so) *(f32x4*)(sop + c) = h[i];
        const f32x4 dd = hp[i] - h[i];
        *(uint2*)(XR + (size_t)row * 1024 + c) = pack4(h[i] + dd * mr[i]);
        *(uint2*)(XK + (size_t)row * 1024 + c) = pack4(h[i] + dd * mk[i]);
        *(uint2*)(XV + (size_t)row * 1024 + c) = pack4(h[i] + dd * mv[i]);
        hp[i] = h[i];
      }
    }
  }
}

__device__ __forceinline__ void phase_final(const Params& p) {
  int tid_l = threadIdx.x;
  asm volatile("" : "+v"(tid_l));
  const int lane = tid_l & 63, w = tid_l >> 6;
  const int nw = gridDim.x * 8;
  for (int row = blockIdx.x * 8 + w; row < MROWS; row += nw) {
    float* xr = p.out + (size_t)row * 1024;
    float4 x[4];
    float ss = 0.f;
#pragma unroll
    for (int i = 0; i < 4; ++i) {
      x[i] = *(const float4*)(xr + lane * 4 + 256 * i);
      ss += x[i].x * x[i].x + x[i].y * x[i].y + x[i].z * x[i].z + x[i].w * x[i].w;
    }
    ss = wavesum(ss);
    const float rs = rsqrtf(ss * (1.f / 1024.f) + 1e-6f);
#pragma unroll
    for (int i = 0; i < 4; ++i) {
      const int c = lane * 4 + 256 * i;
      float4 gg = *(const float4*)(p.final_g + c);
      float4 h;
      h.x = x[i].x * rs * gg.x;
      h.y = x[i].y * rs * gg.y;
      h.z = x[i].z * rs * gg.z;
      h.w = x[i].w * rs * gg.w;
      *(float4*)(xr + c) = h;
    }
  }
}

__device__ __forceinline__ void phase_rwkv_proj(const Params& p, char* lds) {
  const u16* H = (const u16*)(p.ws + WS_H);
  const u16* wt = (const u16*)(p.ws + WS_WT);
  const u16* XR = (const u16*)p.out;
  const u16* XK = XR + (size_t)MROWS * 1024;
  const u16* XV = (const u16*)(p.ws + S_EW);
  u16* R = (u16*)(p.ws + S_R);
  u16* Kk = (u16*)(p.ws + S_K);
  u16* V = (u16*)(p.ws + S_V);
  u16* WH = (u16*)(p.ws + S_WH);
  u16* AH = (u16*)(p.ws + S_AH);
  u16* GH = (u16*)(p.ws + S_GH);
  for (int u = blockIdx.x; u < 780 + 195; u += gridDim.x) {
    if (u < 780) {
      const int kind = u / 260, t = u - kind * 260;
      const int mt = t >> 2, nt = t & 3;
      const int m0 = mt * 256, n0 = nt * 256;
      const u16* A = kind == 2 ? XV : XR + (size_t)kind * ((size_t)MROWS * 1024);
      const u16* Bt = wt + WT_WR + (size_t)kind * (1024 * LDH);
      u16* dst = R + (size_t)kind * (RSZ / 2);
      gemm_tile256(A, 1024, Bt, LDH, 1024, m0, n0, lds, mt == 64, [&](EPI_ARGS) {
        EPI_FOREACH(acc, if (row < MROWS) *(uint2*)(dst + (size_t)row * 1024 + col0) = pack4(v);)
      });
    } else {
      const int s_ = u - 780;
      const int mt = s_ / 3, kind = 3 + (s_ - mt * 3);
      const int m0 = mt * 256, n0 = 0;
      const int N = kind == 5 ? 128 : 64, mixi = kind == 3 ? 1 : kind;
      const u16* Bt = wt + WT_W1 + (size_t)(kind - 3) * (64 * LDH);
      gemm_tile<true>(H, LDH, p.rw_mix + mixi * 1024, Bt, LDH, N, 1024, m0, n0, lds, [&](EPI_ARGS) {
        u16* dst = WH + (size_t)(kind - 3) * ((size_t)MPAD * 64);
        const int ld = kind == 5 ? 128 : 64;
        EPI_FOREACH(acc, if (row < MROWS && col0 < ld) {
          f32x4 o = v;
          if (kind == 3) {
            _Pragma("unroll") for (int q = 0; q < 4; ++q) o[q] = 1.f - 2.f / (__expf(2.f * v[q]) + 1.f);
          } else if (kind == 5) {
            _Pragma("unroll") for (int q = 0; q < 4; ++q) o[q] = sigmoidf_(v[q]);
          }
          *(uint2*)(dst + (size_t)row * ld + col0) = pack4(o);
        })
      });
    }
  }
}

__device__ __forceinline__ void phase_rwkv_lora2(const Params& p, char* lds) {
  {
    const int gtid = blockIdx.x * NTHR + threadIdx.x, gsz = gridDim.x * NTHR;
    for (int i = gtid; i < 128 * 256; i += gsz) ((float4*)(p.out + (size_t)NP * 1024))[i] = ((const float4*)p.x_sample)[i];
  }
  const u16* wt = (const u16*)(p.ws + WS_WT);
  const u16* WH = (const u16*)(p.ws + S_WH);
  const u16* AH = (const u16*)(p.ws + S_AH);
  u16* EW = (u16*)(p.ws + S_EW);
  u16* Aa = (u16*)(p.ws + S_A);
  for (int t = blockIdx.x; t < 65 * 8; t += gridDim.x) {
    const int mt = t >> 3, j = t & 7;
    const int m0 = mt * 256, n0 = (j & 3) * 256;
    const bool isw = j < 4;
    gemm_tile256(isw ? WH : AH, 64, wt + (isw ? WT_W2 : WT_A2), 64, 64, m0, n0, lds, mt == 64, [&](EPI_ARGS) {
      const float* b0 = isw ? p.rw_w0 : p.rw_a0;
      EPI_FOREACH(acc, if (row < MROWS) {
        const float4 b4 = *(const float4*)(b0 + col0);
        const float s0 = sigmoidf_(v[0] + b4.x), s1 = sigmoidf_(v[1] + b4.y), s2 = sigmoidf_(v[2] + b4.z), s3 = sigmoidf_(v[3] + b4.w);
        if (isw) {
          const float c = 0.6065306597126334f;
          uint2 o;
          o.x = (unsigned)f2h(c * s0) | ((unsigned)f2h(c * s1) << 16);
          o.y = (unsigned)f2h(c * s2) | ((unsigned)f2h(c * s3) << 16);
          *(uint2*)(EW + (size_t)row * 1024 + col0) = o;
        } else {
          uint2 o;
          o.x = pack2(s0, s1);
          o.y = pack2(s2, s3);
          *(uint2*)(Aa + (size_t)row * 1024 + col0) = o;
        }
      })
    });
  }
}

__device__ __forceinline__ float fma_(float a, float b, float c) {
  float r;
  asm("v_fma_f32 %0, %1, %2, %3" : "=v"(r) : "v"(a), "v"(b), "v"(c));
  return r;
}
__device__ __forceinline__ float mul_(float a, float b) {
  float r;
  asm("v_mul_f32 %0, %1, %2" : "=v"(r) : "v"(a), "v"(b));
  return r;
}

constexpr int PAIR_TS = 624;
constexpr int PAIR_BUF = 8 * PAIR_TS;

__device__ __forceinline__ void phase_scan(const Params& p, char* lds) {
  int tid_l = threadIdx.x;
  asm volatile("" : "+v"(tid_l));
  const int tid = tid_l, lane = tid & 63, w = tid >> 6;
  const u16* R = (const u16*)(p.ws + S_R);
  const u16* Kk = (const u16*)(p.ws + S_K);
  const u16* V = (const u16*)(p.ws + S_V);
  const u16* EW = (const u16*)(p.ws + S_EW);
  const u16* Aa = (const u16*)(p.ws + S_A);
  u16* Y = (u16*)(p.ws + WS_H);
  float* RK = (float*)(p.ws + WS_RK);
  float* ring = (float*)lds;
  float* ybuf = (float*)(lds + 2 * PAIR_BUF * 4);
  for (int item = blockIdx.x; item < 256; item += gridDim.x) {
    const int chain = item >> 2, qr = item & 3, b = chain >> 4, h = chain & 15;
    const size_t rowbase = (size_t)b * 4096;
    __syncthreads();
    if (tid >= 256) {
      const int pt = tid - 256, grp = pt >> 7, pair = (pt & 127) >> 4, cq = pt & 15;
      const int ch = h * 64 + cq * 4;
      const float4 kk4 = *(const float4*)(p.rw_kk + ch), ka4 = *(const float4*)(p.rw_ka + ch), rk4 = *(const float4*)(p.rw_rk + ch);
      struct PS {
        uint2 rr[2], rk_[2], rv[2], ra_[2], re[2];
      };
      PS S0, S1;
      auto pload = [&](PS& S, int c) __attribute__((always_inline)) {
#pragma unroll
        for (int q = 0; q < 2; ++q) {
          const size_t off = (rowbase + (size_t)c * 16 + pair * 2 + q) * 1024 + ch;
          S.rr[q] = *(const uint2*)(R + off);
          S.rk_[q] = *(const uint2*)(Kk + off);
          S.rv[q] = *(const uint2*)(V + off);
          S.ra_[q] = *(const uint2*)(Aa + off);
          S.re[q] = *(const uint2*)(EW + off);
        }
      };
      auto pproc = [&](PS& S, int c) __attribute__((always_inline)) {
        const float kkw[4] = {kk4.x, kk4.y, kk4.z, kk4.w}, kaw[4] = {ka4.x, ka4.y, ka4.z, ka4.w}, rkw[4] = {rk4.x, rk4.y, rk4.z, rk4.w};
        float am[2][4], dc[2][4], bm[2][4], kp[2][4], rf[2][4], vf[2][4];
#pragma unroll
        for (int q = 0; q < 2; ++q) {
          const uint2 rr = S.rr[q], rk_ = S.rk_[q], rv = S.rv[q], ra_ = S.ra_[q], re = S.re[q];
          const float rfx[4] = {bflo(rr.x), bfhi(rr.x), bflo(rr.y), bfhi(rr.y)};
          const float kf[4] = {bflo(rk_.x), bfhi(rk_.x), bflo(rk_.y), bfhi(rk_.y)};
          const float vfx[4] = {bflo(rv.x), bfhi(rv.x), bflo(rv.y), bfhi(rv.y)};
          const float af[4] = {bflo(ra_.x), bfhi(ra_.x), bflo(ra_.y), bfhi(ra_.y)};
          const float ef[4] = {h2f((u16)(re.x & 0xffff)), h2f((u16)(re.x >> 16)), h2f((u16)(re.y & 0xffff)), h2f((u16)(re.y >> 16))};
          float kkr[4], ss = 0.f, rks = 0.f;
#pragma unroll
          for (int j = 0; j < 4; ++j) {
            kkr[j] = kf[j] * kkw[j];
            ss += kkr[j] * kkr[j];
            kp[q][j] = kf[j] * (1.f + (af[j] - 1.f) * kaw[j]);
            rks += rfx[j] * kp[q][j] * rkw[j];
            rf[q][j] = rfx[j];
            vf[q][j] = vfx[j];
          }
          ss = rowsum16(ss);
          rks = rowsum16(rks);
          const float inv = 1.f / fmaxf(sqrtf(ss), 1e-12f);
#pragma unroll
          for (int j = 0; j < 4; ++j) {
            am[q][j] = -kkr[j] * inv;
            dc[q][j] = __expf(-ef[j]);
            bm[q][j] = kkr[j] * inv * af[j];
          }
          if (cq == 0 && qr == 0) RK[(rowbase + (size_t)c * 16 + pair * 2 + q) * 16 + h] = rks;
        }
        float aw[4], w12[4], b1w[4], k1w[4], wr1[4], wr2[4];
        float cba = 0.f, cka = 0.f, br1 = 0.f, kr1 = 0.f, br12 = 0.f, kr12 = 0.f, br2 = 0.f, kr2 = 0.f;
#pragma unroll
        for (int j = 0; j < 4; ++j) {
          aw[j] = dc[0][j] * am[1][j];
          w12[j] = dc[0][j] * dc[1][j];
          b1w[j] = bm[0][j] * dc[1][j];
          k1w[j] = kp[0][j] * dc[1][j];
          wr1[j] = dc[0][j] * rf[0][j];
          wr2[j] = w12[j] * rf[1][j];
          cba += bm[0][j] * am[1][j];
          cka += kp[0][j] * am[1][j];
          br1 += bm[0][j] * rf[0][j];
          kr1 += kp[0][j] * rf[0][j];
          br12 += b1w[j] * rf[1][j];
          kr12 += k1w[j] * rf[1][j];
          br2 += bm[1][j] * rf[1][j];
          kr2 += kp[1][j] * rf[1][j];
        }
        cba = rowsum16(cba);
        cka = rowsum16(cka);
        br1 = rowsum16(br1);
        kr1 = rowsum16(kr1);
        br12 = rowsum16(br12);
        kr12 = rowsum16(kr12);
        br2 = rowsum16(br2);
        kr2 = rowsum16(kr2);
        float* slot = ring + (c & 1) * PAIR_BUF + pair * PAIR_TS;
        *(float4*)(slot + cq * 4) = make_float4(am[0][0], am[0][1], am[0][2], am[0][3]);
        *(float4*)(slot + 64 + cq * 4) = make_float4(aw[0], aw[1], aw[2], aw[3]);
        *(float4*)(slot + 128 + cq * 4) = make_float4(w12[0], w12[1], w12[2], w12[3]);
        *(float4*)(slot + 192 + cq * 4) = make_float4(b1w[0], b1w[1], b1w[2], b1w[3]);
        *(float4*)(slot + 256 + cq * 4) = make_float4(k1w[0], k1w[1], k1w[2], k1w[3]);
        *(float4*)(slot + 320 + cq * 4) = make_float4(bm[1][0], bm[1][1], bm[1][2], bm[1][3]);
        *(float4*)(slot + 384 + cq * 4) = make_float4(kp[1][0], kp[1][1], kp[1][2], kp[1][3]);
        *(float4*)(slot + 448 + cq * 4) = make_float4(wr1[0], wr1[1], wr1[2], wr1[3]);
        *(float4*)(slot + 512 + cq * 4) = make_float4(wr2[0], wr2[1], wr2[2], wr2[3]);
        if ((cq >> 2) == qr) {
          *(float4*)(slot + 576 + (cq & 3) * 4) = make_float4(vf[0][0], vf[0][1], vf[0][2], vf[0][3]);
          *(float4*)(slot + 592 + (cq & 3) * 4) = make_float4(vf[1][0], vf[1][1], vf[1][2], vf[1][3]);
        }
        if (cq == 0) {
          *(float4*)(slot + 608) = make_float4(cba, cka, br1, kr1);
          *(float4*)(slot + 612) = make_float4(br12, kr12, br2, kr2);
        }
      };
      if (grp == 0) {
        pload(S0, 0);
        pproc(S0, 0);
        pload(S1, 2);
        pload(S0, 4);
      } else {
        pload(S0, 1);
        pload(S1, 3);
      }
      BAR_SYNC();
#pragma unroll 1
      for (int c = 0; c < 256; c += 4) {
        if (grp == 1) {
          pproc(S0, c + 1);
          if (c + 5 < 256) pload(S0, c + 5);
        }
        BAR_SYNC();
        if (grp == 0) {
          pproc(S1, c + 2);
          if (c + 6 < 256) pload(S1, c + 6);
        }
        BAR_SYNC();
        if (grp == 1) {
          pproc(S1, c + 3);
          if (c + 7 < 256) pload(S1, c + 7);
        }
        BAR_SYNC();
        if (grp == 0) {
          if (c + 4 < 256) pproc(S0, c + 4);
          if (c + 8 < 256) pload(S0, c + 8);
        }
        BAR_SYNC();
      }
    } else {
      const int rl = tid >> 4, cgp = tid & 15;
      float s0 = 0.f, s1 = 0.f, s2 = 0.f, s3 = 0.f;
      BAR_SYNC();
      for (int c = 0; c < 256; ++c) {
        if (c > 0) {
          const float4* yp = (const float4*)(ybuf + ((c - 1) & 1) * 4096 + tid * 16);
          const float4 y0 = yp[0], y1 = yp[1], y2 = yp[2], y3 = yp[3];
          const float yv = ((y0.x + y0.y) + (y0.z + y0.w)) + ((y1.x + y1.y) + (y1.z + y1.w)) + ((y2.x + y2.y) + (y2.z + y2.w)) + ((y3.x + y3.y) + (y3.z + y3.w));
          Y[(rowbase + (size_t)(c - 1) * 16 + rl) * LDH + h * 64 + qr * 16 + cgp] = f2bf(yv);
        }
        const float* bufp = ring + (c & 1) * PAIR_BUF;
        float* yb = ybuf + (c & 1) * 4096;
        struct PV {
          float4 a1, aw, w12, b1w, k1w, b2, k2, wr1, wr2, sc0, sc1;
          float v1, v2;
        };
        auto ldpair = [&](const float* slot) __attribute__((always_inline)) {
          PV r;
          r.a1 = *(const float4*)(slot + cgp * 4);
          r.aw = *(const float4*)(slot + 64 + cgp * 4);
          r.w12 = *(const float4*)(slot + 128 + cgp * 4);
          r.b1w = *(const float4*)(slot + 192 + cgp * 4);
          r.k1w = *(const float4*)(slot + 256 + cgp * 4);
          r.b2 = *(const float4*)(slot + 320 + cgp * 4);
          r.k2 = *(const float4*)(slot + 384 + cgp * 4);
          r.wr1 = *(const float4*)(slot + 448 + cgp * 4);
          r.wr2 = *(const float4*)(slot + 512 + cgp * 4);
          r.v1 = slot[576 + rl];
          r.v2 = slot[592 + rl];
          r.sc0 = *(const float4*)(slot + 608);
          r.sc1 = *(const float4*)(slot + 612);
          return r;
        };
        PV cur = ldpair(bufp);
#pragma unroll
        for (int pr = 0; pr < 8; ++pr) {
          PV nxt = cur;
          if (pr + 1 < 8) nxt = ldpair(bufp + (pr + 1) * PAIR_TS);
          float d1 = fma_(s3, cur.a1.w, fma_(s2, cur.a1.z, fma_(s1, cur.a1.y, mul_(s0, cur.a1.x))));
          float d2 = fma_(s3, cur.aw.w, fma_(s2, cur.aw.z, fma_(s1, cur.aw.y, mul_(s0, cur.aw.x))));
          const float e1 = fma_(s3, cur.wr1.w, fma_(s2, cur.wr1.z, fma_(s1, cur.wr1.y, mul_(s0, cur.wr1.x))));
          const float e2 = fma_(s3, cur.wr2.w, fma_(s2, cur.wr2.z, fma_(s1, cur.wr2.y, mul_(s0, cur.wr2.x))));
          const float t0 = fma_(cur.v2, cur.k2.x, fma_(cur.v1, cur.k1w.x, mul_(s0, cur.w12.x)));
          const float t1 = fma_(cur.v2, cur.k2.y, fma_(cur.v1, cur.k1w.y, mul_(s1, cur.w12.y)));
          const float t2 = fma_(cur.v2, cur.k2.z, fma_(cur.v1, cur.k1w.z, mul_(s2, cur.w12.z)));
          const float t3 = fma_(cur.v2, cur.k2.w, fma_(cur.v1, cur.k1w.w, mul_(s3, cur.w12.w)));
          d1 = rowsum16(d1);
          d2 = rowsum16(d2);
          const float sa1 = d1;
          const float sa2 = fma_(cur.v1, cur.sc0.y, fma_(sa1, cur.sc0.x, d2));
          s0 = fma_(sa2, cur.b2.x, fma_(sa1, cur.b1w.x, t0));
          s1 = fma_(sa2, cur.b2.y, fma_(sa1, cur.b1w.y, t1));
          s2 = fma_(sa2, cur.b2.z, fma_(sa1, cur.b1w.z, t2));
          s3 = fma_(sa2, cur.b2.w, fma_(sa1, cur.b1w.w, t3));
          yb[(2 * pr) * 256 + tid] = e1 + 0.0625f * (sa1 * cur.sc0.z + cur.v1 * cur.sc0.w);
          yb[(2 * pr + 1) * 256 + tid] = e2 + 0.0625f * (sa1 * cur.sc1.x + cur.v1 * cur.sc1.y + sa2 * cur.sc1.z + cur.v2 * cur.sc1.w);
          cur = nxt;
        }
        BAR_SYNC();
      }
      {
        const float4* yp = (const float4*)(ybuf + (255 & 1) * 4096 + tid * 16);
        const float4 y0 = yp[0], y1 = yp[1], y2 = yp[2], y3 = yp[3];
        const float yv = ((y0.x + y0.y) + (y0.z + y0.w)) + ((y1.x + y1.y) + (y1.z + y1.w)) + ((y2.x + y2.y) + (y2.z + y2.w)) + ((y3.x + y3.y) + (y3.z + y3.w));
        Y[(rowbase + (size_t)255 * 16 + rl) * LDH + h * 64 + qr * 16 + cgp] = f2bf(yv);
      }
      float* wo = p.out + O_WKVP + (((size_t)(b * 16 + h) * 64) + qr * 16 + rl) * 64 + cgp * 4;
      *(float4*)wo = make_float4(s0, s1, s2, s3);
    }
  }
  float* sl = (float*)lds;
  for (int chain = blockIdx.x; chain < 2048; chain += gridDim.x) {
    const int b = chain >> 4, h = chain & 15;
    const size_t row = (size_t)NP + b;
    __syncthreads();
    if (w == 0) {
      const int ch = h * 64 + lane;
      const size_t off = row * 1024 + ch;
      const float rf = bf2f(R[off]), kf = bf2f(Kk[off]), vf = bf2f(V[off]), af = bf2f(Aa[off]), ef = h2f(EW[off]);
      const float kkr = kf * p.rw_kk[ch];
      const float ss = wavesum(kkr * kkr);
      const float inv = 1.f / fmaxf(sqrtf(ss), 1e-12f);
      const float kp = kf * (1.f + (af - 1.f) * p.rw_ka[ch]);
      const float rks = wavesum(rf * kp * p.rw_rk[ch]);
      sl[lane] = -kkr * inv;
      sl[64 + lane] = __expf(-ef);
      sl[128 + lane] = kkr * inv * af;
      sl[192 + lane] = kp;
      sl[256 + lane] = rf;
      sl[320 + lane] = vf;
      if (lane == 0) RK[row * 16 + h] = rks;
    }
    __syncthreads();
    const int i = tid >> 3, c8 = tid & 7;
    const float* sp = p.state_wkv + (((size_t)(b * 16 + h) * 64) + i) * 64 + c8 * 8;
    float4 sA = *(const float4*)sp, sB = *(const float4*)(sp + 4);
    float s[8] = {sA.x, sA.y, sA.z, sA.w, sB.x, sB.y, sB.z, sB.w};
    float sa = 0.f;
#pragma unroll
    for (int j = 0; j < 8; ++j) sa += s[j] * sl[c8 * 8 + j];
    sa += __shfl_xor(sa, 1);
    sa += __shfl_xor(sa, 2);
    sa += __shfl_xor(sa, 4);
    const float vv = sl[320 + i];
    float y = 0.f;
#pragma unroll
    for (int j = 0; j < 8; ++j) {
      const int cj = c8 * 8 + j;
      s[j] = s[j] * sl[64 + cj] + sa * sl[128 + cj] + vv * sl[192 + cj];
      y += s[j] * sl[256 + cj];
    }
    y += __shfl_xor(y, 1);
    y += __shfl_xor(y, 2);
    y += __shfl_xor(y, 4);
    float* wo = p.out + O_WKVS + (((size_t)(b * 16 + h) * 64) + i) * 64 + c8 * 8;
    *(float4*)wo = make_float4(s[0], s[1], s[2], s[3]);
    *(float4*)(wo + 4) = make_float4(s[4], s[5], s[6], s[7]);
    if (c8 == 0) Y[row * LDH + h * 64 + i] = f2bf(y);
  }
}

__device__ __forceinline__ void phase_gate(const Params& p, char* lds) {
  const u16* wt = (const u16*)(p.ws + WS_WT);
  const u16* GH = (const u16*)(p.ws + S_GH);
  const u16* V = (const u16*)(p.ws + S_V);
  const float* RK = (const float*)(p.ws + WS_RK);
  u16* Y = (u16*)(p.ws + WS_H);
  for (int t = blockIdx.x; t < 65 * 4; t += gridDim.x) {
    const int mt = t >> 2, nt = t & 3;
    const int m0 = mt * 256, n0 = nt * 256;
    gemm_tile256(GH, 128, wt + WT_G2, 128, 128, m0, n0, lds, mt == 64, [&](EPI_ARGS) {
      const int hh = (n0 + wn * 64) >> 6;
#pragma unroll
      for (int mi = 0; mi < 8; ++mi) {
        const int row = m0 + wm * 128 + mi * 16 + lr;
        const int rowc = row < MROWS ? row : MROWS - 1;
        float yv[4][4];
        float sum = 0.f;
#pragma unroll
        for (int ni = 0; ni < 4; ++ni) {
          const uint2 yy = *(const uint2*)(Y + (size_t)rowc * LDH + hh * 64 + ni * 16 + lg * 4);
          yv[ni][0] = bflo(yy.x); yv[ni][1] = bfhi(yy.x); yv[ni][2] = bflo(yy.y); yv[ni][3] = bfhi(yy.y);
          sum += yv[ni][0] + yv[ni][1] + yv[ni][2] + yv[ni][3];
        }
        sum += __shfl_xor(sum, 16);
        sum += __shfl_xor(sum, 32);
        const float mu = sum * (1.f / 64.f);
        float vs = 0.f;
#pragma unroll
        for (int ni = 0; ni < 4; ++ni)
#pragma unroll
          for (int q = 0; q < 4; ++q) {
            const float d = yv[ni][q] - mu;
            vs += d * d;
          }
        vs += __shfl_xor(vs, 16);
        vs += __shfl_xor(vs, 32);
        const float rstd = rsqrtf(vs * (1.f / 64.f) + 64e-5f);
        const float rk = RK[(size_t)rowc * 16 + hh];
#pragma unroll
        for (int ni = 0; ni < 4; ++ni) {
          const int col0 = hh * 64 + ni * 16 + lg * 4;
          const uint2 vv = *(const uint2*)(V + (size_t)rowc * 1024 + col0);
          const float vf[4] = {bflo(vv.x), bfhi(vv.x), bflo(vv.y), bfhi(vv.y)};
          const float4 g4 = *(const float4*)(p.rw_lnx_g + col0), b4 = *(const float4*)(p.rw_lnx_b + col0);
          const float gg[4] = {g4.x, g4.y, g4.z, g4.w}, bb[4] = {b4.x, b4.y, b4.z, b4.w};
          f32x4 o;
#pragma unroll
          for (int q = 0; q < 4; ++q) o[q] = ((yv[ni][q] - mu) * rstd * gg[q] + bb[q] + rk * vf[q]) * acc[mi][ni][q];
          if (row < MROWS) *(uint2*)(Y + (size_t)row * LDH + col0) = pack4(o);
        }
        __builtin_amdgcn_sched_barrier(0);
      }
    });
  }
}

__device__ __forceinline__ void phase_oproj(const Params& p, char* lds, const u16* A, int K, const u16* Bt, int layer, int gidx, bool first) {
  const int ldab = K == 1024 ? LDH : LDU;
  const float* mod = (const float*)(p.ws + WS_MOD);
  for (int u = blockIdx.x; u < 320; u += gridDim.x) {
    const bool split = u >= 256;
    const int s = u - 256;
    const int m0 = split ? NP : (u >> 2) * 256, n0 = (split ? (s & 3) : (u & 3)) * 256;
    const int klen = split ? (K >> 4) : K, kbeg = split ? (s >> 2) * klen : 0;
    gemm_tile256(A + kbeg, ldab, Bt + kbeg, ldab, klen, m0, n0, lds, split, [&](EPI_ARGS) {
      EPI_FOREACH(acc, if (row < MROWS) {
        const float4 gt = *(const float4*)(mod + ((size_t)layer * 132 + bidx_of(row)) * 6144 + gidx * 1024 + col0);
        float* xp = p.out + (size_t)row * 1024 + col0;
        if (split) {
          unsafeAtomicAdd(xp + 0, gt.x * v[0]);
          unsafeAtomicAdd(xp + 1, gt.y * v[1]);
          unsafeAtomicAdd(xp + 2, gt.z * v[2]);
          unsafeAtomicAdd(xp + 3, gt.w * v[3]);
        } else {
          const float* xi = first ? p.x_prompt + (size_t)row * 1024 + col0 : xp;
          const float4 xo = *(const float4*)xi;
          *(float4*)xp = make_float4(xo.x + gt.x * v[0], xo.y + gt.y * v[1], xo.z + gt.z * v[2], xo.w + gt.w * v[3]);
        }
      })
    });
  }
}

__device__ __forceinline__ void phase_up(const Params& p, char* lds, const u16* Bt) {
  const u16* H = (const u16*)(p.ws + WS_H);
  u16* UP = (u16*)(p.ws + S_UP);
  for (int t = blockIdx.x; t < 65 * 16; t += gridDim.x) {
    const int mt = t >> 4, nt = t & 15;
    const int m0 = mt * 256, n0 = nt * 256;
    gemm_tile256(H, LDH, Bt, LDH, 1024, m0, n0, lds, mt == 64, [&](EPI_ARGS) {
      EPI_FOREACH(acc, if (row < MROWS) {
        f32x4 o;
        _Pragma("unroll") for (int q = 0; q < 4; ++q) {
          const float rl = fmaxf(v[q], 0.f);
          o[q] = rl * rl;
        }
        *(uint2*)(UP + (size_t)row * LDU + col0) = pack4(o);
      })
    });
  }
}

__device__ __forceinline__ void phase_qkv(const Params& p, char* lds) {
  const u16* H = (const u16*)(p.ws + WS_H);
  const u16* wt = (const u16*)(p.ws + WS_WT);
  const float* tab = (const float*)(p.ws + WS_TAB);
  u16* Qb = (u16*)(p.ws + S_Q);
  u16* Kb = (u16*)(p.ws + S_KB);
  u16* Vt = (u16*)(p.ws + S_VT);
  for (int t = blockIdx.x; t < 65 * 6; t += gridDim.x) {
    const int mt = t / 6, nt = t % 6;
    const int m0 = mt * 256, n0 = nt * 256;
    gemm_tile256(H, LDH, wt + WT_QKV, LDH, 1024, m0, n0, lds, mt == 64, [&](EPI_ARGS) {
      const int hc0 = n0 + wn * 64;
#pragma unroll
      for (int mi = 0; mi < 8; ++mi) {
        const int row = m0 + wm * 128 + mi * 16 + lr;
        const bool valid = row < MROWS;
        const bool isp = row < NP;
        const int pos = row & 4095;
        const int bq = isp ? (row >> 12) : (row - NP);
        const int posidx = isp ? pos : 4096;
#pragma unroll
        for (int ni = 0; ni < 4; ++ni) {
          const int col0 = hc0 + ni * 16 + lg * 4;
          const float4 b4 = *(const float4*)(p.at_bqkv + col0);
          f32x4 v = acc[mi][ni];
          v[0] += b4.x; v[1] += b4.y; v[2] += b4.z; v[3] += b4.w;
          if (ni == 0 && hc0 < 1280) {
            const float* tp = tab + (size_t)posidx * 16 + (lg & 1) * 8;
            const float4 t0 = *(const float4*)tp, t1 = *(const float4*)(tp + 4);
            const float cs[4] = {t0.x, t0.z, t1.x, t1.z}, sn[4] = {t0.y, t0.w, t1.y, t1.w};
#pragma unroll
            for (int q = 0; q < 4; ++q) {
              const float pv = __shfl_xor(v[q], 32);
              v[q] = (lg < 2) ? (v[q] * cs[q] - pv * sn[q]) : (v[q] * cs[q] + pv * sn[q]);
            }
          }
          if (valid) {
            if (hc0 < 1024) {
              *(uint2*)(Qb + (size_t)row * 1024 + col0) = pack4(v);
            } else if (hc0 < 1280) {
              const int c2 = col0 - 1024;
              *(uint2*)(Kb + (size_t)row * 256 + c2) = pack4(v);
              if (isp) {
                if (pos >= 3968) *(float4*)(p.out + O_KP + ((size_t)(bq * 128 + pos - 3968)) * 256 + c2) = make_float4(v[0], v[1], v[2], v[3]);
              } else {
                *(float4*)(p.out + O_KS + ((size_t)(bq * 128 + 127)) * 256 + c2) = make_float4(v[0], v[1], v[2], v[3]);
              }
            } else {
              const int c3 = col0 - 1280;
              if (isp) {
                u16* vp = Vt + ((size_t)(bq * 4 + (c3 >> 6)) * 64 + (c3 & 63)) * 4096 + pos;
#pragma unroll
                for (int q = 0; q < 4; ++q) vp[(size_t)q * 4096] = f2bf(v[q]);
                if (pos >= 3968) *(float4*)(p.out + O_VP + ((size_t)(bq * 128 + pos - 3968)) * 256 + c3) = make_float4(v[0], v[1], v[2], v[3]);
              } else {
                *(float4*)(p.out + O_VS + ((size_t)(bq * 128 + 127)) * 256 + c3) = make_float4(v[0], v[1], v[2], v[3]);
              }
            }
          }
        }
        __builtin_amdgcn_sched_barrier(0);
      }
    });
  }
}

constexpr int AT_KS = 0, AT_VS = 36864, AT_PS = 36864 + 35840, AT_PW = 5376;

__device__ __forceinline__ void phase_attn(const Params& p, char* lds) {
  int tid_l = threadIdx.x;
  asm volatile("" : "+v"(tid_l));
  const int tid = tid_l, lane = tid & 63, w = tid >> 6, lr = lane & 15, lg = lane >> 4;
  const u16* Qb = (const u16*)(p.ws + S_Q);
  const u16* Kb = (const u16*)(p.ws + S_KB);
  const u16* Vt = (const u16*)(p.ws + S_VT);
  u16* O = (u16*)(p.ws + S_O);
  char* Ks = lds + AT_KS;
  char* Vs = lds + AT_VS;
  char* Ps = lds + AT_PS + w * AT_PW;
  for (int u = blockIdx.x; u < 512; u += gridDim.x) {
    const int b = u >> 7, n = (u >> 2) & 31, kvh = u & 3;
    bf16x8 qfa[4][2];
    {
      const int g_ = w >> 1, hf_ = w & 1, qh_ = kvh * 4 + g_;
#pragma unroll
      for (int i = 0; i < 4; ++i) {
        const size_t tok = (size_t)b * 4096 + n * 128 + hf_ * 64 + i * 16 + lr;
        qfa[i][0] = *(const bf16x8*)(Qb + tok * 1024 + qh_ * 64 + lg * 8);
        qfa[i][1] = *(const bf16x8*)(Qb + tok * 1024 + qh_ * 64 + 32 + lg * 8);
      }
    }
    __syncthreads();
#pragma unroll
    for (int i = 0; i < 4; ++i) {
      const int c = tid + 512 * i;
      {
        const int key = c >> 3, kc = c & 7;
        const int pos = n * 128 - 128 + key;
        uint4 v = {0u, 0u, 0u, 0u};
        if (pos >= 0) v = *(const uint4*)(Kb + ((size_t)b * 4096 + pos) * 256 + kvh * 64 + kc * 8);
        *(uint4*)(Ks + key * 144 + kc * 16) = v;
      }
      {
        const int d = c >> 5, kc = c & 31;
        const int pos0 = n * 128 - 128 + kc * 8;
        uint4 v = {0u, 0u, 0u, 0u};
        if (pos0 >= 0) v = *(const uint4*)(Vt + ((size_t)(b * 4 + kvh) * 64 + d) * 4096 + pos0);
        *(uint4*)(Vs + d * 560 + kc * 16) = v;
      }
    }
    if (tid < 192) {
      const int d = tid / 3, c = tid % 3;
      *(uint4*)(Vs + d * 560 + 512 + c * 16) = uint4{0u, 0u, 0u, 0u};
    }
    {
      const int prow = lane >> 2, pc = 144 + (lane & 3) * 4;
      *(uint2*)(Ps + prow * 336 + pc * 2) = uint2{0u, 0u};
    }
    __syncthreads();
    const int g = w >> 1, hf = w & 1;
    const int qh = kvh * 4 + g;
    const float sink = p.at_sink[qh];
#pragma unroll
    for (int i = 0; i < 4; ++i) {
      const int q0 = hf * 64 + i * 16;
      const bf16x8 qf0 = qfa[i][0];
      const bf16x8 qf1 = qfa[i][1];
      f32x4 s[9];
#pragma unroll
      for (int j = 0; j < 9; ++j) {
        const char* kp = Ks + (q0 + j * 16 + lr) * 144 + lg * 16;
        const bf16x8 k0 = *(const bf16x8*)kp;
        const bf16x8 k1 = *(const bf16x8*)(kp + 64);
        f32x4 z = {0.f, 0.f, 0.f, 0.f};
        z = __builtin_amdgcn_mfma_f32_16x16x32_bf16(qf0, k0, z, 0, 0, 0);
        z = __builtin_amdgcn_mfma_f32_16x16x32_bf16(qf1, k1, z, 0, 0, 0);
        s[j] = z;
      }
      float mx[4], sum[4];
#pragma unroll
      for (int r = 0; r < 4; ++r) {
        const int ql = lg * 4 + r;
        float m = sink;
#pragma unroll
        for (int j = 0; j < 9; ++j) {
          float v = s[j][r] * 0.125f;
          bool ok = true;
          if (j == 0) ok = (lr >= ql);
          if (j == 8) ok = (lr <= ql);
          if (n == 0 && (q0 + j * 16 + lr) < 128) ok = false;
          v = ok ? v : -INFINITY;
          s[j][r] = v;
          m = fmaxf(m, v);
        }
        mx[r] = rowmax16(m);
      }
#pragma unroll
      for (int r = 0; r < 4; ++r) {
        float sm = 0.f;
#pragma unroll
        for (int j = 0; j < 9; ++j) {
          const float e = __expf(s[j][r] - mx[r]);
          s[j][r] = e;
          sm += e;
        }
        sm = rowsum16(sm);
        sum[r] = sm + __expf(sink - mx[r]);
      }
      u16* P = (u16*)Ps;
#pragma unroll
      for (int j = 0; j < 9; ++j)
#pragma unroll
        for (int r = 0; r < 4; ++r) P[(lg * 4 + r) * 168 + j * 16 + lr] = f2bf(s[j][r]);
      __builtin_amdgcn_wave_barrier();
      f32x4 o[4];
#pragma unroll
      for (int nd = 0; nd < 4; ++nd) o[nd] = f32x4{0.f, 0.f, 0.f, 0.f};
#pragma unroll
      for (int kk = 0; kk < 5; ++kk) {
        const bf16x8 pf = *(const bf16x8*)(Ps + lr * 336 + kk * 64 + lg * 16);
#pragma unroll
        for (int nd = 0; nd < 4; ++nd) {
          const bf16x8 vf = *(const bf16x8*)(Vs + (nd * 16 + lr) * 560 + (q0 + kk * 32 + lg * 8) * 2);
          o[nd] = __builtin_amdgcn_mfma_f32_16x16x32_bf16(pf, vf, o[nd], 0, 0, 0);
        }
      }
#pragma unroll
      for (int nd = 0; nd < 4; ++nd)
#pragma unroll
        for (int r = 0; r < 4; ++r) {
          const float v = o[nd][r] / sum[r];
          O[((size_t)b * 4096 + n * 128 + q0 + lg * 4 + r) * LDH + qh * 64 + nd * 16 + lr] = f2bf(v);
        }
      __builtin_amdgcn_wave_barrier();
    }
  }
  float* qs = (float*)lds;
  float* sc = (float*)(lds + 1024);
  float* part = (float*)(lds + 1024 + 2112);
  for (int it = blockIdx.x; it < 512; it += gridDim.x) {
    const int b = it >> 2, kvh = it & 3;
    const size_t row = (size_t)NP + b;
    __syncthreads();
    if (tid < 256) qs[tid] = bf2f(Qb[row * 1024 + kvh * 256 + tid]);
    __syncthreads();
    {
      const int key = tid >> 2, g = tid & 3;
      const float* kp = p.cache_k + (((size_t)b * 128 + key) * 4 + kvh) * 64;
      float dot = 0.f;
#pragma unroll
      for (int d4 = 0; d4 < 16; ++d4) {
        const float4 kv = *(const float4*)(kp + d4 * 4);
        const float* q = qs + g * 64 + d4 * 4;
        dot += kv.x * q[0] + kv.y * q[1] + kv.z * q[2] + kv.w * q[3];
      }
      sc[g * 132 + key] = dot * 0.125f;
      if (key >= 1) {
        float* dst = p.out + O_KS + (((size_t)b * 128 + key - 1) * 4 + kvh) * 64 + g * 16;
        const float* src = kp + g * 16;
#pragma unroll
        for (int d4 = 0; d4 < 4; ++d4) *(float4*)(dst + d4 * 4) = *(const float4*)(src + d4 * 4);
      }
      if (tid < 4) {
        const float* kn = p.out + O_KS + (((size_t)b * 128 + 127) * 4 + kvh) * 64;
        float d2 = 0.f;
        for (int d = 0; d < 64; ++d) d2 += kn[d] * qs[tid * 64 + d];
        sc[tid * 132 + 128] = d2 * 0.125f;
      }
    }
    __syncthreads();
    if (w < 4) {
      const float sink = p.at_sink[kvh * 4 + w];
      float* s = sc + w * 132;
      const float v0 = s[lane], v1 = s[64 + lane], v2 = lane == 0 ? s[128] : -INFINITY;
      float m = fmaxf(fmaxf(v0, v1), fmaxf(v2, sink));
      m = wavemax(m);
      const float e0 = __expf(v0 - m), e1 = __expf(v1 - m), e2 = lane == 0 ? __expf(v2 - m) : 0.f;
      float sm = wavesum(e0 + e1 + e2) + __expf(sink - m);
      const float inv = 1.f / sm;
      s[lane] = e0 * inv;
      s[64 + lane] = e1 * inv;
      if (lane == 0) s[128] = e2 * inv;
    }
    __syncthreads();
    {
      const int d = tid & 63, g = (tid >> 6) & 3, half = tid >> 8;
      const float* vp = p.cache_v + (((size_t)b * 128) * 4 + kvh) * 64 + d;
      float accv = 0.f;
      for (int key = half * 64; key < half * 64 + 64; ++key) {
        const float vv = vp[(size_t)key * 256];
        accv += sc[g * 132 + key] * vv;
        if (g == 0 && key >= 1) p.out[O_VS + (((size_t)b * 128 + key - 1) * 4 + kvh) * 64 + d] = vv;
      }
      if (half == 1) accv += sc[g * 132 + 128] * p.out[O_VS + (((size_t)b * 128 + 127) * 4 + kvh) * 64 + d];
      part[(half * 4 + g) * 64 + d] = accv;
    }
    __syncthreads();
    if (tid < 256) {
      const int d = tid & 63, g = tid >> 6;
      O[row * LDH + (kvh * 4 + g) * 64 + d] = f2bf(part[g * 64 + d] + part[(4 + g) * 64 + d]);
    }
  }
}

__global__ void __launch_bounds__(NTHR) mega(Params p) {
  extern __shared__ __attribute__((aligned(16))) char lds[];
  cg::grid_group grid = cg::this_grid();
  volatile LAS unsigned* xst = (volatile LAS unsigned*)(lds + LDS_BYTES);
  if (threadIdx.x == 0) { xst[0] = 0u; xst[1] = 0u; }
  __syncthreads();
  const XcdBarrier xb = xcd_barrier_post((unsigned*)(p.ws + WS_BAR), xst);
  const u16* wt = (const u16*)(p.ws + WS_WT);
  phase0(p, lds);
  if (p.out == nullptr) grid.sync();
  xcd_barrier(xb);
  phase_ada(p, lds);
  xcd_barrier(xb);
  phase_norm_mix(p);
  xcd_barrier(xb);
  phase_rwkv_proj(p, lds);
  xcd_barrier(xb);
  phase_rwkv_lora2(p, lds);
  xcd_barrier(xb);
  phase_scan(p, lds);
  xcd_barrier(xb);
  phase_gate(p, lds);
  xcd_barrier(xb);
  phase_oproj(p, lds, (const u16*)(p.ws + WS_H), 1024, wt + WT_WO, 0, 2, true);
  xcd_barrier(xb);
  phase_norm(p, 0, 1, false, false);
  xcd_barrier(xb);
  phase_up(p, lds, wt + WT_UP0);
  xcd_barrier(xb);
  phase_oproj(p, lds, (const u16*)(p.ws + S_UP), 4096, wt + WT_DN0, 0, 5, false);
  xcd_barrier(xb);
  phase_norm(p, 1, 0, false, false);
  xcd_barrier(xb);
  phase_qkv(p, lds);
  xcd_barrier(xb);
  phase_attn(p, lds);
  xcd_barrier(xb);
  phase_oproj(p, lds, (const u16*)(p.ws + S_O), 1024, wt + WT_WO1, 1, 2, false);
  xcd_barrier(xb);
  phase_norm(p, 1, 1, false, false);
  xcd_barrier(xb);
  phase_up(p, lds, wt + WT_UP1);
  xcd_barrier(xb);
  phase_oproj(p, lds, (const u16*)(p.ws + S_UP), 4096, wt + WT_DN1, 1, 5, false);
  xcd_barrier(xb);
  phase_final(p);
}

extern "C" void kernel_launch(void* const* d_in, const int* in_sizes, int n_in, void* d_out, int out_size, void* d_ws,
                              size_t ws_size, hipStream_t stream) {
  static int grid_blocks = 0;
  if (grid_blocks == 0) {
    if (ws_size < WS_END) {
      fprintf(stderr, "kernel_launch: workspace too small: %zu < %zu\n", ws_size, (size_t)WS_END);
      grid_blocks = -1;
      return;
    }
    int dev = 0, cus = 0, per_cu = 0;
    hipGetDevice(&dev);
    hipDeviceGetAttribute(&cus, hipDeviceAttributeMultiprocessorCount, dev);
    hipFuncSetAttribute((const void*)mega, hipFuncAttributeMaxDynamicSharedMemorySize, LDS_BYTES + 16);
    hipOccupancyMaxActiveBlocksPerMultiprocessor(&per_cu, (const void*)mega, NTHR, LDS_BYTES + 16);
    if (per_cu < 1) per_cu = 1;
    grid_blocks = cus * per_cu;
  }
  if (grid_blocks < 0) return;
  Params p{};
  const float** pp = (const float**)&p;
  for (int i = 0; i < 37; ++i) pp[i] = (const float*)d_in[i];
  p.out = (float*)d_out;
  p.ws = (char*)d_ws;
  hipMemsetAsync((char*)d_ws + WS_BAR, 0, 16384, stream);
  void* args[] = {&p};
  hipError_t e = hipLaunchCooperativeKernel((const void*)mega, dim3(grid_blocks), dim3(NTHR), args, LDS_BYTES + 16, stream);
  if (e != hipSuccess) fprintf(stderr, "cooperative launch failed: %s (grid %d)\n", hipGetErrorString(e), grid_blocks);
}
```

```cpp
#include <hip/hip_runtime.h>
#include <hip/hip_cooperative_groups.h>
#include <cstdio>
namespace cg = cooperative_groups;

typedef unsigned short u16;
typedef __attribute__((ext_vector_type(8))) short bf16x8;
typedef __attribute__((ext_vector_type(4))) float f32x4;

constexpr int NP = 16384, MROWS = 16512, MPAD = 16640;
constexpr int NTHR = 512;
constexpr size_t MEG = 1048576;
constexpr int LDH = 1088, LDU = 4160;

constexpr size_t O_Y = 0, O_WKVP = 16908288, O_WKVS = 17170432, O_SHP = 25559040, O_SHS = 25563136,
                 O_KP = 25694208, O_KS = 25825280, O_VP = 30019584, O_VS = 30150656;

constexpr size_t WT_WR = 0, WT_WK = WT_WR + 1024 * LDH, WT_WV = WT_WK + 1024 * LDH, WT_WO = WT_WV + 1024 * LDH,
                 WT_W1 = WT_WO + 1024 * LDH, WT_A1 = WT_W1 + 64 * LDH, WT_G1 = WT_A1 + 64 * LDH, WT_W2 = WT_G1 + 128 * LDH,
                 WT_A2 = WT_W2 + 65536, WT_G2 = WT_A2 + 65536, WT_UP0 = WT_G2 + 131072, WT_DN0 = WT_UP0 + 4096 * LDH,
                 WT_QKV = WT_DN0 + 1024 * LDU, WT_WO1 = WT_QKV + 1536 * LDH, WT_UP1 = WT_WO1 + 1024 * LDH,
                 WT_DN1 = WT_UP1 + 4096 * LDH, WT_END = WT_DN1 + 1024 * LDU;
constexpr size_t WS_WT = 0;
constexpr size_t WS_H = WS_WT + WT_END * 2;
constexpr size_t WS_ZR = WS_H + (size_t)MPAD * LDH * 2;
constexpr size_t WS_MOD = WS_ZR + (size_t)LDH * 2;
constexpr size_t WS_TAB = WS_MOD + (size_t)2 * 132 * 6144 * 4;
constexpr size_t WS_HS = WS_H + (size_t)MROWS * LDH * 2;
constexpr size_t WS_RK = WS_TAB + (size_t)4097 * 8 * 8;
constexpr size_t WS_BAR = WS_RK + (size_t)MPAD * 16 * 4;
constexpr size_t WS_S = WS_BAR + 16384;
constexpr size_t RSZ = (size_t)MROWS * 1024 * 2;
constexpr size_t S_ADAWT = WS_S, S_SILUC = S_ADAWT + (size_t)2 * 6144 * LDH * 2;
constexpr size_t S_R = WS_S, S_K = S_R + RSZ, S_V = S_K + RSZ, S_EW = S_V + RSZ, S_A = S_EW + RSZ,
                 S_WH = S_A + RSZ, S_AH = S_WH + (size_t)MPAD * 64 * 2, S_GH = S_AH + (size_t)MPAD * 64 * 2,
                 S_RW_END = S_GH + (size_t)MPAD * 128 * 2;
constexpr size_t S_UP = WS_S;
constexpr size_t S_Q = WS_S, S_O = S_Q + (size_t)MPAD * 1024 * 2, S_KB = S_O + (size_t)MPAD * LDH * 2,
                 S_VT = S_KB + (size_t)MPAD * 256 * 2;
constexpr size_t WS_END = S_RW_END;
static_assert(S_UP + (size_t)MPAD * LDU * 2 <= WS_END, "up fits");
static_assert(S_VT + (size_t)16 * 64 * 4096 * 2 <= WS_END, "attn fits");
static_assert(WS_END <= 282000000, "ws fits sum of inputs");

constexpr int LDS_ROW = 144;
constexpr int LDS_A_BYTES = 256 * LDS_ROW;
constexpr int LDS_B_BYTES = 128 * LDS_ROW;
constexpr int LDS_STAGE = LDS_A_BYTES + LDS_B_BYTES;
constexpr int LDS_BYTES = 147456;

struct Params {
  const float *x_prompt, *x_sample, *c_prompt, *c_sample, *state_wkv, *state_shift, *cache_k, *cache_v;
  const float *norm1_g, *norm2_g, *ada_w, *ada_b, *mlp_up, *mlp_down, *final_g;
  const float *rw_mix, *rw_wr, *rw_wk, *rw_wv, *rw_wo, *rw_w0, *rw_w1, *rw_w2, *rw_a0, *rw_a1, *rw_a2, *rw_g1, *rw_g2,
      *rw_kk, *rw_ka, *rw_rk, *rw_lnx_g, *rw_lnx_b;
  const float *at_wqkv, *at_bqkv, *at_wo, *at_sink;
  float* out;
  char* ws;
};

__device__ __forceinline__ u16 f2bf(float f) {
  unsigned u = __float_as_uint(f);
  u += 0x7fffu + ((u >> 16) & 1u);
  return (u16)(u >> 16);
}
__device__ __forceinline__ float bf2f(u16 h) { return __uint_as_float(((unsigned)h) << 16); }
__device__ __forceinline__ float bflo(unsigned w) { return __uint_as_float(w << 16); }
__device__ __forceinline__ float bfhi(unsigned w) { return __uint_as_float(w & 0xffff0000u); }
__device__ __forceinline__ unsigned pack2(float a, float b) {
  unsigned r;
  asm volatile("v_cvt_pk_bf16_f32 %0, %1, %2" : "=v"(r) : "v"(a), "v"(b));
  return r;
}
__device__ __forceinline__ uint2 pack4(f32x4 v) { return uint2{pack2(v[0], v[1]), pack2(v[2], v[3])}; }
__device__ __forceinline__ float h2f(u16 h) { return (float)__builtin_bit_cast(_Float16, h); }
__device__ __forceinline__ u16 f2h(float f) { return __builtin_bit_cast(u16, (_Float16)f); }
__device__ __forceinline__ float sigmoidf_(float x) { return 1.f / (1.f + __expf(-x)); }

template <int CTRL>
__device__ __forceinline__ float dppf(float x) {
  return __int_as_float(__builtin_amdgcn_update_dpp(0, __float_as_int(x), CTRL, 0xf, 0xf, true));
}
__device__ __forceinline__ float rowsum16(float x) {
  x += dppf<0xB1>(x);
  x += dppf<0x4E>(x);
  x += dppf<0x124>(x);
  x += dppf<0x128>(x);
  return x;
}
__device__ __forceinline__ float rowmax16(float x) {
  x = fmaxf(x, dppf<0xB1>(x));
  x = fmaxf(x, dppf<0x4E>(x));
  x = fmaxf(x, dppf<0x124>(x));
  x = fmaxf(x, dppf<0x128>(x));
  return x;
}
__device__ __forceinline__ float wavesum(float x) {
#pragma unroll
  for (int o = 32; o > 0; o >>= 1) x += __shfl_xor(x, o);
  return x;
}
__device__ __forceinline__ float wavemax(float x) {
#pragma unroll
  for (int o = 32; o > 0; o >>= 1) x = fmaxf(x, __shfl_xor(x, o));
  return x;
}
__device__ __forceinline__ int bidx_of(int row) { return row < NP ? (row >> 12) : (4 + row - NP); }

#define XB_TMO      128
#define XB_XCNT(j)  (256  + 64 * (j))
#define XB_XSUB(j)  (1280 + 64 * (j))
#define XB_XGEN(j)  (2304 + 64 * (j))
#define XB_TOP      3328
#define XB_TOPGEN   3392
#define XCD_BAR_WORDS 3456
#define XB_SPIN_CAP (1u << 22)
#define LAS __attribute__((address_space(3)))
__device__ __forceinline__ unsigned xb_ld(unsigned* p) { return __hip_atomic_load(p, __ATOMIC_RELAXED, __HIP_MEMORY_SCOPE_AGENT); }
__device__ __forceinline__ unsigned xb_add(unsigned* p, unsigned v) { return __hip_atomic_fetch_add(p, v, __ATOMIC_RELAXED, __HIP_MEMORY_SCOPE_AGENT); }
__device__ __forceinline__ unsigned xb_xcc_id() { return (unsigned)__builtin_amdgcn_s_getreg((3 << 11) | 20) & 0xFu; }
#define XB_SPIN(cond, bar) do { unsigned _sp = 0; while (cond) { __builtin_amdgcn_s_sleep(1); \
    if ((++_sp & 255u) == 0u) { if (xb_ld(&(bar)[XB_TMO])) break; if (_sp > XB_SPIN_CAP) { atomicAdd(&(bar)[XB_TMO], 1u); break; } } } } while (0)
struct XcdBarrier {
  unsigned* bar;
  unsigned x;
  volatile LAS unsigned* st;
};
__device__ __forceinline__ XcdBarrier xcd_barrier_post(unsigned* bar, volatile LAS unsigned* st) {
  XcdBarrier b;
  b.bar = bar;
  b.x = xb_xcc_id();
  b.st = st;
  if (threadIdx.x == 0) (void)xb_add(&bar[XB_XCNT(b.x)], 1u);
  return b;
}
__device__ __forceinline__ void xcd_barrier_complete(unsigned* bar, unsigned x, unsigned& nloc, unsigned& nx) {
  const unsigned G = gridDim.x * gridDim.y * gridDim.z;
  unsigned sum, cnt, mine, sp = 0u;
  for (;;) {
    sum = 0u; cnt = 0u; mine = 0u;
#pragma unroll
    for (unsigned j = 0; j < 16; ++j) {
      const unsigned c = xb_ld(&bar[XB_XCNT(j)]);
      sum += c;
      cnt += (c > 0u) ? 1u : 0u;
      mine = (j == x) ? c : mine;
    }
    if (sum == G) break;
    __builtin_amdgcn_s_sleep(1);
    if ((++sp & 255u) == 0u) {
      if (xb_ld(&bar[XB_TMO])) break;
      if (sp > XB_SPIN_CAP) { atomicAdd(&bar[XB_TMO], 1u); break; }
    }
  }
  nloc = mine > 0u ? mine : 1u;
  nx = cnt > 0u ? cnt : 1u;
}
__device__ __forceinline__ void xcd_barrier(const XcdBarrier& b) {
  asm volatile("s_waitcnt vmcnt(0)" ::: "memory");
  __syncthreads();
  if (threadIdx.x == 0) {
    unsigned* bar = b.bar;
    __builtin_amdgcn_s_waitcnt(0);
    unsigned nloc = b.st[0], nx = b.st[1];
    if (nloc == 0u) { xcd_barrier_complete(bar, b.x, nloc, nx); b.st[0] = nloc; b.st[1] = nx; }
    const unsigned old = xb_add(&bar[XB_XSUB(b.x)], 1u);
    const unsigned gen = old / nloc;
    if (old + 1u == (gen + 1u) * nloc) {
      __builtin_amdgcn_fence(__ATOMIC_RELEASE, "agent");
      asm volatile("s_waitcnt vmcnt(0)" ::: "memory");
      const unsigned og = xb_add(&bar[XB_TOP], 1u);
      const unsigned tg = og / nx;
      if (og + 1u == (tg + 1u) * nx) xb_add(&bar[XB_TOPGEN], 1u);
      else XB_SPIN(xb_ld(&bar[XB_TOPGEN]) == tg, bar);
      __builtin_amdgcn_fence(__ATOMIC_ACQUIRE, "agent");
      xb_add(&bar[XB_XGEN(b.x)], 1u);
      asm volatile("s_waitcnt vmcnt(0)" ::: "memory");
    } else {
      XB_SPIN(xb_ld(&bar[XB_XGEN(b.x)]) == gen, bar);
      __builtin_amdgcn_fence(__ATOMIC_ACQUIRE, "agent");
      asm volatile("s_waitcnt vmcnt(0)" ::: "memory");
    }
  }
  __syncthreads();
}

#define BAR_SYNC() do { asm volatile("s_waitcnt lgkmcnt(0)" ::: "memory"); __builtin_amdgcn_s_barrier(); asm volatile("" ::: "memory"); } while (0)

__device__ __forceinline__ unsigned mix2(unsigned h, unsigned p, float m0, float m1) {
  float h0 = bflo(h), h1 = bfhi(h), p0 = bflo(p), p1 = bfhi(p);
  return pack2(h0 + (p0 - h0) * m0, h1 + (p1 - h1) * m1);
}

template <bool MIX, class Epi>
__device__ __forceinline__ void gemm_tile(const u16* __restrict__ A, int lda, const float* __restrict__ mixv,
                                          const u16* __restrict__ Bt, int ldb, int N, int K, int m0, int n0, char* lds, Epi&& epi) {
  int tid_l = threadIdx.x;
  asm volatile("" : "+v"(tid_l));
  const int tid = tid_l, lane = tid & 63, w = tid >> 6;
  const int nk = K >> 6;
  if (w >= 4) {
    const int pt = tid - 256, kc = pt & 7, pr = pt >> 3;
    const u16* Ab = A + (size_t)m0 * lda + (size_t)pr * lda + kc * 8;
    int poff[8];
#pragma unroll
    for (int i = 0; i < 8; ++i) {
      poff[i] = 0;
      if (MIX) {
        const int row = m0 + pr + 32 * i;
        const int prow = row < NP ? ((row & 4095) ? row - 1 : MPAD) : (row < MROWS ? row + 128 : MPAD);
        poff[i] = prow * LDH + kc * 8;
      }
    }
    bool bv[4];
    const u16* bp[4];
#pragma unroll
    for (int j = 0; j < 4; ++j) {
      const int n = n0 + pr + 32 * j;
      bv[j] = n < N;
      bp[j] = Bt + (size_t)(bv[j] ? n : 0) * ldb + kc * 8;
    }
    struct RSet {
      uint4 ra[8], rp[8], rb[4];
      float4 mx0, mx1;
    };
    RSet SA, SB;
    auto gload = [&](RSet& S, int kt) {
      const int ko = kt * 64;
#pragma unroll
      for (int i = 0; i < 8; ++i) {
        S.ra[i] = *(const uint4*)(Ab + (size_t)(32 * i) * lda + ko);
        if (MIX) S.rp[i] = *(const uint4*)(A + poff[i] + ko);
      }
      if (MIX) {
        S.mx0 = *(const float4*)(mixv + ko + kc * 8);
        S.mx1 = *(const float4*)(mixv + ko + kc * 8 + 4);
      }
#pragma unroll
      for (int j = 0; j < 4; ++j) {
        uint4 z = {0u, 0u, 0u, 0u};
        if (bv[j]) z = *(const uint4*)(bp[j] + ko);
        S.rb[j] = z;
      }
    };
    auto lstore = [&](RSet& S, int s) {
      char* base = lds + s * LDS_STAGE + pr * LDS_ROW + kc * 16;
#pragma unroll
      for (int i = 0; i < 8; ++i) {
        uint4 v = S.ra[i];
        if (MIX) {
          v.x = mix2(S.ra[i].x, S.rp[i].x, S.mx0.x, S.mx0.y);
          v.y = mix2(S.ra[i].y, S.rp[i].y, S.mx0.z, S.mx0.w);
          v.z = mix2(S.ra[i].z, S.rp[i].z, S.mx1.x, S.mx1.y);
          v.w = mix2(S.ra[i].w, S.rp[i].w, S.mx1.z, S.mx1.w);
        }
        *(uint4*)(base + (32 * i) * LDS_ROW) = v;
      }
#pragma unroll
      for (int j = 0; j < 4; ++j) *(uint4*)(base + LDS_A_BYTES + (32 * j) * LDS_ROW) = S.rb[j];
    };
    if constexpr (!MIX) {
      gload(SB, 0);
      if (nk > 1) gload(SA, 1);
      lstore(SB, 0);
      if (nk > 2) gload(SB, 2);
      BAR_SYNC();
#pragma unroll 1
      for (int kt = 0; kt < nk; kt += 2) {
        if (kt + 1 < nk) {
          lstore(SA, 1);
          if (kt + 3 < nk) gload(SA, kt + 3);
        }
        BAR_SYNC();
        if (kt + 1 < nk) {
          if (kt + 2 < nk) {
            lstore(SB, 0);
            if (kt + 4 < nk) gload(SB, kt + 4);
          }
          BAR_SYNC();
        }
      }
    } else {
      gload(SA, 0);
      lstore(SA, 0);
      if (nk > 1) gload(SA, 1);
      BAR_SYNC();
#pragma unroll 1
      for (int kt = 0; kt < nk; ++kt) {
        if (kt + 1 < nk) {
          lstore(SA, (kt + 1) & 1);
          if (kt + 2 < nk) gload(SA, kt + 2);
        }
        BAR_SYNC();
      }
    }
  } else {
    const int wm = w >> 1, wn = w & 1, lr = lane & 15, lg = lane >> 4;
    f32x4 acc[8][4];
#pragma unroll
    for (int i = 0; i < 8; ++i)
#pragma unroll
      for (int j = 0; j < 4; ++j) acc[i][j] = f32x4{0.f, 0.f, 0.f, 0.f};
    BAR_SYNC();
#pragma unroll 1
    for (int kt = 0; kt < nk; ++kt) {
      const char* sa = lds + (kt & 1) * LDS_STAGE + (wm * 128 + lr) * LDS_ROW + lg * 16;
      const char* sb = lds + (kt & 1) * LDS_STAGE + LDS_A_BYTES + (wn * 64 + lr) * LDS_ROW + lg * 16;
      bf16x8 bq[2][4], aq[3];
#pragma unroll
      for (int ni = 0; ni < 4; ++ni) bq[0][ni] = *(const bf16x8*)(sb + ni * 16 * LDS_ROW);
      aq[0] = *(const bf16x8*)(sa);
      aq[1] = *(const bf16x8*)(sa + 16 * LDS_ROW);
#pragma unroll
      for (int ni = 0; ni < 4; ++ni) bq[1][ni] = *(const bf16x8*)(sb + ni * 16 * LDS_ROW + 64);
#pragma unroll
      for (int st = 0; st < 16; ++st) {
        if (st + 2 < 16) aq[(st + 2) % 3] = *(const bf16x8*)(sa + ((st + 2) & 7) * 16 * LDS_ROW + ((st + 2) >> 3) * 64);
#pragma unroll
        for (int ni = 0; ni < 4; ++ni)
          acc[st & 7][ni] = __builtin_amdgcn_mfma_f32_16x16x32_bf16(bq[st >> 3][ni], aq[st % 3], acc[st & 7][ni], 0, 0, 0);
        __builtin_amdgcn_sched_barrier(0);
      }
      BAR_SYNC();
    }
    epi(acc, wm, wn, lr, lg);
  }
}

constexpr int LDS_STAGE2 = 2 * LDS_A_BYTES;
template <class Epi>
__device__ __forceinline__ void gemm_tile256(const u16* __restrict__ A, int lda, const u16* __restrict__ Bt, int ldb, int K, int m0,
                                             int n0, char* lds, bool half, Epi&& epi) {
  int tid = threadIdx.x;
  asm volatile("" : "+v"(tid));
  const int lane = tid & 63, w = __builtin_amdgcn_readfirstlane(tid >> 6);
  const int wm = w >> 2, wn = w & 3, lr = lane & 15, lg = lane >> 4;
  const int nk = K >> 5;
  const int drow = lane >> 2, dch = (lane & 3) ^ ((lane >> 4) & 3);
  const u16* As0 = A + (size_t)(m0 + w * 16 + drow) * lda + dch * 8;
  const u16* As1 = A + (size_t)(m0 + (w + 8) * 16 + drow) * lda + dch * 8;
  const u16* Bs0 = Bt + (size_t)(n0 + w * 16 + drow) * ldb + dch * 8;
  const u16* Bs1 = Bt + (size_t)(n0 + (w + 8) * 16 + drow) * ldb + dch * 8;
  auto dma = [&](int kt, int stg) __attribute__((always_inline)) {
    char* sbase = lds + stg * 32768;
    const int ko = kt * 32;
    __builtin_amdgcn_global_load_lds((const unsigned*)(As0 + ko), (unsigned*)(sbase + w * 1024), 16, 0, 0);
    __builtin_amdgcn_global_load_lds((const unsigned*)(As1 + ko), (unsigned*)(sbase + (w + 8) * 1024), 16, 0, 0);
    __builtin_amdgcn_global_load_lds((const unsigned*)(Bs0 + ko), (unsigned*)(sbase + 16384 + w * 1024), 16, 0, 0);
    __builtin_amdgcn_global_load_lds((const unsigned*)(Bs1 + ko), (unsigned*)(sbase + 16384 + (w + 8) * 1024), 16, 0, 0);
  };
  f32x4 acc[8][4];
#pragma unroll
  for (int i = 0; i < 8; ++i)
#pragma unroll
    for (int j = 0; j < 4; ++j) acc[i][j] = f32x4{0.f, 0.f, 0.f, 0.f};
  const int swz = (lg ^ ((lr >> 2) & 3)) * 16;
  const int aoff = (wm * 128 + lr) * 64 + swz, boff = 16384 + (wn * 64 + lr) * 64 + swz;
  const bool skipm = half && wm == 1;
  dma(0, 0);
  dma(nk > 1 ? 1 : nk - 1, 1);
  dma(nk > 2 ? 2 : nk - 1, 2);
  asm volatile("s_waitcnt vmcnt(8)" ::: "memory");
  BAR_SYNC();
#pragma unroll 1
  for (int kt = 0; kt < nk; ++kt) {
    const char* sa = lds + (kt & 3) * 32768 + aoff;
    const char* sb = lds + (kt & 3) * 32768 + boff;
    bf16x8 bq[4], aq[4];
#pragma unroll
    for (int ni = 0; ni < 4; ++ni) bq[ni] = *(const bf16x8*)(sb + ni * 1024);
    aq[0] = *(const bf16x8*)(sa);
    aq[1] = *(const bf16x8*)(sa + 1024);
    aq[2] = *(const bf16x8*)(sa + 2048);
    dma(kt + 3 < nk ? kt + 3 : nk - 1, (kt + 3) & 3);
    if (!skipm) {
#pragma unroll
      for (int st = 0; st < 8; ++st) {
        if (st + 3 < 8) aq[(st + 3) & 3] = *(const bf16x8*)(sa + (st + 3) * 1024);
#pragma unroll
        for (int ni = 0; ni < 4; ++ni)
          acc[st][ni] = __builtin_amdgcn_mfma_f32_16x16x32_bf16(bq[ni], aq[st & 3], acc[st][ni], 0, 0, 0);
        __builtin_amdgcn_sched_barrier(0);
      }
    }
    asm volatile("s_waitcnt vmcnt(8)" ::: "memory");
    BAR_SYNC();
  }
  asm volatile("s_waitcnt vmcnt(0)" ::: "memory");
  BAR_SYNC();
  epi(acc, wm, wn, lr, lg);
}

#define EPI_FOREACH(acc, ...)                                    \
  _Pragma("unroll") for (int mi = 0; mi < 8; ++mi) {             \
    const int row = m0 + wm * 128 + mi * 16 + lr;                \
    _Pragma("unroll") for (int ni = 0; ni < 4; ++ni) {           \
      const int col0 = n0 + wn * 64 + ni * 16 + lg * 4;          \
      const f32x4 v = acc[mi][ni];                               \
      __VA_ARGS__                                                \
    }                                                            \
    __builtin_amdgcn_sched_barrier(0);                           \
  }
#define EPI_ARGS f32x4(&acc)[8][4], int wm, int wn, int lr, int lg

__device__ __forceinline__ void conv_job(const float* __restrict__ src, u16* __restrict__ dst, int K, int N, int ldk, float* tl, int rot) {
  int tid = threadIdx.x;
  asm volatile("" : "+v"(tid));
  const int tn = N >> 6, nt = (K >> 6) * tn;
  const int G = gridDim.x;
  int t = ((int)blockIdx.x + G - (rot % G)) % G;
  float v[8];
  auto ldtile = [&](int tt) {
    const int k0 = (tt / tn) << 6, n0 = (tt % tn) << 6;
#pragma unroll
    for (int i = 0; i < 8; ++i) {
      const int e = tid + 512 * i;
      v[i] = src[(size_t)(k0 + (e >> 6)) * N + n0 + (e & 63)];
    }
  };
  if (t < nt) ldtile(t);
  while (t < nt) {
    const int k0 = (t / tn) << 6, n0 = (t % tn) << 6;
#pragma unroll
    for (int i = 0; i < 8; ++i) {
      const int e = tid + 512 * i;
      tl[(e >> 6) * 65 + (e & 63)] = v[i];
    }
    const int tnx = t + G;
    if (tnx < nt) ldtile(tnx);
    __syncthreads();
    const int n = tid >> 3, kc = tid & 7;
    float f[8];
#pragma unroll
    for (int j = 0; j < 8; ++j) f[j] = tl[(kc * 8 + j) * 65 + n];
    uint4 o;
    o.x = pack2(f[0], f[1]);
    o.y = pack2(f[2], f[3]);
    o.z = pack2(f[4], f[5]);
    o.w = pack2(f[6], f[7]);
    *(uint4*)(dst + (size_t)(n0 + n) * ldk + k0 + kc * 8) = o;
    __syncthreads();
    t = tnx;
  }
}

__device__ __forceinline__ void phase0(const Params& p, char* lds) {
  float* tl = (float*)lds;
  u16* wt = (u16*)(p.ws + WS_WT);
  u16* adawt = (u16*)(p.ws + S_ADAWT);
  int rot = 0;
#define CJ(SRC, DST, K, N)            \
  conv_job(SRC, DST, K, N, ((K) == 1024 ? LDH : (K) == 4096 ? LDU : (K)), tl, rot);  \
  rot += ((K) >> 6) * ((N) >> 6);
  CJ(p.ada_w, adawt, 1024, 6144)
  CJ(p.ada_w + (size_t)1024 * 6144, adawt + (size_t)6144 * LDH, 1024, 6144)
  CJ(p.rw_wr, wt + WT_WR, 1024, 1024)
  CJ(p.rw_wk, wt + WT_WK, 1024, 1024)
  CJ(p.rw_wv, wt + WT_WV, 1024, 1024)
  CJ(p.rw_wo, wt + WT_WO, 1024, 1024)
  CJ(p.rw_w1, wt + WT_W1, 1024, 64)
  CJ(p.rw_a1, wt + WT_A1, 1024, 64)
  CJ(p.rw_g1, wt + WT_G1, 1024, 128)
  CJ(p.rw_w2, wt + WT_W2, 64, 1024)
  CJ(p.rw_a2, wt + WT_A2, 64, 1024)
  CJ(p.rw_g2, wt + WT_G2, 128, 1024)
  CJ(p.mlp_up, wt + WT_UP0, 1024, 4096)
  CJ(p.mlp_down, wt + WT_DN0, 4096, 1024)
  CJ(p.at_wqkv, wt + WT_QKV, 1024, 1536)
  CJ(p.at_wo, wt + WT_WO1, 1024, 1024)
  CJ(p.mlp_up + (size_t)4 * MEG, wt + WT_UP1, 1024, 4096)
  CJ(p.mlp_down + (size_t)4 * MEG, wt + WT_DN1, 4096, 1024)
#undef CJ
  const int gtid = blockIdx.x * NTHR + threadIdx.x, gsz = gridDim.x * NTHR;
  u16* siluc = (u16*)(p.ws + S_SILUC);
  for (int i = gtid; i < 256 * 1024; i += gsz) {
    int row = i >> 10, col = i & 1023;
    float c = 0.f;
    if (row < 4) c = p.c_prompt[row * 1024 + col];
    else if (row < 132) c = p.c_sample[(row - 4) * 1024 + col];
    siluc[i] = f2bf(c * sigmoidf_(c));
  }
  u16* hs = (u16*)(p.ws + WS_HS);
  for (int i = gtid; i < 128 * 1024; i += gsz) hs[(size_t)(i >> 10) * LDH + (i & 1023)] = f2bf(p.state_shift[i]);
  u16* zr = (u16*)(p.ws + WS_ZR);
  for (int i = gtid; i < LDH; i += gsz) zr[i] = 0;
  float2* tab = (float2*)(p.ws + WS_TAB);
  for (int i = gtid; i < 4097 * 8; i += gsz) {
    int pi = i >> 3, f = i & 7;
    float pos = pi < 4096 ? (float)pi : 8192.f;
    float inv = f == 0 ? 1.0f : f == 1 ? 0.1939227432012558f : f == 2 ? 0.03760603070259094f : f == 3 ? 0.007292664609849453f
              : f == 4 ? 0.0014142135623842478f : f == 5 ? 0.00027424818836152554f : f == 6 ? 5.318296098266728e-05f
              : 1.0313386155758053e-05f;
    float ang = pos * inv;
    double t = (double)ang * 0.15915494309189535;
    t -= rint(t);
    float fr = (float)t;
    tab[i] = make_float2(__builtin_amdgcn_cosf(fr), __builtin_amdgcn_sinf(fr));
  }
}

__device__ __forceinline__ void phase_ada(const Params& p, char* lds) {
  const u16* siluc = (const u16*)(p.ws + S_SILUC);
  const u16* adawt = (const u16*)(p.ws + S_ADAWT);
  float* mod = (float*)(p.ws + WS_MOD);
  for (int t = blockIdx.x; t < 96; t += gridDim.x) {
    const int layer = t / 48, nt = t % 48;
    const int m0 = 0, n0 = nt * 128;
    const float* bias = p.ada_b + layer * 6144;
    float* mo = mod + (size_t)layer * 132 * 6144;
    gemm_tile<false>(siluc, 1024, nullptr, adawt + (size_t)layer * 6144 * LDH, LDH, 6144, 1024, m0, n0, lds, [&](EPI_ARGS) {
      EPI_FOREACH(acc, if (row < 132) {
        const float4 b4 = *(const float4*)(bias + col0);
        *(float4*)(mo + (size_t)row * 6144 + col0) = make_float4(v[0] + b4.x, v[1] + b4.y, v[2] + b4.z, v[3] + b4.w);
      })
    });
  }
}

__device__ __forceinline__ void phase_norm(const Params& p, int layer, int which, bool from_input, bool shift_out) {
  int tid_l = threadIdx.x;
  asm volatile("" : "+v"(tid_l));
  const int lane = tid_l & 63, w = tid_l >> 6;
  const float* mod = (const float*)(p.ws + WS_MOD);
  u16* H = (u16*)(p.ws + WS_H);
  const float* g = (which ? p.norm2_g : p.norm1_g) + layer * 1024;
  const int nw = gridDim.x * 8;
  auto xrow = [&](int row) {
    return from_input ? (row < NP ? p.x_prompt + (size_t)row * 1024 : p.x_sample + (size_t)(row - NP) * 1024)
                      : (const float*)p.out + (size_t)row * 1024;
  };
  float4 gg[4];
#pragma unroll
  for (int i = 0; i < 4; ++i) gg[i] = *(const float4*)(g + lane * 4 + 256 * i);
  int row = blockIdx.x * 8 + w;
  float4 xn[4];
  if (row < MROWS) {
    const float* xr = xrow(row);
#pragma unroll
    for (int i = 0; i < 4; ++i) xn[i] = *(const float4*)(xr + lane * 4 + 256 * i);
  }
  while (row < MROWS) {
    float4 x[4];
#pragma unroll
    for (int i = 0; i < 4; ++i) x[i] = xn[i];
    const int nrow = row + nw;
    if (nrow < MROWS) {
      const float* xr = xrow(nrow);
#pragma unroll
      for (int i = 0; i < 4; ++i) xn[i] = *(const float4*)(xr + lane * 4 + 256 * i);
    }
    const int bi = bidx_of(row);
    const float* mb = mod + ((size_t)layer * 132 + bi) * 6144;
    const float* sh = mb + (which ? 3 : 0) * 1024;
    const float* sc = mb + (which ? 4 : 1) * 1024;
    float4 s4[4], c4[4];
#pragma unroll
    for (int i = 0; i < 4; ++i) {
      s4[i] = *(const float4*)(sh + lane * 4 + 256 * i);
      c4[i] = *(const float4*)(sc + lane * 4 + 256 * i);
    }
    float ss = 0.f;
#pragma unroll
    for (int i = 0; i < 4; ++i) ss += x[i].x * x[i].x + x[i].y * x[i].y + x[i].z * x[i].z + x[i].w * x[i].w;
    ss = wavesum(ss);
    const float rs = rsqrtf(ss * (1.f / 1024.f) + 1e-6f);
    const bool so = shift_out && (row >= NP || (row & 4095) == 4095);
    float* sop = row >= NP ? p.out + O_SHS + (size_t)(row - NP) * 1024 : p.out + O_SHP + (size_t)(row >> 12) * 1024;
#pragma unroll
    for (int i = 0; i < 4; ++i) {
      const int c = lane * 4 + 256 * i;
      float4 h;
      h.x = x[i].x * rs * gg[i].x * (1.f + c4[i].x) + s4[i].x;
      h.y = x[i].y * rs * gg[i].y * (1.f + c4[i].y) + s4[i].y;
      h.z = x[i].z * rs * gg[i].z * (1.f + c4[i].z) + s4[i].z;
      h.w = x[i].w * rs * gg[i].w * (1.f + c4[i].w) + s4[i].w;
      uint2 pk;
      pk.x = pack2(h.x, h.y);
      pk.y = pack2(h.z, h.w);
      *(uint2*)(H + (size_t)row * LDH + c) = pk;
      if (so) *(float4*)(sop + c) = h;
    }
    row = nrow;
  }
}

__device__ __forceinline__ void phase_norm_mix(const Params& p) {
  int tid_l = threadIdx.x;
  asm volatile("" : "+v"(tid_l));
  const int lane = tid_l & 63, w = tid_l >> 6;
  const float* mod = (const float*)(p.ws + WS_MOD);
  u16* H = (u16*)(p.ws + WS_H);
  u16* XR = (u16*)p.out;
  u16* XK = XR + (size_t)MROWS * 1024;
  u16* XV = (u16*)(p.ws + S_EW);
  const float* g = p.norm1_g;
  const int nw = gridDim.x * 8;
  f32x4 gg[4], mr[4], mk[4], mv[4];
#pragma unroll
  for (int i = 0; i < 4; ++i) {
    const int c = lane * 4 + 256 * i;
    gg[i] = *(const f32x4*)(g + c);
    mr[i] = *(const f32x4*)(p.rw_mix + c);
    mk[i] = *(const f32x4*)(p.rw_mix + 2 * 1024 + c);
    mv[i] = *(const f32x4*)(p.rw_mix + 3 * 1024 + c);
  }
  auto xrow = [&](int row) { return row < NP ? p.x_prompt + (size_t)row * 1024 : p.x_sample + (size_t)(row - NP) * 1024; };
  auto hrow = [&](const f32x4 (&x)[4], int row, f32x4 (&h)[4]) __attribute__((always_inline)) {
    float ss = 0.f;
#pragma unroll
    for (int i = 0; i < 4; ++i) ss += x[i][0] * x[i][0] + x[i][1] * x[i][1] + x[i][2] * x[i][2] + x[i][3] * x[i][3];
    ss = wavesum(ss);
    const float rs = rsqrtf(ss * (1.f / 1024.f) + 1e-6f);
    const float* mb = mod + (size_t)bidx_of(row) * 6144;
#pragma unroll
    for (int i = 0; i < 4; ++i) {
      const int c = lane * 4 + 256 * i;
      const f32x4 s4 = *(const f32x4*)(mb + c), c4 = *(const f32x4*)(mb + 1024 + c);
      h[i] = x[i] * rs * gg[i] * (1.f + c4) + s4;
    }
  };
  for (int chunk = blockIdx.x * 8 + w; chunk < MROWS / 8; chunk += nw) {
    const int r0 = chunk * 8;
    f32x4 hp[4], x[4], xn[4];
    if (r0 < NP && (r0 & 4095) != 0) {
      const float* xr = xrow(r0 - 1);
#pragma unroll
      for (int i = 0; i < 4; ++i) x[i] = *(const f32x4*)(xr + lane * 4 + 256 * i);
      hrow(x, r0 - 1, hp);
    } else {
#pragma unroll
      for (int i = 0; i < 4; ++i) hp[i] = f32x4{0.f, 0.f, 0.f, 0.f};
    }
    {
      const float* xr = xrow(r0);
#pragma unroll
      for (int i = 0; i < 4; ++i) xn[i] = *(const f32x4*)(xr + lane * 4 + 256 * i);
    }
#pragma unroll 1
    for (int rr = 0; rr < 8; ++rr) {
      const int row = r0 + rr;
#pragma unroll
      for (int i = 0; i < 4; ++i) x[i] = xn[i];
      if (rr + 1 < 8) {
        const float* xr = xrow(row + 1);
#pragma unroll
        for (int i = 0; i < 4; ++i) xn[i] = *(const f32x4*)(xr + lane * 4 + 256 * i);
      }
      if (row >= NP) {
#pragma unroll
        for (int i = 0; i < 4; ++i) hp[i] = *(const f32x4*)(p.state_shift + (size_t)(row - NP) * 1024 + lane * 4 + 256 * i);
      }
      f32x4 h[4];
      hrow(x, row, h);
      const bool so = row >= NP || (row & 4095) == 4095;
      float* sop = row >= NP ? p.out + O_SHS + (size_t)(row - NP) * 1024 : p.out + O_SHP + (size_t)(row >> 12) * 1024;
#pragma unroll
      for (int i = 0; i < 4; ++i) {
        const int c = lane * 4 + 256 * i;
        *(uint2*)(H + (size_t)row * LDH + c) = pack4(h[i]);
        if (so) *(f32x4*)(sop + c) = h[i];
        const f32x4 dd = hp[i] - h[i];
        *(uint2*)(XR + (size_t)row * 1024 + c) = pack4(h[i] + dd * mr[i]);
        *(uint2*)(XK + (size_t)row * 1024 + c) = pack4(h[i] + dd * mk[i]);
        *(uint2*)(XV + (size_t)row * 1024 + c) = pack4(h[i] + dd * mv[i]);
        hp[i] = h[i];
      }
    }
  }
}

__device__ __forceinline__ void phase_final(const Params& p) {
  int tid_l = threadIdx.x;
  asm volatile("" : "+v"(tid_l));
  const int lane = tid_l & 63, w = tid_l >> 6;
  const int nw = gridDim.x * 8;
  for (int row = blockIdx.x * 8 + w; row < MROWS; row += nw) {
    float* xr = p.out + (size_t)row * 1024;
    float4 x[4];
    float ss = 0.f;
#pragma unroll
    for (int i = 0; i < 4; ++i) {
      x[i] = *(const float4*)(xr + lane * 4 + 256 * i);
      ss += x[i].x * x[i].x + x[i].y * x[i].y + x[i].z * x[i].z + x[i].w * x[i].w;
    }
    ss = wavesum(ss);
    const float rs = rsqrtf(ss * (1.f / 1024.f) + 1e-6f);
#pragma unroll
    for (int i = 0; i < 4; ++i) {
      const int c = lane * 4 + 256 * i;
      float4 gg = *(const float4*)(p.final_g + c);
      float4 h;
      h.x = x[i].x * rs * gg.x;
      h.y = x[i].y * rs * gg.y;
      h.z = x[i].z * rs * gg.z;
      h.w = x[i].w * rs * gg.w;
      *(float4*)(xr + c) = h;
    }
  }
}

__device__ __forceinline__ void phase_rwkv_proj(const Params& p, char* lds) {
  const u16* H = (const u16*)(p.ws + WS_H);
  const u16* wt = (const u16*)(p.ws + WS_WT);
  const u16* XR = (const u16*)p.out;
  const u16* XK = XR + (size_t)MROWS * 1024;
  const u16* XV = (const u16*)(p.ws + S_EW);
  u16* R = (u16*)(p.ws + S_R);
  u16* Kk = (u16*)(p.ws + S_K);
  u16* V = (u16*)(p.ws + S_V);
  u16* WH = (u16*)(p.ws + S_WH);
  u16* AH = (u16*)(p.ws + S_AH);
  u16* GH = (u16*)(p.ws + S_GH);
  for (int u = blockIdx.x; u < 780 + 195; u += gridDim.x) {
    if (u < 780) {
      const int kind = u / 260, t = u - kind * 260;
      const int mt = t >> 2, nt = t & 3;
      const int m0 = mt * 256, n0 = nt * 256;
      const u16* A = kind == 2 ? XV : XR + (size_t)kind * ((size_t)MROWS * 1024);
      const u16* Bt = wt + WT_WR + (size_t)kind * (1024 * LDH);
      u16* dst = R + (size_t)kind * (RSZ / 2);
      gemm_tile256(A, 1024, Bt, LDH, 1024, m0, n0, lds, mt == 64, [&](EPI_ARGS) {
        EPI_FOREACH(acc, if (row < MROWS) *(uint2*)(dst + (size_t)row * 1024 + col0) = pack4(v);)
      });
    } else {
      const int s_ = u - 780;
      const int mt = s_ / 3, kind = 3 + (s_ - mt * 3);
      const int m0 = mt * 256, n0 = 0;
      const int N = kind == 5 ? 128 : 64, mixi = kind == 3 ? 1 : kind;
      const u16* Bt = wt + WT_W1 + (size_t)(kind - 3) * (64 * LDH);
      gemm_tile<true>(H, LDH, p.rw_mix + mixi * 1024, Bt, LDH, N, 1024, m0, n0, lds, [&](EPI_ARGS) {
        u16* dst = WH + (size_t)(kind - 3) * ((size_t)MPAD * 64);
        const int ld = kind == 5 ? 128 : 64;
        EPI_FOREACH(acc, if (row < MROWS && col0 < ld) {
          f32x4 o = v;
          if (kind == 3) {
            _Pragma("unroll") for (int q = 0; q < 4; ++q) o[q] = 1.f - 2.f / (__expf(2.f * v[q]) + 1.f);
          } else if (kind == 5) {
            _Pragma("unroll") for (int q = 0; q < 4; ++q) o[q] = sigmoidf_(v[q]);
          }
          *(uint2*)(dst + (size_t)row * ld + col0) = pack4(o);
        })
      });
    }
  }
}

__device__ __forceinline__ void phase_rwkv_lora2(const Params& p, char* lds) {
  {
    const int gtid = blockIdx.x * NTHR + threadIdx.x, gsz = gridDim.x * NTHR;
    for (int i = gtid; i < 128 * 256; i += gsz) ((float4*)(p.out + (size_t)NP * 1024))[i] = ((const float4*)p.x_sample)[i];
  }
  const u16* wt = (const u16*)(p.ws + WS_WT);
  const u16* WH = (const u16*)(p.ws + S_WH);
  const u16* AH = (const u16*)(p.ws + S_AH);
  u16* EW = (u16*)(p.ws + S_EW);
  u16* Aa = (u16*)(p.ws + S_A);
  for (int t = blockIdx.x; t < 65 * 8; t += gridDim.x) {
    const int mt = t >> 3, j = t & 7;
    const int m0 = mt * 256, n0 = (j & 3) * 256;
    const bool isw = j < 4;
    gemm_tile256(isw ? WH : AH, 64, wt + (isw ? WT_W2 : WT_A2), 64, 64, m0, n0, lds, mt == 64, [&](EPI_ARGS) {
      const float* b0 = isw ? p.rw_w0 : p.rw_a0;
      EPI_FOREACH(acc, if (row < MROWS) {
        const float4 b4 = *(const float4*)(b0 + col0);
        const float s0 = sigmoidf_(v[0] + b4.x), s1 = sigmoidf_(v[1] + b4.y), s2 = sigmoidf_(v[2] + b4.z), s3 = sigmoidf_(v[3] + b4.w);
        if (isw) {
          const float c = 0.6065306597126334f;
          uint2 o;
          o.x = (unsigned)f2h(c * s0) | ((unsigned)f2h(c * s1) << 16);
          o.y = (unsigned)f2h(c * s2) | ((unsigned)f2h(c * s3) << 16);
          *(uint2*)(EW + (size_t)row * 1024 + col0) = o;
        } else {
          uint2 o;
          o.x = pack2(s0, s1);
          o.y = pack2(s2, s3);
          *(uint2*)(Aa + (size_t)row * 1024 + col0) = o;
        }
      })
    });
  }
}

__device__ __forceinline__ float fma_(float a, float b, float c) {
  float r;
  asm("v_fma_f32 %0, %1, %2, %3" : "=v"(r) : "v"(a), "v"(b), "v"(c));
  return r;
}
__device__ __forceinline__ float mul_(float a, float b) {
  float r;
  asm("v_mul_f32 %0, %1, %2" : "=v"(r) : "v"(a), "v"(b));
  return r;
}

constexpr int PAIR_TS = 624;
constexpr int PAIR_BUF = 8 * PAIR_TS;

__device__ __forceinline__ void phase_scan(const Params& p, char* lds) {
  int tid_l = threadIdx.x;
  asm volatile("" : "+v"(tid_l));
  const int tid = tid_l, lane = tid & 63, w = tid >> 6;
  const u16* R = (const u16*)(p.ws + S_R);
  const u16* Kk = (const u16*)(p.ws + S_K);
  const u16* V = (const u16*)(p.ws + S_V);
  const u16* EW = (const u16*)(p.ws + S_EW);
  const u16* Aa = (const u16*)(p.ws + S_A);
  u16* Y = (u16*)(p.ws + WS_H);
  float* RK = (float*)(p.ws + WS_RK);
  float* ring = (float*)lds;
  float* ybuf = (float*)(lds + 2 * PAIR_BUF * 4);
  for (int item = blockIdx.x; item < 256; item += gridDim.x) {
    const int chain = item >> 2, qr = item & 3, b = chain >> 4, h = chain & 15;
    const size_t rowbase = (size_t)b * 4096;
    __syncthreads();
    if (tid >= 256) {
      const int pt = tid - 256, grp = pt >> 7, pair = (pt & 127) >> 4, cq = pt & 15;
      const int ch = h * 64 + cq * 4;
      const float4 kk4 = *(const float4*)(p.rw_kk + ch), ka4 = *(const float4*)(p.rw_ka + ch), rk4 = *(const float4*)(p.rw_rk + ch);
      struct PS {
        uint2 rr[2], rk_[2], rv[2], ra_[2], re[2];
      };
      PS S0, S1;
      auto pload = [&](PS& S, int c) __attribute__((always_inline)) {
#pragma unroll
        for (int q = 0; q < 2; ++q) {
          const size_t off = (rowbase + (size_t)c * 16 + pair * 2 + q) * 1024 + ch;
          S.rr[q] = *(const uint2*)(R + off);
          S.rk_[q] = *(const uint2*)(Kk + off);
          S.rv[q] = *(const uint2*)(V + off);
          S.ra_[q] = *(const uint2*)(Aa + off);
          S.re[q] = *(const uint2*)(EW + off);
        }
      };
      auto pproc = [&](PS& S, int c) __attribute__((always_inline)) {
        const float kkw[4] = {kk4.x, kk4.y, kk4.z, kk4.w}, kaw[4] = {ka4.x, ka4.y, ka4.z, ka4.w}, rkw[4] = {rk4.x, rk4.y, rk4.z, rk4.w};
        float am[2][4], dc[2][4], bm[2][4], kp[2][4], rf[2][4], vf[2][4];
#pragma unroll
        for (int q = 0; q < 2; ++q) {
          const uint2 rr = S.rr[q], rk_ = S.rk_[q], rv = S.rv[q], ra_ = S.ra_[q], re = S.re[q];
          const float rfx[4] = {bflo(rr.x), bfhi(rr.x), bflo(rr.y), bfhi(rr.y)};
          const float kf[4] = {bflo(rk_.x), bfhi(rk_.x), bflo(rk_.y), bfhi(rk_.y)};
          const float vfx[4] = {bflo(rv.x), bfhi(rv.x), bflo(rv.y), bfhi(rv.y)};
          const float af[4] = {bflo(ra_.x), bfhi(ra_.x), bflo(ra_.y), bfhi(ra_.y)};
          const float ef[4] = {h2f((u16)(re.x & 0xffff)), h2f((u16)(re.x >> 16)), h2f((u16)(re.y & 0xffff)), h2f((u16)(re.y >> 16))};
          float kkr[4], ss = 0.f, rks = 0.f;
#pragma unroll
          for (int j = 0; j < 4; ++j) {
            kkr[j] = kf[j] * kkw[j];
            ss += kkr[j] * kkr[j];
            kp[q][j] = kf[j] * (1.f + (af[j] - 1.f) * kaw[j]);
            rks += rfx[j] * kp[q][j] * rkw[j];
            rf[q][j] = rfx[j];
            vf[q][j] = vfx[j];
          }
          ss = rowsum16(ss);
          rks = rowsum16(rks);
          const float inv = 1.f / fmaxf(sqrtf(ss), 1e-12f);
#pragma unroll
          for (int j = 0; j < 4; ++j) {
            am[q][j] = -kkr[j] * inv;
            dc[q][j] = __expf(-ef[j]);
            bm[q][j] = kkr[j] * inv * af[j];
          }
          if (cq == 0 && qr == 0) RK[(rowbase + (size_t)c * 16 + pair * 2 + q) * 16 + h] = rks;
        }
        float aw[4], w12[4], b1w[4], k1w[4], wr1[4], wr2[4];
        float cba = 0.f, cka = 0.f, br1 = 0.f, kr1 = 0.f, br12 = 0.f, kr12 = 0.f, br2 = 0.f, kr2 = 0.f;
#pragma unroll
        for (int j = 0; j < 4; ++j) {
          aw[j] = dc[0][j] * am[1][j];
          w12[j] = dc[0][j] * dc[1][j];
          b1w[j] = bm[0][j] * dc[1][j];
          k1w[j] = kp[0][j] * dc[1][j];
          wr1[j] = dc[0][j] * rf[0][j];
          wr2[j] = w12[j] * rf[1][j];
          cba += bm[0][j] * am[1][j];
          cka += kp[0][j] * am[1][j];
          br1 += bm[0][j] * rf[0][j];
          kr1 += kp[0][j] * rf[0][j];
          br12 += b1w[j] * rf[1][j];
          kr12 += k1w[j] * rf[1][j];
          br2 += bm[1][j] * rf[1][j];
          kr2 += kp[1][j] * rf[1][j];
        }
        cba = rowsum16(cba);
        cka = rowsum16(cka);
        br1 = rowsum16(br1);
        kr1 = rowsum16(kr1);
        br12 = rowsum16(br12);
        kr12 = rowsum16(kr12);
        br2 = rowsum16(br2);
        kr2 = rowsum16(kr2);
        float* slot = ring + (c & 1) * PAIR_BUF + pair * PAIR_TS;
        *(float4*)(slot + cq * 4) = make_float4(am[0][0], am[0][1], am[0][2], am[0][3]);
        *(float4*)(slot + 64 + cq * 4) = make_float4(aw[0], aw[1], aw[2], aw[3]);
        *(float4*)(slot + 128 + cq * 4) = make_float4(w12[0], w12[1], w12[2], w12[3]);
        *(float4*)(slot + 192 + cq * 4) = make_float4(b1w[0], b1w[1], b1w[2], b1w[3]);
        *(float4*)(slot + 256 + cq * 4) = make_float4(k1w[0], k1w[1], k1w[2], k1w[3]);
        *(float4*)(slot + 320 + cq * 4) = make_float4(bm[1][0], bm[1][1], bm[1][2], bm[1][3]);
        *(float4*)(slot + 384 + cq * 4) = make_float4(kp[1][0], kp[1][1], kp[1][2], kp[1][3]);
        *(float4*)(slot + 448 + cq * 4) = make_float4(wr1[0], wr1[1], wr1[2], wr1[3]);
        *(float4*)(slot + 512 + cq * 4) = make_float4(wr2[0], wr2[1], wr2[2], wr2[3]);
        if ((cq >> 2) == qr) {
          *(float4*)(slot + 576 + (cq & 3) * 4) = make_float4(vf[0][0], vf[0][1], vf[0][2], vf[0][3]);
          *(float4*)(slot + 592 + (cq & 3) * 4) = make_float4(vf[1][0], vf[1][1], vf[1][2], vf[1][3]);
        }
        if (cq == 0) {
          *(float4*)(slot + 608) = make_float4(cba, cka, br1, kr1);
          *(float4*)(slot + 612) = make_float4(br12, kr12, br2, kr2);
        }
      };
      auto pflush = [&](int cf) __attribute__((always_inline)) {
#pragma unroll
        for (int k2 = 0; k2 < 2; ++k2) {
          const int vi = (pt & 127) + 128 * k2;
          const float4* yp = (const float4*)(ybuf + (cf & 1) * 4096 + vi * 16);
          const float4 y0 = yp[0], y1 = yp[1], y2 = yp[2], y3 = yp[3];
          const float yv = ((y0.x + y0.y) + (y0.z + y0.w)) + ((y1.x + y1.y) + (y1.z + y1.w)) + ((y2.x + y2.y) + (y2.z + y2.w)) + ((y3.x + y3.y) + (y3.z + y3.w));
          Y[(rowbase + (size_t)cf * 16 + (vi >> 4)) * LDH + h * 64 + qr * 16 + (vi & 15)] = f2bf(yv);
        }
      };
      if (grp == 0) {
        pload(S0, 0);
        pproc(S0, 0);
        pload(S1, 2);
        pload(S0, 4);
      } else {
        pload(S0, 1);
        pload(S1, 3);
      }
      BAR_SYNC();
#pragma unroll 1
      for (int c = 0; c < 256; c += 4) {
        if (grp == 1) {
          pproc(S0, c + 1);
          if (c + 5 < 256) pload(S0, c + 5);
        } else if (c > 0) {
          pflush(c - 1);
        }
        BAR_SYNC();
        if (grp == 0) {
          pproc(S1, c + 2);
          if (c + 6 < 256) pload(S1, c + 6);
        } else {
          pflush(c);
        }
        BAR_SYNC();
        if (grp == 1) {
          pproc(S1, c + 3);
          if (c + 7 < 256) pload(S1, c + 7);
        } else {
          pflush(c + 1);
        }
        BAR_SYNC();
        if (grp == 0) {
          if (c + 4 < 256) pproc(S0, c + 4);
          if (c + 8 < 256) pload(S0, c + 8);
        } else {
          pflush(c + 2);
        }
        BAR_SYNC();
      }
    } else {
      const int rl = tid >> 4, cgp = tid & 15;
      float s0 = 0.f, s1 = 0.f, s2 = 0.f, s3 = 0.f;
      BAR_SYNC();
      for (int c = 0; c < 256; ++c) {
        const float* bufp = ring + (c & 1) * PAIR_BUF;
        float* yb = ybuf + (c & 1) * 4096;
        struct PV {
          float4 a1, aw, w12, b1w, k1w, b2, k2, wr1, wr2, sc0, sc1;
          float v1, v2;
        };
        auto ldpair = [&](const float* slot) __attribute__((always_inline)) {
          PV r;
          r.a1 = *(const float4*)(slot + cgp * 4);
          r.aw = *(const float4*)(slot + 64 + cgp * 4);
          r.w12 = *(const float4*)(slot + 128 + cgp * 4);
          r.b1w = *(const float4*)(slot + 192 + cgp * 4);
          r.k1w = *(const float4*)(slot + 256 + cgp * 4);
          r.b2 = *(const float4*)(slot + 320 + cgp * 4);
          r.k2 = *(const float4*)(slot + 384 + cgp * 4);
          r.wr1 = *(const float4*)(slot + 448 + cgp * 4);
          r.wr2 = *(const float4*)(slot + 512 + cgp * 4);
          r.v1 = slot[576 + rl];
          r.v2 = slot[592 + rl];
          r.sc0 = *(const float4*)(slot + 608);
          r.sc1 = *(const float4*)(slot + 612);
          return r;
        };
        PV cur = ldpair(bufp);
#pragma unroll
        for (int pr = 0; pr < 8; ++pr) {
          PV nxt = cur;
          if (pr + 1 < 8) nxt = ldpair(bufp + (pr + 1) * PAIR_TS);
          float d1 = fma_(s3, cur.a1.w, fma_(s2, cur.a1.z, fma_(s1, cur.a1.y, mul_(s0, cur.a1.x))));
          float d2 = fma_(s3, cur.aw.w, fma_(s2, cur.aw.z, fma_(s1, cur.aw.y, mul_(s0, cur.aw.x))));
          const float e1 = fma_(s3, cur.wr1.w, fma_(s2, cur.wr1.z, fma_(s1, cur.wr1.y, mul_(s0, cur.wr1.x))));
          const float e2 = fma_(s3, cur.wr2.w, fma_(s2, cur.wr2.z, fma_(s1, cur.wr2.y, mul_(s0, cur.wr2.x))));
          const float t0 = fma_(cur.v2, cur.k2.x, fma_(cur.v1, cur.k1w.x, mul_(s0, cur.w12.x)));
          const float t1 = fma_(cur.v2, cur.k2.y, fma_(cur.v1, cur.k1w.y, mul_(s1, cur.w12.y)));
          const float t2 = fma_(cur.v2, cur.k2.z, fma_(cur.v1, cur.k1w.z, mul_(s2, cur.w12.z)));
          const float t3 = fma_(cur.v2, cur.k2.w, fma_(cur.v1, cur.k1w.w, mul_(s3, cur.w12.w)));
          d1 = rowsum16(d1);
          d2 = rowsum16(d2);
          const float sa1 = d1;
          const float sa2 = fma_(cur.v1, cur.sc0.y, fma_(sa1, cur.sc0.x, d2));
          s0 = fma_(sa2, cur.b2.x, fma_(sa1, cur.b1w.x, t0));
          s1 = fma_(sa2, cur.b2.y, fma_(sa1, cur.b1w.y, t1));
          s2 = fma_(sa2, cur.b2.z, fma_(sa1, cur.b1w.z, t2));
          s3 = fma_(sa2, cur.b2.w, fma_(sa1, cur.b1w.w, t3));
          yb[(2 * pr) * 256 + tid] = e1 + 0.0625f * (sa1 * cur.sc0.z + cur.v1 * cur.sc0.w);
          yb[(2 * pr + 1) * 256 + tid] = e2 + 0.0625f * (sa1 * cur.sc1.x + cur.v1 * cur.sc1.y + sa2 * cur.sc1.z + cur.v2 * cur.sc1.w);
          cur = nxt;
        }
        BAR_SYNC();
      }
      {
        const float4* yp = (const float4*)(ybuf + (255 & 1) * 4096 + tid * 16);
        const float4 y0 = yp[0], y1 = yp[1], y2 = yp[2], y3 = yp[3];
        const float yv = ((y0.x + y0.y) + (y0.z + y0.w)) + ((y1.x + y1.y) + (y1.z + y1.w)) + ((y2.x + y2.y) + (y2.z + y2.w)) + ((y3.x + y3.y) + (y3.z + y3.w));
        Y[(rowbase + (size_t)255 * 16 + rl) * LDH + h * 64 + qr * 16 + cgp] = f2bf(yv);
      }
      float* wo = p.out + O_WKVP + (((size_t)(b * 16 + h) * 64) + qr * 16 + rl) * 64 + cgp * 4;
      *(float4*)wo = make_float4(s0, s1, s2, s3);
    }
  }
  float* sl = (float*)lds;
  for (int chain = blockIdx.x; chain < 2048; chain += gridDim.x) {
    const int b = chain >> 4, h = chain & 15;
    const size_t row = (size_t)NP + b;
    __syncthreads();
    if (w == 0) {
      const int ch = h * 64 + lane;
      const size_t off = row * 1024 + ch;
      const float rf = bf2f(R[off]), kf = bf2f(Kk[off]), vf = bf2f(V[off]), af = bf2f(Aa[off]), ef = h2f(EW[off]);
      const float kkr = kf * p.rw_kk[ch];
      const float ss = wavesum(kkr * kkr);
      const float inv = 1.f / fmaxf(sqrtf(ss), 1e-12f);
      const float kp = kf * (1.f + (af - 1.f) * p.rw_ka[ch]);
      const float rks = wavesum(rf * kp * p.rw_rk[ch]);
      sl[lane] = -kkr * inv;
      sl[64 + lane] = __expf(-ef);
      sl[128 + lane] = kkr * inv * af;
      sl[192 + lane] = kp;
      sl[256 + lane] = rf;
      sl[320 + lane] = vf;
      if (lane == 0) RK[row * 16 + h] = rks;
    }
    __syncthreads();
    const int i = tid >> 3, c8 = tid & 7;
    const float* sp = p.state_wkv + (((size_t)(b * 16 + h) * 64) + i) * 64 + c8 * 8;
    float4 sA = *(const float4*)sp, sB = *(const float4*)(sp + 4);
    float s[8] = {sA.x, sA.y, sA.z, sA.w, sB.x, sB.y, sB.z, sB.w};
    float sa = 0.f;
#pragma unroll
    for (int j = 0; j < 8; ++j) sa += s[j] * sl[c8 * 8 + j];
    sa += __shfl_xor(sa, 1);
    sa += __shfl_xor(sa, 2);
    sa += __shfl_xor(sa, 4);
    const float vv = sl[320 + i];
    float y = 0.f;
#pragma unroll
    for (int j = 0; j < 8; ++j) {
      const int cj = c8 * 8 + j;
      s[j] = s[j] * sl[64 + cj] + sa * sl[128 + cj] + vv * sl[192 + cj];
      y += s[j] * sl[256 + cj];
    }
    y += __shfl_xor(y, 1);
    y += __shfl_xor(y, 2);
    y += __shfl_xor(y, 4);
    float* wo = p.out + O_WKVS + (((size_t)(b * 16 + h) * 64) + i) * 64 + c8 * 8;
    *(float4*)wo = make_float4(s[0], s[1], s[2], s[3]);
    *(float4*)(wo + 4) = make_float4(s[4], s[5], s[6], s[7]);
    if (c8 == 0) Y[row * LDH + h * 64 + i] = f2bf(y);
  }
}

__device__ __forceinline__ void phase_gate(const Params& p, char* lds) {
  const u16* wt = (const u16*)(p.ws + WS_WT);
  const u16* GH = (const u16*)(p.ws + S_GH);
  const u16* V = (const u16*)(p.ws + S_V);
  const float* RK = (const float*)(p.ws + WS_RK);
  u16* Y = (u16*)(p.ws + WS_H);
  for (int t = blockIdx.x; t < 65 * 4; t += gridDim.x) {
    const int mt = t >> 2, nt = t & 3;
    const int m0 = mt * 256, n0 = nt * 256;
    gemm_tile256(GH, 128, wt + WT_G2, 128, 128, m0, n0, lds, mt == 64, [&](EPI_ARGS) {
      const int hh = (n0 + wn * 64) >> 6;
#pragma unroll
      for (int mi = 0; mi < 8; ++mi) {
        const int row = m0 + wm * 128 + mi * 16 + lr;
        const int rowc = row < MROWS ? row : MROWS - 1;
        float yv[4][4];
        float sum = 0.f;
#pragma unroll
        for (int ni = 0; ni < 4; ++ni) {
          const uint2 yy = *(const uint2*)(Y + (size_t)rowc * LDH + hh * 64 + ni * 16 + lg * 4);
          yv[ni][0] = bflo(yy.x); yv[ni][1] = bfhi(yy.x); yv[ni][2] = bflo(yy.y); yv[ni][3] = bfhi(yy.y);
          sum += yv[ni][0] + yv[ni][1] + yv[ni][2] + yv[ni][3];
        }
        sum += __shfl_xor(sum, 16);
        sum += __shfl_xor(sum, 32);
        const float mu = sum * (1.f / 64.f);
        float vs = 0.f;
#pragma unroll
        for (int ni = 0; ni < 4; ++ni)
#pragma unroll
          for (int q = 0; q < 4; ++q) {
            const float d = yv[ni][q] - mu;
            vs += d * d;
          }
        vs += __shfl_xor(vs, 16);
        vs += __shfl_xor(vs, 32);
        const float rstd = rsqrtf(vs * (1.f / 64.f) + 64e-5f);
        const float rk = RK[(size_t)rowc * 16 + hh];
#pragma unroll
        for (int ni = 0; ni < 4; ++ni) {
          const int col0 = hh * 64 + ni * 16 + lg * 4;
          const uint2 vv = *(const uint2*)(V + (size_t)rowc * 1024 + col0);
          const float vf[4] = {bflo(vv.x), bfhi(vv.x), bflo(vv.y), bfhi(vv.y)};
          const float4 g4 = *(const float4*)(p.rw_lnx_g + col0), b4 = *(const float4*)(p.rw_lnx_b + col0);
          const float gg[4] = {g4.x, g4.y, g4.z, g4.w}, bb[4] = {b4.x, b4.y, b4.z, b4.w};
          f32x4 o;
#pragma unroll
          for (int q = 0; q < 4; ++q) o[q] = ((yv[ni][q] - mu) * rstd * gg[q] + bb[q] + rk * vf[q]) * acc[mi][ni][q];
          if (row < MROWS) *(uint2*)(Y + (size_t)row * LDH + col0) = pack4(o);
        }
        __builtin_amdgcn_sched_barrier(0);
      }
    });
  }
}

__device__ __forceinline__ void phase_oproj(const Params& p, char* lds, const u16* A, int K, const u16* Bt, int layer, int gidx, bool first) {
  const int ldab = K == 1024 ? LDH : LDU;
  const float* mod = (const float*)(p.ws + WS_MOD);
  for (int u = blockIdx.x; u < 320; u += gridDim.x) {
    const bool split = u >= 256;
    const int s = u - 256;
    const int m0 = split ? NP : (u >> 2) * 256, n0 = (split ? (s & 3) : (u & 3)) * 256;
    const int klen = split ? (K >> 4) : K, kbeg = split ? (s >> 2) * klen : 0;
    gemm_tile256(A + kbeg, ldab, Bt + kbeg, ldab, klen, m0, n0, lds, split, [&](EPI_ARGS) {
      EPI_FOREACH(acc, if (row < MROWS) {
        const float4 gt = *(const float4*)(mod + ((size_t)layer * 132 + bidx_of(row)) * 6144 + gidx * 1024 + col0);
        float* xp = p.out + (size_t)row * 1024 + col0;
        if (split) {
          unsafeAtomicAdd(xp + 0, gt.x * v[0]);
          unsafeAtomicAdd(xp + 1, gt.y * v[1]);
          unsafeAtomicAdd(xp + 2, gt.z * v[2]);
          unsafeAtomicAdd(xp + 3, gt.w * v[3]);
        } else {
          const float* xi = first ? p.x_prompt + (size_t)row * 1024 + col0 : xp;
          const float4 xo = *(const float4*)xi;
          *(float4*)xp = make_float4(xo.x + gt.x * v[0], xo.y + gt.y * v[1], xo.z + gt.z * v[2], xo.w + gt.w * v[3]);
        }
      })
    });
  }
}

__device__ __forceinline__ void phase_up(const Params& p, char* lds, const u16* Bt) {
  const u16* H = (const u16*)(p.ws + WS_H);
  u16* UP = (u16*)(p.ws + S_UP);
  for (int t = blockIdx.x; t < 65 * 16; t += gridDim.x) {
    const int mt = t >> 4, nt = t & 15;
    const int m0 = mt * 256, n0 = nt * 256;
    gemm_tile256(H, LDH, Bt, LDH, 1024, m0, n0, lds, mt == 64, [&](EPI_ARGS) {
      EPI_FOREACH(acc, if (row < MROWS) {
        f32x4 o;
        _Pragma("unroll") for (int q = 0; q < 4; ++q) {
          const float rl = fmaxf(v[q], 0.f);
          o[q] = rl * rl;
        }
        *(uint2*)(UP + (size_t)row * LDU + col0) = pack4(o);
      })
    });
  }
}

__device__ __forceinline__ void phase_qkv(const Params& p, char* lds) {
  const u16* H = (const u16*)(p.ws + WS_H);
  const u16* wt = (const u16*)(p.ws + WS_WT);
  const float* tab = (const float*)(p.ws + WS_TAB);
  u16* Qb = (u16*)(p.ws + S_Q);
  u16* Kb = (u16*)(p.ws + S_KB);
  u16* Vt = (u16*)(p.ws + S_VT);
  for (int t = blockIdx.x; t < 65 * 6; t += gridDim.x) {
    const int mt = t / 6, nt = t % 6;
    const int m0 = mt * 256, n0 = nt * 256;
    gemm_tile256(H, LDH, wt + WT_QKV, LDH, 1024, m0, n0, lds, mt == 64, [&](EPI_ARGS) {
      const int hc0 = n0 + wn * 64;
#pragma unroll
      for (int mi = 0; mi < 8; ++mi) {
        const int row = m0 + wm * 128 + mi * 16 + lr;
        const bool valid = row < MROWS;
        const bool isp = row < NP;
        const int pos = row & 4095;
        const int bq = isp ? (row >> 12) : (row - NP);
        const int posidx = isp ? pos : 4096;
#pragma unroll
        for (int ni = 0; ni < 4; ++ni) {
          const int col0 = hc0 + ni * 16 + lg * 4;
          const float4 b4 = *(const float4*)(p.at_bqkv + col0);
          f32x4 v = acc[mi][ni];
          v[0] += b4.x; v[1] += b4.y; v[2] += b4.z; v[3] += b4.w;
          if (ni == 0 && hc0 < 1280) {
            const float* tp = tab + (size_t)posidx * 16 + (lg & 1) * 8;
            const float4 t0 = *(const float4*)tp, t1 = *(const float4*)(tp + 4);
            const float cs[4] = {t0.x, t0.z, t1.x, t1.z}, sn[4] = {t0.y, t0.w, t1.y, t1.w};
#pragma unroll
            for (int q = 0; q < 4; ++q) {
              const float pv = __shfl_xor(v[q], 32);
              v[q] = (lg < 2) ? (v[q] * cs[q] - pv * sn[q]) : (v[q] * cs[q] + pv * sn[q]);
            }
          }
          if (valid) {
            if (hc0 < 1024) {
              *(uint2*)(Qb + (size_t)row * 1024 + col0) = pack4(v);
            } else if (hc0 < 1280) {
              const int c2 = col0 - 1024;
              *(uint2*)(Kb + (size_t)row * 256 + c2) = pack4(v);
              if (isp) {
                if (pos >= 3968) *(float4*)(p.out + O_KP + ((size_t)(bq * 128 + pos - 3968)) * 256 + c2) = make_float4(v[0], v[1], v[2], v[3]);
              } else {
                *(float4*)(p.out + O_KS + ((size_t)(bq * 128 + 127)) * 256 + c2) = make_float4(v[0], v[1], v[2], v[3]);
              }
            } else {
              const int c3 = col0 - 1280;
              if (isp) {
                u16* vp = Vt + ((size_t)(bq * 4 + (c3 >> 6)) * 64 + (c3 & 63)) * 4096 + pos;
#pragma unroll
                for (int q = 0; q < 4; ++q) vp[(size_t)q * 4096] = f2bf(v[q]);
                if (pos >= 3968) *(float4*)(p.out + O_VP + ((size_t)(bq * 128 + pos - 3968)) * 256 + c3) = make_float4(v[0], v[1], v[2], v[3]);
              } else {
                *(float4*)(p.out + O_VS + ((size_t)(bq * 128 + 127)) * 256 + c3) = make_float4(v[0], v[1], v[2], v[3]);
              }
            }
          }
        }
        __builtin_amdgcn_sched_barrier(0);
      }
    });
  }
}

constexpr int AT_KS = 0, AT_VS = 36864, AT_PS = 36864 + 35840, AT_PW = 5376;

__device__ __forceinline__ void phase_attn(const Params& p, char* lds) {
  int tid_l = threadIdx.x;
  asm volatile("" : "+v"(tid_l));
  const int tid = tid_l, lane = tid & 63, w = tid >> 6, lr = lane & 15, lg = lane >> 4;
  const u16* Qb = (const u16*)(p.ws + S_Q);
  const u16* Kb = (const u16*)(p.ws + S_KB);
  const u16* Vt = (const u16*)(p.ws + S_VT);
  u16* O = (u16*)(p.ws + S_O);
  char* Ks = lds + AT_KS;
  char* Vs = lds + AT_VS;
  char* Ps = lds + AT_PS + w * AT_PW;
  for (int u = blockIdx.x; u < 512; u += gridDim.x) {
    const int b = u >> 7, n = (u >> 2) & 31, kvh = u & 3;
    bf16x8 qfa[4][2];
    {
      const int g_ = w >> 1, hf_ = w & 1, qh_ = kvh * 4 + g_;
#pragma unroll
      for (int i = 0; i < 4; ++i) {
        const size_t tok = (size_t)b * 4096 + n * 128 + hf_ * 64 + i * 16 + lr;
        qfa[i][0] = *(const bf16x8*)(Qb + tok * 1024 + qh_ * 64 + lg * 8);
        qfa[i][1] = *(const bf16x8*)(Qb + tok * 1024 + qh_ * 64 + 32 + lg * 8);
      }
    }
    __syncthreads();
#pragma unroll
    for (int i = 0; i < 4; ++i) {
      const int c = tid + 512 * i;
      {
        const int key = c >> 3, kc = c & 7;
        const int pos = n * 128 - 128 + key;
        uint4 v = {0u, 0u, 0u, 0u};
        if (pos >= 0) v = *(const uint4*)(Kb + ((size_t)b * 4096 + pos) * 256 + kvh * 64 + kc * 8);
        *(uint4*)(Ks + key * 144 + kc * 16) = v;
      }
      {
        const int d = c >> 5, kc = c & 31;
        const int pos0 = n * 128 - 128 + kc * 8;
        uint4 v = {0u, 0u, 0u, 0u};
        if (pos0 >= 0) v = *(const uint4*)(Vt + ((size_t)(b * 4 + kvh) * 64 + d) * 4096 + pos0);
        *(uint4*)(Vs + d * 560 + kc * 16) = v;
      }
    }
    if (tid < 192) {
      const int d = tid / 3, c = tid % 3;
      *(uint4*)(Vs + d * 560 + 512 + c * 16) = uint4{0u, 0u, 0u, 0u};
    }
    {
      const int prow = lane >> 2, pc = 144 + (lane & 3) * 4;
      *(uint2*)(Ps + prow * 336 + pc * 2) = uint2{0u, 0u};
    }
    __syncthreads();
    const int g = w >> 1, hf = w & 1;
    const int qh = kvh * 4 + g;
    const float sink = p.at_sink[qh];
#pragma unroll
    for (int i = 0; i < 4; ++i) {
      const int q0 = hf * 64 + i * 16;
      const bf16x8 qf0 = qfa[i][0];
      const bf16x8 qf1 = qfa[i][1];
      f32x4 s[9];
#pragma unroll
      for (int j = 0; j < 9; ++j) {
        const char* kp = Ks + (q0 + j * 16 + lr) * 144 + lg * 16;
        const bf16x8 k0 = *(const bf16x8*)kp;
        const bf16x8 k1 = *(const bf16x8*)(kp + 64);
        f32x4 z = {0.f, 0.f, 0.f, 0.f};
        z = __builtin_amdgcn_mfma_f32_16x16x32_bf16(qf0, k0, z, 0, 0, 0);
        z = __builtin_amdgcn_mfma_f32_16x16x32_bf16(qf1, k1, z, 0, 0, 0);
        s[j] = z;
      }
      float mx[4], sum[4];
#pragma unroll
      for (int r = 0; r < 4; ++r) {
        const int ql = lg * 4 + r;
        float m = sink;
#pragma unroll
        for (int j = 0; j < 9; ++j) {
          float v = s[j][r] * 0.125f;
          bool ok = true;
          if (j == 0) ok = (lr >= ql);
          if (j == 8) ok = (lr <= ql);
          if (n == 0 && (q0 + j * 16 + lr) < 128) ok = false;
          v = ok ? v : -INFINITY;
          s[j][r] = v;
          m = fmaxf(m, v);
        }
        mx[r] = rowmax16(m);
      }
#pragma unroll
      for (int r = 0; r < 4; ++r) {
        float sm = 0.f;
#pragma unroll
        for (int j = 0; j < 9; ++j) {
          const float e = __expf(s[j][r] - mx[r]);
          s[j][r] = e;
          sm += e;
        }
        sm = rowsum16(sm);
        sum[r] = sm + __expf(sink - mx[r]);
      }
      u16* P = (u16*)Ps;
#pragma unroll
      for (int j = 0; j < 9; ++j)
#pragma unroll
        for (int r = 0; r < 4; ++r) P[(lg * 4 + r) * 168 + j * 16 + lr] = f2bf(s[j][r]);
      __builtin_amdgcn_wave_barrier();
      f32x4 o[4];
#pragma unroll
      for (int nd = 0; nd < 4; ++nd) o[nd] = f32x4{0.f, 0.f, 0.f, 0.f};
#pragma unroll
      for (int kk = 0; kk < 5; ++kk) {
        const bf16x8 pf = *(const bf16x8*)(Ps + lr * 336 + kk * 64 + lg * 16);
#pragma unroll
        for (int nd = 0; nd < 4; ++nd) {
          const bf16x8 vf = *(const bf16x8*)(Vs + (nd * 16 + lr) * 560 + (q0 + kk * 32 + lg * 8) * 2);
          o[nd] = __builtin_amdgcn_mfma_f32_16x16x32_bf16(pf, vf, o[nd], 0, 0, 0);
        }
      }
#pragma unroll
      for (int nd = 0; nd < 4; ++nd)
#pragma unroll
        for (int r = 0; r < 4; ++r) {
          const float v = o[nd][r] / sum[r];
          O[((size_t)b * 4096 + n * 128 + q0 + lg * 4 + r) * LDH + qh * 64 + nd * 16 + lr] = f2bf(v);
        }
      __builtin_amdgcn_wave_barrier();
    }
  }
  float* qs = (float*)lds;
  float* sc = (float*)(lds + 1024);
  float* part = (float*)(lds + 1024 + 2112);
  for (int it = blockIdx.x; it < 512; it += gridDim.x) {
    const int b = it >> 2, kvh = it & 3;
    const size_t row = (size_t)NP + b;
    __syncthreads();
    if (tid < 256) qs[tid] = bf2f(Qb[row * 1024 + kvh * 256 + tid]);
    __syncthreads();
    {
      const int key = tid >> 2, g = tid & 3;
      const float* kp = p.cache_k + (((size_t)b * 128 + key) * 4 + kvh) * 64;
      float dot = 0.f;
#pragma unroll
      for (int d4 = 0; d4 < 16; ++d4) {
        const float4 kv = *(const float4*)(kp + d4 * 4);
        const float* q = qs + g * 64 + d4 * 4;
        dot += kv.x * q[0] + kv.y * q[1] + kv.z * q[2] + kv.w * q[3];
      }
      sc[g * 132 + key] = dot * 0.125f;
      if (key >= 1) {
        float* dst = p.out + O_KS + (((size_t)b * 128 + key - 1) * 4 + kvh) * 64 + g * 16;
        const float* src = kp + g * 16;
#pragma unroll
        for (int d4 = 0; d4 < 4; ++d4) *(float4*)(dst + d4 * 4) = *(const float4*)(src + d4 * 4);
      }
      if (tid < 4) {
        const float* kn = p.out + O_KS + (((size_t)b * 128 + 127) * 4 + kvh) * 64;
        float d2 = 0.f;
        for (int d = 0; d < 64; ++d) d2 += kn[d] * qs[tid * 64 + d];
        sc[tid * 132 + 128] = d2 * 0.125f;
      }
    }
    __syncthreads();
    if (w < 4) {
      const float sink = p.at_sink[kvh * 4 + w];
      float* s = sc + w * 132;
      const float v0 = s[lane], v1 = s[64 + lane], v2 = lane == 0 ? s[128] : -INFINITY;
      float m = fmaxf(fmaxf(v0, v1), fmaxf(v2, sink));
      m = wavemax(m);
      const float e0 = __expf(v0 - m), e1 = __expf(v1 - m), e2 = lane == 0 ? __expf(v2 - m) : 0.f;
      float sm = wavesum(e0 + e1 + e2) + __expf(sink - m);
      const float inv = 1.f / sm;
      s[lane] = e0 * inv;
      s[64 + lane] = e1 * inv;
      if (lane == 0) s[128] = e2 * inv;
    }
    __syncthreads();
    {
      const int d = tid & 63, g = (tid >> 6) & 3, half = tid >> 8;
      const float* vp = p.cache_v + (((size_t)b * 128) * 4 + kvh) * 64 + d;
      float accv = 0.f;
      for (int key = half * 64; key < half * 64 + 64; ++key) {
        const float vv = vp[(size_t)key * 256];
        accv += sc[g * 132 + key] * vv;
        if (g == 0 && key >= 1) p.out[O_VS + (((size_t)b * 128 + key - 1) * 4 + kvh) * 64 + d] = vv;
      }
      if (half == 1) accv += sc[g * 132 + 128] * p.out[O_VS + (((size_t)b * 128 + 127) * 4 + kvh) * 64 + d];
      part[(half * 4 + g) * 64 + d] = accv;
    }
    __syncthreads();
    if (tid < 256) {
      const int d = tid & 63, g = tid >> 6;
      O[row * LDH + (kvh * 4 + g) * 64 + d] = f2bf(part[g * 64 + d] + part[(4 + g) * 64 + d]);
    }
  }
}

__global__ void __launch_bounds__(NTHR) mega(Params p) {
  extern __shared__ __attribute__((aligned(16))) char lds[];
  cg::grid_group grid = cg::this_grid();
  volatile LAS unsigned* xst = (volatile LAS unsigned*)(lds + LDS_BYTES);
  if (threadIdx.x == 0) { xst[0] = 0u; xst[1] = 0u; }
  __syncthreads();
  const XcdBarrier xb = xcd_barrier_post((unsigned*)(p.ws + WS_BAR), xst);
  const u16* wt = (const u16*)(p.ws + WS_WT);
  phase0(p, lds);
  if (p.out == nullptr) grid.sync();
  xcd_barrier(xb);
  phase_ada(p, lds);
  xcd_barrier(xb);
  phase_norm_mix(p);
  xcd_barrier(xb);
  phase_rwkv_proj(p, lds);
  xcd_barrier(xb);
  phase_rwkv_lora2(p, lds);
  xcd_barrier(xb);
  phase_scan(p, lds);
  xcd_barrier(xb);
  phase_gate(p, lds);
  xcd_barrier(xb);
  phase_oproj(p, lds, (const u16*)(p.ws + WS_H), 1024, wt + WT_WO, 0, 2, true);
  xcd_barrier(xb);
  phase_norm(p, 0, 1, false, false);
  xcd_barrier(xb);
  phase_up(p, lds, wt + WT_UP0);
  xcd_barrier(xb);
  phase_oproj(p, lds, (const u16*)(p.ws + S_UP), 4096, wt + WT_DN0, 0, 5, false);
  xcd_barrier(xb);
  phase_norm(p, 1, 0, false, false);
  xcd_barrier(xb);
  phase_qkv(p, lds);
  xcd_barrier(xb);
  phase_attn(p, lds);
  xcd_barrier(xb);
  phase_oproj(p, lds, (const u16*)(p.ws + S_O), 1024, wt + WT_WO1, 1, 2, false);
  xcd_barrier(xb);
  phase_norm(p, 1, 1, false, false);
  xcd_barrier(xb);
  phase_up(p, lds, wt + WT_UP1);
  xcd_barrier(xb);
  phase_oproj(p, lds, (const u16*)(p.ws + S_UP), 4096, wt + WT_DN1, 1, 5, false);
  xcd_barrier(xb);
  phase_final(p);
}

extern "C" void kernel_launch(void* const* d_in, const int* in_sizes, int n_in, void* d_out, int out_size, void* d_ws,
                              size_t ws_size, hipStream_t stream) {
  static int grid_blocks = 0;
  if (grid_blocks == 0) {
    if (ws_size < WS_END) {
      fprintf(stderr, "kernel_launch: workspace too small: %zu < %zu\n", ws_size, (size_t)WS_END);
      grid_blocks = -1;
      return;
    }
    int dev = 0, cus = 0, per_cu = 0;
    hipGetDevice(&dev);
    hipDeviceGetAttribute(&cus, hipDeviceAttributeMultiprocessorCount, dev);
    hipFuncSetAttribute((const void*)mega, hipFuncAttributeMaxDynamicSharedMemorySize, LDS_BYTES + 16);
    hipOccupancyMaxActiveBlocksPerMultiprocessor(&per_cu, (const void*)mega, NTHR, LDS_BYTES + 16);
    if (per_cu < 1) per_cu = 1;
    grid_blocks = cus * per_cu;
  }
  if (grid_blocks < 0) return;
  Params p{};
  const float** pp = (const float**)&p;
  for (int i = 0; i < 37; ++i) pp[i] = (const float*)d_in[i];
  p.out = (float*)d_out;
  p.ws = (char*)d_ws;
  hipMemsetAsync((char*)d_ws + WS_BAR, 0, 16384, stream);
  void* args[] = {&p};
  hipError_t e = hipLaunchCooperativeKernel((const void*)mega, dim3(grid_blocks), dim3(NTHR), args, LDS_BYTES + 16, stream);
  if (e != hipSuccess) fprintf(stderr, "cooperative launch failed: %s (grid %d)\n", hipGetErrorString(e), grid_blocks);
}
```

```cpp
#include <hip/hip_runtime.h>
#include <hip/hip_cooperative_groups.h>
#include <cstdio>
namespace cg = cooperative_groups;

typedef unsigned short u16;
typedef __attribute__((ext_vector_type(8))) short bf16x8;
typedef __attribute__((ext_vector_type(4))) float f32x4;

constexpr int NP = 16384, MROWS = 16512, MPAD = 16640;
constexpr int NTHR = 512;
constexpr size_t MEG = 1048576;
constexpr int LDH = 1088, LDU = 4160;

constexpr size_t O_Y = 0, O_WKVP = 16908288, O_WKVS = 17170432, O_SHP = 25559040, O_SHS = 25563136,
                 O_KP = 25694208, O_KS = 25825280, O_VP = 30019584, O_VS = 30150656;

constexpr size_t WT_WR = 0, WT_WK = WT_WR + 1024 * LDH, WT_WV = WT_WK + 1024 * LDH, WT_WO = WT_WV + 1024 * LDH,
                 WT_W1 = WT_WO + 1024 * LDH, WT_A1 = WT_W1 + 64 * LDH, WT_G1 = WT_A1 + 64 * LDH, WT_W2 = WT_G1 + 128 * LDH,
                 WT_A2 = WT_W2 + 65536, WT_G2 = WT_A2 + 65536, WT_UP0 = WT_G2 + 131072, WT_DN0 = WT_UP0 + 4096 * LDH,
                 WT_QKV = WT_DN0 + 1024 * LDU, WT_WO1 = WT_QKV + 1536 * LDH, WT_UP1 = WT_WO1 + 1024 * LDH,
                 WT_DN1 = WT_UP1 + 4096 * LDH, WT_END = WT_DN1 + 1024 * LDU;
constexpr size_t WS_WT = 0;
constexpr size_t WS_H = WS_WT + WT_END * 2;
constexpr size_t WS_ZR = WS_H + (size_t)MPAD * LDH * 2;
constexpr size_t WS_MOD = WS_ZR + (size_t)LDH * 2;
constexpr size_t WS_TAB = WS_MOD + (size_t)2 * 132 * 6144 * 4;
constexpr size_t WS_HS = WS_H + (size_t)MROWS * LDH * 2;
constexpr size_t WS_RK = WS_TAB + (size_t)4097 * 8 * 8;
constexpr size_t WS_BAR = WS_RK + (size_t)MPAD * 16 * 4;
constexpr size_t WS_S = WS_BAR + 16384;
constexpr size_t RSZ = (size_t)MROWS * 1024 * 2;
constexpr size_t S_ADAWT = WS_S, S_SILUC = S_ADAWT + (size_t)2 * 6144 * LDH * 2;
constexpr size_t S_R = WS_S, S_K = S_R + RSZ, S_V = S_K + RSZ, S_EW = S_V + RSZ, S_A = S_EW + RSZ,
                 S_WH = S_A + RSZ, S_AH = S_WH + (size_t)MPAD * 64 * 2, S_GH = S_AH + (size_t)MPAD * 64 * 2,
                 S_RW_END = S_GH + (size_t)MPAD * 128 * 2;
constexpr size_t S_UP = WS_S;
constexpr size_t S_Q = WS_S, S_O = S_Q + (size_t)MPAD * 1024 * 2, S_KB = S_O + (size_t)MPAD * LDH * 2,
                 S_VT = S_KB + (size_t)MPAD * 256 * 2;
constexpr size_t WS_END = S_RW_END;
static_assert(S_UP + (size_t)MPAD * LDU * 2 <= WS_END, "up fits");
static_assert(S_VT + (size_t)16 * 64 * 4096 * 2 <= WS_END, "attn fits");
static_assert(WS_END <= 282000000, "ws fits sum of inputs");

constexpr int LDS_ROW = 144;
constexpr int LDS_A_BYTES = 256 * LDS_ROW;
constexpr int LDS_B_BYTES = 128 * LDS_ROW;
constexpr int LDS_STAGE = LDS_A_BYTES + LDS_B_BYTES;
constexpr int LDS_BYTES = 147456;

struct Params {
  const float *x_prompt, *x_sample, *c_prompt, *c_sample, *state_wkv, *state_shift, *cache_k, *cache_v;
  const float *norm1_g, *norm2_g, *ada_w, *ada_b, *mlp_up, *mlp_down, *final_g;
  const float *rw_mix, *rw_wr, *rw_wk, *rw_wv, *rw_wo, *rw_w0, *rw_w1, *rw_w2, *rw_a0, *rw_a1, *rw_a2, *rw_g1, *rw_g2,
      *rw_kk, *rw_ka, *rw_rk, *rw_lnx_g, *rw_lnx_b;
  const float *at_wqkv, *at_bqkv, *at_wo, *at_sink;
  float* out;
  char* ws;
};

__device__ __forceinline__ u16 f2bf(float f) {
  unsigned u = __float_as_uint(f);
  u += 0x7fffu + ((u >> 16) & 1u);
  return (u16)(u >> 16);
}
__device__ __forceinline__ float bf2f(u16 h) { return __uint_as_float(((unsigned)h) << 16); }
__device__ __forceinline__ float bflo(unsigned w) { return __uint_as_float(w << 16); }
__device__ __forceinline__ float bfhi(unsigned w) { return __uint_as_float(w & 0xffff0000u); }
__device__ __forceinline__ unsigned pack2(float a, float b) {
  unsigned r;
  asm volatile("v_cvt_pk_bf16_f32 %0, %1, %2" : "=v"(r) : "v"(a), "v"(b));
  return r;
}
__device__ __forceinline__ uint2 pack4(f32x4 v) { return uint2{pack2(v[0], v[1]), pack2(v[2], v[3])}; }
__device__ __forceinline__ float h2f(u16 h) { return (float)__builtin_bit_cast(_Float16, h); }
__device__ __forceinline__ u16 f2h(float f) { return __builtin_bit_cast(u16, (_Float16)f); }
__device__ __forceinline__ float sigmoidf_(float x) { return 1.f / (1.f + __expf(-x)); }

template <int CTRL>
__device__ __forceinline__ float dppf(float x) {
  return __int_as_float(__builtin_amdgcn_update_dpp(0, __float_as_int(x), CTRL, 0xf, 0xf, true));
}
__device__ __forceinline__ float rowsum16(float x) {
  x += dppf<0xB1>(x);
  x += dppf<0x4E>(x);
  x += dppf<0x124>(x);
  x += dppf<0x128>(x);
  return x;
}
__device__ __forceinline__ float rowmax16(float x) {
  x = fmaxf(x, dppf<0xB1>(x));
  x = fmaxf(x, dppf<0x4E>(x));
  x = fmaxf(x, dppf<0x124>(x));
  x = fmaxf(x, dppf<0x128>(x));
  return x;
}
__device__ __forceinline__ float wavesum(float x) {
#pragma unroll
  for (int o = 32; o > 0; o >>= 1) x += __shfl_xor(x, o);
  return x;
}
__device__ __forceinline__ float wavemax(float x) {
#pragma unroll
  for (int o = 32; o > 0; o >>= 1) x = fmaxf(x, __shfl_xor(x, o));
  return x;
}
__device__ __forceinline__ int bidx_of(int row) { return row < NP ? (row >> 12) : (4 + row - NP); }

#define XB_TMO      128
#define XB_XCNT(j)  (256  + 64 * (j))
#define XB_XSUB(j)  (1280 + 64 * (j))
#define XB_XGEN(j)  (2304 + 64 * (j))
#define XB_TOP      3328
#define XB_TOPGEN   3392
#define XCD_BAR_WORDS 3456
#define XB_SPIN_CAP (1u << 22)
#define LAS __attribute__((address_space(3)))
__device__ __forceinline__ unsigned xb_ld(unsigned* p) { return __hip_atomic_load(p, __ATOMIC_RELAXED, __HIP_MEMORY_SCOPE_AGENT); }
__device__ __forceinline__ unsigned xb_add(unsigned* p, unsigned v) { return __hip_atomic_fetch_add(p, v, __ATOMIC_RELAXED, __HIP_MEMORY_SCOPE_AGENT); }
__device__ __forceinline__ unsigned xb_xcc_id() { return (unsigned)__builtin_amdgcn_s_getreg((3 << 11) | 20) & 0xFu; }
#define XB_SPIN(cond, bar) do { unsigned _sp = 0; while (cond) { __builtin_amdgcn_s_sleep(1); \
    if ((++_sp & 255u) == 0u) { if (xb_ld(&(bar)[XB_TMO])) break; if (_sp > XB_SPIN_CAP) { atomicAdd(&(bar)[XB_TMO], 1u); break; } } } } while (0)
struct XcdBarrier {
  unsigned* bar;
  unsigned x;
  volatile LAS unsigned* st;
};
__device__ __forceinline__ XcdBarrier xcd_barrier_post(unsigned* bar, volatile LAS unsigned* st) {
  XcdBarrier b;
  b.bar = bar;
  b.x = xb_xcc_id();
  b.st = st;
  if (threadIdx.x == 0) (void)xb_add(&bar[XB_XCNT(b.x)], 1u);
  return b;
}
__device__ __forceinline__ void xcd_barrier_complete(unsigned* bar, unsigned x, unsigned& nloc, unsigned& nx) {
  const unsigned G = gridDim.x * gridDim.y * gridDim.z;
  unsigned sum, cnt, mine, sp = 0u;
  for (;;) {
    sum = 0u; cnt = 0u; mine = 0u;
#pragma unroll
    for (unsigned j = 0; j < 16; ++j) {
      const unsigned c = xb_ld(&bar[XB_XCNT(j)]);
      sum += c;
      cnt += (c > 0u) ? 1u : 0u;
      mine = (j == x) ? c : mine;
    }
    if (sum == G) break;
    __builtin_amdgcn_s_sleep(1);
    if ((++sp & 255u) == 0u) {
      if (xb_ld(&bar[XB_TMO])) break;
      if (sp > XB_SPIN_CAP) { atomicAdd(&bar[XB_TMO], 1u); break; }
    }
  }
  nloc = mine > 0u ? mine : 1u;
  nx = cnt > 0u ? cnt : 1u;
}
__device__ __forceinline__ void xcd_barrier(const XcdBarrier& b) {
  asm volatile("s_waitcnt vmcnt(0)" ::: "memory");
  __syncthreads();
  if (threadIdx.x == 0) {
    unsigned* bar = b.bar;
    __builtin_amdgcn_s_waitcnt(0);
    unsigned nloc = b.st[0], nx = b.st[1];
    if (nloc == 0u) { xcd_barrier_complete(bar, b.x, nloc, nx); b.st[0] = nloc; b.st[1] = nx; }
    const unsigned old = xb_add(&bar[XB_XSUB(b.x)], 1u);
    const unsigned gen = old / nloc;
    if (old + 1u == (gen + 1u) * nloc) {
      __builtin_amdgcn_fence(__ATOMIC_RELEASE, "agent");
      asm volatile("s_waitcnt vmcnt(0)" ::: "memory");
      const unsigned og = xb_add(&bar[XB_TOP], 1u);
      const unsigned tg = og / nx;
      if (og + 1u == (tg + 1u) * nx) xb_add(&bar[XB_TOPGEN], 1u);
      else XB_SPIN(xb_ld(&bar[XB_TOPGEN]) == tg, bar);
      __builtin_amdgcn_fence(__ATOMIC_ACQUIRE, "agent");
      xb_add(&bar[XB_XGEN(b.x)], 1u);
      asm volatile("s_waitcnt vmcnt(0)" ::: "memory");
    } else {
      XB_SPIN(xb_ld(&bar[XB_XGEN(b.x)]) == gen, bar);
      __builtin_amdgcn_fence(__ATOMIC_ACQUIRE, "agent");
      asm volatile("s_waitcnt vmcnt(0)" ::: "memory");
    }
  }
  __syncthreads();
}

#define BAR_SYNC() do { asm volatile("s_waitcnt lgkmcnt(0)" ::: "memory"); __builtin_amdgcn_s_barrier(); asm volatile("" ::: "memory"); } while (0)

__device__ __forceinline__ unsigned mix2(unsigned h, unsigned p, float m0, float m1) {
  float h0 = bflo(h), h1 = bfhi(h), p0 = bflo(p), p1 = bfhi(p);
  return pack2(h0 + (p0 - h0) * m0, h1 + (p1 - h1) * m1);
}

template <bool MIX, class Epi>
__device__ __forceinline__ void gemm_tile(const u16* __restrict__ A, int lda, const float* __restrict__ mixv,
                                          const u16* __restrict__ Bt, int ldb, int N, int K, int m0, int n0, char* lds, Epi&& epi) {
  int tid_l = threadIdx.x;
  asm volatile("" : "+v"(tid_l));
  const int tid = tid_l, lane = tid & 63, w = tid >> 6;
  const int nk = K >> 6;
  if (w >= 4) {
    const int pt = tid - 256, kc = pt & 7, pr = pt >> 3;
    const u16* Ab = A + (size_t)m0 * lda + (size_t)pr * lda + kc * 8;
    int poff[8];
#pragma unroll
    for (int i = 0; i < 8; ++i) {
      poff[i] = 0;
      if (MIX) {
        const int row = m0 + pr + 32 * i;
        const int prow = row < NP ? ((row & 4095) ? row - 1 : MPAD) : (row < MROWS ? row + 128 : MPAD);
        poff[i] = prow * LDH + kc * 8;
      }
    }
    bool bv[4];
    const u16* bp[4];
#pragma unroll
    for (int j = 0; j < 4; ++j) {
      const int n = n0 + pr + 32 * j;
      bv[j] = n < N;
      bp[j] = Bt + (size_t)(bv[j] ? n : 0) * ldb + kc * 8;
    }
    struct RSet {
      uint4 ra[8], rp[8], rb[4];
      float4 mx0, mx1;
    };
    RSet SA, SB;
    auto gload = [&](RSet& S, int kt) {
      const int ko = kt * 64;
#pragma unroll
      for (int i = 0; i < 8; ++i) {
        S.ra[i] = *(const uint4*)(Ab + (size_t)(32 * i) * lda + ko);
        if (MIX) S.rp[i] = *(const uint4*)(A + poff[i] + ko);
      }
      if (MIX) {
        S.mx0 = *(const float4*)(mixv + ko + kc * 8);
        S.mx1 = *(const float4*)(mixv + ko + kc * 8 + 4);
      }
#pragma unroll
      for (int j = 0; j < 4; ++j) {
        uint4 z = {0u, 0u, 0u, 0u};
        if (bv[j]) z = *(const uint4*)(bp[j] + ko);
        S.rb[j] = z;
      }
    };
    auto lstore = [&](RSet& S, int s) {
      char* base = lds + s * LDS_STAGE + pr * LDS_ROW + kc * 16;
#pragma unroll
      for (int i = 0; i < 8; ++i) {
        uint4 v = S.ra[i];
        if (MIX) {
          v.x = mix2(S.ra[i].x, S.rp[i].x, S.mx0.x, S.mx0.y);
          v.y = mix2(S.ra[i].y, S.rp[i].y, S.mx0.z, S.mx0.w);
          v.z = mix2(S.ra[i].z, S.rp[i].z, S.mx1.x, S.mx1.y);
          v.w = mix2(S.ra[i].w, S.rp[i].w, S.mx1.z, S.mx1.w);
        }
        *(uint4*)(base + (32 * i) * LDS_ROW) = v;
      }
#pragma unroll
      for (int j = 0; j < 4; ++j) *(uint4*)(base + LDS_A_BYTES + (32 * j) * LDS_ROW) = S.rb[j];
    };
    if constexpr (!MIX) {
      gload(SB, 0);
      if (nk > 1) gload(SA, 1);
      lstore(SB, 0);
      if (nk > 2) gload(SB, 2);
      BAR_SYNC();
#pragma unroll 1
      for (int kt = 0; kt < nk; kt += 2) {
        if (kt + 1 < nk) {
          lstore(SA, 1);
          if (kt + 3 < nk) gload(SA, kt + 3);
        }
        BAR_SYNC();
        if (kt + 1 < nk) {
          if (kt + 2 < nk) {
            lstore(SB, 0);
            if (kt + 4 < nk) gload(SB, kt + 4);
          }
          BAR_SYNC();
        }
      }
    } else {
      gload(SA, 0);
      lstore(SA, 0);
      if (nk > 1) gload(SA, 1);
      BAR_SYNC();
#pragma unroll 1
      for (int kt = 0; kt < nk; ++kt) {
        if (kt + 1 < nk) {
          lstore(SA, (kt + 1) & 1);
          if (kt + 2 < nk) gload(SA, kt + 2);
        }
        BAR_SYNC();
      }
    }
  } else {
    const int wm = w >> 1, wn = w & 1, lr = lane & 15, lg = lane >> 4;
    f32x4 acc[8][4];
#pragma unroll
    for (int i = 0; i < 8; ++i)
#pragma unroll
      for (int j = 0; j < 4; ++j) acc[i][j] = f32x4{0.f, 0.f, 0.f, 0.f};
    BAR_SYNC();
#pragma unroll 1
    for (int kt = 0; kt < nk; ++kt) {
      const char* sa = lds + (kt & 1) * LDS_STAGE + (wm * 128 + lr) * LDS_ROW + lg * 16;
      const char* sb = lds + (kt & 1) * LDS_STAGE + LDS_A_BYTES + (wn * 64 + lr) * LDS_ROW + lg * 16;
      bf16x8 bq[2][4], aq[3];
#pragma unroll
      for (int ni = 0; ni < 4; ++ni) bq[0][ni] = *(const bf16x8*)(sb + ni * 16 * LDS_ROW);
      aq[0] = *(const bf16x8*)(sa);
      aq[1] = *(const bf16x8*)(sa + 16 * LDS_ROW);
#pragma unroll
      for (int ni = 0; ni < 4; ++ni) bq[1][ni] = *(const bf16x8*)(sb + ni * 16 * LDS_ROW + 64);
#pragma unroll
      for (int st = 0; st < 16; ++st) {
        if (st + 2 < 16) aq[(st + 2) % 3] = *(const bf16x8*)(sa + ((st + 2) & 7) * 16 * LDS_ROW + ((st + 2) >> 3) * 64);
#pragma unroll
        for (int ni = 0; ni < 4; ++ni)
          acc[st & 7][ni] = __builtin_amdgcn_mfma_f32_16x16x32_bf16(bq[st >> 3][ni], aq[st % 3], acc[st & 7][ni], 0, 0, 0);
        __builtin_amdgcn_sched_barrier(0);
      }
      BAR_SYNC();
    }
    epi(acc, wm, wn, lr, lg);
  }
}

constexpr int LDS_STAGE2 = 2 * LDS_A_BYTES;
template <class Epi>
__device__ __forceinline__ void gemm_tile256(const u16* __restrict__ A, int lda, const u16* __restrict__ Bt, int ldb, int K, int m0,
                                             int n0, char* lds, bool half, Epi&& epi) {
  int tid = threadIdx.x;
  asm volatile("" : "+v"(tid));
  const int lane = tid & 63, w = __builtin_amdgcn_readfirstlane(tid >> 6);
  const int wm = w >> 2, wn = w & 3, lr = lane & 15, lg = lane >> 4;
  const int nk = K >> 5;
  const int drow = lane >> 2, dch = (lane & 3) ^ ((lane >> 4) & 3);
  const u16* As0 = A + (size_t)(m0 + w * 16 + drow) * lda + dch * 8;
  const u16* As1 = A + (size_t)(m0 + (w + 8) * 16 + drow) * lda + dch * 8;
  const u16* Bs0 = Bt + (size_t)(n0 + w * 16 + drow) * ldb + dch * 8;
  const u16* Bs1 = Bt + (size_t)(n0 + (w + 8) * 16 + drow) * ldb + dch * 8;
  auto dma = [&](int kt, int stg) __attribute__((always_inline)) {
    char* sbase = lds + stg * 32768;
    const int ko = kt * 32;
    __builtin_amdgcn_global_load_lds((const unsigned*)(As0 + ko), (unsigned*)(sbase + w * 1024), 16, 0, 0);
    __builtin_amdgcn_global_load_lds((const unsigned*)(As1 + ko), (unsigned*)(sbase + (w + 8) * 1024), 16, 0, 0);
    __builtin_amdgcn_global_load_lds((const unsigned*)(Bs0 + ko), (unsigned*)(sbase + 16384 + w * 1024), 16, 0, 0);
    __builtin_amdgcn_global_load_lds((const unsigned*)(Bs1 + ko), (unsigned*)(sbase + 16384 + (w + 8) * 1024), 16, 0, 0);
  };
  f32x4 acc[8][4];
#pragma unroll
  for (int i = 0; i < 8; ++i)
#pragma unroll
    for (int j = 0; j < 4; ++j) acc[i][j] = f32x4{0.f, 0.f, 0.f, 0.f};
  const int swz = (lg ^ ((lr >> 2) & 3)) * 16;
  const int aoff = (wm * 128 + lr) * 64 + swz, boff = 16384 + (wn * 64 + lr) * 64 + swz;
  const bool skipm = half && wm == 1;
  dma(0, 0);
  dma(nk > 1 ? 1 : nk - 1, 1);
  dma(nk > 2 ? 2 : nk - 1, 2);
  asm volatile("s_waitcnt vmcnt(8)" ::: "memory");
  BAR_SYNC();
#pragma unroll 1
  for (int kt = 0; kt < nk; ++kt) {
    const char* sa = lds + (kt & 3) * 32768 + aoff;
    const char* sb = lds + (kt & 3) * 32768 + boff;
    bf16x8 bq[4], aq[4];
#pragma unroll
    for (int ni = 0; ni < 4; ++ni) bq[ni] = *(const bf16x8*)(sb + ni * 1024);
    aq[0] = *(const bf16x8*)(sa);
    aq[1] = *(const bf16x8*)(sa + 1024);
    aq[2] = *(const bf16x8*)(sa + 2048);
    dma(kt + 3 < nk ? kt + 3 : nk - 1, (kt + 3) & 3);
    if (!skipm) {
#pragma unroll
      for (int st = 0; st < 8; ++st) {
        if (st + 3 < 8) aq[(st + 3) & 3] = *(const bf16x8*)(sa + (st + 3) * 1024);
#pragma unroll
        for (int ni = 0; ni < 4; ++ni)
          acc[st][ni] = __builtin_amdgcn_mfma_f32_16x16x32_bf16(bq[ni], aq[st & 3], acc[st][ni], 0, 0, 0);
        __builtin_amdgcn_sched_barrier(0);
      }
    }
    asm volatile("s_waitcnt vmcnt(8)" ::: "memory");
    BAR_SYNC();
  }
  asm volatile("s_waitcnt vmcnt(0)" ::: "memory");
  BAR_SYNC();
  epi(acc, wm, wn, lr, lg);
}

#define EPI_FOREACH(acc, ...)                                    \
  _Pragma("unroll") for (int mi = 0; mi < 8; ++mi) {             \
    const int row = m0 + wm * 128 + mi * 16 + lr;                \
    _Pragma("unroll") for (int ni = 0; ni < 4; ++ni) {           \
      const int col0 = n0 + wn * 64 + ni * 16 + lg * 4;          \
      const f32x4 v = acc[mi][ni];                               \
      __VA_ARGS__                                                \
    }                                                            \
    __builtin_amdgcn_sched_barrier(0);                           \
  }
#define EPI_ARGS f32x4(&acc)[8][4], int wm, int wn, int lr, int lg

__device__ __forceinline__ void conv_job(const float* __restrict__ src, u16* __restrict__ dst, int K, int N, int ldk, float* tl, int rot) {
  int tid = threadIdx.x;
  asm volatile("" : "+v"(tid));
  const int tn = N >> 6, nt = (K >> 6) * tn;
  const int G = gridDim.x;
  int t = ((int)blockIdx.x + G - (rot % G)) % G;
  float v[8];
  auto ldtile = [&](int tt) {
    const int k0 = (tt / tn) << 6, n0 = (tt % tn) << 6;
#pragma unroll
    for (int i = 0; i < 8; ++i) {
      const int e = tid + 512 * i;
      v[i] = src[(size_t)(k0 + (e >> 6)) * N + n0 + (e & 63)];
    }
  };
  if (t < nt) ldtile(t);
  while (t < nt) {
    const int k0 = (t / tn) << 6, n0 = (t % tn) << 6;
#pragma unroll
    for (int i = 0; i < 8; ++i) {
      const int e = tid + 512 * i;
      tl[(e >> 6) * 65 + (e & 63)] = v[i];
    }
    const int tnx = t + G;
    if (tnx < nt) ldtile(tnx);
    __syncthreads();
    const int n = tid >> 3, kc = tid & 7;
    float f[8];
#pragma unroll
    for (int j = 0; j < 8; ++j) f[j] = tl[(kc * 8 + j) * 65 + n];
    uint4 o;
    o.x = pack2(f[0], f[1]);
    o.y = pack2(f[2], f[3]);
    o.z = pack2(f[4], f[5]);
    o.w = pack2(f[6], f[7]);
    *(uint4*)(dst + (size_t)(n0 + n) * ldk + k0 + kc * 8) = o;
    __syncthreads();
    t = tnx;
  }
}

__device__ __forceinline__ void phase0(const Params& p, char* lds) {
  float* tl = (float*)lds;
  u16* wt = (u16*)(p.ws + WS_WT);
  u16* adawt = (u16*)(p.ws + S_ADAWT);
  int rot = 0;
#define CJ(SRC, DST, K, N)            \
  conv_job(SRC, DST, K, N, ((K) == 1024 ? LDH : (K) == 4096 ? LDU : (K)), tl, rot);  \
  rot += ((K) >> 6) * ((N) >> 6);
  CJ(p.ada_w, adawt, 1024, 6144)
  CJ(p.ada_w + (size_t)1024 * 6144, adawt + (size_t)6144 * LDH, 1024, 6144)
  CJ(p.rw_wr, wt + WT_WR, 1024, 1024)
  CJ(p.rw_wk, wt + WT_WK, 1024, 1024)
  CJ(p.rw_wv, wt + WT_WV, 1024, 1024)
  CJ(p.rw_wo, wt + WT_WO, 1024, 1024)
  CJ(p.rw_w1, wt + WT_W1, 1024, 64)
  CJ(p.rw_a1, wt + WT_A1, 1024, 64)
  CJ(p.rw_g1, wt + WT_G1, 1024, 128)
  CJ(p.rw_w2, wt + WT_W2, 64, 1024)
  CJ(p.rw_a2, wt + WT_A2, 64, 1024)
  CJ(p.rw_g2, wt + WT_G2, 128, 1024)
  CJ(p.mlp_up, wt + WT_UP0, 1024, 4096)
  CJ(p.mlp_down, wt + WT_DN0, 4096, 1024)
  CJ(p.at_wqkv, wt + WT_QKV, 1024, 1536)
  CJ(p.at_wo, wt + WT_WO1, 1024, 1024)
  CJ(p.mlp_up + (size_t)4 * MEG, wt + WT_UP1, 1024, 4096)
  CJ(p.mlp_down + (size_t)4 * MEG, wt + WT_DN1, 4096, 1024)
#undef CJ
  const int gtid = blockIdx.x * NTHR + threadIdx.x, gsz = gridDim.x * NTHR;
  u16* siluc = (u16*)(p.ws + S_SILUC);
  for (int i = gtid; i < 256 * 1024; i += gsz) {
    int row = i >> 10, col = i & 1023;
    float c = 0.f;
    if (row < 4) c = p.c_prompt[row * 1024 + col];
    else if (row < 132) c = p.c_sample[(row - 4) * 1024 + col];
    siluc[i] = f2bf(c * sigmoidf_(c));
  }
  u16* hs = (u16*)(p.ws + WS_HS);
  for (int i = gtid; i < 128 * 1024; i += gsz) hs[(size_t)(i >> 10) * LDH + (i & 1023)] = f2bf(p.state_shift[i]);
  u16* zr = (u16*)(p.ws + WS_ZR);
  for (int i = gtid; i < LDH; i += gsz) zr[i] = 0;
  float2* tab = (float2*)(p.ws + WS_TAB);
  for (int i = gtid; i < 4097 * 8; i += gsz) {
    int pi = i >> 3, f = i & 7;
    float pos = pi < 4096 ? (float)pi : 8192.f;
    float inv = f == 0 ? 1.0f : f == 1 ? 0.1939227432012558f : f == 2 ? 0.03760603070259094f : f == 3 ? 0.007292664609849453f
              : f == 4 ? 0.0014142135623842478f : f == 5 ? 0.00027424818836152554f : f == 6 ? 5.318296098266728e-05f
              : 1.0313386155758053e-05f;
    float ang = pos * inv;
    double t = (double)ang * 0.15915494309189535;
    t -= rint(t);
    float fr = (float)t;
    tab[i] = make_float2(__builtin_amdgcn_cosf(fr), __builtin_amdgcn_sinf(fr));
  }
}

__device__ __forceinline__ void phase_ada(const Params& p, char* lds) {
  const u16* siluc = (const u16*)(p.ws + S_SILUC);
  const u16* adawt = (const u16*)(p.ws + S_ADAWT);
  float* mod = (float*)(p.ws + WS_MOD);
  for (int t = blockIdx.x; t < 96; t += gridDim.x) {
    const int layer = t / 48, nt = t % 48;
    const int m0 = 0, n0 = nt * 128;
    const float* bias = p.ada_b + layer * 6144;
    float* mo = mod + (size_t)layer * 132 * 6144;
    gemm_tile<false>(siluc, 1024, nullptr, adawt + (size_t)layer * 6144 * LDH, LDH, 6144, 1024, m0, n0, lds, [&](EPI_ARGS) {
      EPI_FOREACH(acc, if (row < 132) {
        const float4 b4 = *(const float4*)(bias + col0);
        *(float4*)(mo + (size_t)row * 6144 + col0) = make_float4(v[0] + b4.x, v[1] + b4.y, v[2] + b4.z, v[3] + b4.w);
      })
    });
  }
}

__device__ __forceinline__ void phase_norm(const Params& p, int layer, int which, bool from_input, bool shift_out) {
  int tid_l = threadIdx.x;
  asm volatile("" : "+v"(tid_l));
  const int lane = tid_l & 63, w = tid_l >> 6;
  const float* mod = (const float*)(p.ws + WS_MOD);
  u16* H = (u16*)(p.ws + WS_H);
  const float* g = (which ? p.norm2_g : p.norm1_g) + layer * 1024;
  const int nw = gridDim.x * 8;
  auto xrow = [&](int row) {
    return from_input ? (row < NP ? p.x_prompt + (size_t)row * 1024 : p.x_sample + (size_t)(row - NP) * 1024)
                      : (const float*)p.out + (size_t)row * 1024;
  };
  float4 gg[4];
#pragma unroll
  for (int i = 0; i < 4; ++i) gg[i] = *(const float4*)(g + lane * 4 + 256 * i);
  int row = blockIdx.x * 8 + w;
  float4 xn[4];
  if (row < MROWS) {
    const float* xr = xrow(row);
#pragma unroll
    for (int i = 0; i < 4; ++i) xn[i] = *(const float4*)(xr + lane * 4 + 256 * i);
  }
  while (row < MROWS) {
    float4 x[4];
#pragma unroll
    for (int i = 0; i < 4; ++i) x[i] = xn[i];
    const int nrow = row + nw;
    if (nrow < MROWS) {
      const float* xr = xrow(nrow);
#pragma unroll
      for (int i = 0; i < 4; ++i) xn[i] = *(const float4*)(xr + lane * 4 + 256 * i);
    }
    const int bi = bidx_of(row);
    const float* mb = mod + ((size_t)layer * 132 + bi) * 6144;
    const float* sh = mb + (which ? 3 : 0) * 1024;
    const float* sc = mb + (which ? 4 : 1) * 1024;
    float4 s4[4], c4[4];
#pragma unroll
    for (int i = 0; i < 4; ++i) {
      s4[i] = *(const float4*)(sh + lane * 4 + 256 * i);
      c4[i] = *(const float4*)(sc + lane * 4 + 256 * i);
    }
    float ss = 0.f;
#pragma unroll
    for (int i = 0; i < 4; ++i) ss += x[i].x * x[i].x + x[i].y * x[i].y + x[i].z * x[i].z + x[i].w * x[i].w;
    ss = wavesum(ss);
    const float rs = rsqrtf(ss * (1.f / 1024.f) + 1e-6f);
    const bool so = shift_out && (row >= NP || (row & 4095) == 4095);
    float* sop = row >= NP ? p.out + O_SHS + (size_t)(row - NP) * 1024 : p.out + O_SHP + (size_t)(row >> 12) * 1024;
#pragma unroll
    for (int i = 0; i < 4; ++i) {
      const int c = lane * 4 + 256 * i;
      float4 h;
      h.x = x[i].x * rs * gg[i].x * (1.f + c4[i].x) + s4[i].x;
      h.y = x[i].y * rs * gg[i].y * (1.f + c4[i].y) + s4[i].y;
      h.z = x[i].z * rs * gg[i].z * (1.f + c4[i].z) + s4[i].z;
      h.w = x[i].w * rs * gg[i].w * (1.f + c4[i].w) + s4[i].w;
      uint2 pk;
      pk.x = pack2(h.x, h.y);
      pk.y = pack2(h.z, h.w);
      *(uint2*)(H + (size_t)row * LDH + c) = pk;
      if (so) *(float4*)(sop + c) = h;
    }
    row = nrow;
  }
}

__device__ __forceinline__ void phase_norm_mix(const Params& p) {
  int tid_l = threadIdx.x;
  asm volatile("" : "+v"(tid_l));
  const int lane = tid_l & 63, w = tid_l >> 6;
  const float* mod = (const float*)(p.ws + WS_MOD);
  u16* H = (u16*)(p.ws + WS_H);
  u16* XR = (u16*)p.out;
  u16* XK = XR + (size_t)MROWS * 1024;
  u16* XV = (u16*)(p.ws + S_EW);
  const float* g = p.norm1_g;
  const int nw = gridDim.x * 8;
  f32x4 gg[4], mr[4], mk[4], mv[4];
#pragma unroll
  for (int i = 0; i < 4; ++i) {
    const int c = lane * 4 + 256 * i;
    gg[i] = *(const f32x4*)(g + c);
    mr[i] = *(const f32x4*)(p.rw_mix + c);
    mk[i] = *(const f32x4*)(p.rw_mix + 2 * 1024 + c);
    mv[i] = *(const f32x4*)(p.rw_mix + 3 * 1024 + c);
  }
  auto xrow = [&](int row) { return row < NP ? p.x_prompt + (size_t)row * 1024 : p.x_sample + (size_t)(row - NP) * 1024; };
  auto hrow = [&](const f32x4 (&x)[4], int row, f32x4 (&h)[4]) __attribute__((always_inline)) {
    float ss = 0.f;
#pragma unroll
    for (int i = 0; i < 4; ++i) ss += x[i][0] * x[i][0] + x[i][1] * x[i][1] + x[i][2] * x[i][2] + x[i][3] * x[i][3];
    ss = wavesum(ss);
    const float rs = rsqrtf(ss * (1.f / 1024.f) + 1e-6f);
    const float* mb = mod + (size_t)bidx_of(row) * 6144;
#pragma unroll
    for (int i = 0; i < 4; ++i) {
      const int c = lane * 4 + 256 * i;
      const f32x4 s4 = *(const f32x4*)(mb + c), c4 = *(const f32x4*)(mb + 1024 + c);
      h[i] = x[i] * rs * gg[i] * (1.f + c4) + s4;
    }
  };
  for (int chunk = blockIdx.x * 8 + w; chunk < MROWS / 8; chunk += nw) {
    const int r0 = chunk * 8;
    f32x4 hp[4], x[4], xn[4];
    if (r0 < NP && (r0 & 4095) != 0) {
      const float* xr = xrow(r0 - 1);
#pragma unroll
      for (int i = 0; i < 4; ++i) x[i] = *(const f32x4*)(xr + lane * 4 + 256 * i);
      hrow(x, r0 - 1, hp);
    } else {
#pragma unroll
      for (int i = 0; i < 4; ++i) hp[i] = f32x4{0.f, 0.f, 0.f, 0.f};
    }
    {
      const float* xr = xrow(r0);
#pragma unroll
      for (int i = 0; i < 4; ++i) xn[i] = *(const f32x4*)(xr + lane * 4 + 256 * i);
    }
#pragma unroll 1
    for (int rr = 0; rr < 8; ++rr) {
      const int row = r0 + rr;
#pragma unroll
      for (int i = 0; i < 4; ++i) x[i] = xn[i];
      if (rr + 1 < 8) {
        const float* xr = xrow(row + 1);
#pragma unroll
        for (int i = 0; i < 4; ++i) xn[i] = *(const f32x4*)(xr + lane * 4 + 256 * i);
      }
      if (row >= NP) {
#pragma unroll
        for (int i = 0; i < 4; ++i) hp[i] = *(const f32x4*)(p.state_shift + (size_t)(row - NP) * 1024 + lane * 4 + 256 * i);
      }
      f32x4 h[4];
      hrow(x, row, h);
      const bool so = row >= NP || (row & 4095) == 4095;
      float* sop = row >= NP ? p.out + O_SHS + (size_t)(row - NP) * 1024 : p.out + O_SHP + (size_t)(row >> 12) * 1024;
#pragma unroll
      for (int i = 0; i < 4; ++i) {
        const int c = lane * 4 + 256 * i;
        *(uint2*)(H + (size_t)row * LDH + c) = pack4(h[i]);
        if (so) *(f32x4*)(sop + c) = h[i];
        const f32x4 dd = hp[i] - h[i];
        *(uint2*)(XR + (size_t)row * 1024 + c) = pack4(h[i] + dd * mr[i]);
        *(uint2*)(XK + (size_t)row * 1024 + c) = pack4(h[i] + dd * mk[i]);
        *(uint2*)(XV + (size_t)row * 1024 + c) = pack4(h[i] + dd * mv[i]);
        hp[i] = h[i];
      }
    }
  }
}

__device__ __forceinline__ void phase_final(const Params& p) {
  int tid_l = threadIdx.x;
  asm volatile("" : "+v"(tid_l));
  const int lane = tid_l & 63, w = tid_l >> 6;
  const int nw = gridDim.x * 8;
  for (int row = blockIdx.x * 8 + w; row < MROWS; row += nw) {
    float* xr = p.out + (size_t)row * 1024;
    float4 x[4];
    float ss = 0.f;
#pragma unroll
    for (int i = 0; i < 4; ++i) {
      x[i] = *(const float4*)(xr + lane * 4 + 256 * i);
      ss += x[i].x * x[i].x + x[i].y * x[i].y + x[i].z * x[i].z + x[i].w * x[i].w;
    }
    ss = wavesum(ss);
    const float rs = rsqrtf(ss * (1.f / 1024.f) + 1e-6f);
#pragma unroll
    for (int i = 0; i < 4; ++i) {
      const int c = lane * 4 + 256 * i;
      float4 gg = *(const float4*)(p.final_g + c);
      float4 h;
      h.x = x[i].x * rs * gg.x;
      h.y = x[i].y * rs * gg.y;
      h.z = x[i].z * rs * gg.z;
      h.w = x[i].w * rs * gg.w;
      *(float4*)(xr + c) = h;
    }
  }
}

__device__ __forceinline__ void phase_rwkv_proj(const Params& p, char* lds) {
  const u16* H = (const u16*)(p.ws + WS_H);
  const u16* wt = (const u16*)(p.ws + WS_WT);
  const u16* XR = (const u16*)p.out;
  const u16* XK = XR + (size_t)MROWS * 1024;
  const u16* XV = (const u16*)(p.ws + S_EW);
  u16* R = (u16*)(p.ws + S_R);
  u16* Kk = (u16*)(p.ws + S_K);
  u16* V = (u16*)(p.ws + S_V);
  u16* WH = (u16*)(p.ws + S_WH);
  u16* AH = (u16*)(p.ws + S_AH);
  u16* GH = (u16*)(p.ws + S_GH);
  for (int u = blockIdx.x; u < 780 + 195; u += gridDim.x) {
    if (u < 780) {
      const int kind = u / 260, t = u - kind * 260;
      const int mt = t >> 2, nt = t & 3;
      const int m0 = mt * 256, n0 = nt * 256;
      const u16* A = kind == 2 ? XV : XR + (size_t)kind * ((size_t)MROWS * 1024);
      const u16* Bt = wt + WT_WR + (size_t)kind * (1024 * LDH);
      u16* dst = R + (size_t)kind * (RSZ / 2);
      gemm_tile256(A, 1024, Bt, LDH, 1024, m0, n0, lds, mt == 64, [&](EPI_ARGS) {
        EPI_FOREACH(acc, if (row < MROWS) *(uint2*)(dst + (size_t)row * 1024 + col0) = pack4(v);)
      });
    } else {
      const int s_ = u - 780;
      const int mt = s_ / 3, kind = 3 + (s_ - mt * 3);
      const int m0 = mt * 256, n0 = 0;
      const int N = kind == 5 ? 128 : 64, mixi = kind == 3 ? 1 : kind;
      const u16* Bt = wt + WT_W1 + (size_t)(kind - 3) * (64 * LDH);
      gemm_tile<true>(H, LDH, p.rw_mix + mixi * 1024, Bt, LDH, N, 1024, m0, n0, lds, [&](EPI_ARGS) {
        u16* dst = WH + (size_t)(kind - 3) * ((size_t)MPAD * 64);
        const int ld = kind == 5 ? 128 : 64;
        EPI_FOREACH(acc, if (row < MROWS && col0 < ld) {
          f32x4 o = v;
          if (kind == 3) {
            _Pragma("unroll") for (int q = 0; q < 4; ++q) o[q] = 1.f - 2.f / (__expf(2.f * v[q]) + 1.f);
          } else if (kind == 5) {
            _Pragma("unroll") for (int q = 0; q < 4; ++q) o[q] = sigmoidf_(v[q]);
          }
          *(uint2*)(dst + (size_t)row * ld + col0) = pack4(o);
        })
      });
    }
  }
}

__device__ __forceinline__ void phase_rwkv_lora2(const Params& p, char* lds) {
  {
    const int gtid = blockIdx.x * NTHR + threadIdx.x, gsz = gridDim.x * NTHR;
    for (int i = gtid; i < 128 * 256; i += gsz) ((float4*)(p.out + (size_t)NP * 1024))[i] = ((const float4*)p.x_sample)[i];
  }
  const u16* wt = (const u16*)(p.ws + WS_WT);
  const u16* WH = (const u16*)(p.ws + S_WH);
  const u16* AH = (const u16*)(p.ws + S_AH);
  u16* EW = (u16*)(p.ws + S_EW);
  u16* Aa = (u16*)(p.ws + S_A);
  for (int t = blockIdx.x; t < 65 * 8; t += gridDim.x) {
    const int mt = t >> 3, j = t & 7;
    const int m0 = mt * 256, n0 = (j & 3) * 256;
    const bool isw = j < 4;
    gemm_tile256(isw ? WH : AH, 64, wt + (isw ? WT_W2 : WT_A2), 64, 64, m0, n0, lds, mt == 64, [&](EPI_ARGS) {
      const float* b0 = isw ? p.rw_w0 : p.rw_a0;
      EPI_FOREACH(acc, if (row < MROWS) {
        const float4 b4 = *(const float4*)(b0 + col0);
        const float s0 = sigmoidf_(v[0] + b4.x), s1 = sigmoidf_(v[1] + b4.y), s2 = sigmoidf_(v[2] + b4.z), s3 = sigmoidf_(v[3] + b4.w);
        if (isw) {
          const float c = 0.6065306597126334f;
          uint2 o;
          o.x = (unsigned)f2h(c * s0) | ((unsigned)f2h(c * s1) << 16);
          o.y = (unsigned)f2h(c * s2) | ((unsigned)f2h(c * s3) << 16);
          *(uint2*)(EW + (size_t)row * 1024 + col0) = o;
        } else {
          uint2 o;
          o.x = pack2(s0, s1);
          o.y = pack2(s2, s3);
          *(uint2*)(Aa + (size_t)row * 1024 + col0) = o;
        }
      })
    });
  }
}

__device__ __forceinline__ float fma_(float a, float b, float c) {
  float r;
  asm("v_fma_f32 %0, %1, %2, %3" : "=v"(r) : "v"(a), "v"(b), "v"(c));
  return r;
}
__device__ __forceinline__ float mul_(float a, float b) {
  float r;
  asm("v_mul_f32 %0, %1, %2" : "=v"(r) : "v"(a), "v"(b));
  return r;
}

constexpr int PAIR_TS = 624;
constexpr int PAIR_BUF = 8 * PAIR_TS;

__device__ __forceinline__ void phase_scan(const Params& p, char* lds) {
  int tid_l = threadIdx.x;
  asm volatile("" : "+v"(tid_l));
  const int tid = tid_l, lane = tid & 63, w = tid >> 6;
  const u16* R = (const u16*)(p.ws + S_R);
  const u16* Kk = (const u16*)(p.ws + S_K);
  const u16* V = (const u16*)(p.ws + S_V);
  const u16* EW = (const u16*)(p.ws + S_EW);
  const u16* Aa = (const u16*)(p.ws + S_A);
  u16* Y = (u16*)(p.ws + WS_H);
  float* RK = (float*)(p.ws + WS_RK);
  float* ring = (float*)lds;
  float* ybuf = (float*)(lds + 2 * PAIR_BUF * 4);
  for (int item = blockIdx.x; item < 256; item += gridDim.x) {
    const int chain = item >> 2, qr = item & 3, b = chain >> 4, h = chain & 15;
    const size_t rowbase = (size_t)b * 4096;
    __syncthreads();
    if (tid >= 256) {
      const int pt = tid - 256, grp = pt >> 7, pair = (pt & 127) >> 4, cq = pt & 15;
      const int ch = h * 64 + cq * 4;
      const float4 kk4 = *(const float4*)(p.rw_kk + ch), ka4 = *(const float4*)(p.rw_ka + ch), rk4 = *(const float4*)(p.rw_rk + ch);
      struct PS {
        uint2 rr[2], rk_[2], rv[2], ra_[2], re[2];
      };
      PS S0, S1;
      auto pload = [&](PS& S, int c) __attribute__((always_inline)) {
#pragma unroll
        for (int q = 0; q < 2; ++q) {
          const size_t off = (rowbase + (size_t)c * 16 + pair * 2 + q) * 1024 + ch;
          S.rr[q] = *(const uint2*)(R + off);
          S.rk_[q] = *(const uint2*)(Kk + off);
          S.rv[q] = *(const uint2*)(V + off);
          S.ra_[q] = *(const uint2*)(Aa + off);
          S.re[q] = *(const uint2*)(EW + off);
        }
      };
      auto pproc = [&](PS& S, int c) __attribute__((always_inline)) {
        const float kkw[4] = {kk4.x, kk4.y, kk4.z, kk4.w}, kaw[4] = {ka4.x, ka4.y, ka4.z, ka4.w}, rkw[4] = {rk4.x, rk4.y, rk4.z, rk4.w};
        float am[2][4], dc[2][4], bm[2][4], kp[2][4], rf[2][4], vf[2][4];
#pragma unroll
        for (int q = 0; q < 2; ++q) {
          const uint2 rr = S.rr[q], rk_ = S.rk_[q], rv = S.rv[q], ra_ = S.ra_[q], re = S.re[q];
          const float rfx[4] = {bflo(rr.x), bfhi(rr.x), bflo(rr.y), bfhi(rr.y)};
          const float kf[4] = {bflo(rk_.x), bfhi(rk_.x), bflo(rk_.y), bfhi(rk_.y)};
          const float vfx[4] = {bflo(rv.x), bfhi(rv.x), bflo(rv.y), bfhi(rv.y)};
          const float af[4] = {bflo(ra_.x), bfhi(ra_.x), bflo(ra_.y), bfhi(ra_.y)};
          const float ef[4] = {h2f((u16)(re.x & 0xffff)), h2f((u16)(re.x >> 16)), h2f((u16)(re.y & 0xffff)), h2f((u16)(re.y >> 16))};
          float kkr[4], ss = 0.f, rks = 0.f;
#pragma unroll
          for (int j = 0; j < 4; ++j) {
            kkr[j] = kf[j] * kkw[j];
            ss += kkr[j] * kkr[j];
            kp[q][j] = kf[j] * (1.f + (af[j] - 1.f) * kaw[j]);
            rks += rfx[j] * kp[q][j] * rkw[j];
            rf[q][j] = rfx[j];
            vf[q][j] = vfx[j];
          }
          ss = rowsum16(ss);
          rks = rowsum16(rks);
          const float inv = 1.f / fmaxf(sqrtf(ss), 1e-12f);
#pragma unroll
          for (int j = 0; j < 4; ++j) {
            am[q][j] = -kkr[j] * inv;
            dc[q][j] = __expf(-ef[j]);
            bm[q][j] = kkr[j] * inv * af[j];
          }
          if (cq == 0 && qr == 0) RK[(rowbase + (size_t)c * 16 + pair * 2 + q) * 16 + h] = rks;
        }
        float aw[4], w12[4], b1w[4], k1w[4], wr1[4], wr2[4];
        float cba = 0.f, cka = 0.f, br1 = 0.f, kr1 = 0.f, br12 = 0.f, kr12 = 0.f, br2 = 0.f, kr2 = 0.f;
#pragma unroll
        for (int j = 0; j < 4; ++j) {
          aw[j] = dc[0][j] * am[1][j];
          w12[j] = dc[0][j] * dc[1][j];
          b1w[j] = bm[0][j] * dc[1][j];
          k1w[j] = kp[0][j] * dc[1][j];
          wr1[j] = dc[0][j] * rf[0][j];
          wr2[j] = w12[j] * rf[1][j];
          cba += bm[0][j] * am[1][j];
          cka += kp[0][j] * am[1][j];
          br1 += bm[0][j] * rf[0][j];
          kr1 += kp[0][j] * rf[0][j];
          br12 += b1w[j] * rf[1][j];
          kr12 += k1w[j] * rf[1][j];
          br2 += bm[1][j] * rf[1][j];
          kr2 += kp[1][j] * rf[1][j];
        }
        cba = rowsum16(cba);
        cka = rowsum16(cka);
        br1 = rowsum16(br1);
        kr1 = rowsum16(kr1);
        br12 = rowsum16(br12);
        kr12 = rowsum16(kr12);
        br2 = rowsum16(br2);
        kr2 = rowsum16(kr2);
        float* slot = ring + (c & 1) * PAIR_BUF + pair * PAIR_TS;
        *(float4*)(slot + cq * 4) = make_float4(am[0][0], am[0][1], am[0][2], am[0][3]);
        *(float4*)(slot + 64 + cq * 4) = make_float4(aw[0], aw[1], aw[2], aw[3]);
        *(float4*)(slot + 128 + cq * 4) = make_float4(w12[0], w12[1], w12[2], w12[3]);
        *(float4*)(slot + 192 + cq * 4) = make_float4(b1w[0], b1w[1], b1w[2], b1w[3]);
        *(float4*)(slot + 256 + cq * 4) = make_float4(k1w[0], k1w[1], k1w[2], k1w[3]);
        *(float4*)(slot + 320 + cq * 4) = make_float4(bm[1][0], bm[1][1], bm[1][2], bm[1][3]);
        *(float4*)(slot + 384 + cq * 4) = make_float4(kp[1][0], kp[1][1], kp[1][2], kp[1][3]);
        *(float4*)(slot + 448 + cq * 4) = make_float4(wr1[0], wr1[1], wr1[2], wr1[3]);
        *(float4*)(slot + 512 + cq * 4) = make_float4(wr2[0], wr2[1], wr2[2], wr2[3]);
        if ((cq >> 2) == qr) {
          *(float4*)(slot + 576 + (cq & 3) * 4) = make_float4(vf[0][0], vf[0][1], vf[0][2], vf[0][3]);
          *(float4*)(slot + 592 + (cq & 3) * 4) = make_float4(vf[1][0], vf[1][1], vf[1][2], vf[1][3]);
        }
        if (cq == 0) {
          *(float4*)(slot + 608) = make_float4(cba, cka, 0.0625f * br1, 0.0625f * kr1);
          *(float4*)(slot + 612) = make_float4(0.0625f * br12, 0.0625f * kr12, 0.0625f * br2, 0.0625f * kr2);
        }
      };
      auto pflush = [&](int cf) __attribute__((always_inline)) {
#pragma unroll
        for (int k2 = 0; k2 < 2; ++k2) {
          const int vi = (pt & 127) + 128 * k2;
          const float4* yp = (const float4*)(ybuf + (cf & 1) * 4096 + vi * 16);
          const float4 y0 = yp[0], y1 = yp[1], y2 = yp[2], y3 = yp[3];
          const float yv = ((y0.x + y0.y) + (y0.z + y0.w)) + ((y1.x + y1.y) + (y1.z + y1.w)) + ((y2.x + y2.y) + (y2.z + y2.w)) + ((y3.x + y3.y) + (y3.z + y3.w));
          Y[(rowbase + (size_t)cf * 16 + (vi >> 4)) * LDH + h * 64 + qr * 16 + (vi & 15)] = f2bf(yv);
        }
      };
      if (grp == 0) {
        pload(S0, 0);
        pproc(S0, 0);
        pload(S1, 2);
        pload(S0, 4);
      } else {
        pload(S0, 1);
        pload(S1, 3);
      }
      BAR_SYNC();
#pragma unroll 1
      for (int c = 0; c < 256; c += 4) {
        if (grp == 1) {
          pproc(S0, c + 1);
          if (c + 5 < 256) pload(S0, c + 5);
        } else if (c > 0) {
          pflush(c - 1);
        }
        BAR_SYNC();
        if (grp == 0) {
          pproc(S1, c + 2);
          if (c + 6 < 256) pload(S1, c + 6);
        } else {
          pflush(c);
        }
        BAR_SYNC();
        if (grp == 1) {
          pproc(S1, c + 3);
          if (c + 7 < 256) pload(S1, c + 7);
        } else {
          pflush(c + 1);
        }
        BAR_SYNC();
        if (grp == 0) {
          if (c + 4 < 256) pproc(S0, c + 4);
          if (c + 8 < 256) pload(S0, c + 8);
        } else {
          pflush(c + 2);
        }
        BAR_SYNC();
      }
    } else {
      const int rl = tid >> 4, cgp = tid & 15;
      float s0 = 0.f, s1 = 0.f, s2 = 0.f, s3 = 0.f;
      BAR_SYNC();
      for (int c = 0; c < 256; ++c) {
        const float* bufp = ring + (c & 1) * PAIR_BUF;
        float* yb = ybuf + (c & 1) * 4096;
        struct PV {
          float4 a1, aw, w12, b1w, k1w, b2, k2, wr1, wr2, sc0, sc1;
          float v1, v2;
        };
        auto ldpair = [&](const float* slot) __attribute__((always_inline)) {
          PV r;
          r.a1 = *(const float4*)(slot + cgp * 4);
          r.aw = *(const float4*)(slot + 64 + cgp * 4);
          r.w12 = *(const float4*)(slot + 128 + cgp * 4);
          r.b1w = *(const float4*)(slot + 192 + cgp * 4);
          r.k1w = *(const float4*)(slot + 256 + cgp * 4);
          r.b2 = *(const float4*)(slot + 320 + cgp * 4);
          r.k2 = *(const float4*)(slot + 384 + cgp * 4);
          r.wr1 = *(const float4*)(slot + 448 + cgp * 4);
          r.wr2 = *(const float4*)(slot + 512 + cgp * 4);
          r.v1 = slot[576 + rl];
          r.v2 = slot[592 + rl];
          r.sc0 = *(const float4*)(slot + 608);
          r.sc1 = *(const float4*)(slot + 612);
          return r;
        };
        PV cur = ldpair(bufp);
#pragma unroll
        for (int pr = 0; pr < 8; ++pr) {
          PV nxt = cur;
          if (pr + 1 < 8) nxt = ldpair(bufp + (pr + 1) * PAIR_TS);
          float d1 = fma_(s3, cur.a1.w, fma_(s2, cur.a1.z, fma_(s1, cur.a1.y, mul_(s0, cur.a1.x))));
          float d2 = fma_(s3, cur.aw.w, fma_(s2, cur.aw.z, fma_(s1, cur.aw.y, mul_(s0, cur.aw.x))));
          const float e1 = fma_(s3, cur.wr1.w, fma_(s2, cur.wr1.z, fma_(s1, cur.wr1.y, mul_(s0, cur.wr1.x))));
          const float e2 = fma_(s3, cur.wr2.w, fma_(s2, cur.wr2.z, fma_(s1, cur.wr2.y, mul_(s0, cur.wr2.x))));
          const float t0 = fma_(cur.v2, cur.k2.x, fma_(cur.v1, cur.k1w.x, mul_(s0, cur.w12.x)));
          const float t1 = fma_(cur.v2, cur.k2.y, fma_(cur.v1, cur.k1w.y, mul_(s1, cur.w12.y)));
          const float t2 = fma_(cur.v2, cur.k2.z, fma_(cur.v1, cur.k1w.z, mul_(s2, cur.w12.z)));
          const float t3 = fma_(cur.v2, cur.k2.w, fma_(cur.v1, cur.k1w.w, mul_(s3, cur.w12.w)));
          d1 = rowsum16(d1);
          d2 = rowsum16(d2);
          const float sa1 = d1;
          const float sa2 = fma_(cur.v1, cur.sc0.y, fma_(sa1, cur.sc0.x, d2));
          s0 = fma_(sa2, cur.b2.x, fma_(sa1, cur.b1w.x, t0));
          s1 = fma_(sa2, cur.b2.y, fma_(sa1, cur.b1w.y, t1));
          s2 = fma_(sa2, cur.b2.z, fma_(sa1, cur.b1w.z, t2));
          s3 = fma_(sa2, cur.b2.w, fma_(sa1, cur.b1w.w, t3));
          yb[(2 * pr) * 256 + tid] = fma_(sa1, cur.sc0.z, fma_(cur.v1, cur.sc0.w, e1));
          yb[(2 * pr + 1) * 256 + tid] = fma_(sa1, cur.sc1.x, fma_(cur.v1, cur.sc1.y, fma_(sa2, cur.sc1.z, fma_(cur.v2, cur.sc1.w, e2))));
          cur = nxt;
        }
        BAR_SYNC();
      }
      {
        const float4* yp = (const float4*)(ybuf + (255 & 1) * 4096 + tid * 16);
        const float4 y0 = yp[0], y1 = yp[1], y2 = yp[2], y3 = yp[3];
        const float yv = ((y0.x + y0.y) + (y0.z + y0.w)) + ((y1.x + y1.y) + (y1.z + y1.w)) + ((y2.x + y2.y) + (y2.z + y2.w)) + ((y3.x + y3.y) + (y3.z + y3.w));
        Y[(rowbase + (size_t)255 * 16 + rl) * LDH + h * 64 + qr * 16 + cgp] = f2bf(yv);
      }
      float* wo = p.out + O_WKVP + (((size_t)(b * 16 + h) * 64) + qr * 16 + rl) * 64 + cgp * 4;
      *(float4*)wo = make_float4(s0, s1, s2, s3);
    }
  }
  float* sl = (float*)lds;
  for (int chain = blockIdx.x; chain < 2048; chain += gridDim.x) {
    const int b = chain >> 4, h = chain & 15;
    const size_t row = (size_t)NP + b;
    __syncthreads();
    if (w == 0) {
      const int ch = h * 64 + lane;
      const size_t off = row * 1024 + ch;
      const float rf = bf2f(R[off]), kf = bf2f(Kk[off]), vf = bf2f(V[off]), af = bf2f(Aa[off]), ef = h2f(EW[off]);
      const float kkr = kf * p.rw_kk[ch];
      const float ss = wavesum(kkr * kkr);
      const float inv = 1.f / fmaxf(sqrtf(ss), 1e-12f);
      const float kp = kf * (1.f + (af - 1.f) * p.rw_ka[ch]);
      const float rks = wavesum(rf * kp * p.rw_rk[ch]);
      sl[lane] = -kkr * inv;
      sl[64 + lane] = __expf(-ef);
      sl[128 + lane] = kkr * inv * af;
      sl[192 + lane] = kp;
      sl[256 + lane] = rf;
      sl[320 + lane] = vf;
      if (lane == 0) RK[row * 16 + h] = rks;
    }
    __syncthreads();
    const int i = tid >> 3, c8 = tid & 7;
    const float* sp = p.state_wkv + (((size_t)(b * 16 + h) * 64) + i) * 64 + c8 * 8;
    float4 sA = *(const float4*)sp, sB = *(const float4*)(sp + 4);
    float s[8] = {sA.x, sA.y, sA.z, sA.w, sB.x, sB.y, sB.z, sB.w};
    float sa = 0.f;
#pragma unroll
    for (int j = 0; j < 8; ++j) sa += s[j] * sl[c8 * 8 + j];
    sa += __shfl_xor(sa, 1);
    sa += __shfl_xor(sa, 2);
    sa += __shfl_xor(sa, 4);
    const float vv = sl[320 + i];
    float y = 0.f;
#pragma unroll
    for (int j = 0; j < 8; ++j) {
      const int cj = c8 * 8 + j;
      s[j] = s[j] * sl[64 + cj] + sa * sl[128 + cj] + vv * sl[192 + cj];
      y += s[j] * sl[256 + cj];
    }
    y += __shfl_xor(y, 1);
    y += __shfl_xor(y, 2);
    y += __shfl_xor(y, 4);
    float* wo = p.out + O_WKVS + (((size_t)(b * 16 + h) * 64) + i) * 64 + c8 * 8;
    *(float4*)wo = make_float4(s[0], s[1], s[2], s[3]);
    *(float4*)(wo + 4) = make_float4(s[4], s[5], s[6], s[7]);
    if (c8 == 0) Y[row * LDH + h * 64 + i] = f2bf(y);
  }
}

__device__ __forceinline__ void phase_gate(const Params& p, char* lds) {
  const u16* wt = (const u16*)(p.ws + WS_WT);
  const u16* GH = (const u16*)(p.ws + S_GH);
  const u16* V = (const u16*)(p.ws + S_V);
  const float* RK = (const float*)(p.ws + WS_RK);
  u16* Y = (u16*)(p.ws + WS_H);
  for (int t = blockIdx.x; t < 65 * 4; t += gridDim.x) {
    const int mt = t >> 2, nt = t & 3;
    const int m0 = mt * 256, n0 = nt * 256;
    gemm_tile256(GH, 128, wt + WT_G2, 128, 128, m0, n0, lds, mt == 64, [&](EPI_ARGS) {
      const int hh = (n0 + wn * 64) >> 6;
#pragma unroll
      for (int mi = 0; mi < 8; ++mi) {
        const int row = m0 + wm * 128 + mi * 16 + lr;
        const int rowc = row < MROWS ? row : MROWS - 1;
        float yv[4][4];
        float sum = 0.f;
#pragma unroll
        for (int ni = 0; ni < 4; ++ni) {
          const uint2 yy = *(const uint2*)(Y + (size_t)rowc * LDH + hh * 64 + ni * 16 + lg * 4);
          yv[ni][0] = bflo(yy.x); yv[ni][1] = bfhi(yy.x); yv[ni][2] = bflo(yy.y); yv[ni][3] = bfhi(yy.y);
          sum += yv[ni][0] + yv[ni][1] + yv[ni][2] + yv[ni][3];
        }
        sum += __shfl_xor(sum, 16);
        sum += __shfl_xor(sum, 32);
        const float mu = sum * (1.f / 64.f);
        float vs = 0.f;
#pragma unroll
        for (int ni = 0; ni < 4; ++ni)
#pragma unroll
          for (int q = 0; q < 4; ++q) {
            const float d = yv[ni][q] - mu;
            vs += d * d;
          }
        vs += __shfl_xor(vs, 16);
        vs += __shfl_xor(vs, 32);
        const float rstd = rsqrtf(vs * (1.f / 64.f) + 64e-5f);
        const float rk = RK[(size_t)rowc * 16 + hh];
#pragma unroll
        for (int ni = 0; ni < 4; ++ni) {
          const int col0 = hh * 64 + ni * 16 + lg * 4;
          const uint2 vv = *(const uint2*)(V + (size_t)rowc * 1024 + col0);
          const float vf[4] = {bflo(vv.x), bfhi(vv.x), bflo(vv.y), bfhi(vv.y)};
          const float4 g4 = *(const float4*)(p.rw_lnx_g + col0), b4 = *(const float4*)(p.rw_lnx_b + col0);
          const float gg[4] = {g4.x, g4.y, g4.z, g4.w}, bb[4] = {b4.x, b4.y, b4.z, b4.w};
          f32x4 o;
#pragma unroll
          for (int q = 0; q < 4; ++q) o[q] = ((yv[ni][q] - mu) * rstd * gg[q] + bb[q] + rk * vf[q]) * acc[mi][ni][q];
          if (row < MROWS) *(uint2*)(Y + (size_t)row * LDH + col0) = pack4(o);
        }
        __builtin_amdgcn_sched_barrier(0);
      }
    });
  }
}

__device__ __forceinline__ void phase_oproj(const Params& p, char* lds, const u16* A, int K, const u16* Bt, int layer, int gidx, bool first) {
  const int ldab = K == 1024 ? LDH : LDU;
  const float* mod = (const float*)(p.ws + WS_MOD);
  for (int u = blockIdx.x; u < 320; u += gridDim.x) {
    const bool split = u >= 256;
    const int s = u - 256;
    const int m0 = split ? NP : (u >> 2) * 256, n0 = (split ? (s & 3) : (u & 3)) * 256;
    const int klen = split ? (K >> 4) : K, kbeg = split ? (s >> 2) * klen : 0;
    gemm_tile256(A + kbeg, ldab, Bt + kbeg, ldab, klen, m0, n0, lds, split, [&](EPI_ARGS) {
      EPI_FOREACH(acc, if (row < MROWS) {
        const float4 gt = *(const float4*)(mod + ((size_t)layer * 132 + bidx_of(row)) * 6144 + gidx * 1024 + col0);
        float* xp = p.out + (size_t)row * 1024 + col0;
        if (split) {
          unsafeAtomicAdd(xp + 0, gt.x * v[0]);
          unsafeAtomicAdd(xp + 1, gt.y * v[1]);
          unsafeAtomicAdd(xp + 2, gt.z * v[2]);
          unsafeAtomicAdd(xp + 3, gt.w * v[3]);
        } else {
          const float* xi = first ? p.x_prompt + (size_t)row * 1024 + col0 : xp;
          const float4 xo = *(const float4*)xi;
          *(float4*)xp = make_float4(xo.x + gt.x * v[0], xo.y + gt.y * v[1], xo.z + gt.z * v[2], xo.w + gt.w * v[3]);
        }
      })
    });
  }
}

__device__ __forceinline__ void phase_up(const Params& p, char* lds, const u16* Bt) {
  const u16* H = (const u16*)(p.ws + WS_H);
  u16* UP = (u16*)(p.ws + S_UP);
  for (int t = blockIdx.x; t < 65 * 16; t += gridDim.x) {
    const int mt = t >> 4, nt = t & 15;
    const int m0 = mt * 256, n0 = nt * 256;
    gemm_tile256(H, LDH, Bt, LDH, 1024, m0, n0, lds, mt == 64, [&](EPI_ARGS) {
      EPI_FOREACH(acc, if (row < MROWS) {
        f32x4 o;
        _Pragma("unroll") for (int q = 0; q < 4; ++q) {
          const float rl = fmaxf(v[q], 0.f);
          o[q] = rl * rl;
        }
        *(uint2*)(UP + (size_t)row * LDU + col0) = pack4(o);
      })
    });
  }
}

__device__ __forceinline__ void phase_qkv(const Params& p, char* lds) {
  const u16* H = (const u16*)(p.ws + WS_H);
  const u16* wt = (const u16*)(p.ws + WS_WT);
  const float* tab = (const float*)(p.ws + WS_TAB);
  u16* Qb = (u16*)(p.ws + S_Q);
  u16* Kb = (u16*)(p.ws + S_KB);
  u16* Vt = (u16*)(p.ws + S_VT);
  for (int t = blockIdx.x; t < 65 * 6; t += gridDim.x) {
    const int mt = t / 6, nt = t % 6;
    const int m0 = mt * 256, n0 = nt * 256;
    gemm_tile256(H, LDH, wt + WT_QKV, LDH, 1024, m0, n0, lds, mt == 64, [&](EPI_ARGS) {
      const int hc0 = n0 + wn * 64;
#pragma unroll
      for (int mi = 0; mi < 8; ++mi) {
        const int row = m0 + wm * 128 + mi * 16 + lr;
        const bool valid = row < MROWS;
        const bool isp = row < NP;
        const int pos = row & 4095;
        const int bq = isp ? (row >> 12) : (row - NP);
        const int posidx = isp ? pos : 4096;
#pragma unroll
        for (int ni = 0; ni < 4; ++ni) {
          const int col0 = hc0 + ni * 16 + lg * 4;
          const float4 b4 = *(const float4*)(p.at_bqkv + col0);
          f32x4 v = acc[mi][ni];
          v[0] += b4.x; v[1] += b4.y; v[2] += b4.z; v[3] += b4.w;
          if (ni == 0 && hc0 < 1280) {
            const float* tp = tab + (size_t)posidx * 16 + (lg & 1) * 8;
            const float4 t0 = *(const float4*)tp, t1 = *(const float4*)(tp + 4);
            const float cs[4] = {t0.x, t0.z, t1.x, t1.z}, sn[4] = {t0.y, t0.w, t1.y, t1.w};
#pragma unroll
            for (int q = 0; q < 4; ++q) {
              const float pv = __shfl_xor(v[q], 32);
              v[q] = (lg < 2) ? (v[q] * cs[q] - pv * sn[q]) : (v[q] * cs[q] + pv * sn[q]);
            }
          }
          if (valid) {
            if (hc0 < 1024) {
              *(uint2*)(Qb + (size_t)row * 1024 + col0) = pack4(v);
            } else if (hc0 < 1280) {
              const int c2 = col0 - 1024;
              *(uint2*)(Kb + (size_t)row * 256 + c2) = pack4(v);
              if (isp) {
                if (pos >= 3968) *(float4*)(p.out + O_KP + ((size_t)(bq * 128 + pos - 3968)) * 256 + c2) = make_float4(v[0], v[1], v[2], v[3]);
              } else {
                *(float4*)(p.out + O_KS + ((size_t)(bq * 128 + 127)) * 256 + c2) = make_float4(v[0], v[1], v[2], v[3]);
              }
            } else {
              const int c3 = col0 - 1280;
              if (isp) {
                u16* vp = Vt + ((size_t)(bq * 4 + (c3 >> 6)) * 64 + (c3 & 63)) * 4096 + pos;
#pragma unroll
                for (int q = 0; q < 4; ++q) vp[(size_t)q * 4096] = f2bf(v[q]);
                if (pos >= 3968) *(float4*)(p.out + O_VP + ((size_t)(bq * 128 + pos - 3968)) * 256 + c3) = make_float4(v[0], v[1], v[2], v[3]);
              } else {
                *(float4*)(p.out + O_VS + ((size_t)(bq * 128 + 127)) * 256 + c3) = make_float4(v[0], v[1], v[2], v[3]);
              }
            }
          }
        }
        __builtin_amdgcn_sched_barrier(0);
      }
    });
  }
}

constexpr int AT_KS = 0, AT_VS = 36864, AT_PS = 36864 + 35840, AT_PW = 5376;

__device__ __forceinline__ void phase_attn(const Params& p, char* lds) {
  int tid_l = threadIdx.x;
  asm volatile("" : "+v"(tid_l));
  const int tid = tid_l, lane = tid & 63, w = tid >> 6, lr = lane & 15, lg = lane >> 4;
  const u16* Qb = (const u16*)(p.ws + S_Q);
  const u16* Kb = (const u16*)(p.ws + S_KB);
  const u16* Vt = (const u16*)(p.ws + S_VT);
  u16* O = (u16*)(p.ws + S_O);
  char* Ks = lds + AT_KS;
  char* Vs = lds + AT_VS;
  char* Ps = lds + AT_PS + w * AT_PW;
  for (int u = blockIdx.x; u < 512; u += gridDim.x) {
    const int b = u >> 7, n = (u >> 2) & 31, kvh = u & 3;
    bf16x8 qfa[4][2];
    {
      const int g_ = w >> 1, hf_ = w & 1, qh_ = kvh * 4 + g_;
#pragma unroll
      for (int i = 0; i < 4; ++i) {
        const size_t tok = (size_t)b * 4096 + n * 128 + hf_ * 64 + i * 16 + lr;
        qfa[i][0] = *(const bf16x8*)(Qb + tok * 1024 + qh_ * 64 + lg * 8);
        qfa[i][1] = *(const bf16x8*)(Qb + tok * 1024 + qh_ * 64 + 32 + lg * 8);
      }
    }
    __syncthreads();
#pragma unroll
    for (int i = 0; i < 4; ++i) {
      const int c = tid + 512 * i;
      {
        const int key = c >> 3, kc = c & 7;
        const int pos = n * 128 - 128 + key;
        uint4 v = {0u, 0u, 0u, 0u};
        if (pos >= 0) v = *(const uint4*)(Kb + ((size_t)b * 4096 + pos) * 256 + kvh * 64 + kc * 8);
        *(uint4*)(Ks + key * 144 + kc * 16) = v;
      }
      {
        const int d = c >> 5, kc = c & 31;
        const int pos0 = n * 128 - 128 + kc * 8;
        uint4 v = {0u, 0u, 0u, 0u};
        if (pos0 >= 0) v = *(const uint4*)(Vt + ((size_t)(b * 4 + kvh) * 64 + d) * 4096 + pos0);
        *(uint4*)(Vs + d * 560 + kc * 16) = v;
      }
    }
    if (tid < 192) {
      const int d = tid / 3, c = tid % 3;
      *(uint4*)(Vs + d * 560 + 512 + c * 16) = uint4{0u, 0u, 0u, 0u};
    }
    {
      const int prow = lane >> 2, pc = 144 + (lane & 3) * 4;
      *(uint2*)(Ps + prow * 336 + pc * 2) = uint2{0u, 0u};
    }
    __syncthreads();
    const int g = w >> 1, hf = w & 1;
    const int qh = kvh * 4 + g;
    const float sink = p.at_sink[qh];
#pragma unroll
    for (int i = 0; i < 4; ++i) {
      const int q0 = hf * 64 + i * 16;
      const bf16x8 qf0 = qfa[i][0];
      const bf16x8 qf1 = qfa[i][1];
      f32x4 s[9];
#pragma unroll
      for (int j = 0; j < 9; ++j) {
        const char* kp = Ks + (q0 + j * 16 + lr) * 144 + lg * 16;
        const bf16x8 k0 = *(const bf16x8*)kp;
        const bf16x8 k1 = *(const bf16x8*)(kp + 64);
        f32x4 z = {0.f, 0.f, 0.f, 0.f};
        z = __builtin_amdgcn_mfma_f32_16x16x32_bf16(qf0, k0, z, 0, 0, 0);
        z = __builtin_amdgcn_mfma_f32_16x16x32_bf16(qf1, k1, z, 0, 0, 0);
        s[j] = z;
      }
      float mx[4], sum[4];
#pragma unroll
      for (int r = 0; r < 4; ++r) {
        const int ql = lg * 4 + r;
        float m = sink;
#pragma unroll
        for (int j = 0; j < 9; ++j) {
          float v = s[j][r] * 0.125f;
          bool ok = true;
          if (j == 0) ok = (lr >= ql);
          if (j == 8) ok = (lr <= ql);
          if (n == 0 && (q0 + j * 16 + lr) < 128) ok = false;
          v = ok ? v : -INFINITY;
          s[j][r] = v;
          m = fmaxf(m, v);
        }
        mx[r] = rowmax16(m);
      }
#pragma unroll
      for (int r = 0; r < 4; ++r) {
        float sm = 0.f;
#pragma unroll
        for (int j = 0; j < 9; ++j) {
          const float e = __expf(s[j][r] - mx[r]);
          s[j][r] = e;
          sm += e;
        }
        sm = rowsum16(sm);
        sum[r] = sm + __expf(sink - mx[r]);
      }
      u16* P = (u16*)Ps;
#pragma unroll
      for (int j = 0; j < 9; ++j)
#pragma unroll
        for (int r = 0; r < 4; ++r) P[(lg * 4 + r) * 168 + j * 16 + lr] = f2bf(s[j][r]);
      __builtin_amdgcn_wave_barrier();
      f32x4 o[4];
#pragma unroll
      for (int nd = 0; nd < 4; ++nd) o[nd] = f32x4{0.f, 0.f, 0.f, 0.f};
#pragma unroll
      for (int kk = 0; kk < 5; ++kk) {
        const bf16x8 pf = *(const bf16x8*)(Ps + lr * 336 + kk * 64 + lg * 16);
#pragma unroll
        for (int nd = 0; nd < 4; ++nd) {
          const bf16x8 vf = *(const bf16x8*)(Vs + (nd * 16 + lr) * 560 + (q0 + kk * 32 + lg * 8) * 2);
          o[nd] = __builtin_amdgcn_mfma_f32_16x16x32_bf16(pf, vf, o[nd], 0, 0, 0);
        }
      }
#pragma unroll
      for (int nd = 0; nd < 4; ++nd)
#pragma unroll
        for (int r = 0; r < 4; ++r) {
          const float v = o[nd][r] / sum[r];
          O[((size_t)b * 4096 + n * 128 + q0 + lg * 4 + r) * LDH + qh * 64 + nd * 16 + lr] = f2bf(v);
        }
      __builtin_amdgcn_wave_barrier();
    }
  }
  float* qs = (float*)lds;
  float* sc = (float*)(lds + 1024);
  float* part = (float*)(lds + 1024 + 2112);
  for (int it = blockIdx.x; it < 512; it += gridDim.x) {
    const int b = it >> 2, kvh = it & 3;
    const size_t row = (size_t)NP + b;
    __syncthreads();
    if (tid < 256) qs[tid] = bf2f(Qb[row * 1024 + kvh * 256 + tid]);
    __syncthreads();
    {
      const int key = tid >> 2, g = tid & 3;
      const float* kp = p.cache_k + (((size_t)b * 128 + key) * 4 + kvh) * 64;
      float dot = 0.f;
#pragma unroll
      for (int d4 = 0; d4 < 16; ++d4) {
        const float4 kv = *(const float4*)(kp + d4 * 4);
        const float* q = qs + g * 64 + d4 * 4;
        dot += kv.x * q[0] + kv.y * q[1] + kv.z * q[2] + kv.w * q[3];
      }
      sc[g * 132 + key] = dot * 0.125f;
      if (key >= 1) {
        float* dst = p.out + O_KS + (((size_t)b * 128 + key - 1) * 4 + kvh) * 64 + g * 16;
        const float* src = kp + g * 16;
#pragma unroll
        for (int d4 = 0; d4 < 4; ++d4) *(float4*)(dst + d4 * 4) = *(const float4*)(src + d4 * 4);
      }
      if (tid < 4) {
        const float* kn = p.out + O_KS + (((size_t)b * 128 + 127) * 4 + kvh) * 64;
        float d2 = 0.f;
        for (int d = 0; d < 64; ++d) d2 += kn[d] * qs[tid * 64 + d];
        sc[tid * 132 + 128] = d2 * 0.125f;
      }
    }
    __syncthreads();
    if (w < 4) {
      const float sink = p.at_sink[kvh * 4 + w];
      float* s = sc + w * 132;
      const float v0 = s[lane], v1 = s[64 + lane], v2 = lane == 0 ? s[128] : -INFINITY;
      float m = fmaxf(fmaxf(v0, v1), fmaxf(v2, sink));
      m = wavemax(m);
      const float e0 = __expf(v0 - m), e1 = __expf(v1 - m), e2 = lane == 0 ? __expf(v2 - m) : 0.f;
      float sm = wavesum(e0 + e1 + e2) + __expf(sink - m);
      const float inv = 1.f / sm;
      s[lane] = e0 * inv;
      s[64 + lane] = e1 * inv;
      if (lane == 0) s[128] = e2 * inv;
    }
    __syncthreads();
    {
      const int d = tid & 63, g = (tid >> 6) & 3, half = tid >> 8;
      const float* vp = p.cache_v + (((size_t)b * 128) * 4 + kvh) * 64 + d;
      float accv = 0.f;
      for (int key = half * 64; key < half * 64 + 64; ++key) {
        const float vv = vp[(size_t)key * 256];
        accv += sc[g * 132 + key] * vv;
        if (g == 0 && key >= 1) p.out[O_VS + (((size_t)b * 128 + key - 1) * 4 + kvh) * 64 + d] = vv;
      }
      if (half == 1) accv += sc[g * 132 + 128] * p.out[O_VS + (((size_t)b * 128 + 127) * 4 + kvh) * 64 + d];
      part[(half * 4 + g) * 64 + d] = accv;
    }
    __syncthreads();
    if (tid < 256) {
      const int d = tid & 63, g = tid >> 6;
      O[row * LDH + (kvh * 4 + g) * 64 + d] = f2bf(part[g * 64 + d] + part[(4 + g) * 64 + d]);
    }
  }
}

__global__ void __launch_bounds__(NTHR) mega(Params p) {
  extern __shared__ __attribute__((aligned(16))) char lds[];
  cg::grid_group grid = cg::this_grid();
  volatile LAS unsigned* xst = (volatile LAS unsigned*)(lds + LDS_BYTES);
  if (threadIdx.x == 0) { xst[0] = 0u; xst[1] = 0u; }
  __syncthreads();
  const XcdBarrier xb = xcd_barrier_post((unsigned*)(p.ws + WS_BAR), xst);
  const u16* wt = (const u16*)(p.ws + WS_WT);
  phase0(p, lds);
  if (p.out == nullptr) grid.sync();
  xcd_barrier(xb);
  phase_ada(p, lds);
  xcd_barrier(xb);
  phase_norm_mix(p);
  xcd_barrier(xb);
  phase_rwkv_proj(p, lds);
  xcd_barrier(xb);
  phase_rwkv_lora2(p, lds);
  xcd_barrier(xb);
  phase_scan(p, lds);
  xcd_barrier(xb);
  phase_gate(p, lds);
  xcd_barrier(xb);
  phase_oproj(p, lds, (const u16*)(p.ws + WS_H), 1024, wt + WT_WO, 0, 2, true);
  xcd_barrier(xb);
  phase_norm(p, 0, 1, false, false);
  xcd_barrier(xb);
  phase_up(p, lds, wt + WT_UP0);
  xcd_barrier(xb);
  phase_oproj(p, lds, (const u16*)(p.ws + S_UP), 4096, wt + WT_DN0, 0, 5, false);
  xcd_barrier(xb);
  phase_norm(p, 1, 0, false, false);
  xcd_barrier(xb);
  phase_qkv(p, lds);
  xcd_barrier(xb);
  phase_attn(p, lds);
  xcd_barrier(xb);
  phase_oproj(p, lds, (const u16*)(p.ws + S_O), 1024, wt + WT_WO1, 1, 2, false);
  xcd_barrier(xb);
  phase_norm(p, 1, 1, false, false);
  xcd_barrier(xb);
  phase_up(p, lds, wt + WT_UP1);
  xcd_barrier(xb);
  phase_oproj(p, lds, (const u16*)(p.ws + S_UP), 4096, wt + WT_DN1, 1, 5, false);
  xcd_barrier(xb);
  phase_final(p);
}

extern "C" void kernel_launch(void* const* d_in, const int* in_sizes, int n_in, void* d_out, int out_size, void* d_ws,
                              size_t ws_size, hipStream_t stream) {
  static int grid_blocks = 0;
  if (grid_blocks == 0) {
    if (ws_size < WS_END) {
      fprintf(stderr, "kernel_launch: workspace too small: %zu < %zu\n", ws_size, (size_t)WS_END);
      grid_blocks = -1;
      return;
    }
    int dev = 0, cus = 0, per_cu = 0;
    hipGetDevice(&dev);
    hipDeviceGetAttribute(&cus, hipDeviceAttributeMultiprocessorCount, dev);
    hipFuncSetAttribute((const void*)mega, hipFuncAttributeMaxDynamicSharedMemorySize, LDS_BYTES + 16);
    hipOccupancyMaxActiveBlocksPerMultiprocessor(&per_cu, (const void*)mega, NTHR, LDS_BYTES + 16);
    if (per_cu < 1) per_cu = 1;
    grid_blocks = cus * per_cu;
  }
  if (grid_blocks < 0) return;
  Params p{};
  const float** pp = (const float**)&p;
  for (int i = 0; i < 37; ++i) pp[i] = (const float*)d_in[i];
  p.out = (float*)d_out;
  p.ws = (char*)d_ws;
  hipMemsetAsync((char*)d_ws + WS_BAR, 0, 16384, stream);
  void* args[] = {&p};
  hipError_t e = hipLaunchCooperativeKernel((const void*)mega, dim3(grid_blocks), dim3(NTHR), args, LDS_BYTES + 16, stream);
  if (e != hipSuccess) fprintf(stderr, "cooperative launch failed: %s (grid %d)\n", hipGetErrorString(e), grid_blocks);
}
```
